# Optimizing an MI355X kernel written in HIP

```python
import jax, jax.numpy as jnp
from jax import lax
import numpy as np


D_MODEL = 1024
BATCH = 8
SEQ = 4096
DEPTH = 2

NSA_HEADS = 8
NSA_GROUPS = 2
NSA_HPG = NSA_HEADS // NSA_GROUPS
NSA_DK = 64
CMP_LEN = 32
CMP_STRIDE = 16
CMP_HID = 256
SLC_BLOCK = 64
SLC_TOPN = 16
WINDOW = 512
Q_BLOCK = 128
SGU_CHUNK = 128
SGU_GROUPS = 4
SGU_WIDTH = 512
SGU_GROUP_DIM = SGU_WIDTH // SGU_GROUPS
RWKV_HEADS = 8
RWKV_HEAD_DIM = 64
RWKV_WIDTH = RWKV_HEADS * RWKV_HEAD_DIM
DECAY_LORA = 64
AAA_LORA = 64
MV_LORA = 32
GATE_LORA = 128
N_BRANCH = 3
BRANCH_WIDTH = 512
D_FF = 2816
MACARON_WEIGHT = 0.5
RMS_EPS = 1e-6
LN_EPS = 1e-5
LNX_EPS = 64e-5
NEG_INF = -1e30
FORCE_SCORE = 1e4

NSA_SPLITS = (NSA_HEADS * NSA_DK,) + (NSA_GROUPS * NSA_DK,) * 6 + (3 * NSA_HEADS,)
RWKV_SPLITS = (RWKV_WIDTH,) * 3 + (DECAY_LORA, AAA_LORA, GATE_LORA)
RWKV_COLS = sum(RWKV_SPLITS)
IN_SPLITS = (sum(NSA_SPLITS), 2 * SGU_WIDTH, RWKV_COLS, N_BRANCH * D_MODEL)
IN_COLS = sum(IN_SPLITS)

kernel_name = 'hybrid_nsa_sgu_rwkv7_macaron_block'


def _split(z, sizes):
    return jnp.split(z, np.cumsum(sizes)[:-1].tolist(), axis=-1)


def rms_norm(x, g):
    xf = x.astype(jnp.float32)
    y = xf * lax.rsqrt(jnp.mean(jnp.square(xf), -1, keepdims=True) + RMS_EPS)
    return (y * g).astype(x.dtype)


def layer_norm(x, g, b):
    xf = x.astype(jnp.float32)
    mu = xf.mean(-1, keepdims=True)
    var = jnp.mean(jnp.square(xf - mu), -1, keepdims=True)
    return ((xf - mu) * lax.rsqrt(var + LN_EPS) * g + b).astype(x.dtype)


def _pre(x, g, m):
    return rms_norm(x, g) * (1 + m[:, 1][:, None]) + m[:, 0][:, None]


def _swiglu(h, w_in, w_out):
    w_gate, w_up = w_in[:, :D_FF], w_in[:, D_FF:]
    return (jax.nn.silu(h @ w_gate) * (h @ w_up)) @ w_out


def _alibi_slopes():
    h = np.arange(1, NSA_HEADS + 1, dtype=np.float32)
    return jnp.asarray(2.0 ** (-8.0 * h / NSA_HEADS), jnp.float32).reshape(NSA_GROUPS, NSA_HPG)


def _masked_softmax(s, valid):
    s = jnp.where(valid, s, NEG_INF)
    return jnp.where(valid, jax.nn.softmax(s, axis=-1), 0.0)


def _selection_map(n_cmp, n_slc):
    rs, rc = SLC_BLOCK // CMP_STRIDE, CMP_LEN // CMP_STRIDE
    j = np.arange(n_slc)[:, None, None]
    i = np.broadcast_to(rs * j - np.arange(rs)[None, :, None] - np.arange(rc)[None, None, :], (n_slc, rs, rc))
    jj = np.broadcast_to(j, i.shape)
    ok = (i >= 0) & (i < n_cmp)
    m = np.zeros((n_cmp, n_slc), np.float32)
    np.add.at(m, (i[ok], jj[ok]), 1.0)
    return jnp.asarray(m)


def _compress(blk, pe, w1, w2):
    B, n, L, G, DK = blk.shape
    blk = (blk + pe[:, None, :]).transpose(0, 1, 3, 2, 4).reshape(B, n, G, L * DK)
    return jax.nn.silu(blk @ w1) @ w2


def nsa_mixer(p, k_w1, k_w2, k_pe, v_w1, v_w2, v_pe):
    B, S, _ = p.shape
    G, HPG, DK = NSA_GROUPS, NSA_HPG, NSA_DK
    f32 = jnp.float32
    q, kc, vc, ks, vs, kw, vw, gt = _split(p, NSA_SPLITS)
    q = (q * NSA_DK ** -0.5).reshape(B, S, G, HPG, DK)
    kc, vc, ks, vs, kw, vw = [z.reshape(B, S, G, DK) for z in (kc, vc, ks, vs, kw, vw)]
    gt = jax.nn.sigmoid(gt.astype(f32)).reshape(B, S, G, HPG, 3)
    n_cmp = (S - CMP_LEN) // CMP_STRIDE + 1
    cmp_idx = np.arange(n_cmp)[:, None] * CMP_STRIDE + np.arange(CMP_LEN)[None, :]
    kc = _compress(kc[:, cmp_idx], k_pe, k_w1, k_w2)
    vc = _compress(vc[:, cmp_idx], v_pe, v_w1, v_w2)
    cmp_end = jnp.asarray(cmp_idx[:, -1], jnp.int32)
    n_slc = S // SLC_BLOCK
    n_top = min(SLC_TOPN, n_slc)
    sel_map = _selection_map(n_cmp, n_slc)
    ks = ks.reshape(B, n_slc, SLC_BLOCK, G, DK).transpose(0, 3, 1, 2, 4)
    vs = vs.reshape(B, n_slc, SLC_BLOCK, G, DK).transpose(0, 3, 1, 2, 4)
    pad = ((0, 0), (WINDOW, 0), (0, 0), (0, 0))
    kw, vw = jnp.pad(kw, pad), jnp.pad(vw, pad)
    slopes = _alibi_slopes()
    b_ix = jnp.arange(B)[:, None, None, None]
    g_ix = jnp.arange(G)[None, :, None, None]
    slc_ids = jnp.arange(n_slc, dtype=jnp.int32)
    n_qb = S // Q_BLOCK

    def to_blocks(z):
        return jnp.moveaxis(z.reshape((B, n_qb, Q_BLOCK) + z.shape[2:]), 1, 0)

    def one_block(args):
        qb, gb, s0 = args
        t = s0 + jnp.arange(Q_BLOCK, dtype=jnp.int32)
        d_c = (t[:, None] - cmp_end[None, :]).astype(f32)
        s_c = jnp.einsum('bqghd,bngd->bghqn', qb, kc, preferred_element_type=f32)
        p_c = _masked_softmax(s_c - slopes[:, :, None, None] * d_c, d_c >= 0)
        o_c = jnp.einsum('bghqn,bngd->bqghd', p_c.astype(vc.dtype), vc, preferred_element_type=f32)
        imp = jnp.einsum('bghqn,nj->bgqj', p_c, sel_map)
        cur = (t // SLC_BLOCK)[:, None]
        forced = (slc_ids == 0) | (slc_ids == cur) | (slc_ids == cur - 1)
        live = slc_ids * SLC_BLOCK <= t[:, None]
        imp = jnp.where(forced, FORCE_SCORE, jnp.where(live, imp, NEG_INF))
        _, sel = lax.top_k(imp, n_top)
        k_sel = ks[b_ix, g_ix, sel].reshape(B, G, Q_BLOCK, n_top * SLC_BLOCK, DK)
        v_sel = vs[b_ix, g_ix, sel].reshape(B, G, Q_BLOCK, n_top * SLC_BLOCK, DK)
        pos_s = (sel[..., None] * SLC_BLOCK + jnp.arange(SLC_BLOCK, dtype=jnp.int32)).reshape(B, G, Q_BLOCK, n_top * SLC_BLOCK)
        d_s = (t[:, None] - pos_s).astype(f32)[:, :, None]
        s_s = jnp.einsum('bqghd,bgqkd->bghqk', qb, k_sel, preferred_element_type=f32)
        p_s = _masked_softmax(s_s - slopes[:, :, None, None] * d_s, d_s >= 0)
        o_s = jnp.einsum('bghqk,bgqkd->bqghd', p_s.astype(v_sel.dtype), v_sel, preferred_element_type=f32)
        k_win = lax.dynamic_slice_in_dim(kw, s0, WINDOW + Q_BLOCK, axis=1)
        v_win = lax.dynamic_slice_in_dim(vw, s0, WINDOW + Q_BLOCK, axis=1)
        pos_w = s0 - WINDOW + jnp.arange(WINDOW + Q_BLOCK, dtype=jnp.int32)
        d_w = t[:, None] - pos_w[None, :]
        valid_w = (d_w >= 0) & (d_w < WINDOW) & (pos_w[None, :] >= 0)
        s_w = jnp.einsum('bqghd,bkgd->bghqk', qb, k_win, preferred_element_type=f32)
        p_w = _masked_softmax(s_w - slopes[:, :, None, None] * d_w.astype(f32), valid_w)
        o_w = jnp.einsum('bghqk,bkgd->bqghd', p_w.astype(v_win.dtype), v_win, preferred_element_type=f32)
        o = gb[..., 0:1] * o_c + gb[..., 1:2] * o_s + gb[..., 2:3] * o_w
        return o.reshape(B, Q_BLOCK, NSA_HEADS * NSA_DK).astype(p.dtype)

    starts = jnp.arange(n_qb, dtype=jnp.int32) * Q_BLOCK
    out = lax.map(one_block, (to_blocks(q), to_blocks(gt), starts))
    return jnp.moveaxis(out, 0, 1).reshape(B, S, NSA_HEADS * NSA_DK)


def sgu_mixer(p, ln_g, ln_b, w_s, b_s):
    B, S, _ = p.shape
    u, v = jnp.split(jax.nn.gelu(p), 2, axis=-1)
    v = layer_norm(v, ln_g, ln_b)
    v = v.reshape(B, S // SGU_CHUNK, SGU_CHUNK, SGU_GROUPS, SGU_GROUP_DIM)
    causal = jnp.tril(jnp.ones((SGU_CHUNK, SGU_CHUNK), dtype=bool))
    w = jnp.where(causal, w_s, 0).astype(v.dtype)
    s = jnp.einsum('gts,bnsgc->bntgc', w, v) + b_s.T[:, :, None]
    return u * s.reshape(B, S, SGU_WIDTH)


def rwkv7_mixer(p, mu, w0, w2, a0, a2, g2, k_k, k_a, r_k, lnx_g, lnx_b, v_first, v_res):
    B, S, _ = p.shape
    H, N = RWKV_HEADS, RWKV_HEAD_DIM
    f32 = jnp.float32
    p_prev = jnp.pad(p, ((0, 0), (1, 0), (0, 0)))[:, :-1]
    p = p + (p_prev - p) * mu
    r, k, v, wd, ad, gd = _split(p, RWKV_SPLITS)
    w = -jax.nn.softplus(-(w0 + jnp.tanh(wd) @ w2)) - 0.5
    a = jax.nn.sigmoid(a0 + ad @ a2)
    g = jax.nn.sigmoid(gd) @ g2
    if v_res is None:
        v_first = v
    else:
        v0, v1, v2 = v_res
        v = v + (v_first - v) * jax.nn.sigmoid(v0 + (v @ v1) @ v2)

    def heads(z):
        return z.astype(f32).reshape(B, S, H, N)

    kk = heads(k * k_k)
    kk = kk / jnp.maximum(jnp.linalg.norm(kk, axis=-1, keepdims=True), 1e-12)
    k = k * (1 + (a - 1) * k_a)
    rh, kh, vh, ah = heads(r), heads(k), heads(v), heads(a)
    decay = jnp.exp(-jnp.exp(heads(w)))
    xs = tuple(jnp.moveaxis(z, 1, 0) for z in (rh, decay, kh, vh, -kk, kk * ah))

    def step(state, inp):
        r_t, w_t, k_t, v_t, a_t, b_t = inp
        sa = jnp.einsum('bhij,bhj->bhi', state, a_t)
        state = state * w_t[:, :, None, :] + sa[..., None] * b_t[:, :, None, :] + v_t[..., None] * k_t[:, :, None, :]
        return state, jnp.einsum('bhij,bhj->bhi', state, r_t)

    _, y = lax.scan(step, jnp.zeros((B, H, N, N), f32), xs)
    y = jnp.moveaxis(y, 0, 1)
    mean = y.mean(-1, keepdims=True)
    var = jnp.mean(jnp.square(y - mean), -1, keepdims=True)
    y = ((y - mean) * lax.rsqrt(var + LNX_EPS)).reshape(B, S, RWKV_WIDTH) * lnx_g + lnx_b
    bonus = (jnp.sum(rh * kh * r_k, -1, keepdims=True) * vh).reshape(B, S, RWKV_WIDTH)
    y = (y + bonus) * g
    return y.astype(p.dtype), v_first


def setup_inputs(seed: int = 0) -> dict:
    key = jax.random.key(seed)
    ks = iter(jax.random.split(key, 40))
    L, D = DEPTH, D_MODEL

    def nrm(shape, s):
        return s * jax.random.normal(next(ks), shape, jnp.float32)

    return {
        'x': nrm((BATCH, SEQ, D), 1.0),
        'c': nrm((BATCH, D), 1.0),
        'ada_w': nrm((L, D, 9 * D), 0.5 * D ** -0.5),
        'ada_b': nrm((L, 9 * D), 0.02),
        'pre_g': 1.0 + nrm((L, 3, D), 0.1),
        'post_g': 1.0 + nrm((L, 3, D), 0.1),
        'ffn_w_in': nrm((L, 2, D, 2 * D_FF), D ** -0.5),
        'ffn_w_out': nrm((L, 2, D_FF, D), D_FF ** -0.5),
        'mix_w_in': nrm((L, D, IN_COLS), D ** -0.5),
        'branch_w': nrm((L, N_BRANCH, BRANCH_WIDTH, D), BRANCH_WIDTH ** -0.5),
        'out_w': nrm((L, D, D), D ** -0.5),
        'cmp_k_w1': nrm((L, CMP_LEN * NSA_DK, CMP_HID), (CMP_LEN * NSA_DK) ** -0.5),
        'cmp_k_w2': nrm((L, CMP_HID, NSA_DK), CMP_HID ** -0.5),
        'cmp_k_pe': nrm((L, CMP_LEN, NSA_DK), 0.1),
        'cmp_v_w1': nrm((L, CMP_LEN * NSA_DK, CMP_HID), (CMP_LEN * NSA_DK) ** -0.5),
        'cmp_v_w2': nrm((L, CMP_HID, NSA_DK), CMP_HID ** -0.5),
        'cmp_v_pe': nrm((L, CMP_LEN, NSA_DK), 0.1),
        'sgu_ln_g': 1.0 + nrm((L, SGU_WIDTH), 0.1),
        'sgu_ln_b': nrm((L, SGU_WIDTH), 0.02),
        'sgu_w': nrm((L, SGU_GROUPS, SGU_CHUNK, SGU_CHUNK), 0.5 * SGU_CHUNK ** -0.5),
        'sgu_b': 1.0 + nrm((L, SGU_GROUPS, SGU_CHUNK), 0.1),
        'rwkv_mu': jax.random.uniform(next(ks), (L, RWKV_COLS), jnp.float32),
        'rwkv_w0': -1.0 + nrm((L, RWKV_WIDTH), 0.3),
        'rwkv_w2': nrm((L, DECAY_LORA, RWKV_WIDTH), 0.5 * DECAY_LORA ** -0.5),
        'rwkv_a0': nrm((L, RWKV_WIDTH), 0.1),
        'rwkv_a2': nrm((L, AAA_LORA, RWKV_WIDTH), 0.5 * AAA_LORA ** -0.5),
        'rwkv_g2': nrm((L, GATE_LORA, RWKV_WIDTH), GATE_LORA ** -0.5),
        'rwkv_kk': 1.0 + nrm((L, RWKV_WIDTH), 0.1),
        'rwkv_ka': 1.0 + nrm((L, RWKV_WIDTH), 0.1),
        'rwkv_rk': nrm((L, RWKV_HEADS, RWKV_HEAD_DIM), 0.1),
        'rwkv_lnx_g': 1.0 + nrm((L, RWKV_WIDTH), 0.1),
        'rwkv_lnx_b': nrm((L, RWKV_WIDTH), 0.02),
        'rwkv_v0': nrm((L - 1, RWKV_WIDTH), 0.1),
        'rwkv_v1': nrm((L - 1, RWKV_WIDTH, MV_LORA), RWKV_WIDTH ** -0.5),
        'rwkv_v2': nrm((L - 1, MV_LORA, RWKV_WIDTH), MV_LORA ** -0.5),
    }


def reference(x, c, ada_w, ada_b, pre_g, post_g, ffn_w_in, ffn_w_out, mix_w_in, branch_w, out_w,
              cmp_k_w1, cmp_k_w2, cmp_k_pe, cmp_v_w1, cmp_v_w2, cmp_v_pe,
              sgu_ln_g, sgu_ln_b, sgu_w, sgu_b,
              rwkv_mu, rwkv_w0, rwkv_w2, rwkv_a0, rwkv_a2, rwkv_g2, rwkv_kk, rwkv_ka, rwkv_rk,
              rwkv_lnx_g, rwkv_lnx_b, rwkv_v0, rwkv_v1, rwkv_v2):
    B = x.shape[0]
    cond = jax.nn.silu(c)
    v_first = None
    for l in range(DEPTH):
        mod = (cond @ ada_w[l] + ada_b[l]).reshape(B, 3, 3, D_MODEL)
        h = _pre(x, pre_g[l, 0], mod[:, 0])
        y = _swiglu(h, ffn_w_in[l, 0], ffn_w_out[l, 0])
        x = x + MACARON_WEIGHT * mod[:, 0, 2][:, None] * rms_norm(y, post_g[l, 0])
        h = _pre(x, pre_g[l, 1], mod[:, 1])
        w_nsa, w_sgu, w_rwkv, w_gate = _split(mix_w_in[l], IN_SPLITS)
        y_a = nsa_mixer(h @ w_nsa, cmp_k_w1[l], cmp_k_w2[l], cmp_k_pe[l], cmp_v_w1[l], cmp_v_w2[l], cmp_v_pe[l])
        y_b = sgu_mixer(h @ w_sgu, sgu_ln_g[l], sgu_ln_b[l], sgu_w[l], sgu_b[l])
        v_res = None if l == 0 else (rwkv_v0[l - 1], rwkv_v1[l - 1], rwkv_v2[l - 1])
        y_c, v_first = rwkv7_mixer(h @ w_rwkv, rwkv_mu[l], rwkv_w0[l], rwkv_w2[l], rwkv_a0[l], rwkv_a2[l],
                                   rwkv_g2[l], rwkv_kk[l], rwkv_ka[l], rwkv_rk[l], rwkv_lnx_g[l], rwkv_lnx_b[l],
                                   v_first, v_res)
        gate_cols = _split(w_gate, (D_MODEL,) * N_BRANCH)
        merged = 0.0
        for i, (w_g, y_i) in enumerate(zip(gate_cols, (y_a, y_b, y_c))):
            merged = merged + jax.nn.sigmoid(h @ w_g) * (y_i @ branch_w[l, i])
        y = merged @ out_w[l]
        x = x + mod[:, 1, 2][:, None] * rms_norm(y, post_g[l, 1])
        h = _pre(x, pre_g[l, 2], mod[:, 2])
        y = _swiglu(h, ffn_w_in[l, 1], ffn_w_out[l, 1])
        x = x + MACARON_WEIGHT * mod[:, 2, 2][:, None] * rms_norm(y, post_g[l, 2])
    return x
```

```cpp
#include <hip/hip_runtime.h>
#include <hip/hip_cooperative_groups.h>
#include <cstdio>
#include <cstdint>
namespace cg = cooperative_groups;

#ifndef COOP
#define COOP 1
#endif

typedef unsigned short u16;
using bf16x8 = __attribute__((ext_vector_type(8))) short;
using f32x4 = __attribute__((ext_vector_type(4))) float;

constexpr int T = 32768, D = 1024, SEQ = 4096, DFF = 2816;
constexpr int PS1 = 2072, PS2 = 3328;
constexpr int MIXC = 7192, MIXN = 4120;
constexpr size_t OFF_P1 = 0;
constexpr size_t OFF_P2 = OFF_P1 + (size_t)T * PS1 * 2;
constexpr size_t OFF_H = OFF_P2 + (size_t)T * PS2 * 2;
constexpr size_t OFF_WMIX = OFF_H + (size_t)T * 1024 * 2;
constexpr size_t OFF_WG = OFF_WMIX + (size_t)4224 * 1024 * 2;
constexpr size_t OFF_WB = OFF_WG + (size_t)3072 * 1024 * 2;
constexpr size_t OFF_WO = OFF_WB + (size_t)3 * 1024 * 512 * 2;
constexpr size_t OFF_W1 = OFF_WO + (size_t)1024 * 1024 * 2;
constexpr size_t OFF_WIN = OFF_W1 + (size_t)2 * 256 * 2048 * 2;
constexpr size_t OFF_WOUT = OFF_WIN + (size_t)5632 * 1024 * 2;
constexpr size_t OFF_VFIRST = OFF_WOUT + (size_t)1024 * 2816 * 2;
constexpr size_t OFF_VT = OFF_VFIRST + (size_t)T * 512 * 2;
constexpr size_t OFF_MOD = OFF_VT + (size_t)2 * 8 * 2 * 64 * 4096 * 2;
constexpr size_t OFF_PB = OFF_MOD + (size_t)2 * 8 * 9216 * 4;
constexpr size_t OFF_HID = OFF_PB + (size_t)1024 * 1792 * 2;
constexpr size_t OFF_KC = OFF_HID + (size_t)2 * 4096 * 256 * 2;
constexpr size_t OFF_VC = OFF_KC + (size_t)8 * 2 * 256 * 64 * 2;
constexpr size_t OFF_LV = OFF_VC + (size_t)8 * 2 * 64 * 256 * 2;
constexpr size_t WS_END = OFF_LV + (size_t)T * 32 * 4;
constexpr size_t OFF_ACT = OFF_P1;
constexpr size_t OFF_YF = OFF_ACT + (size_t)T * DFF * 2;
constexpr size_t OFF_H2 = OFF_P2;
constexpr size_t OFF_MERGED = OFF_H2 + (size_t)T * 1024 * 2;
constexpr size_t OFF_YM = OFF_MERGED + (size_t)T * 1024 * 2;
constexpr size_t OFF_YC = OFF_H;

constexpr int SMEM_BYTES = 73728;

struct Params { const float* in[35]; float* out; char* ws; };

__device__ __forceinline__ int tidx() { int t = __builtin_amdgcn_workitem_id_x(); asm volatile("" : "+v"(t)); return t; }
__device__ __forceinline__ float bf2f(u16 u) { return __uint_as_float(((unsigned)u) << 16); }
__device__ __forceinline__ u16 f2bf(float f) { unsigned u = __float_as_uint(f); u += 0x7fffu + ((u >> 16) & 1u); return (u16)(u >> 16); }
__device__ __forceinline__ unsigned pack2(float a, float b) { return (unsigned)f2bf(a) | (((unsigned)f2bf(b)) << 16); }
__device__ __forceinline__ float sigmoidf_(float x) { return 1.f / (1.f + __expf(-x)); }
__device__ __forceinline__ float siluf_(float x) { return x / (1.f + __expf(-x)); }
__device__ __forceinline__ float geluf_(float x) { float u = 0.7978845608028654f * (x + 0.044715f * x * x * x); return 0.5f * x * (1.f + tanhf(u)); }
__device__ __forceinline__ float wave_sum(float v) {
#pragma unroll
  for (int o = 32; o >= 1; o >>= 1) v += __shfl_xor(v, o);
  return v;
}
__device__ __forceinline__ f32x4 mfma16(bf16x8 a, bf16x8 b, f32x4 c) { return __builtin_amdgcn_mfma_f32_16x16x32_bf16(a, b, c, 0, 0, 0); }

__device__ __forceinline__ void conv_w(const float* src, int ld, int K, u16* dst, int NR, int nvalid, int coff, int kind, char* smem) {
  float* tl = (float*)smem;
  const int tid = tidx();
  const int ktn = K >> 6, ntile = (NR >> 6) * ktn;
  for (int tix = blockIdx.x; tix < ntile; tix += gridDim.x) {
    const int R0 = (tix / ktn) << 6, k0 = (tix % ktn) << 6;
    const int c = tid & 63, kq = tid >> 6;
    const int R = R0 + c;
    int sc; bool ok;
    if (kind == 0) { sc = coff + R; ok = R < nvalid; }
    else { int ntl = R >> 7, w = (R >> 6) & 1, n = (R >> 4) & 3, r = R & 15; sc = ((n >= 2) ? DFF : 0) + ntl * 64 + w * 32 + (n & 1) * 16 + r; ok = true; }
#pragma unroll 4
    for (int i = 0; i < 16; ++i) {
      int k = k0 + kq * 16 + i;
      tl[c * 65 + kq * 16 + i] = ok ? src[(size_t)k * ld + sc] : 0.f;
    }
    __syncthreads();
    {
      const int r = tid >> 2, ks = tid & 3;
      const float* s = tl + r * 65 + ks * 16;
      uint4 o0, o1;
      o0.x = pack2(s[0], s[1]); o0.y = pack2(s[2], s[3]); o0.z = pack2(s[4], s[5]); o0.w = pack2(s[6], s[7]);
      o1.x = pack2(s[8], s[9]); o1.y = pack2(s[10], s[11]); o1.z = pack2(s[12], s[13]); o1.w = pack2(s[14], s[15]);
      uint4* dp = (uint4*)(dst + (size_t)(R0 + r) * K + k0 + ks * 16);
      dp[0] = o0; dp[1] = o1;
    }
    __syncthreads();
  }
}

__device__ __forceinline__ void conv_ffn(const Params& p, int l, int f, char* smem) {
  conv_w(p.in[6] + (size_t)(l * 2 + f) * D * (2 * DFF), 2 * DFF, D, (u16*)(p.ws + OFF_WIN), 5632, 5632, 0, 1, smem);
  conv_w(p.in[7] + (size_t)(l * 2 + f) * DFF * D, D, DFF, (u16*)(p.ws + OFF_WOUT), 1024, 1024, 0, 0, smem);
}
__device__ __forceinline__ void conv_mix(const Params& p, int l, char* smem) {
  const float* mw = p.in[8] + (size_t)l * D * MIXC;
  conv_w(mw, MIXC, D, (u16*)(p.ws + OFF_WMIX), 4224, MIXN, 0, 0, smem);
  conv_w(mw, MIXC, D, (u16*)(p.ws + OFF_WG), 3072, 3072, MIXN, 0, smem);
  for (int i = 0; i < 3; ++i)
    conv_w(p.in[9] + (size_t)(l * 3 + i) * 512 * D, D, 512, (u16*)(p.ws + OFF_WB) + (size_t)i * 1024 * 512, 1024, 1024, 0, 0, smem);
  conv_w(p.in[10] + (size_t)l * D * D, D, D, (u16*)(p.ws + OFF_WO), 1024, 1024, 0, 0, smem);
  conv_w(p.in[11] + (size_t)l * 2048 * 256, 256, 2048, (u16*)(p.ws + OFF_W1), 256, 256, 0, 0, smem);
  conv_w(p.in[14] + (size_t)l * 2048 * 256, 256, 2048, (u16*)(p.ws + OFF_W1) + (size_t)256 * 2048, 256, 256, 0, 0, smem);
}

__device__ __forceinline__ void phase_mod(const Params& p, char* smem) {
  float* cond = (float*)smem;
  float* red = cond + 8192;
  const int tid = tidx();
  float* MOD = (float*)(p.ws + OFF_MOD);
  for (int item = blockIdx.x; item < 288; item += gridDim.x) {
    for (int e = tid; e < 8192; e += 256) cond[e] = siluf_(p.in[1][e]);
    __syncthreads();
    const int l = item / 144, n0 = (item % 144) * 64, col = n0 + (tid & 63), kq = tid >> 6;
    float acc[8];
#pragma unroll
    for (int b = 0; b < 8; ++b) acc[b] = 0.f;
    const float* w = p.in[2] + (size_t)l * D * 9216 + col;
#pragma unroll 4
    for (int k = kq * 256; k < kq * 256 + 256; ++k) {
      float wv = w[(size_t)k * 9216];
#pragma unroll
      for (int b = 0; b < 8; ++b) acc[b] += cond[b * 1024 + k] * wv;
    }
#pragma unroll
    for (int b = 0; b < 8; ++b) red[(kq * 8 + b) * 64 + (tid & 63)] = acc[b];
    __syncthreads();
    for (int e = tid; e < 512; e += 256) {
      int b = e >> 6, c = e & 63;
      float s = red[(0 * 8 + b) * 64 + c] + red[(1 * 8 + b) * 64 + c] + red[(2 * 8 + b) * 64 + c] + red[(3 * 8 + b) * 64 + c];
      MOD[(size_t)(l * 8 + b) * 9216 + n0 + c] = s + p.in[3][(size_t)l * 9216 + n0 + c];
    }
    __syncthreads();
  }
}

__device__ __forceinline__ void phase_norm(const float* xin, float* xout, const u16* y, const float* postg, const float* gate, float wgt,
                           const float* preg, const float* shift, const float* scale, u16* h) {
  const int lane = tidx() & 63, wid = tidx() >> 6;
  for (int row = blockIdx.x * 4 + wid; row < T; row += gridDim.x * 4) {
    const int b = row >> 12;
    float4 xv[4];
#pragma unroll
    for (int i = 0; i < 4; ++i) xv[i] = *(const float4*)(xin + (size_t)row * D + i * 256 + lane * 4);
    if (y) {
      float yv[4][4]; float ss = 0.f;
#pragma unroll
      for (int i = 0; i < 4; ++i) {
        uint2 u = *(const uint2*)(y + (size_t)row * D + i * 256 + lane * 4);
        yv[i][0] = bf2f((u16)(u.x & 0xffff)); yv[i][1] = bf2f((u16)(u.x >> 16));
        yv[i][2] = bf2f((u16)(u.y & 0xffff)); yv[i][3] = bf2f((u16)(u.y >> 16));
        ss += yv[i][0] * yv[i][0] + yv[i][1] * yv[i][1] + yv[i][2] * yv[i][2] + yv[i][3] * yv[i][3];
      }
      ss = wave_sum(ss);
      const float rs = rsqrtf(ss * (1.f / 1024.f) + 1e-6f) * wgt;
#pragma unroll
      for (int i = 0; i < 4; ++i) {
        const int c = i * 256 + lane * 4;
        float4 g = *(const float4*)(gate + (size_t)b * 9216 + c);
        float4 pg = *(const float4*)(postg + c);
        xv[i].x += g.x * yv[i][0] * rs * pg.x; xv[i].y += g.y * yv[i][1] * rs * pg.y;
        xv[i].z += g.z * yv[i][2] * rs * pg.z; xv[i].w += g.w * yv[i][3] * rs * pg.w;
      }
    }
    if (xout) {
#pragma unroll
      for (int i = 0; i < 4; ++i) *(float4*)(xout + (size_t)row * D + i * 256 + lane * 4) = xv[i];
    }
    if (h) {
      float ss = 0.f;
#pragma unroll
      for (int i = 0; i < 4; ++i) ss += xv[i].x * xv[i].x + xv[i].y * xv[i].y + xv[i].z * xv[i].z + xv[i].w * xv[i].w;
      ss = wave_sum(ss);
      const float rs = rsqrtf(ss * (1.f / 1024.f) + 1e-6f);
#pragma unroll
      for (int i = 0; i < 4; ++i) {
        const int c = i * 256 + lane * 4;
        float4 pg = *(const float4*)(preg + c);
        float4 sh = *(const float4*)(shift + (size_t)b * 9216 + c);
        float4 sc = *(const float4*)(scale + (size_t)b * 9216 + c);
        uint2 o;
        o.x = pack2(xv[i].x * rs * pg.x * (1.f + sc.x) + sh.x, xv[i].y * rs * pg.y * (1.f + sc.y) + sh.y);
        o.y = pack2(xv[i].z * rs * pg.z * (1.f + sc.z) + sh.z, xv[i].w * rs * pg.w * (1.f + sc.w) + sh.w);
        *(uint2*)(h + (size_t)row * D + c) = o;
      }
    }
  }
}

template <int NS, class FA, class FB>
__device__ __forceinline__ void gemm_loop(f32x4 (&acc)[4][NS], const FA& fa, const FB& fb, int K, u16* sm) {
  constexpr int BN = 32 * NS;
  constexpr int NBV = BN / 32;
  const int tid = tidx(), lane = tid & 63, wid = tid >> 6, wr = wid >> 1, wc = wid & 1, fr = lane & 15, fq = lane >> 4;
  u16* As = sm; u16* Bs = sm + 2 * 128 * 72;
  uint4 ra[4], rb[NBV];
  const int nt = K >> 6;
#pragma unroll
  for (int i = 0; i < 4; ++i) { int v = tid + i * 256; ra[i] = fa(v >> 3, (v & 7) * 8); }
#pragma unroll
  for (int i = 0; i < NBV; ++i) { int v = tid + i * 256; rb[i] = fb(v >> 3, (v & 7) * 8); }
#pragma unroll
  for (int i = 0; i < 4; ++i) { int v = tid + i * 256; *(uint4*)(As + (v >> 3) * 72 + (v & 7) * 8) = ra[i]; }
#pragma unroll
  for (int i = 0; i < NBV; ++i) { int v = tid + i * 256; *(uint4*)(Bs + (v >> 3) * 72 + (v & 7) * 8) = rb[i]; }
  __syncthreads();
#pragma unroll 1
  for (int kt = 0; kt < nt; ++kt) {
    const int cur = kt & 1;
    if (kt + 1 < nt) {
      const int kb = (kt + 1) << 6;
#pragma unroll
      for (int i = 0; i < 4; ++i) { int v = tid + i * 256; ra[i] = fa(v >> 3, kb + (v & 7) * 8); }
#pragma unroll
      for (int i = 0; i < NBV; ++i) { int v = tid + i * 256; rb[i] = fb(v >> 3, kb + (v & 7) * 8); }
    }
    const u16* Ab = As + cur * 128 * 72 + (wr * 64 + fr) * 72 + fq * 8;
    const u16* Bb = Bs + cur * BN * 72 + (wc * 16 * NS + fr) * 72 + fq * 8;
#pragma unroll
    for (int ks = 0; ks < 2; ++ks) {
      bf16x8 a[4], b[NS];
#pragma unroll
      for (int m = 0; m < 4; ++m) a[m] = *(const bf16x8*)(Ab + m * 16 * 72 + ks * 32);
#pragma unroll
      for (int n = 0; n < NS; ++n) b[n] = *(const bf16x8*)(Bb + n * 16 * 72 + ks * 32);
#pragma unroll
      for (int m = 0; m < 4; ++m)
#pragma unroll
        for (int n = 0; n < NS; ++n) acc[m][n] = mfma16(a[m], b[n], acc[m][n]);
    }
    if (kt + 1 < nt) {
      u16* Aw = As + (cur ^ 1) * 128 * 72; u16* Bw = Bs + (cur ^ 1) * BN * 72;
#pragma unroll
      for (int i = 0; i < 4; ++i) { int v = tid + i * 256; *(uint4*)(Aw + (v >> 3) * 72 + (v & 7) * 8) = ra[i]; }
#pragma unroll
      for (int i = 0; i < NBV; ++i) { int v = tid + i * 256; *(uint4*)(Bw + (v >> 3) * 72 + (v & 7) * 8) = rb[i]; }
    }
    __syncthreads();
  }
}

__device__ __forceinline__ bool tile_map(int it, int NT, int& mt, int& nt) {
  const int g = gridDim.x;
  if ((g & 7) == 0) {
    const int xcd = blockIdx.x & 7, bx = blockIdx.x >> 3, nbx = g >> 3;
    const int lid = bx + it * nbx;
    if (lid >= 32 * NT) return false;
    const int grp = lid / (8 * NT), rem = lid - grp * 8 * NT;
    nt = rem >> 3; mt = xcd * 32 + grp * 8 + (rem & 7);
    return true;
  } else {
    const int id = blockIdx.x + it * g;
    if (id >= 256 * NT) return false;
    nt = id % NT; mt = id / NT;
    return true;
  }
}

#define ZERO_ACC(acc, NSV) _Pragma("unroll") for (int m_ = 0; m_ < 4; ++m_) _Pragma("unroll") for (int n_ = 0; n_ < NSV; ++n_) acc[m_][n_] = f32x4{0.f, 0.f, 0.f, 0.f};

__device__ __forceinline__ void phase_ffn_in(const Params& p, char* smem) {
  const u16* H = (const u16*)(p.ws + OFF_H); const u16* W = (const u16*)(p.ws + OFF_WIN); u16* ACT = (u16*)(p.ws + OFF_ACT);
  const int lane = tidx() & 63, wid = tidx() >> 6, wr = wid >> 1, wc = wid & 1, fr = lane & 15, fq = lane >> 4;
  int mt, nt;
  for (int it = 0; tile_map(it, 44, mt, nt); ++it) {
    const int m0 = mt * 128, n0 = nt * 128;
    f32x4 acc[4][4]; ZERO_ACC(acc, 4)
    auto fa = [&](int r, int k) { return *(const uint4*)(H + (size_t)(m0 + r) * 1024 + k); };
    auto fb = [&](int r, int k) { return *(const uint4*)(W + (size_t)(n0 + r) * 1024 + k); };
    gemm_loop<4>(acc, fa, fb, 1024, (u16*)smem);
#pragma unroll
    for (int m = 0; m < 4; ++m)
#pragma unroll
      for (int n = 0; n < 2; ++n) {
        const int col = nt * 64 + wc * 32 + n * 16 + fr;
        const int r0 = m0 + wr * 64 + m * 16 + fq * 4;
#pragma unroll
        for (int j = 0; j < 4; ++j) ACT[(size_t)(r0 + j) * DFF + col] = f2bf(siluf_(acc[m][n][j]) * acc[m][n + 2][j]);
      }
  }
}

__device__ __forceinline__ void phase_gemm_plain(const u16* A, int lda, const u16* Bt, int K, u16* C, char* smem) {
  const int lane = tidx() & 63, wid = tidx() >> 6, wr = wid >> 1, wc = wid & 1, fr = lane & 15, fq = lane >> 4;
  int mt, nt;
  for (int it = 0; tile_map(it, 8, mt, nt); ++it) {
    const int m0 = mt * 128, n0 = nt * 128;
    f32x4 acc[4][4]; ZERO_ACC(acc, 4)
    auto fa = [&](int r, int k) { return *(const uint4*)(A + (size_t)(m0 + r) * lda + k); };
    auto fb = [&](int r, int k) { return *(const uint4*)(Bt + (size_t)(n0 + r) * K + k); };
    gemm_loop<4>(acc, fa, fb, K, (u16*)smem);
#pragma unroll
    for (int m = 0; m < 4; ++m)
#pragma unroll
      for (int n = 0; n < 4; ++n) {
        const int col = n0 + wc * 64 + n * 16 + fr;
        const int r0 = m0 + wr * 64 + m * 16 + fq * 4;
#pragma unroll
        for (int j = 0; j < 4; ++j) C[(size_t)(r0 + j) * 1024 + col] = f2bf(acc[m][n][j]);
      }
  }
}

__device__ __forceinline__ void phase_inproj(const Params& p, char* smem) {
  const u16* H = (const u16*)(p.ws + OFF_H); const u16* W = (const u16*)(p.ws + OFF_WMIX);
  u16* P1 = (u16*)(p.ws + OFF_P1); u16* P2 = (u16*)(p.ws + OFF_P2); u16* VT = (u16*)(p.ws + OFF_VT); u16* PB = (u16*)(p.ws + OFF_PB);
  const int lane = tidx() & 63, wid = tidx() >> 6, wr = wid >> 1, wc = wid & 1, fr = lane & 15, fq = lane >> 4;
  int mt, nt;
  for (int it = 0; tile_map(it, 33, mt, nt); ++it) {
    const int m0 = mt * 128, n0 = nt * 128;
    f32x4 acc[4][4]; ZERO_ACC(acc, 4)
    auto fa = [&](int r, int k) { return *(const uint4*)(H + (size_t)(m0 + r) * 1024 + k); };
    auto fb = [&](int r, int k) { return *(const uint4*)(W + (size_t)(n0 + r) * 1024 + k); };
    gemm_loop<4>(acc, fa, fb, 1024, (u16*)smem);
#pragma unroll
    for (int m = 0; m < 4; ++m)
#pragma unroll
      for (int nn = 0; nn < 4; ++nn) {
        const int n = n0 + wc * 64 + nn * 16 + fr;
        if (n >= MIXN) continue;
        const int r0 = m0 + wr * 64 + m * 16 + fq * 4;
        f32x4 v = acc[m][nn];
        if ((n >= 896 && n < 1024) || (n >= 1152 && n < 1280)) {
          const int which = (n >= 1152) ? 1 : 0;
          const int gd = n - (which ? 1152 : 896);
          const int b = r0 >> 12, t = r0 & 4095;
          uint2 o; o.x = pack2(v[0], v[1]); o.y = pack2(v[2], v[3]);
          *(uint2*)(VT + ((size_t)((which * 8 + b) * 128 + gd)) * 4096 + (t & ~31) + 8 * fq + 4 * (m & 1)) = o;
        } else if (n < 1304) {
          const int pc = (n < 896) ? n : ((n < 1152) ? n - 128 : n - 256);
          if (n < 512) { v[0] *= 0.125f; v[1] *= 0.125f; v[2] *= 0.125f; v[3] *= 0.125f; }
          if (n >= 1280) { v[0] = sigmoidf_(v[0]); v[1] = sigmoidf_(v[1]); v[2] = sigmoidf_(v[2]); v[3] = sigmoidf_(v[3]); }
#pragma unroll
          for (int j = 0; j < 4; ++j) P1[(size_t)(r0 + j) * PS1 + pc] = f2bf(v[j]);
        } else if (n < 2328) {
#pragma unroll
          for (int j = 0; j < 4; ++j) P1[(size_t)(r0 + j) * PS1 + (n - 256)] = f2bf(geluf_(v[j]));
        } else {
          const int pc = n - 2328;
#pragma unroll
          for (int j = 0; j < 4; ++j) P2[(size_t)(r0 + j) * PS2 + pc] = f2bf(v[j]);
          if ((m & 1) && fq == 3) PB[(size_t)((r0 + 3) >> 5) * 1792 + pc] = f2bf(v[3]);
        }
      }
  }
}

__device__ __forceinline__ void phase_merge(const Params& p, char* smem) {
  const u16* H2 = (const u16*)(p.ws + OFF_H2); const u16* WG = (const u16*)(p.ws + OFF_WG); const u16* WB = (const u16*)(p.ws + OFF_WB);
  const u16* P1 = (const u16*)(p.ws + OFF_P1); const u16* YC = (const u16*)(p.ws + OFF_YC); u16* MG = (u16*)(p.ws + OFF_MERGED);
  const int lane = tidx() & 63, wid = tidx() >> 6, wr = wid >> 1, wc = wid & 1, fr = lane & 15, fq = lane >> 4;
  int mt, nt;
  for (int it = 0; tile_map(it, 16, mt, nt); ++it) {
    const int m0 = mt * 128, n0 = nt * 64;
    f32x4 tot[4][2]; ZERO_ACC(tot, 2)
#pragma unroll 1
    for (int i = 0; i < 3; ++i) {
      unsigned gpk[4][2][2];
      {
        f32x4 ag[4][2]; ZERO_ACC(ag, 2)
        auto fa2 = [&](int r, int k) { return *(const uint4*)(H2 + (size_t)(m0 + r) * 1024 + k); };
        auto fb2 = [&](int r, int k) { return *(const uint4*)(WG + (size_t)(i * 1024 + n0 + r) * 1024 + k); };
        gemm_loop<2>(ag, fa2, fb2, 1024, (u16*)smem);
#pragma unroll
        for (int m = 0; m < 4; ++m)
#pragma unroll
          for (int n = 0; n < 2; ++n) {
            gpk[m][n][0] = pack2(sigmoidf_(ag[m][n][0]), sigmoidf_(ag[m][n][1]));
            gpk[m][n][1] = pack2(sigmoidf_(ag[m][n][2]), sigmoidf_(ag[m][n][3]));
          }
      }
      f32x4 ay[4][2]; ZERO_ACC(ay, 2)
      const u16* ya = (i == 0) ? P1 : ((i == 1) ? P1 + 1048 : YC);
      const int lda = (i == 2) ? 512 : PS1;
      const u16* wb = WB + (size_t)i * 1024 * 512;
      auto fa = [&](int r, int k) { return *(const uint4*)(ya + (size_t)(m0 + r) * lda + k); };
      auto fb = [&](int r, int k) { return *(const uint4*)(wb + (size_t)(n0 + r) * 512 + k); };
      gemm_loop<2>(ay, fa, fb, 512, (u16*)smem);
#pragma unroll
      for (int m = 0; m < 4; ++m)
#pragma unroll
        for (int n = 0; n < 2; ++n) {
          tot[m][n][0] += bf2f((u16)(gpk[m][n][0] & 0xffff)) * ay[m][n][0];
          tot[m][n][1] += bf2f((u16)(gpk[m][n][0] >> 16)) * ay[m][n][1];
          tot[m][n][2] += bf2f((u16)(gpk[m][n][1] & 0xffff)) * ay[m][n][2];
          tot[m][n][3] += bf2f((u16)(gpk[m][n][1] >> 16)) * ay[m][n][3];
        }
    }
#pragma unroll
    for (int m = 0; m < 4; ++m)
#pragma unroll
      for (int n = 0; n < 2; ++n) {
        const int col = n0 + wc * 32 + n * 16 + fr;
        const int r0 = m0 + wr * 64 + m * 16 + fq * 4;
#pragma unroll
        for (int j = 0; j < 4; ++j) MG[(size_t)(r0 + j) * 1024 + col] = f2bf(tot[m][n][j]);
      }
  }
}

__device__ __forceinline__ void phase_cmp1(const Params& p, int l, char* smem) {
  const u16* P1 = (const u16*)(p.ws + OFF_P1); const u16* W1 = (const u16*)(p.ws + OFF_W1); u16* HID = (u16*)(p.ws + OFF_HID);
  const int lane = tidx() & 63, wid = tidx() >> 6, wr = wid >> 1, wc = wid & 1, fr = lane & 15, fq = lane >> 4;
  for (int tix = blockIdx.x; tix < 128; tix += gridDim.x) {
    const int which = tix >> 6, mt = (tix >> 1) & 31, nt = tix & 1;
    const int m0 = mt * 128, n0 = nt * 128;
    const float* pe = (which ? p.in[16] : p.in[13]) + (size_t)l * 2048;
    const u16* w1 = W1 + (size_t)which * 256 * 2048;
    const int cbase = 512 + which * 128;
    f32x4 acc[4][4]; ZERO_ACC(acc, 4)
    auto fa = [&](int r, int k) {
      const int row = m0 + r; const int g = row & 1, n = (row >> 1) & 255, b = row >> 9;
      uint4 o = make_uint4(0, 0, 0, 0);
      if (n < 255) {
        const int lpos = k >> 6, d = k & 63;
        uint4 raw = *(const uint4*)(P1 + (size_t)(b * 4096 + 16 * n + lpos) * PS1 + cbase + g * 64 + d);
        const float* pp = pe + lpos * 64 + d;
        float4 e0 = *(const float4*)pp, e1 = *(const float4*)(pp + 4);
        o.x = pack2(bf2f((u16)(raw.x & 0xffff)) + e0.x, bf2f((u16)(raw.x >> 16)) + e0.y);
        o.y = pack2(bf2f((u16)(raw.y & 0xffff)) + e0.z, bf2f((u16)(raw.y >> 16)) + e0.w);
        o.z = pack2(bf2f((u16)(raw.z & 0xffff)) + e1.x, bf2f((u16)(raw.z >> 16)) + e1.y);
        o.w = pack2(bf2f((u16)(raw.w & 0xffff)) + e1.z, bf2f((u16)(raw.w >> 16)) + e1.w);
      }
      return o;
    };
    auto fb = [&](int r, int k) { return *(const uint4*)(w1 + (size_t)(n0 + r) * 2048 + k); };
    gemm_loop<4>(acc, fa, fb, 2048, (u16*)smem);
#pragma unroll
    for (int m = 0; m < 4; ++m)
#pragma unroll
      for (int n = 0; n < 4; ++n) {
        const int col = n0 + wc * 64 + n * 16 + fr;
        const int r0 = m0 + wr * 64 + m * 16 + fq * 4;
#pragma unroll
        for (int j = 0; j < 4; ++j) HID[((size_t)which * 4096 + r0 + j) * 256 + col] = f2bf(siluf_(acc[m][n][j]));
      }
  }
}

__device__ __forceinline__ void phase_cmp2(const Params& p, int l) {
  const u16* HID = (const u16*)(p.ws + OFF_HID); u16* KC = (u16*)(p.ws + OFF_KC); u16* VC = (u16*)(p.ws + OFF_VC);
  const int total = 2 * 4096 * 64;
  for (int idx = blockIdx.x * 256 + tidx(); idx < total; idx += gridDim.x * 256) {
    const int d = idx & 63, row = (idx >> 6) & 4095, which = idx >> 18;
    const float* w2 = (which ? p.in[15] : p.in[12]) + (size_t)l * 256 * 64;
    const u16* hr = HID + ((size_t)which * 4096 + row) * 256;
    float acc = 0.f;
#pragma unroll 8
    for (int j = 0; j < 256; ++j) acc += bf2f(hr[j]) * w2[j * 64 + d];
    const int g = row & 1, n = (row >> 1) & 255, b = row >> 9;
    if (which == 0) KC[((size_t)(b * 2 + g) * 256 + n) * 64 + d] = f2bf(acc);
    else {
      const int u = n & 31; const int pp = 8 * ((u >> 2) & 3) + 4 * (u >> 4) + (u & 3);
      VC[((size_t)(b * 2 + g) * 64 + d) * 256 + (n & ~31) + pp] = f2bf(acc);
    }
  }
}

__device__ __forceinline__ void phase_sgu(const Params& p, int l, char* smem) {
  u16* P1 = (u16*)(p.ws + OFF_P1);
  u16* Wt = (u16*)smem;
  u16* Vt = Wt + 128 * 136;
  float* st = (float*)(Vt + 128 * 136);
  const int tid = tidx(), lane = tid & 63, wid = tid >> 6, wr = wid >> 1, wc = wid & 1, fr = lane & 15, fq = lane >> 4;
  const float* lng = p.in[17] + (size_t)l * 512; const float* lnb = p.in[18] + (size_t)l * 512;
  for (int item = blockIdx.x; item < 1024; item += gridDim.x) {
    const int ci = item >> 2, gi = item & 3;
    const int tok0 = ci * 128;
    for (int r = wid * 32; r < wid * 32 + 32; ++r) {
      uint4 raw = *(const uint4*)(P1 + (size_t)(tok0 + r) * PS1 + 1560 + lane * 8);
      float f[8];
      f[0] = bf2f((u16)(raw.x & 0xffff)); f[1] = bf2f((u16)(raw.x >> 16)); f[2] = bf2f((u16)(raw.y & 0xffff)); f[3] = bf2f((u16)(raw.y >> 16));
      f[4] = bf2f((u16)(raw.z & 0xffff)); f[5] = bf2f((u16)(raw.z >> 16)); f[6] = bf2f((u16)(raw.w & 0xffff)); f[7] = bf2f((u16)(raw.w >> 16));
      float s = 0.f, s2 = 0.f;
#pragma unroll
      for (int e = 0; e < 8; ++e) { s += f[e]; }
      s = wave_sum(s);
      const float mu = s * (1.f / 512.f);
#pragma unroll
      for (int e = 0; e < 8; ++e) { float dlt = f[e] - mu; s2 += dlt * dlt; }
      s2 = wave_sum(s2);
      if (lane == 0) { st[r * 2] = mu; st[r * 2 + 1] = rsqrtf(s2 * (1.f / 512.f) + 1e-5f); }
    }
    const float* wsrc = p.in[19] + ((size_t)(l * 4 + gi)) * 128 * 128;
    for (int e = tid; e < 128 * 32; e += 256) {
      const int t = e >> 5, s4 = (e & 31) * 4;
      float4 w = *(const float4*)(wsrc + t * 128 + s4);
      uint2 o;
      o.x = pack2(s4 + 0 <= t ? w.x : 0.f, s4 + 1 <= t ? w.y : 0.f);
      o.y = pack2(s4 + 2 <= t ? w.z : 0.f, s4 + 3 <= t ? w.w : 0.f);
      *(uint2*)(Wt + t * 136 + s4) = o;
    }
    __syncthreads();
    for (int e = tid; e < 128 * 16; e += 256) {
      const int s = e >> 4, c8 = (e & 15) * 8;
      uint4 raw = *(const uint4*)(P1 + (size_t)(tok0 + s) * PS1 + 1560 + gi * 128 + c8);
      const float mu = st[s * 2], rs = st[s * 2 + 1];
      u16 rv[8] = {(u16)(raw.x & 0xffff), (u16)(raw.x >> 16), (u16)(raw.y & 0xffff), (u16)(raw.y >> 16), (u16)(raw.z & 0xffff), (u16)(raw.z >> 16), (u16)(raw.w & 0xffff), (u16)(raw.w >> 16)};
#pragma unroll
      for (int i = 0; i < 8; ++i) {
        const int c = gi * 128 + c8 + i;
        Vt[(c8 + i) * 136 + s] = f2bf((bf2f(rv[i]) - mu) * rs * lng[c] + lnb[c]);
      }
    }
    __syncthreads();
    f32x4 acc[4][4]; ZERO_ACC(acc, 4)
#pragma unroll 1
    for (int ks = 0; ks < 4; ++ks) {
      bf16x8 a[4], b[4];
#pragma unroll
      for (int m = 0; m < 4; ++m) a[m] = *(const bf16x8*)(Wt + (wr * 64 + m * 16 + fr) * 136 + ks * 32 + fq * 8);
#pragma unroll
      for (int n = 0; n < 4; ++n) b[n] = *(const bf16x8*)(Vt + (wc * 64 + n * 16 + fr) * 136 + ks * 32 + fq * 8);
#pragma unroll
      for (int m = 0; m < 4; ++m)
#pragma unroll
        for (int n = 0; n < 4; ++n) acc[m][n] = mfma16(a[m], b[n], acc[m][n]);
    }
    const float* bs = p.in[20] + ((size_t)(l * 4 + gi)) * 128;
#pragma unroll
    for (int m = 0; m < 4; ++m)
#pragma unroll
      for (int n = 0; n < 4; ++n) {
        const int c = wc * 64 + n * 16 + fr;
#pragma unroll
        for (int j = 0; j < 4; ++j) {
          const int t = wr * 64 + m * 16 + fq * 4 + j;
          u16* up = P1 + (size_t)(tok0 + t) * PS1 + 1048 + gi * 128 + c;
          *up = f2bf(bf2f(*up) * (acc[m][n][j] + bs[t]));
        }
      }
    __syncthreads();
  }
}

__device__ __forceinline__ void phase_prep1(const Params& p, int l) {
  u16* P2 = (u16*)(p.ws + OFF_P2); const u16* PB = (const u16*)(p.ws + OFF_PB); u16* VF = (u16*)(p.ws + OFF_VFIRST);
  const float* mu = p.in[21] + (size_t)l * 1792;
  const int total = 1024 * 224;
  for (int idx = blockIdx.x * 256 + tidx(); idx < total; idx += gridDim.x * 256) {
    const int tile = idx / 224, cg8 = (idx % 224) * 8;
    const int tok0 = tile * 32;
    float m8[8];
#pragma unroll
    for (int e = 0; e < 8; ++e) m8[e] = mu[cg8 + e];
    uint4 prev = make_uint4(0, 0, 0, 0);
    if ((tok0 & 4095) != 0) prev = *(const uint4*)(PB + (size_t)(tile - 1) * 1792 + cg8);
    for (int r = 0; r < 32; ++r) {
      u16* ptr = P2 + (size_t)(tok0 + r) * PS2 + cg8;
      uint4 cur = *(const uint4*)ptr;
      unsigned cu[4] = {cur.x, cur.y, cur.z, cur.w}, pu[4] = {prev.x, prev.y, prev.z, prev.w};
      float o[8];
#pragma unroll
      for (int e = 0; e < 8; ++e) {
        float c = bf2f((u16)((cu[e >> 1] >> ((e & 1) * 16)) & 0xffff));
        float pv = bf2f((u16)((pu[e >> 1] >> ((e & 1) * 16)) & 0xffff));
        float s = c + (pv - c) * m8[e];
        if (cg8 >= 1536 && cg8 < 1600) s = tanhf(s);
        else if (cg8 >= 1664) s = sigmoidf_(s);
        o[e] = s;
      }
      uint4 ov; ov.x = pack2(o[0], o[1]); ov.y = pack2(o[2], o[3]); ov.z = pack2(o[4], o[5]); ov.w = pack2(o[6], o[7]);
      *(uint4*)ptr = ov;
      if (l == 0 && cg8 >= 1024 && cg8 < 1536) *(uint4*)(VF + (size_t)(tok0 + r) * 512 + cg8 - 1024) = ov;
      prev = cur;
    }
  }
}

__device__ __forceinline__ void phase_prep2(const Params& p, int l, char* smem) {
  u16* P2 = (u16*)(p.ws + OFF_P2); const u16* VF = (const u16*)(p.ws + OFF_VFIRST);
  float* twd = (float*)smem;
  float* adl = twd + 1024;
  float* vsh = adl + 1024;
  float* lv = vsh + 8192;
  const int tid = tidx();
  const float* w0 = p.in[22] + (size_t)l * 512; const float* w2 = p.in[23] + (size_t)l * 64 * 512;
  const float* a0 = p.in[24] + (size_t)l * 512; const float* a2 = p.in[25] + (size_t)l * 64 * 512;
  const float* kkp = p.in[27] + (size_t)l * 512; const float* kap = p.in[28] + (size_t)l * 512;
  for (int item = blockIdx.x; item < 2048; item += gridDim.x) {
    const int tok0 = item * 16;
    for (int e = tid; e < 2048; e += 256) {
      const int r = e >> 7, c = e & 127;
      twd[(c >> 6) * 1024 + r * 64 + (c & 63)] = bf2f(P2[(size_t)(tok0 + r) * PS2 + 1536 + c]);
    }
    if (l > 0) {
      for (int e = tid; e < 8192; e += 256) { const int r = e >> 9, c = e & 511; vsh[e] = bf2f(P2[(size_t)(tok0 + r) * PS2 + 1024 + c]); }
    }
    __syncthreads();
    if (l > 0) {
      const float* v1 = p.in[33];
      for (int e = tid; e < 512; e += 256) {
        const int r = e >> 5, j = e & 31;
        float s = 0.f;
#pragma unroll 8
        for (int c = 0; c < 512; ++c) s += vsh[r * 512 + c] * v1[c * 32 + j];
        lv[r * 32 + j] = s;
      }
      __syncthreads();
    }
#pragma unroll 1
    for (int hc = 0; hc < 2; ++hc) {
      const int ch = tid + hc * 256;
      float aw[16], aa[16];
#pragma unroll
      for (int r = 0; r < 16; ++r) { aw[r] = 0.f; aa[r] = 0.f; }
#pragma unroll 2
      for (int i = 0; i < 64; ++i) {
        const float w2v = w2[i * 512 + ch], a2v = a2[i * 512 + ch];
#pragma unroll
        for (int r = 0; r < 16; ++r) { aw[r] += twd[r * 64 + i] * w2v; aa[r] += adl[r * 64 + i] * a2v; }
      }
      float am[16];
      if (l > 0) {
        const float* v2 = p.in[34];
#pragma unroll
        for (int r = 0; r < 16; ++r) am[r] = 0.f;
        for (int j = 0; j < 32; ++j) {
          const float v2v = v2[j * 512 + ch];
#pragma unroll
          for (int r = 0; r < 16; ++r) am[r] += lv[r * 32 + j] * v2v;
        }
      }
      const float w0v = w0[ch], a0v = a0[ch], kkv = kkp[ch], kav = kap[ch];
      const float v0v = (l > 0) ? p.in[32][ch] : 0.f;
#pragma unroll
      for (int r = 0; r < 16; ++r) {
        u16* row = P2 + (size_t)(tok0 + r) * PS2;
        const float kval = bf2f(row[512 + ch]);
        const float wpre = w0v + aw[r];
        const float nx = -wpre;
        const float sp = fmaxf(nx, 0.f) + log1pf(__expf(-fabsf(nx)));
        const float w = -sp - 0.5f;
        const float decay = __expf(-__expf(w));
        const float a = sigmoidf_(a0v + aa[r]);
        const float kk = kval * kkv;
        const float ss = wave_sum(kk * kk);
        const float kkn = kk / fmaxf(sqrtf(ss), 1e-12f);
        row[1792 + ch] = f2bf(decay);
        row[2304 + ch] = f2bf(kkn);
        row[2816 + ch] = f2bf(kkn * a);
        row[512 + ch] = f2bf(kval * (1.f + (a - 1.f) * kav));
        if (l > 0) {
          const float v = vsh[r * 512 + ch];
          const float vf = bf2f(VF[(size_t)(tok0 + r) * 512 + ch]);
          row[1024 + ch] = f2bf(v + (vf - v) * sigmoidf_(v0v + am[r]));
        }
      }
    }
    __syncthreads();
  }
}

__device__ __forceinline__ void scan_item(const Params& p, int item, char* smem) {
  const u16* P2 = (const u16*)(p.ws + OFF_P2); u16* YC = (u16*)(p.ws + OFF_YC);
  float* vb = (float*)smem;
  float* yb = vb + 2 * 6 * 16 * 64;
  const int tid = tidx(), lane = tid & 63, wid = tid >> 6;
  const int rq = item & 3, h = (item >> 2) & 7, b = item >> 5;
  const int rl = lane >> 4, cq = lane & 15;
  const int rloc = wid * 4 + rl;
  const int ihead = rq * 16 + rloc;
  const int j0 = cq * 4;
  const size_t tokb = (size_t)b * 4096;
  float s0 = 0.f, s1 = 0.f, s2 = 0.f, s3 = 0.f;
  uint4 pre[3];
  auto gload = [&](int c) {
#pragma unroll
    for (int i = 0; i < 3; ++i) {
      const int v = tid + i * 256; const int vec = v >> 7, rem = v & 127, step = rem >> 3, c8 = rem & 7;
      const int off = (vec == 0) ? 0 : (vec == 1) ? 1792 : (vec == 2) ? 512 : (vec == 3) ? 1024 : (vec == 4) ? 2304 : 2816;
      pre[i] = *(const uint4*)(P2 + (tokb + c * 16 + step) * PS2 + off + h * 64 + c8 * 8);
    }
  };
  auto lstore = [&](int buf) {
#pragma unroll
    for (int i = 0; i < 3; ++i) {
      const int v = tid + i * 256; const int vec = v >> 7, rem = v & 127, step = rem >> 3, c8 = rem & 7;
      float* d = vb + ((buf * 6 + vec) * 16 + step) * 64 + c8 * 8;
      float4 f0, f1;
      f0.x = bf2f((u16)(pre[i].x & 0xffff)); f0.y = bf2f((u16)(pre[i].x >> 16)); f0.z = bf2f((u16)(pre[i].y & 0xffff)); f0.w = bf2f((u16)(pre[i].y >> 16));
      f1.x = bf2f((u16)(pre[i].z & 0xffff)); f1.y = bf2f((u16)(pre[i].z >> 16)); f1.z = bf2f((u16)(pre[i].w & 0xffff)); f1.w = bf2f((u16)(pre[i].w >> 16));
      *(float4*)d = f0; *(float4*)(d + 4) = f1;
    }
  };
  gload(0); lstore(0);
  __syncthreads();
  for (int c = 0; c < 256; ++c) {
    const int buf = c & 1;
    if (c + 1 < 256) gload(c + 1);
    const float* base = vb + buf * 6 * 16 * 64;
#pragma unroll 4
    for (int st = 0; st < 16; ++st) {
      const float4 r4 = *(const float4*)(base + (0 * 16 + st) * 64 + j0);
      const float4 w4 = *(const float4*)(base + (1 * 16 + st) * 64 + j0);
      const float4 k4 = *(const float4*)(base + (2 * 16 + st) * 64 + j0);
      const float vi = base[(3 * 16 + st) * 64 + ihead];
      const float4 n4 = *(const float4*)(base + (4 * 16 + st) * 64 + j0);
      const float4 b4 = *(const float4*)(base + (5 * 16 + st) * 64 + j0);
      float sa = s0 * n4.x + s1 * n4.y + s2 * n4.z + s3 * n4.w;
      sa += __shfl_xor(sa, 1); sa += __shfl_xor(sa, 2); sa += __shfl_xor(sa, 4); sa += __shfl_xor(sa, 8);
      sa = -sa;
      s0 = s0 * w4.x + sa * b4.x + vi * k4.x;
      s1 = s1 * w4.y + sa * b4.y + vi * k4.y;
      s2 = s2 * w4.z + sa * b4.z + vi * k4.z;
      s3 = s3 * w4.w + sa * b4.w + vi * k4.w;
      float y = s0 * r4.x + s1 * r4.y + s2 * r4.z + s3 * r4.w;
      y += __shfl_xor(y, 1); y += __shfl_xor(y, 2); y += __shfl_xor(y, 4); y += __shfl_xor(y, 8);
      if (cq == 0) yb[st * 16 + rloc] = y;
    }
    __syncthreads();
    {
      const int st = tid >> 4, r = tid & 15;
      YC[(tokb + c * 16 + st) * 512 + h * 64 + rq * 16 + r] = f2bf(yb[st * 16 + r]);
    }
    if (c + 1 < 256) lstore(buf ^ 1);
    __syncthreads();
  }
}

__device__ __forceinline__ void phase_post(const Params& p, int l, char* smem) {
  const u16* P2 = (const u16*)(p.ws + OFF_P2); u16* YC = (u16*)(p.ws + OFF_YC);
  float* sg = (float*)smem;
  const int tid = tidx();
  const float* g2 = p.in[26] + (size_t)l * 128 * 512;
  const float* rk = p.in[29] + (size_t)l * 512; const float* lg = p.in[30] + (size_t)l * 512; const float* lb = p.in[31] + (size_t)l * 512;
  for (int item = blockIdx.x; item < 2048; item += gridDim.x) {
    const int tok0 = item * 16;
    for (int e = tid; e < 2048; e += 256) { const int r = e >> 7, c = e & 127; sg[e] = bf2f(P2[(size_t)(tok0 + r) * PS2 + 1664 + c]); }
    __syncthreads();
#pragma unroll 1
    for (int hc = 0; hc < 2; ++hc) {
      const int ch = tid + hc * 256;
      float ag[16];
#pragma unroll
      for (int r = 0; r < 16; ++r) ag[r] = 0.f;
#pragma unroll 2
      for (int i = 0; i < 128; ++i) {
        const float gv = g2[i * 512 + ch];
#pragma unroll
        for (int r = 0; r < 16; ++r) ag[r] += sg[r * 128 + i] * gv;
      }
      const float rkv = rk[ch], lgv = lg[ch], lbv = lb[ch];
#pragma unroll
      for (int r = 0; r < 16; ++r) {
        const u16* row = P2 + (size_t)(tok0 + r) * PS2;
        const float y = bf2f(YC[(size_t)(tok0 + r) * 512 + ch]);
        const float mean = wave_sum(y) * (1.f / 64.f);
        const float dv = y - mean;
        const float var = wave_sum(dv * dv) * (1.f / 64.f);
        const float yn = dv * rsqrtf(var + 64e-5f) * lgv + lbv;
        const float rr = bf2f(row[ch]), kk = bf2f(row[512 + ch]), vv = bf2f(row[1024 + ch]);
        const float bon = wave_sum(rr * kk * rkv) * vv;
        YC[(size_t)(tok0 + r) * 512 + ch] = f2bf((yn + bon) * ag[r]);
      }
    }
    __syncthreads();
  }
}

#define NEGV (-1e30f)
struct AttnState { float m[2]; float ls[2]; f32x4 ot[4][2]; };

template <int MODE>
__device__ __forceinline__ void attn_scores(f32x4 (&st)[4][2], const u16* kbase, int kstride, int key0, const bf16x8 (&qf)[2][2],
                                            const float (&slope)[2], int t, bool selbit, int c16, int q4) {
#pragma unroll
  for (int mk = 0; mk < 4; ++mk) {
    const u16* kp = kbase + (size_t)(mk * 16 + c16) * kstride + q4 * 8;
    const bf16x8 k0 = *(const bf16x8*)kp, k1 = *(const bf16x8*)(kp + 32);
#pragma unroll
    for (int nq = 0; nq < 2; ++nq) {
      f32x4 a = {0.f, 0.f, 0.f, 0.f};
      a = mfma16(k0, qf[nq][0], a);
      a = mfma16(k1, qf[nq][1], a);
#pragma unroll
      for (int j = 0; j < 4; ++j) {
        const int key = key0 + mk * 16 + q4 * 4 + j;
        int dist; bool valid;
        if (MODE == 0) { dist = t - (16 * key + 31); valid = dist >= 0; }
        else if (MODE == 1) { dist = t - key; valid = (dist >= 0) && selbit; }
        else { dist = t - key; valid = (dist >= 0) && (dist < 512); }
        a[j] = valid ? (a[j] - slope[nq] * (float)dist) : NEGV;
      }
      st[mk][nq] = a;
    }
  }
}

template <int MODE>
__device__ __forceinline__ void attn_tile(AttnState& S, const u16* kbase, int kstride, const u16* vtbase, int vstride, int key0,
                                          const bf16x8 (&qf)[2][2], const float (&slope)[2], int t, bool selbit, int c16, int q4) {
  f32x4 st[4][2];
  attn_scores<MODE>(st, kbase, kstride, key0, qf, slope, t, selbit, c16, q4);
  __builtin_amdgcn_sched_barrier(0);
#pragma unroll
  for (int nq = 0; nq < 2; ++nq) {
    float mx = NEGV;
#pragma unroll
    for (int mk = 0; mk < 4; ++mk)
#pragma unroll
      for (int j = 0; j < 4; ++j) mx = fmaxf(mx, st[mk][nq][j]);
    mx = fmaxf(mx, __shfl_xor(mx, 16)); mx = fmaxf(mx, __shfl_xor(mx, 32));
    const float mnew = fmaxf(S.m[nq], mx);
    const float alpha = __expf(S.m[nq] - mnew);
    S.m[nq] = mnew;
    float ls = S.ls[nq] * alpha;
#pragma unroll
    for (int md = 0; md < 4; ++md) { S.ot[md][nq][0] *= alpha; S.ot[md][nq][1] *= alpha; S.ot[md][nq][2] *= alpha; S.ot[md][nq][3] *= alpha; }
#pragma unroll
    for (int mk = 0; mk < 4; ++mk)
#pragma unroll
      for (int j = 0; j < 4; ++j) {
        const float sv = st[mk][nq][j];
        const float pv = (sv > -1e29f) ? __expf(sv - mnew) : 0.f;
        st[mk][nq][j] = pv; ls += pv;
      }
    S.ls[nq] = ls;
  }
#pragma unroll
  for (int s2 = 0; s2 < 2; ++s2) {
    __builtin_amdgcn_sched_barrier(0);
    bf16x8 pb[2];
#pragma unroll
    for (int nq = 0; nq < 2; ++nq) {
      uint4 u;
      u.x = pack2(st[2 * s2][nq][0], st[2 * s2][nq][1]); u.y = pack2(st[2 * s2][nq][2], st[2 * s2][nq][3]);
      u.z = pack2(st[2 * s2 + 1][nq][0], st[2 * s2 + 1][nq][1]); u.w = pack2(st[2 * s2 + 1][nq][2], st[2 * s2 + 1][nq][3]);
      pb[nq] = *(bf16x8*)&u;
    }
#pragma unroll
    for (int md = 0; md < 4; ++md) {
      const bf16x8 vf = *(const bf16x8*)(vtbase + (size_t)(md * 16 + c16) * vstride + s2 * 32 + q4 * 8);
#pragma unroll
      for (int nq = 0; nq < 2; ++nq) S.ot[md][nq] = mfma16(vf, pb[nq], S.ot[md][nq]);
    }
  }
}

__device__ __forceinline__ void attn_reset(AttnState& S) {
#pragma unroll
  for (int nq = 0; nq < 2; ++nq) { S.m[nq] = NEGV; S.ls[nq] = 0.f;
#pragma unroll
    for (int md = 0; md < 4; ++md) S.ot[md][nq] = f32x4{0.f, 0.f, 0.f, 0.f}; }
}
__device__ __forceinline__ void attn_fold(AttnState& S, float* oacc, const u16* gp, int br, float (&invl)[2], int lane) {
#pragma unroll
  for (int nq = 0; nq < 2; ++nq) {
    float l = S.ls[nq];
    l += __shfl_xor(l, 16); l += __shfl_xor(l, 32);
    const float inv = (l > 0.f) ? 1.f / l : 0.f;
    invl[nq] = inv;
    const float f = bf2f(gp[nq * 6 + br]) * inv;
#pragma unroll
    for (int md = 0; md < 4; ++md)
#pragma unroll
      for (int j = 0; j < 4; ++j) {
        float* a = oacc + ((md * 2 + nq) * 4 + j) * 64 + lane;
        const float v = f * S.ot[md][nq][j];
        if (br == 0) *a = v; else *a += v;
      }
  }
}

__device__ __forceinline__ void phase_nsa(const Params& p, char* smem, int bid, int nblk) {
  u16* P1 = (u16*)(p.ws + OFF_P1);
  const u16* KC = (const u16*)(p.ws + OFF_KC); const u16* VC = (const u16*)(p.ws + OFF_VC); const u16* VT = (const u16*)(p.ws + OFF_VT);
  const int tid = tidx(), lane = tid & 63, wid = tid >> 6;
  const int c16 = lane & 15, q4 = lane >> 4, tq = lane & 7;
  float* ps = (float*)smem + wid * 2048;
  float* oacc = (float*)(smem + 32768) + wid * 2048;
#pragma unroll 1
  for (int it = bid; it < 2048; it += nblk) {
    const int bg = it >> 7, x = it & 127;
    const int tqd = (x + bg * 45) & 127;
    const int b = bg >> 1, g = bg & 1;
    const int t0 = (tqd * 4 + wid) * 8;
    const int tok0 = b * 4096 + t0;
    const int t = t0 + tq;
    const int cur = t0 >> 6;
#pragma unroll
    for (int i = 0; i < 8; ++i) *(float4*)(ps + i * 256 + lane * 4) = float4{0.f, 0.f, 0.f, 0.f};
    bf16x8 qf[2][2]; float slope[2];
    const u16* gp = P1 + (size_t)(tok0 + tq) * PS1 + 1024 + (g * 4 + (c16 >> 3)) * 3;
#pragma unroll
    for (int nq = 0; nq < 2; ++nq) {
      const int hh = nq * 2 + (c16 >> 3);
      const u16* rp = P1 + (size_t)(tok0 + tq) * PS1;
      qf[nq][0] = *(const bf16x8*)(rp + (g * 4 + hh) * 64 + q4 * 8);
      qf[nq][1] = *(const bf16x8*)(rp + (g * 4 + hh) * 64 + 32 + q4 * 8);
      slope[nq] = exp2f(-(float)(g * 4 + hh + 1));
    }
    AttnState S;
    float invl[2];
    const u16* kcb = KC + (size_t)(b * 2 + g) * 256 * 64;
    const u16* vcb = VC + (size_t)(b * 2 + g) * 64 * 256;
    int ntc = 0;
    if (t0 + 7 >= 31) ntc = (((t0 + 7 - 31) >> 4) >> 6) + 1;
    attn_reset(S);
#pragma unroll 1
    for (int kt = 0; kt < ntc; ++kt) attn_tile<0>(S, kcb + (size_t)kt * 64 * 64, 64, vcb + kt * 64, 256, kt * 64, qf, slope, t, true, c16, q4);
    attn_fold(S, oacc, gp, 0, invl, lane);
#pragma unroll 1
    for (int kt = 0; kt < ntc; ++kt) {
      f32x4 st[4][2];
      attn_scores<0>(st, kcb + (size_t)kt * 64 * 64, 64, kt * 64, qf, slope, t, true, c16, q4);
#pragma unroll
      for (int mk = 0; mk < 4; ++mk) {
        f32x4 hs;
#pragma unroll
        for (int j = 0; j < 4; ++j) {
          const float a0 = st[mk][0][j], a1 = st[mk][1][j];
          const float p0 = (a0 > -1e29f) ? __expf(a0 - S.m[0]) * invl[0] : 0.f;
          const float p1 = (a1 > -1e29f) ? __expf(a1 - S.m[1]) * invl[1] : 0.f;
          float v = p0 + p1;
          v += __shfl_xor(v, 8);
          hs[j] = v;
        }
        if (c16 < 8) *(f32x4*)(ps + c16 * 256 + kt * 64 + mk * 16 + q4 * 4) = hs;
      }
    }
    __syncthreads();
    unsigned long long selm = 0ull, un = 0ull;
#pragma unroll 1
    for (int tqq = 0; tqq < 8; ++tqq) {
      const float* pr = ps + tqq * 256;
      float imp = pr[4 * lane];
      if (lane > 0) imp += pr[4 * lane - 4] + 2.f * (pr[4 * lane - 3] + pr[4 * lane - 2] + pr[4 * lane - 1]);
      const bool forced = (lane == 0) || (lane == cur) || (lane == cur - 1);
      const bool live = lane <= cur;
      const float val = forced ? 1e4f : (live ? imp : NEGV);
      int rank = 0;
#pragma unroll 8
      for (int i = 0; i < 64; ++i) {
        const float vi = __uint_as_float(__builtin_amdgcn_readlane(__float_as_uint(val), i));
        rank += ((vi > val) || (vi == val && i < lane)) ? 1 : 0;
      }
      const unsigned long long bal = __ballot((rank < 16) && live);
      if (tq == tqq) selm = bal;
      un |= bal;
    }
    __syncthreads();
    attn_reset(S);
    {
      const u16* vtb = VT + (size_t)((0 * 8 + b) * 2 + g) * 64 * 4096;
#pragma unroll 1
      for (int j = 0; j <= cur; ++j) {
        if (!((un >> j) & 1ull)) continue;
        const bool sb = (selm >> j) & 1ull;
        attn_tile<1>(S, P1 + (size_t)(b * 4096 + j * 64) * PS1 + 768 + g * 64, PS1, vtb + j * 64, 4096, j * 64, qf, slope, t, sb, c16, q4);
      }
    }
    attn_fold(S, oacc, gp, 1, invl, lane);
    attn_reset(S);
    {
      const u16* vtb = VT + (size_t)((1 * 8 + b) * 2 + g) * 64 * 4096;
      int j0 = t0 - 511; if (j0 < 0) j0 = 0; j0 >>= 6;
#pragma unroll 1
      for (int j = j0; j <= cur; ++j)
        attn_tile<2>(S, P1 + (size_t)(b * 4096 + j * 64) * PS1 + 896 + g * 64, PS1, vtb + j * 64, 4096, j * 64, qf, slope, t, true, c16, q4);
    }
    attn_fold(S, oacc, gp, 2, invl, lane);
#pragma unroll
    for (int nq = 0; nq < 2; ++nq) {
      const int hh = nq * 2 + (c16 >> 3);
      u16* rp = P1 + (size_t)(tok0 + tq) * PS1 + (g * 4 + hh) * 64;
#pragma unroll
      for (int md = 0; md < 4; ++md) {
        const float* a = oacc + ((md * 2 + nq) * 4) * 64 + lane;
        uint2 o; o.x = pack2(a[0], a[64]); o.y = pack2(a[128], a[192]);
        *(uint2*)(rp + md * 16 + q4 * 4) = o;
      }
    }
  }
}

__device__ __forceinline__ const float* modp(const Params& p, int l, int sub, int kind) {
  return (const float*)(p.ws + OFF_MOD) + (size_t)l * 8 * 9216 + sub * 3072 + kind * 1024;
}

__device__ __forceinline__ void run_phase(const Params& p, int ph, char* smem) {
  char* ws = p.ws;
  if (ph == 0) { phase_mod(p, smem); }
  int l = 0, s = -1;
  if (ph >= 2) { l = (ph - 2) / 15; s = (ph - 2) % 15; }
  const float* preg = p.in[4] + (size_t)l * 3 * 1024; const float* postg = p.in[5] + (size_t)l * 3 * 1024;
  const bool is_norm = (ph == 1) || s == 2 || s == 8 || s == 11 || s == 14;
  if (is_norm) {
    const float* xin = p.out; float* xout = p.out; const u16* y = nullptr; const float* pg = nullptr; const float* gate = nullptr; float wgt = 0.f;
    const float* prg = nullptr; const float* sh = nullptr; const float* sc = nullptr; u16* h = (u16*)(ws + OFF_H);
    if (ph == 1) { xin = p.in[0]; prg = p.in[4]; sh = modp(p, 0, 0, 0); sc = modp(p, 0, 0, 1); }
    else if (s == 2) { y = (const u16*)(ws + OFF_YF); pg = postg; gate = modp(p, l, 0, 2); wgt = 0.5f; prg = preg + 1024; sh = modp(p, l, 1, 0); sc = modp(p, l, 1, 1); }
    else if (s == 8) { xout = nullptr; prg = preg + 1024; sh = modp(p, l, 1, 0); sc = modp(p, l, 1, 1); h = (u16*)(ws + OFF_H2); }
    else if (s == 11) { y = (const u16*)(ws + OFF_YM); pg = postg + 1024; gate = modp(p, l, 1, 2); wgt = 1.0f; prg = preg + 2048; sh = modp(p, l, 2, 0); sc = modp(p, l, 2, 1); }
    else { y = (const u16*)(ws + OFF_YF); pg = postg + 2048; gate = modp(p, l, 2, 2); wgt = 0.5f;
      if (l == 0) { prg = p.in[4] + 3 * 1024; sh = modp(p, 1, 0, 0); sc = modp(p, 1, 0, 1); } else { h = nullptr; } }
    phase_norm(xin, xout, y, pg, gate, wgt, prg, sh, sc, h);
  }
  {
    int cl = -1, cf = 0;
    if (ph == 0) { cl = 0; cf = 0; } else if (s == 2) { cl = l; cf = 1; } else if (s == 14 && l == 0) { cl = 1; cf = 0; }
    if (cl >= 0) conv_ffn(p, cl, cf, smem);
    if (cl >= 0 && cf == 0) conv_mix(p, cl, smem);
  }
  if (s == 0 || s == 12) phase_ffn_in(p, smem);
  if (s == 1 || s == 13 || s == 10) {
    const bool o = (s == 10);
    phase_gemm_plain((const u16*)(ws + (o ? OFF_MERGED : OFF_ACT)), o ? 1024 : DFF, (const u16*)(ws + (o ? OFF_WO : OFF_WOUT)), o ? 1024 : DFF,
                     (u16*)(ws + (o ? OFF_YM : OFF_YF)), smem);
  }
  if (s == 3) phase_inproj(p, smem);
  if (s == 4) { phase_prep1(p, l); phase_sgu(p, l, smem); phase_cmp1(p, l, smem); }
  if (s == 5) { phase_prep2(p, l, smem); phase_cmp2(p, l); }
  if (s == 6) {
    const int nb = gridDim.x;
    const bool split = nb >= 512;
    if (!split || (int)blockIdx.x < 256) {
      for (int it = blockIdx.x; it < 256; it += nb) scan_item(p, it, smem);
    }
    if (!split || (int)blockIdx.x >= 256) phase_nsa(p, smem, split ? blockIdx.x - 256 : blockIdx.x, split ? nb - 256 : nb);
  }
  if (s == 7) phase_post(p, l, smem);
  if (s == 9) phase_merge(p, smem);
}

constexpr int NPHASE = 32;

#if COOP
typedef const float* __attribute__((address_space(4))) const* kargp_t;
template <int PH>
__device__ __forceinline__ void run_seq(char* smem, cg::grid_group& grid) {
  if constexpr (PH < NPHASE) {
    {
      kargp_t ka = (kargp_t)__builtin_amdgcn_kernarg_segment_ptr();
      asm volatile("" : "+s"(ka));
      Params q;
#pragma unroll
      for (int i = 0; i < 35; ++i) q.in[i] = ka[i];
      q.out = (float*)ka[35];
      q.ws = (char*)ka[36];
      run_phase(q, PH, smem);
    }
    if constexpr (PH + 1 < NPHASE) grid.sync();
    run_seq<PH + 1>(smem, grid);
  }
}

__global__ void __launch_bounds__(256, 2) mega(Params p) {
  __shared__ __attribute__((aligned(16))) char smem[SMEM_BYTES];
  cg::grid_group grid = cg::this_grid();
  run_seq<0>(smem, grid);
}
#endif

template <int PH>
__global__ void __launch_bounds__(256, 2) kph(Params p) {
  __shared__ __attribute__((aligned(16))) char smem[SMEM_BYTES];
  run_phase(p, PH, smem);
}

template <int PH>
static void launch_seq(const Params& p, int grid, hipStream_t stream) {
  if constexpr (PH < NPHASE) {
    kph<PH><<<grid, 256, 0, stream>>>(p);
    launch_seq<PH + 1>(p, grid, stream);
  }
}

extern "C" void kernel_launch(void* const* d_in, const int* in_sizes, int n_in, void* d_out, int out_size, void* d_ws, size_t ws_size,
                              hipStream_t stream) {
  static int grid_blocks = 0;
  if (!grid_blocks) {
    int dev = 0, cus = 0, per_cu = 0;
    hipGetDevice(&dev);
    hipDeviceGetAttribute(&cus, hipDeviceAttributeMultiprocessorCount, dev);
    #if COOP
    hipOccupancyMaxActiveBlocksPerMultiprocessor(&per_cu, mega, 256, 0);
#else
    per_cu = 2;
#endif
    if (per_cu > 2) per_cu = 2;
    if (per_cu < 1) per_cu = 1;
    grid_blocks = cus * per_cu;
  }
  Params p{};
  for (int i = 0; i < 35; ++i) p.in[i] = (const float*)d_in[i];
  p.out = (float*)d_out;
  p.ws = (char*)d_ws;
#if COOP
  void* args[] = {&p};
  hipError_t e = hipLaunchCooperativeKernel((void*)mega, dim3(grid_blocks), dim3(256), args, 0, stream);
  if (e != hipSuccess) fprintf(stderr, "cooperative launch failed: %s (grid %d)\n", hipGetErrorString(e), grid_blocks);
#else
  launch_seq<0>(p, grid_blocks, stream);
#endif
}
```

```cpp
#include <hip/hip_runtime.h>
#include <hip/hip_cooperative_groups.h>
#include <cstdio>
#include <cstdint>
namespace cg = cooperative_groups;

#ifndef COOP
#define COOP 1
#endif

typedef unsigned short u16;
using bf16x8 = __attribute__((ext_vector_type(8))) short;
using f32x4 = __attribute__((ext_vector_type(4))) float;

constexpr int T = 32768, D = 1024, SEQ = 4096, DFF = 2816;
constexpr int PS1 = 2072, PS2 = 3328;
constexpr int MIXC = 7192, MIXN = 4120;
constexpr size_t OFF_P1 = 0;
constexpr size_t OFF_P2 = OFF_P1 + (size_t)T * PS1 * 2;
constexpr size_t OFF_H = OFF_P2 + (size_t)T * PS2 * 2;
constexpr size_t OFF_WMIX = OFF_H + (size_t)T * 1024 * 2;
constexpr size_t OFF_WG = OFF_WMIX + (size_t)4224 * 1024 * 2;
constexpr size_t OFF_WB = OFF_WG + (size_t)3072 * 1024 * 2;
constexpr size_t OFF_WO = OFF_WB + (size_t)3 * 1024 * 512 * 2;
constexpr size_t OFF_W1 = OFF_WO + (size_t)1024 * 1024 * 2;
constexpr size_t OFF_WIN = OFF_W1 + (size_t)2 * 256 * 2048 * 2;
constexpr size_t OFF_WOUT = OFF_WIN + (size_t)5632 * 1024 * 2;
constexpr size_t OFF_VFIRST = OFF_WOUT + (size_t)1024 * 2816 * 2;
constexpr size_t OFF_VT = OFF_VFIRST + (size_t)T * 512 * 2;
constexpr size_t OFF_MOD = OFF_VT + (size_t)2 * 8 * 2 * 64 * 4096 * 2;
constexpr size_t OFF_PB = OFF_MOD + (size_t)2 * 8 * 9216 * 4;
constexpr size_t OFF_HID = OFF_PB + (size_t)1024 * 1792 * 2;
constexpr size_t OFF_KC = OFF_HID + (size_t)2 * 4096 * 256 * 2;
constexpr size_t OFF_VC = OFF_KC + (size_t)8 * 2 * 256 * 64 * 2;
constexpr size_t OFF_LV = OFF_VC + (size_t)8 * 2 * 64 * 256 * 2;
constexpr size_t OFF_CNT = OFF_LV + (size_t)T * 32 * 4;
constexpr size_t WS_END = OFF_CNT + 4096;
constexpr size_t OFF_ACT = OFF_P1;
constexpr size_t OFF_YF = OFF_ACT + (size_t)T * DFF * 2;
constexpr size_t OFF_H2 = OFF_P2;
constexpr size_t OFF_MERGED = OFF_H2 + (size_t)T * 1024 * 2;
constexpr size_t OFF_YM = OFF_MERGED + (size_t)T * 1024 * 2;
constexpr size_t OFF_YC = OFF_H;

constexpr int SMEM_BYTES = 73728;

struct Params { const float* in[35]; float* out; char* ws; };

__device__ __forceinline__ int tidx() { int t = __builtin_amdgcn_workitem_id_x(); asm volatile("" : "+v"(t)); return t; }
__device__ __forceinline__ void gbar(unsigned* cnt, unsigned target) {
  asm volatile("s_waitcnt vmcnt(0) lgkmcnt(0)" ::: "memory");
  __syncthreads();
  if (tidx() == 0) {
    __builtin_amdgcn_fence(__ATOMIC_RELEASE, "agent");
    asm volatile("s_waitcnt vmcnt(0)" ::: "memory");
    __hip_atomic_fetch_add(cnt, 1u, __ATOMIC_RELAXED, __HIP_MEMORY_SCOPE_AGENT);
    while (__hip_atomic_load(cnt, __ATOMIC_RELAXED, __HIP_MEMORY_SCOPE_AGENT) < target) __builtin_amdgcn_s_sleep(1);
    __builtin_amdgcn_fence(__ATOMIC_ACQUIRE, "agent");
    asm volatile("s_waitcnt vmcnt(0)" ::: "memory");
  }
  __syncthreads();
}
__device__ __forceinline__ float dpp_sum16(float v) {
  v += __int_as_float(__builtin_amdgcn_update_dpp(0, __float_as_int(v), 0xB1, 0xF, 0xF, true));
  v += __int_as_float(__builtin_amdgcn_update_dpp(0, __float_as_int(v), 0x4E, 0xF, 0xF, true));
  v += __int_as_float(__builtin_amdgcn_update_dpp(0, __float_as_int(v), 0x141, 0xF, 0xF, true));
  v += __int_as_float(__builtin_amdgcn_update_dpp(0, __float_as_int(v), 0x140, 0xF, 0xF, true));
  return v;
}
__device__ __forceinline__ float bf2f(u16 u) { return __uint_as_float(((unsigned)u) << 16); }
__device__ __forceinline__ u16 f2bf(float f) { unsigned u = __float_as_uint(f); u += 0x7fffu + ((u >> 16) & 1u); return (u16)(u >> 16); }
__device__ __forceinline__ unsigned pack2(float a, float b) { return (unsigned)f2bf(a) | (((unsigned)f2bf(b)) << 16); }
__device__ __forceinline__ float sigmoidf_(float x) { return 1.f / (1.f + __expf(-x)); }
__device__ __forceinline__ float siluf_(float x) { return x / (1.f + __expf(-x)); }
__device__ __forceinline__ float geluf_(float x) { float u = 0.7978845608028654f * (x + 0.044715f * x * x * x); return 0.5f * x * (1.f + tanhf(u)); }
__device__ __forceinline__ float wave_sum(float v) {
#pragma unroll
  for (int o = 32; o >= 1; o >>= 1) v += __shfl_xor(v, o);
  return v;
}
__device__ __forceinline__ f32x4 mfma16(bf16x8 a, bf16x8 b, f32x4 c) { return __builtin_amdgcn_mfma_f32_16x16x32_bf16(a, b, c, 0, 0, 0); }

__device__ __forceinline__ void conv_w(const float* src, int ld, int K, u16* dst, int NR, int nvalid, int coff, int kind, char* smem) {
  float* tl = (float*)smem;
  const int tid = tidx();
  const int ktn = K >> 6, ntile = (NR >> 6) * ktn;
  for (int tix = blockIdx.x; tix < ntile; tix += gridDim.x) {
    const int R0 = (tix / ktn) << 6, k0 = (tix % ktn) << 6;
    const int c = tid & 63, kq = tid >> 6;
    const int R = R0 + c;
    int sc; bool ok;
    if (kind == 0) { sc = coff + R; ok = R < nvalid; }
    else { int ntl = R >> 7, w = (R >> 6) & 1, n = (R >> 4) & 3, r = R & 15; sc = ((n >= 2) ? DFF : 0) + ntl * 64 + w * 32 + (n & 1) * 16 + r; ok = true; }
#pragma unroll 4
    for (int i = 0; i < 16; ++i) {
      int k = k0 + kq * 16 + i;
      tl[c * 65 + kq * 16 + i] = ok ? src[(size_t)k * ld + sc] : 0.f;
    }
    __syncthreads();
    {
      const int r = tid >> 2, ks = tid & 3;
      const float* s = tl + r * 65 + ks * 16;
      uint4 o0, o1;
      o0.x = pack2(s[0], s[1]); o0.y = pack2(s[2], s[3]); o0.z = pack2(s[4], s[5]); o0.w = pack2(s[6], s[7]);
      o1.x = pack2(s[8], s[9]); o1.y = pack2(s[10], s[11]); o1.z = pack2(s[12], s[13]); o1.w = pack2(s[14], s[15]);
      uint4* dp = (uint4*)(dst + (size_t)(R0 + r) * K + k0 + ks * 16);
      dp[0] = o0; dp[1] = o1;
    }
    __syncthreads();
  }
}

__device__ __forceinline__ void conv_ffn(const Params& p, int l, int f, char* smem) {
  conv_w(p.in[6] + (size_t)(l * 2 + f) * D * (2 * DFF), 2 * DFF, D, (u16*)(p.ws + OFF_WIN), 5632, 5632, 0, 1, smem);
  conv_w(p.in[7] + (size_t)(l * 2 + f) * DFF * D, D, DFF, (u16*)(p.ws + OFF_WOUT), 1024, 1024, 0, 0, smem);
}
__device__ __forceinline__ void conv_mix(const Params& p, int l, char* smem) {
  const float* mw = p.in[8] + (size_t)l * D * MIXC;
  conv_w(mw, MIXC, D, (u16*)(p.ws + OFF_WMIX), 4224, MIXN, 0, 0, smem);
  conv_w(mw, MIXC, D, (u16*)(p.ws + OFF_WG), 3072, 3072, MIXN, 0, smem);
  for (int i = 0; i < 3; ++i)
    conv_w(p.in[9] + (size_t)(l * 3 + i) * 512 * D, D, 512, (u16*)(p.ws + OFF_WB) + (size_t)i * 1024 * 512, 1024, 1024, 0, 0, smem);
  conv_w(p.in[10] + (size_t)l * D * D, D, D, (u16*)(p.ws + OFF_WO), 1024, 1024, 0, 0, smem);
  conv_w(p.in[11] + (size_t)l * 2048 * 256, 256, 2048, (u16*)(p.ws + OFF_W1), 256, 256, 0, 0, smem);
  conv_w(p.in[14] + (size_t)l * 2048 * 256, 256, 2048, (u16*)(p.ws + OFF_W1) + (size_t)256 * 2048, 256, 256, 0, 0, smem);
}

__device__ __forceinline__ void phase_mod(const Params& p, char* smem) {
  float* cond = (float*)smem;
  float* red = cond + 8192;
  const int tid = tidx();
  float* MOD = (float*)(p.ws + OFF_MOD);
  for (int item = blockIdx.x; item < 288; item += gridDim.x) {
    for (int e = tid; e < 8192; e += 256) cond[e] = siluf_(p.in[1][e]);
    __syncthreads();
    const int l = item / 144, n0 = (item % 144) * 64, col = n0 + (tid & 63), kq = tid >> 6;
    float acc[8];
#pragma unroll
    for (int b = 0; b < 8; ++b) acc[b] = 0.f;
    const float* w = p.in[2] + (size_t)l * D * 9216 + col;
#pragma unroll 4
    for (int k = kq * 256; k < kq * 256 + 256; ++k) {
      float wv = w[(size_t)k * 9216];
#pragma unroll
      for (int b = 0; b < 8; ++b) acc[b] += cond[b * 1024 + k] * wv;
    }
#pragma unroll
    for (int b = 0; b < 8; ++b) red[(kq * 8 + b) * 64 + (tid & 63)] = acc[b];
    __syncthreads();
    for (int e = tid; e < 512; e += 256) {
      int b = e >> 6, c = e & 63;
      float s = red[(0 * 8 + b) * 64 + c] + red[(1 * 8 + b) * 64 + c] + red[(2 * 8 + b) * 64 + c] + red[(3 * 8 + b) * 64 + c];
      MOD[(size_t)(l * 8 + b) * 9216 + n0 + c] = s + p.in[3][(size_t)l * 9216 + n0 + c];
    }
    __syncthreads();
  }
}

__device__ __forceinline__ void phase_norm(const float* xin, float* xout, const u16* y, const float* postg, const float* gate, float wgt,
                           const float* preg, const float* shift, const float* scale, u16* h) {
  const int lane = tidx() & 63, wid = tidx() >> 6;
  for (int row = blockIdx.x * 4 + wid; row < T; row += gridDim.x * 4) {
    const int b = row >> 12;
    float4 xv[4];
#pragma unroll
    for (int i = 0; i < 4; ++i) xv[i] = *(const float4*)(xin + (size_t)row * D + i * 256 + lane * 4);
    if (y) {
      float yv[4][4]; float ss = 0.f;
#pragma unroll
      for (int i = 0; i < 4; ++i) {
        uint2 u = *(const uint2*)(y + (size_t)row * D + i * 256 + lane * 4);
        yv[i][0] = bf2f((u16)(u.x & 0xffff)); yv[i][1] = bf2f((u16)(u.x >> 16));
        yv[i][2] = bf2f((u16)(u.y & 0xffff)); yv[i][3] = bf2f((u16)(u.y >> 16));
        ss += yv[i][0] * yv[i][0] + yv[i][1] * yv[i][1] + yv[i][2] * yv[i][2] + yv[i][3] * yv[i][3];
      }
      ss = wave_sum(ss);
      const float rs = rsqrtf(ss * (1.f / 1024.f) + 1e-6f) * wgt;
#pragma unroll
      for (int i = 0; i < 4; ++i) {
        const int c = i * 256 + lane * 4;
        float4 g = *(const float4*)(gate + (size_t)b * 9216 + c);
        float4 pg = *(const float4*)(postg + c);
        xv[i].x += g.x * yv[i][0] * rs * pg.x; xv[i].y += g.y * yv[i][1] * rs * pg.y;
        xv[i].z += g.z * yv[i][2] * rs * pg.z; xv[i].w += g.w * yv[i][3] * rs * pg.w;
      }
    }
    if (xout) {
#pragma unroll
      for (int i = 0; i < 4; ++i) *(float4*)(xout + (size_t)row * D + i * 256 + lane * 4) = xv[i];
    }
    if (h) {
      float ss = 0.f;
#pragma unroll
      for (int i = 0; i < 4; ++i) ss += xv[i].x * xv[i].x + xv[i].y * xv[i].y + xv[i].z * xv[i].z + xv[i].w * xv[i].w;
      ss = wave_sum(ss);
      const float rs = rsqrtf(ss * (1.f / 1024.f) + 1e-6f);
#pragma unroll
      for (int i = 0; i < 4; ++i) {
        const int c = i * 256 + lane * 4;
        float4 pg = *(const float4*)(preg + c);
        float4 sh = *(const float4*)(shift + (size_t)b * 9216 + c);
        float4 sc = *(const float4*)(scale + (size_t)b * 9216 + c);
        uint2 o;
        o.x = pack2(xv[i].x * rs * pg.x * (1.f + sc.x) + sh.x, xv[i].y * rs * pg.y * (1.f + sc.y) + sh.y);
        o.y = pack2(xv[i].z * rs * pg.z * (1.f + sc.z) + sh.z, xv[i].w * rs * pg.w * (1.f + sc.w) + sh.w);
        *(uint2*)(h + (size_t)row * D + c) = o;
      }
    }
  }
}

template <int NS, class FA, class FB>
__device__ __forceinline__ void gemm_loop(f32x4 (&acc)[4][NS], const FA& fa, const FB& fb, int K, u16* sm) {
  constexpr int BN = 32 * NS;
  constexpr int NBV = BN / 32;
  const int tid = tidx(), lane = tid & 63, wid = tid >> 6, wr = wid >> 1, wc = wid & 1, fr = lane & 15, fq = lane >> 4;
  u16* As = sm; u16* Bs = sm + 2 * 128 * 72;
  uint4 ra[4], rb[NBV];
  const int nt = K >> 6;
#pragma unroll
  for (int i = 0; i < 4; ++i) { int v = tid + i * 256; ra[i] = fa(v >> 3, (v & 7) * 8); }
#pragma unroll
  for (int i = 0; i < NBV; ++i) { int v = tid + i * 256; rb[i] = fb(v >> 3, (v & 7) * 8); }
#pragma unroll
  for (int i = 0; i < 4; ++i) { int v = tid + i * 256; *(uint4*)(As + (v >> 3) * 72 + (v & 7) * 8) = ra[i]; }
#pragma unroll
  for (int i = 0; i < NBV; ++i) { int v = tid + i * 256; *(uint4*)(Bs + (v >> 3) * 72 + (v & 7) * 8) = rb[i]; }
  __syncthreads();
#pragma unroll 1
  for (int kt = 0; kt < nt; ++kt) {
    const int cur = kt & 1;
    if (kt + 1 < nt) {
      const int kb = (kt + 1) << 6;
#pragma unroll
      for (int i = 0; i < 4; ++i) { int v = tid + i * 256; ra[i] = fa(v >> 3, kb + (v & 7) * 8); }
#pragma unroll
      for (int i = 0; i < NBV; ++i) { int v = tid + i * 256; rb[i] = fb(v >> 3, kb + (v & 7) * 8); }
    }
    const u16* Ab = As + cur * 128 * 72 + (wr * 64 + fr) * 72 + fq * 8;
    const u16* Bb = Bs + cur * BN * 72 + (wc * 16 * NS + fr) * 72 + fq * 8;
#pragma unroll
    for (int ks = 0; ks < 2; ++ks) {
      bf16x8 a[4], b[NS];
#pragma unroll
      for (int m = 0; m < 4; ++m) a[m] = *(const bf16x8*)(Ab + m * 16 * 72 + ks * 32);
#pragma unroll
      for (int n = 0; n < NS; ++n) b[n] = *(const bf16x8*)(Bb + n * 16 * 72 + ks * 32);
#pragma unroll
      for (int m = 0; m < 4; ++m)
#pragma unroll
        for (int n = 0; n < NS; ++n) acc[m][n] = mfma16(a[m], b[n], acc[m][n]);
    }
    if (kt + 1 < nt) {
      u16* Aw = As + (cur ^ 1) * 128 * 72; u16* Bw = Bs + (cur ^ 1) * BN * 72;
#pragma unroll
      for (int i = 0; i < 4; ++i) { int v = tid + i * 256; *(uint4*)(Aw + (v >> 3) * 72 + (v & 7) * 8) = ra[i]; }
#pragma unroll
      for (int i = 0; i < NBV; ++i) { int v = tid + i * 256; *(uint4*)(Bw + (v >> 3) * 72 + (v & 7) * 8) = rb[i]; }
    }
    __syncthreads();
  }
}

__device__ __forceinline__ bool tile_map(int it, int NT, int& mt, int& nt) {
  const int g = gridDim.x;
  if ((g & 7) == 0) {
    const int xcd = blockIdx.x & 7, bx = blockIdx.x >> 3, nbx = g >> 3;
    const int lid = bx + it * nbx;
    if (lid >= 32 * NT) return false;
    const int grp = lid / (8 * NT), rem = lid - grp * 8 * NT;
    nt = rem >> 3; mt = xcd * 32 + grp * 8 + (rem & 7);
    return true;
  } else {
    const int id = blockIdx.x + it * g;
    if (id >= 256 * NT) return false;
    nt = id % NT; mt = id / NT;
    return true;
  }
}

#define ZERO_ACC(acc, NSV) _Pragma("unroll") for (int m_ = 0; m_ < 4; ++m_) _Pragma("unroll") for (int n_ = 0; n_ < NSV; ++n_) acc[m_][n_] = f32x4{0.f, 0.f, 0.f, 0.f};

__device__ __forceinline__ void phase_ffn_in(const Params& p, char* smem) {
  const u16* H = (const u16*)(p.ws + OFF_H); const u16* W = (const u16*)(p.ws + OFF_WIN); u16* ACT = (u16*)(p.ws + OFF_ACT);
  const int lane = tidx() & 63, wid = tidx() >> 6, wr = wid >> 1, wc = wid & 1, fr = lane & 15, fq = lane >> 4;
  int mt, nt;
  for (int it = 0; tile_map(it, 44, mt, nt); ++it) {
    const int m0 = mt * 128, n0 = nt * 128;
    f32x4 acc[4][4]; ZERO_ACC(acc, 4)
    auto fa = [&](int r, int k) { return *(const uint4*)(H + (size_t)(m0 + r) * 1024 + k); };
    auto fb = [&](int r, int k) { return *(const uint4*)(W + (size_t)(n0 + r) * 1024 + k); };
    gemm_loop<4>(acc, fa, fb, 1024, (u16*)smem);
#pragma unroll
    for (int m = 0; m < 4; ++m)
#pragma unroll
      for (int n = 0; n < 2; ++n) {
        const int col = nt * 64 + wc * 32 + n * 16 + fr;
        const int r0 = m0 + wr * 64 + m * 16 + fq * 4;
#pragma unroll
        for (int j = 0; j < 4; ++j) ACT[(size_t)(r0 + j) * DFF + col] = f2bf(siluf_(acc[m][n][j]) * acc[m][n + 2][j]);
      }
  }
}

__device__ __forceinline__ void phase_gemm_plain(const u16* A, int lda, const u16* Bt, int K, u16* C, char* smem) {
  const int lane = tidx() & 63, wid = tidx() >> 6, wr = wid >> 1, wc = wid & 1, fr = lane & 15, fq = lane >> 4;
  int mt, nt;
  for (int it = 0; tile_map(it, 8, mt, nt); ++it) {
    const int m0 = mt * 128, n0 = nt * 128;
    f32x4 acc[4][4]; ZERO_ACC(acc, 4)
    auto fa = [&](int r, int k) { return *(const uint4*)(A + (size_t)(m0 + r) * lda + k); };
    auto fb = [&](int r, int k) { return *(const uint4*)(Bt + (size_t)(n0 + r) * K + k); };
    gemm_loop<4>(acc, fa, fb, K, (u16*)smem);
#pragma unroll
    for (int m = 0; m < 4; ++m)
#pragma unroll
      for (int n = 0; n < 4; ++n) {
        const int col = n0 + wc * 64 + n * 16 + fr;
        const int r0 = m0 + wr * 64 + m * 16 + fq * 4;
#pragma unroll
        for (int j = 0; j < 4; ++j) C[(size_t)(r0 + j) * 1024 + col] = f2bf(acc[m][n][j]);
      }
  }
}

__device__ __forceinline__ void phase_inproj(const Params& p, char* smem) {
  const u16* H = (const u16*)(p.ws + OFF_H); const u16* W = (const u16*)(p.ws + OFF_WMIX);
  u16* P1 = (u16*)(p.ws + OFF_P1); u16* P2 = (u16*)(p.ws + OFF_P2); u16* VT = (u16*)(p.ws + OFF_VT); u16* PB = (u16*)(p.ws + OFF_PB);
  const int lane = tidx() & 63, wid = tidx() >> 6, wr = wid >> 1, wc = wid & 1, fr = lane & 15, fq = lane >> 4;
  int mt, nt;
  for (int it = 0; tile_map(it, 33, mt, nt); ++it) {
    const int m0 = mt * 128, n0 = nt * 128;
    f32x4 acc[4][4]; ZERO_ACC(acc, 4)
    auto fa = [&](int r, int k) { return *(const uint4*)(H + (size_t)(m0 + r) * 1024 + k); };
    auto fb = [&](int r, int k) { return *(const uint4*)(W + (size_t)(n0 + r) * 1024 + k); };
    gemm_loop<4>(acc, fa, fb, 1024, (u16*)smem);
#pragma unroll
    for (int m = 0; m < 4; ++m)
#pragma unroll
      for (int nn = 0; nn < 4; ++nn) {
        const int n = n0 + wc * 64 + nn * 16 + fr;
        if (n >= MIXN) continue;
        const int r0 = m0 + wr * 64 + m * 16 + fq * 4;
        f32x4 v = acc[m][nn];
        if ((n >= 896 && n < 1024) || (n >= 1152 && n < 1280)) {
          const int which = (n >= 1152) ? 1 : 0;
          const int gd = n - (which ? 1152 : 896);
          const int b = r0 >> 12, t = r0 & 4095;
          uint2 o; o.x = pack2(v[0], v[1]); o.y = pack2(v[2], v[3]);
          *(uint2*)(VT + ((size_t)((which * 8 + b) * 128 + gd)) * 4096 + (t & ~31) + 8 * fq + 4 * (m & 1)) = o;
        } else if (n < 1304) {
          const int pc = (n < 896) ? n : ((n < 1152) ? n - 128 : n - 256);
          if (n < 512) { v[0] *= 0.125f; v[1] *= 0.125f; v[2] *= 0.125f; v[3] *= 0.125f; }
          if (n >= 1280) { v[0] = sigmoidf_(v[0]); v[1] = sigmoidf_(v[1]); v[2] = sigmoidf_(v[2]); v[3] = sigmoidf_(v[3]); }
#pragma unroll
          for (int j = 0; j < 4; ++j) P1[(size_t)(r0 + j) * PS1 + pc] = f2bf(v[j]);
        } else if (n < 2328) {
#pragma unroll
          for (int j = 0; j < 4; ++j) P1[(size_t)(r0 + j) * PS1 + (n - 256)] = f2bf(geluf_(v[j]));
        } else {
          const int pc = n - 2328;
#pragma unroll
          for (int j = 0; j < 4; ++j) P2[(size_t)(r0 + j) * PS2 + pc] = f2bf(v[j]);
          if ((m & 1) && fq == 3) PB[(size_t)((r0 + 3) >> 5) * 1792 + pc] = f2bf(v[3]);
        }
      }
  }
}

__device__ __forceinline__ void phase_merge(const Params& p, char* smem) {
  const u16* H2 = (const u16*)(p.ws + OFF_H2); const u16* WG = (const u16*)(p.ws + OFF_WG); const u16* WB = (const u16*)(p.ws + OFF_WB);
  const u16* P1 = (const u16*)(p.ws + OFF_P1); const u16* YC = (const u16*)(p.ws + OFF_YC); u16* MG = (u16*)(p.ws + OFF_MERGED);
  const int lane = tidx() & 63, wid = tidx() >> 6, wr = wid >> 1, wc = wid & 1, fr = lane & 15, fq = lane >> 4;
  int mt, nt;
  for (int it = 0; tile_map(it, 16, mt, nt); ++it) {
    const int m0 = mt * 128, n0 = nt * 64;
    f32x4 tot[4][2]; ZERO_ACC(tot, 2)
#pragma unroll 1
    for (int i = 0; i < 3; ++i) {
      unsigned gpk[4][2][2];
      {
        f32x4 ag[4][2]; ZERO_ACC(ag, 2)
        auto fa2 = [&](int r, int k) { return *(const uint4*)(H2 + (size_t)(m0 + r) * 1024 + k); };
        auto fb2 = [&](int r, int k) { return *(const uint4*)(WG + (size_t)(i * 1024 + n0 + r) * 1024 + k); };
        gemm_loop<2>(ag, fa2, fb2, 1024, (u16*)smem);
#pragma unroll
        for (int m = 0; m < 4; ++m)
#pragma unroll
          for (int n = 0; n < 2; ++n) {
            gpk[m][n][0] = pack2(sigmoidf_(ag[m][n][0]), sigmoidf_(ag[m][n][1]));
            gpk[m][n][1] = pack2(sigmoidf_(ag[m][n][2]), sigmoidf_(ag[m][n][3]));
          }
      }
      f32x4 ay[4][2]; ZERO_ACC(ay, 2)
      const u16* ya = (i == 0) ? P1 : ((i == 1) ? P1 + 1048 : YC);
      const int lda = (i == 2) ? 512 : PS1;
      const u16* wb = WB + (size_t)i * 1024 * 512;
      auto fa = [&](int r, int k) { return *(const uint4*)(ya + (size_t)(m0 + r) * lda + k); };
      auto fb = [&](int r, int k) { return *(const uint4*)(wb + (size_t)(n0 + r) * 512 + k); };
      gemm_loop<2>(ay, fa, fb, 512, (u16*)smem);
#pragma unroll
      for (int m = 0; m < 4; ++m)
#pragma unroll
        for (int n = 0; n < 2; ++n) {
          tot[m][n][0] += bf2f((u16)(gpk[m][n][0] & 0xffff)) * ay[m][n][0];
          tot[m][n][1] += bf2f((u16)(gpk[m][n][0] >> 16)) * ay[m][n][1];
          tot[m][n][2] += bf2f((u16)(gpk[m][n][1] & 0xffff)) * ay[m][n][2];
          tot[m][n][3] += bf2f((u16)(gpk[m][n][1] >> 16)) * ay[m][n][3];
        }
    }
#pragma unroll
    for (int m = 0; m < 4; ++m)
#pragma unroll
      for (int n = 0; n < 2; ++n) {
        const int col = n0 + wc * 32 + n * 16 + fr;
        const int r0 = m0 + wr * 64 + m * 16 + fq * 4;
#pragma unroll
        for (int j = 0; j < 4; ++j) MG[(size_t)(r0 + j) * 1024 + col] = f2bf(tot[m][n][j]);
      }
  }
}

__device__ __forceinline__ void phase_cmp1(const Params& p, int l, char* smem) {
  const u16* P1 = (const u16*)(p.ws + OFF_P1); const u16* W1 = (const u16*)(p.ws + OFF_W1); u16* HID = (u16*)(p.ws + OFF_HID);
  const int lane = tidx() & 63, wid = tidx() >> 6, wr = wid >> 1, wc = wid & 1, fr = lane & 15, fq = lane >> 4;
  for (int tix = blockIdx.x; tix < 128; tix += gridDim.x) {
    const int which = tix >> 6, mt = (tix >> 1) & 31, nt = tix & 1;
    const int m0 = mt * 128, n0 = nt * 128;
    const float* pe = (which ? p.in[16] : p.in[13]) + (size_t)l * 2048;
    const u16* w1 = W1 + (size_t)which * 256 * 2048;
    const int cbase = 512 + which * 128;
    f32x4 acc[4][4]; ZERO_ACC(acc, 4)
    auto fa = [&](int r, int k) {
      const int row = m0 + r; const int g = row & 1, n = (row >> 1) & 255, b = row >> 9;
      uint4 o = make_uint4(0, 0, 0, 0);
      if (n < 255) {
        const int lpos = k >> 6, d = k & 63;
        uint4 raw = *(const uint4*)(P1 + (size_t)(b * 4096 + 16 * n + lpos) * PS1 + cbase + g * 64 + d);
        const float* pp = pe + lpos * 64 + d;
        float4 e0 = *(const float4*)pp, e1 = *(const float4*)(pp + 4);
        o.x = pack2(bf2f((u16)(raw.x & 0xffff)) + e0.x, bf2f((u16)(raw.x >> 16)) + e0.y);
        o.y = pack2(bf2f((u16)(raw.y & 0xffff)) + e0.z, bf2f((u16)(raw.y >> 16)) + e0.w);
        o.z = pack2(bf2f((u16)(raw.z & 0xffff)) + e1.x, bf2f((u16)(raw.z >> 16)) + e1.y);
        o.w = pack2(bf2f((u16)(raw.w & 0xffff)) + e1.z, bf2f((u16)(raw.w >> 16)) + e1.w);
      }
      return o;
    };
    auto fb = [&](int r, int k) { return *(const uint4*)(w1 + (size_t)(n0 + r) * 2048 + k); };
    gemm_loop<4>(acc, fa, fb, 2048, (u16*)smem);
#pragma unroll
    for (int m = 0; m < 4; ++m)
#pragma unroll
      for (int n = 0; n < 4; ++n) {
        const int col = n0 + wc * 64 + n * 16 + fr;
        const int r0 = m0 + wr * 64 + m * 16 + fq * 4;
#pragma unroll
        for (int j = 0; j < 4; ++j) HID[((size_t)which * 4096 + r0 + j) * 256 + col] = f2bf(siluf_(acc[m][n][j]));
      }
  }
}

__device__ __forceinline__ void phase_cmp2(const Params& p, int l) {
  const u16* HID = (const u16*)(p.ws + OFF_HID); u16* KC = (u16*)(p.ws + OFF_KC); u16* VC = (u16*)(p.ws + OFF_VC);
  const int total = 2 * 4096 * 64;
  for (int idx = blockIdx.x * 256 + tidx(); idx < total; idx += gridDim.x * 256) {
    const int d = idx & 63, row = (idx >> 6) & 4095, which = idx >> 18;
    const float* w2 = (which ? p.in[15] : p.in[12]) + (size_t)l * 256 * 64;
    const u16* hr = HID + ((size_t)which * 4096 + row) * 256;
    float acc = 0.f;
#pragma unroll 8
    for (int j = 0; j < 256; ++j) acc += bf2f(hr[j]) * w2[j * 64 + d];
    const int g = row & 1, n = (row >> 1) & 255, b = row >> 9;
    if (which == 0) KC[((size_t)(b * 2 + g) * 256 + n) * 64 + d] = f2bf(acc);
    else {
      const int u = n & 31; const int pp = 8 * ((u >> 2) & 3) + 4 * (u >> 4) + (u & 3);
      VC[((size_t)(b * 2 + g) * 64 + d) * 256 + (n & ~31) + pp] = f2bf(acc);
    }
  }
}

__device__ __forceinline__ void phase_sgu(const Params& p, int l, char* smem) {
  u16* P1 = (u16*)(p.ws + OFF_P1);
  u16* Wt = (u16*)smem;
  u16* Vt = Wt + 128 * 136;
  float* st = (float*)(Vt + 128 * 136);
  const int tid = tidx(), lane = tid & 63, wid = tid >> 6, wr = wid >> 1, wc = wid & 1, fr = lane & 15, fq = lane >> 4;
  const float* lng = p.in[17] + (size_t)l * 512; const float* lnb = p.in[18] + (size_t)l * 512;
  for (int item = blockIdx.x; item < 1024; item += gridDim.x) {
    const int ci = item >> 2, gi = item & 3;
    const int tok0 = ci * 128;
    for (int r = wid * 32; r < wid * 32 + 32; ++r) {
      uint4 raw = *(const uint4*)(P1 + (size_t)(tok0 + r) * PS1 + 1560 + lane * 8);
      float f[8];
      f[0] = bf2f((u16)(raw.x & 0xffff)); f[1] = bf2f((u16)(raw.x >> 16)); f[2] = bf2f((u16)(raw.y & 0xffff)); f[3] = bf2f((u16)(raw.y >> 16));
      f[4] = bf2f((u16)(raw.z & 0xffff)); f[5] = bf2f((u16)(raw.z >> 16)); f[6] = bf2f((u16)(raw.w & 0xffff)); f[7] = bf2f((u16)(raw.w >> 16));
      float s = 0.f, s2 = 0.f;
#pragma unroll
      for (int e = 0; e < 8; ++e) { s += f[e]; }
      s = wave_sum(s);
      const float mu = s * (1.f / 512.f);
#pragma unroll
      for (int e = 0; e < 8; ++e) { float dlt = f[e] - mu; s2 += dlt * dlt; }
      s2 = wave_sum(s2);
      if (lane == 0) { st[r * 2] = mu; st[r * 2 + 1] = rsqrtf(s2 * (1.f / 512.f) + 1e-5f); }
    }
    const float* wsrc = p.in[19] + ((size_t)(l * 4 + gi)) * 128 * 128;
    for (int e = tid; e < 128 * 32; e += 256) {
      const int t = e >> 5, s4 = (e & 31) * 4;
      float4 w = *(const float4*)(wsrc + t * 128 + s4);
      uint2 o;
      o.x = pack2(s4 + 0 <= t ? w.x : 0.f, s4 + 1 <= t ? w.y : 0.f);
      o.y = pack2(s4 + 2 <= t ? w.z : 0.f, s4 + 3 <= t ? w.w : 0.f);
      *(uint2*)(Wt + t * 136 + s4) = o;
    }
    __syncthreads();
    for (int e = tid; e < 128 * 16; e += 256) {
      const int s = e >> 4, c8 = (e & 15) * 8;
      uint4 raw = *(const uint4*)(P1 + (size_t)(tok0 + s) * PS1 + 1560 + gi * 128 + c8);
      const float mu = st[s * 2], rs = st[s * 2 + 1];
      u16 rv[8] = {(u16)(raw.x & 0xffff), (u16)(raw.x >> 16), (u16)(raw.y & 0xffff), (u16)(raw.y >> 16), (u16)(raw.z & 0xffff), (u16)(raw.z >> 16), (u16)(raw.w & 0xffff), (u16)(raw.w >> 16)};
#pragma unroll
      for (int i = 0; i < 8; ++i) {
        const int c = gi * 128 + c8 + i;
        Vt[(c8 + i) * 136 + s] = f2bf((bf2f(rv[i]) - mu) * rs * lng[c] + lnb[c]);
      }
    }
    __syncthreads();
    f32x4 acc[4][4]; ZERO_ACC(acc, 4)
#pragma unroll 1
    for (int ks = 0; ks < 4; ++ks) {
      bf16x8 a[4], b[4];
#pragma unroll
      for (int m = 0; m < 4; ++m) a[m] = *(const bf16x8*)(Wt + (wr * 64 + m * 16 + fr) * 136 + ks * 32 + fq * 8);
#pragma unroll
      for (int n = 0; n < 4; ++n) b[n] = *(const bf16x8*)(Vt + (wc * 64 + n * 16 + fr) * 136 + ks * 32 + fq * 8);
#pragma unroll
      for (int m = 0; m < 4; ++m)
#pragma unroll
        for (int n = 0; n < 4; ++n) acc[m][n] = mfma16(a[m], b[n], acc[m][n]);
    }
    const float* bs = p.in[20] + ((size_t)(l * 4 + gi)) * 128;
#pragma unroll
    for (int m = 0; m < 4; ++m)
#pragma unroll
      for (int n = 0; n < 4; ++n) {
        const int c = wc * 64 + n * 16 + fr;
#pragma unroll
        for (int j = 0; j < 4; ++j) {
          const int t = wr * 64 + m * 16 + fq * 4 + j;
          u16* up = P1 + (size_t)(tok0 + t) * PS1 + 1048 + gi * 128 + c;
          *up = f2bf(bf2f(*up) * (acc[m][n][j] + bs[t]));
        }
      }
    __syncthreads();
  }
}

__device__ __forceinline__ void phase_prep1(const Params& p, int l) {
  u16* P2 = (u16*)(p.ws + OFF_P2); const u16* PB = (const u16*)(p.ws + OFF_PB); u16* VF = (u16*)(p.ws + OFF_VFIRST);
  const float* mu = p.in[21] + (size_t)l * 1792;
  const int total = 1024 * 224;
  for (int idx = blockIdx.x * 256 + tidx(); idx < total; idx += gridDim.x * 256) {
    const int tile = idx / 224, cg8 = (idx % 224) * 8;
    const int tok0 = tile * 32;
    float m8[8];
#pragma unroll
    for (int e = 0; e < 8; ++e) m8[e] = mu[cg8 + e];
    uint4 prev = make_uint4(0, 0, 0, 0);
    if ((tok0 & 4095) != 0) prev = *(const uint4*)(PB + (size_t)(tile - 1) * 1792 + cg8);
    for (int r = 0; r < 32; ++r) {
      u16* ptr = P2 + (size_t)(tok0 + r) * PS2 + cg8;
      uint4 cur = *(const uint4*)ptr;
      unsigned cu[4] = {cur.x, cur.y, cur.z, cur.w}, pu[4] = {prev.x, prev.y, prev.z, prev.w};
      float o[8];
#pragma unroll
      for (int e = 0; e < 8; ++e) {
        float c = bf2f((u16)((cu[e >> 1] >> ((e & 1) * 16)) & 0xffff));
        float pv = bf2f((u16)((pu[e >> 1] >> ((e & 1) * 16)) & 0xffff));
        float s = c + (pv - c) * m8[e];
        if (cg8 >= 1536 && cg8 < 1600) s = tanhf(s);
        else if (cg8 >= 1664) s = sigmoidf_(s);
        o[e] = s;
      }
      uint4 ov; ov.x = pack2(o[0], o[1]); ov.y = pack2(o[2], o[3]); ov.z = pack2(o[4], o[5]); ov.w = pack2(o[6], o[7]);
      *(uint4*)ptr = ov;
      if (l == 0 && cg8 >= 1024 && cg8 < 1536) *(uint4*)(VF + (size_t)(tok0 + r) * 512 + cg8 - 1024) = ov;
      prev = cur;
    }
  }
}

__device__ __forceinline__ void phase_prep2(const Params& p, int l, char* smem) {
  u16* P2 = (u16*)(p.ws + OFF_P2); const u16* VF = (const u16*)(p.ws + OFF_VFIRST);
  float* twd = (float*)smem;
  float* adl = twd + 1024;
  float* vsh = adl + 1024;
  float* lv = vsh + 8192;
  const int tid = tidx();
  const float* w0 = p.in[22] + (size_t)l * 512; const float* w2 = p.in[23] + (size_t)l * 64 * 512;
  const float* a0 = p.in[24] + (size_t)l * 512; const float* a2 = p.in[25] + (size_t)l * 64 * 512;
  const float* kkp = p.in[27] + (size_t)l * 512; const float* kap = p.in[28] + (size_t)l * 512;
  for (int item = blockIdx.x; item < 2048; item += gridDim.x) {
    const int tok0 = item * 16;
    for (int e = tid; e < 2048; e += 256) {
      const int r = e >> 7, c = e & 127;
      twd[(c >> 6) * 1024 + r * 64 + (c & 63)] = bf2f(P2[(size_t)(tok0 + r) * PS2 + 1536 + c]);
    }
    if (l > 0) {
      for (int e = tid; e < 8192; e += 256) { const int r = e >> 9, c = e & 511; vsh[e] = bf2f(P2[(size_t)(tok0 + r) * PS2 + 1024 + c]); }
    }
    __syncthreads();
    if (l > 0) {
      const float* v1 = p.in[33];
      for (int e = tid; e < 512; e += 256) {
        const int r = e >> 5, j = e & 31;
        float s = 0.f;
#pragma unroll 8
        for (int c = 0; c < 512; ++c) s += vsh[r * 512 + c] * v1[c * 32 + j];
        lv[r * 32 + j] = s;
      }
      __syncthreads();
    }
#pragma unroll 1
    for (int hc = 0; hc < 2; ++hc) {
      const int ch = tid + hc * 256;
      float aw[16], aa[16];
#pragma unroll
      for (int r = 0; r < 16; ++r) { aw[r] = 0.f; aa[r] = 0.f; }
#pragma unroll 2
      for (int i = 0; i < 64; ++i) {
        const float w2v = w2[i * 512 + ch], a2v = a2[i * 512 + ch];
#pragma unroll
        for (int r = 0; r < 16; ++r) { aw[r] += twd[r * 64 + i] * w2v; aa[r] += adl[r * 64 + i] * a2v; }
      }
      float am[16];
      if (l > 0) {
        const float* v2 = p.in[34];
#pragma unroll
        for (int r = 0; r < 16; ++r) am[r] = 0.f;
        for (int j = 0; j < 32; ++j) {
          const float v2v = v2[j * 512 + ch];
#pragma unroll
          for (int r = 0; r < 16; ++r) am[r] += lv[r * 32 + j] * v2v;
        }
      }
      const float w0v = w0[ch], a0v = a0[ch], kkv = kkp[ch], kav = kap[ch];
      const float v0v = (l > 0) ? p.in[32][ch] : 0.f;
#pragma unroll
      for (int r = 0; r < 16; ++r) {
        u16* row = P2 + (size_t)(tok0 + r) * PS2;
        const float kval = bf2f(row[512 + ch]);
        const float wpre = w0v + aw[r];
        const float nx = -wpre;
        const float sp = fmaxf(nx, 0.f) + log1pf(__expf(-fabsf(nx)));
        const float w = -sp - 0.5f;
        const float decay = __expf(-__expf(w));
        const float a = sigmoidf_(a0v + aa[r]);
        const float kk = kval * kkv;
        const float ss = wave_sum(kk * kk);
        const float kkn = kk / fmaxf(sqrtf(ss), 1e-12f);
        row[1792 + ch] = f2bf(decay);
        row[2304 + ch] = f2bf(kkn);
        row[2816 + ch] = f2bf(kkn * a);
        row[512 + ch] = f2bf(kval * (1.f + (a - 1.f) * kav));
        if (l > 0) {
          const float v = vsh[r * 512 + ch];
          const float vf = bf2f(VF[(size_t)(tok0 + r) * 512 + ch]);
          row[1024 + ch] = f2bf(v + (vf - v) * sigmoidf_(v0v + am[r]));
        }
      }
    }
    __syncthreads();
  }
}

__device__ __forceinline__ void scan_item(const Params& p, int item, char* smem) {
  const u16* P2 = (const u16*)(p.ws + OFF_P2); u16* YC = (u16*)(p.ws + OFF_YC);
  float* vb = (float*)smem;
  float* yb = vb + 2 * 6 * 16 * 64;
  const int tid = tidx(), lane = tid & 63, wid = tid >> 6;
  const int rq = item & 3, h = (item >> 2) & 7, b = item >> 5;
  const int rl = lane >> 4, cq = lane & 15;
  const int rloc = wid * 4 + rl;
  const int ihead = rq * 16 + rloc;
  const int j0 = cq * 4;
  const size_t tokb = (size_t)b * 4096;
  float s0 = 0.f, s1 = 0.f, s2 = 0.f, s3 = 0.f;
  uint4 pre[3];
  auto gload = [&](int c) {
#pragma unroll
    for (int i = 0; i < 3; ++i) {
      const int v = tid + i * 256; const int vec = v >> 7, rem = v & 127, step = rem >> 3, c8 = rem & 7;
      const int off = (vec == 0) ? 0 : (vec == 1) ? 1792 : (vec == 2) ? 512 : (vec == 3) ? 1024 : (vec == 4) ? 2304 : 2816;
      pre[i] = *(const uint4*)(P2 + (tokb + c * 16 + step) * PS2 + off + h * 64 + c8 * 8);
    }
  };
  auto lstore = [&](int buf) {
#pragma unroll
    for (int i = 0; i < 3; ++i) {
      const int v = tid + i * 256; const int vec = v >> 7, rem = v & 127, step = rem >> 3, c8 = rem & 7;
      float* d = vb + ((buf * 6 + vec) * 16 + step) * 64 + c8 * 8;
      float4 f0, f1;
      f0.x = bf2f((u16)(pre[i].x & 0xffff)); f0.y = bf2f((u16)(pre[i].x >> 16)); f0.z = bf2f((u16)(pre[i].y & 0xffff)); f0.w = bf2f((u16)(pre[i].y >> 16));
      f1.x = bf2f((u16)(pre[i].z & 0xffff)); f1.y = bf2f((u16)(pre[i].z >> 16)); f1.z = bf2f((u16)(pre[i].w & 0xffff)); f1.w = bf2f((u16)(pre[i].w >> 16));
      *(float4*)d = f0; *(float4*)(d + 4) = f1;
    }
  };
  gload(0); lstore(0);
  __syncthreads();
  for (int c = 0; c < 256; ++c) {
    const int buf = c & 1;
    if (c + 1 < 256) gload(c + 1);
    const float* base = vb + buf * 6 * 16 * 64;
#pragma unroll 4
    for (int st = 0; st < 16; ++st) {
      const float4 r4 = *(const float4*)(base + (0 * 16 + st) * 64 + j0);
      const float4 w4 = *(const float4*)(base + (1 * 16 + st) * 64 + j0);
      const float4 k4 = *(const float4*)(base + (2 * 16 + st) * 64 + j0);
      const float vi = base[(3 * 16 + st) * 64 + ihead];
      const float4 n4 = *(const float4*)(base + (4 * 16 + st) * 64 + j0);
      const float4 b4 = *(const float4*)(base + (5 * 16 + st) * 64 + j0);
      float sa = s0 * n4.x + s1 * n4.y + s2 * n4.z + s3 * n4.w;
      sa = -dpp_sum16(sa);
      s0 = s0 * w4.x + sa * b4.x + vi * k4.x;
      s1 = s1 * w4.y + sa * b4.y + vi * k4.y;
      s2 = s2 * w4.z + sa * b4.z + vi * k4.z;
      s3 = s3 * w4.w + sa * b4.w + vi * k4.w;
      float y = s0 * r4.x + s1 * r4.y + s2 * r4.z + s3 * r4.w;
      y = dpp_sum16(y);
      if (cq == 0) yb[st * 16 + rloc] = y;
    }
    __syncthreads();
    {
      const int st = tid >> 4, r = tid & 15;
      YC[(tokb + c * 16 + st) * 512 + h * 64 + rq * 16 + r] = f2bf(yb[st * 16 + r]);
    }
    if (c + 1 < 256) lstore(buf ^ 1);
    __syncthreads();
  }
}

__device__ __forceinline__ void phase_post(const Params& p, int l, char* smem) {
  const u16* P2 = (const u16*)(p.ws + OFF_P2); u16* YC = (u16*)(p.ws + OFF_YC);
  float* sg = (float*)smem;
  const int tid = tidx();
  const float* g2 = p.in[26] + (size_t)l * 128 * 512;
  const float* rk = p.in[29] + (size_t)l * 512; const float* lg = p.in[30] + (size_t)l * 512; const float* lb = p.in[31] + (size_t)l * 512;
  for (int item = blockIdx.x; item < 2048; item += gridDim.x) {
    const int tok0 = item * 16;
    for (int e = tid; e < 2048; e += 256) { const int r = e >> 7, c = e & 127; sg[e] = bf2f(P2[(size_t)(tok0 + r) * PS2 + 1664 + c]); }
    __syncthreads();
#pragma unroll 1
    for (int hc = 0; hc < 2; ++hc) {
      const int ch = tid + hc * 256;
      float ag[16];
#pragma unroll
      for (int r = 0; r < 16; ++r) ag[r] = 0.f;
#pragma unroll 2
      for (int i = 0; i < 128; ++i) {
        const float gv = g2[i * 512 + ch];
#pragma unroll
        for (int r = 0; r < 16; ++r) ag[r] += sg[r * 128 + i] * gv;
      }
      const float rkv = rk[ch], lgv = lg[ch], lbv = lb[ch];
#pragma unroll
      for (int r = 0; r < 16; ++r) {
        const u16* row = P2 + (size_t)(tok0 + r) * PS2;
        const float y = bf2f(YC[(size_t)(tok0 + r) * 512 + ch]);
        const float mean = wave_sum(y) * (1.f / 64.f);
        const float dv = y - mean;
        const float var = wave_sum(dv * dv) * (1.f / 64.f);
        const float yn = dv * rsqrtf(var + 64e-5f) * lgv + lbv;
        const float rr = bf2f(row[ch]), kk = bf2f(row[512 + ch]), vv = bf2f(row[1024 + ch]);
        const float bon = wave_sum(rr * kk * rkv) * vv;
        YC[(size_t)(tok0 + r) * 512 + ch] = f2bf((yn + bon) * ag[r]);
      }
    }
    __syncthreads();
  }
}

#define NEGV (-1e30f)
struct AttnState { float m[2]; float ls[2]; f32x4 ot[4][2]; };

template <int MODE>
__device__ __forceinline__ void attn_scores(f32x4 (&st)[4][2], const u16* kbase, int kstride, int key0, const bf16x8 (&qf)[2][2],
                                            const float (&slope)[2], int t, bool selbit, int c16, int q4) {
#pragma unroll
  for (int mk = 0; mk < 4; ++mk) {
    const u16* kp = kbase + (size_t)(mk * 16 + c16) * kstride + q4 * 8;
    const bf16x8 k0 = *(const bf16x8*)kp, k1 = *(const bf16x8*)(kp + 32);
#pragma unroll
    for (int nq = 0; nq < 2; ++nq) {
      f32x4 a = {0.f, 0.f, 0.f, 0.f};
      a = mfma16(k0, qf[nq][0], a);
      a = mfma16(k1, qf[nq][1], a);
#pragma unroll
      for (int j = 0; j < 4; ++j) {
        const int key = key0 + mk * 16 + q4 * 4 + j;
        int dist; bool valid;
        if (MODE == 0) { dist = t - (16 * key + 31); valid = dist >= 0; }
        else if (MODE == 1) { dist = t - key; valid = (dist >= 0) && selbit; }
        else { dist = t - key; valid = (dist >= 0) && (dist < 512); }
        a[j] = valid ? (a[j] - slope[nq] * (float)dist) : NEGV;
      }
      st[mk][nq] = a;
    }
  }
}

template <int MODE>
__device__ __forceinline__ void attn_tile(AttnState& S, const u16* kbase, int kstride, const u16* vtbase, int vstride, int key0,
                                          const bf16x8 (&qf)[2][2], const float (&slope)[2], int t, bool selbit, int c16, int q4) {
  f32x4 st[4][2];
  attn_scores<MODE>(st, kbase, kstride, key0, qf, slope, t, selbit, c16, q4);
  __builtin_amdgcn_sched_barrier(0);
#pragma unroll
  for (int nq = 0; nq < 2; ++nq) {
    float mx = NEGV;
#pragma unroll
    for (int mk = 0; mk < 4; ++mk)
#pragma unroll
      for (int j = 0; j < 4; ++j) mx = fmaxf(mx, st[mk][nq][j]);
    mx = fmaxf(mx, __shfl_xor(mx, 16)); mx = fmaxf(mx, __shfl_xor(mx, 32));
    const float mnew = fmaxf(S.m[nq], mx);
    const float alpha = __expf(S.m[nq] - mnew);
    S.m[nq] = mnew;
    float ls = S.ls[nq] * alpha;
#pragma unroll
    for (int md = 0; md < 4; ++md) { S.ot[md][nq][0] *= alpha; S.ot[md][nq][1] *= alpha; S.ot[md][nq][2] *= alpha; S.ot[md][nq][3] *= alpha; }
#pragma unroll
    for (int mk = 0; mk < 4; ++mk)
#pragma unroll
      for (int j = 0; j < 4; ++j) {
        const float sv = st[mk][nq][j];
        const float pv = (sv > -1e29f) ? __expf(sv - mnew) : 0.f;
        st[mk][nq][j] = pv; ls += pv;
      }
    S.ls[nq] = ls;
  }
#pragma unroll
  for (int s2 = 0; s2 < 2; ++s2) {
    __builtin_amdgcn_sched_barrier(0);
    bf16x8 pb[2];
#pragma unroll
    for (int nq = 0; nq < 2; ++nq) {
      uint4 u;
      u.x = pack2(st[2 * s2][nq][0], st[2 * s2][nq][1]); u.y = pack2(st[2 * s2][nq][2], st[2 * s2][nq][3]);
      u.z = pack2(st[2 * s2 + 1][nq][0], st[2 * s2 + 1][nq][1]); u.w = pack2(st[2 * s2 + 1][nq][2], st[2 * s2 + 1][nq][3]);
      pb[nq] = *(bf16x8*)&u;
    }
#pragma unroll
    for (int md = 0; md < 4; ++md) {
      const bf16x8 vf = *(const bf16x8*)(vtbase + (size_t)(md * 16 + c16) * vstride + s2 * 32 + q4 * 8);
#pragma unroll
      for (int nq = 0; nq < 2; ++nq) S.ot[md][nq] = mfma16(vf, pb[nq], S.ot[md][nq]);
    }
  }
}

__device__ __forceinline__ void attn_reset(AttnState& S) {
#pragma unroll
  for (int nq = 0; nq < 2; ++nq) { S.m[nq] = NEGV; S.ls[nq] = 0.f;
#pragma unroll
    for (int md = 0; md < 4; ++md) S.ot[md][nq] = f32x4{0.f, 0.f, 0.f, 0.f}; }
}
__device__ __forceinline__ void attn_fold(AttnState& S, float* oacc, const u16* gp, int br, float (&invl)[2], int lane) {
#pragma unroll
  for (int nq = 0; nq < 2; ++nq) {
    float l = S.ls[nq];
    l += __shfl_xor(l, 16); l += __shfl_xor(l, 32);
    const float inv = (l > 0.f) ? 1.f / l : 0.f;
    invl[nq] = inv;
    const float f = bf2f(gp[nq * 6 + br]) * inv;
#pragma unroll
    for (int md = 0; md < 4; ++md)
#pragma unroll
      for (int j = 0; j < 4; ++j) {
        float* a = oacc + ((md * 2 + nq) * 4 + j) * 64 + lane;
        const float v = f * S.ot[md][nq][j];
        if (br == 0) *a = v; else *a += v;
      }
  }
}

__device__ __forceinline__ void phase_nsa(const Params& p, char* smem, unsigned* queue) {
  u16* P1 = (u16*)(p.ws + OFF_P1);
  const u16* KC = (const u16*)(p.ws + OFF_KC); const u16* VC = (const u16*)(p.ws + OFF_VC); const u16* VT = (const u16*)(p.ws + OFF_VT);
  const int tid = tidx(), lane = tid & 63, wid = tid >> 6;
  const int c16 = lane & 15, q4 = lane >> 4, tq = lane & 7;
  float* ps = (float*)smem + wid * 2048;
  float* oacc = (float*)(smem + 32768) + wid * 2048;
  int* qslot = (int*)(smem + 65536);
#pragma unroll 1
  for (;;) {
    if (tid == 0) *qslot = (int)atomicAdd(queue, 1u);
    __syncthreads();
    const int it = *qslot;
    if (it >= 2048) break;
    const int bg = it & 15;
    const int tqd = 127 - (it >> 4);
    const int b = bg >> 1, g = bg & 1;
    const int t0 = (tqd * 4 + wid) * 8;
    const int tok0 = b * 4096 + t0;
    const int t = t0 + tq;
    const int cur = t0 >> 6;
#pragma unroll
    for (int i = 0; i < 8; ++i) *(float4*)(ps + i * 256 + lane * 4) = float4{0.f, 0.f, 0.f, 0.f};
    bf16x8 qf[2][2]; float slope[2];
    const u16* gp = P1 + (size_t)(tok0 + tq) * PS1 + 1024 + (g * 4 + (c16 >> 3)) * 3;
#pragma unroll
    for (int nq = 0; nq < 2; ++nq) {
      const int hh = nq * 2 + (c16 >> 3);
      const u16* rp = P1 + (size_t)(tok0 + tq) * PS1;
      qf[nq][0] = *(const bf16x8*)(rp + (g * 4 + hh) * 64 + q4 * 8);
      qf[nq][1] = *(const bf16x8*)(rp + (g * 4 + hh) * 64 + 32 + q4 * 8);
      slope[nq] = exp2f(-(float)(g * 4 + hh + 1));
    }
    AttnState S;
    float invl[2];
    const u16* kcb = KC + (size_t)(b * 2 + g) * 256 * 64;
    const u16* vcb = VC + (size_t)(b * 2 + g) * 64 * 256;
    int ntc = 0;
    if (t0 + 7 >= 31) ntc = (((t0 + 7 - 31) >> 4) >> 6) + 1;
    attn_reset(S);
#pragma unroll 1
    for (int kt = 0; kt < ntc; ++kt) attn_tile<0>(S, kcb + (size_t)kt * 64 * 64, 64, vcb + kt * 64, 256, kt * 64, qf, slope, t, true, c16, q4);
    attn_fold(S, oacc, gp, 0, invl, lane);
#pragma unroll 1
    for (int kt = 0; kt < ntc; ++kt) {
      f32x4 st[4][2];
      attn_scores<0>(st, kcb + (size_t)kt * 64 * 64, 64, kt * 64, qf, slope, t, true, c16, q4);
#pragma unroll
      for (int mk = 0; mk < 4; ++mk) {
        f32x4 hs;
#pragma unroll
        for (int j = 0; j < 4; ++j) {
          const float a0 = st[mk][0][j], a1 = st[mk][1][j];
          const float p0 = (a0 > -1e29f) ? __expf(a0 - S.m[0]) * invl[0] : 0.f;
          const float p1 = (a1 > -1e29f) ? __expf(a1 - S.m[1]) * invl[1] : 0.f;
          float v = p0 + p1;
          v += __shfl_xor(v, 8);
          hs[j] = v;
        }
        if (c16 < 8) *(f32x4*)(ps + c16 * 256 + kt * 64 + mk * 16 + q4 * 4) = hs;
      }
    }
    __syncthreads();
    unsigned long long selm = 0ull, un = 0ull;
#pragma unroll 1
    for (int tqq = 0; tqq < 8; ++tqq) {
      const float* pr = ps + tqq * 256;
      float imp = pr[4 * lane];
      if (lane > 0) imp += pr[4 * lane - 4] + 2.f * (pr[4 * lane - 3] + pr[4 * lane - 2] + pr[4 * lane - 1]);
      const bool forced = (lane == 0) || (lane == cur) || (lane == cur - 1);
      const bool live = lane <= cur;
      const float val = forced ? 1e4f : (live ? imp : NEGV);
      int rank = 0;
#pragma unroll 8
      for (int i = 0; i < 64; ++i) {
        const float vi = __uint_as_float(__builtin_amdgcn_readlane(__float_as_uint(val), i));
        rank += ((vi > val) || (vi == val && i < lane)) ? 1 : 0;
      }
      const unsigned long long bal = __ballot((rank < 16) && live);
      if (tq == tqq) selm = bal;
      un |= bal;
    }
    __syncthreads();
    attn_reset(S);
    {
      const u16* vtb = VT + (size_t)((0 * 8 + b) * 2 + g) * 64 * 4096;
#pragma unroll 1
      for (int j = 0; j <= cur; ++j) {
        if (!((un >> j) & 1ull)) continue;
        const bool sb = (selm >> j) & 1ull;
        attn_tile<1>(S, P1 + (size_t)(b * 4096 + j * 64) * PS1 + 768 + g * 64, PS1, vtb + j * 64, 4096, j * 64, qf, slope, t, sb, c16, q4);
      }
    }
    attn_fold(S, oacc, gp, 1, invl, lane);
    attn_reset(S);
    {
      const u16* vtb = VT + (size_t)((1 * 8 + b) * 2 + g) * 64 * 4096;
      int j0 = t0 - 511; if (j0 < 0) j0 = 0; j0 >>= 6;
#pragma unroll 1
      for (int j = j0; j <= cur; ++j)
        attn_tile<2>(S, P1 + (size_t)(b * 4096 + j * 64) * PS1 + 896 + g * 64, PS1, vtb + j * 64, 4096, j * 64, qf, slope, t, true, c16, q4);
    }
    attn_fold(S, oacc, gp, 2, invl, lane);
#pragma unroll
    for (int nq = 0; nq < 2; ++nq) {
      const int hh = nq * 2 + (c16 >> 3);
      u16* rp = P1 + (size_t)(tok0 + tq) * PS1 + (g * 4 + hh) * 64;
#pragma unroll
      for (int md = 0; md < 4; ++md) {
        const float* a = oacc + ((md * 2 + nq) * 4) * 64 + lane;
        uint2 o; o.x = pack2(a[0], a[64]); o.y = pack2(a[128], a[192]);
        *(uint2*)(rp + md * 16 + q4 * 4) = o;
      }
    }
  }
}

__device__ __forceinline__ const float* modp(const Params& p, int l, int sub, int kind) {
  return (const float*)(p.ws + OFF_MOD) + (size_t)l * 8 * 9216 + sub * 3072 + kind * 1024;
}

__device__ __forceinline__ void run_phase(const Params& p, int ph, char* smem) {
  char* ws = p.ws;
  if (ph == 0) {
    if (blockIdx.x == 0) { unsigned* c = (unsigned*)(ws + OFF_CNT); for (int e = tidx(); e < 1024; e += 256) c[e] = 0u; }
    phase_mod(p, smem);
  }
  int l = 0, s = -1;
  if (ph >= 2) { l = (ph - 2) / 15; s = (ph - 2) % 15; }
  const float* preg = p.in[4] + (size_t)l * 3 * 1024; const float* postg = p.in[5] + (size_t)l * 3 * 1024;
  const bool is_norm = (ph == 1) || s == 2 || s == 8 || s == 11 || s == 14;
  if (is_norm) {
    const float* xin = p.out; float* xout = p.out; const u16* y = nullptr; const float* pg = nullptr; const float* gate = nullptr; float wgt = 0.f;
    const float* prg = nullptr; const float* sh = nullptr; const float* sc = nullptr; u16* h = (u16*)(ws + OFF_H);
    if (ph == 1) { xin = p.in[0]; prg = p.in[4]; sh = modp(p, 0, 0, 0); sc = modp(p, 0, 0, 1); }
    else if (s == 2) { y = (const u16*)(ws + OFF_YF); pg = postg; gate = modp(p, l, 0, 2); wgt = 0.5f; prg = preg + 1024; sh = modp(p, l, 1, 0); sc = modp(p, l, 1, 1); }
    else if (s == 8) { xout = nullptr; prg = preg + 1024; sh = modp(p, l, 1, 0); sc = modp(p, l, 1, 1); h = (u16*)(ws + OFF_H2); }
    else if (s == 11) { y = (const u16*)(ws + OFF_YM); pg = postg + 1024; gate = modp(p, l, 1, 2); wgt = 1.0f; prg = preg + 2048; sh = modp(p, l, 2, 0); sc = modp(p, l, 2, 1); }
    else { y = (const u16*)(ws + OFF_YF); pg = postg + 2048; gate = modp(p, l, 2, 2); wgt = 0.5f;
      if (l == 0) { prg = p.in[4] + 3 * 1024; sh = modp(p, 1, 0, 0); sc = modp(p, 1, 0, 1); } else { h = nullptr; } }
    phase_norm(xin, xout, y, pg, gate, wgt, prg, sh, sc, h);
  }
  {
    int cl = -1, cf = 0;
    if (ph == 0) { cl = 0; cf = 0; } else if (s == 2) { cl = l; cf = 1; } else if (s == 14 && l == 0) { cl = 1; cf = 0; }
    if (cl >= 0) conv_ffn(p, cl, cf, smem);
    if (cl >= 0 && cf == 0) conv_mix(p, cl, smem);
  }
  if (s == 0 || s == 12) phase_ffn_in(p, smem);
  if (s == 1 || s == 13 || s == 10) {
    const bool o = (s == 10);
    phase_gemm_plain((const u16*)(ws + (o ? OFF_MERGED : OFF_ACT)), o ? 1024 : DFF, (const u16*)(ws + (o ? OFF_WO : OFF_WOUT)), o ? 1024 : DFF,
                     (u16*)(ws + (o ? OFF_YM : OFF_YF)), smem);
  }
  if (s == 3) phase_inproj(p, smem);
  if (s == 4) { phase_prep1(p, l); phase_sgu(p, l, smem); phase_cmp1(p, l, smem); }
  if (s == 5) { phase_prep2(p, l, smem); phase_cmp2(p, l); }
  if (s == 6) {
    const int nb = gridDim.x;
    const int sid = (nb >= 512) ? (((int)blockIdx.x & 1) ? -1 : ((int)blockIdx.x >> 1)) : (int)blockIdx.x;
    const int sstride = (nb >= 512) ? (nb >> 1) : nb;
    if (sid >= 0) for (int it = sid; it < 256; it += sstride) scan_item(p, it, smem);
    phase_nsa(p, smem, (unsigned*)(ws + OFF_CNT) + 64 + l * 64);
  }
  if (s == 7) phase_post(p, l, smem);
  if (s == 9) phase_merge(p, smem);
}

constexpr int NPHASE = 32;

#if COOP
typedef const float* __attribute__((address_space(4))) const* kargp_t;
template <int PH>
__device__ __forceinline__ void run_seq(char* smem, cg::grid_group& grid) {
  if constexpr (PH < NPHASE) {
    {
      kargp_t ka = (kargp_t)__builtin_amdgcn_kernarg_segment_ptr();
      asm volatile("" : "+s"(ka));
      Params q;
#pragma unroll
      for (int i = 0; i < 35; ++i) q.in[i] = ka[i];
      q.out = (float*)ka[35];
      q.ws = (char*)ka[36];
      run_phase(q, PH, smem);
    }
    if constexpr (PH == 0) grid.sync();
    else if constexpr (PH + 1 < NPHASE) {
      kargp_t kb = (kargp_t)__builtin_amdgcn_kernarg_segment_ptr();
      asm volatile("" : "+s"(kb));
      gbar((unsigned*)((char*)kb[36] + OFF_CNT), (unsigned)PH * gridDim.x);
    }
    run_seq<PH + 1>(smem, grid);
  }
}

__global__ void __launch_bounds__(256, 2) mega(Params p) {
  __shared__ __attribute__((aligned(16))) char smem[SMEM_BYTES];
  cg::grid_group grid = cg::this_grid();
  run_seq<0>(smem, grid);
}
#endif

template <int PH>
__global__ void __launch_bounds__(256, 2) kph(Params p) {
  __shared__ __attribute__((aligned(16))) char smem[SMEM_BYTES];
  run_phase(p, PH, smem);
}

template <int PH>
static void launch_seq(const Params& p, int grid, hipStream_t stream) {
  if constexpr (PH < NPHASE) {
    kph<PH><<<grid, 256, 0, stream>>>(p);
    launch_seq<PH + 1>(p, grid, stream);
  }
}

extern "C" void kernel_launch(void* const* d_in, const int* in_sizes, int n_in, void* d_out, int out_size, void* d_ws, size_t ws_size,
                              hipStream_t stream) {
  static int grid_blocks = 0;
  if (!grid_blocks) {
    int dev = 0, cus = 0, per_cu = 0;
    hipGetDevice(&dev);
    hipDeviceGetAttribute(&cus, hipDeviceAttributeMultiprocessorCount, dev);
    #if COOP
    hipOccupancyMaxActiveBlocksPerMultiprocessor(&per_cu, mega, 256, 0);
#else
    per_cu = 2;
#endif
    if (per_cu > 2) per_cu = 2;
    if (per_cu < 1) per_cu = 1;
    grid_blocks = cus * per_cu;
  }
  Params p{};
  for (int i = 0; i < 35; ++i) p.in[i] = (const float*)d_in[i];
  p.out = (float*)d_out;
  p.ws = (char*)d_ws;
#if COOP
  void* args[] = {&p};
  hipError_t e = hipLaunchCooperativeKernel((void*)mega, dim3(grid_blocks), dim3(256), args, 0, stream);
  if (e != hipSuccess) fprintf(stderr, "cooperative launch failed: %s (grid %d)\n", hipGetErrorString(e), grid_blocks);
#else
  launch_seq<0>(p, grid_blocks, stream);
#endif
}
```

```cpp
#include <hip/hip_runtime.h>
#include <hip/hip_cooperative_groups.h>
#include <cstdio>
#include <cstdint>
namespace cg = cooperative_groups;

#ifndef COOP
#define COOP 1
#endif

typedef unsigned short u16;
using bf16x8 = __attribute__((ext_vector_type(8))) short;
using f32x4 = __attribute__((ext_vector_type(4))) float;

constexpr int T = 32768, D = 1024, SEQ = 4096, DFF = 2816;
constexpr int PS1 = 2072, PS2 = 3328;
constexpr int MIXC = 7192, MIXN = 4120;
constexpr size_t OFF_P1 = 0;
constexpr size_t OFF_P2 = OFF_P1 + (size_t)T * PS1 * 2;
constexpr size_t OFF_H = OFF_P2 + (size_t)T * PS2 * 2;
constexpr size_t OFF_WMIX = OFF_H + (size_t)T * 1024 * 2;
constexpr size_t OFF_WG = OFF_WMIX + (size_t)4224 * 1024 * 2;
constexpr size_t OFF_WB = OFF_WG + (size_t)3072 * 1024 * 2;
constexpr size_t OFF_WO = OFF_WB + (size_t)3 * 1024 * 512 * 2;
constexpr size_t OFF_W1 = OFF_WO + (size_t)1024 * 1024 * 2;
constexpr size_t OFF_WIN = OFF_W1 + (size_t)2 * 256 * 2048 * 2;
constexpr size_t OFF_WOUT = OFF_WIN + (size_t)5632 * 1024 * 2;
constexpr size_t OFF_VFIRST = OFF_WOUT + (size_t)1024 * 2816 * 2;
constexpr size_t OFF_VT = OFF_VFIRST + (size_t)T * 512 * 2;
constexpr size_t OFF_MOD = OFF_VT + (size_t)2 * 8 * 2 * 64 * 4096 * 2;
constexpr size_t OFF_PB = OFF_MOD + (size_t)2 * 8 * 9216 * 4;
constexpr size_t OFF_HID = OFF_PB + (size_t)1024 * 1792 * 2;
constexpr size_t OFF_KC = OFF_HID + (size_t)2 * 4096 * 256 * 2;
constexpr size_t OFF_VC = OFF_KC + (size_t)8 * 2 * 256 * 64 * 2;
constexpr size_t OFF_LV = OFF_VC + (size_t)8 * 2 * 64 * 256 * 2;
constexpr size_t OFF_CNT = OFF_LV + (size_t)T * 32 * 4;
constexpr size_t WS_END = OFF_CNT + 4096;
constexpr size_t OFF_ACT = OFF_P1;
constexpr size_t OFF_YF = OFF_ACT + (size_t)T * DFF * 2;
constexpr size_t OFF_H2 = OFF_P2;
constexpr size_t OFF_MERGED = OFF_H2 + (size_t)T * 1024 * 2;
constexpr size_t OFF_YM = OFF_MERGED + (size_t)T * 1024 * 2;
constexpr size_t OFF_YC = OFF_H;

constexpr int SMEM_BYTES = 73728;

struct Params { const float* in[35]; float* out; char* ws; };

__device__ __forceinline__ int tidx() { int t = __builtin_amdgcn_workitem_id_x(); asm volatile("" : "+v"(t)); return t; }
__device__ __forceinline__ void gbar(unsigned* cnt, unsigned target) {
  asm volatile("s_waitcnt vmcnt(0) lgkmcnt(0)" ::: "memory");
  __syncthreads();
  if (tidx() == 0) {
    __builtin_amdgcn_fence(__ATOMIC_RELEASE, "agent");
    asm volatile("s_waitcnt vmcnt(0)" ::: "memory");
    __hip_atomic_fetch_add(cnt, 1u, __ATOMIC_RELAXED, __HIP_MEMORY_SCOPE_AGENT);
    while (__hip_atomic_load(cnt, __ATOMIC_RELAXED, __HIP_MEMORY_SCOPE_AGENT) < target) __builtin_amdgcn_s_sleep(1);
    __builtin_amdgcn_fence(__ATOMIC_ACQUIRE, "agent");
    asm volatile("s_waitcnt vmcnt(0)" ::: "memory");
  }
  __syncthreads();
}
__device__ __forceinline__ float dpp_sum16(float v) {
  v += __int_as_float(__builtin_amdgcn_update_dpp(0, __float_as_int(v), 0xB1, 0xF, 0xF, true));
  v += __int_as_float(__builtin_amdgcn_update_dpp(0, __float_as_int(v), 0x4E, 0xF, 0xF, true));
  v += __int_as_float(__builtin_amdgcn_update_dpp(0, __float_as_int(v), 0x141, 0xF, 0xF, true));
  v += __int_as_float(__builtin_amdgcn_update_dpp(0, __float_as_int(v), 0x140, 0xF, 0xF, true));
  return v;
}
__device__ __forceinline__ float bf2f(u16 u) { return __uint_as_float(((unsigned)u) << 16); }
__device__ __forceinline__ u16 f2bf(float f) { __bf16 r = (__bf16)f; return *(u16*)&r; }
typedef __attribute__((ext_vector_type(2))) float f2_t;
typedef __attribute__((ext_vector_type(2))) __bf16 b2_t;
__device__ __forceinline__ unsigned pack2(float a, float b) { f2_t v = {a, b}; b2_t r = __builtin_convertvector(v, b2_t); return *(unsigned*)&r; }
__device__ __forceinline__ float sigmoidf_(float x) { return 1.f / (1.f + __expf(-x)); }
__device__ __forceinline__ float siluf_(float x) { return x / (1.f + __expf(-x)); }
__device__ __forceinline__ float geluf_(float x) { float u = 0.7978845608028654f * (x + 0.044715f * x * x * x); return 0.5f * x * (1.f + tanhf(u)); }
__device__ __forceinline__ float wave_sum(float v) {
#pragma unroll
  for (int o = 32; o >= 1; o >>= 1) v += __shfl_xor(v, o);
  return v;
}
__device__ __forceinline__ f32x4 mfma16(bf16x8 a, bf16x8 b, f32x4 c) { return __builtin_amdgcn_mfma_f32_16x16x32_bf16(a, b, c, 0, 0, 0); }

__device__ __forceinline__ void conv_w(const float* src, int ld, int K, u16* dst, int NR, int nvalid, int coff, int kind, char* smem) {
  float* tl = (float*)smem;
  const int tid = tidx();
  const int ktn = K >> 6, ntile = (NR >> 6) * ktn;
  for (int tix = blockIdx.x; tix < ntile; tix += gridDim.x) {
    const int R0 = (tix / ktn) << 6, k0 = (tix % ktn) << 6;
    const int c = tid & 63, kq = tid >> 6;
    const int R = R0 + c;
    int sc; bool ok;
    if (kind == 0) { sc = coff + R; ok = R < nvalid; }
    else { int ntl = R >> 7, w = (R >> 6) & 1, n = (R >> 4) & 3, r = R & 15; sc = ((n >= 2) ? DFF : 0) + ntl * 64 + w * 32 + (n & 1) * 16 + r; ok = true; }
#pragma unroll 4
    for (int i = 0; i < 16; ++i) {
      int k = k0 + kq * 16 + i;
      tl[c * 65 + kq * 16 + i] = ok ? src[(size_t)k * ld + sc] : 0.f;
    }
    __syncthreads();
    {
      const int r = tid >> 2, ks = tid & 3;
      const float* s = tl + r * 65 + ks * 16;
      uint4 o0, o1;
      o0.x = pack2(s[0], s[1]); o0.y = pack2(s[2], s[3]); o0.z = pack2(s[4], s[5]); o0.w = pack2(s[6], s[7]);
      o1.x = pack2(s[8], s[9]); o1.y = pack2(s[10], s[11]); o1.z = pack2(s[12], s[13]); o1.w = pack2(s[14], s[15]);
      uint4* dp = (uint4*)(dst + (size_t)(R0 + r) * K + k0 + ks * 16);
      dp[0] = o0; dp[1] = o1;
    }
    __syncthreads();
  }
}

__device__ __forceinline__ void conv_ffn(const Params& p, int l, int f, char* smem) {
  conv_w(p.in[6] + (size_t)(l * 2 + f) * D * (2 * DFF), 2 * DFF, D, (u16*)(p.ws + OFF_WIN), 5632, 5632, 0, 1, smem);
  conv_w(p.in[7] + (size_t)(l * 2 + f) * DFF * D, D, DFF, (u16*)(p.ws + OFF_WOUT), 1024, 1024, 0, 0, smem);
}
__device__ __forceinline__ void conv_mix(const Params& p, int l, char* smem) {
  const float* mw = p.in[8] + (size_t)l * D * MIXC;
  conv_w(mw, MIXC, D, (u16*)(p.ws + OFF_WMIX), 4224, MIXN, 0, 0, smem);
  conv_w(mw, MIXC, D, (u16*)(p.ws + OFF_WG), 3072, 3072, MIXN, 0, smem);
  for (int i = 0; i < 3; ++i)
    conv_w(p.in[9] + (size_t)(l * 3 + i) * 512 * D, D, 512, (u16*)(p.ws + OFF_WB) + (size_t)i * 1024 * 512, 1024, 1024, 0, 0, smem);
  conv_w(p.in[10] + (size_t)l * D * D, D, D, (u16*)(p.ws + OFF_WO), 1024, 1024, 0, 0, smem);
  conv_w(p.in[11] + (size_t)l * 2048 * 256, 256, 2048, (u16*)(p.ws + OFF_W1), 256, 256, 0, 0, smem);
  conv_w(p.in[14] + (size_t)l * 2048 * 256, 256, 2048, (u16*)(p.ws + OFF_W1) + (size_t)256 * 2048, 256, 256, 0, 0, smem);
}

__device__ __forceinline__ void phase_mod(const Params& p, char* smem) {
  float* cond = (float*)smem;
  float* red = cond + 8192;
  const int tid = tidx();
  float* MOD = (float*)(p.ws + OFF_MOD);
  for (int item = blockIdx.x; item < 288; item += gridDim.x) {
    for (int e = tid; e < 8192; e += 256) cond[e] = siluf_(p.in[1][e]);
    __syncthreads();
    const int l = item / 144, n0 = (item % 144) * 64, col = n0 + (tid & 63), kq = tid >> 6;
    float acc[8];
#pragma unroll
    for (int b = 0; b < 8; ++b) acc[b] = 0.f;
    const float* w = p.in[2] + (size_t)l * D * 9216 + col;
#pragma unroll 4
    for (int k = kq * 256; k < kq * 256 + 256; ++k) {
      float wv = w[(size_t)k * 9216];
#pragma unroll
      for (int b = 0; b < 8; ++b) acc[b] += cond[b * 1024 + k] * wv;
    }
#pragma unroll
    for (int b = 0; b < 8; ++b) red[(kq * 8 + b) * 64 + (tid & 63)] = acc[b];
    __syncthreads();
    for (int e = tid; e < 512; e += 256) {
      int b = e >> 6, c = e & 63;
      float s = red[(0 * 8 + b) * 64 + c] + red[(1 * 8 + b) * 64 + c] + red[(2 * 8 + b) * 64 + c] + red[(3 * 8 + b) * 64 + c];
      MOD[(size_t)(l * 8 + b) * 9216 + n0 + c] = s + p.in[3][(size_t)l * 9216 + n0 + c];
    }
    __syncthreads();
  }
}

__device__ __forceinline__ void phase_norm(const float* xin, float* xout, const u16* y, const float* postg, const float* gate, float wgt,
                           const float* preg, const float* shift, const float* scale, u16* h) {
  const int lane = tidx() & 63, wid = tidx() >> 6;
  for (int row = blockIdx.x * 4 + wid; row < T; row += gridDim.x * 4) {
    const int b = row >> 12;
    float4 xv[4];
#pragma unroll
    for (int i = 0; i < 4; ++i) xv[i] = *(const float4*)(xin + (size_t)row * D + i * 256 + lane * 4);
    if (y) {
      float yv[4][4]; float ss = 0.f;
#pragma unroll
      for (int i = 0; i < 4; ++i) {
        uint2 u = *(const uint2*)(y + (size_t)row * D + i * 256 + lane * 4);
        yv[i][0] = bf2f((u16)(u.x & 0xffff)); yv[i][1] = bf2f((u16)(u.x >> 16));
        yv[i][2] = bf2f((u16)(u.y & 0xffff)); yv[i][3] = bf2f((u16)(u.y >> 16));
        ss += yv[i][0] * yv[i][0] + yv[i][1] * yv[i][1] + yv[i][2] * yv[i][2] + yv[i][3] * yv[i][3];
      }
      ss = wave_sum(ss);
      const float rs = rsqrtf(ss * (1.f / 1024.f) + 1e-6f) * wgt;
#pragma unroll
      for (int i = 0; i < 4; ++i) {
        const int c = i * 256 + lane * 4;
        float4 g = *(const float4*)(gate + (size_t)b * 9216 + c);
        float4 pg = *(const float4*)(postg + c);
        xv[i].x += g.x * yv[i][0] * rs * pg.x; xv[i].y += g.y * yv[i][1] * rs * pg.y;
        xv[i].z += g.z * yv[i][2] * rs * pg.z; xv[i].w += g.w * yv[i][3] * rs * pg.w;
      }
    }
    if (xout) {
#pragma unroll
      for (int i = 0; i < 4; ++i) *(float4*)(xout + (size_t)row * D + i * 256 + lane * 4) = xv[i];
    }
    if (h) {
      float ss = 0.f;
#pragma unroll
      for (int i = 0; i < 4; ++i) ss += xv[i].x * xv[i].x + xv[i].y * xv[i].y + xv[i].z * xv[i].z + xv[i].w * xv[i].w;
      ss = wave_sum(ss);
      const float rs = rsqrtf(ss * (1.f / 1024.f) + 1e-6f);
#pragma unroll
      for (int i = 0; i < 4; ++i) {
        const int c = i * 256 + lane * 4;
        float4 pg = *(const float4*)(preg + c);
        float4 sh = *(const float4*)(shift + (size_t)b * 9216 + c);
        float4 sc = *(const float4*)(scale + (size_t)b * 9216 + c);
        uint2 o;
        o.x = pack2(xv[i].x * rs * pg.x * (1.f + sc.x) + sh.x, xv[i].y * rs * pg.y * (1.f + sc.y) + sh.y);
        o.y = pack2(xv[i].z * rs * pg.z * (1.f + sc.z) + sh.z, xv[i].w * rs * pg.w * (1.f + sc.w) + sh.w);
        *(uint2*)(h + (size_t)row * D + c) = o;
      }
    }
  }
}

template <int NS, class FA, class FB>
__device__ __forceinline__ void gemm_loop(f32x4 (&acc)[4][NS], const FA& fa, const FB& fb, int K, u16* sm) {
  constexpr int BN = 32 * NS;
  constexpr int NBV = BN / 32;
  const int tid = tidx(), lane = tid & 63, wid = tid >> 6, wr = wid >> 1, wc = wid & 1, fr = lane & 15, fq = lane >> 4;
  u16* As = sm; u16* Bs = sm + 2 * 128 * 64;
  uint4 ra0[4], rb0[NBV], ra1[4], rb1[NBV];
  const int nt = K >> 6;
  const int lrow = tid >> 3, lk = (tid & 7) * 8;
  const int lsw = lrow * 64 + (((tid & 7) ^ ((lrow >> 1) & 7)) << 3);
  const int c0 = (fq ^ ((fr >> 1) & 7)) << 3, c1 = c0 ^ 32;
#define G_LOAD(RA, RB, KT) { const int kb_ = (KT) << 6; \
    _Pragma("unroll") for (int i = 0; i < 4; ++i) RA[i] = fa(lrow + 32 * i, kb_ + lk); \
    _Pragma("unroll") for (int i = 0; i < NBV; ++i) RB[i] = fb(lrow + 32 * i, kb_ + lk); }
#define G_STORE(RA, RB, BUF) { u16* Aw_ = As + (BUF) * 128 * 64 + lsw; u16* Bw_ = Bs + (BUF) * BN * 64 + lsw; \
    _Pragma("unroll") for (int i = 0; i < 4; ++i) *(uint4*)(Aw_ + i * 32 * 64) = RA[i]; \
    _Pragma("unroll") for (int i = 0; i < NBV; ++i) *(uint4*)(Bw_ + i * 32 * 64) = RB[i]; }
#define G_COMPUTE(BUF) { const u16* Ab = As + (BUF) * 128 * 64 + (wr * 64 + fr) * 64; \
    const u16* Bb = Bs + (BUF) * BN * 64 + (wc * 16 * NS + fr) * 64; \
    _Pragma("unroll") for (int ks = 0; ks < 2; ++ks) { bf16x8 a[4], b[NS]; const int co = ks ? c1 : c0; \
      _Pragma("unroll") for (int m = 0; m < 4; ++m) a[m] = *(const bf16x8*)(Ab + m * 16 * 64 + co); \
      _Pragma("unroll") for (int n = 0; n < NS; ++n) b[n] = *(const bf16x8*)(Bb + n * 16 * 64 + co); \
      _Pragma("unroll") for (int m = 0; m < 4; ++m) _Pragma("unroll") for (int n = 0; n < NS; ++n) acc[m][n] = mfma16(a[m], b[n], acc[m][n]); } }
  G_LOAD(ra0, rb0, 0)
  if (nt > 1) G_LOAD(ra1, rb1, 1)
  G_STORE(ra0, rb0, 0)
  __syncthreads();
#pragma unroll 1
  for (int kt = 0; kt < nt; kt += 2) {
    if (kt + 2 < nt) G_LOAD(ra0, rb0, kt + 2)
    G_COMPUTE(0)
    if (kt + 1 < nt) G_STORE(ra1, rb1, 1)
    __syncthreads();
    if (kt + 1 >= nt) break;
    if (kt + 3 < nt) G_LOAD(ra1, rb1, kt + 3)
    G_COMPUTE(1)
    if (kt + 2 < nt) G_STORE(ra0, rb0, 0)
    __syncthreads();
  }
#undef G_LOAD
#undef G_STORE
#undef G_COMPUTE
}

__device__ __forceinline__ bool tile_map(int it, int NT, int& mt, int& nt) {
  const int g = gridDim.x;
  if ((g & 7) == 0) {
    const int xcd = blockIdx.x & 7, bx = blockIdx.x >> 3, nbx = g >> 3;
    const int lid = bx + it * nbx;
    if (lid >= 32 * NT) return false;
    const int grp = lid / (8 * NT), rem = lid - grp * 8 * NT;
    nt = rem >> 3; mt = xcd * 32 + grp * 8 + (rem & 7);
    return true;
  } else {
    const int id = blockIdx.x + it * g;
    if (id >= 256 * NT) return false;
    nt = id % NT; mt = id / NT;
    return true;
  }
}

#define ZERO_ACC(acc, NSV) _Pragma("unroll") for (int m_ = 0; m_ < 4; ++m_) _Pragma("unroll") for (int n_ = 0; n_ < NSV; ++n_) acc[m_][n_] = f32x4{0.f, 0.f, 0.f, 0.f};

__device__ __forceinline__ void phase_ffn_in(const Params& p, char* smem) {
  const u16* H = (const u16*)(p.ws + OFF_H); const u16* W = (const u16*)(p.ws + OFF_WIN); u16* ACT = (u16*)(p.ws + OFF_ACT);
  const int lane = tidx() & 63, wid = tidx() >> 6, wr = wid >> 1, wc = wid & 1, fr = lane & 15, fq = lane >> 4;
  int mt, nt;
  for (int it = 0; tile_map(it, 44, mt, nt); ++it) {
    const int m0 = mt * 128, n0 = nt * 128;
    f32x4 acc[4][4]; ZERO_ACC(acc, 4)
    const char* Ab_ = (const char*)(H + (size_t)m0 * 1024); const char* Bb_ = (const char*)(W + (size_t)n0 * 1024);
    auto fa = [&](int r, int k) { return *(const uint4*)(Ab_ + (unsigned)((r * 1024 + k) * 2)); };
    auto fb = [&](int r, int k) { return *(const uint4*)(Bb_ + (unsigned)((r * 1024 + k) * 2)); };
    gemm_loop<4>(acc, fa, fb, 1024, (u16*)smem);
#pragma unroll
    for (int m = 0; m < 4; ++m)
#pragma unroll
      for (int n = 0; n < 2; ++n) {
        const int col = nt * 64 + wc * 32 + n * 16 + fr;
        const int r0 = m0 + wr * 64 + m * 16 + fq * 4;
#pragma unroll
        for (int j = 0; j < 4; ++j) ACT[(size_t)(r0 + j) * DFF + col] = f2bf(siluf_(acc[m][n][j]) * acc[m][n + 2][j]);
      }
  }
}

__device__ __forceinline__ void phase_gemm_plain(const u16* A, int lda, const u16* Bt, int K, u16* C, char* smem) {
  const int lane = tidx() & 63, wid = tidx() >> 6, wr = wid >> 1, wc = wid & 1, fr = lane & 15, fq = lane >> 4;
  int mt, nt;
  for (int it = 0; tile_map(it, 8, mt, nt); ++it) {
    const int m0 = mt * 128, n0 = nt * 128;
    f32x4 acc[4][4]; ZERO_ACC(acc, 4)
    const char* Ab_ = (const char*)(A + (size_t)m0 * lda); const char* Bb_ = (const char*)(Bt + (size_t)n0 * K);
    auto fa = [&](int r, int k) { return *(const uint4*)(Ab_ + (unsigned)((r * lda + k) * 2)); };
    auto fb = [&](int r, int k) { return *(const uint4*)(Bb_ + (unsigned)((r * K + k) * 2)); };
    gemm_loop<4>(acc, fa, fb, K, (u16*)smem);
#pragma unroll
    for (int m = 0; m < 4; ++m)
#pragma unroll
      for (int n = 0; n < 4; ++n) {
        const int col = n0 + wc * 64 + n * 16 + fr;
        const int r0 = m0 + wr * 64 + m * 16 + fq * 4;
#pragma unroll
        for (int j = 0; j < 4; ++j) C[(size_t)(r0 + j) * 1024 + col] = f2bf(acc[m][n][j]);
      }
  }
}

__device__ __forceinline__ void phase_inproj(const Params& p, char* smem) {
  const u16* H = (const u16*)(p.ws + OFF_H); const u16* W = (const u16*)(p.ws + OFF_WMIX);
  u16* P1 = (u16*)(p.ws + OFF_P1); u16* P2 = (u16*)(p.ws + OFF_P2); u16* VT = (u16*)(p.ws + OFF_VT); u16* PB = (u16*)(p.ws + OFF_PB);
  const int lane = tidx() & 63, wid = tidx() >> 6, wr = wid >> 1, wc = wid & 1, fr = lane & 15, fq = lane >> 4;
  int mt, nt;
  for (int it = 0; tile_map(it, 33, mt, nt); ++it) {
    const int m0 = mt * 128, n0 = nt * 128;
    f32x4 acc[4][4]; ZERO_ACC(acc, 4)
    const char* Ab_ = (const char*)(H + (size_t)m0 * 1024); const char* Bb_ = (const char*)(W + (size_t)n0 * 1024);
    auto fa = [&](int r, int k) { return *(const uint4*)(Ab_ + (unsigned)((r * 1024 + k) * 2)); };
    auto fb = [&](int r, int k) { return *(const uint4*)(Bb_ + (unsigned)((r * 1024 + k) * 2)); };
    gemm_loop<4>(acc, fa, fb, 1024, (u16*)smem);
#pragma unroll
    for (int m = 0; m < 4; ++m)
#pragma unroll
      for (int nn = 0; nn < 4; ++nn) {
        const int n = n0 + wc * 64 + nn * 16 + fr;
        if (n >= MIXN) continue;
        const int r0 = m0 + wr * 64 + m * 16 + fq * 4;
        f32x4 v = acc[m][nn];
        if ((n >= 896 && n < 1024) || (n >= 1152 && n < 1280)) {
          const int which = (n >= 1152) ? 1 : 0;
          const int gd = n - (which ? 1152 : 896);
          const int b = r0 >> 12, t = r0 & 4095;
          uint2 o; o.x = pack2(v[0], v[1]); o.y = pack2(v[2], v[3]);
          *(uint2*)(VT + ((size_t)((which * 8 + b) * 128 + gd)) * 4096 + (t & ~31) + 8 * fq + 4 * (m & 1)) = o;
        } else if (n < 1304) {
          const int pc = (n < 896) ? n : ((n < 1152) ? n - 128 : n - 256);
          if (n < 512) { v[0] *= 0.125f; v[1] *= 0.125f; v[2] *= 0.125f; v[3] *= 0.125f; }
          if (n >= 1280) { v[0] = sigmoidf_(v[0]); v[1] = sigmoidf_(v[1]); v[2] = sigmoidf_(v[2]); v[3] = sigmoidf_(v[3]); }
#pragma unroll
          for (int j = 0; j < 4; ++j) P1[(size_t)(r0 + j) * PS1 + pc] = f2bf(v[j]);
        } else if (n < 2328) {
#pragma unroll
          for (int j = 0; j < 4; ++j) P1[(size_t)(r0 + j) * PS1 + (n - 256)] = f2bf(geluf_(v[j]));
        } else {
          const int pc = n - 2328;
#pragma unroll
          for (int j = 0; j < 4; ++j) P2[(size_t)(r0 + j) * PS2 + pc] = f2bf(v[j]);
          if ((m & 1) && fq == 3) PB[(size_t)((r0 + 3) >> 5) * 1792 + pc] = f2bf(v[3]);
        }
      }
  }
}

__device__ __forceinline__ void phase_merge(const Params& p, char* smem) {
  const u16* H2 = (const u16*)(p.ws + OFF_H2); const u16* WG = (const u16*)(p.ws + OFF_WG); const u16* WB = (const u16*)(p.ws + OFF_WB);
  const u16* P1 = (const u16*)(p.ws + OFF_P1); const u16* YC = (const u16*)(p.ws + OFF_YC); u16* MG = (u16*)(p.ws + OFF_MERGED);
  const int lane = tidx() & 63, wid = tidx() >> 6, wr = wid >> 1, wc = wid & 1, fr = lane & 15, fq = lane >> 4;
  int mt, nt;
  for (int it = 0; tile_map(it, 16, mt, nt); ++it) {
    const int m0 = mt * 128, n0 = nt * 64;
    f32x4 tot[4][2]; ZERO_ACC(tot, 2)
#pragma unroll 1
    for (int i = 0; i < 3; ++i) {
      unsigned gpk[4][2][2];
      {
        f32x4 ag[4][2]; ZERO_ACC(ag, 2)
        const char* Ab2_ = (const char*)(H2 + (size_t)m0 * 1024); const char* Bb2_ = (const char*)(WG + (size_t)(i * 1024 + n0) * 1024);
        auto fa2 = [&](int r, int k) { return *(const uint4*)(Ab2_ + (unsigned)((r * 1024 + k) * 2)); };
        auto fb2 = [&](int r, int k) { return *(const uint4*)(Bb2_ + (unsigned)((r * 1024 + k) * 2)); };
        gemm_loop<2>(ag, fa2, fb2, 1024, (u16*)smem);
#pragma unroll
        for (int m = 0; m < 4; ++m)
#pragma unroll
          for (int n = 0; n < 2; ++n) {
            gpk[m][n][0] = pack2(sigmoidf_(ag[m][n][0]), sigmoidf_(ag[m][n][1]));
            gpk[m][n][1] = pack2(sigmoidf_(ag[m][n][2]), sigmoidf_(ag[m][n][3]));
          }
      }
      f32x4 ay[4][2]; ZERO_ACC(ay, 2)
      const u16* ya = (i == 0) ? P1 : ((i == 1) ? P1 + 1048 : YC);
      const int lda = (i == 2) ? 512 : PS1;
      const u16* wb = WB + (size_t)i * 1024 * 512;
      const char* Ab_ = (const char*)(ya + (size_t)m0 * lda); const char* Bb_ = (const char*)(wb + (size_t)n0 * 512);
      auto fa = [&](int r, int k) { return *(const uint4*)(Ab_ + (unsigned)((r * lda + k) * 2)); };
      auto fb = [&](int r, int k) { return *(const uint4*)(Bb_ + (unsigned)((r * 512 + k) * 2)); };
      gemm_loop<2>(ay, fa, fb, 512, (u16*)smem);
#pragma unroll
      for (int m = 0; m < 4; ++m)
#pragma unroll
        for (int n = 0; n < 2; ++n) {
          tot[m][n][0] += bf2f((u16)(gpk[m][n][0] & 0xffff)) * ay[m][n][0];
          tot[m][n][1] += bf2f((u16)(gpk[m][n][0] >> 16)) * ay[m][n][1];
          tot[m][n][2] += bf2f((u16)(gpk[m][n][1] & 0xffff)) * ay[m][n][2];
          tot[m][n][3] += bf2f((u16)(gpk[m][n][1] >> 16)) * ay[m][n][3];
        }
    }
#pragma unroll
    for (int m = 0; m < 4; ++m)
#pragma unroll
      for (int n = 0; n < 2; ++n) {
        const int col = n0 + wc * 32 + n * 16 + fr;
        const int r0 = m0 + wr * 64 + m * 16 + fq * 4;
#pragma unroll
        for (int j = 0; j < 4; ++j) MG[(size_t)(r0 + j) * 1024 + col] = f2bf(tot[m][n][j]);
      }
  }
}

__device__ __forceinline__ void phase_cmp1(const Params& p, int l, char* smem) {
  const u16* P1 = (const u16*)(p.ws + OFF_P1); const u16* W1 = (const u16*)(p.ws + OFF_W1); u16* HID = (u16*)(p.ws + OFF_HID);
  const int lane = tidx() & 63, wid = tidx() >> 6, wr = wid >> 1, wc = wid & 1, fr = lane & 15, fq = lane >> 4;
  for (int tix = blockIdx.x; tix < 128; tix += gridDim.x) {
    const int which = tix >> 6, mt = (tix >> 1) & 31, nt = tix & 1;
    const int m0 = mt * 128, n0 = nt * 128;
    const float* pe = (which ? p.in[16] : p.in[13]) + (size_t)l * 2048;
    const u16* w1 = W1 + (size_t)which * 256 * 2048;
    const int cbase = 512 + which * 128;
    f32x4 acc[4][4]; ZERO_ACC(acc, 4)
    auto fa = [&](int r, int k) {
      const int row = m0 + r; const int g = row & 1, n = (row >> 1) & 255, b = row >> 9;
      uint4 o = make_uint4(0, 0, 0, 0);
      if (n < 255) {
        const int lpos = k >> 6, d = k & 63;
        uint4 raw = *(const uint4*)(P1 + (size_t)(b * 4096 + 16 * n + lpos) * PS1 + cbase + g * 64 + d);
        const float* pp = pe + lpos * 64 + d;
        float4 e0 = *(const float4*)pp, e1 = *(const float4*)(pp + 4);
        o.x = pack2(bf2f((u16)(raw.x & 0xffff)) + e0.x, bf2f((u16)(raw.x >> 16)) + e0.y);
        o.y = pack2(bf2f((u16)(raw.y & 0xffff)) + e0.z, bf2f((u16)(raw.y >> 16)) + e0.w);
        o.z = pack2(bf2f((u16)(raw.z & 0xffff)) + e1.x, bf2f((u16)(raw.z >> 16)) + e1.y);
        o.w = pack2(bf2f((u16)(raw.w & 0xffff)) + e1.z, bf2f((u16)(raw.w >> 16)) + e1.w);
      }
      return o;
    };
    auto fb = [&](int r, int k) { return *(const uint4*)(w1 + (size_t)(n0 + r) * 2048 + k); };
    gemm_loop<4>(acc, fa, fb, 2048, (u16*)smem);
#pragma unroll
    for (int m = 0; m < 4; ++m)
#pragma unroll
      for (int n = 0; n < 4; ++n) {
        const int col = n0 + wc * 64 + n * 16 + fr;
        const int r0 = m0 + wr * 64 + m * 16 + fq * 4;
#pragma unroll
        for (int j = 0; j < 4; ++j) HID[((size_t)which * 4096 + r0 + j) * 256 + col] = f2bf(siluf_(acc[m][n][j]));
      }
  }
}

__device__ __forceinline__ void phase_cmp2(const Params& p, int l) {
  const u16* HID = (const u16*)(p.ws + OFF_HID); u16* KC = (u16*)(p.ws + OFF_KC); u16* VC = (u16*)(p.ws + OFF_VC);
  const int total = 2 * 4096 * 64;
  for (int idx = blockIdx.x * 256 + tidx(); idx < total; idx += gridDim.x * 256) {
    const int d = idx & 63, row = (idx >> 6) & 4095, which = idx >> 18;
    const float* w2 = (which ? p.in[15] : p.in[12]) + (size_t)l * 256 * 64;
    const u16* hr = HID + ((size_t)which * 4096 + row) * 256;
    float acc = 0.f;
#pragma unroll 8
    for (int j = 0; j < 256; ++j) acc += bf2f(hr[j]) * w2[j * 64 + d];
    const int g = row & 1, n = (row >> 1) & 255, b = row >> 9;
    if (which == 0) KC[((size_t)(b * 2 + g) * 256 + n) * 64 + d] = f2bf(acc);
    else {
      const int u = n & 31; const int pp = 8 * ((u >> 2) & 3) + 4 * (u >> 4) + (u & 3);
      VC[((size_t)(b * 2 + g) * 64 + d) * 256 + (n & ~31) + pp] = f2bf(acc);
    }
  }
}

__device__ __forceinline__ void phase_sgu(const Params& p, int l, char* smem) {
  u16* P1 = (u16*)(p.ws + OFF_P1);
  u16* Wt = (u16*)smem;
  u16* Vt = Wt + 128 * 136;
  float* st = (float*)(Vt + 128 * 136);
  const int tid = tidx(), lane = tid & 63, wid = tid >> 6, wr = wid >> 1, wc = wid & 1, fr = lane & 15, fq = lane >> 4;
  const float* lng = p.in[17] + (size_t)l * 512; const float* lnb = p.in[18] + (size_t)l * 512;
  for (int item = blockIdx.x; item < 1024; item += gridDim.x) {
    const int ci = item >> 2, gi = item & 3;
    const int tok0 = ci * 128;
#pragma unroll 1
    for (int r0 = wid * 32; r0 < wid * 32 + 32; r0 += 8) {
      uint4 raw[8];
#pragma unroll
      for (int u = 0; u < 8; ++u) raw[u] = *(const uint4*)(P1 + (size_t)(tok0 + r0 + u) * PS1 + 1560 + lane * 8);
#pragma unroll
      for (int u = 0; u < 8; ++u) {
        float f[8];
        f[0] = bf2f((u16)(raw[u].x & 0xffff)); f[1] = bf2f((u16)(raw[u].x >> 16)); f[2] = bf2f((u16)(raw[u].y & 0xffff)); f[3] = bf2f((u16)(raw[u].y >> 16));
        f[4] = bf2f((u16)(raw[u].z & 0xffff)); f[5] = bf2f((u16)(raw[u].z >> 16)); f[6] = bf2f((u16)(raw[u].w & 0xffff)); f[7] = bf2f((u16)(raw[u].w >> 16));
        float s = 0.f, s2 = 0.f;
#pragma unroll
        for (int e = 0; e < 8; ++e) { s += f[e]; }
        s = wave_sum(s);
        const float mu = s * (1.f / 512.f);
#pragma unroll
        for (int e = 0; e < 8; ++e) { float dlt = f[e] - mu; s2 += dlt * dlt; }
        s2 = wave_sum(s2);
        if (lane == 0) { st[(r0 + u) * 2] = mu; st[(r0 + u) * 2 + 1] = rsqrtf(s2 * (1.f / 512.f) + 1e-5f); }
      }
    }
    const float* wsrc = p.in[19] + ((size_t)(l * 4 + gi)) * 128 * 128;
    for (int e = tid; e < 128 * 32; e += 256) {
      const int t = e >> 5, s4 = (e & 31) * 4;
      float4 w = *(const float4*)(wsrc + t * 128 + s4);
      uint2 o;
      o.x = pack2(s4 + 0 <= t ? w.x : 0.f, s4 + 1 <= t ? w.y : 0.f);
      o.y = pack2(s4 + 2 <= t ? w.z : 0.f, s4 + 3 <= t ? w.w : 0.f);
      *(uint2*)(Wt + t * 136 + s4) = o;
    }
    __syncthreads();
    for (int e = tid; e < 128 * 16; e += 256) {
      const int s = e >> 4, c8 = (e & 15) * 8;
      uint4 raw = *(const uint4*)(P1 + (size_t)(tok0 + s) * PS1 + 1560 + gi * 128 + c8);
      const float mu = st[s * 2], rs = st[s * 2 + 1];
      u16 rv[8] = {(u16)(raw.x & 0xffff), (u16)(raw.x >> 16), (u16)(raw.y & 0xffff), (u16)(raw.y >> 16), (u16)(raw.z & 0xffff), (u16)(raw.z >> 16), (u16)(raw.w & 0xffff), (u16)(raw.w >> 16)};
#pragma unroll
      for (int i = 0; i < 8; ++i) {
        const int c = gi * 128 + c8 + i;
        Vt[(c8 + i) * 136 + s] = f2bf((bf2f(rv[i]) - mu) * rs * lng[c] + lnb[c]);
      }
    }
    __syncthreads();
    f32x4 acc[4][4]; ZERO_ACC(acc, 4)
#pragma unroll 1
    for (int ks = 0; ks < 4; ++ks) {
      bf16x8 a[4], b[4];
#pragma unroll
      for (int m = 0; m < 4; ++m) a[m] = *(const bf16x8*)(Wt + (wr * 64 + m * 16 + fr) * 136 + ks * 32 + fq * 8);
#pragma unroll
      for (int n = 0; n < 4; ++n) b[n] = *(const bf16x8*)(Vt + (wc * 64 + n * 16 + fr) * 136 + ks * 32 + fq * 8);
#pragma unroll
      for (int m = 0; m < 4; ++m)
#pragma unroll
        for (int n = 0; n < 4; ++n) acc[m][n] = mfma16(a[m], b[n], acc[m][n]);
    }
    const float* bs = p.in[20] + ((size_t)(l * 4 + gi)) * 128;
#pragma unroll
    for (int m = 0; m < 4; ++m)
#pragma unroll
      for (int n = 0; n < 4; ++n) {
        const int c = wc * 64 + n * 16 + fr;
#pragma unroll
        for (int j = 0; j < 4; ++j) {
          const int t = wr * 64 + m * 16 + fq * 4 + j;
          u16* up = P1 + (size_t)(tok0 + t) * PS1 + 1048 + gi * 128 + c;
          *up = f2bf(bf2f(*up) * (acc[m][n][j] + bs[t]));
        }
      }
    __syncthreads();
  }
}

__device__ __forceinline__ void phase_prep1(const Params& p, int l) {
  u16* P2 = (u16*)(p.ws + OFF_P2); const u16* PB = (const u16*)(p.ws + OFF_PB); u16* VF = (u16*)(p.ws + OFF_VFIRST);
  const float* mu = p.in[21] + (size_t)l * 1792;
  const int total = 1024 * 224;
  for (int idx = blockIdx.x * 256 + tidx(); idx < total; idx += gridDim.x * 256) {
    const int tile = idx / 224, cg8 = (idx % 224) * 8;
    const int tok0 = tile * 32;
    float m8[8];
#pragma unroll
    for (int e = 0; e < 8; ++e) m8[e] = mu[cg8 + e];
    uint4 prev = make_uint4(0, 0, 0, 0);
    if ((tok0 & 4095) != 0) prev = *(const uint4*)(PB + (size_t)(tile - 1) * 1792 + cg8);
    for (int r = 0; r < 32; ++r) {
      u16* ptr = P2 + (size_t)(tok0 + r) * PS2 + cg8;
      uint4 cur = *(const uint4*)ptr;
      unsigned cu[4] = {cur.x, cur.y, cur.z, cur.w}, pu[4] = {prev.x, prev.y, prev.z, prev.w};
      float o[8];
#pragma unroll
      for (int e = 0; e < 8; ++e) {
        float c = bf2f((u16)((cu[e >> 1] >> ((e & 1) * 16)) & 0xffff));
        float pv = bf2f((u16)((pu[e >> 1] >> ((e & 1) * 16)) & 0xffff));
        float s = c + (pv - c) * m8[e];
        if (cg8 >= 1536 && cg8 < 1600) s = tanhf(s);
        else if (cg8 >= 1664) s = sigmoidf_(s);
        o[e] = s;
      }
      uint4 ov; ov.x = pack2(o[0], o[1]); ov.y = pack2(o[2], o[3]); ov.z = pack2(o[4], o[5]); ov.w = pack2(o[6], o[7]);
      *(uint4*)ptr = ov;
      if (l == 0 && cg8 >= 1024 && cg8 < 1536) *(uint4*)(VF + (size_t)(tok0 + r) * 512 + cg8 - 1024) = ov;
      prev = cur;
    }
  }
}

__device__ __forceinline__ void phase_prep2(const Params& p, int l, char* smem) {
  u16* P2 = (u16*)(p.ws + OFF_P2); const u16* VF = (const u16*)(p.ws + OFF_VFIRST);
  float* twd = (float*)smem;
  float* adl = twd + 1024;
  float* vsh = adl + 1024;
  float* lv = vsh + 8192;
  const int tid = tidx();
  const float* w0 = p.in[22] + (size_t)l * 512; const float* w2 = p.in[23] + (size_t)l * 64 * 512;
  const float* a0 = p.in[24] + (size_t)l * 512; const float* a2 = p.in[25] + (size_t)l * 64 * 512;
  const float* kkp = p.in[27] + (size_t)l * 512; const float* kap = p.in[28] + (size_t)l * 512;
  for (int item = blockIdx.x; item < 2048; item += gridDim.x) {
    const int tok0 = item * 16;
    for (int e = tid; e < 2048; e += 256) {
      const int r = e >> 7, c = e & 127;
      twd[(c >> 6) * 1024 + r * 64 + (c & 63)] = bf2f(P2[(size_t)(tok0 + r) * PS2 + 1536 + c]);
    }
    if (l > 0) {
      for (int e = tid; e < 8192; e += 256) { const int r = e >> 9, c = e & 511; vsh[e] = bf2f(P2[(size_t)(tok0 + r) * PS2 + 1024 + c]); }
    }
    __syncthreads();
    if (l > 0) {
      const float* v1 = p.in[33];
      for (int e = tid; e < 512; e += 256) {
        const int r = e >> 5, j = e & 31;
        float s = 0.f;
#pragma unroll 2
        for (int c = 0; c < 512; c += 4) {
          const float4 t4 = *(const float4*)(vsh + r * 512 + c);
          s += t4.x * v1[c * 32 + j] + t4.y * v1[(c + 1) * 32 + j] + t4.z * v1[(c + 2) * 32 + j] + t4.w * v1[(c + 3) * 32 + j];
        }
        lv[r * 32 + j] = s;
      }
      __syncthreads();
    }
#pragma unroll 1
    for (int hc = 0; hc < 2; ++hc) {
      const int ch = tid + hc * 256;
      float aw[16], aa[16];
#pragma unroll
      for (int r = 0; r < 16; ++r) { aw[r] = 0.f; aa[r] = 0.f; }
#pragma unroll 4
      for (int i = 0; i < 64; i += 4) {
        const float w20 = w2[i * 512 + ch], w21 = w2[(i + 1) * 512 + ch], w22 = w2[(i + 2) * 512 + ch], w23 = w2[(i + 3) * 512 + ch];
        const float a20 = a2[i * 512 + ch], a21 = a2[(i + 1) * 512 + ch], a22 = a2[(i + 2) * 512 + ch], a23 = a2[(i + 3) * 512 + ch];
#pragma unroll
        for (int r = 0; r < 16; ++r) {
          const float4 tw = *(const float4*)(twd + r * 64 + i);
          const float4 ta = *(const float4*)(adl + r * 64 + i);
          aw[r] += tw.x * w20 + tw.y * w21 + tw.z * w22 + tw.w * w23;
          aa[r] += ta.x * a20 + ta.y * a21 + ta.z * a22 + ta.w * a23;
        }
      }
      float am[16];
      if (l > 0) {
        const float* v2 = p.in[34];
#pragma unroll
        for (int r = 0; r < 16; ++r) am[r] = 0.f;
#pragma unroll 4
        for (int j = 0; j < 32; j += 4) {
          const float v20 = v2[j * 512 + ch], v21 = v2[(j + 1) * 512 + ch], v22 = v2[(j + 2) * 512 + ch], v23 = v2[(j + 3) * 512 + ch];
#pragma unroll
          for (int r = 0; r < 16; ++r) {
            const float4 t4 = *(const float4*)(lv + r * 32 + j);
            am[r] += t4.x * v20 + t4.y * v21 + t4.z * v22 + t4.w * v23;
          }
        }
      }
      const float w0v = w0[ch], a0v = a0[ch], kkv = kkp[ch], kav = kap[ch];
      const float v0v = (l > 0) ? p.in[32][ch] : 0.f;
#pragma unroll
      for (int r = 0; r < 16; ++r) {
        u16* row = P2 + (size_t)(tok0 + r) * PS2;
        const float kval = bf2f(row[512 + ch]);
        const float wpre = w0v + aw[r];
        const float nx = -wpre;
        const float sp = fmaxf(nx, 0.f) + log1pf(__expf(-fabsf(nx)));
        const float w = -sp - 0.5f;
        const float decay = __expf(-__expf(w));
        const float a = sigmoidf_(a0v + aa[r]);
        const float kk = kval * kkv;
        const float ss = wave_sum(kk * kk);
        const float kkn = kk / fmaxf(sqrtf(ss), 1e-12f);
        row[1792 + ch] = f2bf(decay);
        row[2304 + ch] = f2bf(kkn);
        row[2816 + ch] = f2bf(kkn * a);
        row[512 + ch] = f2bf(kval * (1.f + (a - 1.f) * kav));
        if (l > 0) {
          const float v = vsh[r * 512 + ch];
          const float vf = bf2f(VF[(size_t)(tok0 + r) * 512 + ch]);
          row[1024 + ch] = f2bf(v + (vf - v) * sigmoidf_(v0v + am[r]));
        }
      }
    }
    __syncthreads();
  }
}

__device__ __forceinline__ void scan_item(const Params& p, int item, char* smem) {
  const u16* P2 = (const u16*)(p.ws + OFF_P2); u16* YC = (u16*)(p.ws + OFF_YC);
  float* vb = (float*)smem;
  float* yb = vb + 2 * 6 * 16 * 64;
  const int tid = tidx(), lane = tid & 63, wid = tid >> 6;
  const int rq = item & 3, h = (item >> 2) & 7, b = item >> 5;
  const int rl = lane >> 4, cq = lane & 15;
  const int rloc = wid * 4 + rl;
  const int ihead = rq * 16 + rloc;
  const int j0 = cq * 4;
  const size_t tokb = (size_t)b * 4096;
  float s0 = 0.f, s1 = 0.f, s2 = 0.f, s3 = 0.f;
  uint4 pre[3];
  auto gload = [&](int c) {
#pragma unroll
    for (int i = 0; i < 3; ++i) {
      const int v = tid + i * 256; const int vec = v >> 7, rem = v & 127, step = rem >> 3, c8 = rem & 7;
      const int off = (vec == 0) ? 0 : (vec == 1) ? 1792 : (vec == 2) ? 512 : (vec == 3) ? 1024 : (vec == 4) ? 2304 : 2816;
      pre[i] = *(const uint4*)(P2 + (tokb + c * 16 + step) * PS2 + off + h * 64 + c8 * 8);
    }
  };
  auto lstore = [&](int buf) {
#pragma unroll
    for (int i = 0; i < 3; ++i) {
      const int v = tid + i * 256; const int vec = v >> 7, rem = v & 127, step = rem >> 3, c8 = rem & 7;
      float* d = vb + ((buf * 6 + vec) * 16 + step) * 64 + c8 * 8;
      float4 f0, f1;
      f0.x = bf2f((u16)(pre[i].x & 0xffff)); f0.y = bf2f((u16)(pre[i].x >> 16)); f0.z = bf2f((u16)(pre[i].y & 0xffff)); f0.w = bf2f((u16)(pre[i].y >> 16));
      f1.x = bf2f((u16)(pre[i].z & 0xffff)); f1.y = bf2f((u16)(pre[i].z >> 16)); f1.z = bf2f((u16)(pre[i].w & 0xffff)); f1.w = bf2f((u16)(pre[i].w >> 16));
      *(float4*)d = f0; *(float4*)(d + 4) = f1;
    }
  };
  gload(0); lstore(0);
  __syncthreads();
  for (int c = 0; c < 256; ++c) {
    const int buf = c & 1;
    if (c + 1 < 256) gload(c + 1);
    const float* base = vb + buf * 6 * 16 * 64;
#pragma unroll 4
    for (int st = 0; st < 16; ++st) {
      const float4 r4 = *(const float4*)(base + (0 * 16 + st) * 64 + j0);
      const float4 w4 = *(const float4*)(base + (1 * 16 + st) * 64 + j0);
      const float4 k4 = *(const float4*)(base + (2 * 16 + st) * 64 + j0);
      const float vi = base[(3 * 16 + st) * 64 + ihead];
      const float4 n4 = *(const float4*)(base + (4 * 16 + st) * 64 + j0);
      const float4 b4 = *(const float4*)(base + (5 * 16 + st) * 64 + j0);
      float sa = s0 * n4.x + s1 * n4.y + s2 * n4.z + s3 * n4.w;
      sa = -dpp_sum16(sa);
      s0 = s0 * w4.x + sa * b4.x + vi * k4.x;
      s1 = s1 * w4.y + sa * b4.y + vi * k4.y;
      s2 = s2 * w4.z + sa * b4.z + vi * k4.z;
      s3 = s3 * w4.w + sa * b4.w + vi * k4.w;
      float y = s0 * r4.x + s1 * r4.y + s2 * r4.z + s3 * r4.w;
      y = dpp_sum16(y);
      if (cq == 0) yb[st * 16 + rloc] = y;
    }
    __syncthreads();
    {
      const int st = tid >> 4, r = tid & 15;
      YC[(tokb + c * 16 + st) * 512 + h * 64 + rq * 16 + r] = f2bf(yb[st * 16 + r]);
    }
    if (c + 1 < 256) lstore(buf ^ 1);
    __syncthreads();
  }
}

__device__ __forceinline__ void phase_post(const Params& p, int l, char* smem) {
  const u16* P2 = (const u16*)(p.ws + OFF_P2); u16* YC = (u16*)(p.ws + OFF_YC);
  float* sg = (float*)smem;
  const int tid = tidx();
  const float* g2 = p.in[26] + (size_t)l * 128 * 512;
  const float* rk = p.in[29] + (size_t)l * 512; const float* lg = p.in[30] + (size_t)l * 512; const float* lb = p.in[31] + (size_t)l * 512;
  for (int item = blockIdx.x; item < 2048; item += gridDim.x) {
    const int tok0 = item * 16;
    for (int e = tid; e < 2048; e += 256) { const int r = e >> 7, c = e & 127; sg[e] = bf2f(P2[(size_t)(tok0 + r) * PS2 + 1664 + c]); }
    __syncthreads();
#pragma unroll 1
    for (int hc = 0; hc < 2; ++hc) {
      const int ch = tid + hc * 256;
      float ag[16];
#pragma unroll
      for (int r = 0; r < 16; ++r) ag[r] = 0.f;
#pragma unroll 4
      for (int i = 0; i < 128; i += 4) {
        const float g0 = g2[i * 512 + ch], g1 = g2[(i + 1) * 512 + ch], g2v = g2[(i + 2) * 512 + ch], g3 = g2[(i + 3) * 512 + ch];
#pragma unroll
        for (int r = 0; r < 16; ++r) {
          const float4 t4 = *(const float4*)(sg + r * 128 + i);
          ag[r] += t4.x * g0 + t4.y * g1 + t4.z * g2v + t4.w * g3;
        }
      }
      const float rkv = rk[ch], lgv = lg[ch], lbv = lb[ch];
#pragma unroll
      for (int r = 0; r < 16; ++r) {
        const u16* row = P2 + (size_t)(tok0 + r) * PS2;
        const float y = bf2f(YC[(size_t)(tok0 + r) * 512 + ch]);
        const float mean = wave_sum(y) * (1.f / 64.f);
        const float dv = y - mean;
        const float var = wave_sum(dv * dv) * (1.f / 64.f);
        const float yn = dv * rsqrtf(var + 64e-5f) * lgv + lbv;
        const float rr = bf2f(row[ch]), kk = bf2f(row[512 + ch]), vv = bf2f(row[1024 + ch]);
        const float bon = wave_sum(rr * kk * rkv) * vv;
        YC[(size_t)(tok0 + r) * 512 + ch] = f2bf((yn + bon) * ag[r]);
      }
    }
    __syncthreads();
  }
}

#define NEGV (-1e30f)
struct AttnState { float m[2]; float ls[2]; f32x4 ot[4][2]; };

template <int MODE>
__device__ __forceinline__ void attn_scores(f32x4 (&st)[4][2], const u16* kbase, int kstride, int key0, const bf16x8 (&qf)[2][2],
                                            const float (&slope)[2], int t, bool selbit, int c16, int q4) {
#pragma unroll
  for (int mk = 0; mk < 4; ++mk) {
    const u16* kp = kbase + (size_t)(mk * 16 + c16) * kstride + q4 * 8;
    const bf16x8 k0 = *(const bf16x8*)kp, k1 = *(const bf16x8*)(kp + 32);
#pragma unroll
    for (int nq = 0; nq < 2; ++nq) {
      f32x4 a = {0.f, 0.f, 0.f, 0.f};
      a = mfma16(k0, qf[nq][0], a);
      a = mfma16(k1, qf[nq][1], a);
#pragma unroll
      for (int j = 0; j < 4; ++j) {
        const int key = key0 + mk * 16 + q4 * 4 + j;
        int dist; bool valid;
        if (MODE == 0) { dist = t - (16 * key + 31); valid = dist >= 0; }
        else if (MODE == 1) { dist = t - key; valid = (dist >= 0) && selbit; }
        else { dist = t - key; valid = (dist >= 0) && (dist < 512); }
        a[j] = valid ? (a[j] - slope[nq] * (float)dist) : NEGV;
      }
      st[mk][nq] = a;
    }
  }
}

template <int MODE>
__device__ __forceinline__ void attn_tile(AttnState& S, const u16* kbase, int kstride, const u16* vtbase, int vstride, int key0,
                                          const bf16x8 (&qf)[2][2], const float (&slope)[2], int t, bool selbit, int c16, int q4) {
  f32x4 st[4][2];
  attn_scores<MODE>(st, kbase, kstride, key0, qf, slope, t, selbit, c16, q4);
  __builtin_amdgcn_sched_barrier(0);
#pragma unroll
  for (int nq = 0; nq < 2; ++nq) {
    float mx = NEGV;
#pragma unroll
    for (int mk = 0; mk < 4; ++mk)
#pragma unroll
      for (int j = 0; j < 4; ++j) mx = fmaxf(mx, st[mk][nq][j]);
    mx = fmaxf(mx, __shfl_xor(mx, 16)); mx = fmaxf(mx, __shfl_xor(mx, 32));
    const float mnew = fmaxf(S.m[nq], mx);
    const float alpha = __expf(S.m[nq] - mnew);
    S.m[nq] = mnew;
    float ls = S.ls[nq] * alpha;
#pragma unroll
    for (int md = 0; md < 4; ++md) { S.ot[md][nq][0] *= alpha; S.ot[md][nq][1] *= alpha; S.ot[md][nq][2] *= alpha; S.ot[md][nq][3] *= alpha; }
#pragma unroll
    for (int mk = 0; mk < 4; ++mk)
#pragma unroll
      for (int j = 0; j < 4; ++j) {
        const float sv = st[mk][nq][j];
        const float pv = (sv > -1e29f) ? __expf(sv - mnew) : 0.f;
        st[mk][nq][j] = pv; ls += pv;
      }
    S.ls[nq] = ls;
  }
#pragma unroll
  for (int s2 = 0; s2 < 2; ++s2) {
    __builtin_amdgcn_sched_barrier(0);
    bf16x8 pb[2];
#pragma unroll
    for (int nq = 0; nq < 2; ++nq) {
      uint4 u;
      u.x = pack2(st[2 * s2][nq][0], st[2 * s2][nq][1]); u.y = pack2(st[2 * s2][nq][2], st[2 * s2][nq][3]);
      u.z = pack2(st[2 * s2 + 1][nq][0], st[2 * s2 + 1][nq][1]); u.w = pack2(st[2 * s2 + 1][nq][2], st[2 * s2 + 1][nq][3]);
      pb[nq] = *(bf16x8*)&u;
    }
#pragma unroll
    for (int md = 0; md < 4; ++md) {
      const bf16x8 vf = *(const bf16x8*)(vtbase + (size_t)(md * 16 + c16) * vstride + s2 * 32 + q4 * 8);
#pragma unroll
      for (int nq = 0; nq < 2; ++nq) S.ot[md][nq] = mfma16(vf, pb[nq], S.ot[md][nq]);
    }
  }
}

__device__ __forceinline__ void attn_reset(AttnState& S) {
#pragma unroll
  for (int nq = 0; nq < 2; ++nq) { S.m[nq] = NEGV; S.ls[nq] = 0.f;
#pragma unroll
    for (int md = 0; md < 4; ++md) S.ot[md][nq] = f32x4{0.f, 0.f, 0.f, 0.f}; }
}
__device__ __forceinline__ void attn_fold(AttnState& S, float* oacc, const u16* gp, int br, float (&invl)[2], int lane) {
#pragma unroll
  for (int nq = 0; nq < 2; ++nq) {
    float l = S.ls[nq];
    l += __shfl_xor(l, 16); l += __shfl_xor(l, 32);
    const float inv = (l > 0.f) ? 1.f / l : 0.f;
    invl[nq] = inv;
    const float f = bf2f(gp[nq * 6 + br]) * inv;
#pragma unroll
    for (int md = 0; md < 4; ++md)
#pragma unroll
      for (int j = 0; j < 4; ++j) {
        float* a = oacc + ((md * 2 + nq) * 4 + j) * 64 + lane;
        const float v = f * S.ot[md][nq][j];
        if (br == 0) *a = v; else *a += v;
      }
  }
}

__device__ __forceinline__ void phase_nsa(const Params& p, char* smem, unsigned* queue) {
  u16* P1 = (u16*)(p.ws + OFF_P1);
  const u16* KC = (const u16*)(p.ws + OFF_KC); const u16* VC = (const u16*)(p.ws + OFF_VC); const u16* VT = (const u16*)(p.ws + OFF_VT);
  const int tid = tidx(), lane = tid & 63, wid = tid >> 6;
  const int c16 = lane & 15, q4 = lane >> 4, tq = lane & 7;
  float* ps = (float*)smem + wid * 2048;
  float* oacc = (float*)(smem + 32768) + wid * 2048;
  int* qslot = (int*)(smem + 65536);
#pragma unroll 1
  for (;;) {
    if (tid == 0) *qslot = (int)atomicAdd(queue, 1u);
    __syncthreads();
    const int it = *qslot;
    if (it >= 2048) break;
    const int bg = it & 15;
    const int tqd = 127 - (it >> 4);
    const int b = bg >> 1, g = bg & 1;
    const int t0 = (tqd * 4 + wid) * 8;
    const int tok0 = b * 4096 + t0;
    const int t = t0 + tq;
    const int cur = t0 >> 6;
#pragma unroll
    for (int i = 0; i < 8; ++i) *(float4*)(ps + i * 256 + lane * 4) = float4{0.f, 0.f, 0.f, 0.f};
    bf16x8 qf[2][2]; float slope[2];
    const u16* gp = P1 + (size_t)(tok0 + tq) * PS1 + 1024 + (g * 4 + (c16 >> 3)) * 3;
#pragma unroll
    for (int nq = 0; nq < 2; ++nq) {
      const int hh = nq * 2 + (c16 >> 3);
      const u16* rp = P1 + (size_t)(tok0 + tq) * PS1;
      qf[nq][0] = *(const bf16x8*)(rp + (g * 4 + hh) * 64 + q4 * 8);
      qf[nq][1] = *(const bf16x8*)(rp + (g * 4 + hh) * 64 + 32 + q4 * 8);
      slope[nq] = exp2f(-(float)(g * 4 + hh + 1));
    }
    AttnState S;
    float invl[2];
    const u16* kcb = KC + (size_t)(b * 2 + g) * 256 * 64;
    const u16* vcb = VC + (size_t)(b * 2 + g) * 64 * 256;
    int ntc = 0;
    if (t0 + 7 >= 31) ntc = (((t0 + 7 - 31) >> 4) >> 6) + 1;
    attn_reset(S);
#pragma unroll 1
    for (int kt = 0; kt < ntc; ++kt) attn_tile<0>(S, kcb + (size_t)kt * 64 * 64, 64, vcb + kt * 64, 256, kt * 64, qf, slope, t, true, c16, q4);
    attn_fold(S, oacc, gp, 0, invl, lane);
#pragma unroll 1
    for (int kt = 0; kt < ntc; ++kt) {
      f32x4 st[4][2];
      attn_scores<0>(st, kcb + (size_t)kt * 64 * 64, 64, kt * 64, qf, slope, t, true, c16, q4);
#pragma unroll
      for (int mk = 0; mk < 4; ++mk) {
        f32x4 hs;
#pragma unroll
        for (int j = 0; j < 4; ++j) {
          const float a0 = st[mk][0][j], a1 = st[mk][1][j];
          const float p0 = (a0 > -1e29f) ? __expf(a0 - S.m[0]) * invl[0] : 0.f;
          const float p1 = (a1 > -1e29f) ? __expf(a1 - S.m[1]) * invl[1] : 0.f;
          float v = p0 + p1;
          v += __shfl_xor(v, 8);
          hs[j] = v;
        }
        if (c16 < 8) *(f32x4*)(ps + c16 * 256 + kt * 64 + mk * 16 + q4 * 4) = hs;
      }
    }
    __syncthreads();
    unsigned long long selm = 0ull, un = 0ull;
#pragma unroll 1
    for (int tqq = 0; tqq < 8; ++tqq) {
      const float* pr = ps + tqq * 256;
      float imp = pr[4 * lane];
      if (lane > 0) imp += pr[4 * lane - 4] + 2.f * (pr[4 * lane - 3] + pr[4 * lane - 2] + pr[4 * lane - 1]);
      const bool forced = (lane == 0) || (lane == cur) || (lane == cur - 1);
      const bool live = lane <= cur;
      const float val = forced ? 1e4f : (live ? imp : NEGV);
      int rank = 0;
#pragma unroll 8
      for (int i = 0; i < 64; ++i) {
        const float vi = __uint_as_float(__builtin_amdgcn_readlane(__float_as_uint(val), i));
        rank += ((vi > val) || (vi == val && i < lane)) ? 1 : 0;
      }
      const unsigned long long bal = __ballot((rank < 16) && live);
      if (tq == tqq) selm = bal;
      un |= bal;
    }
    __syncthreads();
    attn_reset(S);
    {
      const u16* vtb = VT + (size_t)((0 * 8 + b) * 2 + g) * 64 * 4096;
#pragma unroll 1
      for (int j = 0; j <= cur; ++j) {
        if (!((un >> j) & 1ull)) continue;
        const bool sb = (selm >> j) & 1ull;
        attn_tile<1>(S, P1 + (size_t)(b * 4096 + j * 64) * PS1 + 768 + g * 64, PS1, vtb + j * 64, 4096, j * 64, qf, slope, t, sb, c16, q4);
      }
    }
    attn_fold(S, oacc, gp, 1, invl, lane);
    attn_reset(S);
    {
      const u16* vtb = VT + (size_t)((1 * 8 + b) * 2 + g) * 64 * 4096;
      int j0 = t0 - 511; if (j0 < 0) j0 = 0; j0 >>= 6;
#pragma unroll 1
      for (int j = j0; j <= cur; ++j)
        attn_tile<2>(S, P1 + (size_t)(b * 4096 + j * 64) * PS1 + 896 + g * 64, PS1, vtb + j * 64, 4096, j * 64, qf, slope, t, true, c16, q4);
    }
    attn_fold(S, oacc, gp, 2, invl, lane);
#pragma unroll
    for (int nq = 0; nq < 2; ++nq) {
      const int hh = nq * 2 + (c16 >> 3);
      u16* rp = P1 + (size_t)(tok0 + tq) * PS1 + (g * 4 + hh) * 64;
#pragma unroll
      for (int md = 0; md < 4; ++md) {
        const float* a = oacc + ((md * 2 + nq) * 4) * 64 + lane;
        uint2 o; o.x = pack2(a[0], a[64]); o.y = pack2(a[128], a[192]);
        *(uint2*)(rp + md * 16 + q4 * 4) = o;
      }
    }
  }
}

__device__ __forceinline__ const float* modp(const Params& p, int l, int sub, int kind) {
  return (const float*)(p.ws + OFF_MOD) + (size_t)l * 8 * 9216 + sub * 3072 + kind * 1024;
}

__device__ __forceinline__ void run_phase(const Params& p, int ph, char* smem) {
  char* ws = p.ws;
  if (ph == 0) {
    if (blockIdx.x == 0) { unsigned* c = (unsigned*)(ws + OFF_CNT); for (int e = tidx(); e < 1024; e += 256) c[e] = 0u; }
    phase_mod(p, smem);
  }
  int l = 0, s = -1;
  if (ph >= 2) { l = (ph - 2) / 15; s = (ph - 2) % 15; }
  const float* preg = p.in[4] + (size_t)l * 3 * 1024; const float* postg = p.in[5] + (size_t)l * 3 * 1024;
  const bool is_norm = (ph == 1) || s == 2 || s == 8 || s == 11 || s == 14;
  if (is_norm) {
    const float* xin = p.out; float* xout = p.out; const u16* y = nullptr; const float* pg = nullptr; const float* gate = nullptr; float wgt = 0.f;
    const float* prg = nullptr; const float* sh = nullptr; const float* sc = nullptr; u16* h = (u16*)(ws + OFF_H);
    if (ph == 1) { xin = p.in[0]; prg = p.in[4]; sh = modp(p, 0, 0, 0); sc = modp(p, 0, 0, 1); }
    else if (s == 2) { y = (const u16*)(ws + OFF_YF); pg = postg; gate = modp(p, l, 0, 2); wgt = 0.5f; prg = preg + 1024; sh = modp(p, l, 1, 0); sc = modp(p, l, 1, 1); }
    else if (s == 8) { xout = nullptr; prg = preg + 1024; sh = modp(p, l, 1, 0); sc = modp(p, l, 1, 1); h = (u16*)(ws + OFF_H2); }
    else if (s == 11) { y = (const u16*)(ws + OFF_YM); pg = postg + 1024; gate = modp(p, l, 1, 2); wgt = 1.0f; prg = preg + 2048; sh = modp(p, l, 2, 0); sc = modp(p, l, 2, 1); }
    else { y = (const u16*)(ws + OFF_YF); pg = postg + 2048; gate = modp(p, l, 2, 2); wgt = 0.5f;
      if (l == 0) { prg = p.in[4] + 3 * 1024; sh = modp(p, 1, 0, 0); sc = modp(p, 1, 0, 1); } else { h = nullptr; } }
    phase_norm(xin, xout, y, pg, gate, wgt, prg, sh, sc, h);
  }
  {
    int cl = -1, cf = 0;
    if (ph == 0) { cl = 0; cf = 0; } else if (s == 2) { cl = l; cf = 1; } else if (s == 14 && l == 0) { cl = 1; cf = 0; }
    if (cl >= 0) conv_ffn(p, cl, cf, smem);
    if (cl >= 0 && cf == 0) conv_mix(p, cl, smem);
  }
  if (s == 0 || s == 12) phase_ffn_in(p, smem);
  if (s == 1 || s == 13 || s == 10) {
    const bool o = (s == 10);
    phase_gemm_plain((const u16*)(ws + (o ? OFF_MERGED : OFF_ACT)), o ? 1024 : DFF, (const u16*)(ws + (o ? OFF_WO : OFF_WOUT)), o ? 1024 : DFF,
                     (u16*)(ws + (o ? OFF_YM : OFF_YF)), smem);
  }
  if (s == 3) phase_inproj(p, smem);
  if (s == 4) { phase_prep1(p, l); phase_sgu(p, l, smem); phase_cmp1(p, l, smem); }
  if (s == 5) { phase_prep2(p, l, smem); phase_cmp2(p, l); }
  if (s == 6) {
    const int nb = gridDim.x;
    const int sid = (nb >= 512) ? (((int)blockIdx.x & 1) ? -1 : ((int)blockIdx.x >> 1)) : (int)blockIdx.x;
    const int sstride = (nb >= 512) ? (nb >> 1) : nb;
    if (sid >= 0) for (int it = sid; it < 256; it += sstride) scan_item(p, it, smem);
    phase_nsa(p, smem, (unsigned*)(ws + OFF_CNT) + 64 + l * 64);
  }
  if (s == 7) phase_post(p, l, smem);
  if (s == 9) phase_merge(p, smem);
}

constexpr int NPHASE = 32;

#if COOP
typedef const float* __attribute__((address_space(4))) const* kargp_t;
template <int PH>
__device__ __forceinline__ void run_seq(char* smem, cg::grid_group& grid) {
  if constexpr (PH < NPHASE) {
    {
      kargp_t ka = (kargp_t)__builtin_amdgcn_kernarg_segment_ptr();
      asm volatile("" : "+s"(ka));
      Params q;
#pragma unroll
      for (int i = 0; i < 35; ++i) q.in[i] = ka[i];
      q.out = (float*)ka[35];
      q.ws = (char*)ka[36];
      run_phase(q, PH, smem);
    }
    if constexpr (PH == 0) grid.sync();
    else if constexpr (PH + 1 < NPHASE) {
      kargp_t kb = (kargp_t)__builtin_amdgcn_kernarg_segment_ptr();
      asm volatile("" : "+s"(kb));
      gbar((unsigned*)((char*)kb[36] + OFF_CNT), (unsigned)PH * gridDim.x);
    }
    run_seq<PH + 1>(smem, grid);
  }
}

__global__ void __launch_bounds__(256, 2) mega(Params p) {
  __shared__ __attribute__((aligned(16))) char smem[SMEM_BYTES];
  cg::grid_group grid = cg::this_grid();
  run_seq<0>(smem, grid);
}
#endif

template <int PH>
__global__ void __launch_bounds__(256, 2) kph(Params p) {
  __shared__ __attribute__((aligned(16))) char smem[SMEM_BYTES];
  run_phase(p, PH, smem);
}

template <int PH>
static void launch_seq(const Params& p, int grid, hipStream_t stream) {
  if constexpr (PH < NPHASE) {
    kph<PH><<<grid, 256, 0, stream>>>(p);
    launch_seq<PH + 1>(p, grid, stream);
  }
}

extern "C" void kernel_launch(void* const* d_in, const int* in_sizes, int n_in, void* d_out, int out_size, void* d_ws, size_t ws_size,
                              hipStream_t stream) {
  static int grid_blocks = 0;
  if (!grid_blocks) {
    int dev = 0, cus = 0, per_cu = 0;
    hipGetDevice(&dev);
    hipDeviceGetAttribute(&cus, hipDeviceAttributeMultiprocessorCount, dev);
    #if COOP
    hipOccupancyMaxActiveBlocksPerMultiprocessor(&per_cu, mega, 256, 0);
#else
    per_cu = 2;
#endif
    if (per_cu > 2) per_cu = 2;
    if (per_cu < 1) per_cu = 1;
    grid_blocks = cus * per_cu;
  }
  Params p{};
  for (int i = 0; i < 35; ++i) p.in[i] = (const float*)d_in[i];
  p.out = (float*)d_out;
  p.ws = (char*)d_ws;
#if COOP
  void* args[] = {&p};
  hipError_t e = hipLaunchCooperativeKernel((void*)mega, dim3(grid_blocks), dim3(256), args, 0, stream);
  if (e != hipSuccess) fprintf(stderr, "cooperative launch failed: %s (grid %d)\n", hipGetErrorString(e), grid_blocks);
#else
  launch_seq<0>(p, grid_blocks, stream);
#endif
}
```

```cpp
#include <hip/hip_runtime.h>
#include <hip/hip_cooperative_groups.h>
#include <cstdio>
#include <cstdint>
namespace cg = cooperative_groups;

#ifndef COOP
#define COOP 1
#endif

typedef unsigned short u16;
using bf16x8 = __attribute__((ext_vector_type(8))) short;
using f32x4 = __attribute__((ext_vector_type(4))) float;

constexpr int T = 32768, D = 1024, SEQ = 4096, DFF = 2816;
constexpr int PS1 = 2072, PS2 = 3328;
constexpr int MIXC = 7192, MIXN = 4120;
constexpr size_t OFF_P1 = 0;
constexpr size_t OFF_P2 = OFF_P1 + (size_t)T * PS1 * 2;
constexpr size_t OFF_H = OFF_P2 + (size_t)T * PS2 * 2;
constexpr size_t OFF_WMIX = OFF_H + (size_t)T * 1024 * 2;
constexpr size_t OFF_WG = OFF_WMIX + (size_t)4224 * 1024 * 2;
constexpr size_t OFF_WB = OFF_WG + (size_t)3072 * 1024 * 2;
constexpr size_t OFF_WO = OFF_WB + (size_t)3 * 1024 * 512 * 2;
constexpr size_t OFF_W1 = OFF_WO + (size_t)1024 * 1024 * 2;
constexpr size_t OFF_WIN = OFF_W1 + (size_t)2 * 256 * 2048 * 2;
constexpr size_t OFF_WOUT = OFF_WIN + (size_t)5632 * 1024 * 2;
constexpr size_t OFF_VFIRST = OFF_WOUT + (size_t)1024 * 2816 * 2;
constexpr size_t OFF_VT = OFF_VFIRST + (size_t)T * 512 * 2;
constexpr size_t OFF_MOD = OFF_VT + (size_t)2 * 8 * 2 * 64 * 4096 * 2;
constexpr size_t OFF_PB = OFF_MOD + (size_t)2 * 8 * 9216 * 4;
constexpr size_t OFF_HID = OFF_PB + (size_t)1024 * 1792 * 2;
constexpr size_t OFF_KC = OFF_HID + (size_t)2 * 4096 * 256 * 2;
constexpr size_t OFF_VC = OFF_KC + (size_t)8 * 2 * 256 * 64 * 2;
constexpr size_t OFF_LV = OFF_VC + (size_t)8 * 2 * 64 * 256 * 2;
constexpr size_t OFF_CNT = OFF_LV + (size_t)T * 32 * 4;
constexpr size_t WS_END = OFF_CNT + 4096;
constexpr size_t OFF_ACT = OFF_P1;
constexpr size_t OFF_YF = OFF_ACT + (size_t)T * DFF * 2;
constexpr size_t OFF_H2 = OFF_P2;
constexpr size_t OFF_MERGED = OFF_P2;
constexpr size_t OFF_YM = OFF_MERGED + (size_t)T * 1024 * 2;
constexpr size_t OFF_YC = OFF_H;

constexpr int SMEM_BYTES = 73728;

struct Params { const float* in[35]; float* out; char* ws; };

__device__ __forceinline__ int tidx() { int t = __builtin_amdgcn_workitem_id_x(); asm volatile("" : "+v"(t)); return t; }
__device__ __forceinline__ void gbar(unsigned* cnt, unsigned target) {
  asm volatile("s_waitcnt vmcnt(0) lgkmcnt(0)" ::: "memory");
  __syncthreads();
  if (tidx() == 0) {
    __builtin_amdgcn_fence(__ATOMIC_RELEASE, "agent");
    asm volatile("s_waitcnt vmcnt(0)" ::: "memory");
    __hip_atomic_fetch_add(cnt, 1u, __ATOMIC_RELAXED, __HIP_MEMORY_SCOPE_AGENT);
    while (__hip_atomic_load(cnt, __ATOMIC_RELAXED, __HIP_MEMORY_SCOPE_AGENT) < target) __builtin_amdgcn_s_sleep(1);
    __builtin_amdgcn_fence(__ATOMIC_ACQUIRE, "agent");
    asm volatile("s_waitcnt vmcnt(0)" ::: "memory");
  }
  __syncthreads();
}
__device__ __forceinline__ float dpp_sum16(float v) {
  v += __int_as_float(__builtin_amdgcn_update_dpp(0, __float_as_int(v), 0xB1, 0xF, 0xF, true));
  v += __int_as_float(__builtin_amdgcn_update_dpp(0, __float_as_int(v), 0x4E, 0xF, 0xF, true));
  v += __int_as_float(__builtin_amdgcn_update_dpp(0, __float_as_int(v), 0x141, 0xF, 0xF, true));
  v += __int_as_float(__builtin_amdgcn_update_dpp(0, __float_as_int(v), 0x140, 0xF, 0xF, true));
  return v;
}
__device__ __forceinline__ float bf2f(u16 u) { return __uint_as_float(((unsigned)u) << 16); }
__device__ __forceinline__ u16 f2bf(float f) { __bf16 r = (__bf16)f; return *(u16*)&r; }
typedef __attribute__((ext_vector_type(2))) float f2_t;
typedef __attribute__((ext_vector_type(2))) __bf16 b2_t;
__device__ __forceinline__ unsigned pack2(float a, float b) { f2_t v = {a, b}; b2_t r = __builtin_convertvector(v, b2_t); return *(unsigned*)&r; }
__device__ __forceinline__ float sigmoidf_(float x) { return 1.f / (1.f + __expf(-x)); }
__device__ __forceinline__ float siluf_(float x) { return x / (1.f + __expf(-x)); }
__device__ __forceinline__ float geluf_(float x) { float u = 0.7978845608028654f * (x + 0.044715f * x * x * x); return 0.5f * x * (1.f + tanhf(u)); }
__device__ __forceinline__ float wave_sum(float v) {
#pragma unroll
  for (int o = 32; o >= 1; o >>= 1) v += __shfl_xor(v, o);
  return v;
}
__device__ __forceinline__ f32x4 mfma16(bf16x8 a, bf16x8 b, f32x4 c) { return __builtin_amdgcn_mfma_f32_16x16x32_bf16(a, b, c, 0, 0, 0); }

__device__ __forceinline__ void conv_w(const float* src, int ld, int K, u16* dst, int NR, int nvalid, int coff, int kind, char* smem) {
  float* tl = (float*)smem;
  const int tid = tidx();
  const int ktn = K >> 6, ntile = (NR >> 6) * ktn;
  for (int tix = blockIdx.x; tix < ntile; tix += gridDim.x) {
    const int R0 = (tix / ktn) << 6, k0 = (tix % ktn) << 6;
    const int c = tid & 63, kq = tid >> 6;
    const int R = R0 + c;
    int sc; bool ok;
    if (kind == 0) { sc = coff + R; ok = R < nvalid; }
    else { int ntl = R >> 7, w = (R >> 6) & 1, n = (R >> 4) & 3, r = R & 15; sc = ((n >= 2) ? DFF : 0) + ntl * 64 + w * 32 + (n & 1) * 16 + r; ok = true; }
#pragma unroll 4
    for (int i = 0; i < 16; ++i) {
      int k = k0 + kq * 16 + i;
      tl[c * 65 + kq * 16 + i] = ok ? src[(size_t)k * ld + sc] : 0.f;
    }
    __syncthreads();
    {
      const int r = tid >> 2, ks = tid & 3;
      const float* s = tl + r * 65 + ks * 16;
      uint4 o0, o1;
      o0.x = pack2(s[0], s[1]); o0.y = pack2(s[2], s[3]); o0.z = pack2(s[4], s[5]); o0.w = pack2(s[6], s[7]);
      o1.x = pack2(s[8], s[9]); o1.y = pack2(s[10], s[11]); o1.z = pack2(s[12], s[13]); o1.w = pack2(s[14], s[15]);
      uint4* dp = (uint4*)(dst + (size_t)(R0 + r) * K + k0 + ks * 16);
      dp[0] = o0; dp[1] = o1;
    }
    __syncthreads();
  }
}

__device__ __forceinline__ void conv_ffn(const Params& p, int l, int f, char* smem) {
  conv_w(p.in[6] + (size_t)(l * 2 + f) * D * (2 * DFF), 2 * DFF, D, (u16*)(p.ws + OFF_WIN), 5632, 5632, 0, 1, smem);
  conv_w(p.in[7] + (size_t)(l * 2 + f) * DFF * D, D, DFF, (u16*)(p.ws + OFF_WOUT), 1024, 1024, 0, 0, smem);
}
__device__ __forceinline__ void conv_mix(const Params& p, int l, char* smem) {
  const float* mw = p.in[8] + (size_t)l * D * MIXC;
  conv_w(mw, MIXC, D, (u16*)(p.ws + OFF_WMIX), 4224, MIXN, 0, 0, smem);
  conv_w(mw, MIXC, D, (u16*)(p.ws + OFF_WG), 3072, 3072, MIXN, 0, smem);
  for (int i = 0; i < 3; ++i)
    conv_w(p.in[9] + (size_t)(l * 3 + i) * 512 * D, D, 512, (u16*)(p.ws + OFF_WB) + (size_t)i * 1024 * 512, 1024, 1024, 0, 0, smem);
  conv_w(p.in[10] + (size_t)l * D * D, D, D, (u16*)(p.ws + OFF_WO), 1024, 1024, 0, 0, smem);
  conv_w(p.in[11] + (size_t)l * 2048 * 256, 256, 2048, (u16*)(p.ws + OFF_W1), 256, 256, 0, 0, smem);
  conv_w(p.in[14] + (size_t)l * 2048 * 256, 256, 2048, (u16*)(p.ws + OFF_W1) + (size_t)256 * 2048, 256, 256, 0, 0, smem);
}

__device__ __forceinline__ void phase_mod(const Params& p, char* smem) {
  float* cond = (float*)smem;
  float* red = cond + 8192;
  const int tid = tidx();
  float* MOD = (float*)(p.ws + OFF_MOD);
  for (int item = blockIdx.x; item < 288; item += gridDim.x) {
    for (int e = tid; e < 8192; e += 256) cond[e] = siluf_(p.in[1][e]);
    __syncthreads();
    const int l = item / 144, n0 = (item % 144) * 64, col = n0 + (tid & 63), kq = tid >> 6;
    float acc[8];
#pragma unroll
    for (int b = 0; b < 8; ++b) acc[b] = 0.f;
    const float* w = p.in[2] + (size_t)l * D * 9216 + col;
#pragma unroll 4
    for (int k = kq * 256; k < kq * 256 + 256; ++k) {
      float wv = w[(size_t)k * 9216];
#pragma unroll
      for (int b = 0; b < 8; ++b) acc[b] += cond[b * 1024 + k] * wv;
    }
#pragma unroll
    for (int b = 0; b < 8; ++b) red[(kq * 8 + b) * 64 + (tid & 63)] = acc[b];
    __syncthreads();
    for (int e = tid; e < 512; e += 256) {
      int b = e >> 6, c = e & 63;
      float s = red[(0 * 8 + b) * 64 + c] + red[(1 * 8 + b) * 64 + c] + red[(2 * 8 + b) * 64 + c] + red[(3 * 8 + b) * 64 + c];
      MOD[(size_t)(l * 8 + b) * 9216 + n0 + c] = s + p.in[3][(size_t)l * 9216 + n0 + c];
    }
    __syncthreads();
  }
}

__device__ __forceinline__ void phase_norm(const float* xin, float* xout, const u16* y, const float* postg, const float* gate, float wgt,
                           const float* preg, const float* shift, const float* scale, u16* h) {
  const int lane = tidx() & 63, wid = tidx() >> 6;
  for (int row = blockIdx.x * 4 + wid; row < T; row += gridDim.x * 4) {
    const int b = row >> 12;
    float4 xv[4];
#pragma unroll
    for (int i = 0; i < 4; ++i) xv[i] = *(const float4*)(xin + (size_t)row * D + i * 256 + lane * 4);
    if (y) {
      float yv[4][4]; float ss = 0.f;
#pragma unroll
      for (int i = 0; i < 4; ++i) {
        uint2 u = *(const uint2*)(y + (size_t)row * D + i * 256 + lane * 4);
        yv[i][0] = bf2f((u16)(u.x & 0xffff)); yv[i][1] = bf2f((u16)(u.x >> 16));
        yv[i][2] = bf2f((u16)(u.y & 0xffff)); yv[i][3] = bf2f((u16)(u.y >> 16));
        ss += yv[i][0] * yv[i][0] + yv[i][1] * yv[i][1] + yv[i][2] * yv[i][2] + yv[i][3] * yv[i][3];
      }
      ss = wave_sum(ss);
      const float rs = rsqrtf(ss * (1.f / 1024.f) + 1e-6f) * wgt;
#pragma unroll
      for (int i = 0; i < 4; ++i) {
        const int c = i * 256 + lane * 4;
        float4 g = *(const float4*)(gate + (size_t)b * 9216 + c);
        float4 pg = *(const float4*)(postg + c);
        xv[i].x += g.x * yv[i][0] * rs * pg.x; xv[i].y += g.y * yv[i][1] * rs * pg.y;
        xv[i].z += g.z * yv[i][2] * rs * pg.z; xv[i].w += g.w * yv[i][3] * rs * pg.w;
      }
    }
    if (xout) {
#pragma unroll
      for (int i = 0; i < 4; ++i) *(float4*)(xout + (size_t)row * D + i * 256 + lane * 4) = xv[i];
    }
    if (h) {
      float ss = 0.f;
#pragma unroll
      for (int i = 0; i < 4; ++i) ss += xv[i].x * xv[i].x + xv[i].y * xv[i].y + xv[i].z * xv[i].z + xv[i].w * xv[i].w;
      ss = wave_sum(ss);
      const float rs = rsqrtf(ss * (1.f / 1024.f) + 1e-6f);
#pragma unroll
      for (int i = 0; i < 4; ++i) {
        const int c = i * 256 + lane * 4;
        float4 pg = *(const float4*)(preg + c);
        float4 sh = *(const float4*)(shift + (size_t)b * 9216 + c);
        float4 sc = *(const float4*)(scale + (size_t)b * 9216 + c);
        uint2 o;
        o.x = pack2(xv[i].x * rs * pg.x * (1.f + sc.x) + sh.x, xv[i].y * rs * pg.y * (1.f + sc.y) + sh.y);
        o.y = pack2(xv[i].z * rs * pg.z * (1.f + sc.z) + sh.z, xv[i].w * rs * pg.w * (1.f + sc.w) + sh.w);
        *(uint2*)(h + (size_t)row * D + c) = o;
      }
    }
  }
}

template <int NS, class FA, class FB>
__device__ __forceinline__ void gemm_loop(f32x4 (&acc)[4][NS], const FA& fa, const FB& fb, int K, u16* sm) {
  constexpr int BN = 32 * NS;
  constexpr int NBV = BN / 32;
  const int tid = tidx(), lane = tid & 63, wid = tid >> 6, wr = wid >> 1, wc = wid & 1, fr = lane & 15, fq = lane >> 4;
  u16* As = sm; u16* Bs = sm + 2 * 128 * 64;
  uint4 ra0[4], rb0[NBV], ra1[4], rb1[NBV];
  const int nt = K >> 6;
  const int lrow = tid >> 3, lk = (tid & 7) * 8;
  const int lsw = lrow * 64 + (((tid & 7) ^ ((lrow >> 1) & 7)) << 3);
  const int c0 = (fq ^ ((fr >> 1) & 7)) << 3, c1 = c0 ^ 32;
#define G_LOAD(RA, RB, KT) { const int kb_ = (KT) << 6; \
    _Pragma("unroll") for (int i = 0; i < 4; ++i) RA[i] = fa(lrow + 32 * i, kb_ + lk); \
    _Pragma("unroll") for (int i = 0; i < NBV; ++i) RB[i] = fb(lrow + 32 * i, kb_ + lk); }
#define G_STORE(RA, RB, BUF) { u16* Aw_ = As + (BUF) * 128 * 64 + lsw; u16* Bw_ = Bs + (BUF) * BN * 64 + lsw; \
    _Pragma("unroll") for (int i = 0; i < 4; ++i) *(uint4*)(Aw_ + i * 32 * 64) = RA[i]; \
    _Pragma("unroll") for (int i = 0; i < NBV; ++i) *(uint4*)(Bw_ + i * 32 * 64) = RB[i]; }
#define G_COMPUTE(BUF) { const u16* Ab = As + (BUF) * 128 * 64 + (wr * 64 + fr) * 64; \
    const u16* Bb = Bs + (BUF) * BN * 64 + (wc * 16 * NS + fr) * 64; \
    _Pragma("unroll") for (int ks = 0; ks < 2; ++ks) { bf16x8 a[4], b[NS]; const int co = ks ? c1 : c0; \
      _Pragma("unroll") for (int m = 0; m < 4; ++m) a[m] = *(const bf16x8*)(Ab + m * 16 * 64 + co); \
      _Pragma("unroll") for (int n = 0; n < NS; ++n) b[n] = *(const bf16x8*)(Bb + n * 16 * 64 + co); \
      _Pragma("unroll") for (int m = 0; m < 4; ++m) _Pragma("unroll") for (int n = 0; n < NS; ++n) acc[m][n] = mfma16(a[m], b[n], acc[m][n]); } }
  G_LOAD(ra0, rb0, 0)
  if (nt > 1) G_LOAD(ra1, rb1, 1)
  G_STORE(ra0, rb0, 0)
  __syncthreads();
#pragma unroll 1
  for (int kt = 0; kt < nt; kt += 2) {
    if (kt + 2 < nt) G_LOAD(ra0, rb0, kt + 2)
    G_COMPUTE(0)
    if (kt + 1 < nt) G_STORE(ra1, rb1, 1)
    __syncthreads();
    if (kt + 1 >= nt) break;
    if (kt + 3 < nt) G_LOAD(ra1, rb1, kt + 3)
    G_COMPUTE(1)
    if (kt + 2 < nt) G_STORE(ra0, rb0, 0)
    __syncthreads();
  }
#undef G_LOAD
#undef G_STORE
#undef G_COMPUTE
}

__device__ __forceinline__ bool tile_map(int it, int NT, int& mt, int& nt) {
  const int g = gridDim.x;
  if ((g & 7) == 0) {
    const int xcd = blockIdx.x & 7, bx = blockIdx.x >> 3, nbx = g >> 3;
    const int lid = bx + it * nbx;
    if (lid >= 32 * NT) return false;
    const int grp = lid / (8 * NT), rem = lid - grp * 8 * NT;
    nt = rem >> 3; mt = xcd * 32 + grp * 8 + (rem & 7);
    return true;
  } else {
    const int id = blockIdx.x + it * g;
    if (id >= 256 * NT) return false;
    nt = id % NT; mt = id / NT;
    return true;
  }
}

#define ZERO_ACC(acc, NSV) _Pragma("unroll") for (int m_ = 0; m_ < 4; ++m_) _Pragma("unroll") for (int n_ = 0; n_ < NSV; ++n_) acc[m_][n_] = f32x4{0.f, 0.f, 0.f, 0.f};

__device__ __forceinline__ void phase_ffn_in(const Params& p, char* smem) {
  const u16* H = (const u16*)(p.ws + OFF_H); const u16* W = (const u16*)(p.ws + OFF_WIN); u16* ACT = (u16*)(p.ws + OFF_ACT);
  const int lane = tidx() & 63, wid = tidx() >> 6, wr = wid >> 1, wc = wid & 1, fr = lane & 15, fq = lane >> 4;
  int mt, nt;
  for (int it = 0; tile_map(it, 44, mt, nt); ++it) {
    const int m0 = mt * 128, n0 = nt * 128;
    f32x4 acc[4][4]; ZERO_ACC(acc, 4)
    const char* Ab_ = (const char*)(H + (size_t)m0 * 1024); const char* Bb_ = (const char*)(W + (size_t)n0 * 1024);
    auto fa = [&](int r, int k) { return *(const uint4*)(Ab_ + (unsigned)((r * 1024 + k) * 2)); };
    auto fb = [&](int r, int k) { return *(const uint4*)(Bb_ + (unsigned)((r * 1024 + k) * 2)); };
    gemm_loop<4>(acc, fa, fb, 1024, (u16*)smem);
#pragma unroll
    for (int m = 0; m < 4; ++m)
#pragma unroll
      for (int n = 0; n < 2; ++n) {
        const int col = nt * 64 + wc * 32 + n * 16 + fr;
        const int r0 = m0 + wr * 64 + m * 16 + fq * 4;
#pragma unroll
        for (int j = 0; j < 4; ++j) ACT[(size_t)(r0 + j) * DFF + col] = f2bf(siluf_(acc[m][n][j]) * acc[m][n + 2][j]);
      }
  }
}

__device__ __forceinline__ void phase_gemm_plain(const u16* A, int lda, const u16* Bt, int K, u16* C, char* smem) {
  const int lane = tidx() & 63, wid = tidx() >> 6, wr = wid >> 1, wc = wid & 1, fr = lane & 15, fq = lane >> 4;
  int mt, nt;
  for (int it = 0; tile_map(it, 8, mt, nt); ++it) {
    const int m0 = mt * 128, n0 = nt * 128;
    f32x4 acc[4][4]; ZERO_ACC(acc, 4)
    const char* Ab_ = (const char*)(A + (size_t)m0 * lda); const char* Bb_ = (const char*)(Bt + (size_t)n0 * K);
    auto fa = [&](int r, int k) { return *(const uint4*)(Ab_ + (unsigned)((r * lda + k) * 2)); };
    auto fb = [&](int r, int k) { return *(const uint4*)(Bb_ + (unsigned)((r * K + k) * 2)); };
    gemm_loop<4>(acc, fa, fb, K, (u16*)smem);
#pragma unroll
    for (int m = 0; m < 4; ++m)
#pragma unroll
      for (int n = 0; n < 4; ++n) {
        const int col = n0 + wc * 64 + n * 16 + fr;
        const int r0 = m0 + wr * 64 + m * 16 + fq * 4;
#pragma unroll
        for (int j = 0; j < 4; ++j) C[(size_t)(r0 + j) * 1024 + col] = f2bf(acc[m][n][j]);
      }
  }
}

__device__ __forceinline__ void phase_inproj(const Params& p, char* smem) {
  const u16* H = (const u16*)(p.ws + OFF_H); const u16* W = (const u16*)(p.ws + OFF_WMIX);
  u16* P1 = (u16*)(p.ws + OFF_P1); u16* P2 = (u16*)(p.ws + OFF_P2); u16* VT = (u16*)(p.ws + OFF_VT); u16* PB = (u16*)(p.ws + OFF_PB);
  const int lane = tidx() & 63, wid = tidx() >> 6, wr = wid >> 1, wc = wid & 1, fr = lane & 15, fq = lane >> 4;
  int mt, nt;
  for (int it = 0; tile_map(it, 33, mt, nt); ++it) {
    const int m0 = mt * 128, n0 = nt * 128;
    f32x4 acc[4][4]; ZERO_ACC(acc, 4)
    const char* Ab_ = (const char*)(H + (size_t)m0 * 1024); const char* Bb_ = (const char*)(W + (size_t)n0 * 1024);
    auto fa = [&](int r, int k) { return *(const uint4*)(Ab_ + (unsigned)((r * 1024 + k) * 2)); };
    auto fb = [&](int r, int k) { return *(const uint4*)(Bb_ + (unsigned)((r * 1024 + k) * 2)); };
    gemm_loop<4>(acc, fa, fb, 1024, (u16*)smem);
#pragma unroll
    for (int m = 0; m < 4; ++m)
#pragma unroll
      for (int nn = 0; nn < 4; ++nn) {
        const int n = n0 + wc * 64 + nn * 16 + fr;
        if (n >= MIXN) continue;
        const int r0 = m0 + wr * 64 + m * 16 + fq * 4;
        f32x4 v = acc[m][nn];
        if ((n >= 896 && n < 1024) || (n >= 1152 && n < 1280)) {
          const int which = (n >= 1152) ? 1 : 0;
          const int gd = n - (which ? 1152 : 896);
          const int b = r0 >> 12, t = r0 & 4095;
          uint2 o; o.x = pack2(v[0], v[1]); o.y = pack2(v[2], v[3]);
          *(uint2*)(VT + ((size_t)((which * 8 + b) * 128 + gd)) * 4096 + (t & ~31) + 8 * fq + 4 * (m & 1)) = o;
        } else if (n < 1304) {
          const int pc = (n < 896) ? n : ((n < 1152) ? n - 128 : n - 256);
          if (n < 512) { v[0] *= 0.125f; v[1] *= 0.125f; v[2] *= 0.125f; v[3] *= 0.125f; }
          if (n >= 1280) { v[0] = sigmoidf_(v[0]); v[1] = sigmoidf_(v[1]); v[2] = sigmoidf_(v[2]); v[3] = sigmoidf_(v[3]); }
#pragma unroll
          for (int j = 0; j < 4; ++j) P1[(size_t)(r0 + j) * PS1 + pc] = f2bf(v[j]);
        } else if (n < 2328) {
#pragma unroll
          for (int j = 0; j < 4; ++j) P1[(size_t)(r0 + j) * PS1 + (n - 256)] = f2bf(geluf_(v[j]));
        } else {
          const int pc = n - 2328;
#pragma unroll
          for (int j = 0; j < 4; ++j) P2[(size_t)(r0 + j) * PS2 + pc] = f2bf(v[j]);
          if ((m & 1) && fq == 3) PB[(size_t)((r0 + 3) >> 5) * 1792 + pc] = f2bf(v[3]);
        }
      }
  }
}

__device__ __forceinline__ void phase_merge(const Params& p, char* smem) {
  const u16* H2 = (const u16*)(p.ws + OFF_H); const u16* WG = (const u16*)(p.ws + OFF_WG); const u16* WB = (const u16*)(p.ws + OFF_WB);
  const u16* P1 = (const u16*)(p.ws + OFF_P1); u16* MG = (u16*)(p.ws + OFF_MERGED);
  const int lane = tidx() & 63, wid = tidx() >> 6, wr = wid >> 1, wc = wid & 1, fr = lane & 15, fq = lane >> 4;
  int mt, nt;
  for (int it = 0; tile_map(it, 16, mt, nt); ++it) {
    const int m0 = mt * 128, n0 = nt * 64;
    f32x4 tot[4][2]; ZERO_ACC(tot, 2)
#pragma unroll 1
    for (int i = 0; i < 3; ++i) {
      unsigned gpk[4][2][2];
      {
        f32x4 ag[4][2]; ZERO_ACC(ag, 2)
        const char* Ab2_ = (const char*)(H2 + (size_t)m0 * 1024); const char* Bb2_ = (const char*)(WG + (size_t)(i * 1024 + n0) * 1024);
        auto fa2 = [&](int r, int k) { return *(const uint4*)(Ab2_ + (unsigned)((r * 1024 + k) * 2)); };
        auto fb2 = [&](int r, int k) { return *(const uint4*)(Bb2_ + (unsigned)((r * 1024 + k) * 2)); };
        gemm_loop<2>(ag, fa2, fb2, 1024, (u16*)smem);
#pragma unroll
        for (int m = 0; m < 4; ++m)
#pragma unroll
          for (int n = 0; n < 2; ++n) {
            gpk[m][n][0] = pack2(sigmoidf_(ag[m][n][0]), sigmoidf_(ag[m][n][1]));
            gpk[m][n][1] = pack2(sigmoidf_(ag[m][n][2]), sigmoidf_(ag[m][n][3]));
          }
      }
      f32x4 ay[4][2]; ZERO_ACC(ay, 2)
      const u16* ya = (i == 0) ? P1 : ((i == 1) ? P1 + 1048 : P1 + 1560);
      const int lda = PS1;
      const u16* wb = WB + (size_t)i * 1024 * 512;
      const char* Ab_ = (const char*)(ya + (size_t)m0 * lda); const char* Bb_ = (const char*)(wb + (size_t)n0 * 512);
      auto fa = [&](int r, int k) { return *(const uint4*)(Ab_ + (unsigned)((r * lda + k) * 2)); };
      auto fb = [&](int r, int k) { return *(const uint4*)(Bb_ + (unsigned)((r * 512 + k) * 2)); };
      gemm_loop<2>(ay, fa, fb, 512, (u16*)smem);
#pragma unroll
      for (int m = 0; m < 4; ++m)
#pragma unroll
        for (int n = 0; n < 2; ++n) {
          tot[m][n][0] += bf2f((u16)(gpk[m][n][0] & 0xffff)) * ay[m][n][0];
          tot[m][n][1] += bf2f((u16)(gpk[m][n][0] >> 16)) * ay[m][n][1];
          tot[m][n][2] += bf2f((u16)(gpk[m][n][1] & 0xffff)) * ay[m][n][2];
          tot[m][n][3] += bf2f((u16)(gpk[m][n][1] >> 16)) * ay[m][n][3];
        }
    }
#pragma unroll
    for (int m = 0; m < 4; ++m)
#pragma unroll
      for (int n = 0; n < 2; ++n) {
        const int col = n0 + wc * 32 + n * 16 + fr;
        const int r0 = m0 + wr * 64 + m * 16 + fq * 4;
#pragma unroll
        for (int j = 0; j < 4; ++j) MG[(size_t)(r0 + j) * 1024 + col] = f2bf(tot[m][n][j]);
      }
  }
}

__device__ __forceinline__ void phase_cmp1(const Params& p, int l, char* smem) {
  const u16* P1 = (const u16*)(p.ws + OFF_P1); const u16* W1 = (const u16*)(p.ws + OFF_W1); u16* HID = (u16*)(p.ws + OFF_HID);
  const int lane = tidx() & 63, wid = tidx() >> 6, wr = wid >> 1, wc = wid & 1, fr = lane & 15, fq = lane >> 4;
  for (int tix = blockIdx.x; tix < 128; tix += gridDim.x) {
    const int which = tix >> 6, mt = (tix >> 1) & 31, nt = tix & 1;
    const int m0 = mt * 128, n0 = nt * 128;
    const float* pe = (which ? p.in[16] : p.in[13]) + (size_t)l * 2048;
    const u16* w1 = W1 + (size_t)which * 256 * 2048;
    const int cbase = 512 + which * 128;
    f32x4 acc[4][4]; ZERO_ACC(acc, 4)
    auto fa = [&](int r, int k) {
      const int row = m0 + r; const int g = row & 1, n = (row >> 1) & 255, b = row >> 9;
      uint4 o = make_uint4(0, 0, 0, 0);
      if (n < 255) {
        const int lpos = k >> 6, d = k & 63;
        uint4 raw = *(const uint4*)(P1 + (size_t)(b * 4096 + 16 * n + lpos) * PS1 + cbase + g * 64 + d);
        const float* pp = pe + lpos * 64 + d;
        float4 e0 = *(const float4*)pp, e1 = *(const float4*)(pp + 4);
        o.x = pack2(bf2f((u16)(raw.x & 0xffff)) + e0.x, bf2f((u16)(raw.x >> 16)) + e0.y);
        o.y = pack2(bf2f((u16)(raw.y & 0xffff)) + e0.z, bf2f((u16)(raw.y >> 16)) + e0.w);
        o.z = pack2(bf2f((u16)(raw.z & 0xffff)) + e1.x, bf2f((u16)(raw.z >> 16)) + e1.y);
        o.w = pack2(bf2f((u16)(raw.w & 0xffff)) + e1.z, bf2f((u16)(raw.w >> 16)) + e1.w);
      }
      return o;
    };
    auto fb = [&](int r, int k) { return *(const uint4*)(w1 + (size_t)(n0 + r) * 2048 + k); };
    gemm_loop<4>(acc, fa, fb, 2048, (u16*)smem);
#pragma unroll
    for (int m = 0; m < 4; ++m)
#pragma unroll
      for (int n = 0; n < 4; ++n) {
        const int col = n0 + wc * 64 + n * 16 + fr;
        const int r0 = m0 + wr * 64 + m * 16 + fq * 4;
#pragma unroll
        for (int j = 0; j < 4; ++j) HID[((size_t)which * 4096 + r0 + j) * 256 + col] = f2bf(siluf_(acc[m][n][j]));
      }
  }
}

__device__ __forceinline__ void phase_cmp2(const Params& p, int l) {
  const u16* HID = (const u16*)(p.ws + OFF_HID); u16* KC = (u16*)(p.ws + OFF_KC); u16* VC = (u16*)(p.ws + OFF_VC);
  const int total = 2 * 4096 * 64;
  for (int idx = blockIdx.x * 256 + tidx(); idx < total; idx += gridDim.x * 256) {
    const int d = idx & 63, row = (idx >> 6) & 4095, which = idx >> 18;
    const float* w2 = (which ? p.in[15] : p.in[12]) + (size_t)l * 256 * 64;
    const u16* hr = HID + ((size_t)which * 4096 + row) * 256;
    float acc = 0.f;
#pragma unroll 8
    for (int j = 0; j < 256; ++j) acc += bf2f(hr[j]) * w2[j * 64 + d];
    const int g = row & 1, n = (row >> 1) & 255, b = row >> 9;
    if (which == 0) KC[((size_t)(b * 2 + g) * 256 + n) * 64 + d] = f2bf(acc);
    else {
      const int u = n & 31; const int pp = 8 * ((u >> 2) & 3) + 4 * (u >> 4) + (u & 3);
      VC[((size_t)(b * 2 + g) * 64 + d) * 256 + (n & ~31) + pp] = f2bf(acc);
    }
  }
}

__device__ __forceinline__ void phase_sgu(const Params& p, int l, char* smem) {
  u16* P1 = (u16*)(p.ws + OFF_P1);
  u16* Wt = (u16*)smem;
  u16* Vt = Wt + 128 * 136;
  float* st = (float*)(Vt + 128 * 136);
  const int tid = tidx(), lane = tid & 63, wid = tid >> 6, wr = wid >> 1, wc = wid & 1, fr = lane & 15, fq = lane >> 4;
  const float* lng = p.in[17] + (size_t)l * 512; const float* lnb = p.in[18] + (size_t)l * 512;
  for (int item = blockIdx.x; item < 1024; item += gridDim.x) {
    const int ci = item >> 2, gi = item & 3;
    const int tok0 = ci * 128;
#pragma unroll 1
    for (int r0 = wid * 32; r0 < wid * 32 + 32; r0 += 8) {
      uint4 raw[8];
#pragma unroll
      for (int u = 0; u < 8; ++u) raw[u] = *(const uint4*)(P1 + (size_t)(tok0 + r0 + u) * PS1 + 1560 + lane * 8);
#pragma unroll
      for (int u = 0; u < 8; ++u) {
        float f[8];
        f[0] = bf2f((u16)(raw[u].x & 0xffff)); f[1] = bf2f((u16)(raw[u].x >> 16)); f[2] = bf2f((u16)(raw[u].y & 0xffff)); f[3] = bf2f((u16)(raw[u].y >> 16));
        f[4] = bf2f((u16)(raw[u].z & 0xffff)); f[5] = bf2f((u16)(raw[u].z >> 16)); f[6] = bf2f((u16)(raw[u].w & 0xffff)); f[7] = bf2f((u16)(raw[u].w >> 16));
        float s = 0.f, s2 = 0.f;
#pragma unroll
        for (int e = 0; e < 8; ++e) { s += f[e]; }
        s = wave_sum(s);
        const float mu = s * (1.f / 512.f);
#pragma unroll
        for (int e = 0; e < 8; ++e) { float dlt = f[e] - mu; s2 += dlt * dlt; }
        s2 = wave_sum(s2);
        if (lane == 0) { st[(r0 + u) * 2] = mu; st[(r0 + u) * 2 + 1] = rsqrtf(s2 * (1.f / 512.f) + 1e-5f); }
      }
    }
    const float* wsrc = p.in[19] + ((size_t)(l * 4 + gi)) * 128 * 128;
    for (int e = tid; e < 128 * 32; e += 256) {
      const int t = e >> 5, s4 = (e & 31) * 4;
      float4 w = *(const float4*)(wsrc + t * 128 + s4);
      uint2 o;
      o.x = pack2(s4 + 0 <= t ? w.x : 0.f, s4 + 1 <= t ? w.y : 0.f);
      o.y = pack2(s4 + 2 <= t ? w.z : 0.f, s4 + 3 <= t ? w.w : 0.f);
      *(uint2*)(Wt + t * 136 + s4) = o;
    }
    __syncthreads();
    for (int e = tid; e < 128 * 16; e += 256) {
      const int s = e >> 4, c8 = (e & 15) * 8;
      uint4 raw = *(const uint4*)(P1 + (size_t)(tok0 + s) * PS1 + 1560 + gi * 128 + c8);
      const float mu = st[s * 2], rs = st[s * 2 + 1];
      u16 rv[8] = {(u16)(raw.x & 0xffff), (u16)(raw.x >> 16), (u16)(raw.y & 0xffff), (u16)(raw.y >> 16), (u16)(raw.z & 0xffff), (u16)(raw.z >> 16), (u16)(raw.w & 0xffff), (u16)(raw.w >> 16)};
#pragma unroll
      for (int i = 0; i < 8; ++i) {
        const int c = gi * 128 + c8 + i;
        Vt[(c8 + i) * 136 + s] = f2bf((bf2f(rv[i]) - mu) * rs * lng[c] + lnb[c]);
      }
    }
    __syncthreads();
    f32x4 acc[4][4]; ZERO_ACC(acc, 4)
#pragma unroll 1
    for (int ks = 0; ks < 4; ++ks) {
      bf16x8 a[4], b[4];
#pragma unroll
      for (int m = 0; m < 4; ++m) a[m] = *(const bf16x8*)(Wt + (wr * 64 + m * 16 + fr) * 136 + ks * 32 + fq * 8);
#pragma unroll
      for (int n = 0; n < 4; ++n) b[n] = *(const bf16x8*)(Vt + (wc * 64 + n * 16 + fr) * 136 + ks * 32 + fq * 8);
#pragma unroll
      for (int m = 0; m < 4; ++m)
#pragma unroll
        for (int n = 0; n < 4; ++n) acc[m][n] = mfma16(a[m], b[n], acc[m][n]);
    }
    const float* bs = p.in[20] + ((size_t)(l * 4 + gi)) * 128;
#pragma unroll
    for (int m = 0; m < 4; ++m)
#pragma unroll
      for (int n = 0; n < 4; ++n) {
        const int c = wc * 64 + n * 16 + fr;
#pragma unroll
        for (int j = 0; j < 4; ++j) {
          const int t = wr * 64 + m * 16 + fq * 4 + j;
          u16* up = P1 + (size_t)(tok0 + t) * PS1 + 1048 + gi * 128 + c;
          *up = f2bf(bf2f(*up) * (acc[m][n][j] + bs[t]));
        }
      }
    __syncthreads();
  }
}

__device__ __forceinline__ void phase_prep1(const Params& p, int l) {
  u16* P2 = (u16*)(p.ws + OFF_P2); const u16* PB = (const u16*)(p.ws + OFF_PB); u16* VF = (u16*)(p.ws + OFF_VFIRST);
  const float* mu = p.in[21] + (size_t)l * 1792;
  const int total = 1024 * 224;
  for (int idx = blockIdx.x * 256 + tidx(); idx < total; idx += gridDim.x * 256) {
    const int tile = idx / 224, cg8 = (idx % 224) * 8;
    const int tok0 = tile * 32;
    float m8[8];
#pragma unroll
    for (int e = 0; e < 8; ++e) m8[e] = mu[cg8 + e];
    uint4 prev = make_uint4(0, 0, 0, 0);
    if ((tok0 & 4095) != 0) prev = *(const uint4*)(PB + (size_t)(tile - 1) * 1792 + cg8);
    for (int r = 0; r < 32; ++r) {
      u16* ptr = P2 + (size_t)(tok0 + r) * PS2 + cg8;
      uint4 cur = *(const uint4*)ptr;
      unsigned cu[4] = {cur.x, cur.y, cur.z, cur.w}, pu[4] = {prev.x, prev.y, prev.z, prev.w};
      float o[8];
#pragma unroll
      for (int e = 0; e < 8; ++e) {
        float c = bf2f((u16)((cu[e >> 1] >> ((e & 1) * 16)) & 0xffff));
        float pv = bf2f((u16)((pu[e >> 1] >> ((e & 1) * 16)) & 0xffff));
        float s = c + (pv - c) * m8[e];
        if (cg8 >= 1536 && cg8 < 1600) s = tanhf(s);
        else if (cg8 >= 1664) s = sigmoidf_(s);
        o[e] = s;
      }
      uint4 ov; ov.x = pack2(o[0], o[1]); ov.y = pack2(o[2], o[3]); ov.z = pack2(o[4], o[5]); ov.w = pack2(o[6], o[7]);
      *(uint4*)ptr = ov;
      if (l == 0 && cg8 >= 1024 && cg8 < 1536) *(uint4*)(VF + (size_t)(tok0 + r) * 512 + cg8 - 1024) = ov;
      prev = cur;
    }
  }
}

__device__ __forceinline__ void phase_prep2(const Params& p, int l, char* smem) {
  u16* P2 = (u16*)(p.ws + OFF_P2); const u16* VF = (const u16*)(p.ws + OFF_VFIRST);
  float* twd = (float*)smem;
  float* adl = twd + 1024;
  float* vsh = adl + 1024;
  float* lv = vsh + 8192;
  const int tid = tidx();
  const float* w0 = p.in[22] + (size_t)l * 512; const float* w2 = p.in[23] + (size_t)l * 64 * 512;
  const float* a0 = p.in[24] + (size_t)l * 512; const float* a2 = p.in[25] + (size_t)l * 64 * 512;
  const float* kkp = p.in[27] + (size_t)l * 512; const float* kap = p.in[28] + (size_t)l * 512;
  for (int item = blockIdx.x; item < 2048; item += gridDim.x) {
    const int tok0 = item * 16;
    for (int e = tid; e < 2048; e += 256) {
      const int r = e >> 7, c = e & 127;
      twd[(c >> 6) * 1024 + r * 64 + (c & 63)] = bf2f(P2[(size_t)(tok0 + r) * PS2 + 1536 + c]);
    }
    if (l > 0) {
      for (int e = tid; e < 8192; e += 256) { const int r = e >> 9, c = e & 511; vsh[e] = bf2f(P2[(size_t)(tok0 + r) * PS2 + 1024 + c]); }
    }
    __syncthreads();
    if (l > 0) {
      const float* v1 = p.in[33];
      for (int e = tid; e < 512; e += 256) {
        const int r = e >> 5, j = e & 31;
        float s = 0.f;
#pragma unroll 2
        for (int c = 0; c < 512; c += 4) {
          const float4 t4 = *(const float4*)(vsh + r * 512 + c);
          s += t4.x * v1[c * 32 + j] + t4.y * v1[(c + 1) * 32 + j] + t4.z * v1[(c + 2) * 32 + j] + t4.w * v1[(c + 3) * 32 + j];
        }
        lv[r * 32 + j] = s;
      }
      __syncthreads();
    }
#pragma unroll 1
    for (int hc = 0; hc < 2; ++hc) {
      const int ch = tid + hc * 256;
      float aw[16], aa[16];
#pragma unroll
      for (int r = 0; r < 16; ++r) { aw[r] = 0.f; aa[r] = 0.f; }
#pragma unroll 4
      for (int i = 0; i < 64; i += 4) {
        const float w20 = w2[i * 512 + ch], w21 = w2[(i + 1) * 512 + ch], w22 = w2[(i + 2) * 512 + ch], w23 = w2[(i + 3) * 512 + ch];
        const float a20 = a2[i * 512 + ch], a21 = a2[(i + 1) * 512 + ch], a22 = a2[(i + 2) * 512 + ch], a23 = a2[(i + 3) * 512 + ch];
#pragma unroll
        for (int r = 0; r < 16; ++r) {
          const float4 tw = *(const float4*)(twd + r * 64 + i);
          const float4 ta = *(const float4*)(adl + r * 64 + i);
          aw[r] += tw.x * w20 + tw.y * w21 + tw.z * w22 + tw.w * w23;
          aa[r] += ta.x * a20 + ta.y * a21 + ta.z * a22 + ta.w * a23;
        }
      }
      float am[16];
      if (l > 0) {
        const float* v2 = p.in[34];
#pragma unroll
        for (int r = 0; r < 16; ++r) am[r] = 0.f;
#pragma unroll 4
        for (int j = 0; j < 32; j += 4) {
          const float v20 = v2[j * 512 + ch], v21 = v2[(j + 1) * 512 + ch], v22 = v2[(j + 2) * 512 + ch], v23 = v2[(j + 3) * 512 + ch];
#pragma unroll
          for (int r = 0; r < 16; ++r) {
            const float4 t4 = *(const float4*)(lv + r * 32 + j);
            am[r] += t4.x * v20 + t4.y * v21 + t4.z * v22 + t4.w * v23;
          }
        }
      }
      const float w0v = w0[ch], a0v = a0[ch], kkv = kkp[ch], kav = kap[ch];
      const float v0v = (l > 0) ? p.in[32][ch] : 0.f;
#pragma unroll
      for (int r = 0; r < 16; ++r) {
        u16* row = P2 + (size_t)(tok0 + r) * PS2;
        const float kval = bf2f(row[512 + ch]);
        const float wpre = w0v + aw[r];
        const float nx = -wpre;
        const float sp = fmaxf(nx, 0.f) + log1pf(__expf(-fabsf(nx)));
        const float w = -sp - 0.5f;
        const float decay = __expf(-__expf(w));
        const float a = sigmoidf_(a0v + aa[r]);
        const float kk = kval * kkv;
        const float ss = wave_sum(kk * kk);
        const float kkn = kk / fmaxf(sqrtf(ss), 1e-12f);
        row[1792 + ch] = f2bf(decay);
        row[2304 + ch] = f2bf(kkn);
        row[2816 + ch] = f2bf(kkn * a);
        row[512 + ch] = f2bf(kval * (1.f + (a - 1.f) * kav));
        if (l > 0) {
          const float v = vsh[r * 512 + ch];
          const float vf = bf2f(VF[(size_t)(tok0 + r) * 512 + ch]);
          row[1024 + ch] = f2bf(v + (vf - v) * sigmoidf_(v0v + am[r]));
        }
      }
    }
    __syncthreads();
  }
}

__device__ __forceinline__ void scan_item(const Params& p, int item, char* smem) {
  const u16* P2 = (const u16*)(p.ws + OFF_P2); u16* YC = (u16*)(p.ws + OFF_P1) + 1560;
  float* vb = (float*)smem;
  float* yb = vb + 2 * 6 * 16 * 64;
  const int tid = tidx(), lane = tid & 63, wid = tid >> 6;
  const int rq = item & 3, h = (item >> 2) & 7, b = item >> 5;
  const int rl = lane >> 4, cq = lane & 15;
  const int rloc = wid * 4 + rl;
  const int ihead = rq * 16 + rloc;
  const int j0 = cq * 4;
  const size_t tokb = (size_t)b * 4096;
  float s0 = 0.f, s1 = 0.f, s2 = 0.f, s3 = 0.f;
  uint4 pre[3];
  auto gload = [&](int c) {
#pragma unroll
    for (int i = 0; i < 3; ++i) {
      const int v = tid + i * 256; const int vec = v >> 7, rem = v & 127, step = rem >> 3, c8 = rem & 7;
      const int off = (vec == 0) ? 0 : (vec == 1) ? 1792 : (vec == 2) ? 512 : (vec == 3) ? 1024 : (vec == 4) ? 2304 : 2816;
      pre[i] = *(const uint4*)(P2 + (tokb + c * 16 + step) * PS2 + off + h * 64 + c8 * 8);
    }
  };
  auto lstore = [&](int buf) {
#pragma unroll
    for (int i = 0; i < 3; ++i) {
      const int v = tid + i * 256; const int vec = v >> 7, rem = v & 127, step = rem >> 3, c8 = rem & 7;
      float* d = vb + ((buf * 6 + vec) * 16 + step) * 64 + c8 * 8;
      float4 f0, f1;
      f0.x = bf2f((u16)(pre[i].x & 0xffff)); f0.y = bf2f((u16)(pre[i].x >> 16)); f0.z = bf2f((u16)(pre[i].y & 0xffff)); f0.w = bf2f((u16)(pre[i].y >> 16));
      f1.x = bf2f((u16)(pre[i].z & 0xffff)); f1.y = bf2f((u16)(pre[i].z >> 16)); f1.z = bf2f((u16)(pre[i].w & 0xffff)); f1.w = bf2f((u16)(pre[i].w >> 16));
      *(float4*)d = f0; *(float4*)(d + 4) = f1;
    }
  };
  gload(0); lstore(0);
  __syncthreads();
  for (int c = 0; c < 256; ++c) {
    const int buf = c & 1;
    if (c + 1 < 256) gload(c + 1);
    const float* base = vb + buf * 6 * 16 * 64;
#pragma unroll
    for (int st = 0; st < 16; ++st) {
      const float4 r4 = *(const float4*)(base + (0 * 16 + st) * 64 + j0);
      const float4 w4 = *(const float4*)(base + (1 * 16 + st) * 64 + j0);
      const float4 k4 = *(const float4*)(base + (2 * 16 + st) * 64 + j0);
      const float vi = base[(3 * 16 + st) * 64 + ihead];
      const float4 n4 = *(const float4*)(base + (4 * 16 + st) * 64 + j0);
      const float4 b4 = *(const float4*)(base + (5 * 16 + st) * 64 + j0);
      float sa = s0 * n4.x + s1 * n4.y + s2 * n4.z + s3 * n4.w;
      sa = -dpp_sum16(sa);
      s0 = s0 * w4.x + sa * b4.x + vi * k4.x;
      s1 = s1 * w4.y + sa * b4.y + vi * k4.y;
      s2 = s2 * w4.z + sa * b4.z + vi * k4.z;
      s3 = s3 * w4.w + sa * b4.w + vi * k4.w;
      float y = s0 * r4.x + s1 * r4.y + s2 * r4.z + s3 * r4.w;
      y = dpp_sum16(y);
      yb[st * 16 + rloc] = y;
    }
    __syncthreads();
    {
      const int st = tid >> 4, r = tid & 15;
      YC[(tokb + c * 16 + st) * PS1 + h * 64 + rq * 16 + r] = f2bf(yb[st * 16 + r]);
    }
    if (c + 1 < 256) lstore(buf ^ 1);
    __syncthreads();
  }
}

__device__ __forceinline__ void phase_post(const Params& p, int l, char* smem) {
  const u16* P2 = (const u16*)(p.ws + OFF_P2); u16* YC = (u16*)(p.ws + OFF_P1) + 1560;
  float* sg = (float*)smem;
  const int tid = tidx();
  const float* g2 = p.in[26] + (size_t)l * 128 * 512;
  const float* rk = p.in[29] + (size_t)l * 512; const float* lg = p.in[30] + (size_t)l * 512; const float* lb = p.in[31] + (size_t)l * 512;
  for (int item = blockIdx.x; item < 2048; item += gridDim.x) {
    const int tok0 = item * 16;
    for (int e = tid; e < 2048; e += 256) { const int r = e >> 7, c = e & 127; sg[e] = bf2f(P2[(size_t)(tok0 + r) * PS2 + 1664 + c]); }
    __syncthreads();
#pragma unroll 1
    for (int hc = 0; hc < 2; ++hc) {
      const int ch = tid + hc * 256;
      float ag[16];
#pragma unroll
      for (int r = 0; r < 16; ++r) ag[r] = 0.f;
#pragma unroll 4
      for (int i = 0; i < 128; i += 4) {
        const float g0 = g2[i * 512 + ch], g1 = g2[(i + 1) * 512 + ch], g2v = g2[(i + 2) * 512 + ch], g3 = g2[(i + 3) * 512 + ch];
#pragma unroll
        for (int r = 0; r < 16; ++r) {
          const float4 t4 = *(const float4*)(sg + r * 128 + i);
          ag[r] += t4.x * g0 + t4.y * g1 + t4.z * g2v + t4.w * g3;
        }
      }
      const float rkv = rk[ch], lgv = lg[ch], lbv = lb[ch];
#pragma unroll
      for (int r = 0; r < 16; ++r) {
        const u16* row = P2 + (size_t)(tok0 + r) * PS2;
        const float y = bf2f(YC[(size_t)(tok0 + r) * PS1 + ch]);
        const float mean = wave_sum(y) * (1.f / 64.f);
        const float dv = y - mean;
        const float var = wave_sum(dv * dv) * (1.f / 64.f);
        const float yn = dv * rsqrtf(var + 64e-5f) * lgv + lbv;
        const float rr = bf2f(row[ch]), kk = bf2f(row[512 + ch]), vv = bf2f(row[1024 + ch]);
        const float bon = wave_sum(rr * kk * rkv) * vv;
        YC[(size_t)(tok0 + r) * PS1 + ch] = f2bf((yn + bon) * ag[r]);
      }
    }
    __syncthreads();
  }
}

#define NEGV (-1e30f)
struct AttnState { float m[2]; float ls[2]; f32x4 ot[4][2]; };

template <int MODE>
__device__ __forceinline__ void attn_scores(f32x4 (&st)[4][2], const u16* kbase, int kstride, int key0, const bf16x8 (&qf)[2][2],
                                            const float (&slope)[2], int t, bool selbit, int c16, int q4) {
#pragma unroll
  for (int mk = 0; mk < 4; ++mk) {
    const u16* kp = kbase + (size_t)(mk * 16 + c16) * kstride + q4 * 8;
    const bf16x8 k0 = *(const bf16x8*)kp, k1 = *(const bf16x8*)(kp + 32);
#pragma unroll
    for (int nq = 0; nq < 2; ++nq) {
      f32x4 a = {0.f, 0.f, 0.f, 0.f};
      a = mfma16(k0, qf[nq][0], a);
      a = mfma16(k1, qf[nq][1], a);
#pragma unroll
      for (int j = 0; j < 4; ++j) {
        const int key = key0 + mk * 16 + q4 * 4 + j;
        int dist; bool valid;
        if (MODE == 0) { dist = t - (16 * key + 31); valid = dist >= 0; }
        else if (MODE == 1) { dist = t - key; valid = (dist >= 0) && selbit; }
        else { dist = t - key; valid = (dist >= 0) && (dist < 512); }
        a[j] = valid ? (a[j] - slope[nq] * (float)dist) : NEGV;
      }
      st[mk][nq] = a;
    }
  }
}

template <int MODE>
__device__ __forceinline__ void attn_tile(AttnState& S, const u16* kbase, int kstride, const u16* vtbase, int vstride, int key0,
                                          const bf16x8 (&qf)[2][2], const float (&slope)[2], int t, bool selbit, int c16, int q4) {
  f32x4 st[4][2];
  attn_scores<MODE>(st, kbase, kstride, key0, qf, slope, t, selbit, c16, q4);
  __builtin_amdgcn_sched_barrier(0);
#pragma unroll
  for (int nq = 0; nq < 2; ++nq) {
    float mx = NEGV;
#pragma unroll
    for (int mk = 0; mk < 4; ++mk)
#pragma unroll
      for (int j = 0; j < 4; ++j) mx = fmaxf(mx, st[mk][nq][j]);
    mx = fmaxf(mx, __shfl_xor(mx, 16)); mx = fmaxf(mx, __shfl_xor(mx, 32));
    const float mnew = fmaxf(S.m[nq], mx);
    const float alpha = __expf(S.m[nq] - mnew);
    S.m[nq] = mnew;
    float ls = S.ls[nq] * alpha;
#pragma unroll
    for (int md = 0; md < 4; ++md) { S.ot[md][nq][0] *= alpha; S.ot[md][nq][1] *= alpha; S.ot[md][nq][2] *= alpha; S.ot[md][nq][3] *= alpha; }
#pragma unroll
    for (int mk = 0; mk < 4; ++mk)
#pragma unroll
      for (int j = 0; j < 4; ++j) {
        const float sv = st[mk][nq][j];
        const float pv = (sv > -1e29f) ? __expf(sv - mnew) : 0.f;
        st[mk][nq][j] = pv; ls += pv;
      }
    S.ls[nq] = ls;
  }
#pragma unroll
  for (int s2 = 0; s2 < 2; ++s2) {
    __builtin_amdgcn_sched_barrier(0);
    bf16x8 pb[2];
#pragma unroll
    for (int nq = 0; nq < 2; ++nq) {
      uint4 u;
      u.x = pack2(st[2 * s2][nq][0], st[2 * s2][nq][1]); u.y = pack2(st[2 * s2][nq][2], st[2 * s2][nq][3]);
      u.z = pack2(st[2 * s2 + 1][nq][0], st[2 * s2 + 1][nq][1]); u.w = pack2(st[2 * s2 + 1][nq][2], st[2 * s2 + 1][nq][3]);
      pb[nq] = *(bf16x8*)&u;
    }
#pragma unroll
    for (int md = 0; md < 4; ++md) {
      const bf16x8 vf = *(const bf16x8*)(vtbase + (size_t)(md * 16 + c16) * vstride + s2 * 32 + q4 * 8);
#pragma unroll
      for (int nq = 0; nq < 2; ++nq) S.ot[md][nq] = mfma16(vf, pb[nq], S.ot[md][nq]);
    }
  }
}

__device__ __forceinline__ void attn_reset(AttnState& S) {
#pragma unroll
  for (int nq = 0; nq < 2; ++nq) { S.m[nq] = NEGV; S.ls[nq] = 0.f;
#pragma unroll
    for (int md = 0; md < 4; ++md) S.ot[md][nq] = f32x4{0.f, 0.f, 0.f, 0.f}; }
}
__device__ __forceinline__ void attn_fold(AttnState& S, float* oacc, const u16* gp, int br, float (&invl)[2], int lane) {
#pragma unroll
  for (int nq = 0; nq < 2; ++nq) {
    float l = S.ls[nq];
    l += __shfl_xor(l, 16); l += __shfl_xor(l, 32);
    const float inv = (l > 0.f) ? 1.f / l : 0.f;
    invl[nq] = inv;
    const float f = bf2f(gp[nq * 6 + br]) * inv;
#pragma unroll
    for (int md = 0; md < 4; ++md)
#pragma unroll
      for (int j = 0; j < 4; ++j) {
        float* a = oacc + ((md * 2 + nq) * 4 + j) * 64 + lane;
        const float v = f * S.ot[md][nq][j];
        if (br == 0) *a = v; else *a += v;
      }
  }
}

__device__ __forceinline__ void phase_nsa(const Params& p, char* smem, unsigned* queue) {
  u16* P1 = (u16*)(p.ws + OFF_P1);
  const u16* KC = (const u16*)(p.ws + OFF_KC); const u16* VC = (const u16*)(p.ws + OFF_VC); const u16* VT = (const u16*)(p.ws + OFF_VT);
  const int tid = tidx(), lane = tid & 63, wid = tid >> 6;
  const int c16 = lane & 15, q4 = lane >> 4, tq = lane & 7;
  float* ps = (float*)smem + wid * 2048;
  float* oacc = (float*)(smem + 32768) + wid * 2048;
  int* qslot = (int*)(smem + 65536);
#pragma unroll 1
  for (;;) {
    if (tid == 0) *qslot = (int)atomicAdd(queue, 1u);
    __syncthreads();
    const int it = *qslot;
    if (it >= 2048) break;
    const int bg = it & 15;
    const int tqd = 127 - (it >> 4);
    const int b = bg >> 1, g = bg & 1;
    const int t0 = (tqd * 4 + wid) * 8;
    const int tok0 = b * 4096 + t0;
    const int t = t0 + tq;
    const int cur = t0 >> 6;
#pragma unroll
    for (int i = 0; i < 8; ++i) *(float4*)(ps + i * 256 + lane * 4) = float4{0.f, 0.f, 0.f, 0.f};
    bf16x8 qf[2][2]; float slope[2];
    const u16* gp = P1 + (size_t)(tok0 + tq) * PS1 + 1024 + (g * 4 + (c16 >> 3)) * 3;
#pragma unroll
    for (int nq = 0; nq < 2; ++nq) {
      const int hh = nq * 2 + (c16 >> 3);
      const u16* rp = P1 + (size_t)(tok0 + tq) * PS1;
      qf[nq][0] = *(const bf16x8*)(rp + (g * 4 + hh) * 64 + q4 * 8);
      qf[nq][1] = *(const bf16x8*)(rp + (g * 4 + hh) * 64 + 32 + q4 * 8);
      slope[nq] = exp2f(-(float)(g * 4 + hh + 1));
    }
    AttnState S;
    float invl[2];
    const u16* kcb = KC + (size_t)(b * 2 + g) * 256 * 64;
    const u16* vcb = VC + (size_t)(b * 2 + g) * 64 * 256;
    int ntc = 0;
    if (t0 + 7 >= 31) ntc = (((t0 + 7 - 31) >> 4) >> 6) + 1;
    attn_reset(S);
#pragma unroll 1
    for (int kt = 0; kt < ntc; ++kt) attn_tile<0>(S, kcb + (size_t)kt * 64 * 64, 64, vcb + kt * 64, 256, kt * 64, qf, slope, t, true, c16, q4);
    attn_fold(S, oacc, gp, 0, invl, lane);
#pragma unroll 1
    for (int kt = 0; kt < ntc; ++kt) {
      f32x4 st[4][2];
      attn_scores<0>(st, kcb + (size_t)kt * 64 * 64, 64, kt * 64, qf, slope, t, true, c16, q4);
#pragma unroll
      for (int mk = 0; mk < 4; ++mk) {
        f32x4 hs;
#pragma unroll
        for (int j = 0; j < 4; ++j) {
          const float a0 = st[mk][0][j], a1 = st[mk][1][j];
          const float p0 = (a0 > -1e29f) ? __expf(a0 - S.m[0]) * invl[0] : 0.f;
          const float p1 = (a1 > -1e29f) ? __expf(a1 - S.m[1]) * invl[1] : 0.f;
          float v = p0 + p1;
          v += __shfl_xor(v, 8);
          hs[j] = v;
        }
        if (c16 < 8) *(f32x4*)(ps + c16 * 256 + kt * 64 + mk * 16 + q4 * 4) = hs;
      }
    }
    __syncthreads();
    unsigned long long selm = 0ull, un = 0ull;
#pragma unroll 1
    for (int tqq = 0; tqq < 8; ++tqq) {
      const float* pr = ps + tqq * 256;
      float imp = pr[4 * lane];
      if (lane > 0) imp += pr[4 * lane - 4] + 2.f * (pr[4 * lane - 3] + pr[4 * lane - 2] + pr[4 * lane - 1]);
      const bool forced = (lane == 0) || (lane == cur) || (lane == cur - 1);
      const bool live = lane <= cur;
      const float val = forced ? 1e4f : (live ? imp : NEGV);
      int rank = 0;
#pragma unroll 8
      for (int i = 0; i < 64; ++i) {
        const float vi = __uint_as_float(__builtin_amdgcn_readlane(__float_as_uint(val), i));
        rank += ((vi > val) || (vi == val && i < lane)) ? 1 : 0;
      }
      const unsigned long long bal = __ballot((rank < 16) && live);
      if (tq == tqq) selm = bal;
      un |= bal;
    }
    __syncthreads();
    attn_reset(S);
    {
      const u16* vtb = VT + (size_t)((0 * 8 + b) * 2 + g) * 64 * 4096;
#pragma unroll 1
      for (int j = 0; j <= cur; ++j) {
        if (!((un >> j) & 1ull)) continue;
        const bool sb = (selm >> j) & 1ull;
        attn_tile<1>(S, P1 + (size_t)(b * 4096 + j * 64) * PS1 + 768 + g * 64, PS1, vtb + j * 64, 4096, j * 64, qf, slope, t, sb, c16, q4);
      }
    }
    attn_fold(S, oacc, gp, 1, invl, lane);
    attn_reset(S);
    {
      const u16* vtb = VT + (size_t)((1 * 8 + b) * 2 + g) * 64 * 4096;
      int j0 = t0 - 511; if (j0 < 0) j0 = 0; j0 >>= 6;
#pragma unroll 1
      for (int j = j0; j <= cur; ++j)
        attn_tile<2>(S, P1 + (size_t)(b * 4096 + j * 64) * PS1 + 896 + g * 64, PS1, vtb + j * 64, 4096, j * 64, qf, slope, t, true, c16, q4);
    }
    attn_fold(S, oacc, gp, 2, invl, lane);
#pragma unroll
    for (int nq = 0; nq < 2; ++nq) {
      const int hh = nq * 2 + (c16 >> 3);
      u16* rp = P1 + (size_t)(tok0 + tq) * PS1 + (g * 4 + hh) * 64;
#pragma unroll
      for (int md = 0; md < 4; ++md) {
        const float* a = oacc + ((md * 2 + nq) * 4) * 64 + lane;
        uint2 o; o.x = pack2(a[0], a[64]); o.y = pack2(a[128], a[192]);
        *(uint2*)(rp + md * 16 + q4 * 4) = o;
      }
    }
  }
}

__device__ __forceinline__ const float* modp(const Params& p, int l, int sub, int kind) {
  return (const float*)(p.ws + OFF_MOD) + (size_t)l * 8 * 9216 + sub * 3072 + kind * 1024;
}

__device__ __forceinline__ void run_phase(const Params& p, int ph, char* smem) {
  char* ws = p.ws;
  if (ph == 0) {
    if (blockIdx.x == 0) { unsigned* c = (unsigned*)(ws + OFF_CNT); for (int e = tidx(); e < 1024; e += 256) c[e] = 0u; }
    phase_mod(p, smem);
  }
  int l = 0, s = -1;
  if (ph >= 2) { l = (ph - 2) / 14; s = (ph - 2) % 14; }
  const float* preg = p.in[4] + (size_t)l * 3 * 1024; const float* postg = p.in[5] + (size_t)l * 3 * 1024;
  const bool is_norm = (ph == 1) || s == 2 || s == 10 || s == 13;
  if (is_norm) {
    const float* xin = p.out; float* xout = p.out; const u16* y = nullptr; const float* pg = nullptr; const float* gate = nullptr; float wgt = 0.f;
    const float* prg = nullptr; const float* sh = nullptr; const float* sc = nullptr; u16* h = (u16*)(ws + OFF_H);
    if (ph == 1) { xin = p.in[0]; prg = p.in[4]; sh = modp(p, 0, 0, 0); sc = modp(p, 0, 0, 1); }
    else if (s == 2) { y = (const u16*)(ws + OFF_YF); pg = postg; gate = modp(p, l, 0, 2); wgt = 0.5f; prg = preg + 1024; sh = modp(p, l, 1, 0); sc = modp(p, l, 1, 1); }
    else if (s == 10) { y = (const u16*)(ws + OFF_YM); pg = postg + 1024; gate = modp(p, l, 1, 2); wgt = 1.0f; prg = preg + 2048; sh = modp(p, l, 2, 0); sc = modp(p, l, 2, 1); }
    else { y = (const u16*)(ws + OFF_YF); pg = postg + 2048; gate = modp(p, l, 2, 2); wgt = 0.5f;
      if (l == 0) { prg = p.in[4] + 3 * 1024; sh = modp(p, 1, 0, 0); sc = modp(p, 1, 0, 1); } else { h = nullptr; } }
    phase_norm(xin, xout, y, pg, gate, wgt, prg, sh, sc, h);
  }
  {
    int cl = -1, cf = 0;
    if (ph == 0) { cl = 0; cf = 0; } else if (s == 2) { cl = l; cf = 1; } else if (s == 13 && l == 0) { cl = 1; cf = 0; }
    if (cl >= 0) conv_ffn(p, cl, cf, smem);
    if (cl >= 0 && cf == 0) conv_mix(p, cl, smem);
  }
  if (s == 0 || s == 11) phase_ffn_in(p, smem);
  if (s == 1 || s == 12 || s == 9) {
    const bool o = (s == 9);
    phase_gemm_plain((const u16*)(ws + (o ? OFF_MERGED : OFF_ACT)), o ? 1024 : DFF, (const u16*)(ws + (o ? OFF_WO : OFF_WOUT)), o ? 1024 : DFF,
                     (u16*)(ws + (o ? OFF_YM : OFF_YF)), smem);
  }
  if (s == 3) phase_inproj(p, smem);
  if (s == 4) { phase_prep1(p, l); phase_sgu(p, l, smem); phase_cmp1(p, l, smem); }
  if (s == 5) { phase_prep2(p, l, smem); phase_cmp2(p, l); }
  if (s == 6) {
    const int nb = gridDim.x;
    const int sid = (nb >= 512) ? (((int)blockIdx.x & 1) ? -1 : ((int)blockIdx.x >> 1)) : (int)blockIdx.x;
    const int sstride = (nb >= 512) ? (nb >> 1) : nb;
    if (sid >= 0) for (int it = sid; it < 256; it += sstride) scan_item(p, it, smem);
    phase_nsa(p, smem, (unsigned*)(ws + OFF_CNT) + 64 + l * 64);
  }
  if (s == 7) phase_post(p, l, smem);
  if (s == 8) phase_merge(p, smem);
}

constexpr int NPHASE = 30;

#if COOP
typedef const float* __attribute__((address_space(4))) const* kargp_t;
template <int PH>
__device__ __forceinline__ void run_seq(char* smem, cg::grid_group& grid) {
  if constexpr (PH < NPHASE) {
    {
      kargp_t ka = (kargp_t)__builtin_amdgcn_kernarg_segment_ptr();
      asm volatile("" : "+s"(ka));
      Params q;
#pragma unroll
      for (int i = 0; i < 35; ++i) q.in[i] = ka[i];
      q.out = (float*)ka[35];
      q.ws = (char*)ka[36];
      run_phase(q, PH, smem);
    }
    if constexpr (PH == 0) grid.sync();
    else if constexpr (PH + 1 < NPHASE) {
      kargp_t kb = (kargp_t)__builtin_amdgcn_kernarg_segment_ptr();
      asm volatile("" : "+s"(kb));
      gbar((unsigned*)((char*)kb[36] + OFF_CNT), (unsigned)PH * gridDim.x);
    }
    run_seq<PH + 1>(smem, grid);
  }
}

__global__ void __launch_bounds__(256, 2) mega(Params p) {
  __shared__ __attribute__((aligned(16))) char smem[SMEM_BYTES];
  cg::grid_group grid = cg::this_grid();
  run_seq<0>(smem, grid);
}
#endif

template <int PH>
__global__ void __launch_bounds__(256, 2) kph(Params p) {
  __shared__ __attribute__((aligned(16))) char smem[SMEM_BYTES];
  run_phase(p, PH, smem);
}

template <int PH>
static void launch_seq(const Params& p, int grid, hipStream_t stream) {
  if constexpr (PH < NPHASE) {
    kph<PH><<<grid, 256, 0, stream>>>(p);
    launch_seq<PH + 1>(p, grid, stream);
  }
}

extern "C" void kernel_launch(void* const* d_in, const int* in_sizes, int n_in, void* d_out, int out_size, void* d_ws, size_t ws_size,
                              hipStream_t stream) {
  static int grid_blocks = 0;
  if (!grid_blocks) {
    int dev = 0, cus = 0, per_cu = 0;
    hipGetDevice(&dev);
    hipDeviceGetAttribute(&cus, hipDeviceAttributeMultiprocessorCount, dev);
    #if COOP
    hipOccupancyMaxActiveBlocksPerMultiprocessor(&per_cu, mega, 256, 0);
#else
    per_cu = 2;
#endif
    if (per_cu > 2) per_cu = 2;
    if (per_cu < 1) per_cu = 1;
    grid_blocks = cus * per_cu;
  }
  Params p{};
  for (int i = 0; i < 35; ++i) p.in[i] = (const float*)d_in[i];
  p.out = (float*)d_out;
  p.ws = (char*)d_ws;
#if COOP
  void* args[] = {&p};
  hipError_t e = hipLaunchCooperativeKernel((void*)mega, dim3(grid_blocks), dim3(256), args, 0, stream);
  if (e != hipSuccess) fprintf(stderr, "cooperative launch failed: %s (grid %d)\n", hipGetErrorString(e), grid_blocks);
#else
  launch_seq<0>(p, grid_blocks, stream);
#endif
}
```

```cpp
#include <hip/hip_runtime.h>
#include <hip/hip_cooperative_groups.h>
#include <cstdio>
#include <cstdint>
namespace cg = cooperative_groups;

#ifndef COOP
#define COOP 1
#endif

typedef unsigned short u16;
using bf16x8 = __attribute__((ext_vector_type(8))) short;
using f32x4 = __attribute__((ext_vector_type(4))) float;

constexpr int T = 32768, D = 1024, SEQ = 4096, DFF = 2816;
constexpr int PS1 = 2072, PS2 = 3328;
constexpr int MIXC = 7192, MIXN = 4120;
constexpr size_t OFF_P1 = 0;
constexpr size_t OFF_P2 = OFF_P1 + (size_t)T * PS1 * 2;
constexpr size_t OFF_H = OFF_P2 + (size_t)T * PS2 * 2;
constexpr size_t OFF_WMIX = OFF_H + (size_t)T * 1024 * 2;
constexpr size_t OFF_WG = OFF_WMIX + (size_t)4224 * 1024 * 2;
constexpr size_t OFF_WB = OFF_WG + (size_t)3072 * 1024 * 2;
constexpr size_t OFF_WO = OFF_WB + (size_t)3 * 1024 * 512 * 2;
constexpr size_t OFF_W1 = OFF_WO + (size_t)1024 * 1024 * 2;
constexpr size_t OFF_WIN = OFF_W1 + (size_t)2 * 256 * 2048 * 2;
constexpr size_t OFF_WOUT = OFF_WIN + (size_t)5632 * 1024 * 2;
constexpr size_t OFF_VFIRST = OFF_WOUT + (size_t)1024 * 2816 * 2;
constexpr size_t OFF_VT = OFF_VFIRST + (size_t)T * 512 * 2;
constexpr size_t OFF_MOD = OFF_VT + (size_t)2 * 8 * 2 * 64 * 4096 * 2;
constexpr size_t OFF_PB = OFF_MOD + (size_t)2 * 8 * 9216 * 4;
constexpr size_t OFF_HID = OFF_PB + (size_t)1024 * 1792 * 2;
constexpr size_t OFF_KC = OFF_HID + (size_t)2 * 4096 * 256 * 2;
constexpr size_t OFF_VC = OFF_KC + (size_t)8 * 2 * 256 * 64 * 2;
constexpr size_t OFF_LV = OFF_VC + (size_t)8 * 2 * 64 * 256 * 2;
constexpr size_t OFF_CNT = OFF_LV + (size_t)T * 32 * 4;
constexpr size_t WS_END = OFF_CNT + 4096;
constexpr size_t OFF_ACT = OFF_P1;
constexpr size_t OFF_YF = OFF_ACT + (size_t)T * DFF * 2;
constexpr size_t OFF_H2 = OFF_P2;
constexpr size_t OFF_MERGED = OFF_P2;
constexpr size_t OFF_YM = OFF_MERGED + (size_t)T * 1024 * 2;
constexpr size_t OFF_YC = OFF_H;

constexpr int SMEM_BYTES = 73728;

struct Params { const float* in[35]; float* out; char* ws; };

__device__ __forceinline__ int tidx() { int t = __builtin_amdgcn_workitem_id_x(); asm volatile("" : "+v"(t)); return t; }
__device__ __forceinline__ void gbar(unsigned* cnt, unsigned target) {
  asm volatile("s_waitcnt vmcnt(0) lgkmcnt(0)" ::: "memory");
  __syncthreads();
  if (tidx() == 0) {
    __builtin_amdgcn_fence(__ATOMIC_RELEASE, "agent");
    asm volatile("s_waitcnt vmcnt(0)" ::: "memory");
    __hip_atomic_fetch_add(cnt, 1u, __ATOMIC_RELAXED, __HIP_MEMORY_SCOPE_AGENT);
    while (__hip_atomic_load(cnt, __ATOMIC_RELAXED, __HIP_MEMORY_SCOPE_AGENT) < target) __builtin_amdgcn_s_sleep(1);
    __builtin_amdgcn_fence(__ATOMIC_ACQUIRE, "agent");
    asm volatile("s_waitcnt vmcnt(0)" ::: "memory");
  }
  __syncthreads();
}
__device__ __forceinline__ float dpp_sum16(float v) {
  v += __int_as_float(__builtin_amdgcn_update_dpp(0, __float_as_int(v), 0xB1, 0xF, 0xF, true));
  v += __int_as_float(__builtin_amdgcn_update_dpp(0, __float_as_int(v), 0x4E, 0xF, 0xF, true));
  v += __int_as_float(__builtin_amdgcn_update_dpp(0, __float_as_int(v), 0x141, 0xF, 0xF, true));
  v += __int_as_float(__builtin_amdgcn_update_dpp(0, __float_as_int(v), 0x140, 0xF, 0xF, true));
  return v;
}
__device__ __forceinline__ float bf2f(u16 u) { return __uint_as_float(((unsigned)u) << 16); }
__device__ __forceinline__ u16 f2bf(float f) { __bf16 r = (__bf16)f; return *(u16*)&r; }
typedef __attribute__((ext_vector_type(2))) float f2_t;
typedef __attribute__((ext_vector_type(2))) __bf16 b2_t;
__device__ __forceinline__ unsigned pack2(float a, float b) { f2_t v = {a, b}; b2_t r = __builtin_convertvector(v, b2_t); return *(unsigned*)&r; }
__device__ __forceinline__ float sigmoidf_(float x) { return 1.f / (1.f + __expf(-x)); }
__device__ __forceinline__ float siluf_(float x) { return x / (1.f + __expf(-x)); }
__device__ __forceinline__ float geluf_(float x) { float u = 0.7978845608028654f * (x + 0.044715f * x * x * x); return 0.5f * x * (1.f + tanhf(u)); }
__device__ __forceinline__ float wave_sum(float v) {
#pragma unroll
  for (int o = 32; o >= 1; o >>= 1) v += __shfl_xor(v, o);
  return v;
}
__device__ __forceinline__ f32x4 mfma16(bf16x8 a, bf16x8 b, f32x4 c) { return __builtin_amdgcn_mfma_f32_16x16x32_bf16(a, b, c, 0, 0, 0); }

__device__ __forceinline__ void conv_w(const float* src, int ld, int K, u16* dst, int NR, int nvalid, int coff, int kind, char* smem) {
  float* tl = (float*)smem;
  const int tid = tidx();
  const int ktn = K >> 6, ntile = (NR >> 6) * ktn;
  for (int tix = blockIdx.x; tix < ntile; tix += gridDim.x) {
    const int R0 = (tix / ktn) << 6, k0 = (tix % ktn) << 6;
    const int c = tid & 63, kq = tid >> 6;
    const int R = R0 + c;
    int sc; bool ok;
    if (kind == 0) { sc = coff + R; ok = R < nvalid; }
    else { int ntl = R >> 7, w = (R >> 6) & 1, n = (R >> 4) & 3, r = R & 15; sc = ((n >= 2) ? DFF : 0) + ntl * 64 + w * 32 + (n & 1) * 16 + r; ok = true; }
#pragma unroll 4
    for (int i = 0; i < 16; ++i) {
      int k = k0 + kq * 16 + i;
      tl[c * 65 + kq * 16 + i] = ok ? src[(size_t)k * ld + sc] : 0.f;
    }
    __syncthreads();
    {
      const int r = tid >> 2, ks = tid & 3;
      const float* s = tl + r * 65 + ks * 16;
      uint4 o0, o1;
      o0.x = pack2(s[0], s[1]); o0.y = pack2(s[2], s[3]); o0.z = pack2(s[4], s[5]); o0.w = pack2(s[6], s[7]);
      o1.x = pack2(s[8], s[9]); o1.y = pack2(s[10], s[11]); o1.z = pack2(s[12], s[13]); o1.w = pack2(s[14], s[15]);
      uint4* dp = (uint4*)(dst + (size_t)(R0 + r) * K + k0 + ks * 16);
      dp[0] = o0; dp[1] = o1;
    }
    __syncthreads();
  }
}

__device__ __forceinline__ void conv_ffn(const Params& p, int l, int f, char* smem) {
  conv_w(p.in[6] + (size_t)(l * 2 + f) * D * (2 * DFF), 2 * DFF, D, (u16*)(p.ws + OFF_WIN), 5632, 5632, 0, 1, smem);
  conv_w(p.in[7] + (size_t)(l * 2 + f) * DFF * D, D, DFF, (u16*)(p.ws + OFF_WOUT), 1024, 1024, 0, 0, smem);
}
__device__ __forceinline__ void conv_mix(const Params& p, int l, char* smem) {
  const float* mw = p.in[8] + (size_t)l * D * MIXC;
  conv_w(mw, MIXC, D, (u16*)(p.ws + OFF_WMIX), 4224, MIXN, 0, 0, smem);
  conv_w(mw, MIXC, D, (u16*)(p.ws + OFF_WG), 3072, 3072, MIXN, 0, smem);
  for (int i = 0; i < 3; ++i)
    conv_w(p.in[9] + (size_t)(l * 3 + i) * 512 * D, D, 512, (u16*)(p.ws + OFF_WB) + (size_t)i * 1024 * 512, 1024, 1024, 0, 0, smem);
  conv_w(p.in[10] + (size_t)l * D * D, D, D, (u16*)(p.ws + OFF_WO), 1024, 1024, 0, 0, smem);
  conv_w(p.in[11] + (size_t)l * 2048 * 256, 256, 2048, (u16*)(p.ws + OFF_W1), 256, 256, 0, 0, smem);
  conv_w(p.in[14] + (size_t)l * 2048 * 256, 256, 2048, (u16*)(p.ws + OFF_W1) + (size_t)256 * 2048, 256, 256, 0, 0, smem);
}

__device__ __forceinline__ void phase_mod(const Params& p, char* smem) {
  float* cond = (float*)smem;
  float* red = cond + 8192;
  const int tid = tidx();
  float* MOD = (float*)(p.ws + OFF_MOD);
  for (int item = blockIdx.x; item < 288; item += gridDim.x) {
    for (int e = tid; e < 8192; e += 256) cond[e] = siluf_(p.in[1][e]);
    __syncthreads();
    const int l = item / 144, n0 = (item % 144) * 64, col = n0 + (tid & 63), kq = tid >> 6;
    float acc[8];
#pragma unroll
    for (int b = 0; b < 8; ++b) acc[b] = 0.f;
    const float* w = p.in[2] + (size_t)l * D * 9216 + col;
#pragma unroll 4
    for (int k = kq * 256; k < kq * 256 + 256; ++k) {
      float wv = w[(size_t)k * 9216];
#pragma unroll
      for (int b = 0; b < 8; ++b) acc[b] += cond[b * 1024 + k] * wv;
    }
#pragma unroll
    for (int b = 0; b < 8; ++b) red[(kq * 8 + b) * 64 + (tid & 63)] = acc[b];
    __syncthreads();
    for (int e = tid; e < 512; e += 256) {
      int b = e >> 6, c = e & 63;
      float s = red[(0 * 8 + b) * 64 + c] + red[(1 * 8 + b) * 64 + c] + red[(2 * 8 + b) * 64 + c] + red[(3 * 8 + b) * 64 + c];
      MOD[(size_t)(l * 8 + b) * 9216 + n0 + c] = s + p.in[3][(size_t)l * 9216 + n0 + c];
    }
    __syncthreads();
  }
}

__device__ __forceinline__ void phase_norm(const float* xin, float* xout, const u16* y, const float* postg, const float* gate, float wgt,
                           const float* preg, const float* shift, const float* scale, u16* h) {
  const int lane = tidx() & 63, wid = tidx() >> 6;
  for (int row = blockIdx.x * 4 + wid; row < T; row += gridDim.x * 4) {
    const int b = row >> 12;
    float4 xv[4];
#pragma unroll
    for (int i = 0; i < 4; ++i) xv[i] = *(const float4*)(xin + (size_t)row * D + i * 256 + lane * 4);
    if (y) {
      float yv[4][4]; float ss = 0.f;
#pragma unroll
      for (int i = 0; i < 4; ++i) {
        uint2 u = *(const uint2*)(y + (size_t)row * D + i * 256 + lane * 4);
        yv[i][0] = bf2f((u16)(u.x & 0xffff)); yv[i][1] = bf2f((u16)(u.x >> 16));
        yv[i][2] = bf2f((u16)(u.y & 0xffff)); yv[i][3] = bf2f((u16)(u.y >> 16));
        ss += yv[i][0] * yv[i][0] + yv[i][1] * yv[i][1] + yv[i][2] * yv[i][2] + yv[i][3] * yv[i][3];
      }
      ss = wave_sum(ss);
      const float rs = rsqrtf(ss * (1.f / 1024.f) + 1e-6f) * wgt;
#pragma unroll
      for (int i = 0; i < 4; ++i) {
        const int c = i * 256 + lane * 4;
        float4 g = *(const float4*)(gate + (size_t)b * 9216 + c);
        float4 pg = *(const float4*)(postg + c);
        xv[i].x += g.x * yv[i][0] * rs * pg.x; xv[i].y += g.y * yv[i][1] * rs * pg.y;
        xv[i].z += g.z * yv[i][2] * rs * pg.z; xv[i].w += g.w * yv[i][3] * rs * pg.w;
      }
    }
    if (xout) {
#pragma unroll
      for (int i = 0; i < 4; ++i) *(float4*)(xout + (size_t)row * D + i * 256 + lane * 4) = xv[i];
    }
    if (h) {
      float ss = 0.f;
#pragma unroll
      for (int i = 0; i < 4; ++i) ss += xv[i].x * xv[i].x + xv[i].y * xv[i].y + xv[i].z * xv[i].z + xv[i].w * xv[i].w;
      ss = wave_sum(ss);
      const float rs = rsqrtf(ss * (1.f / 1024.f) + 1e-6f);
#pragma unroll
      for (int i = 0; i < 4; ++i) {
        const int c = i * 256 + lane * 4;
        float4 pg = *(const float4*)(preg + c);
        float4 sh = *(const float4*)(shift + (size_t)b * 9216 + c);
        float4 sc = *(const float4*)(scale + (size_t)b * 9216 + c);
        uint2 o;
        o.x = pack2(xv[i].x * rs * pg.x * (1.f + sc.x) + sh.x, xv[i].y * rs * pg.y * (1.f + sc.y) + sh.y);
        o.y = pack2(xv[i].z * rs * pg.z * (1.f + sc.z) + sh.z, xv[i].w * rs * pg.w * (1.f + sc.w) + sh.w);
        *(uint2*)(h + (size_t)row * D + c) = o;
      }
    }
  }
}

template <int NS, class FA, class FB>
__device__ __forceinline__ void gemm_loop(f32x4 (&acc)[4][NS], const FA& fa, const FB& fb, int K, u16* sm) {
  constexpr int BN = 32 * NS;
  constexpr int NBV = BN / 32;
  const int tid = tidx(), lane = tid & 63, wid = tid >> 6, wr = wid >> 1, wc = wid & 1, fr = lane & 15, fq = lane >> 4;
  u16* As = sm; u16* Bs = sm + 2 * 128 * 64;
  uint4 ra0[4], rb0[NBV], ra1[4], rb1[NBV];
  const int nt = K >> 6;
  const int lrow = tid >> 3, lk = (tid & 7) * 8;
  const int lsw = lrow * 64 + (((tid & 7) ^ ((lrow >> 1) & 7)) << 3);
  const int c0 = (fq ^ ((fr >> 1) & 7)) << 3, c1 = c0 ^ 32;
#define G_LOAD(RA, RB, KT) { const int kb_ = (KT) << 6; \
    _Pragma("unroll") for (int i = 0; i < 4; ++i) RA[i] = fa(lrow + 32 * i, kb_ + lk); \
    _Pragma("unroll") for (int i = 0; i < NBV; ++i) RB[i] = fb(lrow + 32 * i, kb_ + lk); }
#define G_STORE(RA, RB, BUF) { u16* Aw_ = As + (BUF) * 128 * 64 + lsw; u16* Bw_ = Bs + (BUF) * BN * 64 + lsw; \
    _Pragma("unroll") for (int i = 0; i < 4; ++i) *(uint4*)(Aw_ + i * 32 * 64) = RA[i]; \
    _Pragma("unroll") for (int i = 0; i < NBV; ++i) *(uint4*)(Bw_ + i * 32 * 64) = RB[i]; }
#define G_COMPUTE(BUF) { const u16* Ab = As + (BUF) * 128 * 64 + (wr * 64 + fr) * 64; \
    const u16* Bb = Bs + (BUF) * BN * 64 + (wc * 16 * NS + fr) * 64; \
    _Pragma("unroll") for (int ks = 0; ks < 2; ++ks) { bf16x8 a[4], b[NS]; const int co = ks ? c1 : c0; \
      _Pragma("unroll") for (int m = 0; m < 4; ++m) a[m] = *(const bf16x8*)(Ab + m * 16 * 64 + co); \
      _Pragma("unroll") for (int n = 0; n < NS; ++n) b[n] = *(const bf16x8*)(Bb + n * 16 * 64 + co); \
      _Pragma("unroll") for (int m = 0; m < 4; ++m) _Pragma("unroll") for (int n = 0; n < NS; ++n) acc[m][n] = mfma16(a[m], b[n], acc[m][n]); } }
  G_LOAD(ra0, rb0, 0)
  if (nt > 1) G_LOAD(ra1, rb1, 1)
  G_STORE(ra0, rb0, 0)
  __syncthreads();
#pragma unroll 1
  for (int kt = 0; kt < nt; kt += 2) {
    if (kt + 2 < nt) G_LOAD(ra0, rb0, kt + 2)
    G_COMPUTE(0)
    if (kt + 1 < nt) G_STORE(ra1, rb1, 1)
    __syncthreads();
    if (kt + 1 >= nt) break;
    if (kt + 3 < nt) G_LOAD(ra1, rb1, kt + 3)
    G_COMPUTE(1)
    if (kt + 2 < nt) G_STORE(ra0, rb0, 0)
    __syncthreads();
  }
#undef G_LOAD
#undef G_STORE
#undef G_COMPUTE
}

__device__ __forceinline__ bool tile_map(int it, int NT, int& mt, int& nt) {
  const int g = gridDim.x;
  if ((g & 7) == 0) {
    const int xcd = blockIdx.x & 7, bx = blockIdx.x >> 3, nbx = g >> 3;
    const int lid = bx + it * nbx;
    if (lid >= 32 * NT) return false;
    const int grp = lid / (8 * NT), rem = lid - grp * 8 * NT;
    nt = rem >> 3; mt = xcd * 32 + grp * 8 + (rem & 7);
    return true;
  } else {
    const int id = blockIdx.x + it * g;
    if (id >= 256 * NT) return false;
    nt = id % NT; mt = id / NT;
    return true;
  }
}

#define ZERO_ACC(acc, NSV) _Pragma("unroll") for (int m_ = 0; m_ < 4; ++m_) _Pragma("unroll") for (int n_ = 0; n_ < NSV; ++n_) acc[m_][n_] = f32x4{0.f, 0.f, 0.f, 0.f};

__device__ __forceinline__ void phase_ffn_in(const Params& p, char* smem) {
  const u16* H = (const u16*)(p.ws + OFF_H); const u16* W = (const u16*)(p.ws + OFF_WIN); u16* ACT = (u16*)(p.ws + OFF_ACT);
  const int lane = tidx() & 63, wid = tidx() >> 6, wr = wid >> 1, wc = wid & 1, fr = lane & 15, fq = lane >> 4;
  int mt, nt;
  for (int it = 0; tile_map(it, 44, mt, nt); ++it) {
    const int m0 = mt * 128, n0 = nt * 128;
    f32x4 acc[4][4]; ZERO_ACC(acc, 4)
    const char* Ab_ = (const char*)(H + (size_t)m0 * 1024); const char* Bb_ = (const char*)(W + (size_t)n0 * 1024);
    auto fa = [&](int r, int k) { return *(const uint4*)(Ab_ + (unsigned)((r * 1024 + k) * 2)); };
    auto fb = [&](int r, int k) { return *(const uint4*)(Bb_ + (unsigned)((r * 1024 + k) * 2)); };
    gemm_loop<4>(acc, fa, fb, 1024, (u16*)smem);
#pragma unroll
    for (int m = 0; m < 4; ++m)
#pragma unroll
      for (int n = 0; n < 2; ++n) {
        const int col = nt * 64 + wc * 32 + n * 16 + fr;
        const int r0 = m0 + wr * 64 + m * 16 + fq * 4;
#pragma unroll
        for (int j = 0; j < 4; ++j) ACT[(size_t)(r0 + j) * DFF + col] = f2bf(siluf_(acc[m][n][j]) * acc[m][n + 2][j]);
      }
  }
}

__device__ __forceinline__ void phase_gemm_plain(const u16* A, int lda, const u16* Bt, int K, u16* C, char* smem) {
  const int lane = tidx() & 63, wid = tidx() >> 6, wr = wid >> 1, wc = wid & 1, fr = lane & 15, fq = lane >> 4;
  int mt, nt;
  for (int it = 0; tile_map(it, 8, mt, nt); ++it) {
    const int m0 = mt * 128, n0 = nt * 128;
    f32x4 acc[4][4]; ZERO_ACC(acc, 4)
    const char* Ab_ = (const char*)(A + (size_t)m0 * lda); const char* Bb_ = (const char*)(Bt + (size_t)n0 * K);
    auto fa = [&](int r, int k) { return *(const uint4*)(Ab_ + (unsigned)((r * lda + k) * 2)); };
    auto fb = [&](int r, int k) { return *(const uint4*)(Bb_ + (unsigned)((r * K + k) * 2)); };
    gemm_loop<4>(acc, fa, fb, K, (u16*)smem);
#pragma unroll
    for (int m = 0; m < 4; ++m)
#pragma unroll
      for (int n = 0; n < 4; ++n) {
        const int col = n0 + wc * 64 + n * 16 + fr;
        const int r0 = m0 + wr * 64 + m * 16 + fq * 4;
#pragma unroll
        for (int j = 0; j < 4; ++j) C[(size_t)(r0 + j) * 1024 + col] = f2bf(acc[m][n][j]);
      }
  }
}

__device__ __forceinline__ void phase_inproj(const Params& p, char* smem) {
  const u16* H = (const u16*)(p.ws + OFF_H); const u16* W = (const u16*)(p.ws + OFF_WMIX);
  u16* P1 = (u16*)(p.ws + OFF_P1); u16* P2 = (u16*)(p.ws + OFF_P2); u16* VT = (u16*)(p.ws + OFF_VT); u16* PB = (u16*)(p.ws + OFF_PB);
  const int lane = tidx() & 63, wid = tidx() >> 6, wr = wid >> 1, wc = wid & 1, fr = lane & 15, fq = lane >> 4;
  int mt, nt;
  for (int it = 0; tile_map(it, 33, mt, nt); ++it) {
    const int m0 = mt * 128, n0 = nt * 128;
    f32x4 acc[4][4]; ZERO_ACC(acc, 4)
    const char* Ab_ = (const char*)(H + (size_t)m0 * 1024); const char* Bb_ = (const char*)(W + (size_t)n0 * 1024);
    auto fa = [&](int r, int k) { return *(const uint4*)(Ab_ + (unsigned)((r * 1024 + k) * 2)); };
    auto fb = [&](int r, int k) { return *(const uint4*)(Bb_ + (unsigned)((r * 1024 + k) * 2)); };
    gemm_loop<4>(acc, fa, fb, 1024, (u16*)smem);
#pragma unroll
    for (int m = 0; m < 4; ++m)
#pragma unroll
      for (int nn = 0; nn < 4; ++nn) {
        const int n = n0 + wc * 64 + nn * 16 + fr;
        if (n >= MIXN) continue;
        const int r0 = m0 + wr * 64 + m * 16 + fq * 4;
        f32x4 v = acc[m][nn];
        if ((n >= 896 && n < 1024) || (n >= 1152 && n < 1280)) {
          const int which = (n >= 1152) ? 1 : 0;
          const int gd = n - (which ? 1152 : 896);
          const int b = r0 >> 12, t = r0 & 4095;
          uint2 o; o.x = pack2(v[0], v[1]); o.y = pack2(v[2], v[3]);
          *(uint2*)(VT + ((size_t)((which * 8 + b) * 128 + gd)) * 4096 + (t & ~31) + 8 * fq + 4 * (m & 1)) = o;
        } else if (n < 1304) {
          const int pc = (n < 896) ? n : ((n < 1152) ? n - 128 : n - 256);
          if (n < 512) { v[0] *= 0.125f; v[1] *= 0.125f; v[2] *= 0.125f; v[3] *= 0.125f; }
          if (n >= 1280) { v[0] = sigmoidf_(v[0]); v[1] = sigmoidf_(v[1]); v[2] = sigmoidf_(v[2]); v[3] = sigmoidf_(v[3]); }
#pragma unroll
          for (int j = 0; j < 4; ++j) P1[(size_t)(r0 + j) * PS1 + pc] = f2bf(v[j]);
        } else if (n < 2328) {
#pragma unroll
          for (int j = 0; j < 4; ++j) P1[(size_t)(r0 + j) * PS1 + (n - 256)] = f2bf(geluf_(v[j]));
        } else {
          const int pc = n - 2328;
#pragma unroll
          for (int j = 0; j < 4; ++j) P2[(size_t)(r0 + j) * PS2 + pc] = f2bf(v[j]);
          if ((m & 1) && fq == 3) PB[(size_t)((r0 + 3) >> 5) * 1792 + pc] = f2bf(v[3]);
        }
      }
  }
}

__device__ __forceinline__ void phase_merge(const Params& p, char* smem) {
  const u16* H2 = (const u16*)(p.ws + OFF_H); const u16* WG = (const u16*)(p.ws + OFF_WG); const u16* WB = (const u16*)(p.ws + OFF_WB);
  const u16* P1 = (const u16*)(p.ws + OFF_P1); u16* MG = (u16*)(p.ws + OFF_MERGED);
  const int lane = tidx() & 63, wid = tidx() >> 6, wr = wid >> 1, wc = wid & 1, fr = lane & 15, fq = lane >> 4;
  int mt, nt;
  for (int it = 0; tile_map(it, 16, mt, nt); ++it) {
    const int m0 = mt * 128, n0 = nt * 64;
    f32x4 tot[4][2]; ZERO_ACC(tot, 2)
#pragma unroll 1
    for (int i = 0; i < 3; ++i) {
      unsigned gpk[4][2][2];
      {
        f32x4 ag[4][2]; ZERO_ACC(ag, 2)
        const char* Ab2_ = (const char*)(H2 + (size_t)m0 * 1024); const char* Bb2_ = (const char*)(WG + (size_t)(i * 1024 + n0) * 1024);
        auto fa2 = [&](int r, int k) { return *(const uint4*)(Ab2_ + (unsigned)((r * 1024 + k) * 2)); };
        auto fb2 = [&](int r, int k) { return *(const uint4*)(Bb2_ + (unsigned)((r * 1024 + k) * 2)); };
        gemm_loop<2>(ag, fa2, fb2, 1024, (u16*)smem);
#pragma unroll
        for (int m = 0; m < 4; ++m)
#pragma unroll
          for (int n = 0; n < 2; ++n) {
            gpk[m][n][0] = pack2(sigmoidf_(ag[m][n][0]), sigmoidf_(ag[m][n][1]));
            gpk[m][n][1] = pack2(sigmoidf_(ag[m][n][2]), sigmoidf_(ag[m][n][3]));
          }
      }
      f32x4 ay[4][2]; ZERO_ACC(ay, 2)
      const u16* ya = (i == 0) ? P1 : ((i == 1) ? P1 + 1048 : P1 + 1560);
      const int lda = PS1;
      const u16* wb = WB + (size_t)i * 1024 * 512;
      const char* Ab_ = (const char*)(ya + (size_t)m0 * lda); const char* Bb_ = (const char*)(wb + (size_t)n0 * 512);
      auto fa = [&](int r, int k) { return *(const uint4*)(Ab_ + (unsigned)((r * lda + k) * 2)); };
      auto fb = [&](int r, int k) { return *(const uint4*)(Bb_ + (unsigned)((r * 512 + k) * 2)); };
      gemm_loop<2>(ay, fa, fb, 512, (u16*)smem);
#pragma unroll
      for (int m = 0; m < 4; ++m)
#pragma unroll
        for (int n = 0; n < 2; ++n) {
          tot[m][n][0] += bf2f((u16)(gpk[m][n][0] & 0xffff)) * ay[m][n][0];
          tot[m][n][1] += bf2f((u16)(gpk[m][n][0] >> 16)) * ay[m][n][1];
          tot[m][n][2] += bf2f((u16)(gpk[m][n][1] & 0xffff)) * ay[m][n][2];
          tot[m][n][3] += bf2f((u16)(gpk[m][n][1] >> 16)) * ay[m][n][3];
        }
    }
#pragma unroll
    for (int m = 0; m < 4; ++m)
#pragma unroll
      for (int n = 0; n < 2; ++n) {
        const int col = n0 + wc * 32 + n * 16 + fr;
        const int r0 = m0 + wr * 64 + m * 16 + fq * 4;
#pragma unroll
        for (int j = 0; j < 4; ++j) MG[(size_t)(r0 + j) * 1024 + col] = f2bf(tot[m][n][j]);
      }
  }
}

__device__ __forceinline__ void phase_cmp1(const Params& p, int l, char* smem) {
  const u16* P1 = (const u16*)(p.ws + OFF_P1); const u16* W1 = (const u16*)(p.ws + OFF_W1); u16* HID = (u16*)(p.ws + OFF_HID);
  const int lane = tidx() & 63, wid = tidx() >> 6, wr = wid >> 1, wc = wid & 1, fr = lane & 15, fq = lane >> 4;
  for (int tix = blockIdx.x; tix < 128; tix += gridDim.x) {
    const int which = tix >> 6, mt = (tix >> 1) & 31, nt = tix & 1;
    const int m0 = mt * 128, n0 = nt * 128;
    const float* pe = (which ? p.in[16] : p.in[13]) + (size_t)l * 2048;
    const u16* w1 = W1 + (size_t)which * 256 * 2048;
    const int cbase = 512 + which * 128;
    f32x4 acc[4][4]; ZERO_ACC(acc, 4)
    auto fa = [&](int r, int k) {
      const int row = m0 + r; const int g = row & 1, n = (row >> 1) & 255, b = row >> 9;
      uint4 o = make_uint4(0, 0, 0, 0);
      if (n < 255) {
        const int lpos = k >> 6, d = k & 63;
        uint4 raw = *(const uint4*)(P1 + (size_t)(b * 4096 + 16 * n + lpos) * PS1 + cbase + g * 64 + d);
        const float* pp = pe + lpos * 64 + d;
        float4 e0 = *(const float4*)pp, e1 = *(const float4*)(pp + 4);
        o.x = pack2(bf2f((u16)(raw.x & 0xffff)) + e0.x, bf2f((u16)(raw.x >> 16)) + e0.y);
        o.y = pack2(bf2f((u16)(raw.y & 0xffff)) + e0.z, bf2f((u16)(raw.y >> 16)) + e0.w);
        o.z = pack2(bf2f((u16)(raw.z & 0xffff)) + e1.x, bf2f((u16)(raw.z >> 16)) + e1.y);
        o.w = pack2(bf2f((u16)(raw.w & 0xffff)) + e1.z, bf2f((u16)(raw.w >> 16)) + e1.w);
      }
      return o;
    };
    auto fb = [&](int r, int k) { return *(const uint4*)(w1 + (size_t)(n0 + r) * 2048 + k); };
    gemm_loop<4>(acc, fa, fb, 2048, (u16*)smem);
#pragma unroll
    for (int m = 0; m < 4; ++m)
#pragma unroll
      for (int n = 0; n < 4; ++n) {
        const int col = n0 + wc * 64 + n * 16 + fr;
        const int r0 = m0 + wr * 64 + m * 16 + fq * 4;
#pragma unroll
        for (int j = 0; j < 4; ++j) HID[((size_t)which * 4096 + r0 + j) * 256 + col] = f2bf(siluf_(acc[m][n][j]));
      }
  }
}

__device__ __forceinline__ void phase_cmp2(const Params& p, int l) {
  const u16* HID = (const u16*)(p.ws + OFF_HID); u16* KC = (u16*)(p.ws + OFF_KC); u16* VC = (u16*)(p.ws + OFF_VC);
  const int total = 2 * 4096 * 64;
  for (int idx = blockIdx.x * 256 + tidx(); idx < total; idx += gridDim.x * 256) {
    const int d = idx & 63, row = (idx >> 6) & 4095, which = idx >> 18;
    const float* w2 = (which ? p.in[15] : p.in[12]) + (size_t)l * 256 * 64;
    const u16* hr = HID + ((size_t)which * 4096 + row) * 256;
    float acc = 0.f;
#pragma unroll 8
    for (int j = 0; j < 256; ++j) acc += bf2f(hr[j]) * w2[j * 64 + d];
    const int g = row & 1, n = (row >> 1) & 255, b = row >> 9;
    if (which == 0) KC[((size_t)(b * 2 + g) * 256 + n) * 64 + d] = f2bf(acc);
    else {
      const int u = n & 31; const int pp = 8 * ((u >> 2) & 3) + 4 * (u >> 4) + (u & 3);
      VC[((size_t)(b * 2 + g) * 64 + d) * 256 + (n & ~31) + pp] = f2bf(acc);
    }
  }
}

__device__ __forceinline__ void phase_sgu(const Params& p, int l, char* smem) {
  u16* P1 = (u16*)(p.ws + OFF_P1);
  u16* Wt = (u16*)smem;
  u16* Vt = Wt + 128 * 136;
  float* st = (float*)(Vt + 128 * 136);
  const int tid = tidx(), lane = tid & 63, wid = tid >> 6, wr = wid >> 1, wc = wid & 1, fr = lane & 15, fq = lane >> 4;
  const float* lng = p.in[17] + (size_t)l * 512; const float* lnb = p.in[18] + (size_t)l * 512;
  for (int item = blockIdx.x; item < 1024; item += gridDim.x) {
    const int ci = item >> 2, gi = item & 3;
    const int tok0 = ci * 128;
#pragma unroll 1
    for (int r0 = wid * 32; r0 < wid * 32 + 32; r0 += 8) {
      uint4 raw[8];
#pragma unroll
      for (int u = 0; u < 8; ++u) raw[u] = *(const uint4*)(P1 + (size_t)(tok0 + r0 + u) * PS1 + 1560 + lane * 8);
#pragma unroll
      for (int u = 0; u < 8; ++u) {
        float f[8];
        f[0] = bf2f((u16)(raw[u].x & 0xffff)); f[1] = bf2f((u16)(raw[u].x >> 16)); f[2] = bf2f((u16)(raw[u].y & 0xffff)); f[3] = bf2f((u16)(raw[u].y >> 16));
        f[4] = bf2f((u16)(raw[u].z & 0xffff)); f[5] = bf2f((u16)(raw[u].z >> 16)); f[6] = bf2f((u16)(raw[u].w & 0xffff)); f[7] = bf2f((u16)(raw[u].w >> 16));
        float s = 0.f, s2 = 0.f;
#pragma unroll
        for (int e = 0; e < 8; ++e) { s += f[e]; }
        s = wave_sum(s);
        const float mu = s * (1.f / 512.f);
#pragma unroll
        for (int e = 0; e < 8; ++e) { float dlt = f[e] - mu; s2 += dlt * dlt; }
        s2 = wave_sum(s2);
        if (lane == 0) { st[(r0 + u) * 2] = mu; st[(r0 + u) * 2 + 1] = rsqrtf(s2 * (1.f / 512.f) + 1e-5f); }
      }
    }
    const float* wsrc = p.in[19] + ((size_t)(l * 4 + gi)) * 128 * 128;
    for (int e = tid; e < 128 * 32; e += 256) {
      const int t = e >> 5, s4 = (e & 31) * 4;
      float4 w = *(const float4*)(wsrc + t * 128 + s4);
      uint2 o;
      o.x = pack2(s4 + 0 <= t ? w.x : 0.f, s4 + 1 <= t ? w.y : 0.f);
      o.y = pack2(s4 + 2 <= t ? w.z : 0.f, s4 + 3 <= t ? w.w : 0.f);
      *(uint2*)(Wt + t * 136 + s4) = o;
    }
    __syncthreads();
    for (int e = tid; e < 128 * 16; e += 256) {
      const int s = e >> 4, c8 = (e & 15) * 8;
      uint4 raw = *(const uint4*)(P1 + (size_t)(tok0 + s) * PS1 + 1560 + gi * 128 + c8);
      const float mu = st[s * 2], rs = st[s * 2 + 1];
      u16 rv[8] = {(u16)(raw.x & 0xffff), (u16)(raw.x >> 16), (u16)(raw.y & 0xffff), (u16)(raw.y >> 16), (u16)(raw.z & 0xffff), (u16)(raw.z >> 16), (u16)(raw.w & 0xffff), (u16)(raw.w >> 16)};
#pragma unroll
      for (int i = 0; i < 8; ++i) {
        const int c = gi * 128 + c8 + i;
        Vt[(c8 + i) * 136 + s] = f2bf((bf2f(rv[i]) - mu) * rs * lng[c] + lnb[c]);
      }
    }
    __syncthreads();
    f32x4 acc[4][4]; ZERO_ACC(acc, 4)
#pragma unroll 1
    for (int ks = 0; ks < 4; ++ks) {
      bf16x8 a[4], b[4];
#pragma unroll
      for (int m = 0; m < 4; ++m) a[m] = *(const bf16x8*)(Wt + (wr * 64 + m * 16 + fr) * 136 + ks * 32 + fq * 8);
#pragma unroll
      for (int n = 0; n < 4; ++n) b[n] = *(const bf16x8*)(Vt + (wc * 64 + n * 16 + fr) * 136 + ks * 32 + fq * 8);
#pragma unroll
      for (int m = 0; m < 4; ++m)
#pragma unroll
        for (int n = 0; n < 4; ++n) acc[m][n] = mfma16(a[m], b[n], acc[m][n]);
    }
    const float* bs = p.in[20] + ((size_t)(l * 4 + gi)) * 128;
#pragma unroll
    for (int m = 0; m < 4; ++m)
#pragma unroll
      for (int n = 0; n < 4; ++n) {
        const int c = wc * 64 + n * 16 + fr;
#pragma unroll
        for (int j = 0; j < 4; ++j) {
          const int t = wr * 64 + m * 16 + fq * 4 + j;
          u16* up = P1 + (size_t)(tok0 + t) * PS1 + 1048 + gi * 128 + c;
          *up = f2bf(bf2f(*up) * (acc[m][n][j] + bs[t]));
        }
      }
    __syncthreads();
  }
}

__device__ __forceinline__ void phase_prep1(const Params& p, int l) {
  u16* P2 = (u16*)(p.ws + OFF_P2); const u16* PB = (const u16*)(p.ws + OFF_PB); u16* VF = (u16*)(p.ws + OFF_VFIRST);
  const float* mu = p.in[21] + (size_t)l * 1792;
  const int total = 1024 * 224;
  for (int idx = blockIdx.x * 256 + tidx(); idx < total; idx += gridDim.x * 256) {
    const int tile = idx / 224, cg8 = (idx % 224) * 8;
    const int tok0 = tile * 32;
    float m8[8];
#pragma unroll
    for (int e = 0; e < 8; ++e) m8[e] = mu[cg8 + e];
    uint4 prev = make_uint4(0, 0, 0, 0);
    if ((tok0 & 4095) != 0) prev = *(const uint4*)(PB + (size_t)(tile - 1) * 1792 + cg8);
    for (int r = 0; r < 32; ++r) {
      u16* ptr = P2 + (size_t)(tok0 + r) * PS2 + cg8;
      uint4 cur = *(const uint4*)ptr;
      unsigned cu[4] = {cur.x, cur.y, cur.z, cur.w}, pu[4] = {prev.x, prev.y, prev.z, prev.w};
      float o[8];
#pragma unroll
      for (int e = 0; e < 8; ++e) {
        float c = bf2f((u16)((cu[e >> 1] >> ((e & 1) * 16)) & 0xffff));
        float pv = bf2f((u16)((pu[e >> 1] >> ((e & 1) * 16)) & 0xffff));
        float s = c + (pv - c) * m8[e];
        if (cg8 >= 1536 && cg8 < 1600) s = tanhf(s);
        else if (cg8 >= 1664) s = sigmoidf_(s);
        o[e] = s;
      }
      uint4 ov; ov.x = pack2(o[0], o[1]); ov.y = pack2(o[2], o[3]); ov.z = pack2(o[4], o[5]); ov.w = pack2(o[6], o[7]);
      *(uint4*)ptr = ov;
      if (l == 0 && cg8 >= 1024 && cg8 < 1536) *(uint4*)(VF + (size_t)(tok0 + r) * 512 + cg8 - 1024) = ov;
      prev = cur;
    }
  }
}

__device__ __forceinline__ void phase_prep2(const Params& p, int l, char* smem) {
  u16* P2 = (u16*)(p.ws + OFF_P2); const u16* VF = (const u16*)(p.ws + OFF_VFIRST);
  float* twd = (float*)smem;
  float* adl = twd + 1024;
  float* vsh = adl + 1024;
  float* lv = vsh + 8192;
  const int tid = tidx();
  const float* w0 = p.in[22] + (size_t)l * 512; const float* w2 = p.in[23] + (size_t)l * 64 * 512;
  const float* a0 = p.in[24] + (size_t)l * 512; const float* a2 = p.in[25] + (size_t)l * 64 * 512;
  const float* kkp = p.in[27] + (size_t)l * 512; const float* kap = p.in[28] + (size_t)l * 512;
  for (int item = blockIdx.x; item < 2048; item += gridDim.x) {
    const int tok0 = item * 16;
    for (int e = tid; e < 2048; e += 256) {
      const int r = e >> 7, c = e & 127;
      twd[(c >> 6) * 1024 + r * 64 + (c & 63)] = bf2f(P2[(size_t)(tok0 + r) * PS2 + 1536 + c]);
    }
    if (l > 0) {
      for (int e = tid; e < 8192; e += 256) { const int r = e >> 9, c = e & 511; vsh[e] = bf2f(P2[(size_t)(tok0 + r) * PS2 + 1024 + c]); }
    }
    __syncthreads();
    if (l > 0) {
      const float* v1 = p.in[33];
      for (int e = tid; e < 512; e += 256) {
        const int r = e >> 5, j = e & 31;
        float s = 0.f;
#pragma unroll 2
        for (int c = 0; c < 512; c += 4) {
          const float4 t4 = *(const float4*)(vsh + r * 512 + c);
          s += t4.x * v1[c * 32 + j] + t4.y * v1[(c + 1) * 32 + j] + t4.z * v1[(c + 2) * 32 + j] + t4.w * v1[(c + 3) * 32 + j];
        }
        lv[r * 32 + j] = s;
      }
      __syncthreads();
    }
    {
      float aw[2][16], aa[2][16], am[2][16];
#pragma unroll
      for (int c = 0; c < 2; ++c)
#pragma unroll
        for (int r = 0; r < 16; ++r) { aw[c][r] = 0.f; aa[c][r] = 0.f; am[c][r] = 0.f; }
#pragma unroll 2
      for (int i = 0; i < 64; i += 4) {
        float wv[2][4], av[2][4];
#pragma unroll
        for (int c = 0; c < 2; ++c)
#pragma unroll
          for (int u = 0; u < 4; ++u) { wv[c][u] = w2[(i + u) * 512 + tid + c * 256]; av[c][u] = a2[(i + u) * 512 + tid + c * 256]; }
#pragma unroll
        for (int r = 0; r < 16; ++r) {
          const float4 tw = *(const float4*)(twd + r * 64 + i);
          const float4 ta = *(const float4*)(adl + r * 64 + i);
#pragma unroll
          for (int c = 0; c < 2; ++c) {
            aw[c][r] += tw.x * wv[c][0] + tw.y * wv[c][1] + tw.z * wv[c][2] + tw.w * wv[c][3];
            aa[c][r] += ta.x * av[c][0] + ta.y * av[c][1] + ta.z * av[c][2] + ta.w * av[c][3];
          }
        }
      }
      if (l > 0) {
        const float* v2 = p.in[34];
#pragma unroll 2
        for (int j = 0; j < 32; j += 4) {
          float vv[2][4];
#pragma unroll
          for (int c = 0; c < 2; ++c)
#pragma unroll
            for (int u = 0; u < 4; ++u) vv[c][u] = v2[(j + u) * 512 + tid + c * 256];
#pragma unroll
          for (int r = 0; r < 16; ++r) {
            const float4 t4 = *(const float4*)(lv + r * 32 + j);
#pragma unroll
            for (int c = 0; c < 2; ++c) am[c][r] += t4.x * vv[c][0] + t4.y * vv[c][1] + t4.z * vv[c][2] + t4.w * vv[c][3];
          }
        }
      }
#pragma unroll
      for (int c = 0; c < 2; ++c) {
        const int ch = tid + c * 256;
        const float w0v = w0[ch], a0v = a0[ch], kkv = kkp[ch], kav = kap[ch];
        const float v0v = (l > 0) ? p.in[32][ch] : 0.f;
        float kval[16];
#pragma unroll
        for (int r = 0; r < 16; ++r) kval[r] = bf2f(P2[(size_t)(tok0 + r) * PS2 + 512 + ch]);
#pragma unroll
        for (int r = 0; r < 16; ++r) {
          u16* row = P2 + (size_t)(tok0 + r) * PS2;
          const float wpre = w0v + aw[c][r];
          const float nx = -wpre;
          const float sp = fmaxf(nx, 0.f) + __logf(1.f + __expf(-fabsf(nx)));
          const float w = -sp - 0.5f;
          const float decay = __expf(-__expf(w));
          const float a = sigmoidf_(a0v + aa[c][r]);
          const float kk = kval[r] * kkv;
          const float ss = wave_sum(kk * kk);
          const float kkn = kk / fmaxf(sqrtf(ss), 1e-12f);
          row[1792 + ch] = f2bf(decay);
          row[2304 + ch] = f2bf(kkn);
          row[2816 + ch] = f2bf(kkn * a);
          row[512 + ch] = f2bf(kval[r] * (1.f + (a - 1.f) * kav));
          if (l > 0) {
            const float v = vsh[r * 512 + ch];
            const float vf = bf2f(VF[(size_t)(tok0 + r) * 512 + ch]);
            row[1024 + ch] = f2bf(v + (vf - v) * sigmoidf_(v0v + am[c][r]));
          }
        }
      }
    }
    __syncthreads();
  }
}

__device__ __forceinline__ void scan_item(const Params& p, int item, char* smem) {
  const u16* P2 = (const u16*)(p.ws + OFF_P2); u16* YC = (u16*)(p.ws + OFF_P1) + 1560;
  float* vb = (float*)smem;
  float* yb = vb + 2 * 6 * 16 * 64;
  const int tid = tidx(), lane = tid & 63, wid = tid >> 6;
  const int rq = item & 3, h = (item >> 2) & 7, b = item >> 5;
  const int rl = lane >> 4, cq = lane & 15;
  const int rloc = wid * 4 + rl;
  const int ihead = rq * 16 + rloc;
  const int j0 = cq * 4;
  const size_t tokb = (size_t)b * 4096;
  float s0 = 0.f, s1 = 0.f, s2 = 0.f, s3 = 0.f;
  uint4 pre[3];
  auto gload = [&](int c) {
#pragma unroll
    for (int i = 0; i < 3; ++i) {
      const int v = tid + i * 256; const int vec = v >> 7, rem = v & 127, step = rem >> 3, c8 = rem & 7;
      const int off = (vec == 0) ? 0 : (vec == 1) ? 1792 : (vec == 2) ? 512 : (vec == 3) ? 1024 : (vec == 4) ? 2304 : 2816;
      pre[i] = *(const uint4*)(P2 + (tokb + c * 16 + step) * PS2 + off + h * 64 + c8 * 8);
    }
  };
  auto lstore = [&](int buf) {
#pragma unroll
    for (int i = 0; i < 3; ++i) {
      const int v = tid + i * 256; const int vec = v >> 7, rem = v & 127, step = rem >> 3, c8 = rem & 7;
      float* d = vb + ((buf * 6 + vec) * 16 + step) * 64 + c8 * 8;
      float4 f0, f1;
      f0.x = bf2f((u16)(pre[i].x & 0xffff)); f0.y = bf2f((u16)(pre[i].x >> 16)); f0.z = bf2f((u16)(pre[i].y & 0xffff)); f0.w = bf2f((u16)(pre[i].y >> 16));
      f1.x = bf2f((u16)(pre[i].z & 0xffff)); f1.y = bf2f((u16)(pre[i].z >> 16)); f1.z = bf2f((u16)(pre[i].w & 0xffff)); f1.w = bf2f((u16)(pre[i].w >> 16));
      *(float4*)d = f0; *(float4*)(d + 4) = f1;
    }
  };
  gload(0); lstore(0);
  __syncthreads();
  for (int c = 0; c < 256; ++c) {
    const int buf = c & 1;
    if (c + 1 < 256) gload(c + 1);
    const float* base = vb + buf * 6 * 16 * 64;
#pragma unroll
    for (int st = 0; st < 16; ++st) {
      const float4 r4 = *(const float4*)(base + (0 * 16 + st) * 64 + j0);
      const float4 w4 = *(const float4*)(base + (1 * 16 + st) * 64 + j0);
      const float4 k4 = *(const float4*)(base + (2 * 16 + st) * 64 + j0);
      const float vi = base[(3 * 16 + st) * 64 + ihead];
      const float4 n4 = *(const float4*)(base + (4 * 16 + st) * 64 + j0);
      const float4 b4 = *(const float4*)(base + (5 * 16 + st) * 64 + j0);
      float sa = s0 * n4.x + s1 * n4.y + s2 * n4.z + s3 * n4.w;
      sa = -dpp_sum16(sa);
      s0 = s0 * w4.x + sa * b4.x + vi * k4.x;
      s1 = s1 * w4.y + sa * b4.y + vi * k4.y;
      s2 = s2 * w4.z + sa * b4.z + vi * k4.z;
      s3 = s3 * w4.w + sa * b4.w + vi * k4.w;
      float y = s0 * r4.x + s1 * r4.y + s2 * r4.z + s3 * r4.w;
      y = dpp_sum16(y);
      yb[st * 16 + rloc] = y;
    }
    __syncthreads();
    {
      const int st = tid >> 4, r = tid & 15;
      YC[(tokb + c * 16 + st) * PS1 + h * 64 + rq * 16 + r] = f2bf(yb[st * 16 + r]);
    }
    if (c + 1 < 256) lstore(buf ^ 1);
    __syncthreads();
  }
}

__device__ __forceinline__ void phase_post(const Params& p, int l, char* smem) {
  const u16* P2 = (const u16*)(p.ws + OFF_P2); u16* YC = (u16*)(p.ws + OFF_P1) + 1560;
  float* sg = (float*)smem;
  const int tid = tidx();
  const float* g2 = p.in[26] + (size_t)l * 128 * 512;
  const float* rk = p.in[29] + (size_t)l * 512; const float* lg = p.in[30] + (size_t)l * 512; const float* lb = p.in[31] + (size_t)l * 512;
  for (int item = blockIdx.x; item < 2048; item += gridDim.x) {
    const int tok0 = item * 16;
    for (int e = tid; e < 2048; e += 256) { const int r = e >> 7, c = e & 127; sg[e] = bf2f(P2[(size_t)(tok0 + r) * PS2 + 1664 + c]); }
    __syncthreads();
    {
      float ag[2][16];
#pragma unroll
      for (int c = 0; c < 2; ++c)
#pragma unroll
        for (int r = 0; r < 16; ++r) ag[c][r] = 0.f;
#pragma unroll 4
      for (int i = 0; i < 128; i += 4) {
        float gv[2][4];
#pragma unroll
        for (int c = 0; c < 2; ++c)
#pragma unroll
          for (int u = 0; u < 4; ++u) gv[c][u] = g2[(i + u) * 512 + tid + c * 256];
#pragma unroll
        for (int r = 0; r < 16; ++r) {
          const float4 t4 = *(const float4*)(sg + r * 128 + i);
#pragma unroll
          for (int c = 0; c < 2; ++c) ag[c][r] += t4.x * gv[c][0] + t4.y * gv[c][1] + t4.z * gv[c][2] + t4.w * gv[c][3];
        }
      }
#pragma unroll
      for (int c = 0; c < 2; ++c) {
        const int ch = tid + c * 256;
        const float rkv = rk[ch], lgv = lg[ch], lbv = lb[ch];
        float yv[16], rr[16], kk[16], vv[16];
#pragma unroll
        for (int r = 0; r < 16; ++r) {
          const u16* row = P2 + (size_t)(tok0 + r) * PS2;
          yv[r] = bf2f(YC[(size_t)(tok0 + r) * PS1 + ch]);
          rr[r] = bf2f(row[ch]); kk[r] = bf2f(row[512 + ch]); vv[r] = bf2f(row[1024 + ch]);
        }
#pragma unroll
        for (int r = 0; r < 16; ++r) {
          const float mean = wave_sum(yv[r]) * (1.f / 64.f);
          const float dv = yv[r] - mean;
          const float var = wave_sum(dv * dv) * (1.f / 64.f);
          const float yn = dv * rsqrtf(var + 64e-5f) * lgv + lbv;
          const float bon = wave_sum(rr[r] * kk[r] * rkv) * vv[r];
          YC[(size_t)(tok0 + r) * PS1 + ch] = f2bf((yn + bon) * ag[c][r]);
        }
      }
    }
    __syncthreads();
  }
}

#define NEGV (-1e30f)
struct AttnState { float m[2]; float ls[2]; f32x4 ot[4][2]; };

template <int MODE>
__device__ __forceinline__ void attn_scores(f32x4 (&st)[4][2], const u16* kbase, int kstride, int key0, const bf16x8 (&qf)[2][2],
                                            const float (&slope)[2], int t, bool selbit, int c16, int q4) {
#pragma unroll
  for (int mk = 0; mk < 4; ++mk) {
    const u16* kp = kbase + (size_t)(mk * 16 + c16) * kstride + q4 * 8;
    const bf16x8 k0 = *(const bf16x8*)kp, k1 = *(const bf16x8*)(kp + 32);
#pragma unroll
    for (int nq = 0; nq < 2; ++nq) {
      f32x4 a = {0.f, 0.f, 0.f, 0.f};
      a = mfma16(k0, qf[nq][0], a);
      a = mfma16(k1, qf[nq][1], a);
#pragma unroll
      for (int j = 0; j < 4; ++j) {
        const int key = key0 + mk * 16 + q4 * 4 + j;
        int dist; bool valid;
        if (MODE == 0) { dist = t - (16 * key + 31); valid = dist >= 0; }
        else if (MODE == 1) { dist = t - key; valid = (dist >= 0) && selbit; }
        else { dist = t - key; valid = (dist >= 0) && (dist < 512); }
        a[j] = valid ? (a[j] - slope[nq] * (float)dist) : NEGV;
      }
      st[mk][nq] = a;
    }
  }
}

template <int MODE>
__device__ __forceinline__ void attn_tile(AttnState& S, const u16* kbase, int kstride, const u16* vtbase, int vstride, int key0,
                                          const bf16x8 (&qf)[2][2], const float (&slope)[2], int t, bool selbit, int c16, int q4) {
  f32x4 st[4][2];
  attn_scores<MODE>(st, kbase, kstride, key0, qf, slope, t, selbit, c16, q4);
  __builtin_amdgcn_sched_barrier(0);
#pragma unroll
  for (int nq = 0; nq < 2; ++nq) {
    float mx = NEGV;
#pragma unroll
    for (int mk = 0; mk < 4; ++mk)
#pragma unroll
      for (int j = 0; j < 4; ++j) mx = fmaxf(mx, st[mk][nq][j]);
    mx = fmaxf(mx, __shfl_xor(mx, 16)); mx = fmaxf(mx, __shfl_xor(mx, 32));
    const float mnew = fmaxf(S.m[nq], mx);
    const float alpha = __expf(S.m[nq] - mnew);
    S.m[nq] = mnew;
    float ls = S.ls[nq] * alpha;
#pragma unroll
    for (int md = 0; md < 4; ++md) { S.ot[md][nq][0] *= alpha; S.ot[md][nq][1] *= alpha; S.ot[md][nq][2] *= alpha; S.ot[md][nq][3] *= alpha; }
#pragma unroll
    for (int mk = 0; mk < 4; ++mk)
#pragma unroll
      for (int j = 0; j < 4; ++j) {
        const float sv = st[mk][nq][j];
        const float pv = (sv > -1e29f) ? __expf(sv - mnew) : 0.f;
        st[mk][nq][j] = pv; ls += pv;
      }
    S.ls[nq] = ls;
  }
#pragma unroll
  for (int s2 = 0; s2 < 2; ++s2) {
    __builtin_amdgcn_sched_barrier(0);
    bf16x8 pb[2];
#pragma unroll
    for (int nq = 0; nq < 2; ++nq) {
      uint4 u;
      u.x = pack2(st[2 * s2][nq][0], st[2 * s2][nq][1]); u.y = pack2(st[2 * s2][nq][2], st[2 * s2][nq][3]);
      u.z = pack2(st[2 * s2 + 1][nq][0], st[2 * s2 + 1][nq][1]); u.w = pack2(st[2 * s2 + 1][nq][2], st[2 * s2 + 1][nq][3]);
      pb[nq] = *(bf16x8*)&u;
    }
#pragma unroll
    for (int md = 0; md < 4; ++md) {
      const bf16x8 vf = *(const bf16x8*)(vtbase + (size_t)(md * 16 + c16) * vstride + s2 * 32 + q4 * 8);
#pragma unroll
      for (int nq = 0; nq < 2; ++nq) S.ot[md][nq] = mfma16(vf, pb[nq], S.ot[md][nq]);
    }
  }
}

__device__ __forceinline__ void attn_reset(AttnState& S) {
#pragma unroll
  for (int nq = 0; nq < 2; ++nq) { S.m[nq] = NEGV; S.ls[nq] = 0.f;
#pragma unroll
    for (int md = 0; md < 4; ++md) S.ot[md][nq] = f32x4{0.f, 0.f, 0.f, 0.f}; }
}
__device__ __forceinline__ void attn_fold(AttnState& S, float* oacc, const u16* gp, int br, float (&invl)[2], int lane) {
#pragma unroll
  for (int nq = 0; nq < 2; ++nq) {
    float l = S.ls[nq];
    l += __shfl_xor(l, 16); l += __shfl_xor(l, 32);
    const float inv = (l > 0.f) ? 1.f / l : 0.f;
    invl[nq] = inv;
    const float f = bf2f(gp[nq * 6 + br]) * inv;
#pragma unroll
    for (int md = 0; md < 4; ++md)
#pragma unroll
      for (int j = 0; j < 4; ++j) {
        float* a = oacc + ((md * 2 + nq) * 4 + j) * 64 + lane;
        const float v = f * S.ot[md][nq][j];
        if (br == 0) *a = v; else *a += v;
      }
  }
}

__device__ __forceinline__ void phase_nsa(const Params& p, char* smem, unsigned* queue) {
  u16* P1 = (u16*)(p.ws + OFF_P1);
  const u16* KC = (const u16*)(p.ws + OFF_KC); const u16* VC = (const u16*)(p.ws + OFF_VC); const u16* VT = (const u16*)(p.ws + OFF_VT);
  const int tid = tidx(), lane = tid & 63, wid = tid >> 6;
  const int c16 = lane & 15, q4 = lane >> 4, tq = lane & 7;
  float* ps = (float*)smem + wid * 2048;
  float* oacc = (float*)(smem + 32768) + wid * 2048;
  int* qslot = (int*)(smem + 65536);
#pragma unroll 1
  for (;;) {
    if (tid == 0) *qslot = (int)atomicAdd(queue, 1u);
    __syncthreads();
    const int it = *qslot;
    if (it >= 2048) break;
    const int bg = it & 15;
    const int tqd = 127 - (it >> 4);
    const int b = bg >> 1, g = bg & 1;
    const int t0 = (tqd * 4 + wid) * 8;
    const int tok0 = b * 4096 + t0;
    const int t = t0 + tq;
    const int cur = t0 >> 6;
#pragma unroll
    for (int i = 0; i < 8; ++i) *(float4*)(ps + i * 256 + lane * 4) = float4{0.f, 0.f, 0.f, 0.f};
    bf16x8 qf[2][2]; float slope[2];
    const u16* gp = P1 + (size_t)(tok0 + tq) * PS1 + 1024 + (g * 4 + (c16 >> 3)) * 3;
#pragma unroll
    for (int nq = 0; nq < 2; ++nq) {
      const int hh = nq * 2 + (c16 >> 3);
      const u16* rp = P1 + (size_t)(tok0 + tq) * PS1;
      qf[nq][0] = *(const bf16x8*)(rp + (g * 4 + hh) * 64 + q4 * 8);
      qf[nq][1] = *(const bf16x8*)(rp + (g * 4 + hh) * 64 + 32 + q4 * 8);
      slope[nq] = exp2f(-(float)(g * 4 + hh + 1));
    }
    AttnState S;
    float invl[2];
    const u16* kcb = KC + (size_t)(b * 2 + g) * 256 * 64;
    const u16* vcb = VC + (size_t)(b * 2 + g) * 64 * 256;
    int ntc = 0;
    if (t0 + 7 >= 31) ntc = (((t0 + 7 - 31) >> 4) >> 6) + 1;
    attn_reset(S);
#pragma unroll 1
    for (int kt = 0; kt < ntc; ++kt) attn_tile<0>(S, kcb + (size_t)kt * 64 * 64, 64, vcb + kt * 64, 256, kt * 64, qf, slope, t, true, c16, q4);
    attn_fold(S, oacc, gp, 0, invl, lane);
#pragma unroll 1
    for (int kt = 0; kt < ntc; ++kt) {
      f32x4 st[4][2];
      attn_scores<0>(st, kcb + (size_t)kt * 64 * 64, 64, kt * 64, qf, slope, t, true, c16, q4);
#pragma unroll
      for (int mk = 0; mk < 4; ++mk) {
        f32x4 hs;
#pragma unroll
        for (int j = 0; j < 4; ++j) {
          const float a0 = st[mk][0][j], a1 = st[mk][1][j];
          const float p0 = (a0 > -1e29f) ? __expf(a0 - S.m[0]) * invl[0] : 0.f;
          const float p1 = (a1 > -1e29f) ? __expf(a1 - S.m[1]) * invl[1] : 0.f;
          float v = p0 + p1;
          v += __shfl_xor(v, 8);
          hs[j] = v;
        }
        if (c16 < 8) *(f32x4*)(ps + c16 * 256 + kt * 64 + mk * 16 + q4 * 4) = hs;
      }
    }
    __syncthreads();
    unsigned long long selm = 0ull, un = 0ull;
#pragma unroll 1
    for (int tqq = 0; tqq < 8; ++tqq) {
      const float* pr = ps + tqq * 256;
      float imp = pr[4 * lane];
      if (lane > 0) imp += pr[4 * lane - 4] + 2.f * (pr[4 * lane - 3] + pr[4 * lane - 2] + pr[4 * lane - 1]);
      const bool forced = (lane == 0) || (lane == cur) || (lane == cur - 1);
      const bool live = lane <= cur;
      const float val = forced ? 1e4f : (live ? imp : NEGV);
      int rank = 0;
#pragma unroll 8
      for (int i = 0; i < 64; ++i) {
        const float vi = __uint_as_float(__builtin_amdgcn_readlane(__float_as_uint(val), i));
        rank += ((vi > val) || (vi == val && i < lane)) ? 1 : 0;
      }
      const unsigned long long bal = __ballot((rank < 16) && live);
      if (tq == tqq) selm = bal;
      un |= bal;
    }
    __syncthreads();
    attn_reset(S);
    {
      const u16* vtb = VT + (size_t)((0 * 8 + b) * 2 + g) * 64 * 4096;
#pragma unroll 1
      for (int j = 0; j <= cur; ++j) {
        if (!((un >> j) & 1ull)) continue;
        const bool sb = (selm >> j) & 1ull;
        attn_tile<1>(S, P1 + (size_t)(b * 4096 + j * 64) * PS1 + 768 + g * 64, PS1, vtb + j * 64, 4096, j * 64, qf, slope, t, sb, c16, q4);
      }
    }
    attn_fold(S, oacc, gp, 1, invl, lane);
    attn_reset(S);
    {
      const u16* vtb = VT + (size_t)((1 * 8 + b) * 2 + g) * 64 * 4096;
      int j0 = t0 - 511; if (j0 < 0) j0 = 0; j0 >>= 6;
#pragma unroll 1
      for (int j = j0; j <= cur; ++j)
        attn_tile<2>(S, P1 + (size_t)(b * 4096 + j * 64) * PS1 + 896 + g * 64, PS1, vtb + j * 64, 4096, j * 64, qf, slope, t, true, c16, q4);
    }
    attn_fold(S, oacc, gp, 2, invl, lane);
#pragma unroll
    for (int nq = 0; nq < 2; ++nq) {
      const int hh = nq * 2 + (c16 >> 3);
      u16* rp = P1 + (size_t)(tok0 + tq) * PS1 + (g * 4 + hh) * 64;
#pragma unroll
      for (int md = 0; md < 4; ++md) {
        const float* a = oacc + ((md * 2 + nq) * 4) * 64 + lane;
        uint2 o; o.x = pack2(a[0], a[64]); o.y = pack2(a[128], a[192]);
        *(uint2*)(rp + md * 16 + q4 * 4) = o;
      }
    }
  }
}

__device__ __forceinline__ const float* modp(const Params& p, int l, int sub, int kind) {
  return (const float*)(p.ws + OFF_MOD) + (size_t)l * 8 * 9216 + sub * 3072 + kind * 1024;
}

__device__ __forceinline__ void run_phase(const Params& p, int ph, char* smem) {
  char* ws = p.ws;
  if (ph == 0) {
    if (blockIdx.x == 0) { unsigned* c = (unsigned*)(ws + OFF_CNT); for (int e = tidx(); e < 1024; e += 256) c[e] = 0u; }
    phase_mod(p, smem);
  }
  int l = 0, s = -1;
  if (ph >= 2) { l = (ph - 2) / 14; s = (ph - 2) % 14; }
  const float* preg = p.in[4] + (size_t)l * 3 * 1024; const float* postg = p.in[5] + (size_t)l * 3 * 1024;
  const bool is_norm = (ph == 1) || s == 2 || s == 10 || s == 13;
  if (is_norm) {
    const float* xin = p.out; float* xout = p.out; const u16* y = nullptr; const float* pg = nullptr; const float* gate = nullptr; float wgt = 0.f;
    const float* prg = nullptr; const float* sh = nullptr; const float* sc = nullptr; u16* h = (u16*)(ws + OFF_H);
    if (ph == 1) { xin = p.in[0]; prg = p.in[4]; sh = modp(p, 0, 0, 0); sc = modp(p, 0, 0, 1); }
    else if (s == 2) { y = (const u16*)(ws + OFF_YF); pg = postg; gate = modp(p, l, 0, 2); wgt = 0.5f; prg = preg + 1024; sh = modp(p, l, 1, 0); sc = modp(p, l, 1, 1); }
    else if (s == 10) { y = (const u16*)(ws + OFF_YM); pg = postg + 1024; gate = modp(p, l, 1, 2); wgt = 1.0f; prg = preg + 2048; sh = modp(p, l, 2, 0); sc = modp(p, l, 2, 1); }
    else { y = (const u16*)(ws + OFF_YF); pg = postg + 2048; gate = modp(p, l, 2, 2); wgt = 0.5f;
      if (l == 0) { prg = p.in[4] + 3 * 1024; sh = modp(p, 1, 0, 0); sc = modp(p, 1, 0, 1); } else { h = nullptr; } }
    phase_norm(xin, xout, y, pg, gate, wgt, prg, sh, sc, h);
  }
  {
    int cl = -1, cf = 0;
    if (ph == 0) { cl = 0; cf = 0; } else if (s == 2) { cl = l; cf = 1; } else if (s == 13 && l == 0) { cl = 1; cf = 0; }
    if (cl >= 0) conv_ffn(p, cl, cf, smem);
    if (cl >= 0 && cf == 0) conv_mix(p, cl, smem);
  }
  if (s == 0 || s == 11) phase_ffn_in(p, smem);
  if (s == 1 || s == 12 || s == 9) {
    const bool o = (s == 9);
    phase_gemm_plain((const u16*)(ws + (o ? OFF_MERGED : OFF_ACT)), o ? 1024 : DFF, (const u16*)(ws + (o ? OFF_WO : OFF_WOUT)), o ? 1024 : DFF,
                     (u16*)(ws + (o ? OFF_YM : OFF_YF)), smem);
  }
  if (s == 3) phase_inproj(p, smem);
  if (s == 4) { phase_prep1(p, l); phase_sgu(p, l, smem); phase_cmp1(p, l, smem); }
  if (s == 5) { phase_prep2(p, l, smem); phase_cmp2(p, l); }
  if (s == 6) {
    const int nb = gridDim.x;
    const int sid = (nb >= 512) ? (((int)blockIdx.x & 1) ? -1 : ((int)blockIdx.x >> 1)) : (int)blockIdx.x;
    const int sstride = (nb >= 512) ? (nb >> 1) : nb;
    if (sid >= 0) for (int it = sid; it < 256; it += sstride) scan_item(p, it, smem);
    phase_nsa(p, smem, (unsigned*)(ws + OFF_CNT) + 64 + l * 64);
  }
  if (s == 7) phase_post(p, l, smem);
  if (s == 8) phase_merge(p, smem);
}

constexpr int NPHASE = 30;

#if COOP
typedef const float* __attribute__((address_space(4))) const* kargp_t;
template <int PH>
__device__ __forceinline__ void run_seq(char* smem, cg::grid_group& grid) {
  if constexpr (PH < NPHASE) {
    {
      kargp_t ka = (kargp_t)__builtin_amdgcn_kernarg_segment_ptr();
      asm volatile("" : "+s"(ka));
      Params q;
#pragma unroll
      for (int i = 0; i < 35; ++i) q.in[i] = ka[i];
      q.out = (float*)ka[35];
      q.ws = (char*)ka[36];
      run_phase(q, PH, smem);
    }
    if constexpr (PH == 0) grid.sync();
    else if constexpr (PH + 1 < NPHASE) {
      kargp_t kb = (kargp_t)__builtin_amdgcn_kernarg_segment_ptr();
      asm volatile("" : "+s"(kb));
      gbar((unsigned*)((char*)kb[36] + OFF_CNT), (unsigned)PH * gridDim.x);
    }
    run_seq<PH + 1>(smem, grid);
  }
}

__global__ void __launch_bounds__(256, 2) mega(Params p) {
  __shared__ __attribute__((aligned(16))) char smem[SMEM_BYTES];
  cg::grid_group grid = cg::this_grid();
  run_seq<0>(smem, grid);
}
#endif

template <int PH>
__global__ void __launch_bounds__(256, 2) kph(Params p) {
  __shared__ __attribute__((aligned(16))) char smem[SMEM_BYTES];
  run_phase(p, PH, smem);
}

template <int PH>
static void launch_seq(const Params& p, int grid, hipStream_t stream) {
  if constexpr (PH < NPHASE) {
    kph<PH><<<grid, 256, 0, stream>>>(p);
    launch_seq<PH + 1>(p, grid, stream);
  }
}

extern "C" void kernel_launch(void* const* d_in, const int* in_sizes, int n_in, void* d_out, int out_size, void* d_ws, size_t ws_size,
                              hipStream_t stream) {
  static int grid_blocks = 0;
  if (!grid_blocks) {
    int dev = 0, cus = 0, per_cu = 0;
    hipGetDevice(&dev);
    hipDeviceGetAttribute(&cus, hipDeviceAttributeMultiprocessorCount, dev);
    #if COOP
    hipOccupancyMaxActiveBlocksPerMultiprocessor(&per_cu, mega, 256, 0);
#else
    per_cu = 2;
#endif
    if (per_cu > 2) per_cu = 2;
    if (per_cu < 1) per_cu = 1;
    grid_blocks = cus * per_cu;
  }
  Params p{};
  for (int i = 0; i < 35; ++i) p.in[i] = (const float*)d_in[i];
  p.out = (float*)d_out;
  p.ws = (char*)d_ws;
#if COOP
  void* args[] = {&p};
  hipError_t e = hipLaunchCooperativeKernel((void*)mega, dim3(grid_blocks), dim3(256), args, 0, stream);
  if (e != hipSuccess) fprintf(stderr, "cooperative launch failed: %s (grid %d)\n", hipGetErrorString(e), grid_blocks);
#else
  launch_seq<0>(p, grid_blocks, stream);
#endif
}
```

```cpp
#include <hip/hip_runtime.h>
#include <hip/hip_cooperative_groups.h>
#include <cstdio>
#include <cstdint>
namespace cg = cooperative_groups;

#ifndef COOP
#define COOP 1
#endif

typedef unsigned short u16;
using bf16x8 = __attribute__((ext_vector_type(8))) short;
using f32x4 = __attribute__((ext_vector_type(4))) float;

constexpr int T = 32768, D = 1024, SEQ = 4096, DFF = 2816;
constexpr int PS1 = 2072, PS2 = 3328;
constexpr int MIXC = 7192, MIXN = 4120;
constexpr size_t OFF_P1 = 0;
constexpr size_t OFF_P2 = OFF_P1 + (size_t)T * PS1 * 2;
constexpr size_t OFF_H = OFF_P2 + (size_t)T * PS2 * 2;
constexpr size_t OFF_WMIX = OFF_H + (size_t)T * 1024 * 2;
constexpr size_t OFF_WG = OFF_WMIX + (size_t)4224 * 1024 * 2;
constexpr size_t OFF_WB = OFF_WG + (size_t)3072 * 1024 * 2;
constexpr size_t OFF_WO = OFF_WB + (size_t)3 * 1024 * 512 * 2;
constexpr size_t OFF_W1 = OFF_WO + (size_t)1024 * 1024 * 2;
constexpr size_t OFF_WIN = OFF_W1 + (size_t)2 * 256 * 2048 * 2;
constexpr size_t OFF_WOUT = OFF_WIN + (size_t)5632 * 1024 * 2;
constexpr size_t OFF_VFIRST = OFF_WOUT + (size_t)1024 * 2816 * 2;
constexpr size_t OFF_VT = OFF_VFIRST + (size_t)T * 512 * 2;
constexpr size_t OFF_MOD = OFF_VT + (size_t)2 * 8 * 2 * 64 * 4096 * 2;
constexpr size_t OFF_PB = OFF_MOD + (size_t)2 * 8 * 9216 * 4;
constexpr size_t OFF_HID = OFF_PB + (size_t)1024 * 1792 * 2;
constexpr size_t OFF_KC = OFF_HID + (size_t)2 * 4096 * 256 * 2;
constexpr size_t OFF_VC = OFF_KC + (size_t)8 * 2 * 256 * 64 * 2;
constexpr size_t OFF_LV = OFF_VC + (size_t)8 * 2 * 64 * 256 * 2;
constexpr size_t OFF_CNT = OFF_LV + (size_t)T * 32 * 4;
constexpr size_t WS_END = OFF_CNT + 4096;
constexpr size_t OFF_ACT = OFF_P1;
constexpr size_t OFF_YF = OFF_ACT + (size_t)T * DFF * 2;
constexpr size_t OFF_H2 = OFF_P2;
constexpr size_t OFF_MERGED = OFF_P2;
constexpr size_t OFF_YM = OFF_MERGED + (size_t)T * 1024 * 2;
constexpr size_t OFF_YC = OFF_H;

constexpr int SMEM_BYTES = 73728;

struct Params { const float* in[35]; float* out; char* ws; };

__device__ __forceinline__ int tidx() { int t = __builtin_amdgcn_workitem_id_x(); asm volatile("" : "+v"(t)); return t; }
__device__ __forceinline__ void gbar(unsigned* cnt, unsigned target) {
  asm volatile("s_waitcnt vmcnt(0) lgkmcnt(0)" ::: "memory");
  __syncthreads();
  if (tidx() == 0) {
    __builtin_amdgcn_fence(__ATOMIC_RELEASE, "agent");
    asm volatile("s_waitcnt vmcnt(0)" ::: "memory");
    __hip_atomic_fetch_add(cnt, 1u, __ATOMIC_RELAXED, __HIP_MEMORY_SCOPE_AGENT);
    while (__hip_atomic_load(cnt, __ATOMIC_RELAXED, __HIP_MEMORY_SCOPE_AGENT) < target) __builtin_amdgcn_s_sleep(1);
    __builtin_amdgcn_fence(__ATOMIC_ACQUIRE, "agent");
    asm volatile("s_waitcnt vmcnt(0)" ::: "memory");
  }
  __syncthreads();
}
__device__ __forceinline__ float dpp_sum16(float v) {
  v += __int_as_float(__builtin_amdgcn_update_dpp(0, __float_as_int(v), 0xB1, 0xF, 0xF, true));
  v += __int_as_float(__builtin_amdgcn_update_dpp(0, __float_as_int(v), 0x4E, 0xF, 0xF, true));
  v += __int_as_float(__builtin_amdgcn_update_dpp(0, __float_as_int(v), 0x141, 0xF, 0xF, true));
  v += __int_as_float(__builtin_amdgcn_update_dpp(0, __float_as_int(v), 0x140, 0xF, 0xF, true));
  return v;
}
__device__ __forceinline__ float bf2f(u16 u) { return __uint_as_float(((unsigned)u) << 16); }
__device__ __forceinline__ u16 f2bf(float f) { __bf16 r = (__bf16)f; return *(u16*)&r; }
typedef __attribute__((ext_vector_type(2))) float f2_t;
typedef __attribute__((ext_vector_type(2))) __bf16 b2_t;
__device__ __forceinline__ unsigned pack2(float a, float b) { f2_t v = {a, b}; b2_t r = __builtin_convertvector(v, b2_t); return *(unsigned*)&r; }
__device__ __forceinline__ float sigmoidf_(float x) { return 1.f / (1.f + __expf(-x)); }
__device__ __forceinline__ float siluf_(float x) { return x / (1.f + __expf(-x)); }
__device__ __forceinline__ float geluf_(float x) { float u = 0.7978845608028654f * (x + 0.044715f * x * x * x); return x / (1.f + __expf(-2.f * u)); }
__device__ __forceinline__ float tanhf_(float x) { return 1.f - 2.f / (1.f + __expf(2.f * x)); }
__device__ __forceinline__ float wave_sum(float v) {
#pragma unroll
  for (int o = 32; o >= 1; o >>= 1) v += __shfl_xor(v, o);
  return v;
}
__device__ __forceinline__ f32x4 mfma16(bf16x8 a, bf16x8 b, f32x4 c) { return __builtin_amdgcn_mfma_f32_16x16x32_bf16(a, b, c, 0, 0, 0); }

__device__ __forceinline__ void conv_w(const float* src, int ld, int K, u16* dst, int NR, int nvalid, int coff, int kind, char* smem) {
  float* tl = (float*)smem;
  const int tid = tidx();
  const int ktn = K >> 6, ntile = (NR >> 6) * ktn;
  for (int tix = blockIdx.x; tix < ntile; tix += gridDim.x) {
    const int R0 = (tix / ktn) << 6, k0 = (tix % ktn) << 6;
    const int c = tid & 63, kq = tid >> 6;
    const int R = R0 + c;
    int sc; bool ok;
    if (kind == 0) { sc = coff + R; ok = R < nvalid; }
    else { int ntl = R >> 7, w = (R >> 6) & 1, n = (R >> 4) & 3, r = R & 15; sc = ((n >= 2) ? DFF : 0) + ntl * 64 + w * 32 + (n & 1) * 16 + r; ok = true; }
#pragma unroll 4
    for (int i = 0; i < 16; ++i) {
      int k = k0 + kq * 16 + i;
      tl[c * 65 + kq * 16 + i] = ok ? src[(size_t)k * ld + sc] : 0.f;
    }
    __syncthreads();
    {
      const int r = tid >> 2, ks = tid & 3;
      const float* s = tl + r * 65 + ks * 16;
      uint4 o0, o1;
      o0.x = pack2(s[0], s[1]); o0.y = pack2(s[2], s[3]); o0.z = pack2(s[4], s[5]); o0.w = pack2(s[6], s[7]);
      o1.x = pack2(s[8], s[9]); o1.y = pack2(s[10], s[11]); o1.z = pack2(s[12], s[13]); o1.w = pack2(s[14], s[15]);
      uint4* dp = (uint4*)(dst + (size_t)(R0 + r) * K + k0 + ks * 16);
      dp[0] = o0; dp[1] = o1;
    }
    __syncthreads();
  }
}

__device__ __forceinline__ void conv_ffn(const Params& p, int l, int f, char* smem) {
  conv_w(p.in[6] + (size_t)(l * 2 + f) * D * (2 * DFF), 2 * DFF, D, (u16*)(p.ws + OFF_WIN), 5632, 5632, 0, 1, smem);
  conv_w(p.in[7] + (size_t)(l * 2 + f) * DFF * D, D, DFF, (u16*)(p.ws + OFF_WOUT), 1024, 1024, 0, 0, smem);
}
__device__ __forceinline__ void conv_mix(const Params& p, int l, char* smem) {
  const float* mw = p.in[8] + (size_t)l * D * MIXC;
  conv_w(mw, MIXC, D, (u16*)(p.ws + OFF_WMIX), 4224, MIXN, 0, 0, smem);
  conv_w(mw, MIXC, D, (u16*)(p.ws + OFF_WG), 3072, 3072, MIXN, 0, smem);
  for (int i = 0; i < 3; ++i)
    conv_w(p.in[9] + (size_t)(l * 3 + i) * 512 * D, D, 512, (u16*)(p.ws + OFF_WB) + (size_t)i * 1024 * 512, 1024, 1024, 0, 0, smem);
  conv_w(p.in[10] + (size_t)l * D * D, D, D, (u16*)(p.ws + OFF_WO), 1024, 1024, 0, 0, smem);
  conv_w(p.in[11] + (size_t)l * 2048 * 256, 256, 2048, (u16*)(p.ws + OFF_W1), 256, 256, 0, 0, smem);
  conv_w(p.in[14] + (size_t)l * 2048 * 256, 256, 2048, (u16*)(p.ws + OFF_W1) + (size_t)256 * 2048, 256, 256, 0, 0, smem);
}

__device__ __forceinline__ void phase_mod(const Params& p, char* smem) {
  float* cond = (float*)smem;
  float* red = cond + 8192;
  const int tid = tidx();
  float* MOD = (float*)(p.ws + OFF_MOD);
  for (int item = blockIdx.x; item < 288; item += gridDim.x) {
    for (int e = tid; e < 8192; e += 256) cond[e] = siluf_(p.in[1][e]);
    __syncthreads();
    const int l = item / 144, n0 = (item % 144) * 64, col = n0 + (tid & 63), kq = tid >> 6;
    float acc[8];
#pragma unroll
    for (int b = 0; b < 8; ++b) acc[b] = 0.f;
    const float* w = p.in[2] + (size_t)l * D * 9216 + col;
#pragma unroll 4
    for (int k = kq * 256; k < kq * 256 + 256; ++k) {
      float wv = w[(size_t)k * 9216];
#pragma unroll
      for (int b = 0; b < 8; ++b) acc[b] += cond[b * 1024 + k] * wv;
    }
#pragma unroll
    for (int b = 0; b < 8; ++b) red[(kq * 8 + b) * 64 + (tid & 63)] = acc[b];
    __syncthreads();
    for (int e = tid; e < 512; e += 256) {
      int b = e >> 6, c = e & 63;
      float s = red[(0 * 8 + b) * 64 + c] + red[(1 * 8 + b) * 64 + c] + red[(2 * 8 + b) * 64 + c] + red[(3 * 8 + b) * 64 + c];
      MOD[(size_t)(l * 8 + b) * 9216 + n0 + c] = s + p.in[3][(size_t)l * 9216 + n0 + c];
    }
    __syncthreads();
  }
}

__device__ __forceinline__ void phase_norm(const float* xin, float* xout, const u16* y, const float* postg, const float* gate, float wgt,
                           const float* preg, const float* shift, const float* scale, u16* h) {
  const int lane = tidx() & 63, wid = tidx() >> 6;
  for (int row = blockIdx.x * 4 + wid; row < T; row += gridDim.x * 4) {
    const int b = row >> 12;
    float4 xv[4];
#pragma unroll
    for (int i = 0; i < 4; ++i) xv[i] = *(const float4*)(xin + (size_t)row * D + i * 256 + lane * 4);
    if (y) {
      float yv[4][4]; float ss = 0.f;
#pragma unroll
      for (int i = 0; i < 4; ++i) {
        uint2 u = *(const uint2*)(y + (size_t)row * D + i * 256 + lane * 4);
        yv[i][0] = bf2f((u16)(u.x & 0xffff)); yv[i][1] = bf2f((u16)(u.x >> 16));
        yv[i][2] = bf2f((u16)(u.y & 0xffff)); yv[i][3] = bf2f((u16)(u.y >> 16));
        ss += yv[i][0] * yv[i][0] + yv[i][1] * yv[i][1] + yv[i][2] * yv[i][2] + yv[i][3] * yv[i][3];
      }
      ss = wave_sum(ss);
      const float rs = rsqrtf(ss * (1.f / 1024.f) + 1e-6f) * wgt;
#pragma unroll
      for (int i = 0; i < 4; ++i) {
        const int c = i * 256 + lane * 4;
        float4 g = *(const float4*)(gate + (size_t)b * 9216 + c);
        float4 pg = *(const float4*)(postg + c);
        xv[i].x += g.x * yv[i][0] * rs * pg.x; xv[i].y += g.y * yv[i][1] * rs * pg.y;
        xv[i].z += g.z * yv[i][2] * rs * pg.z; xv[i].w += g.w * yv[i][3] * rs * pg.w;
      }
    }
    if (xout) {
#pragma unroll
      for (int i = 0; i < 4; ++i) *(float4*)(xout + (size_t)row * D + i * 256 + lane * 4) = xv[i];
    }
    if (h) {
      float ss = 0.f;
#pragma unroll
      for (int i = 0; i < 4; ++i) ss += xv[i].x * xv[i].x + xv[i].y * xv[i].y + xv[i].z * xv[i].z + xv[i].w * xv[i].w;
      ss = wave_sum(ss);
      const float rs = rsqrtf(ss * (1.f / 1024.f) + 1e-6f);
#pragma unroll
      for (int i = 0; i < 4; ++i) {
        const int c = i * 256 + lane * 4;
        float4 pg = *(const float4*)(preg + c);
        float4 sh = *(const float4*)(shift + (size_t)b * 9216 + c);
        float4 sc = *(const float4*)(scale + (size_t)b * 9216 + c);
        uint2 o;
        o.x = pack2(xv[i].x * rs * pg.x * (1.f + sc.x) + sh.x, xv[i].y * rs * pg.y * (1.f + sc.y) + sh.y);
        o.y = pack2(xv[i].z * rs * pg.z * (1.f + sc.z) + sh.z, xv[i].w * rs * pg.w * (1.f + sc.w) + sh.w);
        *(uint2*)(h + (size_t)row * D + c) = o;
      }
    }
  }
}

template <int NS, class FA, class FB>
__device__ __forceinline__ void gemm_loop(f32x4 (&acc)[4][NS], const FA& fa, const FB& fb, int K, u16* sm) {
  constexpr int BN = 32 * NS;
  constexpr int NBV = BN / 32;
  const int tid = tidx(), lane = tid & 63, wid = tid >> 6, wr = wid >> 1, wc = wid & 1, fr = lane & 15, fq = lane >> 4;
  u16* As = sm; u16* Bs = sm + 2 * 128 * 64;
  uint4 ra0[4], rb0[NBV], ra1[4], rb1[NBV];
  const int nt = K >> 6;
  const int lrow = tid >> 3, lk = (tid & 7) * 8;
  const int lsw = lrow * 64 + (((tid & 7) ^ ((lrow >> 1) & 7)) << 3);
  const int c0 = (fq ^ ((fr >> 1) & 7)) << 3, c1 = c0 ^ 32;
#define G_LOAD(RA, RB, KT) { const int kb_ = (KT) << 6; \
    _Pragma("unroll") for (int i = 0; i < 4; ++i) RA[i] = fa(lrow + 32 * i, kb_ + lk); \
    _Pragma("unroll") for (int i = 0; i < NBV; ++i) RB[i] = fb(lrow + 32 * i, kb_ + lk); }
#define G_STORE(RA, RB, BUF) { u16* Aw_ = As + (BUF) * 128 * 64 + lsw; u16* Bw_ = Bs + (BUF) * BN * 64 + lsw; \
    _Pragma("unroll") for (int i = 0; i < 4; ++i) *(uint4*)(Aw_ + i * 32 * 64) = RA[i]; \
    _Pragma("unroll") for (int i = 0; i < NBV; ++i) *(uint4*)(Bw_ + i * 32 * 64) = RB[i]; }
#define G_COMPUTE(BUF) { const u16* Ab = As + (BUF) * 128 * 64 + (wr * 64 + fr) * 64; \
    const u16* Bb = Bs + (BUF) * BN * 64 + (wc * 16 * NS + fr) * 64; \
    _Pragma("unroll") for (int ks = 0; ks < 2; ++ks) { bf16x8 a[4], b[NS]; const int co = ks ? c1 : c0; \
      _Pragma("unroll") for (int m = 0; m < 4; ++m) a[m] = *(const bf16x8*)(Ab + m * 16 * 64 + co); \
      _Pragma("unroll") for (int n = 0; n < NS; ++n) b[n] = *(const bf16x8*)(Bb + n * 16 * 64 + co); \
      _Pragma("unroll") for (int m = 0; m < 4; ++m) _Pragma("unroll") for (int n = 0; n < NS; ++n) acc[m][n] = mfma16(a[m], b[n], acc[m][n]); } }
  G_LOAD(ra0, rb0, 0)
  if (nt > 1) G_LOAD(ra1, rb1, 1)
  G_STORE(ra0, rb0, 0)
  __syncthreads();
#pragma unroll 1
  for (int kt = 0; kt < nt; kt += 2) {
    if (kt + 2 < nt) G_LOAD(ra0, rb0, kt + 2)
    G_COMPUTE(0)
    if (kt + 1 < nt) G_STORE(ra1, rb1, 1)
    __syncthreads();
    if (kt + 1 >= nt) break;
    if (kt + 3 < nt) G_LOAD(ra1, rb1, kt + 3)
    G_COMPUTE(1)
    if (kt + 2 < nt) G_STORE(ra0, rb0, 0)
    __syncthreads();
  }
#undef G_LOAD
#undef G_STORE
#undef G_COMPUTE
}

__device__ __forceinline__ bool tile_map(int it, int NT, int& mt, int& nt) {
  const int g = gridDim.x;
  if ((g & 7) == 0) {
    const int xcd = blockIdx.x & 7, bx = blockIdx.x >> 3, nbx = g >> 3;
    const int lid = bx + it * nbx;
    if (lid >= 32 * NT) return false;
    const int grp = lid / (8 * NT), rem = lid - grp * 8 * NT;
    nt = rem >> 3; mt = xcd * 32 + grp * 8 + (rem & 7);
    return true;
  } else {
    const int id = blockIdx.x + it * g;
    if (id >= 256 * NT) return false;
    nt = id % NT; mt = id / NT;
    return true;
  }
}

#define ZERO_ACC(acc, NSV) _Pragma("unroll") for (int m_ = 0; m_ < 4; ++m_) _Pragma("unroll") for (int n_ = 0; n_ < NSV; ++n_) acc[m_][n_] = f32x4{0.f, 0.f, 0.f, 0.f};

__device__ __forceinline__ void phase_ffn_in(const Params& p, char* smem) {
  const u16* H = (const u16*)(p.ws + OFF_H); const u16* W = (const u16*)(p.ws + OFF_WIN); u16* ACT = (u16*)(p.ws + OFF_ACT);
  const int lane = tidx() & 63, wid = tidx() >> 6, wr = wid >> 1, wc = wid & 1, fr = lane & 15, fq = lane >> 4;
  int mt, nt;
  for (int it = 0; tile_map(it, 44, mt, nt); ++it) {
    const int m0 = mt * 128, n0 = nt * 128;
    f32x4 acc[4][4]; ZERO_ACC(acc, 4)
    const char* Ab_ = (const char*)(H + (size_t)m0 * 1024); const char* Bb_ = (const char*)(W + (size_t)n0 * 1024);
    auto fa = [&](int r, int k) { return *(const uint4*)(Ab_ + (unsigned)((r * 1024 + k) * 2)); };
    auto fb = [&](int r, int k) { return *(const uint4*)(Bb_ + (unsigned)((r * 1024 + k) * 2)); };
    gemm_loop<4>(acc, fa, fb, 1024, (u16*)smem);
#pragma unroll
    for (int m = 0; m < 4; ++m)
#pragma unroll
      for (int n = 0; n < 2; ++n) {
        const int col = nt * 64 + wc * 32 + n * 16 + fr;
        const int r0 = m0 + wr * 64 + m * 16 + fq * 4;
#pragma unroll
        for (int j = 0; j < 4; ++j) ACT[(size_t)(r0 + j) * DFF + col] = f2bf(siluf_(acc[m][n][j]) * acc[m][n + 2][j]);
      }
  }
}

__device__ __forceinline__ void phase_gemm_plain(const u16* A, int lda, const u16* Bt, int K, u16* C, char* smem) {
  const int lane = tidx() & 63, wid = tidx() >> 6, wr = wid >> 1, wc = wid & 1, fr = lane & 15, fq = lane >> 4;
  int mt, nt;
  for (int it = 0; tile_map(it, 8, mt, nt); ++it) {
    const int m0 = mt * 128, n0 = nt * 128;
    f32x4 acc[4][4]; ZERO_ACC(acc, 4)
    const char* Ab_ = (const char*)(A + (size_t)m0 * lda); const char* Bb_ = (const char*)(Bt + (size_t)n0 * K);
    auto fa = [&](int r, int k) { return *(const uint4*)(Ab_ + (unsigned)((r * lda + k) * 2)); };
    auto fb = [&](int r, int k) { return *(const uint4*)(Bb_ + (unsigned)((r * K + k) * 2)); };
    gemm_loop<4>(acc, fa, fb, K, (u16*)smem);
#pragma unroll
    for (int m = 0; m < 4; ++m)
#pragma unroll
      for (int n = 0; n < 4; ++n) {
        const int col = n0 + wc * 64 + n * 16 + fr;
        const int r0 = m0 + wr * 64 + m * 16 + fq * 4;
#pragma unroll
        for (int j = 0; j < 4; ++j) C[(size_t)(r0 + j) * 1024 + col] = f2bf(acc[m][n][j]);
      }
  }
}

__device__ __forceinline__ void phase_inproj(const Params& p, char* smem) {
  const u16* H = (const u16*)(p.ws + OFF_H); const u16* W = (const u16*)(p.ws + OFF_WMIX);
  u16* P1 = (u16*)(p.ws + OFF_P1); u16* P2 = (u16*)(p.ws + OFF_P2); u16* VT = (u16*)(p.ws + OFF_VT); u16* PB = (u16*)(p.ws + OFF_PB);
  const int lane = tidx() & 63, wid = tidx() >> 6, wr = wid >> 1, wc = wid & 1, fr = lane & 15, fq = lane >> 4;
  int mt, nt;
  for (int it = 0; tile_map(it, 33, mt, nt); ++it) {
    const int m0 = mt * 128, n0 = nt * 128;
    f32x4 acc[4][4]; ZERO_ACC(acc, 4)
    const char* Ab_ = (const char*)(H + (size_t)m0 * 1024); const char* Bb_ = (const char*)(W + (size_t)n0 * 1024);
    auto fa = [&](int r, int k) { return *(const uint4*)(Ab_ + (unsigned)((r * 1024 + k) * 2)); };
    auto fb = [&](int r, int k) { return *(const uint4*)(Bb_ + (unsigned)((r * 1024 + k) * 2)); };
    gemm_loop<4>(acc, fa, fb, 1024, (u16*)smem);
#pragma unroll
    for (int m = 0; m < 4; ++m)
#pragma unroll
      for (int nn = 0; nn < 4; ++nn) {
        const int n = n0 + wc * 64 + nn * 16 + fr;
        if (n >= MIXN) continue;
        const int r0 = m0 + wr * 64 + m * 16 + fq * 4;
        f32x4 v = acc[m][nn];
        if ((n >= 896 && n < 1024) || (n >= 1152 && n < 1280)) {
          const int which = (n >= 1152) ? 1 : 0;
          const int gd = n - (which ? 1152 : 896);
          const int b = r0 >> 12, t = r0 & 4095;
          uint2 o; o.x = pack2(v[0], v[1]); o.y = pack2(v[2], v[3]);
          *(uint2*)(VT + ((size_t)((which * 8 + b) * 128 + gd)) * 4096 + (t & ~31) + 8 * fq + 4 * (m & 1)) = o;
        } else if (n < 1304) {
          const int pc = (n < 896) ? n : ((n < 1152) ? n - 128 : n - 256);
          if (n < 512) { const float qs = 0.125f * 1.4426950408889634f; v[0] *= qs; v[1] *= qs; v[2] *= qs; v[3] *= qs; }
          if (n >= 1280) { v[0] = sigmoidf_(v[0]); v[1] = sigmoidf_(v[1]); v[2] = sigmoidf_(v[2]); v[3] = sigmoidf_(v[3]); }
#pragma unroll
          for (int j = 0; j < 4; ++j) P1[(size_t)(r0 + j) * PS1 + pc] = f2bf(v[j]);
        } else if (n < 2328) {
#pragma unroll
          for (int j = 0; j < 4; ++j) P1[(size_t)(r0 + j) * PS1 + (n - 256)] = f2bf(geluf_(v[j]));
        } else {
          const int pc = n - 2328;
#pragma unroll
          for (int j = 0; j < 4; ++j) P2[(size_t)(r0 + j) * PS2 + pc] = f2bf(v[j]);
          if ((m & 1) && fq == 3) PB[(size_t)((r0 + 3) >> 5) * 1792 + pc] = f2bf(v[3]);
        }
      }
  }
}

__device__ __forceinline__ void phase_merge(const Params& p, char* smem) {
  const u16* H2 = (const u16*)(p.ws + OFF_H); const u16* WG = (const u16*)(p.ws + OFF_WG); const u16* WB = (const u16*)(p.ws + OFF_WB);
  const u16* P1 = (const u16*)(p.ws + OFF_P1); u16* MG = (u16*)(p.ws + OFF_MERGED);
  const int lane = tidx() & 63, wid = tidx() >> 6, wr = wid >> 1, wc = wid & 1, fr = lane & 15, fq = lane >> 4;
  int mt, nt;
  for (int it = 0; tile_map(it, 16, mt, nt); ++it) {
    const int m0 = mt * 128, n0 = nt * 64;
    f32x4 tot[4][2]; ZERO_ACC(tot, 2)
#pragma unroll 1
    for (int i = 0; i < 3; ++i) {
      unsigned gpk[4][2][2];
      {
        f32x4 ag[4][2]; ZERO_ACC(ag, 2)
        const char* Ab2_ = (const char*)(H2 + (size_t)m0 * 1024); const char* Bb2_ = (const char*)(WG + (size_t)(i * 1024 + n0) * 1024);
        auto fa2 = [&](int r, int k) { return *(const uint4*)(Ab2_ + (unsigned)((r * 1024 + k) * 2)); };
        auto fb2 = [&](int r, int k) { return *(const uint4*)(Bb2_ + (unsigned)((r * 1024 + k) * 2)); };
        gemm_loop<2>(ag, fa2, fb2, 1024, (u16*)smem);
#pragma unroll
        for (int m = 0; m < 4; ++m)
#pragma unroll
          for (int n = 0; n < 2; ++n) {
            gpk[m][n][0] = pack2(sigmoidf_(ag[m][n][0]), sigmoidf_(ag[m][n][1]));
            gpk[m][n][1] = pack2(sigmoidf_(ag[m][n][2]), sigmoidf_(ag[m][n][3]));
          }
      }
      f32x4 ay[4][2]; ZERO_ACC(ay, 2)
      const u16* ya = (i == 0) ? P1 : ((i == 1) ? P1 + 1048 : P1 + 1560);
      const int lda = PS1;
      const u16* wb = WB + (size_t)i * 1024 * 512;
      const char* Ab_ = (const char*)(ya + (size_t)m0 * lda); const char* Bb_ = (const char*)(wb + (size_t)n0 * 512);
      auto fa = [&](int r, int k) { return *(const uint4*)(Ab_ + (unsigned)((r * lda + k) * 2)); };
      auto fb = [&](int r, int k) { return *(const uint4*)(Bb_ + (unsigned)((r * 512 + k) * 2)); };
      gemm_loop<2>(ay, fa, fb, 512, (u16*)smem);
#pragma unroll
      for (int m = 0; m < 4; ++m)
#pragma unroll
        for (int n = 0; n < 2; ++n) {
          tot[m][n][0] += bf2f((u16)(gpk[m][n][0] & 0xffff)) * ay[m][n][0];
          tot[m][n][1] += bf2f((u16)(gpk[m][n][0] >> 16)) * ay[m][n][1];
          tot[m][n][2] += bf2f((u16)(gpk[m][n][1] & 0xffff)) * ay[m][n][2];
          tot[m][n][3] += bf2f((u16)(gpk[m][n][1] >> 16)) * ay[m][n][3];
        }
    }
#pragma unroll
    for (int m = 0; m < 4; ++m)
#pragma unroll
      for (int n = 0; n < 2; ++n) {
        const int col = n0 + wc * 32 + n * 16 + fr;
        const int r0 = m0 + wr * 64 + m * 16 + fq * 4;
#pragma unroll
        for (int j = 0; j < 4; ++j) MG[(size_t)(r0 + j) * 1024 + col] = f2bf(tot[m][n][j]);
      }
  }
}

__device__ __forceinline__ void phase_cmp1(const Params& p, int l, char* smem) {
  const u16* P1 = (const u16*)(p.ws + OFF_P1); const u16* W1 = (const u16*)(p.ws + OFF_W1); u16* HID = (u16*)(p.ws + OFF_HID);
  const int lane = tidx() & 63, wid = tidx() >> 6, wr = wid >> 1, wc = wid & 1, fr = lane & 15, fq = lane >> 4;
  for (int tix = blockIdx.x; tix < 128; tix += gridDim.x) {
    const int which = tix >> 6, mt = (tix >> 1) & 31, nt = tix & 1;
    const int m0 = mt * 128, n0 = nt * 128;
    const float* pe = (which ? p.in[16] : p.in[13]) + (size_t)l * 2048;
    const u16* w1 = W1 + (size_t)which * 256 * 2048;
    const int cbase = 512 + which * 128;
    f32x4 acc[4][4]; ZERO_ACC(acc, 4)
    auto fa = [&](int r, int k) {
      const int row = m0 + r; const int g = row & 1, n = (row >> 1) & 255, b = row >> 9;
      uint4 o = make_uint4(0, 0, 0, 0);
      if (n < 255) {
        const int lpos = k >> 6, d = k & 63;
        uint4 raw = *(const uint4*)(P1 + (size_t)(b * 4096 + 16 * n + lpos) * PS1 + cbase + g * 64 + d);
        const float* pp = pe + lpos * 64 + d;
        float4 e0 = *(const float4*)pp, e1 = *(const float4*)(pp + 4);
        o.x = pack2(bf2f((u16)(raw.x & 0xffff)) + e0.x, bf2f((u16)(raw.x >> 16)) + e0.y);
        o.y = pack2(bf2f((u16)(raw.y & 0xffff)) + e0.z, bf2f((u16)(raw.y >> 16)) + e0.w);
        o.z = pack2(bf2f((u16)(raw.z & 0xffff)) + e1.x, bf2f((u16)(raw.z >> 16)) + e1.y);
        o.w = pack2(bf2f((u16)(raw.w & 0xffff)) + e1.z, bf2f((u16)(raw.w >> 16)) + e1.w);
      }
      return o;
    };
    auto fb = [&](int r, int k) { return *(const uint4*)(w1 + (size_t)(n0 + r) * 2048 + k); };
    gemm_loop<4>(acc, fa, fb, 2048, (u16*)smem);
#pragma unroll
    for (int m = 0; m < 4; ++m)
#pragma unroll
      for (int n = 0; n < 4; ++n) {
        const int col = n0 + wc * 64 + n * 16 + fr;
        const int r0 = m0 + wr * 64 + m * 16 + fq * 4;
#pragma unroll
        for (int j = 0; j < 4; ++j) HID[((size_t)which * 4096 + r0 + j) * 256 + col] = f2bf(siluf_(acc[m][n][j]));
      }
  }
}

__device__ __forceinline__ void phase_cmp2(const Params& p, int l) {
  const u16* HID = (const u16*)(p.ws + OFF_HID); u16* KC = (u16*)(p.ws + OFF_KC); u16* VC = (u16*)(p.ws + OFF_VC);
  const int total = 2 * 4096 * 64;
  for (int idx = blockIdx.x * 256 + tidx(); idx < total; idx += gridDim.x * 256) {
    const int d = idx & 63, row = (idx >> 6) & 4095, which = idx >> 18;
    const float* w2 = (which ? p.in[15] : p.in[12]) + (size_t)l * 256 * 64;
    const u16* hr = HID + ((size_t)which * 4096 + row) * 256;
    float acc = 0.f;
#pragma unroll 8
    for (int j = 0; j < 256; ++j) acc += bf2f(hr[j]) * w2[j * 64 + d];
    const int g = row & 1, n = (row >> 1) & 255, b = row >> 9;
    if (which == 0) KC[((size_t)(b * 2 + g) * 256 + n) * 64 + d] = f2bf(acc);
    else {
      const int u = n & 31; const int pp = 8 * ((u >> 2) & 3) + 4 * (u >> 4) + (u & 3);
      VC[((size_t)(b * 2 + g) * 64 + d) * 256 + (n & ~31) + pp] = f2bf(acc);
    }
  }
}

__device__ __forceinline__ void phase_sgu(const Params& p, int l, char* smem) {
  u16* P1 = (u16*)(p.ws + OFF_P1);
  u16* Wt = (u16*)smem;
  u16* Vt = Wt + 128 * 136;
  float* st = (float*)(Vt + 128 * 136);
  const int tid = tidx(), lane = tid & 63, wid = tid >> 6, wr = wid >> 1, wc = wid & 1, fr = lane & 15, fq = lane >> 4;
  const float* lng = p.in[17] + (size_t)l * 512; const float* lnb = p.in[18] + (size_t)l * 512;
  for (int item = blockIdx.x; item < 1024; item += gridDim.x) {
    const int ci = item >> 2, gi = item & 3;
    const int tok0 = ci * 128;
#pragma unroll 1
    for (int r0 = wid * 32; r0 < wid * 32 + 32; r0 += 8) {
      uint4 raw[8];
#pragma unroll
      for (int u = 0; u < 8; ++u) raw[u] = *(const uint4*)(P1 + (size_t)(tok0 + r0 + u) * PS1 + 1560 + lane * 8);
#pragma unroll
      for (int u = 0; u < 8; ++u) {
        float f[8];
        f[0] = bf2f((u16)(raw[u].x & 0xffff)); f[1] = bf2f((u16)(raw[u].x >> 16)); f[2] = bf2f((u16)(raw[u].y & 0xffff)); f[3] = bf2f((u16)(raw[u].y >> 16));
        f[4] = bf2f((u16)(raw[u].z & 0xffff)); f[5] = bf2f((u16)(raw[u].z >> 16)); f[6] = bf2f((u16)(raw[u].w & 0xffff)); f[7] = bf2f((u16)(raw[u].w >> 16));
        float s = 0.f, s2 = 0.f;
#pragma unroll
        for (int e = 0; e < 8; ++e) { s += f[e]; }
        s = wave_sum(s);
        const float mu = s * (1.f / 512.f);
#pragma unroll
        for (int e = 0; e < 8; ++e) { float dlt = f[e] - mu; s2 += dlt * dlt; }
        s2 = wave_sum(s2);
        if (lane == 0) { st[(r0 + u) * 2] = mu; st[(r0 + u) * 2 + 1] = rsqrtf(s2 * (1.f / 512.f) + 1e-5f); }
      }
    }
    const float* wsrc = p.in[19] + ((size_t)(l * 4 + gi)) * 128 * 128;
    for (int e = tid; e < 128 * 32; e += 256) {
      const int t = e >> 5, s4 = (e & 31) * 4;
      float4 w = *(const float4*)(wsrc + t * 128 + s4);
      uint2 o;
      o.x = pack2(s4 + 0 <= t ? w.x : 0.f, s4 + 1 <= t ? w.y : 0.f);
      o.y = pack2(s4 + 2 <= t ? w.z : 0.f, s4 + 3 <= t ? w.w : 0.f);
      *(uint2*)(Wt + t * 136 + s4) = o;
    }
    __syncthreads();
    for (int e = tid; e < 128 * 16; e += 256) {
      const int s = e >> 4, c8 = (e & 15) * 8;
      uint4 raw = *(const uint4*)(P1 + (size_t)(tok0 + s) * PS1 + 1560 + gi * 128 + c8);
      const float mu = st[s * 2], rs = st[s * 2 + 1];
      u16 rv[8] = {(u16)(raw.x & 0xffff), (u16)(raw.x >> 16), (u16)(raw.y & 0xffff), (u16)(raw.y >> 16), (u16)(raw.z & 0xffff), (u16)(raw.z >> 16), (u16)(raw.w & 0xffff), (u16)(raw.w >> 16)};
#pragma unroll
      for (int i = 0; i < 8; ++i) {
        const int c = gi * 128 + c8 + i;
        Vt[(c8 + i) * 136 + s] = f2bf((bf2f(rv[i]) - mu) * rs * lng[c] + lnb[c]);
      }
    }
    __syncthreads();
    f32x4 acc[4][4]; ZERO_ACC(acc, 4)
#pragma unroll 1
    for (int ks = 0; ks < 4; ++ks) {
      bf16x8 a[4], b[4];
#pragma unroll
      for (int m = 0; m < 4; ++m) a[m] = *(const bf16x8*)(Wt + (wr * 64 + m * 16 + fr) * 136 + ks * 32 + fq * 8);
#pragma unroll
      for (int n = 0; n < 4; ++n) b[n] = *(const bf16x8*)(Vt + (wc * 64 + n * 16 + fr) * 136 + ks * 32 + fq * 8);
#pragma unroll
      for (int m = 0; m < 4; ++m)
#pragma unroll
        for (int n = 0; n < 4; ++n) acc[m][n] = mfma16(a[m], b[n], acc[m][n]);
    }
    const float* bs = p.in[20] + ((size_t)(l * 4 + gi)) * 128;
#pragma unroll
    for (int m = 0; m < 4; ++m)
#pragma unroll
      for (int n = 0; n < 4; ++n) {
        const int c = wc * 64 + n * 16 + fr;
#pragma unroll
        for (int j = 0; j < 4; ++j) {
          const int t = wr * 64 + m * 16 + fq * 4 + j;
          u16* up = P1 + (size_t)(tok0 + t) * PS1 + 1048 + gi * 128 + c;
          *up = f2bf(bf2f(*up) * (acc[m][n][j] + bs[t]));
        }
      }
    __syncthreads();
  }
}

__device__ __forceinline__ void phase_prep1(const Params& p, int l) {
  u16* P2 = (u16*)(p.ws + OFF_P2); const u16* PB = (const u16*)(p.ws + OFF_PB); u16* VF = (u16*)(p.ws + OFF_VFIRST);
  const float* mu = p.in[21] + (size_t)l * 1792;
  const int total = 1024 * 224;
  for (int idx = blockIdx.x * 256 + tidx(); idx < total; idx += gridDim.x * 256) {
    const int tile = idx / 224, cg8 = (idx % 224) * 8;
    const int tok0 = tile * 32;
    float m8[8];
#pragma unroll
    for (int e = 0; e < 8; ++e) m8[e] = mu[cg8 + e];
    uint4 prev = make_uint4(0, 0, 0, 0);
    if ((tok0 & 4095) != 0) prev = *(const uint4*)(PB + (size_t)(tile - 1) * 1792 + cg8);
    for (int r = 0; r < 32; ++r) {
      u16* ptr = P2 + (size_t)(tok0 + r) * PS2 + cg8;
      uint4 cur = *(const uint4*)ptr;
      unsigned cu[4] = {cur.x, cur.y, cur.z, cur.w}, pu[4] = {prev.x, prev.y, prev.z, prev.w};
      float o[8];
#pragma unroll
      for (int e = 0; e < 8; ++e) {
        float c = bf2f((u16)((cu[e >> 1] >> ((e & 1) * 16)) & 0xffff));
        float pv = bf2f((u16)((pu[e >> 1] >> ((e & 1) * 16)) & 0xffff));
        float s = c + (pv - c) * m8[e];
        if (cg8 >= 1536 && cg8 < 1600) s = tanhf_(s);
        else if (cg8 >= 1664) s = sigmoidf_(s);
        o[e] = s;
      }
      uint4 ov; ov.x = pack2(o[0], o[1]); ov.y = pack2(o[2], o[3]); ov.z = pack2(o[4], o[5]); ov.w = pack2(o[6], o[7]);
      *(uint4*)ptr = ov;
      if (l == 0 && cg8 >= 1024 && cg8 < 1536) *(uint4*)(VF + (size_t)(tok0 + r) * 512 + cg8 - 1024) = ov;
      prev = cur;
    }
  }
}

__device__ __forceinline__ void phase_prep2(const Params& p, int l, char* smem) {
  u16* P2 = (u16*)(p.ws + OFF_P2); const u16* VF = (const u16*)(p.ws + OFF_VFIRST);
  float* twd = (float*)smem;
  float* adl = twd + 1024;
  float* vsh = adl + 1024;
  float* lv = vsh + 8192;
  const int tid = tidx();
  const float* w0 = p.in[22] + (size_t)l * 512; const float* w2 = p.in[23] + (size_t)l * 64 * 512;
  const float* a0 = p.in[24] + (size_t)l * 512; const float* a2 = p.in[25] + (size_t)l * 64 * 512;
  const float* kkp = p.in[27] + (size_t)l * 512; const float* kap = p.in[28] + (size_t)l * 512;
  for (int item = blockIdx.x; item < 2048; item += gridDim.x) {
    const int tok0 = item * 16;
    for (int e = tid; e < 2048; e += 256) {
      const int r = e >> 7, c = e & 127;
      twd[(c >> 6) * 1024 + r * 64 + (c & 63)] = bf2f(P2[(size_t)(tok0 + r) * PS2 + 1536 + c]);
    }
    if (l > 0) {
      for (int e = tid; e < 8192; e += 256) { const int r = e >> 9, c = e & 511; vsh[e] = bf2f(P2[(size_t)(tok0 + r) * PS2 + 1024 + c]); }
    }
    __syncthreads();
    if (l > 0) {
      const float* v1 = p.in[33];
      for (int e = tid; e < 512; e += 256) {
        const int r = e >> 5, j = e & 31;
        float s = 0.f;
#pragma unroll 2
        for (int c = 0; c < 512; c += 4) {
          const float4 t4 = *(const float4*)(vsh + r * 512 + c);
          s += t4.x * v1[c * 32 + j] + t4.y * v1[(c + 1) * 32 + j] + t4.z * v1[(c + 2) * 32 + j] + t4.w * v1[(c + 3) * 32 + j];
        }
        lv[r * 32 + j] = s;
      }
      __syncthreads();
    }
    {
      float aw[2][16], aa[2][16], am[2][16];
#pragma unroll
      for (int c = 0; c < 2; ++c)
#pragma unroll
        for (int r = 0; r < 16; ++r) { aw[c][r] = 0.f; aa[c][r] = 0.f; am[c][r] = 0.f; }
#pragma unroll 2
      for (int i = 0; i < 64; i += 4) {
        float wv[2][4], av[2][4];
#pragma unroll
        for (int c = 0; c < 2; ++c)
#pragma unroll
          for (int u = 0; u < 4; ++u) { wv[c][u] = w2[(i + u) * 512 + tid + c * 256]; av[c][u] = a2[(i + u) * 512 + tid + c * 256]; }
#pragma unroll
        for (int r = 0; r < 16; ++r) {
          const float4 tw = *(const float4*)(twd + r * 64 + i);
          const float4 ta = *(const float4*)(adl + r * 64 + i);
#pragma unroll
          for (int c = 0; c < 2; ++c) {
            aw[c][r] += tw.x * wv[c][0] + tw.y * wv[c][1] + tw.z * wv[c][2] + tw.w * wv[c][3];
            aa[c][r] += ta.x * av[c][0] + ta.y * av[c][1] + ta.z * av[c][2] + ta.w * av[c][3];
          }
        }
      }
      if (l > 0) {
        const float* v2 = p.in[34];
#pragma unroll 2
        for (int j = 0; j < 32; j += 4) {
          float vv[2][4];
#pragma unroll
          for (int c = 0; c < 2; ++c)
#pragma unroll
            for (int u = 0; u < 4; ++u) vv[c][u] = v2[(j + u) * 512 + tid + c * 256];
#pragma unroll
          for (int r = 0; r < 16; ++r) {
            const float4 t4 = *(const float4*)(lv + r * 32 + j);
#pragma unroll
            for (int c = 0; c < 2; ++c) am[c][r] += t4.x * vv[c][0] + t4.y * vv[c][1] + t4.z * vv[c][2] + t4.w * vv[c][3];
          }
        }
      }
#pragma unroll
      for (int c = 0; c < 2; ++c) {
        const int ch = tid + c * 256;
        const float w0v = w0[ch], a0v = a0[ch], kkv = kkp[ch], kav = kap[ch];
        const float v0v = (l > 0) ? p.in[32][ch] : 0.f;
        float kval[16];
#pragma unroll
        for (int r = 0; r < 16; ++r) kval[r] = bf2f(P2[(size_t)(tok0 + r) * PS2 + 512 + ch]);
#pragma unroll
        for (int r = 0; r < 16; ++r) {
          u16* row = P2 + (size_t)(tok0 + r) * PS2;
          const float wpre = w0v + aw[c][r];
          const float nx = -wpre;
          const float sp = fmaxf(nx, 0.f) + __logf(1.f + __expf(-fabsf(nx)));
          const float w = -sp - 0.5f;
          const float decay = __expf(-__expf(w));
          const float a = sigmoidf_(a0v + aa[c][r]);
          const float kk = kval[r] * kkv;
          const float ss = wave_sum(kk * kk);
          const float kkn = kk / fmaxf(sqrtf(ss), 1e-12f);
          row[1792 + ch] = f2bf(decay);
          row[2304 + ch] = f2bf(kkn);
          row[2816 + ch] = f2bf(kkn * a);
          row[512 + ch] = f2bf(kval[r] * (1.f + (a - 1.f) * kav));
          if (l > 0) {
            const float v = vsh[r * 512 + ch];
            const float vf = bf2f(VF[(size_t)(tok0 + r) * 512 + ch]);
            row[1024 + ch] = f2bf(v + (vf - v) * sigmoidf_(v0v + am[c][r]));
          }
        }
      }
    }
    __syncthreads();
  }
}

__device__ __forceinline__ void scan_item(const Params& p, int item, char* smem) {
  const u16* P2 = (const u16*)(p.ws + OFF_P2); u16* YC = (u16*)(p.ws + OFF_P1) + 1560;
  float* vb = (float*)smem;
  float* yb = vb + 2 * 6 * 16 * 64;
  const int tid = tidx(), lane = tid & 63, wid = tid >> 6;
  const int rq = item & 3, h = (item >> 2) & 7, b = item >> 5;
  const int rl = lane >> 4, cq = lane & 15;
  const int rloc = wid * 4 + rl;
  const int ihead = rq * 16 + rloc;
  const int j0 = cq * 4;
  const size_t tokb = (size_t)b * 4096;
  float s0 = 0.f, s1 = 0.f, s2 = 0.f, s3 = 0.f;
  uint4 pre[3];
  auto gload = [&](int c) {
#pragma unroll
    for (int i = 0; i < 3; ++i) {
      const int v = tid + i * 256; const int vec = v >> 7, rem = v & 127, step = rem >> 3, c8 = rem & 7;
      const int off = (vec == 0) ? 0 : (vec == 1) ? 1792 : (vec == 2) ? 512 : (vec == 3) ? 1024 : (vec == 4) ? 2304 : 2816;
      pre[i] = *(const uint4*)(P2 + (tokb + c * 16 + step) * PS2 + off + h * 64 + c8 * 8);
    }
  };
  auto lstore = [&](int buf) {
#pragma unroll
    for (int i = 0; i < 3; ++i) {
      const int v = tid + i * 256; const int vec = v >> 7, rem = v & 127, step = rem >> 3, c8 = rem & 7;
      float* d = vb + ((buf * 6 + vec) * 16 + step) * 64 + c8 * 8;
      float4 f0, f1;
      f0.x = bf2f((u16)(pre[i].x & 0xffff)); f0.y = bf2f((u16)(pre[i].x >> 16)); f0.z = bf2f((u16)(pre[i].y & 0xffff)); f0.w = bf2f((u16)(pre[i].y >> 16));
      f1.x = bf2f((u16)(pre[i].z & 0xffff)); f1.y = bf2f((u16)(pre[i].z >> 16)); f1.z = bf2f((u16)(pre[i].w & 0xffff)); f1.w = bf2f((u16)(pre[i].w >> 16));
      *(float4*)d = f0; *(float4*)(d + 4) = f1;
    }
  };
  gload(0); lstore(0);
  __syncthreads();
  for (int c = 0; c < 256; ++c) {
    const int buf = c & 1;
    if (c + 1 < 256) gload(c + 1);
    const float* base = vb + buf * 6 * 16 * 64;
#pragma unroll
    for (int st = 0; st < 16; ++st) {
      const float4 r4 = *(const float4*)(base + (0 * 16 + st) * 64 + j0);
      const float4 w4 = *(const float4*)(base + (1 * 16 + st) * 64 + j0);
      const float4 k4 = *(const float4*)(base + (2 * 16 + st) * 64 + j0);
      const float vi = base[(3 * 16 + st) * 64 + ihead];
      const float4 n4 = *(const float4*)(base + (4 * 16 + st) * 64 + j0);
      const float4 b4 = *(const float4*)(base + (5 * 16 + st) * 64 + j0);
      float sa = s0 * n4.x + s1 * n4.y + s2 * n4.z + s3 * n4.w;
      sa = -dpp_sum16(sa);
      s0 = s0 * w4.x + sa * b4.x + vi * k4.x;
      s1 = s1 * w4.y + sa * b4.y + vi * k4.y;
      s2 = s2 * w4.z + sa * b4.z + vi * k4.z;
      s3 = s3 * w4.w + sa * b4.w + vi * k4.w;
      float y = s0 * r4.x + s1 * r4.y + s2 * r4.z + s3 * r4.w;
      y = dpp_sum16(y);
      yb[st * 16 + rloc] = y;
    }
    __syncthreads();
    {
      const int st = tid >> 4, r = tid & 15;
      YC[(tokb + c * 16 + st) * PS1 + h * 64 + rq * 16 + r] = f2bf(yb[st * 16 + r]);
    }
    if (c + 1 < 256) lstore(buf ^ 1);
    __syncthreads();
  }
}

__device__ __forceinline__ void phase_post(const Params& p, int l, char* smem) {
  const u16* P2 = (const u16*)(p.ws + OFF_P2); u16* YC = (u16*)(p.ws + OFF_P1) + 1560;
  float* sg = (float*)smem;
  const int tid = tidx();
  const float* g2 = p.in[26] + (size_t)l * 128 * 512;
  const float* rk = p.in[29] + (size_t)l * 512; const float* lg = p.in[30] + (size_t)l * 512; const float* lb = p.in[31] + (size_t)l * 512;
  for (int item = blockIdx.x; item < 2048; item += gridDim.x) {
    const int tok0 = item * 16;
    for (int e = tid; e < 2048; e += 256) { const int r = e >> 7, c = e & 127; sg[e] = bf2f(P2[(size_t)(tok0 + r) * PS2 + 1664 + c]); }
    __syncthreads();
    {
      float ag[2][16];
#pragma unroll
      for (int c = 0; c < 2; ++c)
#pragma unroll
        for (int r = 0; r < 16; ++r) ag[c][r] = 0.f;
#pragma unroll 4
      for (int i = 0; i < 128; i += 4) {
        float gv[2][4];
#pragma unroll
        for (int c = 0; c < 2; ++c)
#pragma unroll
          for (int u = 0; u < 4; ++u) gv[c][u] = g2[(i + u) * 512 + tid + c * 256];
#pragma unroll
        for (int r = 0; r < 16; ++r) {
          const float4 t4 = *(const float4*)(sg + r * 128 + i);
#pragma unroll
          for (int c = 0; c < 2; ++c) ag[c][r] += t4.x * gv[c][0] + t4.y * gv[c][1] + t4.z * gv[c][2] + t4.w * gv[c][3];
        }
      }
#pragma unroll
      for (int c = 0; c < 2; ++c) {
        const int ch = tid + c * 256;
        const float rkv = rk[ch], lgv = lg[ch], lbv = lb[ch];
        float yv[16], rr[16], kk[16], vv[16];
#pragma unroll
        for (int r = 0; r < 16; ++r) {
          const u16* row = P2 + (size_t)(tok0 + r) * PS2;
          yv[r] = bf2f(YC[(size_t)(tok0 + r) * PS1 + ch]);
          rr[r] = bf2f(row[ch]); kk[r] = bf2f(row[512 + ch]); vv[r] = bf2f(row[1024 + ch]);
        }
#pragma unroll
        for (int r = 0; r < 16; ++r) {
          const float mean = wave_sum(yv[r]) * (1.f / 64.f);
          const float dv = yv[r] - mean;
          const float var = wave_sum(dv * dv) * (1.f / 64.f);
          const float yn = dv * rsqrtf(var + 64e-5f) * lgv + lbv;
          const float bon = wave_sum(rr[r] * kk[r] * rkv) * vv[r];
          YC[(size_t)(tok0 + r) * PS1 + ch] = f2bf((yn + bon) * ag[c][r]);
        }
      }
    }
    __syncthreads();
  }
}

#define NEGV (-1e30f)
struct AttnState { float m[2]; float ls[2]; f32x4 ot[4][2]; };

#define MINIT (-1e20f)
template <int MODE, bool FULL>
__device__ __forceinline__ void attn_scores(f32x4 (&st)[4][2], const u16* kbase, int kstride, int key0, const bf16x8 (&qf)[2][2],
                                            const float (&slope)[2], int t, bool selbit, int c16, int q4) {
  const float fb = (float)(key0 + q4 * 4 - t);
#pragma unroll
  for (int mk = 0; mk < 4; ++mk) {
    const u16* kp = kbase + (size_t)(mk * 16 + c16) * kstride + q4 * 8;
    const bf16x8 k0 = *(const bf16x8*)kp, k1 = *(const bf16x8*)(kp + 32);
#pragma unroll
    for (int nq = 0; nq < 2; ++nq) {
      f32x4 a = {0.f, 0.f, 0.f, 0.f};
      a = mfma16(k0, qf[nq][0], a);
      a = mfma16(k1, qf[nq][1], a);
      if (FULL) {
        const float c0 = slope[nq] * fb;
#pragma unroll
        for (int j = 0; j < 4; ++j) {
          const float v = a[j] + (c0 + slope[nq] * (float)(mk * 16 + j));
          a[j] = (MODE == 1) ? (selbit ? v : NEGV) : v;
        }
      } else {
#pragma unroll
        for (int j = 0; j < 4; ++j) {
          const int key = key0 + mk * 16 + q4 * 4 + j;
          int dist; bool valid;
          if (MODE == 0) { dist = t - (16 * key + 31); valid = dist >= 0; }
          else if (MODE == 1) { dist = t - key; valid = (dist >= 0) && selbit; }
          else { dist = t - key; valid = (dist >= 0) && (dist < 512); }
          a[j] = valid ? (a[j] - slope[nq] * (float)dist) : NEGV;
        }
      }
      st[mk][nq] = a;
    }
  }
}

template <int MODE, bool FULL>
__device__ __forceinline__ void attn_tile(AttnState& S, const u16* kbase, int kstride, const u16* vtbase, int vstride, int key0,
                                          const bf16x8 (&qf)[2][2], const float (&slope)[2], int t, bool selbit, int c16, int q4) {
  f32x4 st[4][2];
  attn_scores<MODE, FULL>(st, kbase, kstride, key0, qf, slope, t, selbit, c16, q4);
  __builtin_amdgcn_sched_barrier(0);
#pragma unroll
  for (int nq = 0; nq < 2; ++nq) {
    float mx = fmaxf(fmaxf(st[0][nq][0], st[0][nq][1]), fmaxf(st[0][nq][2], st[0][nq][3]));
#pragma unroll
    for (int mk = 1; mk < 4; ++mk) mx = fmaxf(mx, fmaxf(fmaxf(st[mk][nq][0], st[mk][nq][1]), fmaxf(st[mk][nq][2], st[mk][nq][3])));
    mx = fmaxf(mx, __shfl_xor(mx, 16)); mx = fmaxf(mx, __shfl_xor(mx, 32));
    const float mnew = fmaxf(S.m[nq], mx);
    const float alpha = __builtin_amdgcn_exp2f(S.m[nq] - mnew);
    S.m[nq] = mnew;
    float ls = S.ls[nq] * alpha;
#pragma unroll
    for (int md = 0; md < 4; ++md) { S.ot[md][nq][0] *= alpha; S.ot[md][nq][1] *= alpha; S.ot[md][nq][2] *= alpha; S.ot[md][nq][3] *= alpha; }
#pragma unroll
    for (int mk = 0; mk < 4; ++mk)
#pragma unroll
      for (int j = 0; j < 4; ++j) {
        const float pv = __builtin_amdgcn_exp2f(st[mk][nq][j] - mnew);
        st[mk][nq][j] = pv; ls += pv;
      }
    S.ls[nq] = ls;
  }
#pragma unroll
  for (int s2 = 0; s2 < 2; ++s2) {
    __builtin_amdgcn_sched_barrier(0);
    bf16x8 pb[2];
#pragma unroll
    for (int nq = 0; nq < 2; ++nq) {
      uint4 u;
      u.x = pack2(st[2 * s2][nq][0], st[2 * s2][nq][1]); u.y = pack2(st[2 * s2][nq][2], st[2 * s2][nq][3]);
      u.z = pack2(st[2 * s2 + 1][nq][0], st[2 * s2 + 1][nq][1]); u.w = pack2(st[2 * s2 + 1][nq][2], st[2 * s2 + 1][nq][3]);
      pb[nq] = *(bf16x8*)&u;
    }
#pragma unroll
    for (int md = 0; md < 4; ++md) {
      const bf16x8 vf = *(const bf16x8*)(vtbase + (size_t)(md * 16 + c16) * vstride + s2 * 32 + q4 * 8);
#pragma unroll
      for (int nq = 0; nq < 2; ++nq) S.ot[md][nq] = mfma16(vf, pb[nq], S.ot[md][nq]);
    }
  }
}

__device__ __forceinline__ void attn_reset(AttnState& S) {
#pragma unroll
  for (int nq = 0; nq < 2; ++nq) { S.m[nq] = MINIT; S.ls[nq] = 0.f;
#pragma unroll
    for (int md = 0; md < 4; ++md) S.ot[md][nq] = f32x4{0.f, 0.f, 0.f, 0.f}; }
}
__device__ __forceinline__ void attn_fold(AttnState& S, float* oacc, const u16* gp, int br, float (&invl)[2], int lane) {
#pragma unroll
  for (int nq = 0; nq < 2; ++nq) {
    float l = S.ls[nq];
    l += __shfl_xor(l, 16); l += __shfl_xor(l, 32);
    const float inv = (l > 0.f) ? 1.f / l : 0.f;
    invl[nq] = inv;
    const float f = bf2f(gp[nq * 6 + br]) * inv;
#pragma unroll
    for (int md = 0; md < 4; ++md)
#pragma unroll
      for (int j = 0; j < 4; ++j) {
        float* a = oacc + ((md * 2 + nq) * 4 + j) * 64 + lane;
        const float v = f * S.ot[md][nq][j];
        if (br == 0) *a = v; else *a += v;
      }
  }
}

__device__ __forceinline__ void phase_nsa(const Params& p, char* smem, unsigned* queue) {
  u16* P1 = (u16*)(p.ws + OFF_P1);
  const u16* KC = (const u16*)(p.ws + OFF_KC); const u16* VC = (const u16*)(p.ws + OFF_VC); const u16* VT = (const u16*)(p.ws + OFF_VT);
  const int tid = tidx(), lane = tid & 63, wid = tid >> 6;
  const int c16 = lane & 15, q4 = lane >> 4, tq = lane & 7;
  float* ps = (float*)smem + wid * 2048;
  float* oacc = (float*)(smem + 32768) + wid * 2048;
  int* qslot = (int*)(smem + 65536);
#pragma unroll 1
  for (;;) {
    if (tid == 0) *qslot = (int)atomicAdd(queue, 1u);
    __syncthreads();
    const int it = *qslot;
    if (it >= 2048) break;
    const int bg = it & 15;
    const int tqd = 127 - (it >> 4);
    const int b = bg >> 1, g = bg & 1;
    const int t0 = (tqd * 4 + wid) * 8;
    const int tok0 = b * 4096 + t0;
    const int t = t0 + tq;
    const int cur = t0 >> 6;
#pragma unroll
    for (int i = 0; i < 8; ++i) *(float4*)(ps + i * 256 + lane * 4) = float4{0.f, 0.f, 0.f, 0.f};
    bf16x8 qf[2][2]; float slope[2];
    const u16* gp = P1 + (size_t)(tok0 + tq) * PS1 + 1024 + (g * 4 + (c16 >> 3)) * 3;
#pragma unroll
    for (int nq = 0; nq < 2; ++nq) {
      const int hh = nq * 2 + (c16 >> 3);
      const u16* rp = P1 + (size_t)(tok0 + tq) * PS1;
      qf[nq][0] = *(const bf16x8*)(rp + (g * 4 + hh) * 64 + q4 * 8);
      qf[nq][1] = *(const bf16x8*)(rp + (g * 4 + hh) * 64 + 32 + q4 * 8);
      slope[nq] = exp2f(-(float)(g * 4 + hh + 1)) * 1.4426950408889634f;
    }
    AttnState S;
    float invl[2];
    const u16* kcb = KC + (size_t)(b * 2 + g) * 256 * 64;
    const u16* vcb = VC + (size_t)(b * 2 + g) * 64 * 256;
    int ntc = 0;
    if (t0 + 7 >= 31) ntc = (((t0 + 7 - 31) >> 4) >> 6) + 1;
    attn_reset(S);
#pragma unroll 1
    for (int kt = 0; kt < ntc; ++kt) attn_tile<0, false>(S, kcb + (size_t)kt * 64 * 64, 64, vcb + kt * 64, 256, kt * 64, qf, slope, t, true, c16, q4);
    attn_fold(S, oacc, gp, 0, invl, lane);
#pragma unroll 1
    for (int kt = 0; kt < ntc; ++kt) {
      f32x4 st[4][2];
      attn_scores<0, false>(st, kcb + (size_t)kt * 64 * 64, 64, kt * 64, qf, slope, t, true, c16, q4);
#pragma unroll
      for (int mk = 0; mk < 4; ++mk) {
        f32x4 hs;
#pragma unroll
        for (int j = 0; j < 4; ++j) {
          const float a0 = st[mk][0][j], a1 = st[mk][1][j];
          const float p0 = __builtin_amdgcn_exp2f(a0 - S.m[0]) * invl[0];
          const float p1 = __builtin_amdgcn_exp2f(a1 - S.m[1]) * invl[1];
          float v = p0 + p1;
          v += __shfl_xor(v, 8);
          hs[j] = v;
        }
        if (c16 < 8) *(f32x4*)(ps + c16 * 256 + kt * 64 + mk * 16 + q4 * 4) = hs;
      }
    }
    __syncthreads();
    unsigned long long selm = 0ull, un = 0ull;
#pragma unroll 1
    for (int tqq = 0; tqq < 8; ++tqq) {
      const float* pr = ps + tqq * 256;
      float imp = pr[4 * lane];
      if (lane > 0) imp += pr[4 * lane - 4] + 2.f * (pr[4 * lane - 3] + pr[4 * lane - 2] + pr[4 * lane - 1]);
      const bool forced = (lane == 0) || (lane == cur) || (lane == cur - 1);
      const bool live = lane <= cur;
      const float val = forced ? 1e4f : (live ? imp : NEGV);
      int rank = 0;
#pragma unroll 8
      for (int i = 0; i < 64; ++i) {
        const float vi = __uint_as_float(__builtin_amdgcn_readlane(__float_as_uint(val), i));
        rank += ((vi > val) || (vi == val && i < lane)) ? 1 : 0;
      }
      const unsigned long long bal = __ballot((rank < 16) && live);
      if (tq == tqq) selm = bal;
      un |= bal;
    }
    __syncthreads();
    attn_reset(S);
    {
      const u16* vtb = VT + (size_t)((0 * 8 + b) * 2 + g) * 64 * 4096;
#pragma unroll 1
      for (int j = 0; j <= cur; ++j) {
        if (!((un >> j) & 1ull)) continue;
        const bool sb = (selm >> j) & 1ull;
        const u16* kb_ = P1 + (size_t)(b * 4096 + j * 64) * PS1 + 768 + g * 64;
        if (j < cur) attn_tile<1, true>(S, kb_, PS1, vtb + j * 64, 4096, j * 64, qf, slope, t, sb, c16, q4);
        else attn_tile<1, false>(S, kb_, PS1, vtb + j * 64, 4096, j * 64, qf, slope, t, sb, c16, q4);
      }
    }
    attn_fold(S, oacc, gp, 1, invl, lane);
    attn_reset(S);
    {
      const u16* vtb = VT + (size_t)((1 * 8 + b) * 2 + g) * 64 * 4096;
      int j0 = t0 - 511; if (j0 < 0) j0 = 0; j0 >>= 6;
#pragma unroll 1
      for (int j = j0; j <= cur; ++j) {
        const u16* kb_ = P1 + (size_t)(b * 4096 + j * 64) * PS1 + 896 + g * 64;
        const bool full = (j < cur) && (j * 64 >= t0 + 7 - 511);
        if (full) attn_tile<2, true>(S, kb_, PS1, vtb + j * 64, 4096, j * 64, qf, slope, t, true, c16, q4);
        else attn_tile<2, false>(S, kb_, PS1, vtb + j * 64, 4096, j * 64, qf, slope, t, true, c16, q4);
      }
    }
    attn_fold(S, oacc, gp, 2, invl, lane);
#pragma unroll
    for (int nq = 0; nq < 2; ++nq) {
      const int hh = nq * 2 + (c16 >> 3);
      u16* rp = P1 + (size_t)(tok0 + tq) * PS1 + (g * 4 + hh) * 64;
#pragma unroll
      for (int md = 0; md < 4; ++md) {
        const float* a = oacc + ((md * 2 + nq) * 4) * 64 + lane;
        uint2 o; o.x = pack2(a[0], a[64]); o.y = pack2(a[128], a[192]);
        *(uint2*)(rp + md * 16 + q4 * 4) = o;
      }
    }
  }
}

__device__ __forceinline__ const float* modp(const Params& p, int l, int sub, int kind) {
  return (const float*)(p.ws + OFF_MOD) + (size_t)l * 8 * 9216 + sub * 3072 + kind * 1024;
}

__device__ __forceinline__ void run_phase(const Params& p, int ph, char* smem) {
  char* ws = p.ws;
  if (ph == 0) {
    if (blockIdx.x == 0) { unsigned* c = (unsigned*)(ws + OFF_CNT); for (int e = tidx(); e < 1024; e += 256) c[e] = 0u; }
    phase_mod(p, smem);
  }
  int l = 0, s = -1;
  if (ph >= 2) { l = (ph - 2) / 14; s = (ph - 2) % 14; }
  const float* preg = p.in[4] + (size_t)l * 3 * 1024; const float* postg = p.in[5] + (size_t)l * 3 * 1024;
  const bool is_norm = (ph == 1) || s == 2 || s == 10 || s == 13;
  if (is_norm) {
    const float* xin = p.out; float* xout = p.out; const u16* y = nullptr; const float* pg = nullptr; const float* gate = nullptr; float wgt = 0.f;
    const float* prg = nullptr; const float* sh = nullptr; const float* sc = nullptr; u16* h = (u16*)(ws + OFF_H);
    if (ph == 1) { xin = p.in[0]; prg = p.in[4]; sh = modp(p, 0, 0, 0); sc = modp(p, 0, 0, 1); }
    else if (s == 2) { y = (const u16*)(ws + OFF_YF); pg = postg; gate = modp(p, l, 0, 2); wgt = 0.5f; prg = preg + 1024; sh = modp(p, l, 1, 0); sc = modp(p, l, 1, 1); }
    else if (s == 10) { y = (const u16*)(ws + OFF_YM); pg = postg + 1024; gate = modp(p, l, 1, 2); wgt = 1.0f; prg = preg + 2048; sh = modp(p, l, 2, 0); sc = modp(p, l, 2, 1); }
    else { y = (const u16*)(ws + OFF_YF); pg = postg + 2048; gate = modp(p, l, 2, 2); wgt = 0.5f;
      if (l == 0) { prg = p.in[4] + 3 * 1024; sh = modp(p, 1, 0, 0); sc = modp(p, 1, 0, 1); } else { h = nullptr; } }
    phase_norm(xin, xout, y, pg, gate, wgt, prg, sh, sc, h);
  }
  {
    int cl = -1, cf = 0;
    if (ph == 0) { cl = 0; cf = 0; } else if (s == 2) { cl = l; cf = 1; } else if (s == 13 && l == 0) { cl = 1; cf = 0; }
    if (cl >= 0) conv_ffn(p, cl, cf, smem);
    if (cl >= 0 && cf == 0) conv_mix(p, cl, smem);
  }
  if (s == 0 || s == 11) phase_ffn_in(p, smem);
  if (s == 1 || s == 12 || s == 9) {
    const bool o = (s == 9);
    phase_gemm_plain((const u16*)(ws + (o ? OFF_MERGED : OFF_ACT)), o ? 1024 : DFF, (const u16*)(ws + (o ? OFF_WO : OFF_WOUT)), o ? 1024 : DFF,
                     (u16*)(ws + (o ? OFF_YM : OFF_YF)), smem);
  }
  if (s == 3) phase_inproj(p, smem);
  if (s == 4) { phase_prep1(p, l); phase_sgu(p, l, smem); phase_cmp1(p, l, smem); }
  if (s == 5) { phase_prep2(p, l, smem); phase_cmp2(p, l); }
  if (s == 6) {
    const int nb = gridDim.x;
    const int sid = (nb >= 512) ? (((int)blockIdx.x & 1) ? -1 : ((int)blockIdx.x >> 1)) : (int)blockIdx.x;
    const int sstride = (nb >= 512) ? (nb >> 1) : nb;
    if (sid >= 0) {
      __builtin_amdgcn_s_setprio(3);
      for (int it = sid; it < 256; it += sstride) scan_item(p, it, smem);
      __builtin_amdgcn_s_setprio(0);
    }
    phase_nsa(p, smem, (unsigned*)(ws + OFF_CNT) + 64 + l * 64);
  }
  if (s == 7) phase_post(p, l, smem);
  if (s == 8) phase_merge(p, smem);
}

constexpr int NPHASE = 30;

#if COOP
typedef const float* __attribute__((address_space(4))) const* kargp_t;
template <int PH>
__device__ __forceinline__ void run_seq(char* smem, cg::grid_group& grid) {
  if constexpr (PH < NPHASE) {
    {
      kargp_t ka = (kargp_t)__builtin_amdgcn_kernarg_segment_ptr();
      asm volatile("" : "+s"(ka));
      Params q;
#pragma unroll
      for (int i = 0; i < 35; ++i) q.in[i] = ka[i];
      q.out = (float*)ka[35];
      q.ws = (char*)ka[36];
      run_phase(q, PH, smem);
    }
    if constexpr (PH == 0) grid.sync();
    else if constexpr (PH + 1 < NPHASE) {
      kargp_t kb = (kargp_t)__builtin_amdgcn_kernarg_segment_ptr();
      asm volatile("" : "+s"(kb));
      gbar((unsigned*)((char*)kb[36] + OFF_CNT), (unsigned)PH * gridDim.x);
    }
    run_seq<PH + 1>(smem, grid);
  }
}

__global__ void __launch_bounds__(256, 2) mega(Params p) {
  __shared__ __attribute__((aligned(16))) char smem[SMEM_BYTES];
  cg::grid_group grid = cg::this_grid();
  run_seq<0>(smem, grid);
}
#endif

template <int PH>
__global__ void __launch_bounds__(256, 2) kph(Params p) {
  __shared__ __attribute__((aligned(16))) char smem[SMEM_BYTES];
  run_phase(p, PH, smem);
}

template <int PH>
static void launch_seq(const Params& p, int grid, hipStream_t stream) {
  if constexpr (PH < NPHASE) {
    kph<PH><<<grid, 256, 0, stream>>>(p);
    launch_seq<PH + 1>(p, grid, stream);
  }
}

extern "C" void kernel_launch(void* const* d_in, const int* in_sizes, int n_in, void* d_out, int out_size, void* d_ws, size_t ws_size,
                              hipStream_t stream) {
  static int grid_blocks = 0;
  if (!grid_blocks) {
    int dev = 0, cus = 0, per_cu = 0;
    hipGetDevice(&dev);
    hipDeviceGetAttribute(&cus, hipDeviceAttributeMultiprocessorCount, dev);
    #if COOP
    hipOccupancyMaxActiveBlocksPerMultiprocessor(&per_cu, mega, 256, 0);
#else
    per_cu = 2;
#endif
    if (per_cu > 2) per_cu = 2;
    if (per_cu < 1) per_cu = 1;
    grid_blocks = cus * per_cu;
  }
  Params p{};
  for (int i = 0; i < 35; ++i) p.in[i] = (const float*)d_in[i];
  p.out = (float*)d_out;
  p.ws = (char*)d_ws;
#if COOP
  void* args[] = {&p};
  hipError_t e = hipLaunchCooperativeKernel((void*)mega, dim3(grid_blocks), dim3(256), args, 0, stream);
  if (e != hipSuccess) fprintf(stderr, "cooperative launch failed: %s (grid %d)\n", hipGetErrorString(e), grid_blocks);
#else
  launch_seq<0>(p, grid_blocks, stream);
#endif
}
```

```cpp
#include <hip/hip_runtime.h>
#include <hip/hip_cooperative_groups.h>
#include <cstdio>
#include <cstdint>
namespace cg = cooperative_groups;

#ifndef COOP
#define COOP 1
#endif

typedef unsigned short u16;
using bf16x8 = __attribute__((ext_vector_type(8))) short;
using f32x4 = __attribute__((ext_vector_type(4))) float;

constexpr int T = 32768, D = 1024, SEQ = 4096, DFF = 2816;
constexpr int PS1 = 2072, PS2 = 3328;
constexpr int MIXC = 7192, MIXN = 4120;
constexpr size_t OFF_P1 = 0;
constexpr size_t OFF_P2 = OFF_P1 + (size_t)T * PS1 * 2;
constexpr size_t OFF_H = OFF_P2 + (size_t)T * PS2 * 2;
constexpr size_t OFF_WMIX = OFF_H + (size_t)T * 1024 * 2;
constexpr size_t OFF_WG = OFF_WMIX + (size_t)4224 * 1024 * 2;
constexpr size_t OFF_WB = OFF_WG + (size_t)3072 * 1024 * 2;
constexpr size_t OFF_WO = OFF_WB + (size_t)3 * 1024 * 512 * 2;
constexpr size_t OFF_W1 = OFF_WO + (size_t)1024 * 1024 * 2;
constexpr size_t OFF_WIN = OFF_W1 + (size_t)2 * 256 * 2048 * 2;
constexpr size_t OFF_WOUT = OFF_WIN + (size_t)5632 * 1024 * 2;
constexpr size_t OFF_VFIRST = OFF_WOUT + (size_t)1024 * 2816 * 2;
constexpr size_t OFF_VT = OFF_VFIRST + (size_t)T * 512 * 2;
constexpr size_t OFF_MOD = OFF_VT + (size_t)2 * 8 * 2 * 64 * 4096 * 2;
constexpr size_t OFF_PB = OFF_MOD + (size_t)2 * 8 * 9216 * 4;
constexpr size_t OFF_HID = OFF_PB + (size_t)1024 * 1792 * 2;
constexpr size_t OFF_KC = OFF_HID + (size_t)2 * 4096 * 256 * 2;
constexpr size_t OFF_VC = OFF_KC + (size_t)8 * 2 * 256 * 64 * 2;
constexpr size_t OFF_LV = OFF_VC + (size_t)8 * 2 * 64 * 256 * 2;
constexpr size_t OFF_CNT = OFF_LV + (size_t)T * 32 * 4;
constexpr size_t WS_END = OFF_CNT + 4096;
constexpr size_t OFF_ACT = OFF_P1;
constexpr size_t OFF_YF = OFF_ACT + (size_t)T * DFF * 2;
constexpr size_t OFF_H2 = OFF_P2;
constexpr size_t OFF_MERGED = OFF_P2;
constexpr size_t OFF_YM = OFF_MERGED + (size_t)T * 1024 * 2;
constexpr size_t OFF_YC = OFF_H;

constexpr int SMEM_BYTES = 73728;

struct Params { const float* in[35]; float* out; char* ws; };

__device__ __forceinline__ int tidx() { int t = __builtin_amdgcn_workitem_id_x(); asm volatile("" : "+v"(t)); return t; }
__device__ __forceinline__ void gbar(unsigned* cnt, unsigned target) {
  asm volatile("s_waitcnt vmcnt(0) lgkmcnt(0)" ::: "memory");
  __syncthreads();
  if (tidx() == 0) {
    __builtin_amdgcn_fence(__ATOMIC_RELEASE, "agent");
    asm volatile("s_waitcnt vmcnt(0)" ::: "memory");
    __hip_atomic_fetch_add(cnt, 1u, __ATOMIC_RELAXED, __HIP_MEMORY_SCOPE_AGENT);
    while (__hip_atomic_load(cnt, __ATOMIC_RELAXED, __HIP_MEMORY_SCOPE_AGENT) < target) __builtin_amdgcn_s_sleep(1);
    __builtin_amdgcn_fence(__ATOMIC_ACQUIRE, "agent");
    asm volatile("s_waitcnt vmcnt(0)" ::: "memory");
  }
  __syncthreads();
}
__device__ __forceinline__ float dpp_sum16(float v) {
  v += __int_as_float(__builtin_amdgcn_update_dpp(0, __float_as_int(v), 0xB1, 0xF, 0xF, true));
  v += __int_as_float(__builtin_amdgcn_update_dpp(0, __float_as_int(v), 0x4E, 0xF, 0xF, true));
  v += __int_as_float(__builtin_amdgcn_update_dpp(0, __float_as_int(v), 0x141, 0xF, 0xF, true));
  v += __int_as_float(__builtin_amdgcn_update_dpp(0, __float_as_int(v), 0x140, 0xF, 0xF, true));
  return v;
}
__device__ __forceinline__ float bf2f(u16 u) { return __uint_as_float(((unsigned)u) << 16); }
__device__ __forceinline__ u16 f2bf(float f) { __bf16 r = (__bf16)f; return *(u16*)&r; }
typedef __attribute__((ext_vector_type(2))) float f2_t;
typedef __attribute__((ext_vector_type(2))) __bf16 b2_t;
__device__ __forceinline__ unsigned pack2(float a, float b) { f2_t v = {a, b}; b2_t r = __builtin_convertvector(v, b2_t); return *(unsigned*)&r; }
__device__ __forceinline__ float sigmoidf_(float x) { return 1.f / (1.f + __expf(-x)); }
__device__ __forceinline__ float siluf_(float x) { return x / (1.f + __expf(-x)); }
__device__ __forceinline__ float geluf_(float x) { float u = 0.7978845608028654f * (x + 0.044715f * x * x * x); return x / (1.f + __expf(-2.f * u)); }
__device__ __forceinline__ float tanhf_(float x) { return 1.f - 2.f / (1.f + __expf(2.f * x)); }
__device__ __forceinline__ float wave_sum(float v) {
#pragma unroll
  for (int o = 32; o >= 1; o >>= 1) v += __shfl_xor(v, o);
  return v;
}
__device__ __forceinline__ f32x4 mfma16(bf16x8 a, bf16x8 b, f32x4 c) { return __builtin_amdgcn_mfma_f32_16x16x32_bf16(a, b, c, 0, 0, 0); }

__device__ __forceinline__ void conv_w(const float* src, int ld, int K, u16* dst, int NR, int nvalid, int coff, int kind, char* smem) {
  float* tl = (float*)smem;
  const int tid = tidx();
  const int ktn = K >> 6, ntile = (NR >> 6) * ktn;
  for (int tix = blockIdx.x; tix < ntile; tix += gridDim.x) {
    const int R0 = (tix / ktn) << 6, k0 = (tix % ktn) << 6;
    const int c = tid & 63, kq = tid >> 6;
    const int R = R0 + c;
    int sc; bool ok;
    if (kind == 0) { sc = coff + R; ok = R < nvalid; }
    else { int ntl = R >> 7, w = (R >> 6) & 1, n = (R >> 4) & 3, r = R & 15; sc = ((n >= 2) ? DFF : 0) + ntl * 64 + w * 32 + (n & 1) * 16 + r; ok = true; }
#pragma unroll 4
    for (int i = 0; i < 16; ++i) {
      int k = k0 + kq * 16 + i;
      tl[c * 65 + kq * 16 + i] = ok ? src[(size_t)k * ld + sc] : 0.f;
    }
    __syncthreads();
    {
      const int r = tid >> 2, ks = tid & 3;
      const float* s = tl + r * 65 + ks * 16;
      uint4 o0, o1;
      o0.x = pack2(s[0], s[1]); o0.y = pack2(s[2], s[3]); o0.z = pack2(s[4], s[5]); o0.w = pack2(s[6], s[7]);
      o1.x = pack2(s[8], s[9]); o1.y = pack2(s[10], s[11]); o1.z = pack2(s[12], s[13]); o1.w = pack2(s[14], s[15]);
      uint4* dp = (uint4*)(dst + (size_t)(R0 + r) * K + k0 + ks * 16);
      dp[0] = o0; dp[1] = o1;
    }
    __syncthreads();
  }
}

__device__ __forceinline__ void conv_ffn(const Params& p, int l, int f, char* smem) {
  conv_w(p.in[6] + (size_t)(l * 2 + f) * D * (2 * DFF), 2 * DFF, D, (u16*)(p.ws + OFF_WIN), 5632, 5632, 0, 1, smem);
  conv_w(p.in[7] + (size_t)(l * 2 + f) * DFF * D, D, DFF, (u16*)(p.ws + OFF_WOUT), 1024, 1024, 0, 0, smem);
}
__device__ __forceinline__ void conv_mix(const Params& p, int l, char* smem) {
  const float* mw = p.in[8] + (size_t)l * D * MIXC;
  conv_w(mw, MIXC, D, (u16*)(p.ws + OFF_WMIX), 4224, MIXN, 0, 0, smem);
  conv_w(mw, MIXC, D, (u16*)(p.ws + OFF_WG), 3072, 3072, MIXN, 0, smem);
  for (int i = 0; i < 3; ++i)
    conv_w(p.in[9] + (size_t)(l * 3 + i) * 512 * D, D, 512, (u16*)(p.ws + OFF_WB) + (size_t)i * 1024 * 512, 1024, 1024, 0, 0, smem);
  conv_w(p.in[10] + (size_t)l * D * D, D, D, (u16*)(p.ws + OFF_WO), 1024, 1024, 0, 0, smem);
  conv_w(p.in[11] + (size_t)l * 2048 * 256, 256, 2048, (u16*)(p.ws + OFF_W1), 256, 256, 0, 0, smem);
  conv_w(p.in[14] + (size_t)l * 2048 * 256, 256, 2048, (u16*)(p.ws + OFF_W1) + (size_t)256 * 2048, 256, 256, 0, 0, smem);
}

__device__ __forceinline__ void phase_mod(const Params& p, char* smem) {
  float* cond = (float*)smem;
  float* red = cond + 8192;
  const int tid = tidx();
  float* MOD = (float*)(p.ws + OFF_MOD);
  for (int item = blockIdx.x; item < 288; item += gridDim.x) {
    for (int e = tid; e < 8192; e += 256) cond[e] = siluf_(p.in[1][e]);
    __syncthreads();
    const int l = item / 144, n0 = (item % 144) * 64, col = n0 + (tid & 63), kq = tid >> 6;
    float acc[8];
#pragma unroll
    for (int b = 0; b < 8; ++b) acc[b] = 0.f;
    const float* w = p.in[2] + (size_t)l * D * 9216 + col;
#pragma unroll 4
    for (int k = kq * 256; k < kq * 256 + 256; ++k) {
      float wv = w[(size_t)k * 9216];
#pragma unroll
      for (int b = 0; b < 8; ++b) acc[b] += cond[b * 1024 + k] * wv;
    }
#pragma unroll
    for (int b = 0; b < 8; ++b) red[(kq * 8 + b) * 64 + (tid & 63)] = acc[b];
    __syncthreads();
    for (int e = tid; e < 512; e += 256) {
      int b = e >> 6, c = e & 63;
      float s = red[(0 * 8 + b) * 64 + c] + red[(1 * 8 + b) * 64 + c] + red[(2 * 8 + b) * 64 + c] + red[(3 * 8 + b) * 64 + c];
      MOD[(size_t)(l * 8 + b) * 9216 + n0 + c] = s + p.in[3][(size_t)l * 9216 + n0 + c];
    }
    __syncthreads();
  }
}

__device__ __forceinline__ void phase_norm(const float* xin, float* xout, const u16* y, const float* postg, const float* gate, float wgt,
                           const float* preg, const float* shift, const float* scale, u16* h) {
  const int lane = tidx() & 63, wid = tidx() >> 6;
  for (int row = blockIdx.x * 4 + wid; row < T; row += gridDim.x * 4) {
    const int b = row >> 12;
    float4 xv[4];
#pragma unroll
    for (int i = 0; i < 4; ++i) xv[i] = *(const float4*)(xin + (size_t)row * D + i * 256 + lane * 4);
    if (y) {
      float yv[4][4]; float ss = 0.f;
#pragma unroll
      for (int i = 0; i < 4; ++i) {
        uint2 u = *(const uint2*)(y + (size_t)row * D + i * 256 + lane * 4);
        yv[i][0] = bf2f((u16)(u.x & 0xffff)); yv[i][1] = bf2f((u16)(u.x >> 16));
        yv[i][2] = bf2f((u16)(u.y & 0xffff)); yv[i][3] = bf2f((u16)(u.y >> 16));
        ss += yv[i][0] * yv[i][0] + yv[i][1] * yv[i][1] + yv[i][2] * yv[i][2] + yv[i][3] * yv[i][3];
      }
      ss = wave_sum(ss);
      const float rs = rsqrtf(ss * (1.f / 1024.f) + 1e-6f) * wgt;
#pragma unroll
      for (int i = 0; i < 4; ++i) {
        const int c = i * 256 + lane * 4;
        float4 g = *(const float4*)(gate + (size_t)b * 9216 + c);
        float4 pg = *(const float4*)(postg + c);
        xv[i].x += g.x * yv[i][0] * rs * pg.x; xv[i].y += g.y * yv[i][1] * rs * pg.y;
        xv[i].z += g.z * yv[i][2] * rs * pg.z; xv[i].w += g.w * yv[i][3] * rs * pg.w;
      }
    }
    if (xout) {
#pragma unroll
      for (int i = 0; i < 4; ++i) *(float4*)(xout + (size_t)row * D + i * 256 + lane * 4) = xv[i];
    }
    if (h) {
      float ss = 0.f;
#pragma unroll
      for (int i = 0; i < 4; ++i) ss += xv[i].x * xv[i].x + xv[i].y * xv[i].y + xv[i].z * xv[i].z + xv[i].w * xv[i].w;
      ss = wave_sum(ss);
      const float rs = rsqrtf(ss * (1.f / 1024.f) + 1e-6f);
#pragma unroll
      for (int i = 0; i < 4; ++i) {
        const int c = i * 256 + lane * 4;
        float4 pg = *(const float4*)(preg + c);
        float4 sh = *(const float4*)(shift + (size_t)b * 9216 + c);
        float4 sc = *(const float4*)(scale + (size_t)b * 9216 + c);
        uint2 o;
        o.x = pack2(xv[i].x * rs * pg.x * (1.f + sc.x) + sh.x, xv[i].y * rs * pg.y * (1.f + sc.y) + sh.y);
        o.y = pack2(xv[i].z * rs * pg.z * (1.f + sc.z) + sh.z, xv[i].w * rs * pg.w * (1.f + sc.w) + sh.w);
        *(uint2*)(h + (size_t)row * D + c) = o;
      }
    }
  }
}

template <int NS, class FA, class FB>
__device__ __forceinline__ void gemm_loop(f32x4 (&acc)[4][NS], const FA& fa, const FB& fb, int K, u16* sm) {
  constexpr int BN = 32 * NS;
  constexpr int NBV = BN / 32;
  const int tid = tidx(), lane = tid & 63, wid = tid >> 6, wr = wid >> 1, wc = wid & 1, fr = lane & 15, fq = lane >> 4;
  u16* As = sm; u16* Bs = sm + 2 * 128 * 64;
  uint4 ra0[4], rb0[NBV], ra1[4], rb1[NBV];
  const int nt = K >> 6;
  const int lrow = tid >> 3, lk = (tid & 7) * 8;
  const int lsw = lrow * 64 + (((tid & 7) ^ ((lrow >> 1) & 7)) << 3);
  const int c0 = (fq ^ ((fr >> 1) & 7)) << 3, c1 = c0 ^ 32;
#define G_LOAD(RA, RB, KT) { const int kb_ = (KT) << 6; \
    _Pragma("unroll") for (int i = 0; i < 4; ++i) RA[i] = fa(lrow + 32 * i, kb_ + lk); \
    _Pragma("unroll") for (int i = 0; i < NBV; ++i) RB[i] = fb(lrow + 32 * i, kb_ + lk); }
#define G_STORE(RA, RB, BUF) { u16* Aw_ = As + (BUF) * 128 * 64 + lsw; u16* Bw_ = Bs + (BUF) * BN * 64 + lsw; \
    _Pragma("unroll") for (int i = 0; i < 4; ++i) *(uint4*)(Aw_ + i * 32 * 64) = RA[i]; \
    _Pragma("unroll") for (int i = 0; i < NBV; ++i) *(uint4*)(Bw_ + i * 32 * 64) = RB[i]; }
#define G_COMPUTE(BUF) { const u16* Ab = As + (BUF) * 128 * 64 + (wr * 64 + fr) * 64; \
    const u16* Bb = Bs + (BUF) * BN * 64 + (wc * 16 * NS + fr) * 64; \
    _Pragma("unroll") for (int ks = 0; ks < 2; ++ks) { bf16x8 a[4], b[NS]; const int co = ks ? c1 : c0; \
      _Pragma("unroll") for (int m = 0; m < 4; ++m) a[m] = *(const bf16x8*)(Ab + m * 16 * 64 + co); \
      _Pragma("unroll") for (int n = 0; n < NS; ++n) b[n] = *(const bf16x8*)(Bb + n * 16 * 64 + co); \
      _Pragma("unroll") for (int m = 0; m < 4; ++m) _Pragma("unroll") for (int n = 0; n < NS; ++n) acc[m][n] = mfma16(a[m], b[n], acc[m][n]); } }
  G_LOAD(ra0, rb0, 0)
  if (nt > 1) G_LOAD(ra1, rb1, 1)
  G_STORE(ra0, rb0, 0)
  __syncthreads();
#pragma unroll 1
  for (int kt = 0; kt < nt; kt += 2) {
    if (kt + 2 < nt) G_LOAD(ra0, rb0, kt + 2)
    G_COMPUTE(0)
    if (kt + 1 < nt) G_STORE(ra1, rb1, 1)
    __syncthreads();
    if (kt + 1 >= nt) break;
    if (kt + 3 < nt) G_LOAD(ra1, rb1, kt + 3)
    G_COMPUTE(1)
    if (kt + 2 < nt) G_STORE(ra0, rb0, 0)
    __syncthreads();
  }
#undef G_LOAD
#undef G_STORE
#undef G_COMPUTE
}

__device__ __forceinline__ bool tile_map(int it, int NT, int& mt, int& nt) {
  const int g = gridDim.x;
  if ((g & 7) == 0) {
    const int xcd = blockIdx.x & 7, bx = blockIdx.x >> 3, nbx = g >> 3;
    const int lid = bx + it * nbx;
    if (lid >= 32 * NT) return false;
    const int grp = lid / (8 * NT), rem = lid - grp * 8 * NT;
    nt = rem >> 3; mt = xcd * 32 + grp * 8 + (rem & 7);
    return true;
  } else {
    const int id = blockIdx.x + it * g;
    if (id >= 256 * NT) return false;
    nt = id % NT; mt = id / NT;
    return true;
  }
}

#define ZERO_ACC(acc, NSV) _Pragma("unroll") for (int m_ = 0; m_ < 4; ++m_) _Pragma("unroll") for (int n_ = 0; n_ < NSV; ++n_) acc[m_][n_] = f32x4{0.f, 0.f, 0.f, 0.f};

__device__ __forceinline__ void phase_ffn_in(const Params& p, char* smem) {
  const u16* H = (const u16*)(p.ws + OFF_H); const u16* W = (const u16*)(p.ws + OFF_WIN); u16* ACT = (u16*)(p.ws + OFF_ACT);
  const int lane = tidx() & 63, wid = tidx() >> 6, wr = wid >> 1, wc = wid & 1, fr = lane & 15, fq = lane >> 4;
  int mt, nt;
  for (int it = 0; tile_map(it, 44, mt, nt); ++it) {
    const int m0 = mt * 128, n0 = nt * 128;
    f32x4 acc[4][4]; ZERO_ACC(acc, 4)
    const char* Ab_ = (const char*)(H + (size_t)m0 * 1024); const char* Bb_ = (const char*)(W + (size_t)n0 * 1024);
    auto fa = [&](int r, int k) { return *(const uint4*)(Ab_ + (unsigned)((r * 1024 + k) * 2)); };
    auto fb = [&](int r, int k) { return *(const uint4*)(Bb_ + (unsigned)((r * 1024 + k) * 2)); };
    gemm_loop<4>(acc, fa, fb, 1024, (u16*)smem);
#pragma unroll
    for (int m = 0; m < 4; ++m)
#pragma unroll
      for (int n = 0; n < 2; ++n) {
        const int col = nt * 64 + wc * 32 + n * 16 + fr;
        const int r0 = m0 + wr * 64 + m * 16 + fq * 4;
#pragma unroll
        for (int j = 0; j < 4; ++j) ACT[(size_t)(r0 + j) * DFF + col] = f2bf(siluf_(acc[m][n][j]) * acc[m][n + 2][j]);
      }
  }
}

__device__ __forceinline__ void phase_gemm_plain(const u16* A, int lda, const u16* Bt, int K, u16* C, char* smem) {
  const int lane = tidx() & 63, wid = tidx() >> 6, wr = wid >> 1, wc = wid & 1, fr = lane & 15, fq = lane >> 4;
  int mt, nt;
  for (int it = 0; tile_map(it, 8, mt, nt); ++it) {
    const int m0 = mt * 128, n0 = nt * 128;
    f32x4 acc[4][4]; ZERO_ACC(acc, 4)
    const char* Ab_ = (const char*)(A + (size_t)m0 * lda); const char* Bb_ = (const char*)(Bt + (size_t)n0 * K);
    auto fa = [&](int r, int k) { return *(const uint4*)(Ab_ + (unsigned)((r * lda + k) * 2)); };
    auto fb = [&](int r, int k) { return *(const uint4*)(Bb_ + (unsigned)((r * K + k) * 2)); };
    gemm_loop<4>(acc, fa, fb, K, (u16*)smem);
#pragma unroll
    for (int m = 0; m < 4; ++m)
#pragma unroll
      for (int n = 0; n < 4; ++n) {
        const int col = n0 + wc * 64 + n * 16 + fr;
        const int r0 = m0 + wr * 64 + m * 16 + fq * 4;
#pragma unroll
        for (int j = 0; j < 4; ++j) C[(size_t)(r0 + j) * 1024 + col] = f2bf(acc[m][n][j]);
      }
  }
}

__device__ __forceinline__ void phase_inproj(const Params& p, char* smem) {
  const u16* H = (const u16*)(p.ws + OFF_H); const u16* W = (const u16*)(p.ws + OFF_WMIX);
  u16* P1 = (u16*)(p.ws + OFF_P1); u16* P2 = (u16*)(p.ws + OFF_P2); u16* VT = (u16*)(p.ws + OFF_VT); u16* PB = (u16*)(p.ws + OFF_PB);
  const int lane = tidx() & 63, wid = tidx() >> 6, wr = wid >> 1, wc = wid & 1, fr = lane & 15, fq = lane >> 4;
  int mt, nt;
  for (int it = 0; tile_map(it, 33, mt, nt); ++it) {
    const int m0 = mt * 128, n0 = nt * 128;
    f32x4 acc[4][4]; ZERO_ACC(acc, 4)
    const char* Ab_ = (const char*)(H + (size_t)m0 * 1024); const char* Bb_ = (const char*)(W + (size_t)n0 * 1024);
    auto fa = [&](int r, int k) { return *(const uint4*)(Ab_ + (unsigned)((r * 1024 + k) * 2)); };
    auto fb = [&](int r, int k) { return *(const uint4*)(Bb_ + (unsigned)((r * 1024 + k) * 2)); };
    gemm_loop<4>(acc, fa, fb, 1024, (u16*)smem);
#pragma unroll
    for (int m = 0; m < 4; ++m)
#pragma unroll
      for (int nn = 0; nn < 4; ++nn) {
        const int n = n0 + wc * 64 + nn * 16 + fr;
        if (n >= MIXN) continue;
        const int r0 = m0 + wr * 64 + m * 16 + fq * 4;
        f32x4 v = acc[m][nn];
        if ((n >= 896 && n < 1024) || (n >= 1152 && n < 1280)) {
          const int which = (n >= 1152) ? 1 : 0;
          const int gd = n - (which ? 1152 : 896);
          const int b = r0 >> 12, t = r0 & 4095;
          uint2 o; o.x = pack2(v[0], v[1]); o.y = pack2(v[2], v[3]);
          *(uint2*)(VT + ((size_t)((which * 8 + b) * 128 + gd)) * 4096 + (t & ~31) + 8 * fq + 4 * (m & 1)) = o;
        } else if (n < 1304) {
          const int pc = (n < 896) ? n : ((n < 1152) ? n - 128 : n - 256);
          if (n < 512) { const float qs = 0.125f * 1.4426950408889634f; v[0] *= qs; v[1] *= qs; v[2] *= qs; v[3] *= qs; }
          if (n >= 1280) { v[0] = sigmoidf_(v[0]); v[1] = sigmoidf_(v[1]); v[2] = sigmoidf_(v[2]); v[3] = sigmoidf_(v[3]); }
#pragma unroll
          for (int j = 0; j < 4; ++j) P1[(size_t)(r0 + j) * PS1 + pc] = f2bf(v[j]);
        } else if (n < 2328) {
#pragma unroll
          for (int j = 0; j < 4; ++j) P1[(size_t)(r0 + j) * PS1 + (n - 256)] = f2bf(geluf_(v[j]));
        } else {
          const int pc = n - 2328;
#pragma unroll
          for (int j = 0; j < 4; ++j) P2[(size_t)(r0 + j) * PS2 + pc] = f2bf(v[j]);
          if ((m & 1) && fq == 3) PB[(size_t)((r0 + 3) >> 5) * 1792 + pc] = f2bf(v[3]);
        }
      }
  }
}

__device__ __forceinline__ void phase_merge(const Params& p, char* smem) {
  const u16* H2 = (const u16*)(p.ws + OFF_H); const u16* WG = (const u16*)(p.ws + OFF_WG); const u16* WB = (const u16*)(p.ws + OFF_WB);
  const u16* P1 = (const u16*)(p.ws + OFF_P1); u16* MG = (u16*)(p.ws + OFF_MERGED);
  const int lane = tidx() & 63, wid = tidx() >> 6, wr = wid >> 1, wc = wid & 1, fr = lane & 15, fq = lane >> 4;
  int mt, nt;
  for (int it = 0; tile_map(it, 16, mt, nt); ++it) {
    const int m0 = mt * 128, n0 = nt * 64;
    f32x4 tot[4][2]; ZERO_ACC(tot, 2)
#pragma unroll 1
    for (int i = 0; i < 3; ++i) {
      unsigned gpk[4][2][2];
      {
        f32x4 ag[4][2]; ZERO_ACC(ag, 2)
        const char* Ab2_ = (const char*)(H2 + (size_t)m0 * 1024); const char* Bb2_ = (const char*)(WG + (size_t)(i * 1024 + n0) * 1024);
        auto fa2 = [&](int r, int k) { return *(const uint4*)(Ab2_ + (unsigned)((r * 1024 + k) * 2)); };
        auto fb2 = [&](int r, int k) { return *(const uint4*)(Bb2_ + (unsigned)((r * 1024 + k) * 2)); };
        gemm_loop<2>(ag, fa2, fb2, 1024, (u16*)smem);
#pragma unroll
        for (int m = 0; m < 4; ++m)
#pragma unroll
          for (int n = 0; n < 2; ++n) {
            gpk[m][n][0] = pack2(sigmoidf_(ag[m][n][0]), sigmoidf_(ag[m][n][1]));
            gpk[m][n][1] = pack2(sigmoidf_(ag[m][n][2]), sigmoidf_(ag[m][n][3]));
          }
      }
      f32x4 ay[4][2]; ZERO_ACC(ay, 2)
      const u16* ya = (i == 0) ? P1 : ((i == 1) ? P1 + 1048 : P1 + 1560);
      const int lda = PS1;
      const u16* wb = WB + (size_t)i * 1024 * 512;
      const char* Ab_ = (const char*)(ya + (size_t)m0 * lda); const char* Bb_ = (const char*)(wb + (size_t)n0 * 512);
      auto fa = [&](int r, int k) { return *(const uint4*)(Ab_ + (unsigned)((r * lda + k) * 2)); };
      auto fb = [&](int r, int k) { return *(const uint4*)(Bb_ + (unsigned)((r * 512 + k) * 2)); };
      gemm_loop<2>(ay, fa, fb, 512, (u16*)smem);
#pragma unroll
      for (int m = 0; m < 4; ++m)
#pragma unroll
        for (int n = 0; n < 2; ++n) {
          tot[m][n][0] += bf2f((u16)(gpk[m][n][0] & 0xffff)) * ay[m][n][0];
          tot[m][n][1] += bf2f((u16)(gpk[m][n][0] >> 16)) * ay[m][n][1];
          tot[m][n][2] += bf2f((u16)(gpk[m][n][1] & 0xffff)) * ay[m][n][2];
          tot[m][n][3] += bf2f((u16)(gpk[m][n][1] >> 16)) * ay[m][n][3];
        }
    }
#pragma unroll
    for (int m = 0; m < 4; ++m)
#pragma unroll
      for (int n = 0; n < 2; ++n) {
        const int col = n0 + wc * 32 + n * 16 + fr;
        const int r0 = m0 + wr * 64 + m * 16 + fq * 4;
#pragma unroll
        for (int j = 0; j < 4; ++j) MG[(size_t)(r0 + j) * 1024 + col] = f2bf(tot[m][n][j]);
      }
  }
}

__device__ __forceinline__ void phase_cmp1(const Params& p, int l, char* smem) {
  const u16* P1 = (const u16*)(p.ws + OFF_P1); const u16* W1 = (const u16*)(p.ws + OFF_W1); u16* HID = (u16*)(p.ws + OFF_HID);
  const int lane = tidx() & 63, wid = tidx() >> 6, wr = wid >> 1, wc = wid & 1, fr = lane & 15, fq = lane >> 4;
  for (int tix = blockIdx.x; tix < 128; tix += gridDim.x) {
    const int which = tix >> 6, mt = (tix >> 1) & 31, nt = tix & 1;
    const int m0 = mt * 128, n0 = nt * 128;
    const float* pe = (which ? p.in[16] : p.in[13]) + (size_t)l * 2048;
    const u16* w1 = W1 + (size_t)which * 256 * 2048;
    const int cbase = 512 + which * 128;
    f32x4 acc[4][4]; ZERO_ACC(acc, 4)
    auto fa = [&](int r, int k) {
      const int row = m0 + r; const int g = row & 1, n = (row >> 1) & 255, b = row >> 9;
      uint4 o = make_uint4(0, 0, 0, 0);
      if (n < 255) {
        const int lpos = k >> 6, d = k & 63;
        uint4 raw = *(const uint4*)(P1 + (size_t)(b * 4096 + 16 * n + lpos) * PS1 + cbase + g * 64 + d);
        const float* pp = pe + lpos * 64 + d;
        float4 e0 = *(const float4*)pp, e1 = *(const float4*)(pp + 4);
        o.x = pack2(bf2f((u16)(raw.x & 0xffff)) + e0.x, bf2f((u16)(raw.x >> 16)) + e0.y);
        o.y = pack2(bf2f((u16)(raw.y & 0xffff)) + e0.z, bf2f((u16)(raw.y >> 16)) + e0.w);
        o.z = pack2(bf2f((u16)(raw.z & 0xffff)) + e1.x, bf2f((u16)(raw.z >> 16)) + e1.y);
        o.w = pack2(bf2f((u16)(raw.w & 0xffff)) + e1.z, bf2f((u16)(raw.w >> 16)) + e1.w);
      }
      return o;
    };
    auto fb = [&](int r, int k) { return *(const uint4*)(w1 + (size_t)(n0 + r) * 2048 + k); };
    gemm_loop<4>(acc, fa, fb, 2048, (u16*)smem);
#pragma unroll
    for (int m = 0; m < 4; ++m)
#pragma unroll
      for (int n = 0; n < 4; ++n) {
        const int col = n0 + wc * 64 + n * 16 + fr;
        const int r0 = m0 + wr * 64 + m * 16 + fq * 4;
#pragma unroll
        for (int j = 0; j < 4; ++j) HID[((size_t)which * 4096 + r0 + j) * 256 + col] = f2bf(siluf_(acc[m][n][j]));
      }
  }
}

__device__ __forceinline__ void phase_cmp2(const Params& p, int l) {
  const u16* HID = (const u16*)(p.ws + OFF_HID); u16* KC = (u16*)(p.ws + OFF_KC); u16* VC = (u16*)(p.ws + OFF_VC);
  const int total = 2 * 4096 * 64;
  for (int idx = blockIdx.x * 256 + tidx(); idx < total; idx += gridDim.x * 256) {
    const int d = idx & 63, row = (idx >> 6) & 4095, which = idx >> 18;
    const float* w2 = (which ? p.in[15] : p.in[12]) + (size_t)l * 256 * 64;
    const u16* hr = HID + ((size_t)which * 4096 + row) * 256;
    float acc = 0.f;
#pragma unroll 8
    for (int j = 0; j < 256; ++j) acc += bf2f(hr[j]) * w2[j * 64 + d];
    const int g = row & 1, n = (row >> 1) & 255, b = row >> 9;
    if (which == 0) KC[((size_t)(b * 2 + g) * 256 + n) * 64 + d] = f2bf(acc);
    else {
      const int u = n & 31; const int pp = 8 * ((u >> 2) & 3) + 4 * (u >> 4) + (u & 3);
      VC[((size_t)(b * 2 + g) * 64 + d) * 256 + (n & ~31) + pp] = f2bf(acc);
    }
  }
}

__device__ __forceinline__ void phase_sgu(const Params& p, int l, char* smem) {
  u16* P1 = (u16*)(p.ws + OFF_P1);
  u16* Wt = (u16*)smem;
  u16* Vt = Wt + 128 * 136;
  float* st = (float*)(Vt + 128 * 136);
  const int tid = tidx(), lane = tid & 63, wid = tid >> 6, wr = wid >> 1, wc = wid & 1, fr = lane & 15, fq = lane >> 4;
  const float* lng = p.in[17] + (size_t)l * 512; const float* lnb = p.in[18] + (size_t)l * 512;
  for (int item = blockIdx.x; item < 1024; item += gridDim.x) {
    const int ci = item >> 2, gi = item & 3;
    const int tok0 = ci * 128;
#pragma unroll 1
    for (int r0 = wid * 32; r0 < wid * 32 + 32; r0 += 8) {
      uint4 raw[8];
#pragma unroll
      for (int u = 0; u < 8; ++u) raw[u] = *(const uint4*)(P1 + (size_t)(tok0 + r0 + u) * PS1 + 1560 + lane * 8);
#pragma unroll
      for (int u = 0; u < 8; ++u) {
        float f[8];
        f[0] = bf2f((u16)(raw[u].x & 0xffff)); f[1] = bf2f((u16)(raw[u].x >> 16)); f[2] = bf2f((u16)(raw[u].y & 0xffff)); f[3] = bf2f((u16)(raw[u].y >> 16));
        f[4] = bf2f((u16)(raw[u].z & 0xffff)); f[5] = bf2f((u16)(raw[u].z >> 16)); f[6] = bf2f((u16)(raw[u].w & 0xffff)); f[7] = bf2f((u16)(raw[u].w >> 16));
        float s = 0.f, s2 = 0.f;
#pragma unroll
        for (int e = 0; e < 8; ++e) { s += f[e]; }
        s = wave_sum(s);
        const float mu = s * (1.f / 512.f);
#pragma unroll
        for (int e = 0; e < 8; ++e) { float dlt = f[e] - mu; s2 += dlt * dlt; }
        s2 = wave_sum(s2);
        if (lane == 0) { st[(r0 + u) * 2] = mu; st[(r0 + u) * 2 + 1] = rsqrtf(s2 * (1.f / 512.f) + 1e-5f); }
      }
    }
    const float* wsrc = p.in[19] + ((size_t)(l * 4 + gi)) * 128 * 128;
    for (int e = tid; e < 128 * 32; e += 256) {
      const int t = e >> 5, s4 = (e & 31) * 4;
      float4 w = *(const float4*)(wsrc + t * 128 + s4);
      uint2 o;
      o.x = pack2(s4 + 0 <= t ? w.x : 0.f, s4 + 1 <= t ? w.y : 0.f);
      o.y = pack2(s4 + 2 <= t ? w.z : 0.f, s4 + 3 <= t ? w.w : 0.f);
      *(uint2*)(Wt + t * 136 + s4) = o;
    }
    __syncthreads();
    for (int e = tid; e < 128 * 16; e += 256) {
      const int s = e >> 4, c8 = (e & 15) * 8;
      uint4 raw = *(const uint4*)(P1 + (size_t)(tok0 + s) * PS1 + 1560 + gi * 128 + c8);
      const float mu = st[s * 2], rs = st[s * 2 + 1];
      u16 rv[8] = {(u16)(raw.x & 0xffff), (u16)(raw.x >> 16), (u16)(raw.y & 0xffff), (u16)(raw.y >> 16), (u16)(raw.z & 0xffff), (u16)(raw.z >> 16), (u16)(raw.w & 0xffff), (u16)(raw.w >> 16)};
#pragma unroll
      for (int i = 0; i < 8; ++i) {
        const int c = gi * 128 + c8 + i;
        Vt[(c8 + i) * 136 + s] = f2bf((bf2f(rv[i]) - mu) * rs * lng[c] + lnb[c]);
      }
    }
    __syncthreads();
    f32x4 acc[4][4]; ZERO_ACC(acc, 4)
#pragma unroll 1
    for (int ks = 0; ks < 4; ++ks) {
      bf16x8 a[4], b[4];
#pragma unroll
      for (int m = 0; m < 4; ++m) a[m] = *(const bf16x8*)(Wt + (wr * 64 + m * 16 + fr) * 136 + ks * 32 + fq * 8);
#pragma unroll
      for (int n = 0; n < 4; ++n) b[n] = *(const bf16x8*)(Vt + (wc * 64 + n * 16 + fr) * 136 + ks * 32 + fq * 8);
#pragma unroll
      for (int m = 0; m < 4; ++m)
#pragma unroll
        for (int n = 0; n < 4; ++n) acc[m][n] = mfma16(a[m], b[n], acc[m][n]);
    }
    const float* bs = p.in[20] + ((size_t)(l * 4 + gi)) * 128;
#pragma unroll
    for (int m = 0; m < 4; ++m)
#pragma unroll
      for (int n = 0; n < 4; ++n) {
        const int c = wc * 64 + n * 16 + fr;
#pragma unroll
        for (int j = 0; j < 4; ++j) {
          const int t = wr * 64 + m * 16 + fq * 4 + j;
          u16* up = P1 + (size_t)(tok0 + t) * PS1 + 1048 + gi * 128 + c;
          *up = f2bf(bf2f(*up) * (acc[m][n][j] + bs[t]));
        }
      }
    __syncthreads();
  }
}

__device__ __forceinline__ void phase_prep1(const Params& p, int l) {
  u16* P2 = (u16*)(p.ws + OFF_P2); const u16* PB = (const u16*)(p.ws + OFF_PB); u16* VF = (u16*)(p.ws + OFF_VFIRST);
  const float* mu = p.in[21] + (size_t)l * 1792;
  const int total = 1024 * 224;
  for (int idx = blockIdx.x * 256 + tidx(); idx < total; idx += gridDim.x * 256) {
    const int tile = idx / 224, cg8 = (idx % 224) * 8;
    const int tok0 = tile * 32;
    float m8[8];
#pragma unroll
    for (int e = 0; e < 8; ++e) m8[e] = mu[cg8 + e];
    uint4 prev = make_uint4(0, 0, 0, 0);
    if ((tok0 & 4095) != 0) prev = *(const uint4*)(PB + (size_t)(tile - 1) * 1792 + cg8);
#pragma unroll 1
    for (int r0 = 0; r0 < 32; r0 += 8) {
      uint4 cv[8];
#pragma unroll
      for (int u = 0; u < 8; ++u) cv[u] = *(const uint4*)(P2 + (size_t)(tok0 + r0 + u) * PS2 + cg8);
#pragma unroll
      for (int u = 0; u < 8; ++u) {
        const uint4 cur = cv[u];
        unsigned cu[4] = {cur.x, cur.y, cur.z, cur.w}, pu[4] = {prev.x, prev.y, prev.z, prev.w};
        float o[8];
#pragma unroll
        for (int e = 0; e < 8; ++e) {
          float c = bf2f((u16)((cu[e >> 1] >> ((e & 1) * 16)) & 0xffff));
          float pv = bf2f((u16)((pu[e >> 1] >> ((e & 1) * 16)) & 0xffff));
          float sv = c + (pv - c) * m8[e];
          if (cg8 >= 1536 && cg8 < 1600) sv = tanhf_(sv);
          else if (cg8 >= 1664) sv = sigmoidf_(sv);
          o[e] = sv;
        }
        uint4 ov; ov.x = pack2(o[0], o[1]); ov.y = pack2(o[2], o[3]); ov.z = pack2(o[4], o[5]); ov.w = pack2(o[6], o[7]);
        *(uint4*)(P2 + (size_t)(tok0 + r0 + u) * PS2 + cg8) = ov;
        if (l == 0 && cg8 >= 1024 && cg8 < 1536) *(uint4*)(VF + (size_t)(tok0 + r0 + u) * 512 + cg8 - 1024) = ov;
        prev = cur;
      }
    }
  }
}

__device__ __forceinline__ void phase_prep2(const Params& p, int l, char* smem) {
  u16* P2 = (u16*)(p.ws + OFF_P2); const u16* VF = (const u16*)(p.ws + OFF_VFIRST);
  float* twd = (float*)smem;
  float* adl = twd + 1024;
  float* vsh = adl + 1024;
  float* lv = vsh + 8192;
  const int tid = tidx();
  const float* w0 = p.in[22] + (size_t)l * 512; const float* w2 = p.in[23] + (size_t)l * 64 * 512;
  const float* a0 = p.in[24] + (size_t)l * 512; const float* a2 = p.in[25] + (size_t)l * 64 * 512;
  const float* kkp = p.in[27] + (size_t)l * 512; const float* kap = p.in[28] + (size_t)l * 512;
  for (int item = blockIdx.x; item < 2048; item += gridDim.x) {
    const int tok0 = item * 16;
    for (int e = tid; e < 2048; e += 256) {
      const int r = e >> 7, c = e & 127;
      twd[(c >> 6) * 1024 + r * 64 + (c & 63)] = bf2f(P2[(size_t)(tok0 + r) * PS2 + 1536 + c]);
    }
    if (l > 0) {
      for (int e = tid; e < 8192; e += 256) { const int r = e >> 9, c = e & 511; vsh[e] = bf2f(P2[(size_t)(tok0 + r) * PS2 + 1024 + c]); }
    }
    __syncthreads();
    if (l > 0) {
      const float* v1 = p.in[33];
      for (int e = tid; e < 512; e += 256) {
        const int r = e >> 5, j = e & 31;
        float s = 0.f;
#pragma unroll 2
        for (int c = 0; c < 512; c += 4) {
          const float4 t4 = *(const float4*)(vsh + r * 512 + c);
          s += t4.x * v1[c * 32 + j] + t4.y * v1[(c + 1) * 32 + j] + t4.z * v1[(c + 2) * 32 + j] + t4.w * v1[(c + 3) * 32 + j];
        }
        lv[r * 32 + j] = s;
      }
      __syncthreads();
    }
    {
      float aw[2][16], aa[2][16], am[2][16];
#pragma unroll
      for (int c = 0; c < 2; ++c)
#pragma unroll
        for (int r = 0; r < 16; ++r) { aw[c][r] = 0.f; aa[c][r] = 0.f; am[c][r] = 0.f; }
#pragma unroll 2
      for (int i = 0; i < 64; i += 4) {
        float wv[2][4], av[2][4];
#pragma unroll
        for (int c = 0; c < 2; ++c)
#pragma unroll
          for (int u = 0; u < 4; ++u) { wv[c][u] = w2[(i + u) * 512 + tid + c * 256]; av[c][u] = a2[(i + u) * 512 + tid + c * 256]; }
#pragma unroll
        for (int r = 0; r < 16; ++r) {
          const float4 tw = *(const float4*)(twd + r * 64 + i);
          const float4 ta = *(const float4*)(adl + r * 64 + i);
#pragma unroll
          for (int c = 0; c < 2; ++c) {
            aw[c][r] += tw.x * wv[c][0] + tw.y * wv[c][1] + tw.z * wv[c][2] + tw.w * wv[c][3];
            aa[c][r] += ta.x * av[c][0] + ta.y * av[c][1] + ta.z * av[c][2] + ta.w * av[c][3];
          }
        }
      }
      if (l > 0) {
        const float* v2 = p.in[34];
#pragma unroll 2
        for (int j = 0; j < 32; j += 4) {
          float vv[2][4];
#pragma unroll
          for (int c = 0; c < 2; ++c)
#pragma unroll
            for (int u = 0; u < 4; ++u) vv[c][u] = v2[(j + u) * 512 + tid + c * 256];
#pragma unroll
          for (int r = 0; r < 16; ++r) {
            const float4 t4 = *(const float4*)(lv + r * 32 + j);
#pragma unroll
            for (int c = 0; c < 2; ++c) am[c][r] += t4.x * vv[c][0] + t4.y * vv[c][1] + t4.z * vv[c][2] + t4.w * vv[c][3];
          }
        }
      }
#pragma unroll
      for (int c = 0; c < 2; ++c) {
        const int ch = tid + c * 256;
        const float w0v = w0[ch], a0v = a0[ch], kkv = kkp[ch], kav = kap[ch];
        const float v0v = (l > 0) ? p.in[32][ch] : 0.f;
        float kval[16];
#pragma unroll
        for (int r = 0; r < 16; ++r) kval[r] = bf2f(P2[(size_t)(tok0 + r) * PS2 + 512 + ch]);
#pragma unroll
        for (int r = 0; r < 16; ++r) {
          u16* row = P2 + (size_t)(tok0 + r) * PS2;
          const float wpre = w0v + aw[c][r];
          const float nx = -wpre;
          const float sp = fmaxf(nx, 0.f) + __logf(1.f + __expf(-fabsf(nx)));
          const float w = -sp - 0.5f;
          const float decay = __expf(-__expf(w));
          const float a = sigmoidf_(a0v + aa[c][r]);
          const float kk = kval[r] * kkv;
          const float ss = wave_sum(kk * kk);
          const float kkn = kk / fmaxf(sqrtf(ss), 1e-12f);
          row[1792 + ch] = f2bf(decay);
          row[2304 + ch] = f2bf(kkn);
          row[2816 + ch] = f2bf(kkn * a);
          row[512 + ch] = f2bf(kval[r] * (1.f + (a - 1.f) * kav));
          if (l > 0) {
            const float v = vsh[r * 512 + ch];
            const float vf = bf2f(VF[(size_t)(tok0 + r) * 512 + ch]);
            row[1024 + ch] = f2bf(v + (vf - v) * sigmoidf_(v0v + am[c][r]));
          }
        }
      }
    }
    __syncthreads();
  }
}

__device__ __forceinline__ void scan_item(const Params& p, int item, char* smem) {
  const u16* P2 = (const u16*)(p.ws + OFF_P2); u16* YC = (u16*)(p.ws + OFF_P1) + 1560;
  float* vb = (float*)smem;
  float* yb = vb + 2 * 6 * 16 * 64;
  const int tid = tidx(), lane = tid & 63, wid = tid >> 6;
  const int rq = item & 3, h = (item >> 2) & 7, b = item >> 5;
  const int rl = lane >> 4, cq = lane & 15;
  const int rloc = wid * 4 + rl;
  const int ihead = rq * 16 + rloc;
  const int j0 = cq * 4;
  const size_t tokb = (size_t)b * 4096;
  float s0 = 0.f, s1 = 0.f, s2 = 0.f, s3 = 0.f;
  uint4 pre[3];
  auto gload = [&](int c) {
#pragma unroll
    for (int i = 0; i < 3; ++i) {
      const int v = tid + i * 256; const int vec = v >> 7, rem = v & 127, step = rem >> 3, c8 = rem & 7;
      const int off = (vec == 0) ? 0 : (vec == 1) ? 1792 : (vec == 2) ? 512 : (vec == 3) ? 1024 : (vec == 4) ? 2304 : 2816;
      pre[i] = *(const uint4*)(P2 + (tokb + c * 16 + step) * PS2 + off + h * 64 + c8 * 8);
    }
  };
  auto lstore = [&](int buf) {
#pragma unroll
    for (int i = 0; i < 3; ++i) {
      const int v = tid + i * 256; const int vec = v >> 7, rem = v & 127, step = rem >> 3, c8 = rem & 7;
      float* d = vb + ((buf * 6 + vec) * 16 + step) * 64 + c8 * 8;
      float4 f0, f1;
      f0.x = bf2f((u16)(pre[i].x & 0xffff)); f0.y = bf2f((u16)(pre[i].x >> 16)); f0.z = bf2f((u16)(pre[i].y & 0xffff)); f0.w = bf2f((u16)(pre[i].y >> 16));
      f1.x = bf2f((u16)(pre[i].z & 0xffff)); f1.y = bf2f((u16)(pre[i].z >> 16)); f1.z = bf2f((u16)(pre[i].w & 0xffff)); f1.w = bf2f((u16)(pre[i].w >> 16));
      *(float4*)d = f0; *(float4*)(d + 4) = f1;
    }
  };
  gload(0); lstore(0);
  __syncthreads();
  for (int c = 0; c < 256; ++c) {
    const int buf = c & 1;
    if (c + 1 < 256) gload(c + 1);
    const float* base = vb + buf * 6 * 16 * 64;
#define SC_LOAD(X, ST) { r##X = *(const float4*)(base + (0 * 16 + (ST)) * 64 + j0); w##X = *(const float4*)(base + (1 * 16 + (ST)) * 64 + j0); \
      k##X = *(const float4*)(base + (2 * 16 + (ST)) * 64 + j0); v##X = base[(3 * 16 + (ST)) * 64 + ihead]; \
      n##X = *(const float4*)(base + (4 * 16 + (ST)) * 64 + j0); b##X = *(const float4*)(base + (5 * 16 + (ST)) * 64 + j0); }
#define SC_STEP(X, ST) { float sa = s0 * n##X.x + s1 * n##X.y + s2 * n##X.z + s3 * n##X.w; \
      sa = -dpp_sum16(sa); \
      s0 = s0 * w##X.x + sa * b##X.x + v##X * k##X.x; s1 = s1 * w##X.y + sa * b##X.y + v##X * k##X.y; \
      s2 = s2 * w##X.z + sa * b##X.z + v##X * k##X.z; s3 = s3 * w##X.w + sa * b##X.w + v##X * k##X.w; \
      float y = s0 * r##X.x + s1 * r##X.y + s2 * r##X.z + s3 * r##X.w; \
      y = dpp_sum16(y); yb[(ST) * 16 + rloc] = y; }
    {
      float4 rA, wA, kA, nA, bA, rB, wB, kB, nB, bB; float vA, vB;
      SC_LOAD(A, 0)
#pragma unroll
      for (int st = 0; st < 16; st += 2) {
        SC_LOAD(B, st + 1)
        SC_STEP(A, st)
        if (st + 2 < 16) SC_LOAD(A, st + 2)
        SC_STEP(B, st + 1)
      }
    }
#undef SC_LOAD
#undef SC_STEP
    __syncthreads();
    {
      const int st = tid >> 4, r = tid & 15;
      YC[(tokb + c * 16 + st) * PS1 + h * 64 + rq * 16 + r] = f2bf(yb[st * 16 + r]);
    }
    if (c + 1 < 256) lstore(buf ^ 1);
    __syncthreads();
  }
}

__device__ __forceinline__ void phase_post(const Params& p, int l, char* smem) {
  const u16* P2 = (const u16*)(p.ws + OFF_P2); u16* YC = (u16*)(p.ws + OFF_P1) + 1560;
  float* sg = (float*)smem;
  const int tid = tidx();
  const float* g2 = p.in[26] + (size_t)l * 128 * 512;
  const float* rk = p.in[29] + (size_t)l * 512; const float* lg = p.in[30] + (size_t)l * 512; const float* lb = p.in[31] + (size_t)l * 512;
  for (int item = blockIdx.x; item < 2048; item += gridDim.x) {
    const int tok0 = item * 16;
    for (int e = tid; e < 2048; e += 256) { const int r = e >> 7, c = e & 127; sg[e] = bf2f(P2[(size_t)(tok0 + r) * PS2 + 1664 + c]); }
    __syncthreads();
    {
      float ag[2][16];
#pragma unroll
      for (int c = 0; c < 2; ++c)
#pragma unroll
        for (int r = 0; r < 16; ++r) ag[c][r] = 0.f;
#pragma unroll 4
      for (int i = 0; i < 128; i += 4) {
        float gv[2][4];
#pragma unroll
        for (int c = 0; c < 2; ++c)
#pragma unroll
          for (int u = 0; u < 4; ++u) gv[c][u] = g2[(i + u) * 512 + tid + c * 256];
#pragma unroll
        for (int r = 0; r < 16; ++r) {
          const float4 t4 = *(const float4*)(sg + r * 128 + i);
#pragma unroll
          for (int c = 0; c < 2; ++c) ag[c][r] += t4.x * gv[c][0] + t4.y * gv[c][1] + t4.z * gv[c][2] + t4.w * gv[c][3];
        }
      }
#pragma unroll
      for (int c = 0; c < 2; ++c) {
        const int ch = tid + c * 256;
        const float rkv = rk[ch], lgv = lg[ch], lbv = lb[ch];
        float yv[16], rr[16], kk[16], vv[16];
#pragma unroll
        for (int r = 0; r < 16; ++r) {
          const u16* row = P2 + (size_t)(tok0 + r) * PS2;
          yv[r] = bf2f(YC[(size_t)(tok0 + r) * PS1 + ch]);
          rr[r] = bf2f(row[ch]); kk[r] = bf2f(row[512 + ch]); vv[r] = bf2f(row[1024 + ch]);
        }
#pragma unroll
        for (int r = 0; r < 16; ++r) {
          const float mean = wave_sum(yv[r]) * (1.f / 64.f);
          const float dv = yv[r] - mean;
          const float var = wave_sum(dv * dv) * (1.f / 64.f);
          const float yn = dv * rsqrtf(var + 64e-5f) * lgv + lbv;
          const float bon = wave_sum(rr[r] * kk[r] * rkv) * vv[r];
          YC[(size_t)(tok0 + r) * PS1 + ch] = f2bf((yn + bon) * ag[c][r]);
        }
      }
    }
    __syncthreads();
  }
}

#define NEGV (-1e30f)
struct AttnState { float m[2]; float ls[2]; f32x4 ot[4][2]; };

#define MINIT (-1e20f)
template <int MODE, bool FULL>
__device__ __forceinline__ void attn_scores(f32x4 (&st)[4][2], const u16* kbase, int kstride, int key0, const bf16x8 (&qf)[2][2],
                                            const float (&slope)[2], int t, bool selbit, int c16, int q4) {
  const float fb = (float)(key0 + q4 * 4 - t);
#pragma unroll
  for (int mk = 0; mk < 4; ++mk) {
    const u16* kp = kbase + (size_t)(mk * 16 + c16) * kstride + q4 * 8;
    const bf16x8 k0 = *(const bf16x8*)kp, k1 = *(const bf16x8*)(kp + 32);
#pragma unroll
    for (int nq = 0; nq < 2; ++nq) {
      f32x4 a = {0.f, 0.f, 0.f, 0.f};
      a = mfma16(k0, qf[nq][0], a);
      a = mfma16(k1, qf[nq][1], a);
      if (FULL) {
        const float c0 = slope[nq] * fb;
#pragma unroll
        for (int j = 0; j < 4; ++j) {
          const float v = a[j] + (c0 + slope[nq] * (float)(mk * 16 + j));
          a[j] = (MODE == 1) ? (selbit ? v : NEGV) : v;
        }
      } else {
#pragma unroll
        for (int j = 0; j < 4; ++j) {
          const int key = key0 + mk * 16 + q4 * 4 + j;
          int dist; bool valid;
          if (MODE == 0) { dist = t - (16 * key + 31); valid = dist >= 0; }
          else if (MODE == 1) { dist = t - key; valid = (dist >= 0) && selbit; }
          else { dist = t - key; valid = (dist >= 0) && (dist < 512); }
          a[j] = valid ? (a[j] - slope[nq] * (float)dist) : NEGV;
        }
      }
      st[mk][nq] = a;
    }
  }
}

template <int MODE, bool FULL>
__device__ __forceinline__ void attn_tile(AttnState& S, const u16* kbase, int kstride, const u16* vtbase, int vstride, int key0,
                                          const bf16x8 (&qf)[2][2], const float (&slope)[2], int t, bool selbit, int c16, int q4) {
  f32x4 st[4][2];
  attn_scores<MODE, FULL>(st, kbase, kstride, key0, qf, slope, t, selbit, c16, q4);
  __builtin_amdgcn_sched_barrier(0);
#pragma unroll
  for (int nq = 0; nq < 2; ++nq) {
    float mx = fmaxf(fmaxf(st[0][nq][0], st[0][nq][1]), fmaxf(st[0][nq][2], st[0][nq][3]));
#pragma unroll
    for (int mk = 1; mk < 4; ++mk) mx = fmaxf(mx, fmaxf(fmaxf(st[mk][nq][0], st[mk][nq][1]), fmaxf(st[mk][nq][2], st[mk][nq][3])));
    mx = fmaxf(mx, __shfl_xor(mx, 16)); mx = fmaxf(mx, __shfl_xor(mx, 32));
    const float mnew = fmaxf(S.m[nq], mx);
    const float alpha = __builtin_amdgcn_exp2f(S.m[nq] - mnew);
    S.m[nq] = mnew;
    float ls = S.ls[nq] * alpha;
#pragma unroll
    for (int md = 0; md < 4; ++md) { S.ot[md][nq][0] *= alpha; S.ot[md][nq][1] *= alpha; S.ot[md][nq][2] *= alpha; S.ot[md][nq][3] *= alpha; }
#pragma unroll
    for (int mk = 0; mk < 4; ++mk)
#pragma unroll
      for (int j = 0; j < 4; ++j) {
        const float pv = __builtin_amdgcn_exp2f(st[mk][nq][j] - mnew);
        st[mk][nq][j] = pv; ls += pv;
      }
    S.ls[nq] = ls;
  }
#pragma unroll
  for (int s2 = 0; s2 < 2; ++s2) {
    __builtin_amdgcn_sched_barrier(0);
    bf16x8 pb[2];
#pragma unroll
    for (int nq = 0; nq < 2; ++nq) {
      uint4 u;
      u.x = pack2(st[2 * s2][nq][0], st[2 * s2][nq][1]); u.y = pack2(st[2 * s2][nq][2], st[2 * s2][nq][3]);
      u.z = pack2(st[2 * s2 + 1][nq][0], st[2 * s2 + 1][nq][1]); u.w = pack2(st[2 * s2 + 1][nq][2], st[2 * s2 + 1][nq][3]);
      pb[nq] = *(bf16x8*)&u;
    }
#pragma unroll
    for (int md = 0; md < 4; ++md) {
      const bf16x8 vf = *(const bf16x8*)(vtbase + (size_t)(md * 16 + c16) * vstride + s2 * 32 + q4 * 8);
#pragma unroll
      for (int nq = 0; nq < 2; ++nq) S.ot[md][nq] = mfma16(vf, pb[nq], S.ot[md][nq]);
    }
  }
}

__device__ __forceinline__ void attn_reset(AttnState& S) {
#pragma unroll
  for (int nq = 0; nq < 2; ++nq) { S.m[nq] = MINIT; S.ls[nq] = 0.f;
#pragma unroll
    for (int md = 0; md < 4; ++md) S.ot[md][nq] = f32x4{0.f, 0.f, 0.f, 0.f}; }
}
__device__ __forceinline__ void attn_fold(AttnState& S, float* oacc, const u16* gp, int br, float (&invl)[2], int lane) {
#pragma unroll
  for (int nq = 0; nq < 2; ++nq) {
    float l = S.ls[nq];
    l += __shfl_xor(l, 16); l += __shfl_xor(l, 32);
    const float inv = (l > 0.f) ? 1.f / l : 0.f;
    invl[nq] = inv;
    const float f = bf2f(gp[nq * 6 + br]) * inv;
#pragma unroll
    for (int md = 0; md < 4; ++md)
#pragma unroll
      for (int j = 0; j < 4; ++j) {
        float* a = oacc + ((md * 2 + nq) * 4 + j) * 64 + lane;
        const float v = f * S.ot[md][nq][j];
        if (br == 0) *a = v; else *a += v;
      }
  }
}

__device__ __forceinline__ void phase_nsa(const Params& p, char* smem, unsigned* queue) {
  u16* P1 = (u16*)(p.ws + OFF_P1);
  const u16* KC = (const u16*)(p.ws + OFF_KC); const u16* VC = (const u16*)(p.ws + OFF_VC); const u16* VT = (const u16*)(p.ws + OFF_VT);
  const int tid = tidx(), lane = tid & 63, wid = tid >> 6;
  const int c16 = lane & 15, q4 = lane >> 4, tq = lane & 7;
  float* ps = (float*)smem + wid * 2048;
  float* oacc = (float*)(smem + 32768) + wid * 2048;
  int* qslot = (int*)(smem + 65536);
#pragma unroll 1
  for (;;) {
    if (tid == 0) *qslot = (int)atomicAdd(queue, 1u);
    __syncthreads();
    const int it = *qslot;
    if (it >= 2048) break;
    const int bg = it & 15;
    const int tqd = 127 - (it >> 4);
    const int b = bg >> 1, g = bg & 1;
    const int t0 = (tqd * 4 + wid) * 8;
    const int tok0 = b * 4096 + t0;
    const int t = t0 + tq;
    const int cur = t0 >> 6;
#pragma unroll
    for (int i = 0; i < 8; ++i) *(float4*)(ps + i * 256 + lane * 4) = float4{0.f, 0.f, 0.f, 0.f};
    bf16x8 qf[2][2]; float slope[2];
    const u16* gp = P1 + (size_t)(tok0 + tq) * PS1 + 1024 + (g * 4 + (c16 >> 3)) * 3;
#pragma unroll
    for (int nq = 0; nq < 2; ++nq) {
      const int hh = nq * 2 + (c16 >> 3);
      const u16* rp = P1 + (size_t)(tok0 + tq) * PS1;
      qf[nq][0] = *(const bf16x8*)(rp + (g * 4 + hh) * 64 + q4 * 8);
      qf[nq][1] = *(const bf16x8*)(rp + (g * 4 + hh) * 64 + 32 + q4 * 8);
      slope[nq] = exp2f(-(float)(g * 4 + hh + 1)) * 1.4426950408889634f;
    }
    AttnState S;
    float invl[2];
    const u16* kcb = KC + (size_t)(b * 2 + g) * 256 * 64;
    const u16* vcb = VC + (size_t)(b * 2 + g) * 64 * 256;
    int ntc = 0;
    if (t0 + 7 >= 31) ntc = (((t0 + 7 - 31) >> 4) >> 6) + 1;
    attn_reset(S);
#pragma unroll 1
    for (int kt = 0; kt < ntc; ++kt) attn_tile<0, false>(S, kcb + (size_t)kt * 64 * 64, 64, vcb + kt * 64, 256, kt * 64, qf, slope, t, true, c16, q4);
    attn_fold(S, oacc, gp, 0, invl, lane);
#pragma unroll 1
    for (int kt = 0; kt < ntc; ++kt) {
      f32x4 st[4][2];
      attn_scores<0, false>(st, kcb + (size_t)kt * 64 * 64, 64, kt * 64, qf, slope, t, true, c16, q4);
#pragma unroll
      for (int mk = 0; mk < 4; ++mk) {
        f32x4 hs;
#pragma unroll
        for (int j = 0; j < 4; ++j) {
          const float a0 = st[mk][0][j], a1 = st[mk][1][j];
          const float p0 = __builtin_amdgcn_exp2f(a0 - S.m[0]) * invl[0];
          const float p1 = __builtin_amdgcn_exp2f(a1 - S.m[1]) * invl[1];
          float v = p0 + p1;
          v += __shfl_xor(v, 8);
          hs[j] = v;
        }
        if (c16 < 8) *(f32x4*)(ps + c16 * 256 + kt * 64 + mk * 16 + q4 * 4) = hs;
      }
    }
    __syncthreads();
    unsigned long long selm = 0ull, un = 0ull;
#pragma unroll 1
    for (int tqq = 0; tqq < 8; ++tqq) {
      const float* pr = ps + tqq * 256;
      float imp = pr[4 * lane];
      if (lane > 0) imp += pr[4 * lane - 4] + 2.f * (pr[4 * lane - 3] + pr[4 * lane - 2] + pr[4 * lane - 1]);
      const bool forced = (lane == 0) || (lane == cur) || (lane == cur - 1);
      const bool live = lane <= cur;
      const float val = forced ? 1e4f : (live ? imp : NEGV);
      int rank = 0;
#pragma unroll 8
      for (int i = 0; i < 64; ++i) {
        const float vi = __uint_as_float(__builtin_amdgcn_readlane(__float_as_uint(val), i));
        rank += ((vi > val) || (vi == val && i < lane)) ? 1 : 0;
      }
      const unsigned long long bal = __ballot((rank < 16) && live);
      if (tq == tqq) selm = bal;
      un |= bal;
    }
    __syncthreads();
    attn_reset(S);
    {
      const u16* vtb = VT + (size_t)((0 * 8 + b) * 2 + g) * 64 * 4096;
#pragma unroll 1
      for (int j = 0; j <= cur; ++j) {
        if (!((un >> j) & 1ull)) continue;
        const bool sb = (selm >> j) & 1ull;
        const u16* kb_ = P1 + (size_t)(b * 4096 + j * 64) * PS1 + 768 + g * 64;
        if (j < cur) attn_tile<1, true>(S, kb_, PS1, vtb + j * 64, 4096, j * 64, qf, slope, t, sb, c16, q4);
        else attn_tile<1, false>(S, kb_, PS1, vtb + j * 64, 4096, j * 64, qf, slope, t, sb, c16, q4);
      }
    }
    attn_fold(S, oacc, gp, 1, invl, lane);
    attn_reset(S);
    {
      const u16* vtb = VT + (size_t)((1 * 8 + b) * 2 + g) * 64 * 4096;
      int j0 = t0 - 511; if (j0 < 0) j0 = 0; j0 >>= 6;
#pragma unroll 1
      for (int j = j0; j <= cur; ++j) {
        const u16* kb_ = P1 + (size_t)(b * 4096 + j * 64) * PS1 + 896 + g * 64;
        const bool full = (j < cur) && (j * 64 >= t0 + 7 - 511);
        if (full) attn_tile<2, true>(S, kb_, PS1, vtb + j * 64, 4096, j * 64, qf, slope, t, true, c16, q4);
        else attn_tile<2, false>(S, kb_, PS1, vtb + j * 64, 4096, j * 64, qf, slope, t, true, c16, q4);
      }
    }
    attn_fold(S, oacc, gp, 2, invl, lane);
#pragma unroll
    for (int nq = 0; nq < 2; ++nq) {
      const int hh = nq * 2 + (c16 >> 3);
      u16* rp = P1 + (size_t)(tok0 + tq) * PS1 + (g * 4 + hh) * 64;
#pragma unroll
      for (int md = 0; md < 4; ++md) {
        const float* a = oacc + ((md * 2 + nq) * 4) * 64 + lane;
        uint2 o; o.x = pack2(a[0], a[64]); o.y = pack2(a[128], a[192]);
        *(uint2*)(rp + md * 16 + q4 * 4) = o;
      }
    }
  }
}

__device__ __forceinline__ const float* modp(const Params& p, int l, int sub, int kind) {
  return (const float*)(p.ws + OFF_MOD) + (size_t)l * 8 * 9216 + sub * 3072 + kind * 1024;
}

__device__ __forceinline__ void run_phase(const Params& p, int ph, char* smem) {
  char* ws = p.ws;
  if (ph == 0) {
    if (blockIdx.x == 0) { unsigned* c = (unsigned*)(ws + OFF_CNT); for (int e = tidx(); e < 1024; e += 256) c[e] = 0u; }
    phase_mod(p, smem);
  }
  int l = 0, s = -1;
  if (ph >= 2) { l = (ph - 2) / 14; s = (ph - 2) % 14; }
  const float* preg = p.in[4] + (size_t)l * 3 * 1024; const float* postg = p.in[5] + (size_t)l * 3 * 1024;
  const bool is_norm = (ph == 1) || s == 2 || s == 10 || s == 13;
  if (is_norm) {
    const float* xin = p.out; float* xout = p.out; const u16* y = nullptr; const float* pg = nullptr; const float* gate = nullptr; float wgt = 0.f;
    const float* prg = nullptr; const float* sh = nullptr; const float* sc = nullptr; u16* h = (u16*)(ws + OFF_H);
    if (ph == 1) { xin = p.in[0]; prg = p.in[4]; sh = modp(p, 0, 0, 0); sc = modp(p, 0, 0, 1); }
    else if (s == 2) { y = (const u16*)(ws + OFF_YF); pg = postg; gate = modp(p, l, 0, 2); wgt = 0.5f; prg = preg + 1024; sh = modp(p, l, 1, 0); sc = modp(p, l, 1, 1); }
    else if (s == 10) { y = (const u16*)(ws + OFF_YM); pg = postg + 1024; gate = modp(p, l, 1, 2); wgt = 1.0f; prg = preg + 2048; sh = modp(p, l, 2, 0); sc = modp(p, l, 2, 1); }
    else { y = (const u16*)(ws + OFF_YF); pg = postg + 2048; gate = modp(p, l, 2, 2); wgt = 0.5f;
      if (l == 0) { prg = p.in[4] + 3 * 1024; sh = modp(p, 1, 0, 0); sc = modp(p, 1, 0, 1); } else { h = nullptr; } }
    phase_norm(xin, xout, y, pg, gate, wgt, prg, sh, sc, h);
  }
  {
    int cl = -1, cf = 0;
    if (ph == 0) { cl = 0; cf = 0; } else if (s == 2) { cl = l; cf = 1; } else if (s == 13 && l == 0) { cl = 1; cf = 0; }
    if (cl >= 0) conv_ffn(p, cl, cf, smem);
    if (cl >= 0 && cf == 0) conv_mix(p, cl, smem);
  }
  if (s == 0 || s == 11) phase_ffn_in(p, smem);
  if (s == 1 || s == 12 || s == 9) {
    const bool o = (s == 9);
    phase_gemm_plain((const u16*)(ws + (o ? OFF_MERGED : OFF_ACT)), o ? 1024 : DFF, (const u16*)(ws + (o ? OFF_WO : OFF_WOUT)), o ? 1024 : DFF,
                     (u16*)(ws + (o ? OFF_YM : OFF_YF)), smem);
  }
  if (s == 3) phase_inproj(p, smem);
  if (s == 4) { phase_prep1(p, l); phase_sgu(p, l, smem); phase_cmp1(p, l, smem); }
  if (s == 5) { phase_prep2(p, l, smem); phase_cmp2(p, l); }
  if (s == 6) {
    const int nb = gridDim.x;
    const int sid = (nb >= 512) ? (((int)blockIdx.x & 1) ? -1 : ((int)blockIdx.x >> 1)) : (int)blockIdx.x;
    const int sstride = (nb >= 512) ? (nb >> 1) : nb;
    if (sid >= 0) {
      __builtin_amdgcn_s_setprio(3);
      for (int it = sid; it < 256; it += sstride) scan_item(p, it, smem);
      __builtin_amdgcn_s_setprio(0);
    }
    phase_nsa(p, smem, (unsigned*)(ws + OFF_CNT) + 64 + l * 64);
  }
  if (s == 7) phase_post(p, l, smem);
  if (s == 8) phase_merge(p, smem);
}

constexpr int NPHASE = 30;

#if COOP
typedef const float* __attribute__((address_space(4))) const* kargp_t;
template <int PH>
__device__ __forceinline__ void run_seq(char* smem, cg::grid_group& grid) {
  if constexpr (PH < NPHASE) {
    {
      kargp_t ka = (kargp_t)__builtin_amdgcn_kernarg_segment_ptr();
      asm volatile("" : "+s"(ka));
      Params q;
#pragma unroll
      for (int i = 0; i < 35; ++i) q.in[i] = ka[i];
      q.out = (float*)ka[35];
      q.ws = (char*)ka[36];
      run_phase(q, PH, smem);
    }
    if constexpr (PH == 0) grid.sync();
    else if constexpr (PH + 1 < NPHASE) {
      kargp_t kb = (kargp_t)__builtin_amdgcn_kernarg_segment_ptr();
      asm volatile("" : "+s"(kb));
      gbar((unsigned*)((char*)kb[36] + OFF_CNT), (unsigned)PH * gridDim.x);
    }
    run_seq<PH + 1>(smem, grid);
  }
}

__global__ void __launch_bounds__(256, 2) mega(Params p) {
  __shared__ __attribute__((aligned(16))) char smem[SMEM_BYTES];
  cg::grid_group grid = cg::this_grid();
  run_seq<0>(smem, grid);
}
#endif

template <int PH>
__global__ void __launch_bounds__(256, 2) kph(Params p) {
  __shared__ __attribute__((aligned(16))) char smem[SMEM_BYTES];
  run_phase(p, PH, smem);
}

template <int PH>
static void launch_seq(const Params& p, int grid, hipStream_t stream) {
  if constexpr (PH < NPHASE) {
    kph<PH><<<grid, 256, 0, stream>>>(p);
    launch_seq<PH + 1>(p, grid, stream);
  }
}

extern "C" void kernel_launch(void* const* d_in, const int* in_sizes, int n_in, void* d_out, int out_size, void* d_ws, size_t ws_size,
                              hipStream_t stream) {
  static int grid_blocks = 0;
  if (!grid_blocks) {
    int dev = 0, cus = 0, per_cu = 0;
    hipGetDevice(&dev);
    hipDeviceGetAttribute(&cus, hipDeviceAttributeMultiprocessorCount, dev);
    #if COOP
    hipOccupancyMaxActiveBlocksPerMultiprocessor(&per_cu, mega, 256, 0);
#else
    per_cu = 2;
#endif
    if (per_cu > 2) per_cu = 2;
    if (per_cu < 1) per_cu = 1;
    grid_blocks = cus * per_cu;
  }
  Params p{};
  for (int i = 0; i < 35; ++i) p.in[i] = (const float*)d_in[i];
  p.out = (float*)d_out;
  p.ws = (char*)d_ws;
#if COOP
  void* args[] = {&p};
  hipError_t e = hipLaunchCooperativeKernel((void*)mega, dim3(grid_blocks), dim3(256), args, 0, stream);
  if (e != hipSuccess) fprintf(stderr, "cooperative launch failed: %s (grid %d)\n", hipGetErrorString(e), grid_blocks);
#else
  launch_seq<0>(p, grid_blocks, stream);
#endif
}
```

```cpp
#include <hip/hip_runtime.h>
#include <hip/hip_cooperative_groups.h>
#include <cstdio>
#include <cstdint>
namespace cg = cooperative_groups;

#ifndef COOP
#define COOP 1
#endif

typedef unsigned short u16;
using bf16x8 = __attribute__((ext_vector_type(8))) short;
using f32x4 = __attribute__((ext_vector_type(4))) float;

constexpr int T = 32768, D = 1024, SEQ = 4096, DFF = 2816;
constexpr int PS1 = 2072, PS2 = 3328;
constexpr int MIXC = 7192, MIXN = 4120;
constexpr size_t OFF_P1 = 0;
constexpr size_t OFF_P2 = OFF_P1 + (size_t)T * PS1 * 2;
constexpr size_t OFF_H = OFF_P2 + (size_t)T * PS2 * 2;
constexpr size_t OFF_WMIX = OFF_H + (size_t)T * 1024 * 2;
constexpr size_t OFF_WG = OFF_WMIX + (size_t)4224 * 1024 * 2;
constexpr size_t OFF_WB = OFF_WG + (size_t)3072 * 1024 * 2;
constexpr size_t OFF_WO = OFF_WB + (size_t)3 * 1024 * 512 * 2;
constexpr size_t OFF_W1 = OFF_WO + (size_t)1024 * 1024 * 2;
constexpr size_t OFF_WIN = OFF_W1 + (size_t)2 * 256 * 2048 * 2;
constexpr size_t OFF_WOUT = OFF_WIN + (size_t)5632 * 1024 * 2;
constexpr size_t OFF_VFIRST = OFF_WOUT + (size_t)1024 * 2816 * 2;
constexpr size_t OFF_VT = OFF_VFIRST + (size_t)T * 512 * 2;
constexpr size_t OFF_MOD = OFF_VT + (size_t)2 * 8 * 2 * 64 * 4096 * 2;
constexpr size_t OFF_PB = OFF_MOD + (size_t)2 * 8 * 9216 * 4;
constexpr size_t OFF_HID = OFF_PB + (size_t)1024 * 1792 * 2;
constexpr size_t OFF_KC = OFF_HID + (size_t)2 * 4096 * 256 * 2;
constexpr size_t OFF_VC = OFF_KC + (size_t)8 * 2 * 256 * 64 * 2;
constexpr size_t OFF_LV = OFF_VC + (size_t)8 * 2 * 64 * 256 * 2;
constexpr size_t OFF_CNT = OFF_LV + (size_t)T * 32 * 4;
constexpr size_t WS_END = OFF_CNT + 4096;
constexpr size_t OFF_ACT = OFF_P1;
constexpr size_t OFF_YF = OFF_ACT + (size_t)T * DFF * 2;
constexpr size_t OFF_H2 = OFF_P2;
constexpr size_t OFF_MERGED = OFF_P2;
constexpr size_t OFF_YM = OFF_MERGED + (size_t)T * 1024 * 2;
constexpr size_t OFF_YC = OFF_H;

constexpr int SMEM_BYTES = 73728;

struct Params { const float* in[35]; float* out; char* ws; };

__device__ __forceinline__ int tidx() { int t = __builtin_amdgcn_workitem_id_x(); asm volatile("" : "+v"(t)); return t; }
__device__ __forceinline__ void gbar(unsigned* cnt, unsigned target) {
  asm volatile("s_waitcnt vmcnt(0) lgkmcnt(0)" ::: "memory");
  __syncthreads();
  if (tidx() == 0) {
    __builtin_amdgcn_fence(__ATOMIC_RELEASE, "agent");
    asm volatile("s_waitcnt vmcnt(0)" ::: "memory");
    __hip_atomic_fetch_add(cnt, 1u, __ATOMIC_RELAXED, __HIP_MEMORY_SCOPE_AGENT);
    while (__hip_atomic_load(cnt, __ATOMIC_RELAXED, __HIP_MEMORY_SCOPE_AGENT) < target) __builtin_amdgcn_s_sleep(1);
    __builtin_amdgcn_fence(__ATOMIC_ACQUIRE, "agent");
    asm volatile("s_waitcnt vmcnt(0)" ::: "memory");
  }
  __syncthreads();
}
__device__ __forceinline__ float dpp_sum16(float v) {
  v += __int_as_float(__builtin_amdgcn_update_dpp(0, __float_as_int(v), 0xB1, 0xF, 0xF, true));
  v += __int_as_float(__builtin_amdgcn_update_dpp(0, __float_as_int(v), 0x4E, 0xF, 0xF, true));
  v += __int_as_float(__builtin_amdgcn_update_dpp(0, __float_as_int(v), 0x141, 0xF, 0xF, true));
  v += __int_as_float(__builtin_amdgcn_update_dpp(0, __float_as_int(v), 0x140, 0xF, 0xF, true));
  return v;
}
__device__ __forceinline__ float bf2f(u16 u) { return __uint_as_float(((unsigned)u) << 16); }
__device__ __forceinline__ u16 f2bf(float f) { __bf16 r = (__bf16)f; return *(u16*)&r; }
typedef __attribute__((ext_vector_type(2))) float f2_t;
typedef __attribute__((ext_vector_type(2))) __bf16 b2_t;
__device__ __forceinline__ unsigned pack2(float a, float b) { f2_t v = {a, b}; b2_t r = __builtin_convertvector(v, b2_t); return *(unsigned*)&r; }
__device__ __forceinline__ float sigmoidf_(float x) { return 1.f / (1.f + __expf(-x)); }
__device__ __forceinline__ float siluf_(float x) { return x / (1.f + __expf(-x)); }
__device__ __forceinline__ float geluf_(float x) { float u = 0.7978845608028654f * (x + 0.044715f * x * x * x); return x / (1.f + __expf(-2.f * u)); }
__device__ __forceinline__ float tanhf_(float x) { return 1.f - 2.f / (1.f + __expf(2.f * x)); }
__device__ __forceinline__ float wave_sum(float v) {
#pragma unroll
  for (int o = 32; o >= 1; o >>= 1) v += __shfl_xor(v, o);
  return v;
}
__device__ __forceinline__ f32x4 mfma16(bf16x8 a, bf16x8 b, f32x4 c) { return __builtin_amdgcn_mfma_f32_16x16x32_bf16(a, b, c, 0, 0, 0); }

__device__ __forceinline__ void conv_w(const float* src, int ld, int K, u16* dst, int NR, int nvalid, int coff, int kind, char* smem) {
  float* tl = (float*)smem;
  const int tid = tidx();
  const int ktn = K >> 6, ntile = (NR >> 6) * ktn;
  for (int tix = blockIdx.x; tix < ntile; tix += gridDim.x) {
    const int R0 = (tix / ktn) << 6, k0 = (tix % ktn) << 6;
    const int c = tid & 63, kq = tid >> 6;
    const int R = R0 + c;
    int sc; bool ok;
    if (kind == 0) { sc = coff + R; ok = R < nvalid; }
    else { int ntl = R >> 7, w = (R >> 6) & 1, n = (R >> 4) & 3, r = R & 15; sc = ((n >= 2) ? DFF : 0) + ntl * 64 + w * 32 + (n & 1) * 16 + r; ok = true; }
#pragma unroll 4
    for (int i = 0; i < 16; ++i) {
      int k = k0 + kq * 16 + i;
      tl[c * 65 + kq * 16 + i] = ok ? src[(size_t)k * ld + sc] : 0.f;
    }
    __syncthreads();
    {
      const int r = tid >> 2, ks = tid & 3;
      const float* s = tl + r * 65 + ks * 16;
      uint4 o0, o1;
      o0.x = pack2(s[0], s[1]); o0.y = pack2(s[2], s[3]); o0.z = pack2(s[4], s[5]); o0.w = pack2(s[6], s[7]);
      o1.x = pack2(s[8], s[9]); o1.y = pack2(s[10], s[11]); o1.z = pack2(s[12], s[13]); o1.w = pack2(s[14], s[15]);
      uint4* dp = (uint4*)(dst + (size_t)(R0 + r) * K + k0 + ks * 16);
      dp[0] = o0; dp[1] = o1;
    }
    __syncthreads();
  }
}

__device__ __forceinline__ void conv_ffn(const Params& p, int l, int f, char* smem) {
  conv_w(p.in[6] + (size_t)(l * 2 + f) * D * (2 * DFF), 2 * DFF, D, (u16*)(p.ws + OFF_WIN), 5632, 5632, 0, 1, smem);
  conv_w(p.in[7] + (size_t)(l * 2 + f) * DFF * D, D, DFF, (u16*)(p.ws + OFF_WOUT), 1024, 1024, 0, 0, smem);
}
__device__ __forceinline__ void conv_mix(const Params& p, int l, char* smem) {
  const float* mw = p.in[8] + (size_t)l * D * MIXC;
  conv_w(mw, MIXC, D, (u16*)(p.ws + OFF_WMIX), 4224, MIXN, 0, 0, smem);
  conv_w(mw, MIXC, D, (u16*)(p.ws + OFF_WG), 3072, 3072, MIXN, 0, smem);
  for (int i = 0; i < 3; ++i)
    conv_w(p.in[9] + (size_t)(l * 3 + i) * 512 * D, D, 512, (u16*)(p.ws + OFF_WB) + (size_t)i * 1024 * 512, 1024, 1024, 0, 0, smem);
  conv_w(p.in[10] + (size_t)l * D * D, D, D, (u16*)(p.ws + OFF_WO), 1024, 1024, 0, 0, smem);
  conv_w(p.in[11] + (size_t)l * 2048 * 256, 256, 2048, (u16*)(p.ws + OFF_W1), 256, 256, 0, 0, smem);
  conv_w(p.in[14] + (size_t)l * 2048 * 256, 256, 2048, (u16*)(p.ws + OFF_W1) + (size_t)256 * 2048, 256, 256, 0, 0, smem);
}

__device__ __forceinline__ void phase_mod(const Params& p, char* smem) {
  float* cond = (float*)smem;
  float* red = cond + 8192;
  const int tid = tidx();
  float* MOD = (float*)(p.ws + OFF_MOD);
  for (int item = blockIdx.x; item < 288; item += gridDim.x) {
    for (int e = tid; e < 8192; e += 256) cond[e] = siluf_(p.in[1][e]);
    __syncthreads();
    const int l = item / 144, n0 = (item % 144) * 64, col = n0 + (tid & 63), kq = tid >> 6;
    float acc[8];
#pragma unroll
    for (int b = 0; b < 8; ++b) acc[b] = 0.f;
    const float* w = p.in[2] + (size_t)l * D * 9216 + col;
#pragma unroll 4
    for (int k = kq * 256; k < kq * 256 + 256; ++k) {
      float wv = w[(size_t)k * 9216];
#pragma unroll
      for (int b = 0; b < 8; ++b) acc[b] += cond[b * 1024 + k] * wv;
    }
#pragma unroll
    for (int b = 0; b < 8; ++b) red[(kq * 8 + b) * 64 + (tid & 63)] = acc[b];
    __syncthreads();
    for (int e = tid; e < 512; e += 256) {
      int b = e >> 6, c = e & 63;
      float s = red[(0 * 8 + b) * 64 + c] + red[(1 * 8 + b) * 64 + c] + red[(2 * 8 + b) * 64 + c] + red[(3 * 8 + b) * 64 + c];
      MOD[(size_t)(l * 8 + b) * 9216 + n0 + c] = s + p.in[3][(size_t)l * 9216 + n0 + c];
    }
    __syncthreads();
  }
}

__device__ __forceinline__ void phase_norm(const float* xin, float* xout, const u16* y, const float* postg, const float* gate, float wgt,
                           const float* preg, const float* shift, const float* scale, u16* h) {
  const int lane = tidx() & 63, wid = tidx() >> 6;
  for (int row = blockIdx.x * 4 + wid; row < T; row += gridDim.x * 4) {
    const int b = row >> 12;
    float4 xv[4];
#pragma unroll
    for (int i = 0; i < 4; ++i) xv[i] = *(const float4*)(xin + (size_t)row * D + i * 256 + lane * 4);
    if (y) {
      float yv[4][4]; float ss = 0.f;
#pragma unroll
      for (int i = 0; i < 4; ++i) {
        uint2 u = *(const uint2*)(y + (size_t)row * D + i * 256 + lane * 4);
        yv[i][0] = bf2f((u16)(u.x & 0xffff)); yv[i][1] = bf2f((u16)(u.x >> 16));
        yv[i][2] = bf2f((u16)(u.y & 0xffff)); yv[i][3] = bf2f((u16)(u.y >> 16));
        ss += yv[i][0] * yv[i][0] + yv[i][1] * yv[i][1] + yv[i][2] * yv[i][2] + yv[i][3] * yv[i][3];
      }
      ss = wave_sum(ss);
      const float rs = rsqrtf(ss * (1.f / 1024.f) + 1e-6f) * wgt;
#pragma unroll
      for (int i = 0; i < 4; ++i) {
        const int c = i * 256 + lane * 4;
        float4 g = *(const float4*)(gate + (size_t)b * 9216 + c);
        float4 pg = *(const float4*)(postg + c);
        xv[i].x += g.x * yv[i][0] * rs * pg.x; xv[i].y += g.y * yv[i][1] * rs * pg.y;
        xv[i].z += g.z * yv[i][2] * rs * pg.z; xv[i].w += g.w * yv[i][3] * rs * pg.w;
      }
    }
    if (xout) {
#pragma unroll
      for (int i = 0; i < 4; ++i) *(float4*)(xout + (size_t)row * D + i * 256 + lane * 4) = xv[i];
    }
    if (h) {
      float ss = 0.f;
#pragma unroll
      for (int i = 0; i < 4; ++i) ss += xv[i].x * xv[i].x + xv[i].y * xv[i].y + xv[i].z * xv[i].z + xv[i].w * xv[i].w;
      ss = wave_sum(ss);
      const float rs = rsqrtf(ss * (1.f / 1024.f) + 1e-6f);
#pragma unroll
      for (int i = 0; i < 4; ++i) {
        const int c = i * 256 + lane * 4;
        float4 pg = *(const float4*)(preg + c);
        float4 sh = *(const float4*)(shift + (size_t)b * 9216 + c);
        float4 sc = *(const float4*)(scale + (size_t)b * 9216 + c);
        uint2 o;
        o.x = pack2(xv[i].x * rs * pg.x * (1.f + sc.x) + sh.x, xv[i].y * rs * pg.y * (1.f + sc.y) + sh.y);
        o.y = pack2(xv[i].z * rs * pg.z * (1.f + sc.z) + sh.z, xv[i].w * rs * pg.w * (1.f + sc.w) + sh.w);
        *(uint2*)(h + (size_t)row * D + c) = o;
      }
    }
  }
}

template <int NS, class FA, class FB>
__device__ __forceinline__ void gemm_loop(f32x4 (&acc)[4][NS], const FA& fa, const FB& fb, int K, u16* sm) {
  constexpr int BN = 32 * NS;
  constexpr int NBV = BN / 32;
  const int tid = tidx(), lane = tid & 63, wid = tid >> 6, wr = wid >> 1, wc = wid & 1, fr = lane & 15, fq = lane >> 4;
  u16* As = sm; u16* Bs = sm + 2 * 128 * 64;
  uint4 ra0[4], rb0[NBV], ra1[4], rb1[NBV];
  const int nt = K >> 6;
  const int lrow = tid >> 3, lk = (tid & 7) * 8;
  const int lsw = lrow * 64 + (((tid & 7) ^ ((lrow >> 1) & 7)) << 3);
  const int c0 = (fq ^ ((fr >> 1) & 7)) << 3, c1 = c0 ^ 32;
#define G_LOAD(RA, RB, KT) { const int kb_ = (KT) << 6; \
    _Pragma("unroll") for (int i = 0; i < 4; ++i) RA[i] = fa(lrow + 32 * i, kb_ + lk); \
    _Pragma("unroll") for (int i = 0; i < NBV; ++i) RB[i] = fb(lrow + 32 * i, kb_ + lk); }
#define G_STORE(RA, RB, BUF) { u16* Aw_ = As + (BUF) * 128 * 64 + lsw; u16* Bw_ = Bs + (BUF) * BN * 64 + lsw; \
    _Pragma("unroll") for (int i = 0; i < 4; ++i) *(uint4*)(Aw_ + i * 32 * 64) = RA[i]; \
    _Pragma("unroll") for (int i = 0; i < NBV; ++i) *(uint4*)(Bw_ + i * 32 * 64) = RB[i]; }
#define G_COMPUTE(BUF) { const u16* Ab = As + (BUF) * 128 * 64 + (wr * 64 + fr) * 64; \
    const u16* Bb = Bs + (BUF) * BN * 64 + (wc * 16 * NS + fr) * 64; \
    _Pragma("unroll") for (int ks = 0; ks < 2; ++ks) { bf16x8 a[4], b[NS]; const int co = ks ? c1 : c0; \
      _Pragma("unroll") for (int m = 0; m < 4; ++m) a[m] = *(const bf16x8*)(Ab + m * 16 * 64 + co); \
      _Pragma("unroll") for (int n = 0; n < NS; ++n) b[n] = *(const bf16x8*)(Bb + n * 16 * 64 + co); \
      __builtin_amdgcn_s_setprio(1); \
      _Pragma("unroll") for (int m = 0; m < 4; ++m) _Pragma("unroll") for (int n = 0; n < NS; ++n) acc[m][n] = mfma16(a[m], b[n], acc[m][n]); \
      __builtin_amdgcn_s_setprio(0); } }
  G_LOAD(ra0, rb0, 0)
  if (nt > 1) G_LOAD(ra1, rb1, 1)
  G_STORE(ra0, rb0, 0)
  __syncthreads();
#pragma unroll 1
  for (int kt = 0; kt < nt; kt += 2) {
    if (kt + 2 < nt) G_LOAD(ra0, rb0, kt + 2)
    G_COMPUTE(0)
    if (kt + 1 < nt) G_STORE(ra1, rb1, 1)
    __syncthreads();
    if (kt + 1 >= nt) break;
    if (kt + 3 < nt) G_LOAD(ra1, rb1, kt + 3)
    G_COMPUTE(1)
    if (kt + 2 < nt) G_STORE(ra0, rb0, 0)
    __syncthreads();
  }
#undef G_LOAD
#undef G_STORE
#undef G_COMPUTE
}

template <int NS>
__device__ __forceinline__ void gemm_loop_dma(f32x4 (&acc)[4][NS], const u16* Ab, int lda, const u16* Bb, int ldb, int K, u16* sm) {
  constexpr int BN = 32 * NS;
  constexpr int NBV = BN / 32;
  const int tid = tidx(), lane = tid & 63, wid = tid >> 6, wr = wid >> 1, wc = wid & 1, fr = lane & 15, fq = lane >> 4;
  u16* As = sm; u16* Bs = sm + 2 * 128 * 64;
  const int nt = K >> 6;
  const int lrow = tid >> 3;
  const int gk = (((tid & 7) ^ ((lrow >> 1) & 7)) << 3);
  const int c0 = (fq ^ ((fr >> 1) & 7)) << 3, c1 = c0 ^ 32;
  const u16* ga = Ab + (size_t)lrow * lda + gk;
  const u16* gb = Bb + (size_t)lrow * ldb + gk;
#define D_ISSUE(KT, BUF) { const int kb_ = (KT) << 6; \
    _Pragma("unroll") for (int i = 0; i < 4; ++i) \
      __builtin_amdgcn_global_load_lds((const unsigned*)(ga + (size_t)(32 * i) * lda + kb_), (unsigned*)(As + (BUF) * 128 * 64 + (tid + 256 * i) * 8), 16, 0, 0); \
    _Pragma("unroll") for (int i = 0; i < NBV; ++i) \
      __builtin_amdgcn_global_load_lds((const unsigned*)(gb + (size_t)(32 * i) * ldb + kb_), (unsigned*)(Bs + (BUF) * BN * 64 + (tid + 256 * i) * 8), 16, 0, 0); }
#define D_COMPUTE(BUF) { const u16* Ap = As + (BUF) * 128 * 64 + (wr * 64 + fr) * 64; \
    const u16* Bp = Bs + (BUF) * BN * 64 + (wc * 16 * NS + fr) * 64; \
    _Pragma("unroll") for (int ks = 0; ks < 2; ++ks) { bf16x8 a[4], b[NS]; const int co = ks ? c1 : c0; \
      _Pragma("unroll") for (int m = 0; m < 4; ++m) a[m] = *(const bf16x8*)(Ap + m * 16 * 64 + co); \
      _Pragma("unroll") for (int n = 0; n < NS; ++n) b[n] = *(const bf16x8*)(Bp + n * 16 * 64 + co); \
      __builtin_amdgcn_s_setprio(1); \
      _Pragma("unroll") for (int m = 0; m < 4; ++m) _Pragma("unroll") for (int n = 0; n < NS; ++n) acc[m][n] = mfma16(a[m], b[n], acc[m][n]); \
      __builtin_amdgcn_s_setprio(0); } }
  D_ISSUE(0, 0)
#pragma unroll 1
  for (int kt = 0; kt < nt; kt += 2) {
    __syncthreads();
    if (kt + 1 < nt) D_ISSUE(kt + 1, 1)
    D_COMPUTE(0)
    if (kt + 1 >= nt) break;
    __syncthreads();
    if (kt + 2 < nt) D_ISSUE(kt + 2, 0)
    D_COMPUTE(1)
  }
  __syncthreads();
#undef D_ISSUE
#undef D_COMPUTE
}

__device__ __forceinline__ bool tile_map(int it, int NT, int& mt, int& nt) {
  const int g = gridDim.x;
  if ((g & 7) == 0) {
    const int xcd = blockIdx.x & 7, bx = blockIdx.x >> 3, nbx = g >> 3;
    const int lid = bx + it * nbx;
    if (lid >= 32 * NT) return false;
    const int grp = lid / (8 * NT), rem = lid - grp * 8 * NT;
    nt = rem >> 3; mt = xcd * 32 + grp * 8 + (rem & 7);
    return true;
  } else {
    const int id = blockIdx.x + it * g;
    if (id >= 256 * NT) return false;
    nt = id % NT; mt = id / NT;
    return true;
  }
}

#define ZERO_ACC(acc, NSV) _Pragma("unroll") for (int m_ = 0; m_ < 4; ++m_) _Pragma("unroll") for (int n_ = 0; n_ < NSV; ++n_) acc[m_][n_] = f32x4{0.f, 0.f, 0.f, 0.f};

__device__ __forceinline__ void phase_ffn_in(const Params& p, char* smem) {
  const u16* H = (const u16*)(p.ws + OFF_H); const u16* W = (const u16*)(p.ws + OFF_WIN); u16* ACT = (u16*)(p.ws + OFF_ACT);
  const int lane = tidx() & 63, wid = tidx() >> 6, wr = wid >> 1, wc = wid & 1, fr = lane & 15, fq = lane >> 4;
  int mt, nt;
  for (int it = 0; tile_map(it, 44, mt, nt); ++it) {
    const int m0 = mt * 128, n0 = nt * 128;
    f32x4 acc[4][4]; ZERO_ACC(acc, 4)
    gemm_loop_dma<4>(acc, H + (size_t)m0 * 1024, 1024, W + (size_t)n0 * 1024, 1024, 1024, (u16*)smem);
#pragma unroll
    for (int m = 0; m < 4; ++m)
#pragma unroll
      for (int n = 0; n < 2; ++n) {
        const int col = nt * 64 + wc * 32 + n * 16 + fr;
        const int r0 = m0 + wr * 64 + m * 16 + fq * 4;
#pragma unroll
        for (int j = 0; j < 4; ++j) ACT[(size_t)(r0 + j) * DFF + col] = f2bf(siluf_(acc[m][n][j]) * acc[m][n + 2][j]);
      }
  }
}

__device__ __forceinline__ void phase_gemm_plain(const u16* A, int lda, const u16* Bt, int K, u16* C, char* smem) {
  const int lane = tidx() & 63, wid = tidx() >> 6, wr = wid >> 1, wc = wid & 1, fr = lane & 15, fq = lane >> 4;
  int mt, nt;
  for (int it = 0; tile_map(it, 8, mt, nt); ++it) {
    const int m0 = mt * 128, n0 = nt * 128;
    f32x4 acc[4][4]; ZERO_ACC(acc, 4)
    gemm_loop_dma<4>(acc, A + (size_t)m0 * lda, lda, Bt + (size_t)n0 * K, K, K, (u16*)smem);
#pragma unroll
    for (int m = 0; m < 4; ++m)
#pragma unroll
      for (int n = 0; n < 4; ++n) {
        const int col = n0 + wc * 64 + n * 16 + fr;
        const int r0 = m0 + wr * 64 + m * 16 + fq * 4;
#pragma unroll
        for (int j = 0; j < 4; ++j) C[(size_t)(r0 + j) * 1024 + col] = f2bf(acc[m][n][j]);
      }
  }
}

__device__ __forceinline__ void phase_inproj(const Params& p, char* smem) {
  const u16* H = (const u16*)(p.ws + OFF_H); const u16* W = (const u16*)(p.ws + OFF_WMIX);
  u16* P1 = (u16*)(p.ws + OFF_P1); u16* P2 = (u16*)(p.ws + OFF_P2); u16* VT = (u16*)(p.ws + OFF_VT); u16* PB = (u16*)(p.ws + OFF_PB);
  const int lane = tidx() & 63, wid = tidx() >> 6, wr = wid >> 1, wc = wid & 1, fr = lane & 15, fq = lane >> 4;
  int mt, nt;
  for (int it = 0; tile_map(it, 33, mt, nt); ++it) {
    const int m0 = mt * 128, n0 = nt * 128;
    f32x4 acc[4][4]; ZERO_ACC(acc, 4)
    gemm_loop_dma<4>(acc, H + (size_t)m0 * 1024, 1024, W + (size_t)n0 * 1024, 1024, 1024, (u16*)smem);
#pragma unroll
    for (int m = 0; m < 4; ++m)
#pragma unroll
      for (int nn = 0; nn < 4; ++nn) {
        const int n = n0 + wc * 64 + nn * 16 + fr;
        if (n >= MIXN) continue;
        const int r0 = m0 + wr * 64 + m * 16 + fq * 4;
        f32x4 v = acc[m][nn];
        if ((n >= 896 && n < 1024) || (n >= 1152 && n < 1280)) {
          const int which = (n >= 1152) ? 1 : 0;
          const int gd = n - (which ? 1152 : 896);
          const int b = r0 >> 12, t = r0 & 4095;
          uint2 o; o.x = pack2(v[0], v[1]); o.y = pack2(v[2], v[3]);
          *(uint2*)(VT + ((size_t)((which * 8 + b) * 128 + gd)) * 4096 + (t & ~31) + 8 * fq + 4 * (m & 1)) = o;
        } else if (n < 1304) {
          const int pc = (n < 896) ? n : ((n < 1152) ? n - 128 : n - 256);
          if (n < 512) { const float qs = 0.125f * 1.4426950408889634f; v[0] *= qs; v[1] *= qs; v[2] *= qs; v[3] *= qs; }
          if (n >= 1280) { v[0] = sigmoidf_(v[0]); v[1] = sigmoidf_(v[1]); v[2] = sigmoidf_(v[2]); v[3] = sigmoidf_(v[3]); }
#pragma unroll
          for (int j = 0; j < 4; ++j) P1[(size_t)(r0 + j) * PS1 + pc] = f2bf(v[j]);
        } else if (n < 2328) {
#pragma unroll
          for (int j = 0; j < 4; ++j) P1[(size_t)(r0 + j) * PS1 + (n - 256)] = f2bf(geluf_(v[j]));
        } else {
          const int pc = n - 2328;
#pragma unroll
          for (int j = 0; j < 4; ++j) P2[(size_t)(r0 + j) * PS2 + pc] = f2bf(v[j]);
          if ((m & 1) && fq == 3) PB[(size_t)((r0 + 3) >> 5) * 1792 + pc] = f2bf(v[3]);
        }
      }
  }
}

__device__ __forceinline__ void phase_merge(const Params& p, char* smem) {
  const u16* H2 = (const u16*)(p.ws + OFF_H); const u16* WG = (const u16*)(p.ws + OFF_WG); const u16* WB = (const u16*)(p.ws + OFF_WB);
  const u16* P1 = (const u16*)(p.ws + OFF_P1); u16* MG = (u16*)(p.ws + OFF_MERGED);
  const int lane = tidx() & 63, wid = tidx() >> 6, wr = wid >> 1, wc = wid & 1, fr = lane & 15, fq = lane >> 4;
  int mt, nt;
  for (int it = 0; tile_map(it, 16, mt, nt); ++it) {
    const int m0 = mt * 128, n0 = nt * 64;
    f32x4 tot[4][2]; ZERO_ACC(tot, 2)
#pragma unroll 1
    for (int i = 0; i < 3; ++i) {
      unsigned gpk[4][2][2];
      {
        f32x4 ag[4][2]; ZERO_ACC(ag, 2)
        gemm_loop_dma<2>(ag, H2 + (size_t)m0 * 1024, 1024, WG + (size_t)(i * 1024 + n0) * 1024, 1024, 1024, (u16*)smem);
#pragma unroll
        for (int m = 0; m < 4; ++m)
#pragma unroll
          for (int n = 0; n < 2; ++n) {
            gpk[m][n][0] = pack2(sigmoidf_(ag[m][n][0]), sigmoidf_(ag[m][n][1]));
            gpk[m][n][1] = pack2(sigmoidf_(ag[m][n][2]), sigmoidf_(ag[m][n][3]));
          }
      }
      f32x4 ay[4][2]; ZERO_ACC(ay, 2)
      const u16* ya = (i == 0) ? P1 : ((i == 1) ? P1 + 1048 : P1 + 1560);
      const int lda = PS1;
      const u16* wb = WB + (size_t)i * 1024 * 512;
      gemm_loop_dma<2>(ay, ya + (size_t)m0 * lda, lda, wb + (size_t)n0 * 512, 512, 512, (u16*)smem);
#pragma unroll
      for (int m = 0; m < 4; ++m)
#pragma unroll
        for (int n = 0; n < 2; ++n) {
          tot[m][n][0] += bf2f((u16)(gpk[m][n][0] & 0xffff)) * ay[m][n][0];
          tot[m][n][1] += bf2f((u16)(gpk[m][n][0] >> 16)) * ay[m][n][1];
          tot[m][n][2] += bf2f((u16)(gpk[m][n][1] & 0xffff)) * ay[m][n][2];
          tot[m][n][3] += bf2f((u16)(gpk[m][n][1] >> 16)) * ay[m][n][3];
        }
    }
#pragma unroll
    for (int m = 0; m < 4; ++m)
#pragma unroll
      for (int n = 0; n < 2; ++n) {
        const int col = n0 + wc * 32 + n * 16 + fr;
        const int r0 = m0 + wr * 64 + m * 16 + fq * 4;
#pragma unroll
        for (int j = 0; j < 4; ++j) MG[(size_t)(r0 + j) * 1024 + col] = f2bf(tot[m][n][j]);
      }
  }
}

__device__ __forceinline__ void phase_cmp1(const Params& p, int l, char* smem) {
  const u16* P1 = (const u16*)(p.ws + OFF_P1); const u16* W1 = (const u16*)(p.ws + OFF_W1); u16* HID = (u16*)(p.ws + OFF_HID);
  const int lane = tidx() & 63, wid = tidx() >> 6, wr = wid >> 1, wc = wid & 1, fr = lane & 15, fq = lane >> 4;
  for (int tix = blockIdx.x; tix < 128; tix += gridDim.x) {
    const int which = tix >> 6, mt = (tix >> 1) & 31, nt = tix & 1;
    const int m0 = mt * 128, n0 = nt * 128;
    const float* pe = (which ? p.in[16] : p.in[13]) + (size_t)l * 2048;
    const u16* w1 = W1 + (size_t)which * 256 * 2048;
    const int cbase = 512 + which * 128;
    f32x4 acc[4][4]; ZERO_ACC(acc, 4)
    auto fa = [&](int r, int k) {
      const int row = m0 + r; const int g = row & 1, n = (row >> 1) & 255, b = row >> 9;
      uint4 o = make_uint4(0, 0, 0, 0);
      if (n < 255) {
        const int lpos = k >> 6, d = k & 63;
        uint4 raw = *(const uint4*)(P1 + (size_t)(b * 4096 + 16 * n + lpos) * PS1 + cbase + g * 64 + d);
        const float* pp = pe + lpos * 64 + d;
        float4 e0 = *(const float4*)pp, e1 = *(const float4*)(pp + 4);
        o.x = pack2(bf2f((u16)(raw.x & 0xffff)) + e0.x, bf2f((u16)(raw.x >> 16)) + e0.y);
        o.y = pack2(bf2f((u16)(raw.y & 0xffff)) + e0.z, bf2f((u16)(raw.y >> 16)) + e0.w);
        o.z = pack2(bf2f((u16)(raw.z & 0xffff)) + e1.x, bf2f((u16)(raw.z >> 16)) + e1.y);
        o.w = pack2(bf2f((u16)(raw.w & 0xffff)) + e1.z, bf2f((u16)(raw.w >> 16)) + e1.w);
      }
      return o;
    };
    auto fb = [&](int r, int k) { return *(const uint4*)(w1 + (size_t)(n0 + r) * 2048 + k); };
    gemm_loop<4>(acc, fa, fb, 2048, (u16*)smem);
#pragma unroll
    for (int m = 0; m < 4; ++m)
#pragma unroll
      for (int n = 0; n < 4; ++n) {
        const int col = n0 + wc * 64 + n * 16 + fr;
        const int r0 = m0 + wr * 64 + m * 16 + fq * 4;
#pragma unroll
        for (int j = 0; j < 4; ++j) HID[((size_t)which * 4096 + r0 + j) * 256 + col] = f2bf(siluf_(acc[m][n][j]));
      }
  }
}

__device__ __forceinline__ void phase_cmp2(const Params& p, int l) {
  const u16* HID = (const u16*)(p.ws + OFF_HID); u16* KC = (u16*)(p.ws + OFF_KC); u16* VC = (u16*)(p.ws + OFF_VC);
  const int total = 2 * 4096 * 64;
  for (int idx = blockIdx.x * 256 + tidx(); idx < total; idx += gridDim.x * 256) {
    const int d = idx & 63, row = (idx >> 6) & 4095, which = idx >> 18;
    const float* w2 = (which ? p.in[15] : p.in[12]) + (size_t)l * 256 * 64;
    const u16* hr = HID + ((size_t)which * 4096 + row) * 256;
    float acc = 0.f;
#pragma unroll 8
    for (int j = 0; j < 256; ++j) acc += bf2f(hr[j]) * w2[j * 64 + d];
    const int g = row & 1, n = (row >> 1) & 255, b = row >> 9;
    if (which == 0) KC[((size_t)(b * 2 + g) * 256 + n) * 64 + d] = f2bf(acc);
    else {
      const int u = n & 31; const int pp = 8 * ((u >> 2) & 3) + 4 * (u >> 4) + (u & 3);
      VC[((size_t)(b * 2 + g) * 64 + d) * 256 + (n & ~31) + pp] = f2bf(acc);
    }
  }
}

__device__ __forceinline__ void phase_sgu(const Params& p, int l, char* smem) {
  u16* P1 = (u16*)(p.ws + OFF_P1);
  u16* Wt = (u16*)smem;
  u16* Vt = Wt + 128 * 136;
  float* st = (float*)(Vt + 128 * 136);
  const int tid = tidx(), lane = tid & 63, wid = tid >> 6, wr = wid >> 1, wc = wid & 1, fr = lane & 15, fq = lane >> 4;
  const float* lng = p.in[17] + (size_t)l * 512; const float* lnb = p.in[18] + (size_t)l * 512;
  for (int item = blockIdx.x; item < 1024; item += gridDim.x) {
    const int ci = item >> 2, gi = item & 3;
    const int tok0 = ci * 128;
#pragma unroll 1
    for (int r0 = wid * 32; r0 < wid * 32 + 32; r0 += 8) {
      uint4 raw[8];
#pragma unroll
      for (int u = 0; u < 8; ++u) raw[u] = *(const uint4*)(P1 + (size_t)(tok0 + r0 + u) * PS1 + 1560 + lane * 8);
#pragma unroll
      for (int u = 0; u < 8; ++u) {
        float f[8];
        f[0] = bf2f((u16)(raw[u].x & 0xffff)); f[1] = bf2f((u16)(raw[u].x >> 16)); f[2] = bf2f((u16)(raw[u].y & 0xffff)); f[3] = bf2f((u16)(raw[u].y >> 16));
        f[4] = bf2f((u16)(raw[u].z & 0xffff)); f[5] = bf2f((u16)(raw[u].z >> 16)); f[6] = bf2f((u16)(raw[u].w & 0xffff)); f[7] = bf2f((u16)(raw[u].w >> 16));
        float s = 0.f, s2 = 0.f;
#pragma unroll
        for (int e = 0; e < 8; ++e) { s += f[e]; }
        s = wave_sum(s);
        const float mu = s * (1.f / 512.f);
#pragma unroll
        for (int e = 0; e < 8; ++e) { float dlt = f[e] - mu; s2 += dlt * dlt; }
        s2 = wave_sum(s2);
        if (lane == 0) { st[(r0 + u) * 2] = mu; st[(r0 + u) * 2 + 1] = rsqrtf(s2 * (1.f / 512.f) + 1e-5f); }
      }
    }
    const float* wsrc = p.in[19] + ((size_t)(l * 4 + gi)) * 128 * 128;
    for (int e = tid; e < 128 * 32; e += 256) {
      const int t = e >> 5, s4 = (e & 31) * 4;
      float4 w = *(const float4*)(wsrc + t * 128 + s4);
      uint2 o;
      o.x = pack2(s4 + 0 <= t ? w.x : 0.f, s4 + 1 <= t ? w.y : 0.f);
      o.y = pack2(s4 + 2 <= t ? w.z : 0.f, s4 + 3 <= t ? w.w : 0.f);
      *(uint2*)(Wt + t * 136 + s4) = o;
    }
    __syncthreads();
    for (int e = tid; e < 128 * 16; e += 256) {
      const int s = e >> 4, c8 = (e & 15) * 8;
      uint4 raw = *(const uint4*)(P1 + (size_t)(tok0 + s) * PS1 + 1560 + gi * 128 + c8);
      const float mu = st[s * 2], rs = st[s * 2 + 1];
      u16 rv[8] = {(u16)(raw.x & 0xffff), (u16)(raw.x >> 16), (u16)(raw.y & 0xffff), (u16)(raw.y >> 16), (u16)(raw.z & 0xffff), (u16)(raw.z >> 16), (u16)(raw.w & 0xffff), (u16)(raw.w >> 16)};
#pragma unroll
      for (int i = 0; i < 8; ++i) {
        const int c = gi * 128 + c8 + i;
        Vt[(c8 + i) * 136 + s] = f2bf((bf2f(rv[i]) - mu) * rs * lng[c] + lnb[c]);
      }
    }
    __syncthreads();
    f32x4 acc[4][4]; ZERO_ACC(acc, 4)
#pragma unroll 1
    for (int ks = 0; ks < 4; ++ks) {
      bf16x8 a[4], b[4];
#pragma unroll
      for (int m = 0; m < 4; ++m) a[m] = *(const bf16x8*)(Wt + (wr * 64 + m * 16 + fr) * 136 + ks * 32 + fq * 8);
#pragma unroll
      for (int n = 0; n < 4; ++n) b[n] = *(const bf16x8*)(Vt + (wc * 64 + n * 16 + fr) * 136 + ks * 32 + fq * 8);
#pragma unroll
      for (int m = 0; m < 4; ++m)
#pragma unroll
        for (int n = 0; n < 4; ++n) acc[m][n] = mfma16(a[m], b[n], acc[m][n]);
    }
    const float* bs = p.in[20] + ((size_t)(l * 4 + gi)) * 128;
#pragma unroll
    for (int m = 0; m < 4; ++m)
#pragma unroll
      for (int n = 0; n < 4; ++n) {
        const int c = wc * 64 + n * 16 + fr;
#pragma unroll
        for (int j = 0; j < 4; ++j) {
          const int t = wr * 64 + m * 16 + fq * 4 + j;
          u16* up = P1 + (size_t)(tok0 + t) * PS1 + 1048 + gi * 128 + c;
          *up = f2bf(bf2f(*up) * (acc[m][n][j] + bs[t]));
        }
      }
    __syncthreads();
  }
}

__device__ __forceinline__ void phase_prep1(const Params& p, int l) {
  u16* P2 = (u16*)(p.ws + OFF_P2); const u16* PB = (const u16*)(p.ws + OFF_PB); u16* VF = (u16*)(p.ws + OFF_VFIRST);
  const float* mu = p.in[21] + (size_t)l * 1792;
  const int total = 1024 * 224;
  for (int idx = blockIdx.x * 256 + tidx(); idx < total; idx += gridDim.x * 256) {
    const int tile = idx / 224, cg8 = (idx % 224) * 8;
    const int tok0 = tile * 32;
    float m8[8];
#pragma unroll
    for (int e = 0; e < 8; ++e) m8[e] = mu[cg8 + e];
    uint4 prev = make_uint4(0, 0, 0, 0);
    if ((tok0 & 4095) != 0) prev = *(const uint4*)(PB + (size_t)(tile - 1) * 1792 + cg8);
#pragma unroll 1
    for (int r0 = 0; r0 < 32; r0 += 8) {
      uint4 cv[8];
#pragma unroll
      for (int u = 0; u < 8; ++u) cv[u] = *(const uint4*)(P2 + (size_t)(tok0 + r0 + u) * PS2 + cg8);
#pragma unroll
      for (int u = 0; u < 8; ++u) {
        const uint4 cur = cv[u];
        unsigned cu[4] = {cur.x, cur.y, cur.z, cur.w}, pu[4] = {prev.x, prev.y, prev.z, prev.w};
        float o[8];
#pragma unroll
        for (int e = 0; e < 8; ++e) {
          float c = bf2f((u16)((cu[e >> 1] >> ((e & 1) * 16)) & 0xffff));
          float pv = bf2f((u16)((pu[e >> 1] >> ((e & 1) * 16)) & 0xffff));
          float sv = c + (pv - c) * m8[e];
          if (cg8 >= 1536 && cg8 < 1600) sv = tanhf_(sv);
          else if (cg8 >= 1664) sv = sigmoidf_(sv);
          o[e] = sv;
        }
        uint4 ov; ov.x = pack2(o[0], o[1]); ov.y = pack2(o[2], o[3]); ov.z = pack2(o[4], o[5]); ov.w = pack2(o[6], o[7]);
        *(uint4*)(P2 + (size_t)(tok0 + r0 + u) * PS2 + cg8) = ov;
        if (l == 0 && cg8 >= 1024 && cg8 < 1536) *(uint4*)(VF + (size_t)(tok0 + r0 + u) * 512 + cg8 - 1024) = ov;
        prev = cur;
      }
    }
  }
}

__device__ __forceinline__ void phase_prep2(const Params& p, int l, char* smem) {
  u16* P2 = (u16*)(p.ws + OFF_P2); const u16* VF = (const u16*)(p.ws + OFF_VFIRST);
  float* twd = (float*)smem;
  float* adl = twd + 1024;
  float* vsh = adl + 1024;
  float* lv = vsh + 8192;
  const int tid = tidx();
  const float* w0 = p.in[22] + (size_t)l * 512; const float* w2 = p.in[23] + (size_t)l * 64 * 512;
  const float* a0 = p.in[24] + (size_t)l * 512; const float* a2 = p.in[25] + (size_t)l * 64 * 512;
  const float* kkp = p.in[27] + (size_t)l * 512; const float* kap = p.in[28] + (size_t)l * 512;
  for (int item = blockIdx.x; item < 2048; item += gridDim.x) {
    const int tok0 = item * 16;
    for (int e = tid; e < 2048; e += 256) {
      const int r = e >> 7, c = e & 127;
      twd[(c >> 6) * 1024 + r * 64 + (c & 63)] = bf2f(P2[(size_t)(tok0 + r) * PS2 + 1536 + c]);
    }
    if (l > 0) {
      for (int e = tid; e < 8192; e += 256) { const int r = e >> 9, c = e & 511; vsh[e] = bf2f(P2[(size_t)(tok0 + r) * PS2 + 1024 + c]); }
    }
    __syncthreads();
    if (l > 0) {
      const float* v1 = p.in[33];
      for (int e = tid; e < 512; e += 256) {
        const int r = e >> 5, j = e & 31;
        float s = 0.f;
#pragma unroll 2
        for (int c = 0; c < 512; c += 4) {
          const float4 t4 = *(const float4*)(vsh + r * 512 + c);
          s += t4.x * v1[c * 32 + j] + t4.y * v1[(c + 1) * 32 + j] + t4.z * v1[(c + 2) * 32 + j] + t4.w * v1[(c + 3) * 32 + j];
        }
        lv[r * 32 + j] = s;
      }
      __syncthreads();
    }
    {
      float aw[2][16], aa[2][16], am[2][16];
#pragma unroll
      for (int c = 0; c < 2; ++c)
#pragma unroll
        for (int r = 0; r < 16; ++r) { aw[c][r] = 0.f; aa[c][r] = 0.f; am[c][r] = 0.f; }
#pragma unroll 2
      for (int i = 0; i < 64; i += 4) {
        float wv[2][4], av[2][4];
#pragma unroll
        for (int c = 0; c < 2; ++c)
#pragma unroll
          for (int u = 0; u < 4; ++u) { wv[c][u] = w2[(i + u) * 512 + tid + c * 256]; av[c][u] = a2[(i + u) * 512 + tid + c * 256]; }
#pragma unroll
        for (int r = 0; r < 16; ++r) {
          const float4 tw = *(const float4*)(twd + r * 64 + i);
          const float4 ta = *(const float4*)(adl + r * 64 + i);
#pragma unroll
          for (int c = 0; c < 2; ++c) {
            aw[c][r] += tw.x * wv[c][0] + tw.y * wv[c][1] + tw.z * wv[c][2] + tw.w * wv[c][3];
            aa[c][r] += ta.x * av[c][0] + ta.y * av[c][1] + ta.z * av[c][2] + ta.w * av[c][3];
          }
        }
      }
      if (l > 0) {
        const float* v2 = p.in[34];
#pragma unroll 2
        for (int j = 0; j < 32; j += 4) {
          float vv[2][4];
#pragma unroll
          for (int c = 0; c < 2; ++c)
#pragma unroll
            for (int u = 0; u < 4; ++u) vv[c][u] = v2[(j + u) * 512 + tid + c * 256];
#pragma unroll
          for (int r = 0; r < 16; ++r) {
            const float4 t4 = *(const float4*)(lv + r * 32 + j);
#pragma unroll
            for (int c = 0; c < 2; ++c) am[c][r] += t4.x * vv[c][0] + t4.y * vv[c][1] + t4.z * vv[c][2] + t4.w * vv[c][3];
          }
        }
      }
#pragma unroll
      for (int c = 0; c < 2; ++c) {
        const int ch = tid + c * 256;
        const float w0v = w0[ch], a0v = a0[ch], kkv = kkp[ch], kav = kap[ch];
        const float v0v = (l > 0) ? p.in[32][ch] : 0.f;
        float kval[16];
#pragma unroll
        for (int r = 0; r < 16; ++r) kval[r] = bf2f(P2[(size_t)(tok0 + r) * PS2 + 512 + ch]);
#pragma unroll
        for (int r = 0; r < 16; ++r) {
          u16* row = P2 + (size_t)(tok0 + r) * PS2;
          const float wpre = w0v + aw[c][r];
          const float nx = -wpre;
          const float sp = fmaxf(nx, 0.f) + __logf(1.f + __expf(-fabsf(nx)));
          const float w = -sp - 0.5f;
          const float decay = __expf(-__expf(w));
          const float a = sigmoidf_(a0v + aa[c][r]);
          const float kk = kval[r] * kkv;
          const float ss = wave_sum(kk * kk);
          const float kkn = kk / fmaxf(sqrtf(ss), 1e-12f);
          row[1792 + ch] = f2bf(decay);
          row[2304 + ch] = f2bf(kkn);
          row[2816 + ch] = f2bf(kkn * a);
          row[512 + ch] = f2bf(kval[r] * (1.f + (a - 1.f) * kav));
          if (l > 0) {
            const float v = vsh[r * 512 + ch];
            const float vf = bf2f(VF[(size_t)(tok0 + r) * 512 + ch]);
            row[1024 + ch] = f2bf(v + (vf - v) * sigmoidf_(v0v + am[c][r]));
          }
        }
      }
    }
    __syncthreads();
  }
}

__device__ __forceinline__ void scan_item(const Params& p, int item, char* smem) {
  const u16* P2 = (const u16*)(p.ws + OFF_P2); u16* YC = (u16*)(p.ws + OFF_P1) + 1560;
  float* vb = (float*)smem;
  float* yb = vb + 2 * 6 * 16 * 64;
  const int tid = tidx(), lane = tid & 63, wid = tid >> 6;
  const int rq = item & 3, h = (item >> 2) & 7, b = item >> 5;
  const int rl = lane >> 4, cq = lane & 15;
  const int rloc = wid * 4 + rl;
  const int ihead = rq * 16 + rloc;
  const int j0 = cq * 4;
  const size_t tokb = (size_t)b * 4096;
  float s0 = 0.f, s1 = 0.f, s2 = 0.f, s3 = 0.f;
  uint4 pre[3];
  auto gload = [&](int c) {
#pragma unroll
    for (int i = 0; i < 3; ++i) {
      const int v = tid + i * 256; const int vec = v >> 7, rem = v & 127, step = rem >> 3, c8 = rem & 7;
      const int off = (vec == 0) ? 0 : (vec == 1) ? 1792 : (vec == 2) ? 512 : (vec == 3) ? 1024 : (vec == 4) ? 2304 : 2816;
      pre[i] = *(const uint4*)(P2 + (tokb + c * 16 + step) * PS2 + off + h * 64 + c8 * 8);
    }
  };
  auto lstore = [&](int buf) {
#pragma unroll
    for (int i = 0; i < 3; ++i) {
      const int v = tid + i * 256; const int vec = v >> 7, rem = v & 127, step = rem >> 3, c8 = rem & 7;
      float* d = vb + ((buf * 6 + vec) * 16 + step) * 64 + c8 * 8;
      float4 f0, f1;
      f0.x = bf2f((u16)(pre[i].x & 0xffff)); f0.y = bf2f((u16)(pre[i].x >> 16)); f0.z = bf2f((u16)(pre[i].y & 0xffff)); f0.w = bf2f((u16)(pre[i].y >> 16));
      f1.x = bf2f((u16)(pre[i].z & 0xffff)); f1.y = bf2f((u16)(pre[i].z >> 16)); f1.z = bf2f((u16)(pre[i].w & 0xffff)); f1.w = bf2f((u16)(pre[i].w >> 16));
      *(float4*)d = f0; *(float4*)(d + 4) = f1;
    }
  };
  gload(0); lstore(0);
  __syncthreads();
  for (int c = 0; c < 256; ++c) {
    const int buf = c & 1;
    if (c + 1 < 256) gload(c + 1);
    const float* base = vb + buf * 6 * 16 * 64;
#define SC_LOAD(X, ST) { r##X = *(const float4*)(base + (0 * 16 + (ST)) * 64 + j0); w##X = *(const float4*)(base + (1 * 16 + (ST)) * 64 + j0); \
      k##X = *(const float4*)(base + (2 * 16 + (ST)) * 64 + j0); v##X = base[(3 * 16 + (ST)) * 64 + ihead]; \
      n##X = *(const float4*)(base + (4 * 16 + (ST)) * 64 + j0); b##X = *(const float4*)(base + (5 * 16 + (ST)) * 64 + j0); }
#define SC_STEP(X, ST) { float sa = s0 * n##X.x + s1 * n##X.y + s2 * n##X.z + s3 * n##X.w; \
      sa = -dpp_sum16(sa); \
      s0 = s0 * w##X.x + sa * b##X.x + v##X * k##X.x; s1 = s1 * w##X.y + sa * b##X.y + v##X * k##X.y; \
      s2 = s2 * w##X.z + sa * b##X.z + v##X * k##X.z; s3 = s3 * w##X.w + sa * b##X.w + v##X * k##X.w; \
      float y = s0 * r##X.x + s1 * r##X.y + s2 * r##X.z + s3 * r##X.w; \
      y = dpp_sum16(y); yb[(ST) * 16 + rloc] = y; }
    {
      float4 rA, wA, kA, nA, bA, rB, wB, kB, nB, bB; float vA, vB;
      SC_LOAD(A, 0)
#pragma unroll
      for (int st = 0; st < 16; st += 2) {
        SC_LOAD(B, st + 1)
        SC_STEP(A, st)
        if (st + 2 < 16) SC_LOAD(A, st + 2)
        SC_STEP(B, st + 1)
      }
    }
#undef SC_LOAD
#undef SC_STEP
    __syncthreads();
    {
      const int st = tid >> 4, r = tid & 15;
      YC[(tokb + c * 16 + st) * PS1 + h * 64 + rq * 16 + r] = f2bf(yb[st * 16 + r]);
    }
    if (c + 1 < 256) lstore(buf ^ 1);
    __syncthreads();
  }
}

__device__ __forceinline__ void phase_post(const Params& p, int l, char* smem) {
  const u16* P2 = (const u16*)(p.ws + OFF_P2); u16* YC = (u16*)(p.ws + OFF_P1) + 1560;
  float* sg = (float*)smem;
  const int tid = tidx();
  const float* g2 = p.in[26] + (size_t)l * 128 * 512;
  const float* rk = p.in[29] + (size_t)l * 512; const float* lg = p.in[30] + (size_t)l * 512; const float* lb = p.in[31] + (size_t)l * 512;
  for (int item = blockIdx.x; item < 2048; item += gridDim.x) {
    const int tok0 = item * 16;
    for (int e = tid; e < 2048; e += 256) { const int r = e >> 7, c = e & 127; sg[e] = bf2f(P2[(size_t)(tok0 + r) * PS2 + 1664 + c]); }
    __syncthreads();
    {
      float ag[2][16];
#pragma unroll
      for (int c = 0; c < 2; ++c)
#pragma unroll
        for (int r = 0; r < 16; ++r) ag[c][r] = 0.f;
#pragma unroll 4
      for (int i = 0; i < 128; i += 4) {
        float gv[2][4];
#pragma unroll
        for (int c = 0; c < 2; ++c)
#pragma unroll
          for (int u = 0; u < 4; ++u) gv[c][u] = g2[(i + u) * 512 + tid + c * 256];
#pragma unroll
        for (int r = 0; r < 16; ++r) {
          const float4 t4 = *(const float4*)(sg + r * 128 + i);
#pragma unroll
          for (int c = 0; c < 2; ++c) ag[c][r] += t4.x * gv[c][0] + t4.y * gv[c][1] + t4.z * gv[c][2] + t4.w * gv[c][3];
        }
      }
#pragma unroll
      for (int c = 0; c < 2; ++c) {
        const int ch = tid + c * 256;
        const float rkv = rk[ch], lgv = lg[ch], lbv = lb[ch];
        float yv[16], rr[16], kk[16], vv[16];
#pragma unroll
        for (int r = 0; r < 16; ++r) {
          const u16* row = P2 + (size_t)(tok0 + r) * PS2;
          yv[r] = bf2f(YC[(size_t)(tok0 + r) * PS1 + ch]);
          rr[r] = bf2f(row[ch]); kk[r] = bf2f(row[512 + ch]); vv[r] = bf2f(row[1024 + ch]);
        }
#pragma unroll
        for (int r = 0; r < 16; ++r) {
          const float mean = wave_sum(yv[r]) * (1.f / 64.f);
          const float dv = yv[r] - mean;
          const float var = wave_sum(dv * dv) * (1.f / 64.f);
          const float yn = dv * rsqrtf(var + 64e-5f) * lgv + lbv;
          const float bon = wave_sum(rr[r] * kk[r] * rkv) * vv[r];
          YC[(size_t)(tok0 + r) * PS1 + ch] = f2bf((yn + bon) * ag[c][r]);
        }
      }
    }
    __syncthreads();
  }
}

#define NEGV (-1e30f)
struct AttnState { float m[2]; float ls[2]; f32x4 ot[4][2]; };

#define MINIT (-1e20f)
template <int MODE, bool FULL>
__device__ __forceinline__ void attn_scores(f32x4 (&st)[4][2], const u16* kbase, int kstride, int key0, const bf16x8 (&qf)[2][2],
                                            const float (&slope)[2], int t, bool selbit, int c16, int q4) {
  const float fb = (float)(key0 + q4 * 4 - t);
#pragma unroll
  for (int mk = 0; mk < 4; ++mk) {
    const u16* kp = kbase + (size_t)(mk * 16 + c16) * kstride + q4 * 8;
    const bf16x8 k0 = *(const bf16x8*)kp, k1 = *(const bf16x8*)(kp + 32);
#pragma unroll
    for (int nq = 0; nq < 2; ++nq) {
      f32x4 a = {0.f, 0.f, 0.f, 0.f};
      a = mfma16(k0, qf[nq][0], a);
      a = mfma16(k1, qf[nq][1], a);
      if (FULL) {
        const float c0 = slope[nq] * fb;
#pragma unroll
        for (int j = 0; j < 4; ++j) {
          const float v = a[j] + (c0 + slope[nq] * (float)(mk * 16 + j));
          a[j] = (MODE == 1) ? (selbit ? v : NEGV) : v;
        }
      } else {
#pragma unroll
        for (int j = 0; j < 4; ++j) {
          const int key = key0 + mk * 16 + q4 * 4 + j;
          int dist; bool valid;
          if (MODE == 0) { dist = t - (16 * key + 31); valid = dist >= 0; }
          else if (MODE == 1) { dist = t - key; valid = (dist >= 0) && selbit; }
          else { dist = t - key; valid = (dist >= 0) && (dist < 512); }
          a[j] = valid ? (a[j] - slope[nq] * (float)dist) : NEGV;
        }
      }
      st[mk][nq] = a;
    }
  }
}

template <int MODE, bool FULL>
__device__ __forceinline__ void attn_tile(AttnState& S, const u16* kbase, int kstride, const u16* vtbase, int vstride, int key0,
                                          const bf16x8 (&qf)[2][2], const float (&slope)[2], int t, bool selbit, int c16, int q4) {
  f32x4 st[4][2];
  attn_scores<MODE, FULL>(st, kbase, kstride, key0, qf, slope, t, selbit, c16, q4);
  __builtin_amdgcn_sched_barrier(0);
#pragma unroll
  for (int nq = 0; nq < 2; ++nq) {
    float mx = fmaxf(fmaxf(st[0][nq][0], st[0][nq][1]), fmaxf(st[0][nq][2], st[0][nq][3]));
#pragma unroll
    for (int mk = 1; mk < 4; ++mk) mx = fmaxf(mx, fmaxf(fmaxf(st[mk][nq][0], st[mk][nq][1]), fmaxf(st[mk][nq][2], st[mk][nq][3])));
    mx = fmaxf(mx, __shfl_xor(mx, 16)); mx = fmaxf(mx, __shfl_xor(mx, 32));
    const float mnew = fmaxf(S.m[nq], mx);
    const float alpha = __builtin_amdgcn_exp2f(S.m[nq] - mnew);
    S.m[nq] = mnew;
    float ls = S.ls[nq] * alpha;
#pragma unroll
    for (int md = 0; md < 4; ++md) { S.ot[md][nq][0] *= alpha; S.ot[md][nq][1] *= alpha; S.ot[md][nq][2] *= alpha; S.ot[md][nq][3] *= alpha; }
#pragma unroll
    for (int mk = 0; mk < 4; ++mk)
#pragma unroll
      for (int j = 0; j < 4; ++j) {
        const float pv = __builtin_amdgcn_exp2f(st[mk][nq][j] - mnew);
        st[mk][nq][j] = pv; ls += pv;
      }
    S.ls[nq] = ls;
  }
#pragma unroll
  for (int s2 = 0; s2 < 2; ++s2) {
    __builtin_amdgcn_sched_barrier(0);
    bf16x8 pb[2];
#pragma unroll
    for (int nq = 0; nq < 2; ++nq) {
      uint4 u;
      u.x = pack2(st[2 * s2][nq][0], st[2 * s2][nq][1]); u.y = pack2(st[2 * s2][nq][2], st[2 * s2][nq][3]);
      u.z = pack2(st[2 * s2 + 1][nq][0], st[2 * s2 + 1][nq][1]); u.w = pack2(st[2 * s2 + 1][nq][2], st[2 * s2 + 1][nq][3]);
      pb[nq] = *(bf16x8*)&u;
    }
#pragma unroll
    for (int md = 0; md < 4; ++md) {
      const bf16x8 vf = *(const bf16x8*)(vtbase + (size_t)(md * 16 + c16) * vstride + s2 * 32 + q4 * 8);
#pragma unroll
      for (int nq = 0; nq < 2; ++nq) S.ot[md][nq] = mfma16(vf, pb[nq], S.ot[md][nq]);
    }
  }
}

__device__ __forceinline__ void attn_reset(AttnState& S) {
#pragma unroll
  for (int nq = 0; nq < 2; ++nq) { S.m[nq] = MINIT; S.ls[nq] = 0.f;
#pragma unroll
    for (int md = 0; md < 4; ++md) S.ot[md][nq] = f32x4{0.f, 0.f, 0.f, 0.f}; }
}
__device__ __forceinline__ void attn_fold(AttnState& S, float* oacc, const u16* gp, int br, float (&invl)[2], int lane) {
#pragma unroll
  for (int nq = 0; nq < 2; ++nq) {
    float l = S.ls[nq];
    l += __shfl_xor(l, 16); l += __shfl_xor(l, 32);
    const float inv = (l > 0.f) ? 1.f / l : 0.f;
    invl[nq] = inv;
    const float f = bf2f(gp[nq * 6 + br]) * inv;
#pragma unroll
    for (int md = 0; md < 4; ++md)
#pragma unroll
      for (int j = 0; j < 4; ++j) {
        float* a = oacc + ((md * 2 + nq) * 4 + j) * 64 + lane;
        const float v = f * S.ot[md][nq][j];
        if (br == 0) *a = v; else *a += v;
      }
  }
}

__device__ __forceinline__ void phase_nsa(const Params& p, char* smem, unsigned* queue) {
  u16* P1 = (u16*)(p.ws + OFF_P1);
  const u16* KC = (const u16*)(p.ws + OFF_KC); const u16* VC = (const u16*)(p.ws + OFF_VC); const u16* VT = (const u16*)(p.ws + OFF_VT);
  const int tid = tidx(), lane = tid & 63, wid = tid >> 6;
  const int c16 = lane & 15, q4 = lane >> 4, tq = lane & 7;
  float* ps = (float*)smem + wid * 2048;
  float* oacc = (float*)(smem + 32768) + wid * 2048;
  int* qslot = (int*)(smem + 65536);
#pragma unroll 1
  for (;;) {
    if (tid == 0) *qslot = (int)atomicAdd(queue, 1u);
    __syncthreads();
    const int it = *qslot;
    if (it >= 2048) break;
    const int bg = it & 15;
    const int tqd = 127 - (it >> 4);
    const int b = bg >> 1, g = bg & 1;
    const int t0 = (tqd * 4 + wid) * 8;
    const int tok0 = b * 4096 + t0;
    const int t = t0 + tq;
    const int cur = t0 >> 6;
#pragma unroll
    for (int i = 0; i < 8; ++i) *(float4*)(ps + i * 256 + lane * 4) = float4{0.f, 0.f, 0.f, 0.f};
    bf16x8 qf[2][2]; float slope[2];
    const u16* gp = P1 + (size_t)(tok0 + tq) * PS1 + 1024 + (g * 4 + (c16 >> 3)) * 3;
#pragma unroll
    for (int nq = 0; nq < 2; ++nq) {
      const int hh = nq * 2 + (c16 >> 3);
      const u16* rp = P1 + (size_t)(tok0 + tq) * PS1;
      qf[nq][0] = *(const bf16x8*)(rp + (g * 4 + hh) * 64 + q4 * 8);
      qf[nq][1] = *(const bf16x8*)(rp + (g * 4 + hh) * 64 + 32 + q4 * 8);
      slope[nq] = exp2f(-(float)(g * 4 + hh + 1)) * 1.4426950408889634f;
    }
    AttnState S;
    float invl[2];
    const u16* kcb = KC + (size_t)(b * 2 + g) * 256 * 64;
    const u16* vcb = VC + (size_t)(b * 2 + g) * 64 * 256;
    int ntc = 0;
    if (t0 + 7 >= 31) ntc = (((t0 + 7 - 31) >> 4) >> 6) + 1;
    attn_reset(S);
#pragma unroll 1
    for (int kt = 0; kt < ntc; ++kt) attn_tile<0, false>(S, kcb + (size_t)kt * 64 * 64, 64, vcb + kt * 64, 256, kt * 64, qf, slope, t, true, c16, q4);
    attn_fold(S, oacc, gp, 0, invl, lane);
#pragma unroll 1
    for (int kt = 0; kt < ntc; ++kt) {
      f32x4 st[4][2];
      attn_scores<0, false>(st, kcb + (size_t)kt * 64 * 64, 64, kt * 64, qf, slope, t, true, c16, q4);
#pragma unroll
      for (int mk = 0; mk < 4; ++mk) {
        f32x4 hs;
#pragma unroll
        for (int j = 0; j < 4; ++j) {
          const float a0 = st[mk][0][j], a1 = st[mk][1][j];
          const float p0 = __builtin_amdgcn_exp2f(a0 - S.m[0]) * invl[0];
          const float p1 = __builtin_amdgcn_exp2f(a1 - S.m[1]) * invl[1];
          float v = p0 + p1;
          v += __shfl_xor(v, 8);
          hs[j] = v;
        }
        if (c16 < 8) *(f32x4*)(ps + c16 * 256 + kt * 64 + mk * 16 + q4 * 4) = hs;
      }
    }
    __syncthreads();
    unsigned long long selm = 0ull, un = 0ull;
#pragma unroll 1
    for (int tqq = 0; tqq < 8; ++tqq) {
      const float* pr = ps + tqq * 256;
      float imp = pr[4 * lane];
      if (lane > 0) imp += pr[4 * lane - 4] + 2.f * (pr[4 * lane - 3] + pr[4 * lane - 2] + pr[4 * lane - 1]);
      const bool forced = (lane == 0) || (lane == cur) || (lane == cur - 1);
      const bool live = lane <= cur;
      const float val = forced ? 1e4f : (live ? imp : NEGV);
      int rank = 0;
#pragma unroll 8
      for (int i = 0; i < 64; ++i) {
        const float vi = __uint_as_float(__builtin_amdgcn_readlane(__float_as_uint(val), i));
        rank += ((vi > val) || (vi == val && i < lane)) ? 1 : 0;
      }
      const unsigned long long bal = __ballot((rank < 16) && live);
      if (tq == tqq) selm = bal;
      un |= bal;
    }
    __syncthreads();
    attn_reset(S);
    {
      const u16* vtb = VT + (size_t)((0 * 8 + b) * 2 + g) * 64 * 4096;
#pragma unroll 1
      for (int j = 0; j <= cur; ++j) {
        if (!((un >> j) & 1ull)) continue;
        const bool sb = (selm >> j) & 1ull;
        const u16* kb_ = P1 + (size_t)(b * 4096 + j * 64) * PS1 + 768 + g * 64;
        if (j < cur) attn_tile<1, true>(S, kb_, PS1, vtb + j * 64, 4096, j * 64, qf, slope, t, sb, c16, q4);
        else attn_tile<1, false>(S, kb_, PS1, vtb + j * 64, 4096, j * 64, qf, slope, t, sb, c16, q4);
      }
    }
    attn_fold(S, oacc, gp, 1, invl, lane);
    attn_reset(S);
    {
      const u16* vtb = VT + (size_t)((1 * 8 + b) * 2 + g) * 64 * 4096;
      int j0 = t0 - 511; if (j0 < 0) j0 = 0; j0 >>= 6;
#pragma unroll 1
      for (int j = j0; j <= cur; ++j) {
        const u16* kb_ = P1 + (size_t)(b * 4096 + j * 64) * PS1 + 896 + g * 64;
        const bool full = (j < cur) && (j * 64 >= t0 + 7 - 511);
        if (full) attn_tile<2, true>(S, kb_, PS1, vtb + j * 64, 4096, j * 64, qf, slope, t, true, c16, q4);
        else attn_tile<2, false>(S, kb_, PS1, vtb + j * 64, 4096, j * 64, qf, slope, t, true, c16, q4);
      }
    }
    attn_fold(S, oacc, gp, 2, invl, lane);
#pragma unroll
    for (int nq = 0; nq < 2; ++nq) {
      const int hh = nq * 2 + (c16 >> 3);
      u16* rp = P1 + (size_t)(tok0 + tq) * PS1 + (g * 4 + hh) * 64;
#pragma unroll
      for (int md = 0; md < 4; ++md) {
        const float* a = oacc + ((md * 2 + nq) * 4) * 64 + lane;
        uint2 o; o.x = pack2(a[0], a[64]); o.y = pack2(a[128], a[192]);
        *(uint2*)(rp + md * 16 + q4 * 4) = o;
      }
    }
  }
}

__device__ __forceinline__ const float* modp(const Params& p, int l, int sub, int kind) {
  return (const float*)(p.ws + OFF_MOD) + (size_t)l * 8 * 9216 + sub * 3072 + kind * 1024;
}

__device__ __forceinline__ void run_phase(const Params& p, int ph, char* smem) {
  char* ws = p.ws;
  if (ph == 0) {
    if (blockIdx.x == 0) { unsigned* c = (unsigned*)(ws + OFF_CNT); for (int e = tidx(); e < 1024; e += 256) c[e] = 0u; }
    phase_mod(p, smem);
  }
  int l = 0, s = -1;
  if (ph >= 2) { l = (ph - 2) / 14; s = (ph - 2) % 14; }
  const float* preg = p.in[4] + (size_t)l * 3 * 1024; const float* postg = p.in[5] + (size_t)l * 3 * 1024;
  const bool is_norm = (ph == 1) || s == 2 || s == 10 || s == 13;
  if (is_norm) {
    const float* xin = p.out; float* xout = p.out; const u16* y = nullptr; const float* pg = nullptr; const float* gate = nullptr; float wgt = 0.f;
    const float* prg = nullptr; const float* sh = nullptr; const float* sc = nullptr; u16* h = (u16*)(ws + OFF_H);
    if (ph == 1) { xin = p.in[0]; prg = p.in[4]; sh = modp(p, 0, 0, 0); sc = modp(p, 0, 0, 1); }
    else if (s == 2) { y = (const u16*)(ws + OFF_YF); pg = postg; gate = modp(p, l, 0, 2); wgt = 0.5f; prg = preg + 1024; sh = modp(p, l, 1, 0); sc = modp(p, l, 1, 1); }
    else if (s == 10) { y = (const u16*)(ws + OFF_YM); pg = postg + 1024; gate = modp(p, l, 1, 2); wgt = 1.0f; prg = preg + 2048; sh = modp(p, l, 2, 0); sc = modp(p, l, 2, 1); }
    else { y = (const u16*)(ws + OFF_YF); pg = postg + 2048; gate = modp(p, l, 2, 2); wgt = 0.5f;
      if (l == 0) { prg = p.in[4] + 3 * 1024; sh = modp(p, 1, 0, 0); sc = modp(p, 1, 0, 1); } else { h = nullptr; } }
    phase_norm(xin, xout, y, pg, gate, wgt, prg, sh, sc, h);
  }
  {
    int cl = -1, cf = 0;
    if (ph == 0) { cl = 0; cf = 0; } else if (s == 2) { cl = l; cf = 1; } else if (s == 13 && l == 0) { cl = 1; cf = 0; }
    if (cl >= 0) conv_ffn(p, cl, cf, smem);
    if (cl >= 0 && cf == 0) conv_mix(p, cl, smem);
  }
  if (s == 0 || s == 11) phase_ffn_in(p, smem);
  if (s == 1 || s == 12 || s == 9) {
    const bool o = (s == 9);
    phase_gemm_plain((const u16*)(ws + (o ? OFF_MERGED : OFF_ACT)), o ? 1024 : DFF, (const u16*)(ws + (o ? OFF_WO : OFF_WOUT)), o ? 1024 : DFF,
                     (u16*)(ws + (o ? OFF_YM : OFF_YF)), smem);
  }
  if (s == 3) phase_inproj(p, smem);
  if (s == 4) { phase_prep1(p, l); phase_sgu(p, l, smem); phase_cmp1(p, l, smem); }
  if (s == 5) { phase_prep2(p, l, smem); phase_cmp2(p, l); }
  if (s == 6) {
    const int nb = gridDim.x;
    const int sid = (nb >= 512) ? (((int)blockIdx.x & 1) ? -1 : ((int)blockIdx.x >> 1)) : (int)blockIdx.x;
    const int sstride = (nb >= 512) ? (nb >> 1) : nb;
    if (sid >= 0) {
      __builtin_amdgcn_s_setprio(3);
      for (int it = sid; it < 256; it += sstride) scan_item(p, it, smem);
      __builtin_amdgcn_s_setprio(0);
    }
    phase_nsa(p, smem, (unsigned*)(ws + OFF_CNT) + 64 + l * 64);
  }
  if (s == 7) phase_post(p, l, smem);
  if (s == 8) phase_merge(p, smem);
}

constexpr int NPHASE = 30;

#if COOP
typedef const float* __attribute__((address_space(4))) const* kargp_t;
template <int PH>
__device__ __forceinline__ void run_seq(char* smem, cg::grid_group& grid) {
  if constexpr (PH < NPHASE) {
    {
      kargp_t ka = (kargp_t)__builtin_amdgcn_kernarg_segment_ptr();
      asm volatile("" : "+s"(ka));
      Params q;
#pragma unroll
      for (int i = 0; i < 35; ++i) q.in[i] = ka[i];
      q.out = (float*)ka[35];
      q.ws = (char*)ka[36];
      run_phase(q, PH, smem);
    }
    if constexpr (PH == 0) grid.sync();
    else if constexpr (PH + 1 < NPHASE) {
      kargp_t kb = (kargp_t)__builtin_amdgcn_kernarg_segment_ptr();
      asm volatile("" : "+s"(kb));
      gbar((unsigned*)((char*)kb[36] + OFF_CNT), (unsigned)PH * gridDim.x);
    }
    run_seq<PH + 1>(smem, grid);
  }
}

__global__ void __launch_bounds__(256, 2) mega(Params p) {
  __shared__ __attribute__((aligned(16))) char smem[SMEM_BYTES];
  cg::grid_group grid = cg::this_grid();
  run_seq<0>(smem, grid);
}
#endif

template <int PH>
__global__ void __launch_bounds__(256, 2) kph(Params p) {
  __shared__ __attribute__((aligned(16))) char smem[SMEM_BYTES];
  run_phase(p, PH, smem);
}

template <int PH>
static void launch_seq(const Params& p, int grid, hipStream_t stream) {
  if constexpr (PH < NPHASE) {
    kph<PH><<<grid, 256, 0, stream>>>(p);
    launch_seq<PH + 1>(p, grid, stream);
  }
}

extern "C" void kernel_launch(void* const* d_in, const int* in_sizes, int n_in, void* d_out, int out_size, void* d_ws, size_t ws_size,
                              hipStream_t stream) {
  static int grid_blocks = 0;
  if (!grid_blocks) {
    int dev = 0, cus = 0, per_cu = 0;
    hipGetDevice(&dev);
    hipDeviceGetAttribute(&cus, hipDeviceAttributeMultiprocessorCount, dev);
    #if COOP
    hipOccupancyMaxActiveBlocksPerMultiprocessor(&per_cu, mega, 256, 0);
#else
    per_cu = 2;
#endif
    if (per_cu > 2) per_cu = 2;
    if (per_cu < 1) per_cu = 1;
    grid_blocks = cus * per_cu;
  }
  Params p{};
  for (int i = 0; i < 35; ++i) p.in[i] = (const float*)d_in[i];
  p.out = (float*)d_out;
  p.ws = (char*)d_ws;
#if COOP
  void* args[] = {&p};
  hipError_t e = hipLaunchCooperativeKernel((void*)mega, dim3(grid_blocks), dim3(256), args, 0, stream);
  if (e != hipSuccess) fprintf(stderr, "cooperative launch failed: %s (grid %d)\n", hipGetErrorString(e), grid_blocks);
#else
  launch_seq<0>(p, grid_blocks, stream);
#endif
}
```

```cpp
#include <hip/hip_runtime.h>
#include <hip/hip_cooperative_groups.h>
#include <cstdio>
#include <cstdint>
namespace cg = cooperative_groups;

#ifndef COOP
#define COOP 1
#endif

typedef unsigned short u16;
using bf16x8 = __attribute__((ext_vector_type(8))) short;
using f32x4 = __attribute__((ext_vector_type(4))) float;

constexpr int T = 32768, D = 1024, SEQ = 4096, DFF = 2816;
constexpr int PS1 = 2072, PS2 = 3328;
constexpr int MIXC = 7192, MIXN = 4120;
constexpr size_t OFF_P1 = 0;
constexpr size_t OFF_P2 = OFF_P1 + (size_t)T * PS1 * 2;
constexpr size_t OFF_H = OFF_P2 + (size_t)T * PS2 * 2;
constexpr size_t OFF_WMIX = OFF_H + (size_t)T * 1024 * 2;
constexpr size_t OFF_WG = OFF_WMIX + (size_t)4224 * 1024 * 2;
constexpr size_t OFF_WB = OFF_WG + (size_t)3072 * 1024 * 2;
constexpr size_t OFF_WO = OFF_WB + (size_t)3 * 1024 * 512 * 2;
constexpr size_t OFF_W1 = OFF_WO + (size_t)1024 * 1024 * 2;
constexpr size_t OFF_WIN = OFF_W1 + (size_t)2 * 256 * 2048 * 2;
constexpr size_t OFF_WOUT = OFF_WIN + (size_t)5632 * 1024 * 2;
constexpr size_t OFF_VFIRST = OFF_WOUT + (size_t)1024 * 2816 * 2;
constexpr size_t OFF_VT = OFF_VFIRST + (size_t)T * 512 * 2;
constexpr size_t OFF_MOD = OFF_VT + (size_t)2 * 8 * 2 * 64 * 4096 * 2;
constexpr size_t OFF_PB = OFF_MOD + (size_t)2 * 8 * 9216 * 4;
constexpr size_t OFF_HID = OFF_PB + (size_t)1024 * 1792 * 2;
constexpr size_t OFF_KC = OFF_HID + (size_t)2 * 4096 * 256 * 2;
constexpr size_t OFF_VC = OFF_KC + (size_t)8 * 2 * 256 * 64 * 2;
constexpr size_t OFF_LV = OFF_VC + (size_t)8 * 2 * 64 * 256 * 2;
constexpr size_t OFF_CNT = OFF_LV + (size_t)T * 32 * 4;
constexpr size_t OFF_WL = OFF_CNT + 4096;
constexpr int WL_W2 = 0, WL_A2 = 512 * 64, WL_G2 = 2 * 512 * 64, WL_V1 = WL_G2 + 512 * 128, WL_V2 = WL_V1 + 64 * 512, WL_END = WL_V2 + 512 * 64;
constexpr size_t WS_END = OFF_WL + (size_t)WL_END * 2;
constexpr size_t OFF_ACT = OFF_P1;
constexpr size_t OFF_YF = OFF_ACT + (size_t)T * DFF * 2;
constexpr size_t OFF_H2 = OFF_P2;
constexpr size_t OFF_MERGED = OFF_P2;
constexpr size_t OFF_YM = OFF_MERGED + (size_t)T * 1024 * 2;
constexpr size_t OFF_YC = OFF_H;

constexpr int SMEM_BYTES = 73728;

struct Params { const float* in[35]; float* out; char* ws; };

__device__ __forceinline__ int tidx() { int t = __builtin_amdgcn_workitem_id_x(); asm volatile("" : "+v"(t)); return t; }
__device__ __forceinline__ void gbar(unsigned* cnt, unsigned target) {
  asm volatile("s_waitcnt vmcnt(0) lgkmcnt(0)" ::: "memory");
  __syncthreads();
  if (tidx() == 0) {
    __builtin_amdgcn_fence(__ATOMIC_RELEASE, "agent");
    asm volatile("s_waitcnt vmcnt(0)" ::: "memory");
    __hip_atomic_fetch_add(cnt, 1u, __ATOMIC_RELAXED, __HIP_MEMORY_SCOPE_AGENT);
    while (__hip_atomic_load(cnt, __ATOMIC_RELAXED, __HIP_MEMORY_SCOPE_AGENT) < target) __builtin_amdgcn_s_sleep(1);
    __builtin_amdgcn_fence(__ATOMIC_ACQUIRE, "agent");
    asm volatile("s_waitcnt vmcnt(0)" ::: "memory");
  }
  __syncthreads();
}
__device__ __forceinline__ float dpp_sum16(float v) {
  v += __int_as_float(__builtin_amdgcn_update_dpp(0, __float_as_int(v), 0xB1, 0xF, 0xF, true));
  v += __int_as_float(__builtin_amdgcn_update_dpp(0, __float_as_int(v), 0x4E, 0xF, 0xF, true));
  v += __int_as_float(__builtin_amdgcn_update_dpp(0, __float_as_int(v), 0x141, 0xF, 0xF, true));
  v += __int_as_float(__builtin_amdgcn_update_dpp(0, __float_as_int(v), 0x140, 0xF, 0xF, true));
  return v;
}
__device__ __forceinline__ float bf2f(u16 u) { return __uint_as_float(((unsigned)u) << 16); }
__device__ __forceinline__ u16 f2bf(float f) { __bf16 r = (__bf16)f; return *(u16*)&r; }
typedef __attribute__((ext_vector_type(2))) float f2_t;
typedef __attribute__((ext_vector_type(2))) __bf16 b2_t;
__device__ __forceinline__ unsigned pack2(float a, float b) { f2_t v = {a, b}; b2_t r = __builtin_convertvector(v, b2_t); return *(unsigned*)&r; }
__device__ __forceinline__ float sigmoidf_(float x) { return 1.f / (1.f + __expf(-x)); }
__device__ __forceinline__ float siluf_(float x) { return x / (1.f + __expf(-x)); }
__device__ __forceinline__ float geluf_(float x) { float u = 0.7978845608028654f * (x + 0.044715f * x * x * x); return x / (1.f + __expf(-2.f * u)); }
__device__ __forceinline__ float tanhf_(float x) { return 1.f - 2.f / (1.f + __expf(2.f * x)); }
__device__ __forceinline__ float wave_sum(float v) {
#pragma unroll
  for (int o = 32; o >= 1; o >>= 1) v += __shfl_xor(v, o);
  return v;
}
__device__ __forceinline__ f32x4 mfma16(bf16x8 a, bf16x8 b, f32x4 c) { return __builtin_amdgcn_mfma_f32_16x16x32_bf16(a, b, c, 0, 0, 0); }

__device__ __forceinline__ void conv_w(const float* src, int ld, int K, u16* dst, int NR, int nvalid, int coff, int kind, char* smem, int kvalid = 1 << 30) {
  float* tl = (float*)smem;
  const int tid = tidx();
  const int ktn = K >> 6, ntile = (NR >> 6) * ktn;
  for (int tix = blockIdx.x; tix < ntile; tix += gridDim.x) {
    const int R0 = (tix / ktn) << 6, k0 = (tix % ktn) << 6;
    const int c = tid & 63, kq = tid >> 6;
    const int R = R0 + c;
    int sc; bool ok;
    if (kind == 0) { sc = coff + R; ok = R < nvalid; }
    else { int ntl = R >> 7, w = (R >> 6) & 1, n = (R >> 4) & 3, r = R & 15; sc = ((n >= 2) ? DFF : 0) + ntl * 64 + w * 32 + (n & 1) * 16 + r; ok = true; }
#pragma unroll 4
    for (int i = 0; i < 16; ++i) {
      int k = k0 + kq * 16 + i;
      tl[c * 65 + kq * 16 + i] = (ok && k < kvalid) ? src[(size_t)k * ld + sc] : 0.f;
    }
    __syncthreads();
    {
      const int r = tid >> 2, ks = tid & 3;
      const float* s = tl + r * 65 + ks * 16;
      uint4 o0, o1;
      o0.x = pack2(s[0], s[1]); o0.y = pack2(s[2], s[3]); o0.z = pack2(s[4], s[5]); o0.w = pack2(s[6], s[7]);
      o1.x = pack2(s[8], s[9]); o1.y = pack2(s[10], s[11]); o1.z = pack2(s[12], s[13]); o1.w = pack2(s[14], s[15]);
      uint4* dp = (uint4*)(dst + (size_t)(R0 + r) * K + k0 + ks * 16);
      dp[0] = o0; dp[1] = o1;
    }
    __syncthreads();
  }
}

__device__ __forceinline__ void conv_ffn(const Params& p, int l, int f, char* smem) {
  conv_w(p.in[6] + (size_t)(l * 2 + f) * D * (2 * DFF), 2 * DFF, D, (u16*)(p.ws + OFF_WIN), 5632, 5632, 0, 1, smem);
  conv_w(p.in[7] + (size_t)(l * 2 + f) * DFF * D, D, DFF, (u16*)(p.ws + OFF_WOUT), 1024, 1024, 0, 0, smem);
}
__device__ __forceinline__ void conv_mix(const Params& p, int l, char* smem) {
  const float* mw = p.in[8] + (size_t)l * D * MIXC;
  conv_w(mw, MIXC, D, (u16*)(p.ws + OFF_WMIX), 4224, MIXN, 0, 0, smem);
  conv_w(mw, MIXC, D, (u16*)(p.ws + OFF_WG), 3072, 3072, MIXN, 0, smem);
  for (int i = 0; i < 3; ++i)
    conv_w(p.in[9] + (size_t)(l * 3 + i) * 512 * D, D, 512, (u16*)(p.ws + OFF_WB) + (size_t)i * 1024 * 512, 1024, 1024, 0, 0, smem);
  conv_w(p.in[10] + (size_t)l * D * D, D, D, (u16*)(p.ws + OFF_WO), 1024, 1024, 0, 0, smem);
  conv_w(p.in[11] + (size_t)l * 2048 * 256, 256, 2048, (u16*)(p.ws + OFF_W1), 256, 256, 0, 0, smem);
  conv_w(p.in[14] + (size_t)l * 2048 * 256, 256, 2048, (u16*)(p.ws + OFF_W1) + (size_t)256 * 2048, 256, 256, 0, 0, smem);
  u16* WL = (u16*)(p.ws + OFF_WL);
  conv_w(p.in[23] + (size_t)l * 64 * 512, 512, 64, WL + WL_W2, 512, 512, 0, 0, smem);
  conv_w(p.in[25] + (size_t)l * 64 * 512, 512, 64, WL + WL_A2, 512, 512, 0, 0, smem);
  conv_w(p.in[26] + (size_t)l * 128 * 512, 512, 128, WL + WL_G2, 512, 512, 0, 0, smem);
  if (l > 0) {
    conv_w(p.in[33], 32, 512, WL + WL_V1, 64, 32, 0, 0, smem);
    conv_w(p.in[34], 512, 64, WL + WL_V2, 512, 512, 0, 0, smem, 32);
  }
}

__device__ __forceinline__ void phase_mod(const Params& p, char* smem) {
  float* cond = (float*)smem;
  float* red = cond + 8192;
  const int tid = tidx();
  float* MOD = (float*)(p.ws + OFF_MOD);
  for (int item = blockIdx.x; item < 288; item += gridDim.x) {
    for (int e = tid; e < 8192; e += 256) cond[e] = siluf_(p.in[1][e]);
    __syncthreads();
    const int l = item / 144, n0 = (item % 144) * 64, col = n0 + (tid & 63), kq = tid >> 6;
    float acc[8];
#pragma unroll
    for (int b = 0; b < 8; ++b) acc[b] = 0.f;
    const float* w = p.in[2] + (size_t)l * D * 9216 + col;
#pragma unroll 4
    for (int k = kq * 256; k < kq * 256 + 256; ++k) {
      float wv = w[(size_t)k * 9216];
#pragma unroll
      for (int b = 0; b < 8; ++b) acc[b] += cond[b * 1024 + k] * wv;
    }
#pragma unroll
    for (int b = 0; b < 8; ++b) red[(kq * 8 + b) * 64 + (tid & 63)] = acc[b];
    __syncthreads();
    for (int e = tid; e < 512; e += 256) {
      int b = e >> 6, c = e & 63;
      float s = red[(0 * 8 + b) * 64 + c] + red[(1 * 8 + b) * 64 + c] + red[(2 * 8 + b) * 64 + c] + red[(3 * 8 + b) * 64 + c];
      MOD[(size_t)(l * 8 + b) * 9216 + n0 + c] = s + p.in[3][(size_t)l * 9216 + n0 + c];
    }
    __syncthreads();
  }
}

__device__ __forceinline__ void phase_norm(const float* xin, float* xout, const u16* y, const float* postg, const float* gate, float wgt,
                           const float* preg, const float* shift, const float* scale, u16* h) {
  const int lane = tidx() & 63, wid = tidx() >> 6;
  for (int row = blockIdx.x * 4 + wid; row < T; row += gridDim.x * 4) {
    const int b = row >> 12;
    float4 xv[4];
#pragma unroll
    for (int i = 0; i < 4; ++i) xv[i] = *(const float4*)(xin + (size_t)row * D + i * 256 + lane * 4);
    if (y) {
      float yv[4][4]; float ss = 0.f;
#pragma unroll
      for (int i = 0; i < 4; ++i) {
        uint2 u = *(const uint2*)(y + (size_t)row * D + i * 256 + lane * 4);
        yv[i][0] = bf2f((u16)(u.x & 0xffff)); yv[i][1] = bf2f((u16)(u.x >> 16));
        yv[i][2] = bf2f((u16)(u.y & 0xffff)); yv[i][3] = bf2f((u16)(u.y >> 16));
        ss += yv[i][0] * yv[i][0] + yv[i][1] * yv[i][1] + yv[i][2] * yv[i][2] + yv[i][3] * yv[i][3];
      }
      ss = wave_sum(ss);
      const float rs = rsqrtf(ss * (1.f / 1024.f) + 1e-6f) * wgt;
#pragma unroll
      for (int i = 0; i < 4; ++i) {
        const int c = i * 256 + lane * 4;
        float4 g = *(const float4*)(gate + (size_t)b * 9216 + c);
        float4 pg = *(const float4*)(postg + c);
        xv[i].x += g.x * yv[i][0] * rs * pg.x; xv[i].y += g.y * yv[i][1] * rs * pg.y;
        xv[i].z += g.z * yv[i][2] * rs * pg.z; xv[i].w += g.w * yv[i][3] * rs * pg.w;
      }
    }
    if (xout) {
#pragma unroll
      for (int i = 0; i < 4; ++i) *(float4*)(xout + (size_t)row * D + i * 256 + lane * 4) = xv[i];
    }
    if (h) {
      float ss = 0.f;
#pragma unroll
      for (int i = 0; i < 4; ++i) ss += xv[i].x * xv[i].x + xv[i].y * xv[i].y + xv[i].z * xv[i].z + xv[i].w * xv[i].w;
      ss = wave_sum(ss);
      const float rs = rsqrtf(ss * (1.f / 1024.f) + 1e-6f);
#pragma unroll
      for (int i = 0; i < 4; ++i) {
        const int c = i * 256 + lane * 4;
        float4 pg = *(const float4*)(preg + c);
        float4 sh = *(const float4*)(shift + (size_t)b * 9216 + c);
        float4 sc = *(const float4*)(scale + (size_t)b * 9216 + c);
        uint2 o;
        o.x = pack2(xv[i].x * rs * pg.x * (1.f + sc.x) + sh.x, xv[i].y * rs * pg.y * (1.f + sc.y) + sh.y);
        o.y = pack2(xv[i].z * rs * pg.z * (1.f + sc.z) + sh.z, xv[i].w * rs * pg.w * (1.f + sc.w) + sh.w);
        *(uint2*)(h + (size_t)row * D + c) = o;
      }
    }
  }
}

template <int NS, class FA, class FB>
__device__ __forceinline__ void gemm_loop(f32x4 (&acc)[4][NS], const FA& fa, const FB& fb, int K, u16* sm) {
  constexpr int BN = 32 * NS;
  constexpr int NBV = BN / 32;
  const int tid = tidx(), lane = tid & 63, wid = tid >> 6, wr = wid >> 1, wc = wid & 1, fr = lane & 15, fq = lane >> 4;
  u16* As = sm; u16* Bs = sm + 2 * 128 * 64;
  uint4 ra0[4], rb0[NBV], ra1[4], rb1[NBV];
  const int nt = K >> 6;
  const int lrow = tid >> 3, lk = (tid & 7) * 8;
  const int lsw = lrow * 64 + (((tid & 7) ^ ((lrow >> 1) & 7)) << 3);
  const int c0 = (fq ^ ((fr >> 1) & 7)) << 3, c1 = c0 ^ 32;
#define G_LOAD(RA, RB, KT) { const int kb_ = (KT) << 6; \
    _Pragma("unroll") for (int i = 0; i < 4; ++i) RA[i] = fa(lrow + 32 * i, kb_ + lk); \
    _Pragma("unroll") for (int i = 0; i < NBV; ++i) RB[i] = fb(lrow + 32 * i, kb_ + lk); }
#define G_STORE(RA, RB, BUF) { u16* Aw_ = As + (BUF) * 128 * 64 + lsw; u16* Bw_ = Bs + (BUF) * BN * 64 + lsw; \
    _Pragma("unroll") for (int i = 0; i < 4; ++i) *(uint4*)(Aw_ + i * 32 * 64) = RA[i]; \
    _Pragma("unroll") for (int i = 0; i < NBV; ++i) *(uint4*)(Bw_ + i * 32 * 64) = RB[i]; }
#define G_COMPUTE(BUF) { const u16* Ab = As + (BUF) * 128 * 64 + (wr * 64 + fr) * 64; \
    const u16* Bb = Bs + (BUF) * BN * 64 + (wc * 16 * NS + fr) * 64; \
    _Pragma("unroll") for (int ks = 0; ks < 2; ++ks) { bf16x8 a[4], b[NS]; const int co = ks ? c1 : c0; \
      _Pragma("unroll") for (int m = 0; m < 4; ++m) a[m] = *(const bf16x8*)(Ab + m * 16 * 64 + co); \
      _Pragma("unroll") for (int n = 0; n < NS; ++n) b[n] = *(const bf16x8*)(Bb + n * 16 * 64 + co); \
      __builtin_amdgcn_s_setprio(1); \
      _Pragma("unroll") for (int m = 0; m < 4; ++m) _Pragma("unroll") for (int n = 0; n < NS; ++n) acc[m][n] = mfma16(a[m], b[n], acc[m][n]); \
      __builtin_amdgcn_s_setprio(0); } }
  G_LOAD(ra0, rb0, 0)
  if (nt > 1) G_LOAD(ra1, rb1, 1)
  G_STORE(ra0, rb0, 0)
  __syncthreads();
#pragma unroll 1
  for (int kt = 0; kt < nt; kt += 2) {
    if (kt + 2 < nt) G_LOAD(ra0, rb0, kt + 2)
    G_COMPUTE(0)
    if (kt + 1 < nt) G_STORE(ra1, rb1, 1)
    __syncthreads();
    if (kt + 1 >= nt) break;
    if (kt + 3 < nt) G_LOAD(ra1, rb1, kt + 3)
    G_COMPUTE(1)
    if (kt + 2 < nt) G_STORE(ra0, rb0, 0)
    __syncthreads();
  }
#undef G_LOAD
#undef G_STORE
#undef G_COMPUTE
}

template <int NS>
__device__ __forceinline__ void gemm_loop_dma(f32x4 (&acc)[4][NS], const u16* Ab, int lda, const u16* Bb, int ldb, int K, u16* sm) {
  constexpr int BN = 32 * NS;
  constexpr int NBV = BN / 32;
  const int tid = tidx(), lane = tid & 63, wid = tid >> 6, wr = wid >> 1, wc = wid & 1, fr = lane & 15, fq = lane >> 4;
  u16* As = sm; u16* Bs = sm + 2 * 128 * 64;
  const int nt = K >> 6;
  const int lrow = tid >> 3;
  const int gk = (((tid & 7) ^ ((lrow >> 1) & 7)) << 3);
  const int c0 = (fq ^ ((fr >> 1) & 7)) << 3, c1 = c0 ^ 32;
  const u16* ga = Ab + (size_t)lrow * lda + gk;
  const u16* gb = Bb + (size_t)lrow * ldb + gk;
#define D_ISSUE(KT, BUF) { const int kb_ = (KT) << 6; \
    _Pragma("unroll") for (int i = 0; i < 4; ++i) \
      __builtin_amdgcn_global_load_lds((const unsigned*)(ga + (size_t)(32 * i) * lda + kb_), (unsigned*)(As + (BUF) * 128 * 64 + (tid + 256 * i) * 8), 16, 0, 0); \
    _Pragma("unroll") for (int i = 0; i < NBV; ++i) \
      __builtin_amdgcn_global_load_lds((const unsigned*)(gb + (size_t)(32 * i) * ldb + kb_), (unsigned*)(Bs + (BUF) * BN * 64 + (tid + 256 * i) * 8), 16, 0, 0); }
#define D_COMPUTE(BUF) { const u16* Ap = As + (BUF) * 128 * 64 + (wr * 64 + fr) * 64; \
    const u16* Bp = Bs + (BUF) * BN * 64 + (wc * 16 * NS + fr) * 64; \
    _Pragma("unroll") for (int ks = 0; ks < 2; ++ks) { bf16x8 a[4], b[NS]; const int co = ks ? c1 : c0; \
      _Pragma("unroll") for (int m = 0; m < 4; ++m) a[m] = *(const bf16x8*)(Ap + m * 16 * 64 + co); \
      _Pragma("unroll") for (int n = 0; n < NS; ++n) b[n] = *(const bf16x8*)(Bp + n * 16 * 64 + co); \
      __builtin_amdgcn_s_setprio(1); \
      _Pragma("unroll") for (int m = 0; m < 4; ++m) _Pragma("unroll") for (int n = 0; n < NS; ++n) acc[m][n] = mfma16(a[m], b[n], acc[m][n]); \
      __builtin_amdgcn_s_setprio(0); } }
  D_ISSUE(0, 0)
#pragma unroll 1
  for (int kt = 0; kt < nt; kt += 2) {
    __syncthreads();
    if (kt + 1 < nt) D_ISSUE(kt + 1, 1)
    D_COMPUTE(0)
    if (kt + 1 >= nt) break;
    __syncthreads();
    if (kt + 2 < nt) D_ISSUE(kt + 2, 0)
    D_COMPUTE(1)
  }
  __syncthreads();
#undef D_ISSUE
#undef D_COMPUTE
}

__device__ __forceinline__ bool tile_map(int it, int NT, int& mt, int& nt) {
  const int g = gridDim.x;
  if ((g & 7) == 0) {
    const int xcd = blockIdx.x & 7, bx = blockIdx.x >> 3, nbx = g >> 3;
    const int lid = bx + it * nbx;
    if (lid >= 32 * NT) return false;
    const int grp = lid / (8 * NT), rem = lid - grp * 8 * NT;
    nt = rem >> 3; mt = xcd * 32 + grp * 8 + (rem & 7);
    return true;
  } else {
    const int id = blockIdx.x + it * g;
    if (id >= 256 * NT) return false;
    nt = id % NT; mt = id / NT;
    return true;
  }
}

#define ZERO_ACC(acc, NSV) _Pragma("unroll") for (int m_ = 0; m_ < 4; ++m_) _Pragma("unroll") for (int n_ = 0; n_ < NSV; ++n_) acc[m_][n_] = f32x4{0.f, 0.f, 0.f, 0.f};

__device__ __forceinline__ void phase_ffn_in(const Params& p, char* smem) {
  const u16* H = (const u16*)(p.ws + OFF_H); const u16* W = (const u16*)(p.ws + OFF_WIN); u16* ACT = (u16*)(p.ws + OFF_ACT);
  const int lane = tidx() & 63, wid = tidx() >> 6, wr = wid >> 1, wc = wid & 1, fr = lane & 15, fq = lane >> 4;
  int mt, nt;
  for (int it = 0; tile_map(it, 44, mt, nt); ++it) {
    const int m0 = mt * 128, n0 = nt * 128;
    f32x4 acc[4][4]; ZERO_ACC(acc, 4)
    gemm_loop_dma<4>(acc, H + (size_t)m0 * 1024, 1024, W + (size_t)n0 * 1024, 1024, 1024, (u16*)smem);
#pragma unroll
    for (int m = 0; m < 4; ++m)
#pragma unroll
      for (int n = 0; n < 2; ++n) {
        const int col = nt * 64 + wc * 32 + n * 16 + fr;
        const int r0 = m0 + wr * 64 + m * 16 + fq * 4;
#pragma unroll
        for (int j = 0; j < 4; ++j) ACT[(size_t)(r0 + j) * DFF + col] = f2bf(siluf_(acc[m][n][j]) * acc[m][n + 2][j]);
      }
  }
}

__device__ __forceinline__ void phase_gemm_plain(const u16* A, int lda, const u16* Bt, int K, u16* C, char* smem) {
  const int lane = tidx() & 63, wid = tidx() >> 6, wr = wid >> 1, wc = wid & 1, fr = lane & 15, fq = lane >> 4;
  int mt, nt;
  for (int it = 0; tile_map(it, 8, mt, nt); ++it) {
    const int m0 = mt * 128, n0 = nt * 128;
    f32x4 acc[4][4]; ZERO_ACC(acc, 4)
    gemm_loop_dma<4>(acc, A + (size_t)m0 * lda, lda, Bt + (size_t)n0 * K, K, K, (u16*)smem);
#pragma unroll
    for (int m = 0; m < 4; ++m)
#pragma unroll
      for (int n = 0; n < 4; ++n) {
        const int col = n0 + wc * 64 + n * 16 + fr;
        const int r0 = m0 + wr * 64 + m * 16 + fq * 4;
#pragma unroll
        for (int j = 0; j < 4; ++j) C[(size_t)(r0 + j) * 1024 + col] = f2bf(acc[m][n][j]);
      }
  }
}

__device__ __forceinline__ void phase_inproj(const Params& p, char* smem) {
  const u16* H = (const u16*)(p.ws + OFF_H); const u16* W = (const u16*)(p.ws + OFF_WMIX);
  u16* P1 = (u16*)(p.ws + OFF_P1); u16* P2 = (u16*)(p.ws + OFF_P2); u16* VT = (u16*)(p.ws + OFF_VT); u16* PB = (u16*)(p.ws + OFF_PB);
  const int lane = tidx() & 63, wid = tidx() >> 6, wr = wid >> 1, wc = wid & 1, fr = lane & 15, fq = lane >> 4;
  int mt, nt;
  for (int it = 0; tile_map(it, 33, mt, nt); ++it) {
    const int m0 = mt * 128, n0 = nt * 128;
    f32x4 acc[4][4]; ZERO_ACC(acc, 4)
    gemm_loop_dma<4>(acc, H + (size_t)m0 * 1024, 1024, W + (size_t)n0 * 1024, 1024, 1024, (u16*)smem);
#pragma unroll
    for (int m = 0; m < 4; ++m)
#pragma unroll
      for (int nn = 0; nn < 4; ++nn) {
        const int n = n0 + wc * 64 + nn * 16 + fr;
        if (n >= MIXN) continue;
        const int r0 = m0 + wr * 64 + m * 16 + fq * 4;
        f32x4 v = acc[m][nn];
        if ((n >= 896 && n < 1024) || (n >= 1152 && n < 1280)) {
          const int which = (n >= 1152) ? 1 : 0;
          const int gd = n - (which ? 1152 : 896);
          const int b = r0 >> 12, t = r0 & 4095;
          uint2 o; o.x = pack2(v[0], v[1]); o.y = pack2(v[2], v[3]);
          *(uint2*)(VT + ((size_t)((which * 8 + b) * 128 + gd)) * 4096 + (t & ~31) + 8 * fq + 4 * (m & 1)) = o;
        } else if (n < 1304) {
          const int pc = (n < 896) ? n : ((n < 1152) ? n - 128 : n - 256);
          if (n < 512) { const float qs = 0.125f * 1.4426950408889634f; v[0] *= qs; v[1] *= qs; v[2] *= qs; v[3] *= qs; }
          if (n >= 1280) { v[0] = sigmoidf_(v[0]); v[1] = sigmoidf_(v[1]); v[2] = sigmoidf_(v[2]); v[3] = sigmoidf_(v[3]); }
#pragma unroll
          for (int j = 0; j < 4; ++j) P1[(size_t)(r0 + j) * PS1 + pc] = f2bf(v[j]);
        } else if (n < 2328) {
#pragma unroll
          for (int j = 0; j < 4; ++j) P1[(size_t)(r0 + j) * PS1 + (n - 256)] = f2bf(geluf_(v[j]));
        } else {
          const int pc = n - 2328;
#pragma unroll
          for (int j = 0; j < 4; ++j) P2[(size_t)(r0 + j) * PS2 + pc] = f2bf(v[j]);
          if ((m & 1) && fq == 3) PB[(size_t)((r0 + 3) >> 5) * 1792 + pc] = f2bf(v[3]);
        }
      }
  }
}

__device__ __forceinline__ void phase_merge(const Params& p, char* smem) {
  const u16* H2 = (const u16*)(p.ws + OFF_H); const u16* WG = (const u16*)(p.ws + OFF_WG); const u16* WB = (const u16*)(p.ws + OFF_WB);
  const u16* P1 = (const u16*)(p.ws + OFF_P1); u16* MG = (u16*)(p.ws + OFF_MERGED);
  const int lane = tidx() & 63, wid = tidx() >> 6, wr = wid >> 1, wc = wid & 1, fr = lane & 15, fq = lane >> 4;
  int mt, nt;
  for (int it = 0; tile_map(it, 16, mt, nt); ++it) {
    const int m0 = mt * 128, n0 = nt * 64;
    f32x4 tot[4][2]; ZERO_ACC(tot, 2)
#pragma unroll 1
    for (int i = 0; i < 3; ++i) {
      unsigned gpk[4][2][2];
      {
        f32x4 ag[4][2]; ZERO_ACC(ag, 2)
        gemm_loop_dma<2>(ag, H2 + (size_t)m0 * 1024, 1024, WG + (size_t)(i * 1024 + n0) * 1024, 1024, 1024, (u16*)smem);
#pragma unroll
        for (int m = 0; m < 4; ++m)
#pragma unroll
          for (int n = 0; n < 2; ++n) {
            gpk[m][n][0] = pack2(sigmoidf_(ag[m][n][0]), sigmoidf_(ag[m][n][1]));
            gpk[m][n][1] = pack2(sigmoidf_(ag[m][n][2]), sigmoidf_(ag[m][n][3]));
          }
      }
      f32x4 ay[4][2]; ZERO_ACC(ay, 2)
      const u16* ya = (i == 0) ? P1 : ((i == 1) ? P1 + 1048 : P1 + 1560);
      const int lda = PS1;
      const u16* wb = WB + (size_t)i * 1024 * 512;
      gemm_loop_dma<2>(ay, ya + (size_t)m0 * lda, lda, wb + (size_t)n0 * 512, 512, 512, (u16*)smem);
#pragma unroll
      for (int m = 0; m < 4; ++m)
#pragma unroll
        for (int n = 0; n < 2; ++n) {
          tot[m][n][0] += bf2f((u16)(gpk[m][n][0] & 0xffff)) * ay[m][n][0];
          tot[m][n][1] += bf2f((u16)(gpk[m][n][0] >> 16)) * ay[m][n][1];
          tot[m][n][2] += bf2f((u16)(gpk[m][n][1] & 0xffff)) * ay[m][n][2];
          tot[m][n][3] += bf2f((u16)(gpk[m][n][1] >> 16)) * ay[m][n][3];
        }
    }
#pragma unroll
    for (int m = 0; m < 4; ++m)
#pragma unroll
      for (int n = 0; n < 2; ++n) {
        const int col = n0 + wc * 32 + n * 16 + fr;
        const int r0 = m0 + wr * 64 + m * 16 + fq * 4;
#pragma unroll
        for (int j = 0; j < 4; ++j) MG[(size_t)(r0 + j) * 1024 + col] = f2bf(tot[m][n][j]);
      }
  }
}

__device__ __forceinline__ void phase_cmp1(const Params& p, int l, char* smem) {
  const u16* P1 = (const u16*)(p.ws + OFF_P1); const u16* W1 = (const u16*)(p.ws + OFF_W1); u16* HID = (u16*)(p.ws + OFF_HID);
  const int lane = tidx() & 63, wid = tidx() >> 6, wr = wid >> 1, wc = wid & 1, fr = lane & 15, fq = lane >> 4;
  for (int tix = blockIdx.x; tix < 128; tix += gridDim.x) {
    const int which = tix >> 6, mt = (tix >> 1) & 31, nt = tix & 1;
    const int m0 = mt * 128, n0 = nt * 128;
    const float* pe = (which ? p.in[16] : p.in[13]) + (size_t)l * 2048;
    const u16* w1 = W1 + (size_t)which * 256 * 2048;
    const int cbase = 512 + which * 128;
    f32x4 acc[4][4]; ZERO_ACC(acc, 4)
    auto fa = [&](int r, int k) {
      const int row = m0 + r; const int g = row & 1, n = (row >> 1) & 255, b = row >> 9;
      uint4 o = make_uint4(0, 0, 0, 0);
      if (n < 255) {
        const int lpos = k >> 6, d = k & 63;
        uint4 raw = *(const uint4*)(P1 + (size_t)(b * 4096 + 16 * n + lpos) * PS1 + cbase + g * 64 + d);
        const float* pp = pe + lpos * 64 + d;
        float4 e0 = *(const float4*)pp, e1 = *(const float4*)(pp + 4);
        o.x = pack2(bf2f((u16)(raw.x & 0xffff)) + e0.x, bf2f((u16)(raw.x >> 16)) + e0.y);
        o.y = pack2(bf2f((u16)(raw.y & 0xffff)) + e0.z, bf2f((u16)(raw.y >> 16)) + e0.w);
        o.z = pack2(bf2f((u16)(raw.z & 0xffff)) + e1.x, bf2f((u16)(raw.z >> 16)) + e1.y);
        o.w = pack2(bf2f((u16)(raw.w & 0xffff)) + e1.z, bf2f((u16)(raw.w >> 16)) + e1.w);
      }
      return o;
    };
    auto fb = [&](int r, int k) { return *(const uint4*)(w1 + (size_t)(n0 + r) * 2048 + k); };
    gemm_loop<4>(acc, fa, fb, 2048, (u16*)smem);
#pragma unroll
    for (int m = 0; m < 4; ++m)
#pragma unroll
      for (int n = 0; n < 4; ++n) {
        const int col = n0 + wc * 64 + n * 16 + fr;
        const int r0 = m0 + wr * 64 + m * 16 + fq * 4;
#pragma unroll
        for (int j = 0; j < 4; ++j) HID[((size_t)which * 4096 + r0 + j) * 256 + col] = f2bf(siluf_(acc[m][n][j]));
      }
  }
}

__device__ __forceinline__ void phase_cmp2(const Params& p, int l) {
  const u16* HID = (const u16*)(p.ws + OFF_HID); u16* KC = (u16*)(p.ws + OFF_KC); u16* VC = (u16*)(p.ws + OFF_VC);
  const int total = 2 * 4096 * 64;
  for (int idx = blockIdx.x * 256 + tidx(); idx < total; idx += gridDim.x * 256) {
    const int d = idx & 63, row = (idx >> 6) & 4095, which = idx >> 18;
    const float* w2 = (which ? p.in[15] : p.in[12]) + (size_t)l * 256 * 64;
    const u16* hr = HID + ((size_t)which * 4096 + row) * 256;
    float acc = 0.f;
#pragma unroll 8
    for (int j = 0; j < 256; ++j) acc += bf2f(hr[j]) * w2[j * 64 + d];
    const int g = row & 1, n = (row >> 1) & 255, b = row >> 9;
    if (which == 0) KC[((size_t)(b * 2 + g) * 256 + n) * 64 + d] = f2bf(acc);
    else {
      const int u = n & 31; const int pp = 8 * ((u >> 2) & 3) + 4 * (u >> 4) + (u & 3);
      VC[((size_t)(b * 2 + g) * 64 + d) * 256 + (n & ~31) + pp] = f2bf(acc);
    }
  }
}

__device__ __forceinline__ void phase_sgu(const Params& p, int l, char* smem) {
  u16* P1 = (u16*)(p.ws + OFF_P1);
  u16* Wt = (u16*)smem;
  u16* Vt = Wt + 128 * 136;
  float* st = (float*)(Vt + 128 * 136);
  const int tid = tidx(), lane = tid & 63, wid = tid >> 6, wr = wid >> 1, wc = wid & 1, fr = lane & 15, fq = lane >> 4;
  const float* lng = p.in[17] + (size_t)l * 512; const float* lnb = p.in[18] + (size_t)l * 512;
  for (int item = blockIdx.x; item < 1024; item += gridDim.x) {
    const int ci = item >> 2, gi = item & 3;
    const int tok0 = ci * 128;
#pragma unroll 1
    for (int r0 = wid * 32; r0 < wid * 32 + 32; r0 += 8) {
      uint4 raw[8];
#pragma unroll
      for (int u = 0; u < 8; ++u) raw[u] = *(const uint4*)(P1 + (size_t)(tok0 + r0 + u) * PS1 + 1560 + lane * 8);
#pragma unroll
      for (int u = 0; u < 8; ++u) {
        float f[8];
        f[0] = bf2f((u16)(raw[u].x & 0xffff)); f[1] = bf2f((u16)(raw[u].x >> 16)); f[2] = bf2f((u16)(raw[u].y & 0xffff)); f[3] = bf2f((u16)(raw[u].y >> 16));
        f[4] = bf2f((u16)(raw[u].z & 0xffff)); f[5] = bf2f((u16)(raw[u].z >> 16)); f[6] = bf2f((u16)(raw[u].w & 0xffff)); f[7] = bf2f((u16)(raw[u].w >> 16));
        float s = 0.f, s2 = 0.f;
#pragma unroll
        for (int e = 0; e < 8; ++e) { s += f[e]; }
        s = wave_sum(s);
        const float mu = s * (1.f / 512.f);
#pragma unroll
        for (int e = 0; e < 8; ++e) { float dlt = f[e] - mu; s2 += dlt * dlt; }
        s2 = wave_sum(s2);
        if (lane == 0) { st[(r0 + u) * 2] = mu; st[(r0 + u) * 2 + 1] = rsqrtf(s2 * (1.f / 512.f) + 1e-5f); }
      }
    }
    const float* wsrc = p.in[19] + ((size_t)(l * 4 + gi)) * 128 * 128;
    for (int e = tid; e < 128 * 32; e += 256) {
      const int t = e >> 5, s4 = (e & 31) * 4;
      float4 w = *(const float4*)(wsrc + t * 128 + s4);
      uint2 o;
      o.x = pack2(s4 + 0 <= t ? w.x : 0.f, s4 + 1 <= t ? w.y : 0.f);
      o.y = pack2(s4 + 2 <= t ? w.z : 0.f, s4 + 3 <= t ? w.w : 0.f);
      *(uint2*)(Wt + t * 136 + s4) = o;
    }
    __syncthreads();
    for (int e = tid; e < 128 * 16; e += 256) {
      const int s = e >> 4, c8 = (e & 15) * 8;
      uint4 raw = *(const uint4*)(P1 + (size_t)(tok0 + s) * PS1 + 1560 + gi * 128 + c8);
      const float mu = st[s * 2], rs = st[s * 2 + 1];
      u16 rv[8] = {(u16)(raw.x & 0xffff), (u16)(raw.x >> 16), (u16)(raw.y & 0xffff), (u16)(raw.y >> 16), (u16)(raw.z & 0xffff), (u16)(raw.z >> 16), (u16)(raw.w & 0xffff), (u16)(raw.w >> 16)};
#pragma unroll
      for (int i = 0; i < 8; ++i) {
        const int c = gi * 128 + c8 + i;
        Vt[(c8 + i) * 136 + s] = f2bf((bf2f(rv[i]) - mu) * rs * lng[c] + lnb[c]);
      }
    }
    __syncthreads();
    f32x4 acc[4][4]; ZERO_ACC(acc, 4)
#pragma unroll 1
    for (int ks = 0; ks < 4; ++ks) {
      bf16x8 a[4], b[4];
#pragma unroll
      for (int m = 0; m < 4; ++m) a[m] = *(const bf16x8*)(Wt + (wr * 64 + m * 16 + fr) * 136 + ks * 32 + fq * 8);
#pragma unroll
      for (int n = 0; n < 4; ++n) b[n] = *(const bf16x8*)(Vt + (wc * 64 + n * 16 + fr) * 136 + ks * 32 + fq * 8);
#pragma unroll
      for (int m = 0; m < 4; ++m)
#pragma unroll
        for (int n = 0; n < 4; ++n) acc[m][n] = mfma16(a[m], b[n], acc[m][n]);
    }
    const float* bs = p.in[20] + ((size_t)(l * 4 + gi)) * 128;
#pragma unroll
    for (int m = 0; m < 4; ++m)
#pragma unroll
      for (int n = 0; n < 4; ++n) {
        const int c = wc * 64 + n * 16 + fr;
#pragma unroll
        for (int j = 0; j < 4; ++j) {
          const int t = wr * 64 + m * 16 + fq * 4 + j;
          u16* up = P1 + (size_t)(tok0 + t) * PS1 + 1048 + gi * 128 + c;
          *up = f2bf(bf2f(*up) * (acc[m][n][j] + bs[t]));
        }
      }
    __syncthreads();
  }
}

__device__ __forceinline__ void phase_prep1(const Params& p, int l) {
  u16* P2 = (u16*)(p.ws + OFF_P2); const u16* PB = (const u16*)(p.ws + OFF_PB); u16* VF = (u16*)(p.ws + OFF_VFIRST);
  const float* mu = p.in[21] + (size_t)l * 1792;
  const int total = 1024 * 224;
  for (int idx = blockIdx.x * 256 + tidx(); idx < total; idx += gridDim.x * 256) {
    const int tile = idx / 224, cg8 = (idx % 224) * 8;
    const int tok0 = tile * 32;
    float m8[8];
#pragma unroll
    for (int e = 0; e < 8; ++e) m8[e] = mu[cg8 + e];
    uint4 prev = make_uint4(0, 0, 0, 0);
    if ((tok0 & 4095) != 0) prev = *(const uint4*)(PB + (size_t)(tile - 1) * 1792 + cg8);
#pragma unroll 1
    for (int r0 = 0; r0 < 32; r0 += 8) {
      uint4 cv[8];
#pragma unroll
      for (int u = 0; u < 8; ++u) cv[u] = *(const uint4*)(P2 + (size_t)(tok0 + r0 + u) * PS2 + cg8);
#pragma unroll
      for (int u = 0; u < 8; ++u) {
        const uint4 cur = cv[u];
        unsigned cu[4] = {cur.x, cur.y, cur.z, cur.w}, pu[4] = {prev.x, prev.y, prev.z, prev.w};
        float o[8];
#pragma unroll
        for (int e = 0; e < 8; ++e) {
          float c = bf2f((u16)((cu[e >> 1] >> ((e & 1) * 16)) & 0xffff));
          float pv = bf2f((u16)((pu[e >> 1] >> ((e & 1) * 16)) & 0xffff));
          float sv = c + (pv - c) * m8[e];
          if (cg8 >= 1536 && cg8 < 1600) sv = tanhf_(sv);
          else if (cg8 >= 1664) sv = sigmoidf_(sv);
          o[e] = sv;
        }
        uint4 ov; ov.x = pack2(o[0], o[1]); ov.y = pack2(o[2], o[3]); ov.z = pack2(o[4], o[5]); ov.w = pack2(o[6], o[7]);
        *(uint4*)(P2 + (size_t)(tok0 + r0 + u) * PS2 + cg8) = ov;
        if (l == 0 && cg8 >= 1024 && cg8 < 1536) *(uint4*)(VF + (size_t)(tok0 + r0 + u) * 512 + cg8 - 1024) = ov;
        prev = cur;
      }
    }
  }
}

__device__ __forceinline__ void phase_prep2(const Params& p, int l, char* smem) {
  u16* P2 = (u16*)(p.ws + OFF_P2); const u16* VF = (const u16*)(p.ws + OFF_VFIRST);
  float* twd = (float*)smem;
  float* adl = twd + 1024;
  float* vsh = adl + 1024;
  float* lv = vsh + 8192;
  const int tid = tidx();
  const float* w0 = p.in[22] + (size_t)l * 512; const float* w2 = p.in[23] + (size_t)l * 64 * 512;
  const float* a0 = p.in[24] + (size_t)l * 512; const float* a2 = p.in[25] + (size_t)l * 64 * 512;
  const float* kkp = p.in[27] + (size_t)l * 512; const float* kap = p.in[28] + (size_t)l * 512;
  for (int item = blockIdx.x; item < 2048; item += gridDim.x) {
    const int tok0 = item * 16;
    for (int e = tid; e < 2048; e += 256) {
      const int r = e >> 7, c = e & 127;
      twd[(c >> 6) * 1024 + r * 64 + (c & 63)] = bf2f(P2[(size_t)(tok0 + r) * PS2 + 1536 + c]);
    }
    if (l > 0) {
      for (int e = tid; e < 8192; e += 256) { const int r = e >> 9, c = e & 511; vsh[e] = bf2f(P2[(size_t)(tok0 + r) * PS2 + 1024 + c]); }
    }
    __syncthreads();
    if (l > 0) {
      const float* v1 = p.in[33];
      for (int e = tid; e < 512; e += 256) {
        const int r = e >> 5, j = e & 31;
        float s = 0.f;
#pragma unroll 2
        for (int c = 0; c < 512; c += 4) {
          const float4 t4 = *(const float4*)(vsh + r * 512 + c);
          s += t4.x * v1[c * 32 + j] + t4.y * v1[(c + 1) * 32 + j] + t4.z * v1[(c + 2) * 32 + j] + t4.w * v1[(c + 3) * 32 + j];
        }
        lv[r * 32 + j] = s;
      }
      __syncthreads();
    }
    {
      float aw[2][16], aa[2][16], am[2][16];
#pragma unroll
      for (int c = 0; c < 2; ++c)
#pragma unroll
        for (int r = 0; r < 16; ++r) { aw[c][r] = 0.f; aa[c][r] = 0.f; am[c][r] = 0.f; }
#pragma unroll 2
      for (int i = 0; i < 64; i += 4) {
        float wv[2][4], av[2][4];
#pragma unroll
        for (int c = 0; c < 2; ++c)
#pragma unroll
          for (int u = 0; u < 4; ++u) { wv[c][u] = w2[(i + u) * 512 + tid + c * 256]; av[c][u] = a2[(i + u) * 512 + tid + c * 256]; }
#pragma unroll
        for (int r = 0; r < 16; ++r) {
          const float4 tw = *(const float4*)(twd + r * 64 + i);
          const float4 ta = *(const float4*)(adl + r * 64 + i);
#pragma unroll
          for (int c = 0; c < 2; ++c) {
            aw[c][r] += tw.x * wv[c][0] + tw.y * wv[c][1] + tw.z * wv[c][2] + tw.w * wv[c][3];
            aa[c][r] += ta.x * av[c][0] + ta.y * av[c][1] + ta.z * av[c][2] + ta.w * av[c][3];
          }
        }
      }
      if (l > 0) {
        const float* v2 = p.in[34];
#pragma unroll 2
        for (int j = 0; j < 32; j += 4) {
          float vv[2][4];
#pragma unroll
          for (int c = 0; c < 2; ++c)
#pragma unroll
            for (int u = 0; u < 4; ++u) vv[c][u] = v2[(j + u) * 512 + tid + c * 256];
#pragma unroll
          for (int r = 0; r < 16; ++r) {
            const float4 t4 = *(const float4*)(lv + r * 32 + j);
#pragma unroll
            for (int c = 0; c < 2; ++c) am[c][r] += t4.x * vv[c][0] + t4.y * vv[c][1] + t4.z * vv[c][2] + t4.w * vv[c][3];
          }
        }
      }
#pragma unroll
      for (int c = 0; c < 2; ++c) {
        const int ch = tid + c * 256;
        const float w0v = w0[ch], a0v = a0[ch], kkv = kkp[ch], kav = kap[ch];
        const float v0v = (l > 0) ? p.in[32][ch] : 0.f;
        float kval[16];
#pragma unroll
        for (int r = 0; r < 16; ++r) kval[r] = bf2f(P2[(size_t)(tok0 + r) * PS2 + 512 + ch]);
#pragma unroll
        for (int r = 0; r < 16; ++r) {
          u16* row = P2 + (size_t)(tok0 + r) * PS2;
          const float wpre = w0v + aw[c][r];
          const float nx = -wpre;
          const float sp = fmaxf(nx, 0.f) + __logf(1.f + __expf(-fabsf(nx)));
          const float w = -sp - 0.5f;
          const float decay = __expf(-__expf(w));
          const float a = sigmoidf_(a0v + aa[c][r]);
          const float kk = kval[r] * kkv;
          const float ss = wave_sum(kk * kk);
          const float kkn = kk / fmaxf(sqrtf(ss), 1e-12f);
          row[1792 + ch] = f2bf(decay);
          row[2304 + ch] = f2bf(kkn);
          row[2816 + ch] = f2bf(kkn * a);
          row[512 + ch] = f2bf(kval[r] * (1.f + (a - 1.f) * kav));
          if (l > 0) {
            const float v = vsh[r * 512 + ch];
            const float vf = bf2f(VF[(size_t)(tok0 + r) * 512 + ch]);
            row[1024 + ch] = f2bf(v + (vf - v) * sigmoidf_(v0v + am[c][r]));
          }
        }
      }
    }
    __syncthreads();
  }
}

__device__ __forceinline__ void unpack4(uint2 u, float (&f)[4]) {
  f[0] = bf2f((u16)(u.x & 0xffff)); f[1] = bf2f((u16)(u.x >> 16)); f[2] = bf2f((u16)(u.y & 0xffff)); f[3] = bf2f((u16)(u.y >> 16));
}
__device__ __forceinline__ float quad_sum(float v) { v += __shfl_xor(v, 16); v += __shfl_xor(v, 32); return v; }

__device__ __forceinline__ void phase_prep2m(const Params& p, int l, char* smem) {
  u16* P2 = (u16*)(p.ws + OFF_P2); const u16* VF = (const u16*)(p.ws + OFF_VFIRST); const u16* WL = (const u16*)(p.ws + OFF_WL);
  u16* twl = (u16*)smem;
  u16* adl = twl + 16 * 72;
  u16* vl = adl + 16 * 72;
  const int tid = tidx(), lane = tid & 63, w = tid >> 6, fr = lane & 15, fq = lane >> 4;
  const float* w0 = p.in[22] + (size_t)l * 512; const float* a0 = p.in[24] + (size_t)l * 512;
  const float* kkp = p.in[27] + (size_t)l * 512; const float* kap = p.in[28] + (size_t)l * 512;
#pragma unroll 1
  for (int item = blockIdx.x; item < 2048; item += gridDim.x) {
    const int tok0 = item * 16;
    {
      const int r = tid >> 4, c = tid & 15;
      const uint4 v = *(const uint4*)(P2 + (size_t)(tok0 + r) * PS2 + 1536 + c * 8);
      if (c < 8) *(uint4*)(twl + r * 72 + c * 8) = v; else *(uint4*)(adl + r * 72 + (c - 8) * 8) = v;
    }
    if (l > 0) {
#pragma unroll
      for (int i = 0; i < 4; ++i) {
        const int idx = tid + 256 * i, r = idx >> 6, c = idx & 63;
        *(uint4*)(vl + r * 520 + c * 8) = *(const uint4*)(P2 + (size_t)(tok0 + r) * PS2 + 1024 + c * 8);
      }
    }
    __syncthreads();
    bf16x8 xw[2], xa[2];
#pragma unroll
    for (int ks = 0; ks < 2; ++ks) { xw[ks] = *(const bf16x8*)(twl + fr * 72 + ks * 32 + fq * 8); xa[ks] = *(const bf16x8*)(adl + fr * 72 + ks * 32 + fq * 8); }
    bf16x8 plv = {0, 0, 0, 0, 0, 0, 0, 0};
    if (l > 0) {
      f32x4 lv0 = {0.f, 0.f, 0.f, 0.f}, lv1 = {0.f, 0.f, 0.f, 0.f};
#pragma unroll 4
      for (int ks = 0; ks < 16; ++ks) {
        const bf16x8 xb = *(const bf16x8*)(vl + fr * 520 + ks * 32 + fq * 8);
        const bf16x8 a0f = *(const bf16x8*)(WL + WL_V1 + (size_t)fr * 512 + ks * 32 + fq * 8);
        const bf16x8 a1f = *(const bf16x8*)(WL + WL_V1 + (size_t)(16 + fr) * 512 + ks * 32 + fq * 8);
        lv0 = mfma16(a0f, xb, lv0); lv1 = mfma16(a1f, xb, lv1);
      }
      uint4 u; u.x = pack2(lv0[0], lv0[1]); u.y = pack2(lv0[2], lv0[3]); u.z = pack2(lv1[0], lv1[1]); u.w = pack2(lv1[2], lv1[3]);
      plv = *(bf16x8*)&u;
    }
    const size_t tok = (size_t)tok0 + fr;
    u16* row = P2 + tok * PS2;
#pragma unroll 1
    for (int hh = 0; hh < 2; ++hh) {
      f32x4 aw[4], aa[4], am[4];
#pragma unroll
      for (int m4 = 0; m4 < 4; ++m4) {
        const int chr = w * 128 + (hh * 4 + m4) * 16 + fr;
        f32x4 cw = {0.f, 0.f, 0.f, 0.f}, ca = {0.f, 0.f, 0.f, 0.f}, cm = {0.f, 0.f, 0.f, 0.f};
#pragma unroll
        for (int ks = 0; ks < 2; ++ks) {
          cw = mfma16(*(const bf16x8*)(WL + WL_W2 + (size_t)chr * 64 + ks * 32 + fq * 8), xw[ks], cw);
          ca = mfma16(*(const bf16x8*)(WL + WL_A2 + (size_t)chr * 64 + ks * 32 + fq * 8), xa[ks], ca);
        }
        if (l > 0) {
          const uint2 g0 = *(const uint2*)(WL + WL_V2 + (size_t)chr * 64 + 4 * fq);
          const uint2 g1 = *(const uint2*)(WL + WL_V2 + (size_t)chr * 64 + 16 + 4 * fq);
          uint4 u; u.x = g0.x; u.y = g0.y; u.z = g1.x; u.w = g1.y;
          cm = mfma16(*(bf16x8*)&u, plv, cm);
        }
        aw[m4] = cw; aa[m4] = ca; am[m4] = cm;
      }
      float kv[4][4], av[4][4], kk[4][4];
      float ss = 0.f;
#pragma unroll
      for (int m4 = 0; m4 < 4; ++m4) {
        const int ch0 = w * 128 + (hh * 4 + m4) * 16 + 4 * fq;
        unpack4(*(const uint2*)(row + 512 + ch0), kv[m4]);
        const float4 a0v = *(const float4*)(a0 + ch0), kkv = *(const float4*)(kkp + ch0);
        const float a0a[4] = {a0v.x, a0v.y, a0v.z, a0v.w}, kka[4] = {kkv.x, kkv.y, kkv.z, kkv.w};
#pragma unroll
        for (int j = 0; j < 4; ++j) {
          av[m4][j] = sigmoidf_(a0a[j] + aa[m4][j]);
          kk[m4][j] = kv[m4][j] * kka[j];
          ss += kk[m4][j] * kk[m4][j];
        }
      }
      ss = quad_sum(ss);
      const float rn = 1.f / fmaxf(sqrtf(ss), 1e-12f);
#pragma unroll
      for (int m4 = 0; m4 < 4; ++m4) {
        const int ch0 = w * 128 + (hh * 4 + m4) * 16 + 4 * fq;
        const float4 w0v = *(const float4*)(w0 + ch0), kav = *(const float4*)(kap + ch0);
        const float w0a[4] = {w0v.x, w0v.y, w0v.z, w0v.w}, kaa[4] = {kav.x, kav.y, kav.z, kav.w};
        float dc[4], kn[4], bb[4], kp[4];
#pragma unroll
        for (int j = 0; j < 4; ++j) {
          const float nx = -(w0a[j] + aw[m4][j]);
          const float sp = fmaxf(nx, 0.f) + __logf(1.f + __expf(-fabsf(nx)));
          dc[j] = __expf(-__expf(-sp - 0.5f));
          kn[j] = kk[m4][j] * rn;
          bb[j] = kn[j] * av[m4][j];
          kp[j] = kv[m4][j] * (1.f + (av[m4][j] - 1.f) * kaa[j]);
        }
        uint2 o;
        o.x = pack2(dc[0], dc[1]); o.y = pack2(dc[2], dc[3]); *(uint2*)(row + 1792 + ch0) = o;
        o.x = pack2(kn[0], kn[1]); o.y = pack2(kn[2], kn[3]); *(uint2*)(row + 2304 + ch0) = o;
        o.x = pack2(bb[0], bb[1]); o.y = pack2(bb[2], bb[3]); *(uint2*)(row + 2816 + ch0) = o;
        o.x = pack2(kp[0], kp[1]); o.y = pack2(kp[2], kp[3]); *(uint2*)(row + 512 + ch0) = o;
        if (l > 0) {
          float vv[4], vf[4];
          unpack4(*(const uint2*)(vl + fr * 520 + ch0), vv);
          unpack4(*(const uint2*)(VF + tok * 512 + ch0), vf);
          const float4 v0v = *(const float4*)(p.in[32] + ch0);
          const float v0a[4] = {v0v.x, v0v.y, v0v.z, v0v.w};
          float vo[4];
#pragma unroll
          for (int j = 0; j < 4; ++j) vo[j] = vv[j] + (vf[j] - vv[j]) * sigmoidf_(v0a[j] + am[m4][j]);
          o.x = pack2(vo[0], vo[1]); o.y = pack2(vo[2], vo[3]); *(uint2*)(row + 1024 + ch0) = o;
        }
      }
    }
    __syncthreads();
  }
}

__device__ __forceinline__ void phase_postm(const Params& p, int l, char* smem) {
  const u16* P2 = (const u16*)(p.ws + OFF_P2); u16* YC = (u16*)(p.ws + OFF_P1) + 1560; const u16* WL = (const u16*)(p.ws + OFF_WL);
  u16* sgl = (u16*)smem;
  const int tid = tidx(), lane = tid & 63, w = tid >> 6, fr = lane & 15, fq = lane >> 4;
  const float* rk = p.in[29] + (size_t)l * 512; const float* lg = p.in[30] + (size_t)l * 512; const float* lb = p.in[31] + (size_t)l * 512;
#pragma unroll 1
  for (int item = blockIdx.x; item < 2048; item += gridDim.x) {
    const int tok0 = item * 16;
    {
      const int r = tid >> 4, c = tid & 15;
      *(uint4*)(sgl + r * 136 + c * 8) = *(const uint4*)(P2 + (size_t)(tok0 + r) * PS2 + 1664 + c * 8);
    }
    __syncthreads();
    bf16x8 xb[4];
#pragma unroll
    for (int ks = 0; ks < 4; ++ks) xb[ks] = *(const bf16x8*)(sgl + fr * 136 + ks * 32 + fq * 8);
    const size_t tok = (size_t)tok0 + fr;
    const u16* row = P2 + tok * PS2;
    u16* yrow = YC + tok * PS1;
#pragma unroll 1
    for (int hh = 0; hh < 2; ++hh) {
      f32x4 ag[4];
#pragma unroll
      for (int m4 = 0; m4 < 4; ++m4) {
        const int chr = w * 128 + (hh * 4 + m4) * 16 + fr;
        f32x4 c = {0.f, 0.f, 0.f, 0.f};
#pragma unroll
        for (int ks = 0; ks < 4; ++ks) c = mfma16(*(const bf16x8*)(WL + WL_G2 + (size_t)chr * 128 + ks * 32 + fq * 8), xb[ks], c);
        ag[m4] = c;
      }
      float yv[4][4], vv[4][4];
      float s1 = 0.f, sb = 0.f;
#pragma unroll
      for (int m4 = 0; m4 < 4; ++m4) {
        const int ch0 = w * 128 + (hh * 4 + m4) * 16 + 4 * fq;
        float rr[4], kk[4];
        unpack4(*(const uint2*)(yrow + ch0), yv[m4]);
        unpack4(*(const uint2*)(row + ch0), rr);
        unpack4(*(const uint2*)(row + 512 + ch0), kk);
        unpack4(*(const uint2*)(row + 1024 + ch0), vv[m4]);
        const float4 rkv = *(const float4*)(rk + ch0);
        s1 += yv[m4][0] + yv[m4][1] + yv[m4][2] + yv[m4][3];
        sb += rr[0] * kk[0] * rkv.x + rr[1] * kk[1] * rkv.y + rr[2] * kk[2] * rkv.z + rr[3] * kk[3] * rkv.w;
      }
      s1 = quad_sum(s1); sb = quad_sum(sb);
      const float mean = s1 * (1.f / 64.f);
      float s2 = 0.f;
#pragma unroll
      for (int m4 = 0; m4 < 4; ++m4)
#pragma unroll
        for (int j = 0; j < 4; ++j) { const float d = yv[m4][j] - mean; s2 += d * d; }
      s2 = quad_sum(s2);
      const float rs = rsqrtf(s2 * (1.f / 64.f) + 64e-5f);
#pragma unroll
      for (int m4 = 0; m4 < 4; ++m4) {
        const int ch0 = w * 128 + (hh * 4 + m4) * 16 + 4 * fq;
        const float4 lgv = *(const float4*)(lg + ch0), lbv = *(const float4*)(lb + ch0);
        const float lga[4] = {lgv.x, lgv.y, lgv.z, lgv.w}, lba[4] = {lbv.x, lbv.y, lbv.z, lbv.w};
        float o4[4];
#pragma unroll
        for (int j = 0; j < 4; ++j) o4[j] = ((yv[m4][j] - mean) * rs * lga[j] + lba[j] + sb * vv[m4][j]) * ag[m4][j];
        uint2 o; o.x = pack2(o4[0], o4[1]); o.y = pack2(o4[2], o4[3]);
        *(uint2*)(yrow + ch0) = o;
      }
    }
    __syncthreads();
  }
}

__device__ __forceinline__ void scan_item(const Params& p, int item, char* smem) {
  const u16* P2 = (const u16*)(p.ws + OFF_P2); u16* YC = (u16*)(p.ws + OFF_P1) + 1560;
  float* vb = (float*)smem;
  float* yb = vb + 2 * 6 * 16 * 64;
  const int tid = tidx(), lane = tid & 63, wid = tid >> 6;
  const int rq = item & 3, h = (item >> 2) & 7, b = item >> 5;
  const int rl = lane >> 4, cq = lane & 15;
  const int rloc = wid * 4 + rl;
  const int ihead = rq * 16 + rloc;
  const int j0 = cq * 4;
  const size_t tokb = (size_t)b * 4096;
  float s0 = 0.f, s1 = 0.f, s2 = 0.f, s3 = 0.f;
  uint4 pre[3];
  auto gload = [&](int c) {
#pragma unroll
    for (int i = 0; i < 3; ++i) {
      const int v = tid + i * 256; const int vec = v >> 7, rem = v & 127, step = rem >> 3, c8 = rem & 7;
      const int off = (vec == 0) ? 0 : (vec == 1) ? 1792 : (vec == 2) ? 512 : (vec == 3) ? 1024 : (vec == 4) ? 2304 : 2816;
      pre[i] = *(const uint4*)(P2 + (tokb + c * 16 + step) * PS2 + off + h * 64 + c8 * 8);
    }
  };
  auto lstore = [&](int buf) {
#pragma unroll
    for (int i = 0; i < 3; ++i) {
      const int v = tid + i * 256; const int vec = v >> 7, rem = v & 127, step = rem >> 3, c8 = rem & 7;
      float* d = vb + ((buf * 6 + vec) * 16 + step) * 64 + c8 * 8;
      float4 f0, f1;
      f0.x = bf2f((u16)(pre[i].x & 0xffff)); f0.y = bf2f((u16)(pre[i].x >> 16)); f0.z = bf2f((u16)(pre[i].y & 0xffff)); f0.w = bf2f((u16)(pre[i].y >> 16));
      f1.x = bf2f((u16)(pre[i].z & 0xffff)); f1.y = bf2f((u16)(pre[i].z >> 16)); f1.z = bf2f((u16)(pre[i].w & 0xffff)); f1.w = bf2f((u16)(pre[i].w >> 16));
      *(float4*)d = f0; *(float4*)(d + 4) = f1;
    }
  };
  gload(0); lstore(0);
  __syncthreads();
  for (int c = 0; c < 256; ++c) {
    const int buf = c & 1;
    if (c + 1 < 256) gload(c + 1);
    const float* base = vb + buf * 6 * 16 * 64;
#define SC_LOAD(X, ST) { r##X = *(const float4*)(base + (0 * 16 + (ST)) * 64 + j0); w##X = *(const float4*)(base + (1 * 16 + (ST)) * 64 + j0); \
      k##X = *(const float4*)(base + (2 * 16 + (ST)) * 64 + j0); v##X = base[(3 * 16 + (ST)) * 64 + ihead]; \
      n##X = *(const float4*)(base + (4 * 16 + (ST)) * 64 + j0); b##X = *(const float4*)(base + (5 * 16 + (ST)) * 64 + j0); }
#define SC_STEP(X, ST) { float sa = s0 * n##X.x + s1 * n##X.y + s2 * n##X.z + s3 * n##X.w; \
      sa = -dpp_sum16(sa); \
      s0 = s0 * w##X.x + sa * b##X.x + v##X * k##X.x; s1 = s1 * w##X.y + sa * b##X.y + v##X * k##X.y; \
      s2 = s2 * w##X.z + sa * b##X.z + v##X * k##X.z; s3 = s3 * w##X.w + sa * b##X.w + v##X * k##X.w; \
      float y = s0 * r##X.x + s1 * r##X.y + s2 * r##X.z + s3 * r##X.w; \
      y = dpp_sum16(y); yb[(ST) * 16 + rloc] = y; }
    {
      float4 rA, wA, kA, nA, bA, rB, wB, kB, nB, bB; float vA, vB;
      SC_LOAD(A, 0)
#pragma unroll
      for (int st = 0; st < 16; st += 2) {
        SC_LOAD(B, st + 1)
        SC_STEP(A, st)
        if (st + 2 < 16) SC_LOAD(A, st + 2)
        SC_STEP(B, st + 1)
      }
    }
#undef SC_LOAD
#undef SC_STEP
    __syncthreads();
    {
      const int st = tid >> 4, r = tid & 15;
      YC[(tokb + c * 16 + st) * PS1 + h * 64 + rq * 16 + r] = f2bf(yb[st * 16 + r]);
    }
    if (c + 1 < 256) lstore(buf ^ 1);
    __syncthreads();
  }
}

__device__ __forceinline__ void phase_post(const Params& p, int l, char* smem) {
  const u16* P2 = (const u16*)(p.ws + OFF_P2); u16* YC = (u16*)(p.ws + OFF_P1) + 1560;
  float* sg = (float*)smem;
  const int tid = tidx();
  const float* g2 = p.in[26] + (size_t)l * 128 * 512;
  const float* rk = p.in[29] + (size_t)l * 512; const float* lg = p.in[30] + (size_t)l * 512; const float* lb = p.in[31] + (size_t)l * 512;
  for (int item = blockIdx.x; item < 2048; item += gridDim.x) {
    const int tok0 = item * 16;
    for (int e = tid; e < 2048; e += 256) { const int r = e >> 7, c = e & 127; sg[e] = bf2f(P2[(size_t)(tok0 + r) * PS2 + 1664 + c]); }
    __syncthreads();
    {
      float ag[2][16];
#pragma unroll
      for (int c = 0; c < 2; ++c)
#pragma unroll
        for (int r = 0; r < 16; ++r) ag[c][r] = 0.f;
#pragma unroll 4
      for (int i = 0; i < 128; i += 4) {
        float gv[2][4];
#pragma unroll
        for (int c = 0; c < 2; ++c)
#pragma unroll
          for (int u = 0; u < 4; ++u) gv[c][u] = g2[(i + u) * 512 + tid + c * 256];
#pragma unroll
        for (int r = 0; r < 16; ++r) {
          const float4 t4 = *(const float4*)(sg + r * 128 + i);
#pragma unroll
          for (int c = 0; c < 2; ++c) ag[c][r] += t4.x * gv[c][0] + t4.y * gv[c][1] + t4.z * gv[c][2] + t4.w * gv[c][3];
        }
      }
#pragma unroll
      for (int c = 0; c < 2; ++c) {
        const int ch = tid + c * 256;
        const float rkv = rk[ch], lgv = lg[ch], lbv = lb[ch];
        float yv[16], rr[16], kk[16], vv[16];
#pragma unroll
        for (int r = 0; r < 16; ++r) {
          const u16* row = P2 + (size_t)(tok0 + r) * PS2;
          yv[r] = bf2f(YC[(size_t)(tok0 + r) * PS1 + ch]);
          rr[r] = bf2f(row[ch]); kk[r] = bf2f(row[512 + ch]); vv[r] = bf2f(row[1024 + ch]);
        }
#pragma unroll
        for (int r = 0; r < 16; ++r) {
          const float mean = wave_sum(yv[r]) * (1.f / 64.f);
          const float dv = yv[r] - mean;
          const float var = wave_sum(dv * dv) * (1.f / 64.f);
          const float yn = dv * rsqrtf(var + 64e-5f) * lgv + lbv;
          const float bon = wave_sum(rr[r] * kk[r] * rkv) * vv[r];
          YC[(size_t)(tok0 + r) * PS1 + ch] = f2bf((yn + bon) * ag[c][r]);
        }
      }
    }
    __syncthreads();
  }
}

#define NEGV (-1e30f)
struct AttnState { float m[2]; float ls[2]; f32x4 ot[4][2]; };

#define MINIT (-1e20f)
template <int MODE, bool FULL>
__device__ __forceinline__ void attn_scores(f32x4 (&st)[4][2], const u16* kbase, int kstride, int key0, const bf16x8 (&qf)[2][2],
                                            const float (&slope)[2], int t, bool selbit, int c16, int q4) {
  const float fb = (float)(key0 + q4 * 4 - t);
#pragma unroll
  for (int mk = 0; mk < 4; ++mk) {
    const u16* kp = kbase + (size_t)(mk * 16 + c16) * kstride + q4 * 8;
    const bf16x8 k0 = *(const bf16x8*)kp, k1 = *(const bf16x8*)(kp + 32);
#pragma unroll
    for (int nq = 0; nq < 2; ++nq) {
      f32x4 a = {0.f, 0.f, 0.f, 0.f};
      a = mfma16(k0, qf[nq][0], a);
      a = mfma16(k1, qf[nq][1], a);
      if (FULL) {
        const float c0 = slope[nq] * fb;
#pragma unroll
        for (int j = 0; j < 4; ++j) {
          const float v = a[j] + (c0 + slope[nq] * (float)(mk * 16 + j));
          a[j] = (MODE == 1) ? (selbit ? v : NEGV) : v;
        }
      } else {
#pragma unroll
        for (int j = 0; j < 4; ++j) {
          const int key = key0 + mk * 16 + q4 * 4 + j;
          int dist; bool valid;
          if (MODE == 0) { dist = t - (16 * key + 31); valid = dist >= 0; }
          else if (MODE == 1) { dist = t - key; valid = (dist >= 0) && selbit; }
          else { dist = t - key; valid = (dist >= 0) && (dist < 512); }
          a[j] = valid ? (a[j] - slope[nq] * (float)dist) : NEGV;
        }
      }
      st[mk][nq] = a;
    }
  }
}

template <int MODE, bool FULL>
__device__ __forceinline__ void attn_tile(AttnState& S, const u16* kbase, int kstride, const u16* vtbase, int vstride, int key0,
                                          const bf16x8 (&qf)[2][2], const float (&slope)[2], int t, bool selbit, int c16, int q4) {
  f32x4 st[4][2];
  attn_scores<MODE, FULL>(st, kbase, kstride, key0, qf, slope, t, selbit, c16, q4);
  __builtin_amdgcn_sched_barrier(0);
#pragma unroll
  for (int nq = 0; nq < 2; ++nq) {
    float mx = fmaxf(fmaxf(st[0][nq][0], st[0][nq][1]), fmaxf(st[0][nq][2], st[0][nq][3]));
#pragma unroll
    for (int mk = 1; mk < 4; ++mk) mx = fmaxf(mx, fmaxf(fmaxf(st[mk][nq][0], st[mk][nq][1]), fmaxf(st[mk][nq][2], st[mk][nq][3])));
    mx = fmaxf(mx, __shfl_xor(mx, 16)); mx = fmaxf(mx, __shfl_xor(mx, 32));
    const float mnew = fmaxf(S.m[nq], mx);
    const float alpha = __builtin_amdgcn_exp2f(S.m[nq] - mnew);
    S.m[nq] = mnew;
    float ls = S.ls[nq] * alpha;
#pragma unroll
    for (int md = 0; md < 4; ++md) { S.ot[md][nq][0] *= alpha; S.ot[md][nq][1] *= alpha; S.ot[md][nq][2] *= alpha; S.ot[md][nq][3] *= alpha; }
#pragma unroll
    for (int mk = 0; mk < 4; ++mk)
#pragma unroll
      for (int j = 0; j < 4; ++j) {
        const float pv = __builtin_amdgcn_exp2f(st[mk][nq][j] - mnew);
        st[mk][nq][j] = pv; ls += pv;
      }
    S.ls[nq] = ls;
  }
#pragma unroll
  for (int s2 = 0; s2 < 2; ++s2) {
    __builtin_amdgcn_sched_barrier(0);
    bf16x8 pb[2];
#pragma unroll
    for (int nq = 0; nq < 2; ++nq) {
      uint4 u;
      u.x = pack2(st[2 * s2][nq][0], st[2 * s2][nq][1]); u.y = pack2(st[2 * s2][nq][2], st[2 * s2][nq][3]);
      u.z = pack2(st[2 * s2 + 1][nq][0], st[2 * s2 + 1][nq][1]); u.w = pack2(st[2 * s2 + 1][nq][2], st[2 * s2 + 1][nq][3]);
      pb[nq] = *(bf16x8*)&u;
    }
#pragma unroll
    for (int md = 0; md < 4; ++md) {
      const bf16x8 vf = *(const bf16x8*)(vtbase + (size_t)(md * 16 + c16) * vstride + s2 * 32 + q4 * 8);
#pragma unroll
      for (int nq = 0; nq < 2; ++nq) S.ot[md][nq] = mfma16(vf, pb[nq], S.ot[md][nq]);
    }
  }
}

__device__ __forceinline__ void attn_reset(AttnState& S) {
#pragma unroll
  for (int nq = 0; nq < 2; ++nq) { S.m[nq] = MINIT; S.ls[nq] = 0.f;
#pragma unroll
    for (int md = 0; md < 4; ++md) S.ot[md][nq] = f32x4{0.f, 0.f, 0.f, 0.f}; }
}
__device__ __forceinline__ void attn_fold(AttnState& S, float* oacc, const u16* gp, int br, float (&invl)[2], int lane) {
#pragma unroll
  for (int nq = 0; nq < 2; ++nq) {
    float l = S.ls[nq];
    l += __shfl_xor(l, 16); l += __shfl_xor(l, 32);
    const float inv = (l > 0.f) ? 1.f / l : 0.f;
    invl[nq] = inv;
    const float f = bf2f(gp[nq * 6 + br]) * inv;
#pragma unroll
    for (int md = 0; md < 4; ++md)
#pragma unroll
      for (int j = 0; j < 4; ++j) {
        float* a = oacc + ((md * 2 + nq) * 4 + j) * 64 + lane;
        const float v = f * S.ot[md][nq][j];
        if (br == 0) *a = v; else *a += v;
      }
  }
}

__device__ __forceinline__ void phase_nsa(const Params& p, char* smem, unsigned* queue) {
  u16* P1 = (u16*)(p.ws + OFF_P1);
  const u16* KC = (const u16*)(p.ws + OFF_KC); const u16* VC = (const u16*)(p.ws + OFF_VC); const u16* VT = (const u16*)(p.ws + OFF_VT);
  const int tid = tidx(), lane = tid & 63, wid = tid >> 6;
  const int c16 = lane & 15, q4 = lane >> 4, tq = lane & 7;
  float* ps = (float*)smem + wid * 2048;
  float* oacc = (float*)(smem + 32768) + wid * 2048;
  int* qslot = (int*)(smem + 65536);
#pragma unroll 1
  for (;;) {
    if (tid == 0) *qslot = (int)atomicAdd(queue, 1u);
    __syncthreads();
    const int it = *qslot;
    if (it >= 2048) break;
    const int bg = it & 15;
    const int tqd = 127 - (it >> 4);
    const int b = bg >> 1, g = bg & 1;
    const int t0 = (tqd * 4 + wid) * 8;
    const int tok0 = b * 4096 + t0;
    const int t = t0 + tq;
    const int cur = t0 >> 6;
#pragma unroll
    for (int i = 0; i < 8; ++i) *(float4*)(ps + i * 256 + lane * 4) = float4{0.f, 0.f, 0.f, 0.f};
    bf16x8 qf[2][2]; float slope[2];
    const u16* gp = P1 + (size_t)(tok0 + tq) * PS1 + 1024 + (g * 4 + (c16 >> 3)) * 3;
#pragma unroll
    for (int nq = 0; nq < 2; ++nq) {
      const int hh = nq * 2 + (c16 >> 3);
      const u16* rp = P1 + (size_t)(tok0 + tq) * PS1;
      qf[nq][0] = *(const bf16x8*)(rp + (g * 4 + hh) * 64 + q4 * 8);
      qf[nq][1] = *(const bf16x8*)(rp + (g * 4 + hh) * 64 + 32 + q4 * 8);
      slope[nq] = exp2f(-(float)(g * 4 + hh + 1)) * 1.4426950408889634f;
    }
    AttnState S;
    float invl[2];
    const u16* kcb = KC + (size_t)(b * 2 + g) * 256 * 64;
    const u16* vcb = VC + (size_t)(b * 2 + g) * 64 * 256;
    int ntc = 0;
    if (t0 + 7 >= 31) ntc = (((t0 + 7 - 31) >> 4) >> 6) + 1;
    attn_reset(S);
#pragma unroll 1
    for (int kt = 0; kt < ntc; ++kt) attn_tile<0, false>(S, kcb + (size_t)kt * 64 * 64, 64, vcb + kt * 64, 256, kt * 64, qf, slope, t, true, c16, q4);
    attn_fold(S, oacc, gp, 0, invl, lane);
#pragma unroll 1
    for (int kt = 0; kt < ntc; ++kt) {
      f32x4 st[4][2];
      attn_scores<0, false>(st, kcb + (size_t)kt * 64 * 64, 64, kt * 64, qf, slope, t, true, c16, q4);
#pragma unroll
      for (int mk = 0; mk < 4; ++mk) {
        f32x4 hs;
#pragma unroll
        for (int j = 0; j < 4; ++j) {
          const float a0 = st[mk][0][j], a1 = st[mk][1][j];
          const float p0 = __builtin_amdgcn_exp2f(a0 - S.m[0]) * invl[0];
          const float p1 = __builtin_amdgcn_exp2f(a1 - S.m[1]) * invl[1];
          float v = p0 + p1;
          v += __shfl_xor(v, 8);
          hs[j] = v;
        }
        if (c16 < 8) *(f32x4*)(ps + c16 * 256 + kt * 64 + mk * 16 + q4 * 4) = hs;
      }
    }
    __syncthreads();
    unsigned long long selm = 0ull, un = 0ull;
#pragma unroll 1
    for (int tqq = 0; tqq < 8; ++tqq) {
      const float* pr = ps + tqq * 256;
      float imp = pr[4 * lane];
      if (lane > 0) imp += pr[4 * lane - 4] + 2.f * (pr[4 * lane - 3] + pr[4 * lane - 2] + pr[4 * lane - 1]);
      const bool forced = (lane == 0) || (lane == cur) || (lane == cur - 1);
      const bool live = lane <= cur;
      const float val = forced ? 1e4f : (live ? imp : NEGV);
      int rank = 0;
#pragma unroll 8
      for (int i = 0; i < 64; ++i) {
        const float vi = __uint_as_float(__builtin_amdgcn_readlane(__float_as_uint(val), i));
        rank += ((vi > val) || (vi == val && i < lane)) ? 1 : 0;
      }
      const unsigned long long bal = __ballot((rank < 16) && live);
      if (tq == tqq) selm = bal;
      un |= bal;
    }
    __syncthreads();
    attn_reset(S);
    {
      const u16* vtb = VT + (size_t)((0 * 8 + b) * 2 + g) * 64 * 4096;
#pragma unroll 1
      for (int j = 0; j <= cur; ++j) {
        if (!((un >> j) & 1ull)) continue;
        const bool sb = (selm >> j) & 1ull;
        const u16* kb_ = P1 + (size_t)(b * 4096 + j * 64) * PS1 + 768 + g * 64;
        if (j < cur) attn_tile<1, true>(S, kb_, PS1, vtb + j * 64, 4096, j * 64, qf, slope, t, sb, c16, q4);
        else attn_tile<1, false>(S, kb_, PS1, vtb + j * 64, 4096, j * 64, qf, slope, t, sb, c16, q4);
      }
    }
    attn_fold(S, oacc, gp, 1, invl, lane);
    attn_reset(S);
    {
      const u16* vtb = VT + (size_t)((1 * 8 + b) * 2 + g) * 64 * 4096;
      int j0 = t0 - 511; if (j0 < 0) j0 = 0; j0 >>= 6;
#pragma unroll 1
      for (int j = j0; j <= cur; ++j) {
        const u16* kb_ = P1 + (size_t)(b * 4096 + j * 64) * PS1 + 896 + g * 64;
        const bool full = (j < cur) && (j * 64 >= t0 + 7 - 511);
        if (full) attn_tile<2, true>(S, kb_, PS1, vtb + j * 64, 4096, j * 64, qf, slope, t, true, c16, q4);
        else attn_tile<2, false>(S, kb_, PS1, vtb + j * 64, 4096, j * 64, qf, slope, t, true, c16, q4);
      }
    }
    attn_fold(S, oacc, gp, 2, invl, lane);
#pragma unroll
    for (int nq = 0; nq < 2; ++nq) {
      const int hh = nq * 2 + (c16 >> 3);
      u16* rp = P1 + (size_t)(tok0 + tq) * PS1 + (g * 4 + hh) * 64;
#pragma unroll
      for (int md = 0; md < 4; ++md) {
        const float* a = oacc + ((md * 2 + nq) * 4) * 64 + lane;
        uint2 o; o.x = pack2(a[0], a[64]); o.y = pack2(a[128], a[192]);
        *(uint2*)(rp + md * 16 + q4 * 4) = o;
      }
    }
  }
}

__device__ __forceinline__ const float* modp(const Params& p, int l, int sub, int kind) {
  return (const float*)(p.ws + OFF_MOD) + (size_t)l * 8 * 9216 + sub * 3072 + kind * 1024;
}

__device__ __forceinline__ void run_phase(const Params& p, int ph, char* smem) {
  char* ws = p.ws;
  if (ph == 0) {
    if (blockIdx.x == 0) { unsigned* c = (unsigned*)(ws + OFF_CNT); for (int e = tidx(); e < 1024; e += 256) c[e] = 0u; }
    phase_mod(p, smem);
  }
  int l = 0, s = -1;
  if (ph >= 2) { l = (ph - 2) / 14; s = (ph - 2) % 14; }
  const float* preg = p.in[4] + (size_t)l * 3 * 1024; const float* postg = p.in[5] + (size_t)l * 3 * 1024;
  const bool is_norm = (ph == 1) || s == 2 || s == 10 || s == 13;
  if (is_norm) {
    const float* xin = p.out; float* xout = p.out; const u16* y = nullptr; const float* pg = nullptr; const float* gate = nullptr; float wgt = 0.f;
    const float* prg = nullptr; const float* sh = nullptr; const float* sc = nullptr; u16* h = (u16*)(ws + OFF_H);
    if (ph == 1) { xin = p.in[0]; prg = p.in[4]; sh = modp(p, 0, 0, 0); sc = modp(p, 0, 0, 1); }
    else if (s == 2) { y = (const u16*)(ws + OFF_YF); pg = postg; gate = modp(p, l, 0, 2); wgt = 0.5f; prg = preg + 1024; sh = modp(p, l, 1, 0); sc = modp(p, l, 1, 1); }
    else if (s == 10) { y = (const u16*)(ws + OFF_YM); pg = postg + 1024; gate = modp(p, l, 1, 2); wgt = 1.0f; prg = preg + 2048; sh = modp(p, l, 2, 0); sc = modp(p, l, 2, 1); }
    else { y = (const u16*)(ws + OFF_YF); pg = postg + 2048; gate = modp(p, l, 2, 2); wgt = 0.5f;
      if (l == 0) { prg = p.in[4] + 3 * 1024; sh = modp(p, 1, 0, 0); sc = modp(p, 1, 0, 1); } else { h = nullptr; } }
    phase_norm(xin, xout, y, pg, gate, wgt, prg, sh, sc, h);
  }
  {
    int cl = -1, cf = 0;
    if (ph == 0) { cl = 0; cf = 0; } else if (s == 2) { cl = l; cf = 1; } else if (s == 13 && l == 0) { cl = 1; cf = 0; }
    if (cl >= 0) conv_ffn(p, cl, cf, smem);
    if (cl >= 0 && cf == 0) conv_mix(p, cl, smem);
  }
  if (s == 0 || s == 11) phase_ffn_in(p, smem);
  if (s == 1 || s == 12 || s == 9) {
    const bool o = (s == 9);
    phase_gemm_plain((const u16*)(ws + (o ? OFF_MERGED : OFF_ACT)), o ? 1024 : DFF, (const u16*)(ws + (o ? OFF_WO : OFF_WOUT)), o ? 1024 : DFF,
                     (u16*)(ws + (o ? OFF_YM : OFF_YF)), smem);
  }
  if (s == 3) phase_inproj(p, smem);
  if (s == 4) { phase_prep1(p, l); phase_sgu(p, l, smem); phase_cmp1(p, l, smem); }
  if (s == 5) { phase_prep2m(p, l, smem); phase_cmp2(p, l); }
  if (s == 6) {
    const int nb = gridDim.x;
    const int sid = (nb >= 512) ? (((int)blockIdx.x & 1) ? -1 : ((int)blockIdx.x >> 1)) : (int)blockIdx.x;
    const int sstride = (nb >= 512) ? (nb >> 1) : nb;
    if (sid >= 0) {
      __builtin_amdgcn_s_setprio(3);
      for (int it = sid; it < 256; it += sstride) scan_item(p, it, smem);
      __builtin_amdgcn_s_setprio(0);
    }
    phase_nsa(p, smem, (unsigned*)(ws + OFF_CNT) + 64 + l * 64);
  }
  if (s == 7) phase_postm(p, l, smem);
  if (s == 8) phase_merge(p, smem);
}

constexpr int NPHASE = 30;

#if COOP
typedef const float* __attribute__((address_space(4))) const* kargp_t;
template <int PH>
__device__ __forceinline__ void run_seq(char* smem, cg::grid_group& grid) {
  if constexpr (PH < NPHASE) {
    {
      kargp_t ka = (kargp_t)__builtin_amdgcn_kernarg_segment_ptr();
      asm volatile("" : "+s"(ka));
      Params q;
#pragma unroll
      for (int i = 0; i < 35; ++i) q.in[i] = ka[i];
      q.out = (float*)ka[35];
      q.ws = (char*)ka[36];
      run_phase(q, PH, smem);
    }
    if constexpr (PH == 0) grid.sync();
    else if constexpr (PH + 1 < NPHASE) {
      kargp_t kb = (kargp_t)__builtin_amdgcn_kernarg_segment_ptr();
      asm volatile("" : "+s"(kb));
      gbar((unsigned*)((char*)kb[36] + OFF_CNT), (unsigned)PH * gridDim.x);
    }
    run_seq<PH + 1>(smem, grid);
  }
}

__global__ void __launch_bounds__(256, 2) mega(Params p) {
  __shared__ __attribute__((aligned(16))) char smem[SMEM_BYTES];
  cg::grid_group grid = cg::this_grid();
  run_seq<0>(smem, grid);
}
#endif

template <int PH>
__global__ void __launch_bounds__(256, 2) kph(Params p) {
  __shared__ __attribute__((aligned(16))) char smem[SMEM_BYTES];
  run_phase(p, PH, smem);
}

template <int PH>
static void launch_seq(const Params& p, int grid, hipStream_t stream) {
  if constexpr (PH < NPHASE) {
    kph<PH><<<grid, 256, 0, stream>>>(p);
    launch_seq<PH + 1>(p, grid, stream);
  }
}

extern "C" void kernel_launch(void* const* d_in, const int* in_sizes, int n_in, void* d_out, int out_size, void* d_ws, size_t ws_size,
                              hipStream_t stream) {
  static int grid_blocks = 0;
  if (!grid_blocks) {
    int dev = 0, cus = 0, per_cu = 0;
    hipGetDevice(&dev);
    hipDeviceGetAttribute(&cus, hipDeviceAttributeMultiprocessorCount, dev);
    #if COOP
    hipOccupancyMaxActiveBlocksPerMultiprocessor(&per_cu, mega, 256, 0);
#else
    per_cu = 2;
#endif
    if (per_cu > 2) per_cu = 2;
    if (per_cu < 1) per_cu = 1;
    grid_blocks = cus * per_cu;
  }
  Params p{};
  for (int i = 0; i < 35; ++i) p.in[i] = (const float*)d_in[i];
  p.out = (float*)d_out;
  p.ws = (char*)d_ws;
#if COOP
  void* args[] = {&p};
  hipError_t e = hipLaunchCooperativeKernel((void*)mega, dim3(grid_blocks), dim3(256), args, 0, stream);
  if (e != hipSuccess) fprintf(stderr, "cooperative launch failed: %s (grid %d)\n", hipGetErrorString(e), grid_blocks);
#else
  launch_seq<0>(p, grid_blocks, stream);
#endif
}
```

```cpp
#include <hip/hip_runtime.h>
#include <hip/hip_cooperative_groups.h>
#include <cstdio>
#include <cstdint>
namespace cg = cooperative_groups;

#ifndef COOP
#define COOP 1
#endif

typedef unsigned short u16;
using bf16x8 = __attribute__((ext_vector_type(8))) short;
using f32x4 = __attribute__((ext_vector_type(4))) float;

constexpr int T = 32768, D = 1024, SEQ = 4096, DFF = 2816;
constexpr int PS1 = 2072, PS2 = 3328;
constexpr int MIXC = 7192, MIXN = 4120;
constexpr size_t OFF_P1 = 0;
constexpr size_t OFF_P2 = OFF_P1 + (size_t)T * PS1 * 2;
constexpr size_t OFF_H = OFF_P2 + (size_t)T * PS2 * 2;
constexpr size_t OFF_WMIX = OFF_H + (size_t)T * 1024 * 2;
constexpr size_t OFF_WG = OFF_WMIX + (size_t)4224 * 1024 * 2;
constexpr size_t OFF_WB = OFF_WG + (size_t)3072 * 1024 * 2;
constexpr size_t OFF_WO = OFF_WB + (size_t)3 * 1024 * 512 * 2;
constexpr size_t OFF_W1 = OFF_WO + (size_t)1024 * 1024 * 2;
constexpr size_t OFF_WIN = OFF_W1 + (size_t)2 * 256 * 2048 * 2;
constexpr size_t OFF_WOUT = OFF_WIN + (size_t)5632 * 1024 * 2;
constexpr size_t OFF_VFIRST = OFF_WOUT + (size_t)1024 * 2816 * 2;
constexpr size_t OFF_VT = OFF_VFIRST + (size_t)T * 512 * 2;
constexpr size_t OFF_MOD = OFF_VT + (size_t)2 * 8 * 2 * 64 * 4096 * 2;
constexpr size_t OFF_PB = OFF_MOD + (size_t)2 * 8 * 9216 * 4;
constexpr size_t OFF_HID = OFF_PB + (size_t)1024 * 1792 * 2;
constexpr size_t OFF_KC = OFF_HID + (size_t)2 * 4096 * 256 * 2;
constexpr size_t OFF_VC = OFF_KC + (size_t)8 * 2 * 256 * 64 * 2;
constexpr size_t OFF_LV = OFF_VC + (size_t)8 * 2 * 64 * 256 * 2;
constexpr size_t OFF_CNT = OFF_LV + (size_t)T * 32 * 4;
constexpr size_t OFF_WL = OFF_CNT + 4096;
constexpr int WL_W2 = 0, WL_A2 = 512 * 64, WL_G2 = 2 * 512 * 64, WL_V1 = WL_G2 + 512 * 128, WL_V2 = WL_V1 + 64 * 512, WL_END = WL_V2 + 512 * 64;
constexpr size_t WS_END = OFF_WL + (size_t)WL_END * 2;
constexpr size_t OFF_ACT = OFF_P1;
constexpr size_t OFF_YF = OFF_ACT + (size_t)T * DFF * 2;
constexpr size_t OFF_H2 = OFF_P2;
constexpr size_t OFF_MERGED = OFF_P2;
constexpr size_t OFF_YM = OFF_MERGED + (size_t)T * 1024 * 2;
constexpr size_t OFF_YC = OFF_H;

constexpr int SMEM_BYTES = 73728;

struct Params { const float* in[35]; float* out; char* ws; };

__device__ __forceinline__ int tidx() { int t = __builtin_amdgcn_workitem_id_x(); asm volatile("" : "+v"(t)); return t; }
__device__ __forceinline__ void gbar(unsigned* cnt, unsigned target) {
  asm volatile("s_waitcnt vmcnt(0) lgkmcnt(0)" ::: "memory");
  __syncthreads();
  if (tidx() == 0) {
    __builtin_amdgcn_fence(__ATOMIC_RELEASE, "agent");
    asm volatile("s_waitcnt vmcnt(0)" ::: "memory");
    __hip_atomic_fetch_add(cnt, 1u, __ATOMIC_RELAXED, __HIP_MEMORY_SCOPE_AGENT);
    while (__hip_atomic_load(cnt, __ATOMIC_RELAXED, __HIP_MEMORY_SCOPE_AGENT) < target) __builtin_amdgcn_s_sleep(1);
    __builtin_amdgcn_fence(__ATOMIC_ACQUIRE, "agent");
    asm volatile("s_waitcnt vmcnt(0)" ::: "memory");
  }
  __syncthreads();
}
__device__ __forceinline__ float dpp_sum16(float v) {
  v += __int_as_float(__builtin_amdgcn_update_dpp(0, __float_as_int(v), 0xB1, 0xF, 0xF, true));
  v += __int_as_float(__builtin_amdgcn_update_dpp(0, __float_as_int(v), 0x4E, 0xF, 0xF, true));
  v += __int_as_float(__builtin_amdgcn_update_dpp(0, __float_as_int(v), 0x141, 0xF, 0xF, true));
  v += __int_as_float(__builtin_amdgcn_update_dpp(0, __float_as_int(v), 0x140, 0xF, 0xF, true));
  return v;
}
__device__ __forceinline__ float bf2f(u16 u) { return __uint_as_float(((unsigned)u) << 16); }
__device__ __forceinline__ u16 f2bf(float f) { __bf16 r = (__bf16)f; return *(u16*)&r; }
typedef __attribute__((ext_vector_type(2))) float f2_t;
typedef __attribute__((ext_vector_type(2))) __bf16 b2_t;
__device__ __forceinline__ unsigned pack2(float a, float b) { f2_t v = {a, b}; b2_t r = __builtin_convertvector(v, b2_t); return *(unsigned*)&r; }
__device__ __forceinline__ float sigmoidf_(float x) { return 1.f / (1.f + __expf(-x)); }
__device__ __forceinline__ float siluf_(float x) { return x / (1.f + __expf(-x)); }
__device__ __forceinline__ float geluf_(float x) { float u = 0.7978845608028654f * (x + 0.044715f * x * x * x); return x / (1.f + __expf(-2.f * u)); }
__device__ __forceinline__ float tanhf_(float x) { return 1.f - 2.f / (1.f + __expf(2.f * x)); }
__device__ __forceinline__ float wave_sum(float v) {
#pragma unroll
  for (int o = 32; o >= 1; o >>= 1) v += __shfl_xor(v, o);
  return v;
}
__device__ __forceinline__ f32x4 mfma16(bf16x8 a, bf16x8 b, f32x4 c) { return __builtin_amdgcn_mfma_f32_16x16x32_bf16(a, b, c, 0, 0, 0); }

__device__ __forceinline__ void conv_w(const float* src, int ld, int K, u16* dst, int NR, int nvalid, int coff, int kind, char* smem, int kvalid = 1 << 30) {
  float* tl = (float*)smem;
  const int tid = tidx();
  const int ktn = K >> 6, ntile = (NR >> 6) * ktn;
  for (int tix = blockIdx.x; tix < ntile; tix += gridDim.x) {
    const int R0 = (tix / ktn) << 6, k0 = (tix % ktn) << 6;
    const int c = tid & 63, kq = tid >> 6;
    const int R = R0 + c;
    int sc; bool ok;
    if (kind == 0) { sc = coff + R; ok = R < nvalid; }
    else { int ntl = R >> 7, w = (R >> 6) & 1, n = (R >> 4) & 3, r = R & 15; sc = ((n >= 2) ? DFF : 0) + ntl * 64 + w * 32 + (n & 1) * 16 + r; ok = true; }
#pragma unroll 4
    for (int i = 0; i < 16; ++i) {
      int k = k0 + kq * 16 + i;
      tl[c * 65 + kq * 16 + i] = (ok && k < kvalid) ? src[(size_t)k * ld + sc] : 0.f;
    }
    __syncthreads();
    {
      const int r = tid >> 2, ks = tid & 3;
      const float* s = tl + r * 65 + ks * 16;
      uint4 o0, o1;
      o0.x = pack2(s[0], s[1]); o0.y = pack2(s[2], s[3]); o0.z = pack2(s[4], s[5]); o0.w = pack2(s[6], s[7]);
      o1.x = pack2(s[8], s[9]); o1.y = pack2(s[10], s[11]); o1.z = pack2(s[12], s[13]); o1.w = pack2(s[14], s[15]);
      uint4* dp = (uint4*)(dst + (size_t)(R0 + r) * K + k0 + ks * 16);
      dp[0] = o0; dp[1] = o1;
    }
    __syncthreads();
  }
}

__device__ __forceinline__ void conv_ffn(const Params& p, int l, int f, char* smem) {
  conv_w(p.in[6] + (size_t)(l * 2 + f) * D * (2 * DFF), 2 * DFF, D, (u16*)(p.ws + OFF_WIN), 5632, 5632, 0, 1, smem);
  conv_w(p.in[7] + (size_t)(l * 2 + f) * DFF * D, D, DFF, (u16*)(p.ws + OFF_WOUT), 1024, 1024, 0, 0, smem);
}
__device__ __forceinline__ void conv_mix(const Params& p, int l, char* smem) {
  const float* mw = p.in[8] + (size_t)l * D * MIXC;
  conv_w(mw, MIXC, D, (u16*)(p.ws + OFF_WMIX), 4224, MIXN, 0, 0, smem);
  conv_w(mw, MIXC, D, (u16*)(p.ws + OFF_WG), 3072, 3072, MIXN, 0, smem);
  for (int i = 0; i < 3; ++i)
    conv_w(p.in[9] + (size_t)(l * 3 + i) * 512 * D, D, 512, (u16*)(p.ws + OFF_WB) + (size_t)i * 1024 * 512, 1024, 1024, 0, 0, smem);
  conv_w(p.in[10] + (size_t)l * D * D, D, D, (u16*)(p.ws + OFF_WO), 1024, 1024, 0, 0, smem);
  conv_w(p.in[11] + (size_t)l * 2048 * 256, 256, 2048, (u16*)(p.ws + OFF_W1), 256, 256, 0, 0, smem);
  conv_w(p.in[14] + (size_t)l * 2048 * 256, 256, 2048, (u16*)(p.ws + OFF_W1) + (size_t)256 * 2048, 256, 256, 0, 0, smem);
  u16* WL = (u16*)(p.ws + OFF_WL);
  conv_w(p.in[23] + (size_t)l * 64 * 512, 512, 64, WL + WL_W2, 512, 512, 0, 0, smem);
  conv_w(p.in[25] + (size_t)l * 64 * 512, 512, 64, WL + WL_A2, 512, 512, 0, 0, smem);
  conv_w(p.in[26] + (size_t)l * 128 * 512, 512, 128, WL + WL_G2, 512, 512, 0, 0, smem);
  if (l > 0) {
    conv_w(p.in[33], 32, 512, WL + WL_V1, 64, 32, 0, 0, smem);
    conv_w(p.in[34], 512, 64, WL + WL_V2, 512, 512, 0, 0, smem, 32);
  }
}

__device__ __forceinline__ void phase_mod(const Params& p, char* smem) {
  float* cond = (float*)smem;
  float* red = cond + 8192;
  const int tid = tidx();
  float* MOD = (float*)(p.ws + OFF_MOD);
  for (int item = blockIdx.x; item < 288; item += gridDim.x) {
    for (int e = tid; e < 8192; e += 256) cond[e] = siluf_(p.in[1][e]);
    __syncthreads();
    const int l = item / 144, n0 = (item % 144) * 64, col = n0 + (tid & 63), kq = tid >> 6;
    float acc[8];
#pragma unroll
    for (int b = 0; b < 8; ++b) acc[b] = 0.f;
    const float* w = p.in[2] + (size_t)l * D * 9216 + col;
#pragma unroll 4
    for (int k = kq * 256; k < kq * 256 + 256; ++k) {
      float wv = w[(size_t)k * 9216];
#pragma unroll
      for (int b = 0; b < 8; ++b) acc[b] += cond[b * 1024 + k] * wv;
    }
#pragma unroll
    for (int b = 0; b < 8; ++b) red[(kq * 8 + b) * 64 + (tid & 63)] = acc[b];
    __syncthreads();
    for (int e = tid; e < 512; e += 256) {
      int b = e >> 6, c = e & 63;
      float s = red[(0 * 8 + b) * 64 + c] + red[(1 * 8 + b) * 64 + c] + red[(2 * 8 + b) * 64 + c] + red[(3 * 8 + b) * 64 + c];
      MOD[(size_t)(l * 8 + b) * 9216 + n0 + c] = s + p.in[3][(size_t)l * 9216 + n0 + c];
    }
    __syncthreads();
  }
}

__device__ __forceinline__ void phase_norm(const float* xin, float* xout, const u16* y, const float* postg, const float* gate, float wgt,
                           const float* preg, const float* shift, const float* scale, u16* h) {
  const int lane = tidx() & 63, wid = tidx() >> 6;
  for (int row = blockIdx.x * 4 + wid; row < T; row += gridDim.x * 4) {
    const int b = row >> 12;
    float4 xv[4];
#pragma unroll
    for (int i = 0; i < 4; ++i) xv[i] = *(const float4*)(xin + (size_t)row * D + i * 256 + lane * 4);
    if (y) {
      float yv[4][4]; float ss = 0.f;
#pragma unroll
      for (int i = 0; i < 4; ++i) {
        uint2 u = *(const uint2*)(y + (size_t)row * D + i * 256 + lane * 4);
        yv[i][0] = bf2f((u16)(u.x & 0xffff)); yv[i][1] = bf2f((u16)(u.x >> 16));
        yv[i][2] = bf2f((u16)(u.y & 0xffff)); yv[i][3] = bf2f((u16)(u.y >> 16));
        ss += yv[i][0] * yv[i][0] + yv[i][1] * yv[i][1] + yv[i][2] * yv[i][2] + yv[i][3] * yv[i][3];
      }
      ss = wave_sum(ss);
      const float rs = rsqrtf(ss * (1.f / 1024.f) + 1e-6f) * wgt;
#pragma unroll
      for (int i = 0; i < 4; ++i) {
        const int c = i * 256 + lane * 4;
        float4 g = *(const float4*)(gate + (size_t)b * 9216 + c);
        float4 pg = *(const float4*)(postg + c);
        xv[i].x += g.x * yv[i][0] * rs * pg.x; xv[i].y += g.y * yv[i][1] * rs * pg.y;
        xv[i].z += g.z * yv[i][2] * rs * pg.z; xv[i].w += g.w * yv[i][3] * rs * pg.w;
      }
    }
    if (xout) {
#pragma unroll
      for (int i = 0; i < 4; ++i) *(float4*)(xout + (size_t)row * D + i * 256 + lane * 4) = xv[i];
    }
    if (h) {
      float ss = 0.f;
#pragma unroll
      for (int i = 0; i < 4; ++i) ss += xv[i].x * xv[i].x + xv[i].y * xv[i].y + xv[i].z * xv[i].z + xv[i].w * xv[i].w;
      ss = wave_sum(ss);
      const float rs = rsqrtf(ss * (1.f / 1024.f) + 1e-6f);
#pragma unroll
      for (int i = 0; i < 4; ++i) {
        const int c = i * 256 + lane * 4;
        float4 pg = *(const float4*)(preg + c);
        float4 sh = *(const float4*)(shift + (size_t)b * 9216 + c);
        float4 sc = *(const float4*)(scale + (size_t)b * 9216 + c);
        uint2 o;
        o.x = pack2(xv[i].x * rs * pg.x * (1.f + sc.x) + sh.x, xv[i].y * rs * pg.y * (1.f + sc.y) + sh.y);
        o.y = pack2(xv[i].z * rs * pg.z * (1.f + sc.z) + sh.z, xv[i].w * rs * pg.w * (1.f + sc.w) + sh.w);
        *(uint2*)(h + (size_t)row * D + c) = o;
      }
    }
  }
}

template <int NS, class FA, class FB>
__device__ __forceinline__ void gemm_loop(f32x4 (&acc)[4][NS], const FA& fa, const FB& fb, int K, u16* sm) {
  constexpr int BN = 32 * NS;
  constexpr int NBV = BN / 32;
  const int tid = tidx(), lane = tid & 63, wid = tid >> 6, wr = wid >> 1, wc = wid & 1, fr = lane & 15, fq = lane >> 4;
  u16* As = sm; u16* Bs = sm + 2 * 128 * 64;
  uint4 ra0[4], rb0[NBV], ra1[4], rb1[NBV];
  const int nt = K >> 6;
  const int lrow = tid >> 3, lk = (tid & 7) * 8;
  const int lsw = lrow * 64 + (((tid & 7) ^ ((lrow >> 1) & 7)) << 3);
  const int c0 = (fq ^ ((fr >> 1) & 7)) << 3, c1 = c0 ^ 32;
#define G_LOAD(RA, RB, KT) { const int kb_ = (KT) << 6; \
    _Pragma("unroll") for (int i = 0; i < 4; ++i) RA[i] = fa(lrow + 32 * i, kb_ + lk); \
    _Pragma("unroll") for (int i = 0; i < NBV; ++i) RB[i] = fb(lrow + 32 * i, kb_ + lk); }
#define G_STORE(RA, RB, BUF) { u16* Aw_ = As + (BUF) * 128 * 64 + lsw; u16* Bw_ = Bs + (BUF) * BN * 64 + lsw; \
    _Pragma("unroll") for (int i = 0; i < 4; ++i) *(uint4*)(Aw_ + i * 32 * 64) = RA[i]; \
    _Pragma("unroll") for (int i = 0; i < NBV; ++i) *(uint4*)(Bw_ + i * 32 * 64) = RB[i]; }
#define G_COMPUTE(BUF) { const u16* Ab = As + (BUF) * 128 * 64 + (wr * 64 + fr) * 64; \
    const u16* Bb = Bs + (BUF) * BN * 64 + (wc * 16 * NS + fr) * 64; \
    _Pragma("unroll") for (int ks = 0; ks < 2; ++ks) { bf16x8 a[4], b[NS]; const int co = ks ? c1 : c0; \
      _Pragma("unroll") for (int m = 0; m < 4; ++m) a[m] = *(const bf16x8*)(Ab + m * 16 * 64 + co); \
      _Pragma("unroll") for (int n = 0; n < NS; ++n) b[n] = *(const bf16x8*)(Bb + n * 16 * 64 + co); \
      __builtin_amdgcn_s_setprio(1); \
      _Pragma("unroll") for (int m = 0; m < 4; ++m) _Pragma("unroll") for (int n = 0; n < NS; ++n) acc[m][n] = mfma16(a[m], b[n], acc[m][n]); \
      __builtin_amdgcn_s_setprio(0); } }
  G_LOAD(ra0, rb0, 0)
  if (nt > 1) G_LOAD(ra1, rb1, 1)
  G_STORE(ra0, rb0, 0)
  __syncthreads();
#pragma unroll 1
  for (int kt = 0; kt < nt; kt += 2) {
    if (kt + 2 < nt) G_LOAD(ra0, rb0, kt + 2)
    G_COMPUTE(0)
    if (kt + 1 < nt) G_STORE(ra1, rb1, 1)
    __syncthreads();
    if (kt + 1 >= nt) break;
    if (kt + 3 < nt) G_LOAD(ra1, rb1, kt + 3)
    G_COMPUTE(1)
    if (kt + 2 < nt) G_STORE(ra0, rb0, 0)
    __syncthreads();
  }
#undef G_LOAD
#undef G_STORE
#undef G_COMPUTE
}

template <int NS>
__device__ __forceinline__ void gemm_loop_dma(f32x4 (&acc)[4][NS], const u16* Ab, int lda, const u16* Bb, int ldb, int K, u16* sm) {
  constexpr int BN = 32 * NS;
  constexpr int NBV = BN / 32;
  const int tid = tidx(), lane = tid & 63, wid = tid >> 6, wr = wid >> 1, wc = wid & 1, fr = lane & 15, fq = lane >> 4;
  u16* As = sm; u16* Bs = sm + 2 * 128 * 64;
  const int nt = K >> 6;
  const int lrow = tid >> 3;
  const int gk = (((tid & 7) ^ ((lrow >> 1) & 7)) << 3);
  const int c0 = (fq ^ ((fr >> 1) & 7)) << 3, c1 = c0 ^ 32;
  const u16* ga = Ab + (size_t)lrow * lda + gk;
  const u16* gb = Bb + (size_t)lrow * ldb + gk;
#define D_ISSUE(KT, BUF) { const int kb_ = (KT) << 6; \
    _Pragma("unroll") for (int i = 0; i < 4; ++i) \
      __builtin_amdgcn_global_load_lds((const unsigned*)(ga + (size_t)(32 * i) * lda + kb_), (unsigned*)(As + (BUF) * 128 * 64 + (tid + 256 * i) * 8), 16, 0, 0); \
    _Pragma("unroll") for (int i = 0; i < NBV; ++i) \
      __builtin_amdgcn_global_load_lds((const unsigned*)(gb + (size_t)(32 * i) * ldb + kb_), (unsigned*)(Bs + (BUF) * BN * 64 + (tid + 256 * i) * 8), 16, 0, 0); }
#define D_COMPUTE(BUF) { const u16* Ap = As + (BUF) * 128 * 64 + (wr * 64 + fr) * 64; \
    const u16* Bp = Bs + (BUF) * BN * 64 + (wc * 16 * NS + fr) * 64; \
    _Pragma("unroll") for (int ks = 0; ks < 2; ++ks) { bf16x8 a[4], b[NS]; const int co = ks ? c1 : c0; \
      _Pragma("unroll") for (int m = 0; m < 4; ++m) a[m] = *(const bf16x8*)(Ap + m * 16 * 64 + co); \
      _Pragma("unroll") for (int n = 0; n < NS; ++n) b[n] = *(const bf16x8*)(Bp + n * 16 * 64 + co); \
      __builtin_amdgcn_s_setprio(1); \
      _Pragma("unroll") for (int m = 0; m < 4; ++m) _Pragma("unroll") for (int n = 0; n < NS; ++n) acc[m][n] = mfma16(a[m], b[n], acc[m][n]); \
      __builtin_amdgcn_s_setprio(0); } }
  D_ISSUE(0, 0)
#pragma unroll 1
  for (int kt = 0; kt < nt; kt += 2) {
    __syncthreads();
    if (kt + 1 < nt) D_ISSUE(kt + 1, 1)
    D_COMPUTE(0)
    if (kt + 1 >= nt) break;
    __syncthreads();
    if (kt + 2 < nt) D_ISSUE(kt + 2, 0)
    D_COMPUTE(1)
  }
  __syncthreads();
#undef D_ISSUE
#undef D_COMPUTE
}

__device__ __forceinline__ bool tile_map(int it, int NT, int& mt, int& nt) {
  const int g = gridDim.x;
  if ((g & 7) == 0) {
    const int xcd = blockIdx.x & 7, bx = blockIdx.x >> 3, nbx = g >> 3;
    const int lid = bx + it * nbx;
    if (lid >= 32 * NT) return false;
    const int grp = lid / (8 * NT), rem = lid - grp * 8 * NT;
    nt = rem >> 3; mt = xcd * 32 + grp * 8 + (rem & 7);
    return true;
  } else {
    const int id = blockIdx.x + it * g;
    if (id >= 256 * NT) return false;
    nt = id % NT; mt = id / NT;
    return true;
  }
}

#define ZERO_ACC(acc, NSV) _Pragma("unroll") for (int m_ = 0; m_ < 4; ++m_) _Pragma("unroll") for (int n_ = 0; n_ < NSV; ++n_) acc[m_][n_] = f32x4{0.f, 0.f, 0.f, 0.f};

__device__ __forceinline__ void phase_ffn_in(const Params& p, char* smem) {
  const u16* H = (const u16*)(p.ws + OFF_H); const u16* W = (const u16*)(p.ws + OFF_WIN); u16* ACT = (u16*)(p.ws + OFF_ACT);
  const int lane = tidx() & 63, wid = tidx() >> 6, wr = wid >> 1, wc = wid & 1, fr = lane & 15, fq = lane >> 4;
  int mt, nt;
  for (int it = 0; tile_map(it, 44, mt, nt); ++it) {
    const int m0 = mt * 128, n0 = nt * 128;
    f32x4 acc[4][4]; ZERO_ACC(acc, 4)
    gemm_loop_dma<4>(acc, H + (size_t)m0 * 1024, 1024, W + (size_t)n0 * 1024, 1024, 1024, (u16*)smem);
#pragma unroll
    for (int m = 0; m < 4; ++m)
#pragma unroll
      for (int n = 0; n < 2; ++n) {
        const int col = nt * 64 + wc * 32 + n * 16 + fr;
        const int r0 = m0 + wr * 64 + m * 16 + fq * 4;
#pragma unroll
        for (int j = 0; j < 4; ++j) ACT[(size_t)(r0 + j) * DFF + col] = f2bf(siluf_(acc[m][n][j]) * acc[m][n + 2][j]);
      }
  }
}

__device__ __forceinline__ void phase_gemm_plain(const u16* A, int lda, const u16* Bt, int K, u16* C, char* smem) {
  const int lane = tidx() & 63, wid = tidx() >> 6, wr = wid >> 1, wc = wid & 1, fr = lane & 15, fq = lane >> 4;
  int mt, nt;
  for (int it = 0; tile_map(it, 8, mt, nt); ++it) {
    const int m0 = mt * 128, n0 = nt * 128;
    f32x4 acc[4][4]; ZERO_ACC(acc, 4)
    gemm_loop_dma<4>(acc, A + (size_t)m0 * lda, lda, Bt + (size_t)n0 * K, K, K, (u16*)smem);
#pragma unroll
    for (int m = 0; m < 4; ++m)
#pragma unroll
      for (int n = 0; n < 4; ++n) {
        const int col = n0 + wc * 64 + n * 16 + fr;
        const int r0 = m0 + wr * 64 + m * 16 + fq * 4;
#pragma unroll
        for (int j = 0; j < 4; ++j) C[(size_t)(r0 + j) * 1024 + col] = f2bf(acc[m][n][j]);
      }
  }
}

__device__ __forceinline__ void phase_inproj(const Params& p, char* smem) {
  const u16* H = (const u16*)(p.ws + OFF_H); const u16* W = (const u16*)(p.ws + OFF_WMIX);
  u16* P1 = (u16*)(p.ws + OFF_P1); u16* P2 = (u16*)(p.ws + OFF_P2); u16* VT = (u16*)(p.ws + OFF_VT); u16* PB = (u16*)(p.ws + OFF_PB);
  const int lane = tidx() & 63, wid = tidx() >> 6, wr = wid >> 1, wc = wid & 1, fr = lane & 15, fq = lane >> 4;
  int mt, nt;
  for (int it = 0; tile_map(it, 33, mt, nt); ++it) {
    const int m0 = mt * 128, n0 = nt * 128;
    f32x4 acc[4][4]; ZERO_ACC(acc, 4)
    gemm_loop_dma<4>(acc, H + (size_t)m0 * 1024, 1024, W + (size_t)n0 * 1024, 1024, 1024, (u16*)smem);
#pragma unroll
    for (int m = 0; m < 4; ++m)
#pragma unroll
      for (int nn = 0; nn < 4; ++nn) {
        const int n = n0 + wc * 64 + nn * 16 + fr;
        if (n >= MIXN) continue;
        const int r0 = m0 + wr * 64 + m * 16 + fq * 4;
        f32x4 v = acc[m][nn];
        if ((n >= 896 && n < 1024) || (n >= 1152 && n < 1280)) {
          const int which = (n >= 1152) ? 1 : 0;
          const int gd = n - (which ? 1152 : 896);
          const int b = r0 >> 12, t = r0 & 4095;
          uint2 o; o.x = pack2(v[0], v[1]); o.y = pack2(v[2], v[3]);
          *(uint2*)(VT + ((size_t)((which * 8 + b) * 128 + gd)) * 4096 + (t & ~31) + 8 * fq + 4 * (m & 1)) = o;
        } else if (n < 1304) {
          const int pc = (n < 896) ? n : ((n < 1152) ? n - 128 : n - 256);
          if (n < 512) { const float qs = 0.125f * 1.4426950408889634f; v[0] *= qs; v[1] *= qs; v[2] *= qs; v[3] *= qs; }
          if (n >= 1280) { v[0] = sigmoidf_(v[0]); v[1] = sigmoidf_(v[1]); v[2] = sigmoidf_(v[2]); v[3] = sigmoidf_(v[3]); }
#pragma unroll
          for (int j = 0; j < 4; ++j) P1[(size_t)(r0 + j) * PS1 + pc] = f2bf(v[j]);
        } else if (n < 2328) {
#pragma unroll
          for (int j = 0; j < 4; ++j) P1[(size_t)(r0 + j) * PS1 + (n - 256)] = f2bf(geluf_(v[j]));
        } else {
          const int pc = n - 2328;
#pragma unroll
          for (int j = 0; j < 4; ++j) P2[(size_t)(r0 + j) * PS2 + pc] = f2bf(v[j]);
          if ((m & 1) && fq == 3) PB[(size_t)((r0 + 3) >> 5) * 1792 + pc] = f2bf(v[3]);
        }
      }
  }
}

__device__ __forceinline__ void phase_merge(const Params& p, char* smem) {
  const u16* H2 = (const u16*)(p.ws + OFF_H); const u16* WG = (const u16*)(p.ws + OFF_WG); const u16* WB = (const u16*)(p.ws + OFF_WB);
  const u16* P1 = (const u16*)(p.ws + OFF_P1); u16* MG = (u16*)(p.ws + OFF_MERGED);
  const int lane = tidx() & 63, wid = tidx() >> 6, wr = wid >> 1, wc = wid & 1, fr = lane & 15, fq = lane >> 4;
  int mt, nt;
  for (int it = 0; tile_map(it, 16, mt, nt); ++it) {
    const int m0 = mt * 128, n0 = nt * 64;
    f32x4 tot[4][2]; ZERO_ACC(tot, 2)
#pragma unroll 1
    for (int i = 0; i < 3; ++i) {
      unsigned gpk[4][2][2];
      {
        f32x4 ag[4][2]; ZERO_ACC(ag, 2)
        gemm_loop_dma<2>(ag, H2 + (size_t)m0 * 1024, 1024, WG + (size_t)(i * 1024 + n0) * 1024, 1024, 1024, (u16*)smem);
#pragma unroll
        for (int m = 0; m < 4; ++m)
#pragma unroll
          for (int n = 0; n < 2; ++n) {
            gpk[m][n][0] = pack2(sigmoidf_(ag[m][n][0]), sigmoidf_(ag[m][n][1]));
            gpk[m][n][1] = pack2(sigmoidf_(ag[m][n][2]), sigmoidf_(ag[m][n][3]));
          }
      }
      f32x4 ay[4][2]; ZERO_ACC(ay, 2)
      const u16* ya = (i == 0) ? P1 : ((i == 1) ? P1 + 1048 : P1 + 1560);
      const int lda = PS1;
      const u16* wb = WB + (size_t)i * 1024 * 512;
      gemm_loop_dma<2>(ay, ya + (size_t)m0 * lda, lda, wb + (size_t)n0 * 512, 512, 512, (u16*)smem);
#pragma unroll
      for (int m = 0; m < 4; ++m)
#pragma unroll
        for (int n = 0; n < 2; ++n) {
          tot[m][n][0] += bf2f((u16)(gpk[m][n][0] & 0xffff)) * ay[m][n][0];
          tot[m][n][1] += bf2f((u16)(gpk[m][n][0] >> 16)) * ay[m][n][1];
          tot[m][n][2] += bf2f((u16)(gpk[m][n][1] & 0xffff)) * ay[m][n][2];
          tot[m][n][3] += bf2f((u16)(gpk[m][n][1] >> 16)) * ay[m][n][3];
        }
    }
#pragma unroll
    for (int m = 0; m < 4; ++m)
#pragma unroll
      for (int n = 0; n < 2; ++n) {
        const int col = n0 + wc * 32 + n * 16 + fr;
        const int r0 = m0 + wr * 64 + m * 16 + fq * 4;
#pragma unroll
        for (int j = 0; j < 4; ++j) MG[(size_t)(r0 + j) * 1024 + col] = f2bf(tot[m][n][j]);
      }
  }
}

__device__ __forceinline__ void phase_cmp1(const Params& p, int l, char* smem) {
  const u16* P1 = (const u16*)(p.ws + OFF_P1); const u16* W1 = (const u16*)(p.ws + OFF_W1); u16* HID = (u16*)(p.ws + OFF_HID);
  const int lane = tidx() & 63, wid = tidx() >> 6, wr = wid >> 1, wc = wid & 1, fr = lane & 15, fq = lane >> 4;
  for (int tix = blockIdx.x; tix < 128; tix += gridDim.x) {
    const int which = tix >> 6, mt = (tix >> 1) & 31, nt = tix & 1;
    const int m0 = mt * 128, n0 = nt * 128;
    const float* pe = (which ? p.in[16] : p.in[13]) + (size_t)l * 2048;
    const u16* w1 = W1 + (size_t)which * 256 * 2048;
    const int cbase = 512 + which * 128;
    f32x4 acc[4][4]; ZERO_ACC(acc, 4)
    auto fa = [&](int r, int k) {
      const int row = m0 + r; const int g = row & 1, n = (row >> 1) & 255, b = row >> 9;
      uint4 o = make_uint4(0, 0, 0, 0);
      if (n < 255) {
        const int lpos = k >> 6, d = k & 63;
        uint4 raw = *(const uint4*)(P1 + (size_t)(b * 4096 + 16 * n + lpos) * PS1 + cbase + g * 64 + d);
        const float* pp = pe + lpos * 64 + d;
        float4 e0 = *(const float4*)pp, e1 = *(const float4*)(pp + 4);
        o.x = pack2(bf2f((u16)(raw.x & 0xffff)) + e0.x, bf2f((u16)(raw.x >> 16)) + e0.y);
        o.y = pack2(bf2f((u16)(raw.y & 0xffff)) + e0.z, bf2f((u16)(raw.y >> 16)) + e0.w);
        o.z = pack2(bf2f((u16)(raw.z & 0xffff)) + e1.x, bf2f((u16)(raw.z >> 16)) + e1.y);
        o.w = pack2(bf2f((u16)(raw.w & 0xffff)) + e1.z, bf2f((u16)(raw.w >> 16)) + e1.w);
      }
      return o;
    };
    auto fb = [&](int r, int k) { return *(const uint4*)(w1 + (size_t)(n0 + r) * 2048 + k); };
    gemm_loop<4>(acc, fa, fb, 2048, (u16*)smem);
#pragma unroll
    for (int m = 0; m < 4; ++m)
#pragma unroll
      for (int n = 0; n < 4; ++n) {
        const int col = n0 + wc * 64 + n * 16 + fr;
        const int r0 = m0 + wr * 64 + m * 16 + fq * 4;
#pragma unroll
        for (int j = 0; j < 4; ++j) HID[((size_t)which * 4096 + r0 + j) * 256 + col] = f2bf(siluf_(acc[m][n][j]));
      }
  }
}

__device__ __forceinline__ void phase_cmp2(const Params& p, int l) {
  const u16* HID = (const u16*)(p.ws + OFF_HID); u16* KC = (u16*)(p.ws + OFF_KC); u16* VC = (u16*)(p.ws + OFF_VC);
  const int total = 2 * 4096 * 64;
  for (int idx = blockIdx.x * 256 + tidx(); idx < total; idx += gridDim.x * 256) {
    const int d = idx & 63, row = (idx >> 6) & 4095, which = idx >> 18;
    const float* w2 = (which ? p.in[15] : p.in[12]) + (size_t)l * 256 * 64;
    const u16* hr = HID + ((size_t)which * 4096 + row) * 256;
    float acc = 0.f;
#pragma unroll 8
    for (int j = 0; j < 256; ++j) acc += bf2f(hr[j]) * w2[j * 64 + d];
    const int g = row & 1, n = (row >> 1) & 255, b = row >> 9;
    if (which == 0) KC[((size_t)(b * 2 + g) * 256 + n) * 64 + d] = f2bf(acc);
    else {
      const int u = n & 31; const int pp = 8 * ((u >> 2) & 3) + 4 * (u >> 4) + (u & 3);
      VC[((size_t)(b * 2 + g) * 64 + d) * 256 + (n & ~31) + pp] = f2bf(acc);
    }
  }
}

__device__ __forceinline__ void phase_sgu(const Params& p, int l, char* smem) {
  u16* P1 = (u16*)(p.ws + OFF_P1);
  u16* Wt = (u16*)smem;
  u16* Vt = Wt + 128 * 136;
  float* st = (float*)(Vt + 128 * 136);
  const int tid = tidx(), lane = tid & 63, wid = tid >> 6, wr = wid >> 1, wc = wid & 1, fr = lane & 15, fq = lane >> 4;
  const float* lng = p.in[17] + (size_t)l * 512; const float* lnb = p.in[18] + (size_t)l * 512;
  for (int item = blockIdx.x; item < 1024; item += gridDim.x) {
    const int ci = item >> 2, gi = item & 3;
    const int tok0 = ci * 128;
#pragma unroll 1
    for (int r0 = wid * 32; r0 < wid * 32 + 32; r0 += 8) {
      uint4 raw[8];
#pragma unroll
      for (int u = 0; u < 8; ++u) raw[u] = *(const uint4*)(P1 + (size_t)(tok0 + r0 + u) * PS1 + 1560 + lane * 8);
#pragma unroll
      for (int u = 0; u < 8; ++u) {
        float f[8];
        f[0] = bf2f((u16)(raw[u].x & 0xffff)); f[1] = bf2f((u16)(raw[u].x >> 16)); f[2] = bf2f((u16)(raw[u].y & 0xffff)); f[3] = bf2f((u16)(raw[u].y >> 16));
        f[4] = bf2f((u16)(raw[u].z & 0xffff)); f[5] = bf2f((u16)(raw[u].z >> 16)); f[6] = bf2f((u16)(raw[u].w & 0xffff)); f[7] = bf2f((u16)(raw[u].w >> 16));
        float s = 0.f, s2 = 0.f;
#pragma unroll
        for (int e = 0; e < 8; ++e) { s += f[e]; }
        s = wave_sum(s);
        const float mu = s * (1.f / 512.f);
#pragma unroll
        for (int e = 0; e < 8; ++e) { float dlt = f[e] - mu; s2 += dlt * dlt; }
        s2 = wave_sum(s2);
        if (lane == 0) { st[(r0 + u) * 2] = mu; st[(r0 + u) * 2 + 1] = rsqrtf(s2 * (1.f / 512.f) + 1e-5f); }
      }
    }
    const float* wsrc = p.in[19] + ((size_t)(l * 4 + gi)) * 128 * 128;
    for (int e = tid; e < 128 * 32; e += 256) {
      const int t = e >> 5, s4 = (e & 31) * 4;
      float4 w = *(const float4*)(wsrc + t * 128 + s4);
      uint2 o;
      o.x = pack2(s4 + 0 <= t ? w.x : 0.f, s4 + 1 <= t ? w.y : 0.f);
      o.y = pack2(s4 + 2 <= t ? w.z : 0.f, s4 + 3 <= t ? w.w : 0.f);
      *(uint2*)(Wt + t * 136 + s4) = o;
    }
    __syncthreads();
    for (int e = tid; e < 128 * 16; e += 256) {
      const int s = e >> 4, c8 = (e & 15) * 8;
      uint4 raw = *(const uint4*)(P1 + (size_t)(tok0 + s) * PS1 + 1560 + gi * 128 + c8);
      const float mu = st[s * 2], rs = st[s * 2 + 1];
      u16 rv[8] = {(u16)(raw.x & 0xffff), (u16)(raw.x >> 16), (u16)(raw.y & 0xffff), (u16)(raw.y >> 16), (u16)(raw.z & 0xffff), (u16)(raw.z >> 16), (u16)(raw.w & 0xffff), (u16)(raw.w >> 16)};
#pragma unroll
      for (int i = 0; i < 8; ++i) {
        const int c = gi * 128 + c8 + i;
        Vt[(c8 + i) * 136 + s] = f2bf((bf2f(rv[i]) - mu) * rs * lng[c] + lnb[c]);
      }
    }
    __syncthreads();
    f32x4 acc[4][4]; ZERO_ACC(acc, 4)
#pragma unroll 1
    for (int ks = 0; ks < 4; ++ks) {
      bf16x8 a[4], b[4];
#pragma unroll
      for (int m = 0; m < 4; ++m) a[m] = *(const bf16x8*)(Wt + (wr * 64 + m * 16 + fr) * 136 + ks * 32 + fq * 8);
#pragma unroll
      for (int n = 0; n < 4; ++n) b[n] = *(const bf16x8*)(Vt + (wc * 64 + n * 16 + fr) * 136 + ks * 32 + fq * 8);
#pragma unroll
      for (int m = 0; m < 4; ++m)
#pragma unroll
        for (int n = 0; n < 4; ++n) acc[m][n] = mfma16(a[m], b[n], acc[m][n]);
    }
    const float* bs = p.in[20] + ((size_t)(l * 4 + gi)) * 128;
#pragma unroll
    for (int m = 0; m < 4; ++m)
#pragma unroll
      for (int n = 0; n < 4; ++n) {
        const int c = wc * 64 + n * 16 + fr;
#pragma unroll
        for (int j = 0; j < 4; ++j) {
          const int t = wr * 64 + m * 16 + fq * 4 + j;
          u16* up = P1 + (size_t)(tok0 + t) * PS1 + 1048 + gi * 128 + c;
          *up = f2bf(bf2f(*up) * (acc[m][n][j] + bs[t]));
        }
      }
    __syncthreads();
  }
}

__device__ __forceinline__ void phase_prep1(const Params& p, int l) {
  u16* P2 = (u16*)(p.ws + OFF_P2); const u16* PB = (const u16*)(p.ws + OFF_PB); u16* VF = (u16*)(p.ws + OFF_VFIRST);
  const float* mu = p.in[21] + (size_t)l * 1792;
  const int total = 1024 * 224;
  for (int idx = blockIdx.x * 256 + tidx(); idx < total; idx += gridDim.x * 256) {
    const int tile = idx / 224, cg8 = (idx % 224) * 8;
    const int tok0 = tile * 32;
    float m8[8];
#pragma unroll
    for (int e = 0; e < 8; ++e) m8[e] = mu[cg8 + e];
    uint4 prev = make_uint4(0, 0, 0, 0);
    if ((tok0 & 4095) != 0) prev = *(const uint4*)(PB + (size_t)(tile - 1) * 1792 + cg8);
#pragma unroll 1
    for (int r0 = 0; r0 < 32; r0 += 8) {
      uint4 cv[8];
#pragma unroll
      for (int u = 0; u < 8; ++u) cv[u] = *(const uint4*)(P2 + (size_t)(tok0 + r0 + u) * PS2 + cg8);
#pragma unroll
      for (int u = 0; u < 8; ++u) {
        const uint4 cur = cv[u];
        unsigned cu[4] = {cur.x, cur.y, cur.z, cur.w}, pu[4] = {prev.x, prev.y, prev.z, prev.w};
        float o[8];
#pragma unroll
        for (int e = 0; e < 8; ++e) {
          float c = bf2f((u16)((cu[e >> 1] >> ((e & 1) * 16)) & 0xffff));
          float pv = bf2f((u16)((pu[e >> 1] >> ((e & 1) * 16)) & 0xffff));
          float sv = c + (pv - c) * m8[e];
          if (cg8 >= 1536 && cg8 < 1600) sv = tanhf_(sv);
          else if (cg8 >= 1664) sv = sigmoidf_(sv);
          o[e] = sv;
        }
        uint4 ov; ov.x = pack2(o[0], o[1]); ov.y = pack2(o[2], o[3]); ov.z = pack2(o[4], o[5]); ov.w = pack2(o[6], o[7]);
        *(uint4*)(P2 + (size_t)(tok0 + r0 + u) * PS2 + cg8) = ov;
        if (l == 0 && cg8 >= 1024 && cg8 < 1536) *(uint4*)(VF + (size_t)(tok0 + r0 + u) * 512 + cg8 - 1024) = ov;
        prev = cur;
      }
    }
  }
}

__device__ __forceinline__ void phase_prep2(const Params& p, int l, char* smem) {
  u16* P2 = (u16*)(p.ws + OFF_P2); const u16* VF = (const u16*)(p.ws + OFF_VFIRST);
  float* twd = (float*)smem;
  float* adl = twd + 1024;
  float* vsh = adl + 1024;
  float* lv = vsh + 8192;
  const int tid = tidx();
  const float* w0 = p.in[22] + (size_t)l * 512; const float* w2 = p.in[23] + (size_t)l * 64 * 512;
  const float* a0 = p.in[24] + (size_t)l * 512; const float* a2 = p.in[25] + (size_t)l * 64 * 512;
  const float* kkp = p.in[27] + (size_t)l * 512; const float* kap = p.in[28] + (size_t)l * 512;
  for (int item = blockIdx.x; item < 2048; item += gridDim.x) {
    const int tok0 = item * 16;
    for (int e = tid; e < 2048; e += 256) {
      const int r = e >> 7, c = e & 127;
      twd[(c >> 6) * 1024 + r * 64 + (c & 63)] = bf2f(P2[(size_t)(tok0 + r) * PS2 + 1536 + c]);
    }
    if (l > 0) {
      for (int e = tid; e < 8192; e += 256) { const int r = e >> 9, c = e & 511; vsh[e] = bf2f(P2[(size_t)(tok0 + r) * PS2 + 1024 + c]); }
    }
    __syncthreads();
    if (l > 0) {
      const float* v1 = p.in[33];
      for (int e = tid; e < 512; e += 256) {
        const int r = e >> 5, j = e & 31;
        float s = 0.f;
#pragma unroll 2
        for (int c = 0; c < 512; c += 4) {
          const float4 t4 = *(const float4*)(vsh + r * 512 + c);
          s += t4.x * v1[c * 32 + j] + t4.y * v1[(c + 1) * 32 + j] + t4.z * v1[(c + 2) * 32 + j] + t4.w * v1[(c + 3) * 32 + j];
        }
        lv[r * 32 + j] = s;
      }
      __syncthreads();
    }
    {
      float aw[2][16], aa[2][16], am[2][16];
#pragma unroll
      for (int c = 0; c < 2; ++c)
#pragma unroll
        for (int r = 0; r < 16; ++r) { aw[c][r] = 0.f; aa[c][r] = 0.f; am[c][r] = 0.f; }
#pragma unroll 2
      for (int i = 0; i < 64; i += 4) {
        float wv[2][4], av[2][4];
#pragma unroll
        for (int c = 0; c < 2; ++c)
#pragma unroll
          for (int u = 0; u < 4; ++u) { wv[c][u] = w2[(i + u) * 512 + tid + c * 256]; av[c][u] = a2[(i + u) * 512 + tid + c * 256]; }
#pragma unroll
        for (int r = 0; r < 16; ++r) {
          const float4 tw = *(const float4*)(twd + r * 64 + i);
          const float4 ta = *(const float4*)(adl + r * 64 + i);
#pragma unroll
          for (int c = 0; c < 2; ++c) {
            aw[c][r] += tw.x * wv[c][0] + tw.y * wv[c][1] + tw.z * wv[c][2] + tw.w * wv[c][3];
            aa[c][r] += ta.x * av[c][0] + ta.y * av[c][1] + ta.z * av[c][2] + ta.w * av[c][3];
          }
        }
      }
      if (l > 0) {
        const float* v2 = p.in[34];
#pragma unroll 2
        for (int j = 0; j < 32; j += 4) {
          float vv[2][4];
#pragma unroll
          for (int c = 0; c < 2; ++c)
#pragma unroll
            for (int u = 0; u < 4; ++u) vv[c][u] = v2[(j + u) * 512 + tid + c * 256];
#pragma unroll
          for (int r = 0; r < 16; ++r) {
            const float4 t4 = *(const float4*)(lv + r * 32 + j);
#pragma unroll
            for (int c = 0; c < 2; ++c) am[c][r] += t4.x * vv[c][0] + t4.y * vv[c][1] + t4.z * vv[c][2] + t4.w * vv[c][3];
          }
        }
      }
#pragma unroll
      for (int c = 0; c < 2; ++c) {
        const int ch = tid + c * 256;
        const float w0v = w0[ch], a0v = a0[ch], kkv = kkp[ch], kav = kap[ch];
        const float v0v = (l > 0) ? p.in[32][ch] : 0.f;
        float kval[16];
#pragma unroll
        for (int r = 0; r < 16; ++r) kval[r] = bf2f(P2[(size_t)(tok0 + r) * PS2 + 512 + ch]);
#pragma unroll
        for (int r = 0; r < 16; ++r) {
          u16* row = P2 + (size_t)(tok0 + r) * PS2;
          const float wpre = w0v + aw[c][r];
          const float nx = -wpre;
          const float sp = fmaxf(nx, 0.f) + __logf(1.f + __expf(-fabsf(nx)));
          const float w = -sp - 0.5f;
          const float decay = __expf(-__expf(w));
          const float a = sigmoidf_(a0v + aa[c][r]);
          const float kk = kval[r] * kkv;
          const float ss = wave_sum(kk * kk);
          const float kkn = kk / fmaxf(sqrtf(ss), 1e-12f);
          row[1792 + ch] = f2bf(decay);
          row[2304 + ch] = f2bf(kkn);
          row[2816 + ch] = f2bf(kkn * a);
          row[512 + ch] = f2bf(kval[r] * (1.f + (a - 1.f) * kav));
          if (l > 0) {
            const float v = vsh[r * 512 + ch];
            const float vf = bf2f(VF[(size_t)(tok0 + r) * 512 + ch]);
            row[1024 + ch] = f2bf(v + (vf - v) * sigmoidf_(v0v + am[c][r]));
          }
        }
      }
    }
    __syncthreads();
  }
}

__device__ __forceinline__ void unpack4(uint2 u, float (&f)[4]) {
  f[0] = bf2f((u16)(u.x & 0xffff)); f[1] = bf2f((u16)(u.x >> 16)); f[2] = bf2f((u16)(u.y & 0xffff)); f[3] = bf2f((u16)(u.y >> 16));
}
__device__ __forceinline__ float quad_sum(float v) { v += __shfl_xor(v, 16); v += __shfl_xor(v, 32); return v; }

__device__ __forceinline__ void phase_prep2m(const Params& p, int l, char* smem) {
  u16* P2 = (u16*)(p.ws + OFF_P2); const u16* VF = (const u16*)(p.ws + OFF_VFIRST); const u16* WL = (const u16*)(p.ws + OFF_WL);
  u16* twl = (u16*)smem;
  u16* adl = twl + 16 * 72;
  u16* vl = adl + 16 * 72;
  const int tid = tidx(), lane = tid & 63, w = tid >> 6, fr = lane & 15, fq = lane >> 4;
  const float* w0 = p.in[22] + (size_t)l * 512; const float* a0 = p.in[24] + (size_t)l * 512;
  const float* kkp = p.in[27] + (size_t)l * 512; const float* kap = p.in[28] + (size_t)l * 512;
#pragma unroll 1
  for (int item = blockIdx.x; item < 2048; item += gridDim.x) {
    const int tok0 = item * 16;
    {
      const int r = tid >> 4, c = tid & 15;
      const uint4 v = *(const uint4*)(P2 + (size_t)(tok0 + r) * PS2 + 1536 + c * 8);
      if (c < 8) *(uint4*)(twl + r * 72 + c * 8) = v; else *(uint4*)(adl + r * 72 + (c - 8) * 8) = v;
    }
    if (l > 0) {
#pragma unroll
      for (int i = 0; i < 4; ++i) {
        const int idx = tid + 256 * i, r = idx >> 6, c = idx & 63;
        *(uint4*)(vl + r * 520 + c * 8) = *(const uint4*)(P2 + (size_t)(tok0 + r) * PS2 + 1024 + c * 8);
      }
    }
    __syncthreads();
    bf16x8 xw[2], xa[2];
#pragma unroll
    for (int ks = 0; ks < 2; ++ks) { xw[ks] = *(const bf16x8*)(twl + fr * 72 + ks * 32 + fq * 8); xa[ks] = *(const bf16x8*)(adl + fr * 72 + ks * 32 + fq * 8); }
    bf16x8 plv = {0, 0, 0, 0, 0, 0, 0, 0};
    if (l > 0) {
      f32x4 lv0 = {0.f, 0.f, 0.f, 0.f}, lv1 = {0.f, 0.f, 0.f, 0.f};
#pragma unroll 4
      for (int ks = 0; ks < 16; ++ks) {
        const bf16x8 xb = *(const bf16x8*)(vl + fr * 520 + ks * 32 + fq * 8);
        const bf16x8 a0f = *(const bf16x8*)(WL + WL_V1 + (size_t)fr * 512 + ks * 32 + fq * 8);
        const bf16x8 a1f = *(const bf16x8*)(WL + WL_V1 + (size_t)(16 + fr) * 512 + ks * 32 + fq * 8);
        lv0 = mfma16(a0f, xb, lv0); lv1 = mfma16(a1f, xb, lv1);
      }
      uint4 u; u.x = pack2(lv0[0], lv0[1]); u.y = pack2(lv0[2], lv0[3]); u.z = pack2(lv1[0], lv1[1]); u.w = pack2(lv1[2], lv1[3]);
      plv = *(bf16x8*)&u;
    }
    const size_t tok = (size_t)tok0 + fr;
    u16* row = P2 + tok * PS2;
#pragma unroll 1
    for (int hh = 0; hh < 2; ++hh) {
      f32x4 aw[4], aa[4], am[4];
#pragma unroll
      for (int m4 = 0; m4 < 4; ++m4) {
        const int chr = w * 128 + (hh * 4 + m4) * 16 + fr;
        f32x4 cw = {0.f, 0.f, 0.f, 0.f}, ca = {0.f, 0.f, 0.f, 0.f}, cm = {0.f, 0.f, 0.f, 0.f};
#pragma unroll
        for (int ks = 0; ks < 2; ++ks) {
          cw = mfma16(*(const bf16x8*)(WL + WL_W2 + (size_t)chr * 64 + ks * 32 + fq * 8), xw[ks], cw);
          ca = mfma16(*(const bf16x8*)(WL + WL_A2 + (size_t)chr * 64 + ks * 32 + fq * 8), xa[ks], ca);
        }
        if (l > 0) {
          const uint2 g0 = *(const uint2*)(WL + WL_V2 + (size_t)chr * 64 + 4 * fq);
          const uint2 g1 = *(const uint2*)(WL + WL_V2 + (size_t)chr * 64 + 16 + 4 * fq);
          uint4 u; u.x = g0.x; u.y = g0.y; u.z = g1.x; u.w = g1.y;
          cm = mfma16(*(bf16x8*)&u, plv, cm);
        }
        aw[m4] = cw; aa[m4] = ca; am[m4] = cm;
      }
      float kv[4][4], av[4][4], kk[4][4];
      float ss = 0.f;
#pragma unroll
      for (int m4 = 0; m4 < 4; ++m4) {
        const int ch0 = w * 128 + (hh * 4 + m4) * 16 + 4 * fq;
        unpack4(*(const uint2*)(row + 512 + ch0), kv[m4]);
        const float4 a0v = *(const float4*)(a0 + ch0), kkv = *(const float4*)(kkp + ch0);
        const float a0a[4] = {a0v.x, a0v.y, a0v.z, a0v.w}, kka[4] = {kkv.x, kkv.y, kkv.z, kkv.w};
#pragma unroll
        for (int j = 0; j < 4; ++j) {
          av[m4][j] = sigmoidf_(a0a[j] + aa[m4][j]);
          kk[m4][j] = kv[m4][j] * kka[j];
          ss += kk[m4][j] * kk[m4][j];
        }
      }
      ss = quad_sum(ss);
      const float rn = 1.f / fmaxf(sqrtf(ss), 1e-12f);
#pragma unroll
      for (int m4 = 0; m4 < 4; ++m4) {
        const int ch0 = w * 128 + (hh * 4 + m4) * 16 + 4 * fq;
        const float4 w0v = *(const float4*)(w0 + ch0), kav = *(const float4*)(kap + ch0);
        const float w0a[4] = {w0v.x, w0v.y, w0v.z, w0v.w}, kaa[4] = {kav.x, kav.y, kav.z, kav.w};
        float dc[4], kn[4], bb[4], kp[4];
#pragma unroll
        for (int j = 0; j < 4; ++j) {
          const float nx = -(w0a[j] + aw[m4][j]);
          const float sp = fmaxf(nx, 0.f) + __logf(1.f + __expf(-fabsf(nx)));
          dc[j] = __expf(-__expf(-sp - 0.5f));
          kn[j] = kk[m4][j] * rn;
          bb[j] = kn[j] * av[m4][j];
          kp[j] = kv[m4][j] * (1.f + (av[m4][j] - 1.f) * kaa[j]);
        }
        uint2 o;
        o.x = pack2(dc[0], dc[1]); o.y = pack2(dc[2], dc[3]); *(uint2*)(row + 1792 + ch0) = o;
        o.x = pack2(kn[0], kn[1]); o.y = pack2(kn[2], kn[3]); *(uint2*)(row + 2304 + ch0) = o;
        o.x = pack2(bb[0], bb[1]); o.y = pack2(bb[2], bb[3]); *(uint2*)(row + 2816 + ch0) = o;
        o.x = pack2(kp[0], kp[1]); o.y = pack2(kp[2], kp[3]); *(uint2*)(row + 512 + ch0) = o;
        if (l > 0) {
          float vv[4], vf[4];
          unpack4(*(const uint2*)(vl + fr * 520 + ch0), vv);
          unpack4(*(const uint2*)(VF + tok * 512 + ch0), vf);
          const float4 v0v = *(const float4*)(p.in[32] + ch0);
          const float v0a[4] = {v0v.x, v0v.y, v0v.z, v0v.w};
          float vo[4];
#pragma unroll
          for (int j = 0; j < 4; ++j) vo[j] = vv[j] + (vf[j] - vv[j]) * sigmoidf_(v0a[j] + am[m4][j]);
          o.x = pack2(vo[0], vo[1]); o.y = pack2(vo[2], vo[3]); *(uint2*)(row + 1024 + ch0) = o;
        }
      }
    }
    __syncthreads();
  }
}

__device__ __forceinline__ void phase_postm(const Params& p, int l, char* smem) {
  const u16* P2 = (const u16*)(p.ws + OFF_P2); u16* YC = (u16*)(p.ws + OFF_P1) + 1560; const u16* WL = (const u16*)(p.ws + OFF_WL);
  u16* sgl = (u16*)smem;
  const int tid = tidx(), lane = tid & 63, w = tid >> 6, fr = lane & 15, fq = lane >> 4;
  const float* rk = p.in[29] + (size_t)l * 512; const float* lg = p.in[30] + (size_t)l * 512; const float* lb = p.in[31] + (size_t)l * 512;
#pragma unroll 1
  for (int item = blockIdx.x; item < 2048; item += gridDim.x) {
    const int tok0 = item * 16;
    {
      const int r = tid >> 4, c = tid & 15;
      *(uint4*)(sgl + r * 136 + c * 8) = *(const uint4*)(P2 + (size_t)(tok0 + r) * PS2 + 1664 + c * 8);
    }
    __syncthreads();
    bf16x8 xb[4];
#pragma unroll
    for (int ks = 0; ks < 4; ++ks) xb[ks] = *(const bf16x8*)(sgl + fr * 136 + ks * 32 + fq * 8);
    const size_t tok = (size_t)tok0 + fr;
    const u16* row = P2 + tok * PS2;
    u16* yrow = YC + tok * PS1;
#pragma unroll 1
    for (int hh = 0; hh < 2; ++hh) {
      f32x4 ag[4];
#pragma unroll
      for (int m4 = 0; m4 < 4; ++m4) {
        const int chr = w * 128 + (hh * 4 + m4) * 16 + fr;
        f32x4 c = {0.f, 0.f, 0.f, 0.f};
#pragma unroll
        for (int ks = 0; ks < 4; ++ks) c = mfma16(*(const bf16x8*)(WL + WL_G2 + (size_t)chr * 128 + ks * 32 + fq * 8), xb[ks], c);
        ag[m4] = c;
      }
      float yv[4][4], vv[4][4];
      float s1 = 0.f, sb = 0.f;
#pragma unroll
      for (int m4 = 0; m4 < 4; ++m4) {
        const int ch0 = w * 128 + (hh * 4 + m4) * 16 + 4 * fq;
        float rr[4], kk[4];
        unpack4(*(const uint2*)(yrow + ch0), yv[m4]);
        unpack4(*(const uint2*)(row + ch0), rr);
        unpack4(*(const uint2*)(row + 512 + ch0), kk);
        unpack4(*(const uint2*)(row + 1024 + ch0), vv[m4]);
        const float4 rkv = *(const float4*)(rk + ch0);
        s1 += yv[m4][0] + yv[m4][1] + yv[m4][2] + yv[m4][3];
        sb += rr[0] * kk[0] * rkv.x + rr[1] * kk[1] * rkv.y + rr[2] * kk[2] * rkv.z + rr[3] * kk[3] * rkv.w;
      }
      s1 = quad_sum(s1); sb = quad_sum(sb);
      const float mean = s1 * (1.f / 64.f);
      float s2 = 0.f;
#pragma unroll
      for (int m4 = 0; m4 < 4; ++m4)
#pragma unroll
        for (int j = 0; j < 4; ++j) { const float d = yv[m4][j] - mean; s2 += d * d; }
      s2 = quad_sum(s2);
      const float rs = rsqrtf(s2 * (1.f / 64.f) + 64e-5f);
#pragma unroll
      for (int m4 = 0; m4 < 4; ++m4) {
        const int ch0 = w * 128 + (hh * 4 + m4) * 16 + 4 * fq;
        const float4 lgv = *(const float4*)(lg + ch0), lbv = *(const float4*)(lb + ch0);
        const float lga[4] = {lgv.x, lgv.y, lgv.z, lgv.w}, lba[4] = {lbv.x, lbv.y, lbv.z, lbv.w};
        float o4[4];
#pragma unroll
        for (int j = 0; j < 4; ++j) o4[j] = ((yv[m4][j] - mean) * rs * lga[j] + lba[j] + sb * vv[m4][j]) * ag[m4][j];
        uint2 o; o.x = pack2(o4[0], o4[1]); o.y = pack2(o4[2], o4[3]);
        *(uint2*)(yrow + ch0) = o;
      }
    }
    __syncthreads();
  }
}

__device__ __forceinline__ void scan_item(const Params& p, int item, char* smem) {
  const u16* P2 = (const u16*)(p.ws + OFF_P2); u16* YC = (u16*)(p.ws + OFF_P1) + 1560;
  float* vb = (float*)smem;
  float* yb = vb + 2 * 6 * 16 * 64;
  const int tid = tidx(), lane = tid & 63, wid = tid >> 6;
  const int rq = item & 3, h = (item >> 2) & 7, b = item >> 5;
  const int rl = lane >> 4, cq = lane & 15;
  const int rloc = wid * 4 + rl;
  const int ihead = rq * 16 + rloc;
  const int j0 = cq * 4;
  const size_t tokb = (size_t)b * 4096;
  float s0 = 0.f, s1 = 0.f, s2 = 0.f, s3 = 0.f;
  uint4 pA[3], pB[3], pC[3];
  auto gload = [&](uint4 (&pre)[3], int c) {
#pragma unroll
    for (int i = 0; i < 3; ++i) {
      const int v = tid + i * 256; const int vec = v >> 7, rem = v & 127, step = rem >> 3, c8 = rem & 7;
      const int off = (vec == 0) ? 0 : (vec == 1) ? 1792 : (vec == 2) ? 512 : (vec == 3) ? 1024 : (vec == 4) ? 2304 : 2816;
      pre[i] = *(const uint4*)(P2 + (tokb + c * 16 + step) * PS2 + off + h * 64 + c8 * 8);
    }
  };
  auto lstore = [&](const uint4 (&pre)[3], int buf) {
#pragma unroll
    for (int i = 0; i < 3; ++i) {
      const int v = tid + i * 256; const int vec = v >> 7, rem = v & 127, step = rem >> 3, c8 = rem & 7;
      float* d = vb + ((buf * 6 + vec) * 16 + step) * 64 + c8 * 8;
      float4 f0, f1;
      f0.x = bf2f((u16)(pre[i].x & 0xffff)); f0.y = bf2f((u16)(pre[i].x >> 16)); f0.z = bf2f((u16)(pre[i].y & 0xffff)); f0.w = bf2f((u16)(pre[i].y >> 16));
      f1.x = bf2f((u16)(pre[i].z & 0xffff)); f1.y = bf2f((u16)(pre[i].z >> 16)); f1.z = bf2f((u16)(pre[i].w & 0xffff)); f1.w = bf2f((u16)(pre[i].w >> 16));
      *(float4*)d = f0; *(float4*)(d + 4) = f1;
    }
  };
#define SC_LOAD(X, ST) { r##X = *(const float4*)(base + (0 * 16 + (ST)) * 64 + j0); w##X = *(const float4*)(base + (1 * 16 + (ST)) * 64 + j0); \
      k##X = *(const float4*)(base + (2 * 16 + (ST)) * 64 + j0); v##X = base[(3 * 16 + (ST)) * 64 + ihead]; \
      n##X = *(const float4*)(base + (4 * 16 + (ST)) * 64 + j0); b##X = *(const float4*)(base + (5 * 16 + (ST)) * 64 + j0); }
#define SC_STEP(X, ST) { float sa = s0 * n##X.x + s1 * n##X.y + s2 * n##X.z + s3 * n##X.w; \
      sa = -dpp_sum16(sa); \
      s0 = s0 * w##X.x + sa * b##X.x + v##X * k##X.x; s1 = s1 * w##X.y + sa * b##X.y + v##X * k##X.y; \
      s2 = s2 * w##X.z + sa * b##X.z + v##X * k##X.z; s3 = s3 * w##X.w + sa * b##X.w + v##X * k##X.w; \
      float y = s0 * r##X.x + s1 * r##X.y + s2 * r##X.z + s3 * r##X.w; \
      y = dpp_sum16(y); yb[(ST) * 16 + rloc] = y; }
#define SC_CHUNK(CC, PRE) { const int cc_ = (CC); if (cc_ >= 256) break; \
    const float* base = vb + (cc_ & 1) * 6 * 16 * 64; \
    { float4 rA, wA, kA, nA, bA, rB, wB, kB, nB, bB; float vA, vB; \
      SC_LOAD(A, 0) \
      _Pragma("unroll") for (int st = 0; st < 16; st += 2) { SC_LOAD(B, st + 1) SC_STEP(A, st) if (st + 2 < 16) SC_LOAD(A, st + 2) SC_STEP(B, st + 1) } } \
    __syncthreads(); \
    { const int st = tid >> 4, r = tid & 15; \
      YC[(tokb + cc_ * 16 + st) * PS1 + h * 64 + rq * 16 + r] = f2bf(yb[st * 16 + r]); } \
    if (cc_ + 1 < 256) lstore(PRE, (cc_ + 1) & 1); \
    if (cc_ + 4 < 256) gload(PRE, cc_ + 4); \
    __syncthreads(); }
  gload(pA, 0); lstore(pA, 0);
  __syncthreads();
  gload(pA, 1); gload(pB, 2); gload(pC, 3);
#pragma unroll 1
  for (int c = 0; c < 256; c += 3) {
    SC_CHUNK(c, pA)
    SC_CHUNK(c + 1, pB)
    SC_CHUNK(c + 2, pC)
  }
#undef SC_LOAD
#undef SC_STEP
#undef SC_CHUNK
}

__device__ __forceinline__ void phase_post(const Params& p, int l, char* smem) {
  const u16* P2 = (const u16*)(p.ws + OFF_P2); u16* YC = (u16*)(p.ws + OFF_P1) + 1560;
  float* sg = (float*)smem;
  const int tid = tidx();
  const float* g2 = p.in[26] + (size_t)l * 128 * 512;
  const float* rk = p.in[29] + (size_t)l * 512; const float* lg = p.in[30] + (size_t)l * 512; const float* lb = p.in[31] + (size_t)l * 512;
  for (int item = blockIdx.x; item < 2048; item += gridDim.x) {
    const int tok0 = item * 16;
    for (int e = tid; e < 2048; e += 256) { const int r = e >> 7, c = e & 127; sg[e] = bf2f(P2[(size_t)(tok0 + r) * PS2 + 1664 + c]); }
    __syncthreads();
    {
      float ag[2][16];
#pragma unroll
      for (int c = 0; c < 2; ++c)
#pragma unroll
        for (int r = 0; r < 16; ++r) ag[c][r] = 0.f;
#pragma unroll 4
      for (int i = 0; i < 128; i += 4) {
        float gv[2][4];
#pragma unroll
        for (int c = 0; c < 2; ++c)
#pragma unroll
          for (int u = 0; u < 4; ++u) gv[c][u] = g2[(i + u) * 512 + tid + c * 256];
#pragma unroll
        for (int r = 0; r < 16; ++r) {
          const float4 t4 = *(const float4*)(sg + r * 128 + i);
#pragma unroll
          for (int c = 0; c < 2; ++c) ag[c][r] += t4.x * gv[c][0] + t4.y * gv[c][1] + t4.z * gv[c][2] + t4.w * gv[c][3];
        }
      }
#pragma unroll
      for (int c = 0; c < 2; ++c) {
        const int ch = tid + c * 256;
        const float rkv = rk[ch], lgv = lg[ch], lbv = lb[ch];
        float yv[16], rr[16], kk[16], vv[16];
#pragma unroll
        for (int r = 0; r < 16; ++r) {
          const u16* row = P2 + (size_t)(tok0 + r) * PS2;
          yv[r] = bf2f(YC[(size_t)(tok0 + r) * PS1 + ch]);
          rr[r] = bf2f(row[ch]); kk[r] = bf2f(row[512 + ch]); vv[r] = bf2f(row[1024 + ch]);
        }
#pragma unroll
        for (int r = 0; r < 16; ++r) {
          const float mean = wave_sum(yv[r]) * (1.f / 64.f);
          const float dv = yv[r] - mean;
          const float var = wave_sum(dv * dv) * (1.f / 64.f);
          const float yn = dv * rsqrtf(var + 64e-5f) * lgv + lbv;
          const float bon = wave_sum(rr[r] * kk[r] * rkv) * vv[r];
          YC[(size_t)(tok0 + r) * PS1 + ch] = f2bf((yn + bon) * ag[c][r]);
        }
      }
    }
    __syncthreads();
  }
}

#define NEGV (-1e30f)
struct AttnState { float m[2]; float ls[2]; f32x4 ot[4][2]; };

#define MINIT (-1e20f)
template <int MODE, bool FULL>
__device__ __forceinline__ void attn_scores(f32x4 (&st)[4][2], const u16* kbase, int kstride, int key0, const bf16x8 (&qf)[2][2],
                                            const float (&slope)[2], int t, bool selbit, int c16, int q4) {
  const float fb = (float)(key0 + q4 * 4 - t);
#pragma unroll
  for (int mk = 0; mk < 4; ++mk) {
    const u16* kp = kbase + (size_t)(mk * 16 + c16) * kstride + q4 * 8;
    const bf16x8 k0 = *(const bf16x8*)kp, k1 = *(const bf16x8*)(kp + 32);
#pragma unroll
    for (int nq = 0; nq < 2; ++nq) {
      f32x4 a = {0.f, 0.f, 0.f, 0.f};
      a = mfma16(k0, qf[nq][0], a);
      a = mfma16(k1, qf[nq][1], a);
      if (FULL) {
        const float c0 = slope[nq] * fb;
#pragma unroll
        for (int j = 0; j < 4; ++j) {
          const float v = a[j] + (c0 + slope[nq] * (float)(mk * 16 + j));
          a[j] = (MODE == 1) ? (selbit ? v : NEGV) : v;
        }
      } else {
#pragma unroll
        for (int j = 0; j < 4; ++j) {
          const int key = key0 + mk * 16 + q4 * 4 + j;
          int dist; bool valid;
          if (MODE == 0) { dist = t - (16 * key + 31); valid = dist >= 0; }
          else if (MODE == 1) { dist = t - key; valid = (dist >= 0) && selbit; }
          else { dist = t - key; valid = (dist >= 0) && (dist < 512); }
          a[j] = valid ? (a[j] - slope[nq] * (float)dist) : NEGV;
        }
      }
      st[mk][nq] = a;
    }
  }
}

template <int MODE, bool FULL>
__device__ __forceinline__ void attn_tile(AttnState& S, const u16* kbase, int kstride, const u16* vtbase, int vstride, int key0,
                                          const bf16x8 (&qf)[2][2], const float (&slope)[2], int t, bool selbit, int c16, int q4) {
  f32x4 st[4][2];
  attn_scores<MODE, FULL>(st, kbase, kstride, key0, qf, slope, t, selbit, c16, q4);
  __builtin_amdgcn_sched_barrier(0);
#pragma unroll
  for (int nq = 0; nq < 2; ++nq) {
    float mx = fmaxf(fmaxf(st[0][nq][0], st[0][nq][1]), fmaxf(st[0][nq][2], st[0][nq][3]));
#pragma unroll
    for (int mk = 1; mk < 4; ++mk) mx = fmaxf(mx, fmaxf(fmaxf(st[mk][nq][0], st[mk][nq][1]), fmaxf(st[mk][nq][2], st[mk][nq][3])));
    mx = fmaxf(mx, __shfl_xor(mx, 16)); mx = fmaxf(mx, __shfl_xor(mx, 32));
    const float mnew = fmaxf(S.m[nq], mx);
    const float alpha = __builtin_amdgcn_exp2f(S.m[nq] - mnew);
    S.m[nq] = mnew;
    float ls = S.ls[nq] * alpha;
#pragma unroll
    for (int md = 0; md < 4; ++md) { S.ot[md][nq][0] *= alpha; S.ot[md][nq][1] *= alpha; S.ot[md][nq][2] *= alpha; S.ot[md][nq][3] *= alpha; }
#pragma unroll
    for (int mk = 0; mk < 4; ++mk)
#pragma unroll
      for (int j = 0; j < 4; ++j) {
        const float pv = __builtin_amdgcn_exp2f(st[mk][nq][j] - mnew);
        st[mk][nq][j] = pv; ls += pv;
      }
    S.ls[nq] = ls;
  }
#pragma unroll
  for (int s2 = 0; s2 < 2; ++s2) {
    __builtin_amdgcn_sched_barrier(0);
    bf16x8 pb[2];
#pragma unroll
    for (int nq = 0; nq < 2; ++nq) {
      uint4 u;
      u.x = pack2(st[2 * s2][nq][0], st[2 * s2][nq][1]); u.y = pack2(st[2 * s2][nq][2], st[2 * s2][nq][3]);
      u.z = pack2(st[2 * s2 + 1][nq][0], st[2 * s2 + 1][nq][1]); u.w = pack2(st[2 * s2 + 1][nq][2], st[2 * s2 + 1][nq][3]);
      pb[nq] = *(bf16x8*)&u;
    }
#pragma unroll
    for (int md = 0; md < 4; ++md) {
      const bf16x8 vf = *(const bf16x8*)(vtbase + (size_t)(md * 16 + c16) * vstride + s2 * 32 + q4 * 8);
#pragma unroll
      for (int nq = 0; nq < 2; ++nq) S.ot[md][nq] = mfma16(vf, pb[nq], S.ot[md][nq]);
    }
  }
}

__device__ __forceinline__ void attn_reset(AttnState& S) {
#pragma unroll
  for (int nq = 0; nq < 2; ++nq) { S.m[nq] = MINIT; S.ls[nq] = 0.f;
#pragma unroll
    for (int md = 0; md < 4; ++md) S.ot[md][nq] = f32x4{0.f, 0.f, 0.f, 0.f}; }
}
__device__ __forceinline__ void attn_fold(AttnState& S, float* oacc, const u16* gp, int br, float (&invl)[2], int lane) {
#pragma unroll
  for (int nq = 0; nq < 2; ++nq) {
    float l = S.ls[nq];
    l += __shfl_xor(l, 16); l += __shfl_xor(l, 32);
    const float inv = (l > 0.f) ? 1.f / l : 0.f;
    invl[nq] = inv;
    const float f = bf2f(gp[nq * 6 + br]) * inv;
#pragma unroll
    for (int md = 0; md < 4; ++md)
#pragma unroll
      for (int j = 0; j < 4; ++j) {
        float* a = oacc + ((md * 2 + nq) * 4 + j) * 64 + lane;
        const float v = f * S.ot[md][nq][j];
        if (br == 0) *a = v; else *a += v;
      }
  }
}

__device__ __forceinline__ void phase_nsa(const Params& p, char* smem, unsigned* queue) {
  u16* P1 = (u16*)(p.ws + OFF_P1);
  const u16* KC = (const u16*)(p.ws + OFF_KC); const u16* VC = (const u16*)(p.ws + OFF_VC); const u16* VT = (const u16*)(p.ws + OFF_VT);
  const int tid = tidx(), lane = tid & 63, wid = tid >> 6;
  const int c16 = lane & 15, q4 = lane >> 4, tq = lane & 7;
  float* ps = (float*)smem + wid * 2048;
  float* oacc = (float*)(smem + 32768) + wid * 2048;
  int* qslot = (int*)(smem + 65536);
#pragma unroll 1
  for (;;) {
    if (tid == 0) *qslot = (int)atomicAdd(queue, 1u);
    __syncthreads();
    const int it = *qslot;
    if (it >= 2048) break;
    const int bg = it & 15;
    const int tqd = 127 - (it >> 4);
    const int b = bg >> 1, g = bg & 1;
    const int t0 = (tqd * 4 + wid) * 8;
    const int tok0 = b * 4096 + t0;
    const int t = t0 + tq;
    const int cur = t0 >> 6;
#pragma unroll
    for (int i = 0; i < 8; ++i) *(float4*)(ps + i * 256 + lane * 4) = float4{0.f, 0.f, 0.f, 0.f};
    bf16x8 qf[2][2]; float slope[2];
    const u16* gp = P1 + (size_t)(tok0 + tq) * PS1 + 1024 + (g * 4 + (c16 >> 3)) * 3;
#pragma unroll
    for (int nq = 0; nq < 2; ++nq) {
      const int hh = nq * 2 + (c16 >> 3);
      const u16* rp = P1 + (size_t)(tok0 + tq) * PS1;
      qf[nq][0] = *(const bf16x8*)(rp + (g * 4 + hh) * 64 + q4 * 8);
      qf[nq][1] = *(const bf16x8*)(rp + (g * 4 + hh) * 64 + 32 + q4 * 8);
      slope[nq] = exp2f(-(float)(g * 4 + hh + 1)) * 1.4426950408889634f;
    }
    AttnState S;
    float invl[2];
    const u16* kcb = KC + (size_t)(b * 2 + g) * 256 * 64;
    const u16* vcb = VC + (size_t)(b * 2 + g) * 64 * 256;
    int ntc = 0;
    if (t0 + 7 >= 31) ntc = (((t0 + 7 - 31) >> 4) >> 6) + 1;
    attn_reset(S);
#pragma unroll 1
    for (int kt = 0; kt < ntc; ++kt) attn_tile<0, false>(S, kcb + (size_t)kt * 64 * 64, 64, vcb + kt * 64, 256, kt * 64, qf, slope, t, true, c16, q4);
    attn_fold(S, oacc, gp, 0, invl, lane);
#pragma unroll 1
    for (int kt = 0; kt < ntc; ++kt) {
      f32x4 st[4][2];
      attn_scores<0, false>(st, kcb + (size_t)kt * 64 * 64, 64, kt * 64, qf, slope, t, true, c16, q4);
#pragma unroll
      for (int mk = 0; mk < 4; ++mk) {
        f32x4 hs;
#pragma unroll
        for (int j = 0; j < 4; ++j) {
          const float a0 = st[mk][0][j], a1 = st[mk][1][j];
          const float p0 = __builtin_amdgcn_exp2f(a0 - S.m[0]) * invl[0];
          const float p1 = __builtin_amdgcn_exp2f(a1 - S.m[1]) * invl[1];
          float v = p0 + p1;
          v += __shfl_xor(v, 8);
          hs[j] = v;
        }
        if (c16 < 8) *(f32x4*)(ps + c16 * 256 + kt * 64 + mk * 16 + q4 * 4) = hs;
      }
    }
    __syncthreads();
    unsigned long long selm = 0ull, un = 0ull;
#pragma unroll 1
    for (int tqq = 0; tqq < 8; ++tqq) {
      const float* pr = ps + tqq * 256;
      float imp = pr[4 * lane];
      if (lane > 0) imp += pr[4 * lane - 4] + 2.f * (pr[4 * lane - 3] + pr[4 * lane - 2] + pr[4 * lane - 1]);
      const bool forced = (lane == 0) || (lane == cur) || (lane == cur - 1);
      const bool live = lane <= cur;
      const float val = forced ? 1e4f : (live ? imp : NEGV);
      int rank = 0;
#pragma unroll 8
      for (int i = 0; i < 64; ++i) {
        const float vi = __uint_as_float(__builtin_amdgcn_readlane(__float_as_uint(val), i));
        rank += ((vi > val) || (vi == val && i < lane)) ? 1 : 0;
      }
      const unsigned long long bal = __ballot((rank < 16) && live);
      if (tq == tqq) selm = bal;
      un |= bal;
    }
    __syncthreads();
    attn_reset(S);
    {
      const u16* vtb = VT + (size_t)((0 * 8 + b) * 2 + g) * 64 * 4096;
#pragma unroll 1
      for (int j = 0; j <= cur; ++j) {
        if (!((un >> j) & 1ull)) continue;
        const bool sb = (selm >> j) & 1ull;
        const u16* kb_ = P1 + (size_t)(b * 4096 + j * 64) * PS1 + 768 + g * 64;
        if (j < cur) attn_tile<1, true>(S, kb_, PS1, vtb + j * 64, 4096, j * 64, qf, slope, t, sb, c16, q4);
        else attn_tile<1, false>(S, kb_, PS1, vtb + j * 64, 4096, j * 64, qf, slope, t, sb, c16, q4);
      }
    }
    attn_fold(S, oacc, gp, 1, invl, lane);
    attn_reset(S);
    {
      const u16* vtb = VT + (size_t)((1 * 8 + b) * 2 + g) * 64 * 4096;
      int j0 = t0 - 511; if (j0 < 0) j0 = 0; j0 >>= 6;
#pragma unroll 1
      for (int j = j0; j <= cur; ++j) {
        const u16* kb_ = P1 + (size_t)(b * 4096 + j * 64) * PS1 + 896 + g * 64;
        const bool full = (j < cur) && (j * 64 >= t0 + 7 - 511);
        if (full) attn_tile<2, true>(S, kb_, PS1, vtb + j * 64, 4096, j * 64, qf, slope, t, true, c16, q4);
        else attn_tile<2, false>(S, kb_, PS1, vtb + j * 64, 4096, j * 64, qf, slope, t, true, c16, q4);
      }
    }
    attn_fold(S, oacc, gp, 2, invl, lane);
#pragma unroll
    for (int nq = 0; nq < 2; ++nq) {
      const int hh = nq * 2 + (c16 >> 3);
      u16* rp = P1 + (size_t)(tok0 + tq) * PS1 + (g * 4 + hh) * 64;
#pragma unroll
      for (int md = 0; md < 4; ++md) {
        const float* a = oacc + ((md * 2 + nq) * 4) * 64 + lane;
        uint2 o; o.x = pack2(a[0], a[64]); o.y = pack2(a[128], a[192]);
        *(uint2*)(rp + md * 16 + q4 * 4) = o;
      }
    }
  }
}

__device__ __forceinline__ const float* modp(const Params& p, int l, int sub, int kind) {
  return (const float*)(p.ws + OFF_MOD) + (size_t)l * 8 * 9216 + sub * 3072 + kind * 1024;
}

__device__ __forceinline__ void run_phase(const Params& p, int ph, char* smem) {
  char* ws = p.ws;
  if (ph == 0) {
    if (blockIdx.x == 0) { unsigned* c = (unsigned*)(ws + OFF_CNT); for (int e = tidx(); e < 1024; e += 256) c[e] = 0u; }
    phase_mod(p, smem);
  }
  int l = 0, s = -1;
  if (ph >= 2) { l = (ph - 2) / 14; s = (ph - 2) % 14; }
  const float* preg = p.in[4] + (size_t)l * 3 * 1024; const float* postg = p.in[5] + (size_t)l * 3 * 1024;
  const bool is_norm = (ph == 1) || s == 2 || s == 10 || s == 13;
  if (is_norm) {
    const float* xin = p.out; float* xout = p.out; const u16* y = nullptr; const float* pg = nullptr; const float* gate = nullptr; float wgt = 0.f;
    const float* prg = nullptr; const float* sh = nullptr; const float* sc = nullptr; u16* h = (u16*)(ws + OFF_H);
    if (ph == 1) { xin = p.in[0]; prg = p.in[4]; sh = modp(p, 0, 0, 0); sc = modp(p, 0, 0, 1); }
    else if (s == 2) { y = (const u16*)(ws + OFF_YF); pg = postg; gate = modp(p, l, 0, 2); wgt = 0.5f; prg = preg + 1024; sh = modp(p, l, 1, 0); sc = modp(p, l, 1, 1); }
    else if (s == 10) { y = (const u16*)(ws + OFF_YM); pg = postg + 1024; gate = modp(p, l, 1, 2); wgt = 1.0f; prg = preg + 2048; sh = modp(p, l, 2, 0); sc = modp(p, l, 2, 1); }
    else { y = (const u16*)(ws + OFF_YF); pg = postg + 2048; gate = modp(p, l, 2, 2); wgt = 0.5f;
      if (l == 0) { prg = p.in[4] + 3 * 1024; sh = modp(p, 1, 0, 0); sc = modp(p, 1, 0, 1); } else { h = nullptr; } }
    phase_norm(xin, xout, y, pg, gate, wgt, prg, sh, sc, h);
  }
  {
    int cl = -1, cf = 0;
    if (ph == 0) { cl = 0; cf = 0; } else if (s == 2) { cl = l; cf = 1; } else if (s == 13 && l == 0) { cl = 1; cf = 0; }
    if (cl >= 0) conv_ffn(p, cl, cf, smem);
    if (cl >= 0 && cf == 0) conv_mix(p, cl, smem);
  }
  if (s == 0 || s == 11) phase_ffn_in(p, smem);
  if (s == 1 || s == 12 || s == 9) {
    const bool o = (s == 9);
    phase_gemm_plain((const u16*)(ws + (o ? OFF_MERGED : OFF_ACT)), o ? 1024 : DFF, (const u16*)(ws + (o ? OFF_WO : OFF_WOUT)), o ? 1024 : DFF,
                     (u16*)(ws + (o ? OFF_YM : OFF_YF)), smem);
  }
  if (s == 3) phase_inproj(p, smem);
  if (s == 4) { phase_prep1(p, l); phase_sgu(p, l, smem); phase_cmp1(p, l, smem); }
  if (s == 5) { phase_prep2m(p, l, smem); phase_cmp2(p, l); }
  if (s == 6) {
    const int nb = gridDim.x;
    const int sid = (nb >= 512) ? (((int)blockIdx.x & 1) ? -1 : ((int)blockIdx.x >> 1)) : (int)blockIdx.x;
    const int sstride = (nb >= 512) ? (nb >> 1) : nb;
    if (sid >= 0) {
      __builtin_amdgcn_s_setprio(3);
      for (int it = sid; it < 256; it += sstride) scan_item(p, it, smem);
      __builtin_amdgcn_s_setprio(0);
    }
    phase_nsa(p, smem, (unsigned*)(ws + OFF_CNT) + 64 + l * 64);
  }
  if (s == 7) phase_postm(p, l, smem);
  if (s == 8) phase_merge(p, smem);
}

constexpr int NPHASE = 30;

#if COOP
typedef const float* __attribute__((address_space(4))) const* kargp_t;
template <int PH>
__device__ __forceinline__ void run_seq(char* smem, cg::grid_group& grid) {
  if constexpr (PH < NPHASE) {
    {
      kargp_t ka = (kargp_t)__builtin_amdgcn_kernarg_segment_ptr();
      asm volatile("" : "+s"(ka));
      Params q;
#pragma unroll
      for (int i = 0; i < 35; ++i) q.in[i] = ka[i];
      q.out = (float*)ka[35];
      q.ws = (char*)ka[36];
      run_phase(q, PH, smem);
    }
    if constexpr (PH == 0) grid.sync();
    else if constexpr (PH + 1 < NPHASE) {
      kargp_t kb = (kargp_t)__builtin_amdgcn_kernarg_segment_ptr();
      asm volatile("" : "+s"(kb));
      gbar((unsigned*)((char*)kb[36] + OFF_CNT), (unsigned)PH * gridDim.x);
    }
    run_seq<PH + 1>(smem, grid);
  }
}

__global__ void __launch_bounds__(256, 2) mega(Params p) {
  __shared__ __attribute__((aligned(16))) char smem[SMEM_BYTES];
  cg::grid_group grid = cg::this_grid();
  run_seq<0>(smem, grid);
}
#endif

template <int PH>
__global__ void __launch_bounds__(256, 2) kph(Params p) {
  __shared__ __attribute__((aligned(16))) char smem[SMEM_BYTES];
  run_phase(p, PH, smem);
}

template <int PH>
static void launch_seq(const Params& p, int grid, hipStream_t stream) {
  if constexpr (PH < NPHASE) {
    kph<PH><<<grid, 256, 0, stream>>>(p);
    launch_seq<PH + 1>(p, grid, stream);
  }
}

extern "C" void kernel_launch(void* const* d_in, const int* in_sizes, int n_in, void* d_out, int out_size, void* d_ws, size_t ws_size,
                              hipStream_t stream) {
  static int grid_blocks = 0;
  if (!grid_blocks) {
    int dev = 0, cus = 0, per_cu = 0;
    hipGetDevice(&dev);
    hipDeviceGetAttribute(&cus, hipDeviceAttributeMultiprocessorCount, dev);
    #if COOP
    hipOccupancyMaxActiveBlocksPerMultiprocessor(&per_cu, mega, 256, 0);
#else
    per_cu = 2;
#endif
    if (per_cu > 2) per_cu = 2;
    if (per_cu < 1) per_cu = 1;
    grid_blocks = cus * per_cu;
  }
  Params p{};
  for (int i = 0; i < 35; ++i) p.in[i] = (const float*)d_in[i];
  p.out = (float*)d_out;
  p.ws = (char*)d_ws;
#if COOP
  void* args[] = {&p};
  hipError_t e = hipLaunchCooperativeKernel((void*)mega, dim3(grid_blocks), dim3(256), args, 0, stream);
  if (e != hipSuccess) fprintf(stderr, "cooperative launch failed: %s (grid %d)\n", hipGetErrorString(e), grid_blocks);
#else
  launch_seq<0>(p, grid_blocks, stream);
#endif
}
```

```cpp
#include <hip/hip_runtime.h>
#include <hip/hip_cooperative_groups.h>
#include <cstdio>
#include <cstdint>
namespace cg = cooperative_groups;

#ifndef COOP
#define COOP 1
#endif

typedef unsigned short u16;
using bf16x8 = __attribute__((ext_vector_type(8))) short;
using f32x4 = __attribute__((ext_vector_type(4))) float;

constexpr int T = 32768, D = 1024, SEQ = 4096, DFF = 2816;
constexpr int PS1 = 2072, PS2 = 3328;
constexpr int MIXC = 7192, MIXN = 4120;
constexpr size_t OFF_P1 = 0;
constexpr size_t OFF_P2 = OFF_P1 + (size_t)T * PS1 * 2;
constexpr size_t OFF_H = OFF_P2 + (size_t)T * PS2 * 2;
constexpr size_t OFF_WMIX = OFF_H + (size_t)T * 1024 * 2;
constexpr size_t OFF_WG = OFF_WMIX + (size_t)4224 * 1024 * 2;
constexpr size_t OFF_WB = OFF_WG + (size_t)3072 * 1024 * 2;
constexpr size_t OFF_WO = OFF_WB + (size_t)3 * 1024 * 512 * 2;
constexpr size_t OFF_W1 = OFF_WO + (size_t)1024 * 1024 * 2;
constexpr size_t OFF_WIN = OFF_W1 + (size_t)2 * 256 * 2048 * 2;
constexpr size_t OFF_WOUT = OFF_WIN + (size_t)5632 * 1024 * 2;
constexpr size_t OFF_VFIRST = OFF_WOUT + (size_t)1024 * 2816 * 2;
constexpr size_t OFF_VT = OFF_VFIRST + (size_t)T * 512 * 2;
constexpr size_t OFF_MOD = OFF_VT + (size_t)2 * 8 * 2 * 64 * 4096 * 2;
constexpr size_t OFF_PB = OFF_MOD + (size_t)2 * 8 * 9216 * 4;
constexpr size_t OFF_HID = OFF_PB + (size_t)1024 * 1792 * 2;
constexpr size_t OFF_KC = OFF_HID + (size_t)2 * 4096 * 256 * 2;
constexpr size_t OFF_VC = OFF_KC + (size_t)8 * 2 * 256 * 64 * 2;
constexpr size_t OFF_LV = OFF_VC + (size_t)8 * 2 * 64 * 256 * 2;
constexpr size_t OFF_CNT = OFF_LV + (size_t)T * 32 * 4;
constexpr size_t OFF_WL = OFF_CNT + 4096;
constexpr int WL_W2 = 0, WL_A2 = 512 * 64, WL_G2 = 2 * 512 * 64, WL_V1 = WL_G2 + 512 * 128, WL_V2 = WL_V1 + 64 * 512, WL_END = WL_V2 + 512 * 64;
constexpr size_t OFF_XB = (OFF_WL + (size_t)WL_END * 2 + 255) & ~(size_t)255;
constexpr size_t XB_BYTES = 32768;
constexpr size_t WS_END = OFF_XB + XB_BYTES;
constexpr size_t OFF_ACT = OFF_P1;
constexpr size_t OFF_YF = OFF_ACT + (size_t)T * DFF * 2;
constexpr size_t OFF_H2 = OFF_P2;
constexpr size_t OFF_MERGED = OFF_P2;
constexpr size_t OFF_YM = OFF_MERGED + (size_t)T * 1024 * 2;
constexpr size_t OFF_YC = OFF_H;

constexpr int SMEM_BYTES = 73728;

struct Params { const float* in[35]; float* out; char* ws; };

__device__ __forceinline__ int tidx() { int t = __builtin_amdgcn_workitem_id_x(); asm volatile("" : "+v"(t)); return t; }
__device__ __forceinline__ void gbar(unsigned* cnt, unsigned target) {
  asm volatile("s_waitcnt vmcnt(0) lgkmcnt(0)" ::: "memory");
  __syncthreads();
  if (tidx() == 0) {
    __builtin_amdgcn_fence(__ATOMIC_RELEASE, "agent");
    asm volatile("s_waitcnt vmcnt(0)" ::: "memory");
    __hip_atomic_fetch_add(cnt, 1u, __ATOMIC_RELAXED, __HIP_MEMORY_SCOPE_AGENT);
    while (__hip_atomic_load(cnt, __ATOMIC_RELAXED, __HIP_MEMORY_SCOPE_AGENT) < target) __builtin_amdgcn_s_sleep(1);
    __builtin_amdgcn_fence(__ATOMIC_ACQUIRE, "agent");
    asm volatile("s_waitcnt vmcnt(0)" ::: "memory");
  }
  __syncthreads();
}
#define XB_XCNT(j) (256 + 64 * (j))
#define XB_XSUB(j) (1280 + 64 * (j))
#define XB_XGEN(j) (2304 + 64 * (j))
#define XB_TOP 3328
#define XB_TOPGEN 3392
#define XB_SLOT(b) (4096 + 2 * (b))
__device__ __forceinline__ unsigned xb_ld(unsigned* p) { return __hip_atomic_load(p, __ATOMIC_RELAXED, __HIP_MEMORY_SCOPE_AGENT); }
__device__ __forceinline__ unsigned xb_add(unsigned* p, unsigned v) { return __hip_atomic_fetch_add(p, v, __ATOMIC_RELAXED, __HIP_MEMORY_SCOPE_AGENT); }
__device__ __forceinline__ unsigned xb_xcc_id() { return (unsigned)__builtin_amdgcn_s_getreg((3 << 11) | 20) & 0xFu; }
__device__ __forceinline__ void gbar_xcd(unsigned* bar) {
  asm volatile("s_waitcnt vmcnt(0) lgkmcnt(0)" ::: "memory");
  __syncthreads();
  if (tidx() == 0) {
    const unsigned x = xb_xcc_id();
    const unsigned nloc = xb_ld(&bar[XB_SLOT(blockIdx.x)]), nx = xb_ld(&bar[XB_SLOT(blockIdx.x) + 1]);
    const unsigned old = xb_add(&bar[XB_XSUB(x)], 1u);
    const unsigned gen = old / nloc;
    if (old + 1u == (gen + 1u) * nloc) {
      __builtin_amdgcn_fence(__ATOMIC_RELEASE, "agent");
      asm volatile("s_waitcnt vmcnt(0)" ::: "memory");
      const unsigned og = xb_add(&bar[XB_TOP], 1u);
      const unsigned tg = og / nx;
      if (og + 1u == (tg + 1u) * nx) xb_add(&bar[XB_TOPGEN], 1u);
      else while (xb_ld(&bar[XB_TOPGEN]) == tg) __builtin_amdgcn_s_sleep(1);
      __builtin_amdgcn_fence(__ATOMIC_ACQUIRE, "agent");
      xb_add(&bar[XB_XGEN(x)], 1u);
      asm volatile("s_waitcnt vmcnt(0)" ::: "memory");
    } else {
      while (xb_ld(&bar[XB_XGEN(x)]) == gen) __builtin_amdgcn_s_sleep(1);
      __builtin_amdgcn_fence(__ATOMIC_ACQUIRE, "agent");
      asm volatile("s_waitcnt vmcnt(0)" ::: "memory");
    }
  }
  __syncthreads();
}
__device__ __forceinline__ float dpp_sum16(float v) {
  v += __int_as_float(__builtin_amdgcn_update_dpp(0, __float_as_int(v), 0xB1, 0xF, 0xF, true));
  v += __int_as_float(__builtin_amdgcn_update_dpp(0, __float_as_int(v), 0x4E, 0xF, 0xF, true));
  v += __int_as_float(__builtin_amdgcn_update_dpp(0, __float_as_int(v), 0x141, 0xF, 0xF, true));
  v += __int_as_float(__builtin_amdgcn_update_dpp(0, __float_as_int(v), 0x140, 0xF, 0xF, true));
  return v;
}
__device__ __forceinline__ float bf2f(u16 u) { return __uint_as_float(((unsigned)u) << 16); }
__device__ __forceinline__ u16 f2bf(float f) { __bf16 r = (__bf16)f; return *(u16*)&r; }
typedef __attribute__((ext_vector_type(2))) float f2_t;
typedef __attribute__((ext_vector_type(2))) __bf16 b2_t;
__device__ __forceinline__ unsigned pack2(float a, float b) { f2_t v = {a, b}; b2_t r = __builtin_convertvector(v, b2_t); return *(unsigned*)&r; }
__device__ __forceinline__ float sigmoidf_(float x) { return 1.f / (1.f + __expf(-x)); }
__device__ __forceinline__ float siluf_(float x) { return x / (1.f + __expf(-x)); }
__device__ __forceinline__ float geluf_(float x) { float u = 0.7978845608028654f * (x + 0.044715f * x * x * x); return x / (1.f + __expf(-2.f * u)); }
__device__ __forceinline__ float tanhf_(float x) { return 1.f - 2.f / (1.f + __expf(2.f * x)); }
__device__ __forceinline__ float wave_sum(float v) {
#pragma unroll
  for (int o = 32; o >= 1; o >>= 1) v += __shfl_xor(v, o);
  return v;
}
__device__ __forceinline__ f32x4 mfma16(bf16x8 a, bf16x8 b, f32x4 c) { return __builtin_amdgcn_mfma_f32_16x16x32_bf16(a, b, c, 0, 0, 0); }

__device__ __forceinline__ void conv_w(const float* src, int ld, int K, u16* dst, int NR, int nvalid, int coff, int kind, char* smem, int kvalid = 1 << 30) {
  float* tl = (float*)smem;
  const int tid = tidx();
  const int ktn = K >> 6, ntile = (NR >> 6) * ktn;
  for (int tix = blockIdx.x; tix < ntile; tix += gridDim.x) {
    const int R0 = (tix / ktn) << 6, k0 = (tix % ktn) << 6;
    const int c = tid & 63, kq = tid >> 6;
    const int R = R0 + c;
    int sc; bool ok;
    if (kind == 0) { sc = coff + R; ok = R < nvalid; }
    else { int ntl = R >> 7, w = (R >> 6) & 1, n = (R >> 4) & 3, r = R & 15; sc = ((n >= 2) ? DFF : 0) + ntl * 64 + w * 32 + (n & 1) * 16 + r; ok = true; }
#pragma unroll 4
    for (int i = 0; i < 16; ++i) {
      int k = k0 + kq * 16 + i;
      tl[c * 65 + kq * 16 + i] = (ok && k < kvalid) ? src[(size_t)k * ld + sc] : 0.f;
    }
    __syncthreads();
    {
      const int r = tid >> 2, ks = tid & 3;
      const float* s = tl + r * 65 + ks * 16;
      uint4 o0, o1;
      o0.x = pack2(s[0], s[1]); o0.y = pack2(s[2], s[3]); o0.z = pack2(s[4], s[5]); o0.w = pack2(s[6], s[7]);
      o1.x = pack2(s[8], s[9]); o1.y = pack2(s[10], s[11]); o1.z = pack2(s[12], s[13]); o1.w = pack2(s[14], s[15]);
      uint4* dp = (uint4*)(dst + (size_t)(R0 + r) * K + k0 + ks * 16);
      dp[0] = o0; dp[1] = o1;
    }
    __syncthreads();
  }
}

__device__ __forceinline__ void conv_ffn(const Params& p, int l, int f, char* smem) {
  conv_w(p.in[6] + (size_t)(l * 2 + f) * D * (2 * DFF), 2 * DFF, D, (u16*)(p.ws + OFF_WIN), 5632, 5632, 0, 1, smem);
  conv_w(p.in[7] + (size_t)(l * 2 + f) * DFF * D, D, DFF, (u16*)(p.ws + OFF_WOUT), 1024, 1024, 0, 0, smem);
}
__device__ __forceinline__ void conv_mix(const Params& p, int l, char* smem) {
  const float* mw = p.in[8] + (size_t)l * D * MIXC;
  conv_w(mw, MIXC, D, (u16*)(p.ws + OFF_WMIX), 4224, MIXN, 0, 0, smem);
  conv_w(mw, MIXC, D, (u16*)(p.ws + OFF_WG), 3072, 3072, MIXN, 0, smem);
  for (int i = 0; i < 3; ++i)
    conv_w(p.in[9] + (size_t)(l * 3 + i) * 512 * D, D, 512, (u16*)(p.ws + OFF_WB) + (size_t)i * 1024 * 512, 1024, 1024, 0, 0, smem);
  conv_w(p.in[10] + (size_t)l * D * D, D, D, (u16*)(p.ws + OFF_WO), 1024, 1024, 0, 0, smem);
  conv_w(p.in[11] + (size_t)l * 2048 * 256, 256, 2048, (u16*)(p.ws + OFF_W1), 256, 256, 0, 0, smem);
  conv_w(p.in[14] + (size_t)l * 2048 * 256, 256, 2048, (u16*)(p.ws + OFF_W1) + (size_t)256 * 2048, 256, 256, 0, 0, smem);
  u16* WL = (u16*)(p.ws + OFF_WL);
  conv_w(p.in[23] + (size_t)l * 64 * 512, 512, 64, WL + WL_W2, 512, 512, 0, 0, smem);
  conv_w(p.in[25] + (size_t)l * 64 * 512, 512, 64, WL + WL_A2, 512, 512, 0, 0, smem);
  conv_w(p.in[26] + (size_t)l * 128 * 512, 512, 128, WL + WL_G2, 512, 512, 0, 0, smem);
  if (l > 0) {
    conv_w(p.in[33], 32, 512, WL + WL_V1, 64, 32, 0, 0, smem);
    conv_w(p.in[34], 512, 64, WL + WL_V2, 512, 512, 0, 0, smem, 32);
  }
}

__device__ __forceinline__ void phase_mod(const Params& p, char* smem) {
  float* cond = (float*)smem;
  float* red = cond + 8192;
  const int tid = tidx();
  float* MOD = (float*)(p.ws + OFF_MOD);
  for (int item = blockIdx.x; item < 288; item += gridDim.x) {
    for (int e = tid; e < 8192; e += 256) cond[e] = siluf_(p.in[1][e]);
    __syncthreads();
    const int l = item / 144, n0 = (item % 144) * 64, col = n0 + (tid & 63), kq = tid >> 6;
    float acc[8];
#pragma unroll
    for (int b = 0; b < 8; ++b) acc[b] = 0.f;
    const float* w = p.in[2] + (size_t)l * D * 9216 + col;
#pragma unroll 4
    for (int k = kq * 256; k < kq * 256 + 256; ++k) {
      float wv = w[(size_t)k * 9216];
#pragma unroll
      for (int b = 0; b < 8; ++b) acc[b] += cond[b * 1024 + k] * wv;
    }
#pragma unroll
    for (int b = 0; b < 8; ++b) red[(kq * 8 + b) * 64 + (tid & 63)] = acc[b];
    __syncthreads();
    for (int e = tid; e < 512; e += 256) {
      int b = e >> 6, c = e & 63;
      float s = red[(0 * 8 + b) * 64 + c] + red[(1 * 8 + b) * 64 + c] + red[(2 * 8 + b) * 64 + c] + red[(3 * 8 + b) * 64 + c];
      MOD[(size_t)(l * 8 + b) * 9216 + n0 + c] = s + p.in[3][(size_t)l * 9216 + n0 + c];
    }
    __syncthreads();
  }
}

__device__ __forceinline__ void phase_norm(const float* xin, float* xout, const u16* y, const float* postg, const float* gate, float wgt,
                           const float* preg, const float* shift, const float* scale, u16* h) {
  const int lane = tidx() & 63, wid = tidx() >> 6;
  for (int row = blockIdx.x * 4 + wid; row < T; row += gridDim.x * 4) {
    const int b = row >> 12;
    float4 xv[4];
#pragma unroll
    for (int i = 0; i < 4; ++i) xv[i] = *(const float4*)(xin + (size_t)row * D + i * 256 + lane * 4);
    if (y) {
      float yv[4][4]; float ss = 0.f;
#pragma unroll
      for (int i = 0; i < 4; ++i) {
        uint2 u = *(const uint2*)(y + (size_t)row * D + i * 256 + lane * 4);
        yv[i][0] = bf2f((u16)(u.x & 0xffff)); yv[i][1] = bf2f((u16)(u.x >> 16));
        yv[i][2] = bf2f((u16)(u.y & 0xffff)); yv[i][3] = bf2f((u16)(u.y >> 16));
        ss += yv[i][0] * yv[i][0] + yv[i][1] * yv[i][1] + yv[i][2] * yv[i][2] + yv[i][3] * yv[i][3];
      }
      ss = wave_sum(ss);
      const float rs = rsqrtf(ss * (1.f / 1024.f) + 1e-6f) * wgt;
#pragma unroll
      for (int i = 0; i < 4; ++i) {
        const int c = i * 256 + lane * 4;
        float4 g = *(const float4*)(gate + (size_t)b * 9216 + c);
        float4 pg = *(const float4*)(postg + c);
        xv[i].x += g.x * yv[i][0] * rs * pg.x; xv[i].y += g.y * yv[i][1] * rs * pg.y;
        xv[i].z += g.z * yv[i][2] * rs * pg.z; xv[i].w += g.w * yv[i][3] * rs * pg.w;
      }
    }
    if (xout) {
#pragma unroll
      for (int i = 0; i < 4; ++i) *(float4*)(xout + (size_t)row * D + i * 256 + lane * 4) = xv[i];
    }
    if (h) {
      float ss = 0.f;
#pragma unroll
      for (int i = 0; i < 4; ++i) ss += xv[i].x * xv[i].x + xv[i].y * xv[i].y + xv[i].z * xv[i].z + xv[i].w * xv[i].w;
      ss = wave_sum(ss);
      const float rs = rsqrtf(ss * (1.f / 1024.f) + 1e-6f);
#pragma unroll
      for (int i = 0; i < 4; ++i) {
        const int c = i * 256 + lane * 4;
        float4 pg = *(const float4*)(preg + c);
        float4 sh = *(const float4*)(shift + (size_t)b * 9216 + c);
        float4 sc = *(const float4*)(scale + (size_t)b * 9216 + c);
        uint2 o;
        o.x = pack2(xv[i].x * rs * pg.x * (1.f + sc.x) + sh.x, xv[i].y * rs * pg.y * (1.f + sc.y) + sh.y);
        o.y = pack2(xv[i].z * rs * pg.z * (1.f + sc.z) + sh.z, xv[i].w * rs * pg.w * (1.f + sc.w) + sh.w);
        *(uint2*)(h + (size_t)row * D + c) = o;
      }
    }
  }
}

template <int NS, class FA, class FB>
__device__ __forceinline__ void gemm_loop(f32x4 (&acc)[4][NS], const FA& fa, const FB& fb, int K, u16* sm) {
  constexpr int BN = 32 * NS;
  constexpr int NBV = BN / 32;
  const int tid = tidx(), lane = tid & 63, wid = tid >> 6, wr = wid >> 1, wc = wid & 1, fr = lane & 15, fq = lane >> 4;
  u16* As = sm; u16* Bs = sm + 2 * 128 * 64;
  uint4 ra0[4], rb0[NBV], ra1[4], rb1[NBV];
  const int nt = K >> 6;
  const int lrow = tid >> 3, lk = (tid & 7) * 8;
  const int lsw = lrow * 64 + (((tid & 7) ^ ((lrow >> 1) & 7)) << 3);
  const int c0 = (fq ^ ((fr >> 1) & 7)) << 3, c1 = c0 ^ 32;
#define G_LOAD(RA, RB, KT) { const int kb_ = (KT) << 6; \
    _Pragma("unroll") for (int i = 0; i < 4; ++i) RA[i] = fa(lrow + 32 * i, kb_ + lk); \
    _Pragma("unroll") for (int i = 0; i < NBV; ++i) RB[i] = fb(lrow + 32 * i, kb_ + lk); }
#define G_STORE(RA, RB, BUF) { u16* Aw_ = As + (BUF) * 128 * 64 + lsw; u16* Bw_ = Bs + (BUF) * BN * 64 + lsw; \
    _Pragma("unroll") for (int i = 0; i < 4; ++i) *(uint4*)(Aw_ + i * 32 * 64) = RA[i]; \
    _Pragma("unroll") for (int i = 0; i < NBV; ++i) *(uint4*)(Bw_ + i * 32 * 64) = RB[i]; }
#define G_COMPUTE(BUF) { const u16* Ab = As + (BUF) * 128 * 64 + (wr * 64 + fr) * 64; \
    const u16* Bb = Bs + (BUF) * BN * 64 + (wc * 16 * NS + fr) * 64; \
    _Pragma("unroll") for (int ks = 0; ks < 2; ++ks) { bf16x8 a[4], b[NS]; const int co = ks ? c1 : c0; \
      _Pragma("unroll") for (int m = 0; m < 4; ++m) a[m] = *(const bf16x8*)(Ab + m * 16 * 64 + co); \
      _Pragma("unroll") for (int n = 0; n < NS; ++n) b[n] = *(const bf16x8*)(Bb + n * 16 * 64 + co); \
      __builtin_amdgcn_s_setprio(1); \
      _Pragma("unroll") for (int m = 0; m < 4; ++m) _Pragma("unroll") for (int n = 0; n < NS; ++n) acc[m][n] = mfma16(a[m], b[n], acc[m][n]); \
      __builtin_amdgcn_s_setprio(0); } }
  G_LOAD(ra0, rb0, 0)
  if (nt > 1) G_LOAD(ra1, rb1, 1)
  G_STORE(ra0, rb0, 0)
  __syncthreads();
#pragma unroll 1
  for (int kt = 0; kt < nt; kt += 2) {
    if (kt + 2 < nt) G_LOAD(ra0, rb0, kt + 2)
    G_COMPUTE(0)
    if (kt + 1 < nt) G_STORE(ra1, rb1, 1)
    __syncthreads();
    if (kt + 1 >= nt) break;
    if (kt + 3 < nt) G_LOAD(ra1, rb1, kt + 3)
    G_COMPUTE(1)
    if (kt + 2 < nt) G_STORE(ra0, rb0, 0)
    __syncthreads();
  }
#undef G_LOAD
#undef G_STORE
#undef G_COMPUTE
}

template <int NS>
__device__ __forceinline__ void gemm_loop_dma(f32x4 (&acc)[4][NS], const u16* Ab, int lda, const u16* Bb, int ldb, int K, u16* sm) {
  constexpr int BN = 32 * NS;
  constexpr int NBV = BN / 32;
  const int tid = tidx(), lane = tid & 63, wid = tid >> 6, wr = wid >> 1, wc = wid & 1, fr = lane & 15, fq = lane >> 4;
  u16* As = sm; u16* Bs = sm + 2 * 128 * 64;
  const int nt = K >> 6;
  const int lrow = tid >> 3;
  const int gk = (((tid & 7) ^ ((lrow >> 1) & 7)) << 3);
  const int c0 = (fq ^ ((fr >> 1) & 7)) << 3, c1 = c0 ^ 32;
  const u16* ga = Ab + (size_t)lrow * lda + gk;
  const u16* gb = Bb + (size_t)lrow * ldb + gk;
#define D_ISSUE(KT, BUF) { const int kb_ = (KT) << 6; \
    _Pragma("unroll") for (int i = 0; i < 4; ++i) \
      __builtin_amdgcn_global_load_lds((const unsigned*)(ga + (size_t)(32 * i) * lda + kb_), (unsigned*)(As + (BUF) * 128 * 64 + (tid + 256 * i) * 8), 16, 0, 0); \
    _Pragma("unroll") for (int i = 0; i < NBV; ++i) \
      __builtin_amdgcn_global_load_lds((const unsigned*)(gb + (size_t)(32 * i) * ldb + kb_), (unsigned*)(Bs + (BUF) * BN * 64 + (tid + 256 * i) * 8), 16, 0, 0); }
#define D_COMPUTE(BUF) { const u16* Ap = As + (BUF) * 128 * 64 + (wr * 64 + fr) * 64; \
    const u16* Bp = Bs + (BUF) * BN * 64 + (wc * 16 * NS + fr) * 64; \
    _Pragma("unroll") for (int ks = 0; ks < 2; ++ks) { bf16x8 a[4], b[NS]; const int co = ks ? c1 : c0; \
      _Pragma("unroll") for (int m = 0; m < 4; ++m) a[m] = *(const bf16x8*)(Ap + m * 16 * 64 + co); \
      _Pragma("unroll") for (int n = 0; n < NS; ++n) b[n] = *(const bf16x8*)(Bp + n * 16 * 64 + co); \
      __builtin_amdgcn_s_setprio(1); \
      _Pragma("unroll") for (int m = 0; m < 4; ++m) _Pragma("unroll") for (int n = 0; n < NS; ++n) acc[m][n] = mfma16(a[m], b[n], acc[m][n]); \
      __builtin_amdgcn_s_setprio(0); } }
  D_ISSUE(0, 0)
#pragma unroll 1
  for (int kt = 0; kt < nt; kt += 2) {
    __syncthreads();
    if (kt + 1 < nt) D_ISSUE(kt + 1, 1)
    D_COMPUTE(0)
    if (kt + 1 >= nt) break;
    __syncthreads();
    if (kt + 2 < nt) D_ISSUE(kt + 2, 0)
    D_COMPUTE(1)
  }
  __syncthreads();
#undef D_ISSUE
#undef D_COMPUTE
}

__device__ __forceinline__ bool tile_map(int it, int NT, int& mt, int& nt) {
  const int g = gridDim.x;
  if ((g & 7) == 0) {
    const int xcd = blockIdx.x & 7, bx = blockIdx.x >> 3, nbx = g >> 3;
    const int lid = bx + it * nbx;
    if (lid >= 32 * NT) return false;
    const int grp = lid / (8 * NT), rem = lid - grp * 8 * NT;
    nt = rem >> 3; mt = xcd * 32 + grp * 8 + (rem & 7);
    return true;
  } else {
    const int id = blockIdx.x + it * g;
    if (id >= 256 * NT) return false;
    nt = id % NT; mt = id / NT;
    return true;
  }
}

#define ZERO_ACC(acc, NSV) _Pragma("unroll") for (int m_ = 0; m_ < 4; ++m_) _Pragma("unroll") for (int n_ = 0; n_ < NSV; ++n_) acc[m_][n_] = f32x4{0.f, 0.f, 0.f, 0.f};

__device__ __forceinline__ void phase_ffn_in(const Params& p, char* smem) {
  const u16* H = (const u16*)(p.ws + OFF_H); const u16* W = (const u16*)(p.ws + OFF_WIN); u16* ACT = (u16*)(p.ws + OFF_ACT);
  const int lane = tidx() & 63, wid = tidx() >> 6, wr = wid >> 1, wc = wid & 1, fr = lane & 15, fq = lane >> 4;
  int mt, nt;
  for (int it = 0; tile_map(it, 44, mt, nt); ++it) {
    const int m0 = mt * 128, n0 = nt * 128;
    f32x4 acc[4][4]; ZERO_ACC(acc, 4)
    gemm_loop_dma<4>(acc, H + (size_t)m0 * 1024, 1024, W + (size_t)n0 * 1024, 1024, 1024, (u16*)smem);
#pragma unroll
    for (int m = 0; m < 4; ++m)
#pragma unroll
      for (int n = 0; n < 2; ++n) {
        const int col = nt * 64 + wc * 32 + n * 16 + fr;
        const int r0 = m0 + wr * 64 + m * 16 + fq * 4;
#pragma unroll
        for (int j = 0; j < 4; ++j) ACT[(size_t)(r0 + j) * DFF + col] = f2bf(siluf_(acc[m][n][j]) * acc[m][n + 2][j]);
      }
  }
}

__device__ __forceinline__ void phase_gemm_plain(const u16* A, int lda, const u16* Bt, int K, u16* C, char* smem) {
  const int lane = tidx() & 63, wid = tidx() >> 6, wr = wid >> 1, wc = wid & 1, fr = lane & 15, fq = lane >> 4;
  int mt, nt;
  for (int it = 0; tile_map(it, 8, mt, nt); ++it) {
    const int m0 = mt * 128, n0 = nt * 128;
    f32x4 acc[4][4]; ZERO_ACC(acc, 4)
    gemm_loop_dma<4>(acc, A + (size_t)m0 * lda, lda, Bt + (size_t)n0 * K, K, K, (u16*)smem);
#pragma unroll
    for (int m = 0; m < 4; ++m)
#pragma unroll
      for (int n = 0; n < 4; ++n) {
        const int col = n0 + wc * 64 + n * 16 + fr;
        const int r0 = m0 + wr * 64 + m * 16 + fq * 4;
#pragma unroll
        for (int j = 0; j < 4; ++j) C[(size_t)(r0 + j) * 1024 + col] = f2bf(acc[m][n][j]);
      }
  }
}

__device__ __forceinline__ void phase_inproj(const Params& p, char* smem) {
  const u16* H = (const u16*)(p.ws + OFF_H); const u16* W = (const u16*)(p.ws + OFF_WMIX);
  u16* P1 = (u16*)(p.ws + OFF_P1); u16* P2 = (u16*)(p.ws + OFF_P2); u16* VT = (u16*)(p.ws + OFF_VT); u16* PB = (u16*)(p.ws + OFF_PB);
  const int lane = tidx() & 63, wid = tidx() >> 6, wr = wid >> 1, wc = wid & 1, fr = lane & 15, fq = lane >> 4;
  int mt, nt;
  for (int it = 0; tile_map(it, 33, mt, nt); ++it) {
    const int m0 = mt * 128, n0 = nt * 128;
    f32x4 acc[4][4]; ZERO_ACC(acc, 4)
    gemm_loop_dma<4>(acc, H + (size_t)m0 * 1024, 1024, W + (size_t)n0 * 1024, 1024, 1024, (u16*)smem);
#pragma unroll
    for (int m = 0; m < 4; ++m)
#pragma unroll
      for (int nn = 0; nn < 4; ++nn) {
        const int n = n0 + wc * 64 + nn * 16 + fr;
        if (n >= MIXN) continue;
        const int r0 = m0 + wr * 64 + m * 16 + fq * 4;
        f32x4 v = acc[m][nn];
        if ((n >= 896 && n < 1024) || (n >= 1152 && n < 1280)) {
          const int which = (n >= 1152) ? 1 : 0;
          const int gd = n - (which ? 1152 : 896);
          const int b = r0 >> 12, t = r0 & 4095;
          uint2 o; o.x = pack2(v[0], v[1]); o.y = pack2(v[2], v[3]);
          *(uint2*)(VT + ((size_t)((which * 8 + b) * 128 + gd)) * 4096 + (t & ~31) + 8 * fq + 4 * (m & 1)) = o;
        } else if (n < 1304) {
          const int pc = (n < 896) ? n : ((n < 1152) ? n - 128 : n - 256);
          if (n < 512) { const float qs = 0.125f * 1.4426950408889634f; v[0] *= qs; v[1] *= qs; v[2] *= qs; v[3] *= qs; }
          if (n >= 1280) { v[0] = sigmoidf_(v[0]); v[1] = sigmoidf_(v[1]); v[2] = sigmoidf_(v[2]); v[3] = sigmoidf_(v[3]); }
#pragma unroll
          for (int j = 0; j < 4; ++j) P1[(size_t)(r0 + j) * PS1 + pc] = f2bf(v[j]);
        } else if (n < 2328) {
#pragma unroll
          for (int j = 0; j < 4; ++j) P1[(size_t)(r0 + j) * PS1 + (n - 256)] = f2bf(geluf_(v[j]));
        } else {
          const int pc = n - 2328;
#pragma unroll
          for (int j = 0; j < 4; ++j) P2[(size_t)(r0 + j) * PS2 + pc] = f2bf(v[j]);
          if ((m & 1) && fq == 3) PB[(size_t)((r0 + 3) >> 5) * 1792 + pc] = f2bf(v[3]);
        }
      }
  }
}

__device__ __forceinline__ void phase_merge(const Params& p, char* smem) {
  const u16* H2 = (const u16*)(p.ws + OFF_H); const u16* WG = (const u16*)(p.ws + OFF_WG); const u16* WB = (const u16*)(p.ws + OFF_WB);
  const u16* P1 = (const u16*)(p.ws + OFF_P1); u16* MG = (u16*)(p.ws + OFF_MERGED);
  const int lane = tidx() & 63, wid = tidx() >> 6, wr = wid >> 1, wc = wid & 1, fr = lane & 15, fq = lane >> 4;
  int mt, nt;
  for (int it = 0; tile_map(it, 16, mt, nt); ++it) {
    const int m0 = mt * 128, n0 = nt * 64;
    f32x4 tot[4][2]; ZERO_ACC(tot, 2)
#pragma unroll 1
    for (int i = 0; i < 3; ++i) {
      unsigned gpk[4][2][2];
      {
        f32x4 ag[4][2]; ZERO_ACC(ag, 2)
        gemm_loop_dma<2>(ag, H2 + (size_t)m0 * 1024, 1024, WG + (size_t)(i * 1024 + n0) * 1024, 1024, 1024, (u16*)smem);
#pragma unroll
        for (int m = 0; m < 4; ++m)
#pragma unroll
          for (int n = 0; n < 2; ++n) {
            gpk[m][n][0] = pack2(sigmoidf_(ag[m][n][0]), sigmoidf_(ag[m][n][1]));
            gpk[m][n][1] = pack2(sigmoidf_(ag[m][n][2]), sigmoidf_(ag[m][n][3]));
          }
      }
      f32x4 ay[4][2]; ZERO_ACC(ay, 2)
      const u16* ya = (i == 0) ? P1 : ((i == 1) ? P1 + 1048 : P1 + 1560);
      const int lda = PS1;
      const u16* wb = WB + (size_t)i * 1024 * 512;
      gemm_loop_dma<2>(ay, ya + (size_t)m0 * lda, lda, wb + (size_t)n0 * 512, 512, 512, (u16*)smem);
#pragma unroll
      for (int m = 0; m < 4; ++m)
#pragma unroll
        for (int n = 0; n < 2; ++n) {
          tot[m][n][0] += bf2f((u16)(gpk[m][n][0] & 0xffff)) * ay[m][n][0];
          tot[m][n][1] += bf2f((u16)(gpk[m][n][0] >> 16)) * ay[m][n][1];
          tot[m][n][2] += bf2f((u16)(gpk[m][n][1] & 0xffff)) * ay[m][n][2];
          tot[m][n][3] += bf2f((u16)(gpk[m][n][1] >> 16)) * ay[m][n][3];
        }
    }
#pragma unroll
    for (int m = 0; m < 4; ++m)
#pragma unroll
      for (int n = 0; n < 2; ++n) {
        const int col = n0 + wc * 32 + n * 16 + fr;
        const int r0 = m0 + wr * 64 + m * 16 + fq * 4;
#pragma unroll
        for (int j = 0; j < 4; ++j) MG[(size_t)(r0 + j) * 1024 + col] = f2bf(tot[m][n][j]);
      }
  }
}

__device__ __forceinline__ void phase_cmp1(const Params& p, int l, char* smem) {
  const u16* P1 = (const u16*)(p.ws + OFF_P1); const u16* W1 = (const u16*)(p.ws + OFF_W1); u16* HID = (u16*)(p.ws + OFF_HID);
  const int lane = tidx() & 63, wid = tidx() >> 6, wr = wid >> 1, wc = wid & 1, fr = lane & 15, fq = lane >> 4;
  for (int tix = blockIdx.x; tix < 128; tix += gridDim.x) {
    const int which = tix >> 6, mt = (tix >> 1) & 31, nt = tix & 1;
    const int m0 = mt * 128, n0 = nt * 128;
    const float* pe = (which ? p.in[16] : p.in[13]) + (size_t)l * 2048;
    const u16* w1 = W1 + (size_t)which * 256 * 2048;
    const int cbase = 512 + which * 128;
    f32x4 acc[4][4]; ZERO_ACC(acc, 4)
    auto fa = [&](int r, int k) {
      const int row = m0 + r; const int g = row & 1, n = (row >> 1) & 255, b = row >> 9;
      uint4 o = make_uint4(0, 0, 0, 0);
      if (n < 255) {
        const int lpos = k >> 6, d = k & 63;
        uint4 raw = *(const uint4*)(P1 + (size_t)(b * 4096 + 16 * n + lpos) * PS1 + cbase + g * 64 + d);
        const float* pp = pe + lpos * 64 + d;
        float4 e0 = *(const float4*)pp, e1 = *(const float4*)(pp + 4);
        o.x = pack2(bf2f((u16)(raw.x & 0xffff)) + e0.x, bf2f((u16)(raw.x >> 16)) + e0.y);
        o.y = pack2(bf2f((u16)(raw.y & 0xffff)) + e0.z, bf2f((u16)(raw.y >> 16)) + e0.w);
        o.z = pack2(bf2f((u16)(raw.z & 0xffff)) + e1.x, bf2f((u16)(raw.z >> 16)) + e1.y);
        o.w = pack2(bf2f((u16)(raw.w & 0xffff)) + e1.z, bf2f((u16)(raw.w >> 16)) + e1.w);
      }
      return o;
    };
    auto fb = [&](int r, int k) { return *(const uint4*)(w1 + (size_t)(n0 + r) * 2048 + k); };
    gemm_loop<4>(acc, fa, fb, 2048, (u16*)smem);
#pragma unroll
    for (int m = 0; m < 4; ++m)
#pragma unroll
      for (int n = 0; n < 4; ++n) {
        const int col = n0 + wc * 64 + n * 16 + fr;
        const int r0 = m0 + wr * 64 + m * 16 + fq * 4;
#pragma unroll
        for (int j = 0; j < 4; ++j) HID[((size_t)which * 4096 + r0 + j) * 256 + col] = f2bf(siluf_(acc[m][n][j]));
      }
  }
}

__device__ __forceinline__ void phase_cmp2(const Params& p, int l) {
  const u16* HID = (const u16*)(p.ws + OFF_HID); u16* KC = (u16*)(p.ws + OFF_KC); u16* VC = (u16*)(p.ws + OFF_VC);
  const int total = 2 * 4096 * 64;
  for (int idx = blockIdx.x * 256 + tidx(); idx < total; idx += gridDim.x * 256) {
    const int d = idx & 63, row = (idx >> 6) & 4095, which = idx >> 18;
    const float* w2 = (which ? p.in[15] : p.in[12]) + (size_t)l * 256 * 64;
    const u16* hr = HID + ((size_t)which * 4096 + row) * 256;
    float acc = 0.f;
#pragma unroll 8
    for (int j = 0; j < 256; ++j) acc += bf2f(hr[j]) * w2[j * 64 + d];
    const int g = row & 1, n = (row >> 1) & 255, b = row >> 9;
    if (which == 0) KC[((size_t)(b * 2 + g) * 256 + n) * 64 + d] = f2bf(acc);
    else {
      const int u = n & 31; const int pp = 8 * ((u >> 2) & 3) + 4 * (u >> 4) + (u & 3);
      VC[((size_t)(b * 2 + g) * 64 + d) * 256 + (n & ~31) + pp] = f2bf(acc);
    }
  }
}

__device__ __forceinline__ void phase_sgu(const Params& p, int l, char* smem) {
  u16* P1 = (u16*)(p.ws + OFF_P1);
  u16* Wt = (u16*)smem;
  u16* Vt = Wt + 128 * 136;
  float* st = (float*)(Vt + 128 * 136);
  const int tid = tidx(), lane = tid & 63, wid = tid >> 6, wr = wid >> 1, wc = wid & 1, fr = lane & 15, fq = lane >> 4;
  const float* lng = p.in[17] + (size_t)l * 512; const float* lnb = p.in[18] + (size_t)l * 512;
  for (int item = blockIdx.x; item < 1024; item += gridDim.x) {
    const int ci = item >> 2, gi = item & 3;
    const int tok0 = ci * 128;
#pragma unroll 1
    for (int r0 = wid * 32; r0 < wid * 32 + 32; r0 += 8) {
      uint4 raw[8];
#pragma unroll
      for (int u = 0; u < 8; ++u) raw[u] = *(const uint4*)(P1 + (size_t)(tok0 + r0 + u) * PS1 + 1560 + lane * 8);
#pragma unroll
      for (int u = 0; u < 8; ++u) {
        float f[8];
        f[0] = bf2f((u16)(raw[u].x & 0xffff)); f[1] = bf2f((u16)(raw[u].x >> 16)); f[2] = bf2f((u16)(raw[u].y & 0xffff)); f[3] = bf2f((u16)(raw[u].y >> 16));
        f[4] = bf2f((u16)(raw[u].z & 0xffff)); f[5] = bf2f((u16)(raw[u].z >> 16)); f[6] = bf2f((u16)(raw[u].w & 0xffff)); f[7] = bf2f((u16)(raw[u].w >> 16));
        float s = 0.f, s2 = 0.f;
#pragma unroll
        for (int e = 0; e < 8; ++e) { s += f[e]; }
        s = wave_sum(s);
        const float mu = s * (1.f / 512.f);
#pragma unroll
        for (int e = 0; e < 8; ++e) { float dlt = f[e] - mu; s2 += dlt * dlt; }
        s2 = wave_sum(s2);
        if (lane == 0) { st[(r0 + u) * 2] = mu; st[(r0 + u) * 2 + 1] = rsqrtf(s2 * (1.f / 512.f) + 1e-5f); }
      }
    }
    const float* wsrc = p.in[19] + ((size_t)(l * 4 + gi)) * 128 * 128;
    for (int e = tid; e < 128 * 32; e += 256) {
      const int t = e >> 5, s4 = (e & 31) * 4;
      float4 w = *(const float4*)(wsrc + t * 128 + s4);
      uint2 o;
      o.x = pack2(s4 + 0 <= t ? w.x : 0.f, s4 + 1 <= t ? w.y : 0.f);
      o.y = pack2(s4 + 2 <= t ? w.z : 0.f, s4 + 3 <= t ? w.w : 0.f);
      *(uint2*)(Wt + t * 136 + s4) = o;
    }
    __syncthreads();
    for (int e = tid; e < 128 * 16; e += 256) {
      const int s = e >> 4, c8 = (e & 15) * 8;
      uint4 raw = *(const uint4*)(P1 + (size_t)(tok0 + s) * PS1 + 1560 + gi * 128 + c8);
      const float mu = st[s * 2], rs = st[s * 2 + 1];
      u16 rv[8] = {(u16)(raw.x & 0xffff), (u16)(raw.x >> 16), (u16)(raw.y & 0xffff), (u16)(raw.y >> 16), (u16)(raw.z & 0xffff), (u16)(raw.z >> 16), (u16)(raw.w & 0xffff), (u16)(raw.w >> 16)};
#pragma unroll
      for (int i = 0; i < 8; ++i) {
        const int c = gi * 128 + c8 + i;
        Vt[(c8 + i) * 136 + s] = f2bf((bf2f(rv[i]) - mu) * rs * lng[c] + lnb[c]);
      }
    }
    __syncthreads();
    f32x4 acc[4][4]; ZERO_ACC(acc, 4)
#pragma unroll 1
    for (int ks = 0; ks < 4; ++ks) {
      bf16x8 a[4], b[4];
#pragma unroll
      for (int m = 0; m < 4; ++m) a[m] = *(const bf16x8*)(Wt + (wr * 64 + m * 16 + fr) * 136 + ks * 32 + fq * 8);
#pragma unroll
      for (int n = 0; n < 4; ++n) b[n] = *(const bf16x8*)(Vt + (wc * 64 + n * 16 + fr) * 136 + ks * 32 + fq * 8);
#pragma unroll
      for (int m = 0; m < 4; ++m)
#pragma unroll
        for (int n = 0; n < 4; ++n) acc[m][n] = mfma16(a[m], b[n], acc[m][n]);
    }
    const float* bs = p.in[20] + ((size_t)(l * 4 + gi)) * 128;
#pragma unroll
    for (int m = 0; m < 4; ++m)
#pragma unroll
      for (int n = 0; n < 4; ++n) {
        const int c = wc * 64 + n * 16 + fr;
#pragma unroll
        for (int j = 0; j < 4; ++j) {
          const int t = wr * 64 + m * 16 + fq * 4 + j;
          u16* up = P1 + (size_t)(tok0 + t) * PS1 + 1048 + gi * 128 + c;
          *up = f2bf(bf2f(*up) * (acc[m][n][j] + bs[t]));
        }
      }
    __syncthreads();
  }
}

__device__ __forceinline__ void phase_prep1(const Params& p, int l) {
  u16* P2 = (u16*)(p.ws + OFF_P2); const u16* PB = (const u16*)(p.ws + OFF_PB); u16* VF = (u16*)(p.ws + OFF_VFIRST);
  const float* mu = p.in[21] + (size_t)l * 1792;
  const int total = 1024 * 224;
  for (int idx = blockIdx.x * 256 + tidx(); idx < total; idx += gridDim.x * 256) {
    const int tile = idx / 224, cg8 = (idx % 224) * 8;
    const int tok0 = tile * 32;
    float m8[8];
#pragma unroll
    for (int e = 0; e < 8; ++e) m8[e] = mu[cg8 + e];
    uint4 prev = make_uint4(0, 0, 0, 0);
    if ((tok0 & 4095) != 0) prev = *(const uint4*)(PB + (size_t)(tile - 1) * 1792 + cg8);
#pragma unroll 1
    for (int r0 = 0; r0 < 32; r0 += 8) {
      uint4 cv[8];
#pragma unroll
      for (int u = 0; u < 8; ++u) cv[u] = *(const uint4*)(P2 + (size_t)(tok0 + r0 + u) * PS2 + cg8);
#pragma unroll
      for (int u = 0; u < 8; ++u) {
        const uint4 cur = cv[u];
        unsigned cu[4] = {cur.x, cur.y, cur.z, cur.w}, pu[4] = {prev.x, prev.y, prev.z, prev.w};
        float o[8];
#pragma unroll
        for (int e = 0; e < 8; ++e) {
          float c = bf2f((u16)((cu[e >> 1] >> ((e & 1) * 16)) & 0xffff));
          float pv = bf2f((u16)((pu[e >> 1] >> ((e & 1) * 16)) & 0xffff));
          float sv = c + (pv - c) * m8[e];
          if (cg8 >= 1536 && cg8 < 1600) sv = tanhf_(sv);
          else if (cg8 >= 1664) sv = sigmoidf_(sv);
          o[e] = sv;
        }
        uint4 ov; ov.x = pack2(o[0], o[1]); ov.y = pack2(o[2], o[3]); ov.z = pack2(o[4], o[5]); ov.w = pack2(o[6], o[7]);
        *(uint4*)(P2 + (size_t)(tok0 + r0 + u) * PS2 + cg8) = ov;
        if (l == 0 && cg8 >= 1024 && cg8 < 1536) *(uint4*)(VF + (size_t)(tok0 + r0 + u) * 512 + cg8 - 1024) = ov;
        prev = cur;
      }
    }
  }
}

__device__ __forceinline__ void phase_prep2(const Params& p, int l, char* smem) {
  u16* P2 = (u16*)(p.ws + OFF_P2); const u16* VF = (const u16*)(p.ws + OFF_VFIRST);
  float* twd = (float*)smem;
  float* adl = twd + 1024;
  float* vsh = adl + 1024;
  float* lv = vsh + 8192;
  const int tid = tidx();
  const float* w0 = p.in[22] + (size_t)l * 512; const float* w2 = p.in[23] + (size_t)l * 64 * 512;
  const float* a0 = p.in[24] + (size_t)l * 512; const float* a2 = p.in[25] + (size_t)l * 64 * 512;
  const float* kkp = p.in[27] + (size_t)l * 512; const float* kap = p.in[28] + (size_t)l * 512;
  for (int item = blockIdx.x; item < 2048; item += gridDim.x) {
    const int tok0 = item * 16;
    for (int e = tid; e < 2048; e += 256) {
      const int r = e >> 7, c = e & 127;
      twd[(c >> 6) * 1024 + r * 64 + (c & 63)] = bf2f(P2[(size_t)(tok0 + r) * PS2 + 1536 + c]);
    }
    if (l > 0) {
      for (int e = tid; e < 8192; e += 256) { const int r = e >> 9, c = e & 511; vsh[e] = bf2f(P2[(size_t)(tok0 + r) * PS2 + 1024 + c]); }
    }
    __syncthreads();
    if (l > 0) {
      const float* v1 = p.in[33];
      for (int e = tid; e < 512; e += 256) {
        const int r = e >> 5, j = e & 31;
        float s = 0.f;
#pragma unroll 2
        for (int c = 0; c < 512; c += 4) {
          const float4 t4 = *(const float4*)(vsh + r * 512 + c);
          s += t4.x * v1[c * 32 + j] + t4.y * v1[(c + 1) * 32 + j] + t4.z * v1[(c + 2) * 32 + j] + t4.w * v1[(c + 3) * 32 + j];
        }
        lv[r * 32 + j] = s;
      }
      __syncthreads();
    }
    {
      float aw[2][16], aa[2][16], am[2][16];
#pragma unroll
      for (int c = 0; c < 2; ++c)
#pragma unroll
        for (int r = 0; r < 16; ++r) { aw[c][r] = 0.f; aa[c][r] = 0.f; am[c][r] = 0.f; }
#pragma unroll 2
      for (int i = 0; i < 64; i += 4) {
        float wv[2][4], av[2][4];
#pragma unroll
        for (int c = 0; c < 2; ++c)
#pragma unroll
          for (int u = 0; u < 4; ++u) { wv[c][u] = w2[(i + u) * 512 + tid + c * 256]; av[c][u] = a2[(i + u) * 512 + tid + c * 256]; }
#pragma unroll
        for (int r = 0; r < 16; ++r) {
          const float4 tw = *(const float4*)(twd + r * 64 + i);
          const float4 ta = *(const float4*)(adl + r * 64 + i);
#pragma unroll
          for (int c = 0; c < 2; ++c) {
            aw[c][r] += tw.x * wv[c][0] + tw.y * wv[c][1] + tw.z * wv[c][2] + tw.w * wv[c][3];
            aa[c][r] += ta.x * av[c][0] + ta.y * av[c][1] + ta.z * av[c][2] + ta.w * av[c][3];
          }
        }
      }
      if (l > 0) {
        const float* v2 = p.in[34];
#pragma unroll 2
        for (int j = 0; j < 32; j += 4) {
          float vv[2][4];
#pragma unroll
          for (int c = 0; c < 2; ++c)
#pragma unroll
            for (int u = 0; u < 4; ++u) vv[c][u] = v2[(j + u) * 512 + tid + c * 256];
#pragma unroll
          for (int r = 0; r < 16; ++r) {
            const float4 t4 = *(const float4*)(lv + r * 32 + j);
#pragma unroll
            for (int c = 0; c < 2; ++c) am[c][r] += t4.x * vv[c][0] + t4.y * vv[c][1] + t4.z * vv[c][2] + t4.w * vv[c][3];
          }
        }
      }
#pragma unroll
      for (int c = 0; c < 2; ++c) {
        const int ch = tid + c * 256;
        const float w0v = w0[ch], a0v = a0[ch], kkv = kkp[ch], kav = kap[ch];
        const float v0v = (l > 0) ? p.in[32][ch] : 0.f;
        float kval[16];
#pragma unroll
        for (int r = 0; r < 16; ++r) kval[r] = bf2f(P2[(size_t)(tok0 + r) * PS2 + 512 + ch]);
#pragma unroll
        for (int r = 0; r < 16; ++r) {
          u16* row = P2 + (size_t)(tok0 + r) * PS2;
          const float wpre = w0v + aw[c][r];
          const float nx = -wpre;
          const float sp = fmaxf(nx, 0.f) + __logf(1.f + __expf(-fabsf(nx)));
          const float w = -sp - 0.5f;
          const float decay = __expf(-__expf(w));
          const float a = sigmoidf_(a0v + aa[c][r]);
          const float kk = kval[r] * kkv;
          const float ss = wave_sum(kk * kk);
          const float kkn = kk / fmaxf(sqrtf(ss), 1e-12f);
          row[1792 + ch] = f2bf(decay);
          row[2304 + ch] = f2bf(kkn);
          row[2816 + ch] = f2bf(kkn * a);
          row[512 + ch] = f2bf(kval[r] * (1.f + (a - 1.f) * kav));
          if (l > 0) {
            const float v = vsh[r * 512 + ch];
            const float vf = bf2f(VF[(size_t)(tok0 + r) * 512 + ch]);
            row[1024 + ch] = f2bf(v + (vf - v) * sigmoidf_(v0v + am[c][r]));
          }
        }
      }
    }
    __syncthreads();
  }
}

__device__ __forceinline__ void unpack4(uint2 u, float (&f)[4]) {
  f[0] = bf2f((u16)(u.x & 0xffff)); f[1] = bf2f((u16)(u.x >> 16)); f[2] = bf2f((u16)(u.y & 0xffff)); f[3] = bf2f((u16)(u.y >> 16));
}
__device__ __forceinline__ float quad_sum(float v) { v += __shfl_xor(v, 16); v += __shfl_xor(v, 32); return v; }

__device__ __forceinline__ void phase_prep2m(const Params& p, int l, char* smem) {
  u16* P2 = (u16*)(p.ws + OFF_P2); const u16* VF = (const u16*)(p.ws + OFF_VFIRST); const u16* WL = (const u16*)(p.ws + OFF_WL);
  u16* twl = (u16*)smem;
  u16* adl = twl + 16 * 72;
  u16* vl = adl + 16 * 72;
  const int tid = tidx(), lane = tid & 63, w = tid >> 6, fr = lane & 15, fq = lane >> 4;
  const float* w0 = p.in[22] + (size_t)l * 512; const float* a0 = p.in[24] + (size_t)l * 512;
  const float* kkp = p.in[27] + (size_t)l * 512; const float* kap = p.in[28] + (size_t)l * 512;
#pragma unroll 1
  for (int item = blockIdx.x; item < 2048; item += gridDim.x) {
    const int tok0 = item * 16;
    {
      const int r = tid >> 4, c = tid & 15;
      const uint4 v = *(const uint4*)(P2 + (size_t)(tok0 + r) * PS2 + 1536 + c * 8);
      if (c < 8) *(uint4*)(twl + r * 72 + c * 8) = v; else *(uint4*)(adl + r * 72 + (c - 8) * 8) = v;
    }
    if (l > 0) {
#pragma unroll
      for (int i = 0; i < 4; ++i) {
        const int idx = tid + 256 * i, r = idx >> 6, c = idx & 63;
        *(uint4*)(vl + r * 520 + c * 8) = *(const uint4*)(P2 + (size_t)(tok0 + r) * PS2 + 1024 + c * 8);
      }
    }
    __syncthreads();
    bf16x8 xw[2], xa[2];
#pragma unroll
    for (int ks = 0; ks < 2; ++ks) { xw[ks] = *(const bf16x8*)(twl + fr * 72 + ks * 32 + fq * 8); xa[ks] = *(const bf16x8*)(adl + fr * 72 + ks * 32 + fq * 8); }
    bf16x8 plv = {0, 0, 0, 0, 0, 0, 0, 0};
    if (l > 0) {
      f32x4 lv0 = {0.f, 0.f, 0.f, 0.f}, lv1 = {0.f, 0.f, 0.f, 0.f};
#pragma unroll 4
      for (int ks = 0; ks < 16; ++ks) {
        const bf16x8 xb = *(const bf16x8*)(vl + fr * 520 + ks * 32 + fq * 8);
        const bf16x8 a0f = *(const bf16x8*)(WL + WL_V1 + (size_t)fr * 512 + ks * 32 + fq * 8);
        const bf16x8 a1f = *(const bf16x8*)(WL + WL_V1 + (size_t)(16 + fr) * 512 + ks * 32 + fq * 8);
        lv0 = mfma16(a0f, xb, lv0); lv1 = mfma16(a1f, xb, lv1);
      }
      uint4 u; u.x = pack2(lv0[0], lv0[1]); u.y = pack2(lv0[2], lv0[3]); u.z = pack2(lv1[0], lv1[1]); u.w = pack2(lv1[2], lv1[3]);
      plv = *(bf16x8*)&u;
    }
    const size_t tok = (size_t)tok0 + fr;
    u16* row = P2 + tok * PS2;
#pragma unroll 1
    for (int hh = 0; hh < 2; ++hh) {
      f32x4 aw[4], aa[4], am[4];
#pragma unroll
      for (int m4 = 0; m4 < 4; ++m4) {
        const int chr = w * 128 + (hh * 4 + m4) * 16 + fr;
        f32x4 cw = {0.f, 0.f, 0.f, 0.f}, ca = {0.f, 0.f, 0.f, 0.f}, cm = {0.f, 0.f, 0.f, 0.f};
#pragma unroll
        for (int ks = 0; ks < 2; ++ks) {
          cw = mfma16(*(const bf16x8*)(WL + WL_W2 + (size_t)chr * 64 + ks * 32 + fq * 8), xw[ks], cw);
          ca = mfma16(*(const bf16x8*)(WL + WL_A2 + (size_t)chr * 64 + ks * 32 + fq * 8), xa[ks], ca);
        }
        if (l > 0) {
          const uint2 g0 = *(const uint2*)(WL + WL_V2 + (size_t)chr * 64 + 4 * fq);
          const uint2 g1 = *(const uint2*)(WL + WL_V2 + (size_t)chr * 64 + 16 + 4 * fq);
          uint4 u; u.x = g0.x; u.y = g0.y; u.z = g1.x; u.w = g1.y;
          cm = mfma16(*(bf16x8*)&u, plv, cm);
        }
        aw[m4] = cw; aa[m4] = ca; am[m4] = cm;
      }
      float kv[4][4], av[4][4], kk[4][4];
      float ss = 0.f;
#pragma unroll
      for (int m4 = 0; m4 < 4; ++m4) {
        const int ch0 = w * 128 + (hh * 4 + m4) * 16 + 4 * fq;
        unpack4(*(const uint2*)(row + 512 + ch0), kv[m4]);
        const float4 a0v = *(const float4*)(a0 + ch0), kkv = *(const float4*)(kkp + ch0);
        const float a0a[4] = {a0v.x, a0v.y, a0v.z, a0v.w}, kka[4] = {kkv.x, kkv.y, kkv.z, kkv.w};
#pragma unroll
        for (int j = 0; j < 4; ++j) {
          av[m4][j] = sigmoidf_(a0a[j] + aa[m4][j]);
          kk[m4][j] = kv[m4][j] * kka[j];
          ss += kk[m4][j] * kk[m4][j];
        }
      }
      ss = quad_sum(ss);
      const float rn = 1.f / fmaxf(sqrtf(ss), 1e-12f);
#pragma unroll
      for (int m4 = 0; m4 < 4; ++m4) {
        const int ch0 = w * 128 + (hh * 4 + m4) * 16 + 4 * fq;
        const float4 w0v = *(const float4*)(w0 + ch0), kav = *(const float4*)(kap + ch0);
        const float w0a[4] = {w0v.x, w0v.y, w0v.z, w0v.w}, kaa[4] = {kav.x, kav.y, kav.z, kav.w};
        float dc[4], kn[4], bb[4], kp[4];
#pragma unroll
        for (int j = 0; j < 4; ++j) {
          const float nx = -(w0a[j] + aw[m4][j]);
          const float sp = fmaxf(nx, 0.f) + __logf(1.f + __expf(-fabsf(nx)));
          dc[j] = __expf(-__expf(-sp - 0.5f));
          kn[j] = kk[m4][j] * rn;
          bb[j] = kn[j] * av[m4][j];
          kp[j] = kv[m4][j] * (1.f + (av[m4][j] - 1.f) * kaa[j]);
        }
        uint2 o;
        o.x = pack2(dc[0], dc[1]); o.y = pack2(dc[2], dc[3]); *(uint2*)(row + 1792 + ch0) = o;
        o.x = pack2(kn[0], kn[1]); o.y = pack2(kn[2], kn[3]); *(uint2*)(row + 2304 + ch0) = o;
        o.x = pack2(bb[0], bb[1]); o.y = pack2(bb[2], bb[3]); *(uint2*)(row + 2816 + ch0) = o;
        o.x = pack2(kp[0], kp[1]); o.y = pack2(kp[2], kp[3]); *(uint2*)(row + 512 + ch0) = o;
        if (l > 0) {
          float vv[4], vf[4];
          unpack4(*(const uint2*)(vl + fr * 520 + ch0), vv);
          unpack4(*(const uint2*)(VF + tok * 512 + ch0), vf);
          const float4 v0v = *(const float4*)(p.in[32] + ch0);
          const float v0a[4] = {v0v.x, v0v.y, v0v.z, v0v.w};
          float vo[4];
#pragma unroll
          for (int j = 0; j < 4; ++j) vo[j] = vv[j] + (vf[j] - vv[j]) * sigmoidf_(v0a[j] + am[m4][j]);
          o.x = pack2(vo[0], vo[1]); o.y = pack2(vo[2], vo[3]); *(uint2*)(row + 1024 + ch0) = o;
        }
      }
    }
    __syncthreads();
  }
}

__device__ __forceinline__ void phase_postm(const Params& p, int l, char* smem) {
  const u16* P2 = (const u16*)(p.ws + OFF_P2); u16* YC = (u16*)(p.ws + OFF_P1) + 1560; const u16* WL = (const u16*)(p.ws + OFF_WL);
  u16* sgl = (u16*)smem;
  const int tid = tidx(), lane = tid & 63, w = tid >> 6, fr = lane & 15, fq = lane >> 4;
  const float* rk = p.in[29] + (size_t)l * 512; const float* lg = p.in[30] + (size_t)l * 512; const float* lb = p.in[31] + (size_t)l * 512;
#pragma unroll 1
  for (int item = blockIdx.x; item < 2048; item += gridDim.x) {
    const int tok0 = item * 16;
    {
      const int r = tid >> 4, c = tid & 15;
      *(uint4*)(sgl + r * 136 + c * 8) = *(const uint4*)(P2 + (size_t)(tok0 + r) * PS2 + 1664 + c * 8);
    }
    __syncthreads();
    bf16x8 xb[4];
#pragma unroll
    for (int ks = 0; ks < 4; ++ks) xb[ks] = *(const bf16x8*)(sgl + fr * 136 + ks * 32 + fq * 8);
    const size_t tok = (size_t)tok0 + fr;
    const u16* row = P2 + tok * PS2;
    u16* yrow = YC + tok * PS1;
#pragma unroll 1
    for (int hh = 0; hh < 2; ++hh) {
      f32x4 ag[4];
#pragma unroll
      for (int m4 = 0; m4 < 4; ++m4) {
        const int chr = w * 128 + (hh * 4 + m4) * 16 + fr;
        f32x4 c = {0.f, 0.f, 0.f, 0.f};
#pragma unroll
        for (int ks = 0; ks < 4; ++ks) c = mfma16(*(const bf16x8*)(WL + WL_G2 + (size_t)chr * 128 + ks * 32 + fq * 8), xb[ks], c);
        ag[m4] = c;
      }
      float yv[4][4], vv[4][4];
      float s1 = 0.f, sb = 0.f;
#pragma unroll
      for (int m4 = 0; m4 < 4; ++m4) {
        const int ch0 = w * 128 + (hh * 4 + m4) * 16 + 4 * fq;
        float rr[4], kk[4];
        unpack4(*(const uint2*)(yrow + ch0), yv[m4]);
        unpack4(*(const uint2*)(row + ch0), rr);
        unpack4(*(const uint2*)(row + 512 + ch0), kk);
        unpack4(*(const uint2*)(row + 1024 + ch0), vv[m4]);
        const float4 rkv = *(const float4*)(rk + ch0);
        s1 += yv[m4][0] + yv[m4][1] + yv[m4][2] + yv[m4][3];
        sb += rr[0] * kk[0] * rkv.x + rr[1] * kk[1] * rkv.y + rr[2] * kk[2] * rkv.z + rr[3] * kk[3] * rkv.w;
      }
      s1 = quad_sum(s1); sb = quad_sum(sb);
      const float mean = s1 * (1.f / 64.f);
      float s2 = 0.f;
#pragma unroll
      for (int m4 = 0; m4 < 4; ++m4)
#pragma unroll
        for (int j = 0; j < 4; ++j) { const float d = yv[m4][j] - mean; s2 += d * d; }
      s2 = quad_sum(s2);
      const float rs = rsqrtf(s2 * (1.f / 64.f) + 64e-5f);
#pragma unroll
      for (int m4 = 0; m4 < 4; ++m4) {
        const int ch0 = w * 128 + (hh * 4 + m4) * 16 + 4 * fq;
        const float4 lgv = *(const float4*)(lg + ch0), lbv = *(const float4*)(lb + ch0);
        const float lga[4] = {lgv.x, lgv.y, lgv.z, lgv.w}, lba[4] = {lbv.x, lbv.y, lbv.z, lbv.w};
        float o4[4];
#pragma unroll
        for (int j = 0; j < 4; ++j) o4[j] = ((yv[m4][j] - mean) * rs * lga[j] + lba[j] + sb * vv[m4][j]) * ag[m4][j];
        uint2 o; o.x = pack2(o4[0], o4[1]); o.y = pack2(o4[2], o4[3]);
        *(uint2*)(yrow + ch0) = o;
      }
    }
    __syncthreads();
  }
}

__device__ __forceinline__ void scan_item(const Params& p, int item, char* smem) {
  const u16* P2 = (const u16*)(p.ws + OFF_P2); u16* YC = (u16*)(p.ws + OFF_P1) + 1560;
  float* vb = (float*)smem;
  float* yb = vb + 2 * 6 * 16 * 64;
  const int tid = tidx(), lane = tid & 63, wid = tid >> 6;
  const int rq = item & 3, h = (item >> 2) & 7, b = item >> 5;
  const int rl = lane >> 4, cq = lane & 15;
  const int rloc = wid * 4 + rl;
  const int ihead = rq * 16 + rloc;
  const int j0 = cq * 4;
  const size_t tokb = (size_t)b * 4096;
  float s0 = 0.f, s1 = 0.f, s2 = 0.f, s3 = 0.f;
  uint4 pA[3], pB[3], pC[3];
  auto gload = [&](uint4 (&pre)[3], int c) {
#pragma unroll
    for (int i = 0; i < 3; ++i) {
      const int v = tid + i * 256; const int vec = v >> 7, rem = v & 127, step = rem >> 3, c8 = rem & 7;
      const int off = (vec == 0) ? 0 : (vec == 1) ? 1792 : (vec == 2) ? 512 : (vec == 3) ? 1024 : (vec == 4) ? 2304 : 2816;
      pre[i] = *(const uint4*)(P2 + (tokb + c * 16 + step) * PS2 + off + h * 64 + c8 * 8);
    }
  };
  auto lstore = [&](const uint4 (&pre)[3], int buf) {
#pragma unroll
    for (int i = 0; i < 3; ++i) {
      const int v = tid + i * 256; const int vec = v >> 7, rem = v & 127, step = rem >> 3, c8 = rem & 7;
      float* d = vb + ((buf * 6 + vec) * 16 + step) * 64 + c8 * 8;
      float4 f0, f1;
      f0.x = bf2f((u16)(pre[i].x & 0xffff)); f0.y = bf2f((u16)(pre[i].x >> 16)); f0.z = bf2f((u16)(pre[i].y & 0xffff)); f0.w = bf2f((u16)(pre[i].y >> 16));
      f1.x = bf2f((u16)(pre[i].z & 0xffff)); f1.y = bf2f((u16)(pre[i].z >> 16)); f1.z = bf2f((u16)(pre[i].w & 0xffff)); f1.w = bf2f((u16)(pre[i].w >> 16));
      *(float4*)d = f0; *(float4*)(d + 4) = f1;
    }
  };
#define SC_LOAD(X, ST) { r##X = *(const float4*)(base + (0 * 16 + (ST)) * 64 + j0); w##X = *(const float4*)(base + (1 * 16 + (ST)) * 64 + j0); \
      k##X = *(const float4*)(base + (2 * 16 + (ST)) * 64 + j0); v##X = base[(3 * 16 + (ST)) * 64 + ihead]; \
      n##X = *(const float4*)(base + (4 * 16 + (ST)) * 64 + j0); b##X = *(const float4*)(base + (5 * 16 + (ST)) * 64 + j0); }
#define SC_STEP(X, ST) { float sa = s0 * n##X.x + s1 * n##X.y + s2 * n##X.z + s3 * n##X.w; \
      sa = -dpp_sum16(sa); \
      s0 = s0 * w##X.x + sa * b##X.x + v##X * k##X.x; s1 = s1 * w##X.y + sa * b##X.y + v##X * k##X.y; \
      s2 = s2 * w##X.z + sa * b##X.z + v##X * k##X.z; s3 = s3 * w##X.w + sa * b##X.w + v##X * k##X.w; \
      float y = s0 * r##X.x + s1 * r##X.y + s2 * r##X.z + s3 * r##X.w; \
      y = dpp_sum16(y); yb[(ST) * 16 + rloc] = y; }
#define SC_CHUNK(CC, PRE) { const int cc_ = (CC); if (cc_ >= 256) break; \
    const float* base = vb + (cc_ & 1) * 6 * 16 * 64; \
    { float4 rA, wA, kA, nA, bA, rB, wB, kB, nB, bB; float vA, vB; \
      SC_LOAD(A, 0) \
      _Pragma("unroll") for (int st = 0; st < 16; st += 2) { SC_LOAD(B, st + 1) SC_STEP(A, st) if (st + 2 < 16) SC_LOAD(A, st + 2) SC_STEP(B, st + 1) } } \
    __syncthreads(); \
    { const int st = tid >> 4, r = tid & 15; \
      YC[(tokb + cc_ * 16 + st) * PS1 + h * 64 + rq * 16 + r] = f2bf(yb[st * 16 + r]); } \
    if (cc_ + 1 < 256) lstore(PRE, (cc_ + 1) & 1); \
    if (cc_ + 4 < 256) gload(PRE, cc_ + 4); \
    __syncthreads(); }
  gload(pA, 0); lstore(pA, 0);
  __syncthreads();
  gload(pA, 1); gload(pB, 2); gload(pC, 3);
#pragma unroll 1
  for (int c = 0; c < 256; c += 3) {
    SC_CHUNK(c, pA)
    SC_CHUNK(c + 1, pB)
    SC_CHUNK(c + 2, pC)
  }
#undef SC_LOAD
#undef SC_STEP
#undef SC_CHUNK
}

__device__ __forceinline__ void phase_post(const Params& p, int l, char* smem) {
  const u16* P2 = (const u16*)(p.ws + OFF_P2); u16* YC = (u16*)(p.ws + OFF_P1) + 1560;
  float* sg = (float*)smem;
  const int tid = tidx();
  const float* g2 = p.in[26] + (size_t)l * 128 * 512;
  const float* rk = p.in[29] + (size_t)l * 512; const float* lg = p.in[30] + (size_t)l * 512; const float* lb = p.in[31] + (size_t)l * 512;
  for (int item = blockIdx.x; item < 2048; item += gridDim.x) {
    const int tok0 = item * 16;
    for (int e = tid; e < 2048; e += 256) { const int r = e >> 7, c = e & 127; sg[e] = bf2f(P2[(size_t)(tok0 + r) * PS2 + 1664 + c]); }
    __syncthreads();
    {
      float ag[2][16];
#pragma unroll
      for (int c = 0; c < 2; ++c)
#pragma unroll
        for (int r = 0; r < 16; ++r) ag[c][r] = 0.f;
#pragma unroll 4
      for (int i = 0; i < 128; i += 4) {
        float gv[2][4];
#pragma unroll
        for (int c = 0; c < 2; ++c)
#pragma unroll
          for (int u = 0; u < 4; ++u) gv[c][u] = g2[(i + u) * 512 + tid + c * 256];
#pragma unroll
        for (int r = 0; r < 16; ++r) {
          const float4 t4 = *(const float4*)(sg + r * 128 + i);
#pragma unroll
          for (int c = 0; c < 2; ++c) ag[c][r] += t4.x * gv[c][0] + t4.y * gv[c][1] + t4.z * gv[c][2] + t4.w * gv[c][3];
        }
      }
#pragma unroll
      for (int c = 0; c < 2; ++c) {
        const int ch = tid + c * 256;
        const float rkv = rk[ch], lgv = lg[ch], lbv = lb[ch];
        float yv[16], rr[16], kk[16], vv[16];
#pragma unroll
        for (int r = 0; r < 16; ++r) {
          const u16* row = P2 + (size_t)(tok0 + r) * PS2;
          yv[r] = bf2f(YC[(size_t)(tok0 + r) * PS1 + ch]);
          rr[r] = bf2f(row[ch]); kk[r] = bf2f(row[512 + ch]); vv[r] = bf2f(row[1024 + ch]);
        }
#pragma unroll
        for (int r = 0; r < 16; ++r) {
          const float mean = wave_sum(yv[r]) * (1.f / 64.f);
          const float dv = yv[r] - mean;
          const float var = wave_sum(dv * dv) * (1.f / 64.f);
          const float yn = dv * rsqrtf(var + 64e-5f) * lgv + lbv;
          const float bon = wave_sum(rr[r] * kk[r] * rkv) * vv[r];
          YC[(size_t)(tok0 + r) * PS1 + ch] = f2bf((yn + bon) * ag[c][r]);
        }
      }
    }
    __syncthreads();
  }
}

#define NEGV (-1e30f)
struct AttnState { float m[2]; float ls[2]; f32x4 ot[4][2]; };

#define MINIT (-1e20f)
template <int MODE, bool FULL>
__device__ __forceinline__ void attn_scores(f32x4 (&st)[4][2], const u16* kbase, int kstride, int key0, const bf16x8 (&qf)[2][2],
                                            const float (&slope)[2], int t, bool selbit, int c16, int q4) {
  const float fb = (float)(key0 + q4 * 4 - t);
#pragma unroll
  for (int mk = 0; mk < 4; ++mk) {
    const u16* kp = kbase + (size_t)(mk * 16 + c16) * kstride + q4 * 8;
    const bf16x8 k0 = *(const bf16x8*)kp, k1 = *(const bf16x8*)(kp + 32);
#pragma unroll
    for (int nq = 0; nq < 2; ++nq) {
      f32x4 a = {0.f, 0.f, 0.f, 0.f};
      a = mfma16(k0, qf[nq][0], a);
      a = mfma16(k1, qf[nq][1], a);
      if (FULL) {
        const float c0 = slope[nq] * fb;
#pragma unroll
        for (int j = 0; j < 4; ++j) {
          const float v = a[j] + (c0 + slope[nq] * (float)(mk * 16 + j));
          a[j] = (MODE == 1) ? (selbit ? v : NEGV) : v;
        }
      } else {
#pragma unroll
        for (int j = 0; j < 4; ++j) {
          const int key = key0 + mk * 16 + q4 * 4 + j;
          int dist; bool valid;
          if (MODE == 0) { dist = t - (16 * key + 31); valid = dist >= 0; }
          else if (MODE == 1) { dist = t - key; valid = (dist >= 0) && selbit; }
          else { dist = t - key; valid = (dist >= 0) && (dist < 512); }
          a[j] = valid ? (a[j] - slope[nq] * (float)dist) : NEGV;
        }
      }
      st[mk][nq] = a;
    }
  }
}

template <int MODE, bool FULL>
__device__ __forceinline__ void attn_tile(AttnState& S, const u16* kbase, int kstride, const u16* vtbase, int vstride, int key0,
                                          const bf16x8 (&qf)[2][2], const float (&slope)[2], int t, bool selbit, int c16, int q4) {
  f32x4 st[4][2];
  attn_scores<MODE, FULL>(st, kbase, kstride, key0, qf, slope, t, selbit, c16, q4);
  __builtin_amdgcn_sched_barrier(0);
#pragma unroll
  for (int nq = 0; nq < 2; ++nq) {
    float mx = fmaxf(fmaxf(st[0][nq][0], st[0][nq][1]), fmaxf(st[0][nq][2], st[0][nq][3]));
#pragma unroll
    for (int mk = 1; mk < 4; ++mk) mx = fmaxf(mx, fmaxf(fmaxf(st[mk][nq][0], st[mk][nq][1]), fmaxf(st[mk][nq][2], st[mk][nq][3])));
    mx = fmaxf(mx, __shfl_xor(mx, 16)); mx = fmaxf(mx, __shfl_xor(mx, 32));
    const float mnew = fmaxf(S.m[nq], mx);
    const float alpha = __builtin_amdgcn_exp2f(S.m[nq] - mnew);
    S.m[nq] = mnew;
    float ls = S.ls[nq] * alpha;
#pragma unroll
    for (int md = 0; md < 4; ++md) { S.ot[md][nq][0] *= alpha; S.ot[md][nq][1] *= alpha; S.ot[md][nq][2] *= alpha; S.ot[md][nq][3] *= alpha; }
#pragma unroll
    for (int mk = 0; mk < 4; ++mk)
#pragma unroll
      for (int j = 0; j < 4; ++j) {
        const float pv = __builtin_amdgcn_exp2f(st[mk][nq][j] - mnew);
        st[mk][nq][j] = pv; ls += pv;
      }
    S.ls[nq] = ls;
  }
#pragma unroll
  for (int s2 = 0; s2 < 2; ++s2) {
    __builtin_amdgcn_sched_barrier(0);
    bf16x8 pb[2];
#pragma unroll
    for (int nq = 0; nq < 2; ++nq) {
      uint4 u;
      u.x = pack2(st[2 * s2][nq][0], st[2 * s2][nq][1]); u.y = pack2(st[2 * s2][nq][2], st[2 * s2][nq][3]);
      u.z = pack2(st[2 * s2 + 1][nq][0], st[2 * s2 + 1][nq][1]); u.w = pack2(st[2 * s2 + 1][nq][2], st[2 * s2 + 1][nq][3]);
      pb[nq] = *(bf16x8*)&u;
    }
#pragma unroll
    for (int md = 0; md < 4; ++md) {
      const bf16x8 vf = *(const bf16x8*)(vtbase + (size_t)(md * 16 + c16) * vstride + s2 * 32 + q4 * 8);
#pragma unroll
      for (int nq = 0; nq < 2; ++nq) S.ot[md][nq] = mfma16(vf, pb[nq], S.ot[md][nq]);
    }
  }
}

__device__ __forceinline__ void attn_reset(AttnState& S) {
#pragma unroll
  for (int nq = 0; nq < 2; ++nq) { S.m[nq] = MINIT; S.ls[nq] = 0.f;
#pragma unroll
    for (int md = 0; md < 4; ++md) S.ot[md][nq] = f32x4{0.f, 0.f, 0.f, 0.f}; }
}
__device__ __forceinline__ void attn_fold(AttnState& S, float* oacc, const u16* gp, int br, float (&invl)[2], int lane) {
#pragma unroll
  for (int nq = 0; nq < 2; ++nq) {
    float l = S.ls[nq];
    l += __shfl_xor(l, 16); l += __shfl_xor(l, 32);
    const float inv = (l > 0.f) ? 1.f / l : 0.f;
    invl[nq] = inv;
    const float f = bf2f(gp[nq * 6 + br]) * inv;
#pragma unroll
    for (int md = 0; md < 4; ++md)
#pragma unroll
      for (int j = 0; j < 4; ++j) {
        float* a = oacc + ((md * 2 + nq) * 4 + j) * 64 + lane;
        const float v = f * S.ot[md][nq][j];
        if (br == 0) *a = v; else *a += v;
      }
  }
}

__device__ __forceinline__ void phase_nsa(const Params& p, char* smem, unsigned* queue) {
  u16* P1 = (u16*)(p.ws + OFF_P1);
  const u16* KC = (const u16*)(p.ws + OFF_KC); const u16* VC = (const u16*)(p.ws + OFF_VC); const u16* VT = (const u16*)(p.ws + OFF_VT);
  const int tid = tidx(), lane = tid & 63, wid = tid >> 6;
  const int c16 = lane & 15, q4 = lane >> 4, tq = lane & 7;
  float* ps = (float*)smem + wid * 2048;
  float* oacc = (float*)(smem + 32768) + wid * 2048;
  int* qslot = (int*)(smem + 65536);
#pragma unroll 1
  for (;;) {
    if (tid == 0) *qslot = (int)atomicAdd(queue, 1u);
    __syncthreads();
    const int it = *qslot;
    if (it >= 2048) break;
    const int bg = it & 15;
    const int tqd = 127 - (it >> 4);
    const int b = bg >> 1, g = bg & 1;
    const int t0 = (tqd * 4 + wid) * 8;
    const int tok0 = b * 4096 + t0;
    const int t = t0 + tq;
    const int cur = t0 >> 6;
#pragma unroll
    for (int i = 0; i < 8; ++i) *(float4*)(ps + i * 256 + lane * 4) = float4{0.f, 0.f, 0.f, 0.f};
    bf16x8 qf[2][2]; float slope[2];
    const u16* gp = P1 + (size_t)(tok0 + tq) * PS1 + 1024 + (g * 4 + (c16 >> 3)) * 3;
#pragma unroll
    for (int nq = 0; nq < 2; ++nq) {
      const int hh = nq * 2 + (c16 >> 3);
      const u16* rp = P1 + (size_t)(tok0 + tq) * PS1;
      qf[nq][0] = *(const bf16x8*)(rp + (g * 4 + hh) * 64 + q4 * 8);
      qf[nq][1] = *(const bf16x8*)(rp + (g * 4 + hh) * 64 + 32 + q4 * 8);
      slope[nq] = exp2f(-(float)(g * 4 + hh + 1)) * 1.4426950408889634f;
    }
    AttnState S;
    float invl[2];
    const u16* kcb = KC + (size_t)(b * 2 + g) * 256 * 64;
    const u16* vcb = VC + (size_t)(b * 2 + g) * 64 * 256;
    int ntc = 0;
    if (t0 + 7 >= 31) ntc = (((t0 + 7 - 31) >> 4) >> 6) + 1;
    attn_reset(S);
#pragma unroll 1
    for (int kt = 0; kt < ntc; ++kt) attn_tile<0, false>(S, kcb + (size_t)kt * 64 * 64, 64, vcb + kt * 64, 256, kt * 64, qf, slope, t, true, c16, q4);
    attn_fold(S, oacc, gp, 0, invl, lane);
#pragma unroll 1
    for (int kt = 0; kt < ntc; ++kt) {
      f32x4 st[4][2];
      attn_scores<0, false>(st, kcb + (size_t)kt * 64 * 64, 64, kt * 64, qf, slope, t, true, c16, q4);
#pragma unroll
      for (int mk = 0; mk < 4; ++mk) {
        f32x4 hs;
#pragma unroll
        for (int j = 0; j < 4; ++j) {
          const float a0 = st[mk][0][j], a1 = st[mk][1][j];
          const float p0 = __builtin_amdgcn_exp2f(a0 - S.m[0]) * invl[0];
          const float p1 = __builtin_amdgcn_exp2f(a1 - S.m[1]) * invl[1];
          float v = p0 + p1;
          v += __shfl_xor(v, 8);
          hs[j] = v;
        }
        if (c16 < 8) *(f32x4*)(ps + c16 * 256 + kt * 64 + mk * 16 + q4 * 4) = hs;
      }
    }
    __syncthreads();
    unsigned long long selm = 0ull, un = 0ull;
#pragma unroll 1
    for (int tqq = 0; tqq < 8; ++tqq) {
      const float* pr = ps + tqq * 256;
      float imp = pr[4 * lane];
      if (lane > 0) imp += pr[4 * lane - 4] + 2.f * (pr[4 * lane - 3] + pr[4 * lane - 2] + pr[4 * lane - 1]);
      const bool forced = (lane == 0) || (lane == cur) || (lane == cur - 1);
      const bool live = lane <= cur;
      const float val = forced ? 1e4f : (live ? imp : NEGV);
      int rank = 0;
#pragma unroll 8
      for (int i = 0; i < 64; ++i) {
        const float vi = __uint_as_float(__builtin_amdgcn_readlane(__float_as_uint(val), i));
        rank += ((vi > val) || (vi == val && i < lane)) ? 1 : 0;
      }
      const unsigned long long bal = __ballot((rank < 16) && live);
      if (tq == tqq) selm = bal;
      un |= bal;
    }
    __syncthreads();
    attn_reset(S);
    {
      const u16* vtb = VT + (size_t)((0 * 8 + b) * 2 + g) * 64 * 4096;
#pragma unroll 1
      for (int j = 0; j <= cur; ++j) {
        if (!((un >> j) & 1ull)) continue;
        const bool sb = (selm >> j) & 1ull;
        const u16* kb_ = P1 + (size_t)(b * 4096 + j * 64) * PS1 + 768 + g * 64;
        if (j < cur) attn_tile<1, true>(S, kb_, PS1, vtb + j * 64, 4096, j * 64, qf, slope, t, sb, c16, q4);
        else attn_tile<1, false>(S, kb_, PS1, vtb + j * 64, 4096, j * 64, qf, slope, t, sb, c16, q4);
      }
    }
    attn_fold(S, oacc, gp, 1, invl, lane);
    attn_reset(S);
    {
      const u16* vtb = VT + (size_t)((1 * 8 + b) * 2 + g) * 64 * 4096;
      int j0 = t0 - 511; if (j0 < 0) j0 = 0; j0 >>= 6;
#pragma unroll 1
      for (int j = j0; j <= cur; ++j) {
        const u16* kb_ = P1 + (size_t)(b * 4096 + j * 64) * PS1 + 896 + g * 64;
        const bool full = (j < cur) && (j * 64 >= t0 + 7 - 511);
        if (full) attn_tile<2, true>(S, kb_, PS1, vtb + j * 64, 4096, j * 64, qf, slope, t, true, c16, q4);
        else attn_tile<2, false>(S, kb_, PS1, vtb + j * 64, 4096, j * 64, qf, slope, t, true, c16, q4);
      }
    }
    attn_fold(S, oacc, gp, 2, invl, lane);
#pragma unroll
    for (int nq = 0; nq < 2; ++nq) {
      const int hh = nq * 2 + (c16 >> 3);
      u16* rp = P1 + (size_t)(tok0 + tq) * PS1 + (g * 4 + hh) * 64;
#pragma unroll
      for (int md = 0; md < 4; ++md) {
        const float* a = oacc + ((md * 2 + nq) * 4) * 64 + lane;
        uint2 o; o.x = pack2(a[0], a[64]); o.y = pack2(a[128], a[192]);
        *(uint2*)(rp + md * 16 + q4 * 4) = o;
      }
    }
  }
}

__device__ __forceinline__ const float* modp(const Params& p, int l, int sub, int kind) {
  return (const float*)(p.ws + OFF_MOD) + (size_t)l * 8 * 9216 + sub * 3072 + kind * 1024;
}

__device__ __forceinline__ void run_phase(const Params& p, int ph, char* smem) {
  char* ws = p.ws;
  if (ph == 0) {
    if (blockIdx.x == 0) { unsigned* c = (unsigned*)(ws + OFF_CNT); for (int e = tidx(); e < 1024; e += 256) c[e] = 0u; }
    phase_mod(p, smem);
  }
  int l = 0, s = -1;
  if (ph >= 2) { l = (ph - 2) / 14; s = (ph - 2) % 14; }
  const float* preg = p.in[4] + (size_t)l * 3 * 1024; const float* postg = p.in[5] + (size_t)l * 3 * 1024;
  const bool is_norm = (ph == 1) || s == 2 || s == 10 || s == 13;
  if (is_norm) {
    const float* xin = p.out; float* xout = p.out; const u16* y = nullptr; const float* pg = nullptr; const float* gate = nullptr; float wgt = 0.f;
    const float* prg = nullptr; const float* sh = nullptr; const float* sc = nullptr; u16* h = (u16*)(ws + OFF_H);
    if (ph == 1) { xin = p.in[0]; prg = p.in[4]; sh = modp(p, 0, 0, 0); sc = modp(p, 0, 0, 1); }
    else if (s == 2) { y = (const u16*)(ws + OFF_YF); pg = postg; gate = modp(p, l, 0, 2); wgt = 0.5f; prg = preg + 1024; sh = modp(p, l, 1, 0); sc = modp(p, l, 1, 1); }
    else if (s == 10) { y = (const u16*)(ws + OFF_YM); pg = postg + 1024; gate = modp(p, l, 1, 2); wgt = 1.0f; prg = preg + 2048; sh = modp(p, l, 2, 0); sc = modp(p, l, 2, 1); }
    else { y = (const u16*)(ws + OFF_YF); pg = postg + 2048; gate = modp(p, l, 2, 2); wgt = 0.5f;
      if (l == 0) { prg = p.in[4] + 3 * 1024; sh = modp(p, 1, 0, 0); sc = modp(p, 1, 0, 1); } else { h = nullptr; } }
    phase_norm(xin, xout, y, pg, gate, wgt, prg, sh, sc, h);
  }
  {
    int cl = -1, cf = 0;
    if (ph == 0) { cl = 0; cf = 0; } else if (s == 2) { cl = l; cf = 1; } else if (s == 13 && l == 0) { cl = 1; cf = 0; }
    if (cl >= 0) conv_ffn(p, cl, cf, smem);
    if (cl >= 0 && cf == 0) conv_mix(p, cl, smem);
  }
  if (s == 0 || s == 11) phase_ffn_in(p, smem);
  if (s == 1 || s == 12 || s == 9) {
    const bool o = (s == 9);
    phase_gemm_plain((const u16*)(ws + (o ? OFF_MERGED : OFF_ACT)), o ? 1024 : DFF, (const u16*)(ws + (o ? OFF_WO : OFF_WOUT)), o ? 1024 : DFF,
                     (u16*)(ws + (o ? OFF_YM : OFF_YF)), smem);
  }
  if (s == 3) phase_inproj(p, smem);
  if (s == 4) { phase_prep1(p, l); phase_sgu(p, l, smem); phase_cmp1(p, l, smem); }
  if (s == 5) { phase_prep2m(p, l, smem); phase_cmp2(p, l); }
  if (s == 6) {
    const int nb = gridDim.x;
    const int sid = (nb >= 512) ? (((int)blockIdx.x & 1) ? -1 : ((int)blockIdx.x >> 1)) : (int)blockIdx.x;
    const int sstride = (nb >= 512) ? (nb >> 1) : nb;
    if (sid >= 0) {
      __builtin_amdgcn_s_setprio(3);
      for (int it = sid; it < 256; it += sstride) scan_item(p, it, smem);
      __builtin_amdgcn_s_setprio(0);
    }
    phase_nsa(p, smem, (unsigned*)(ws + OFF_CNT) + 64 + l * 64);
  }
  if (s == 7) phase_postm(p, l, smem);
  if (s == 8) phase_merge(p, smem);
}

constexpr int NPHASE = 30;

#if COOP
typedef const float* __attribute__((address_space(4))) const* kargp_t;
template <int PH>
__device__ __forceinline__ void run_seq(char* smem, cg::grid_group& grid) {
  if constexpr (PH < NPHASE) {
    {
      kargp_t ka = (kargp_t)__builtin_amdgcn_kernarg_segment_ptr();
      asm volatile("" : "+s"(ka));
      Params q;
#pragma unroll
      for (int i = 0; i < 35; ++i) q.in[i] = ka[i];
      q.out = (float*)ka[35];
      q.ws = (char*)ka[36];
      run_phase(q, PH, smem);
    }
    if constexpr (PH == 0) {
      kargp_t kb = (kargp_t)__builtin_amdgcn_kernarg_segment_ptr();
      asm volatile("" : "+s"(kb));
      unsigned* bar = (unsigned*)((char*)kb[36] + OFF_XB);
      if (tidx() == 0) xb_add(&bar[XB_XCNT(xb_xcc_id())], 1u);
      grid.sync();
      if (tidx() == 0) {
        const unsigned x = xb_xcc_id();
        unsigned nloc = 1u, nx = 0u;
        for (unsigned j = 0; j < 16; ++j) { const unsigned c = xb_ld(&bar[XB_XCNT(j)]); nx += (c > 0u) ? 1u : 0u; if (j == x) nloc = c; }
        __hip_atomic_store(&bar[XB_SLOT(blockIdx.x)], nloc, __ATOMIC_RELAXED, __HIP_MEMORY_SCOPE_AGENT); __hip_atomic_store(&bar[XB_SLOT(blockIdx.x) + 1], nx, __ATOMIC_RELAXED, __HIP_MEMORY_SCOPE_AGENT);
      }
    } else if constexpr (PH + 1 < NPHASE) {
      kargp_t kb = (kargp_t)__builtin_amdgcn_kernarg_segment_ptr();
      asm volatile("" : "+s"(kb));
      gbar_xcd((unsigned*)((char*)kb[36] + OFF_XB));
    }
    run_seq<PH + 1>(smem, grid);
  }
}

__global__ void __launch_bounds__(256, 2) mega(Params p) {
  __shared__ __attribute__((aligned(16))) char smem[SMEM_BYTES];
  cg::grid_group grid = cg::this_grid();
  run_seq<0>(smem, grid);
}
#endif

template <int PH>
__global__ void __launch_bounds__(256, 2) kph(Params p) {
  __shared__ __attribute__((aligned(16))) char smem[SMEM_BYTES];
  run_phase(p, PH, smem);
}

template <int PH>
static void launch_seq(const Params& p, int grid, hipStream_t stream) {
  if constexpr (PH < NPHASE) {
    kph<PH><<<grid, 256, 0, stream>>>(p);
    launch_seq<PH + 1>(p, grid, stream);
  }
}

extern "C" void kernel_launch(void* const* d_in, const int* in_sizes, int n_in, void* d_out, int out_size, void* d_ws, size_t ws_size,
                              hipStream_t stream) {
  static int grid_blocks = 0;
  if (!grid_blocks) {
    int dev = 0, cus = 0, per_cu = 0;
    hipGetDevice(&dev);
    hipDeviceGetAttribute(&cus, hipDeviceAttributeMultiprocessorCount, dev);
    #if COOP
    hipOccupancyMaxActiveBlocksPerMultiprocessor(&per_cu, mega, 256, 0);
#else
    per_cu = 2;
#endif
    if (per_cu > 2) per_cu = 2;
    if (per_cu < 1) per_cu = 1;
    grid_blocks = cus * per_cu;
  }
  Params p{};
  for (int i = 0; i < 35; ++i) p.in[i] = (const float*)d_in[i];
  p.out = (float*)d_out;
  p.ws = (char*)d_ws;
#if COOP
  hipMemsetAsync((char*)d_ws + OFF_XB, 0, XB_BYTES, stream);
  void* args[] = {&p};
  hipError_t e = hipLaunchCooperativeKernel((void*)mega, dim3(grid_blocks), dim3(256), args, 0, stream);
  if (e != hipSuccess) fprintf(stderr, "cooperative launch failed: %s (grid %d)\n", hipGetErrorString(e), grid_blocks);
#else
  launch_seq<0>(p, grid_blocks, stream);
#endif
}
```

```cpp
#include <hip/hip_runtime.h>
#include <hip/hip_cooperative_groups.h>
#include <cstdio>
#include <cstdint>
namespace cg = cooperative_groups;

#ifndef COOP
#define COOP 1
#endif

typedef unsigned short u16;
using bf16x8 = __attribute__((ext_vector_type(8))) short;
using f32x4 = __attribute__((ext_vector_type(4))) float;

constexpr int T = 32768, D = 1024, SEQ = 4096, DFF = 2816;
constexpr int PS1 = 2072, PS2 = 3328;
constexpr int MIXC = 7192, MIXN = 4120;
constexpr size_t OFF_P1 = 0;
constexpr size_t OFF_P2 = OFF_P1 + (size_t)T * PS1 * 2;
constexpr size_t OFF_H = OFF_P2 + (size_t)T * PS2 * 2;
constexpr size_t OFF_WMIX = OFF_H + (size_t)T * 1024 * 2;
constexpr size_t OFF_WG = OFF_WMIX + (size_t)4224 * 1024 * 2;
constexpr size_t OFF_WB = OFF_WG + (size_t)3072 * 1024 * 2;
constexpr size_t OFF_WO = OFF_WB + (size_t)3 * 1024 * 512 * 2;
constexpr size_t OFF_W1 = OFF_WO + (size_t)1024 * 1024 * 2;
constexpr size_t OFF_WIN = OFF_W1 + (size_t)2 * 256 * 2048 * 2;
constexpr size_t OFF_WOUT = OFF_WIN + (size_t)5632 * 1024 * 2;
constexpr size_t OFF_VFIRST = OFF_WOUT + (size_t)1024 * 2816 * 2;
constexpr size_t OFF_VT = OFF_VFIRST + (size_t)T * 512 * 2;
constexpr size_t OFF_MOD = OFF_VT + (size_t)2 * 8 * 2 * 64 * 4096 * 2;
constexpr size_t OFF_PB = OFF_MOD + (size_t)2 * 8 * 9216 * 4;
constexpr size_t OFF_HID = OFF_PB + (size_t)1024 * 1792 * 2;
constexpr size_t OFF_KC = OFF_HID + (size_t)2 * 4096 * 256 * 2;
constexpr size_t OFF_VC = OFF_KC + (size_t)8 * 2 * 256 * 64 * 2;
constexpr size_t OFF_LV = OFF_VC + (size_t)8 * 2 * 64 * 256 * 2;
constexpr size_t OFF_CNT = OFF_LV + (size_t)T * 32 * 4;
constexpr size_t OFF_WL = OFF_CNT + 4096;
constexpr int WL_W2 = 0, WL_A2 = 512 * 64, WL_G2 = 2 * 512 * 64, WL_V1 = WL_G2 + 512 * 128, WL_V2 = WL_V1 + 64 * 512, WL_END = WL_V2 + 512 * 64;
constexpr size_t OFF_XB = (OFF_WL + (size_t)WL_END * 2 + 255) & ~(size_t)255;
constexpr size_t XB_BYTES = 32768;
constexpr size_t WS_END = OFF_XB + XB_BYTES;
constexpr size_t OFF_ACT = OFF_P1;
constexpr size_t OFF_YF = OFF_ACT + (size_t)T * DFF * 2;
constexpr size_t OFF_H2 = OFF_P2;
constexpr size_t OFF_MERGED = OFF_P2;
constexpr size_t OFF_YM = OFF_MERGED + (size_t)T * 1024 * 2;
constexpr size_t OFF_YC = OFF_H;

constexpr int SMEM_BYTES = 73728;

struct Params { const float* in[35]; float* out; char* ws; };

__device__ __forceinline__ int tidx() { int t = __builtin_amdgcn_workitem_id_x(); asm volatile("" : "+v"(t)); return t; }
__device__ __forceinline__ void gbar(unsigned* cnt, unsigned target) {
  asm volatile("s_waitcnt vmcnt(0) lgkmcnt(0)" ::: "memory");
  __syncthreads();
  if (tidx() == 0) {
    __builtin_amdgcn_fence(__ATOMIC_RELEASE, "agent");
    asm volatile("s_waitcnt vmcnt(0)" ::: "memory");
    __hip_atomic_fetch_add(cnt, 1u, __ATOMIC_RELAXED, __HIP_MEMORY_SCOPE_AGENT);
    while (__hip_atomic_load(cnt, __ATOMIC_RELAXED, __HIP_MEMORY_SCOPE_AGENT) < target) __builtin_amdgcn_s_sleep(1);
    __builtin_amdgcn_fence(__ATOMIC_ACQUIRE, "agent");
    asm volatile("s_waitcnt vmcnt(0)" ::: "memory");
  }
  __syncthreads();
}
#define XB_XCNT(j) (256 + 64 * (j))
#define XB_XSUB(j) (1280 + 64 * (j))
#define XB_XGEN(j) (2304 + 64 * (j))
#define XB_TOP 3328
#define XB_TOPGEN 3392
#define XB_SLOT(b) (4096 + 2 * (b))
__device__ __forceinline__ unsigned xb_ld(unsigned* p) { return __hip_atomic_load(p, __ATOMIC_RELAXED, __HIP_MEMORY_SCOPE_AGENT); }
__device__ __forceinline__ unsigned xb_add(unsigned* p, unsigned v) { return __hip_atomic_fetch_add(p, v, __ATOMIC_RELAXED, __HIP_MEMORY_SCOPE_AGENT); }
__device__ __forceinline__ unsigned xb_xcc_id() { return (unsigned)__builtin_amdgcn_s_getreg((3 << 11) | 20) & 0xFu; }
__device__ __forceinline__ void gbar_xcd(unsigned* bar) {
  asm volatile("s_waitcnt vmcnt(0) lgkmcnt(0)" ::: "memory");
  __syncthreads();
  if (tidx() == 0) {
    const unsigned x = xb_xcc_id();
    const unsigned nloc = xb_ld(&bar[XB_SLOT(blockIdx.x)]), nx = xb_ld(&bar[XB_SLOT(blockIdx.x) + 1]);
    const unsigned old = xb_add(&bar[XB_XSUB(x)], 1u);
    const unsigned gen = old / nloc;
    if (old + 1u == (gen + 1u) * nloc) {
      __builtin_amdgcn_fence(__ATOMIC_RELEASE, "agent");
      asm volatile("s_waitcnt vmcnt(0)" ::: "memory");
      const unsigned og = xb_add(&bar[XB_TOP], 1u);
      const unsigned tg = og / nx;
      if (og + 1u == (tg + 1u) * nx) xb_add(&bar[XB_TOPGEN], 1u);
      else while (xb_ld(&bar[XB_TOPGEN]) == tg) __builtin_amdgcn_s_sleep(1);
      __builtin_amdgcn_fence(__ATOMIC_ACQUIRE, "agent");
      xb_add(&bar[XB_XGEN(x)], 1u);
      asm volatile("s_waitcnt vmcnt(0)" ::: "memory");
    } else {
      while (xb_ld(&bar[XB_XGEN(x)]) == gen) __builtin_amdgcn_s_sleep(1);
      __builtin_amdgcn_fence(__ATOMIC_ACQUIRE, "agent");
      asm volatile("s_waitcnt vmcnt(0)" ::: "memory");
    }
  }
  __syncthreads();
}
__device__ __forceinline__ float dpp_sum16(float v) {
  v += __int_as_float(__builtin_amdgcn_update_dpp(0, __float_as_int(v), 0xB1, 0xF, 0xF, true));
  v += __int_as_float(__builtin_amdgcn_update_dpp(0, __float_as_int(v), 0x4E, 0xF, 0xF, true));
  v += __int_as_float(__builtin_amdgcn_update_dpp(0, __float_as_int(v), 0x141, 0xF, 0xF, true));
  v += __int_as_float(__builtin_amdgcn_update_dpp(0, __float_as_int(v), 0x140, 0xF, 0xF, true));
  return v;
}
__device__ __forceinline__ float bf2f(u16 u) { return __uint_as_float(((unsigned)u) << 16); }
__device__ __forceinline__ u16 f2bf(float f) { __bf16 r = (__bf16)f; return *(u16*)&r; }
typedef __attribute__((ext_vector_type(2))) float f2_t;
typedef __attribute__((ext_vector_type(2))) __bf16 b2_t;
__device__ __forceinline__ unsigned pack2(float a, float b) { f2_t v = {a, b}; b2_t r = __builtin_convertvector(v, b2_t); return *(unsigned*)&r; }
__device__ __forceinline__ float sigmoidf_(float x) { return 1.f / (1.f + __expf(-x)); }
__device__ __forceinline__ float siluf_(float x) { return x / (1.f + __expf(-x)); }
__device__ __forceinline__ float geluf_(float x) { float u = 0.7978845608028654f * (x + 0.044715f * x * x * x); return x / (1.f + __expf(-2.f * u)); }
__device__ __forceinline__ float tanhf_(float x) { return 1.f - 2.f / (1.f + __expf(2.f * x)); }
__device__ __forceinline__ float wave_sum(float v) {
#pragma unroll
  for (int o = 32; o >= 1; o >>= 1) v += __shfl_xor(v, o);
  return v;
}
__device__ __forceinline__ f32x4 mfma16(bf16x8 a, bf16x8 b, f32x4 c) { return __builtin_amdgcn_mfma_f32_16x16x32_bf16(a, b, c, 0, 0, 0); }

__device__ __forceinline__ void conv_w(const float* src, int ld, int K, u16* dst, int NR, int nvalid, int coff, int kind, char* smem, int kvalid = 1 << 30) {
  float* tl = (float*)smem;
  const int tid = tidx();
  const int ktn = K >> 6, ntile = (NR >> 6) * ktn;
  for (int tix = blockIdx.x; tix < ntile; tix += gridDim.x) {
    const int R0 = (tix / ktn) << 6, k0 = (tix % ktn) << 6;
    const int c = tid & 63, kq = tid >> 6;
    const int R = R0 + c;
    int sc; bool ok;
    if (kind == 0) { sc = coff + R; ok = R < nvalid; }
    else { int ntl = R >> 7, w = (R >> 6) & 1, n = (R >> 4) & 3, r = R & 15; sc = ((n >= 2) ? DFF : 0) + ntl * 64 + w * 32 + (n & 1) * 16 + r; ok = true; }
#pragma unroll 4
    for (int i = 0; i < 16; ++i) {
      int k = k0 + kq * 16 + i;
      tl[c * 65 + kq * 16 + i] = (ok && k < kvalid) ? src[(size_t)k * ld + sc] : 0.f;
    }
    __syncthreads();
    {
      const int r = tid >> 2, ks = tid & 3;
      const float* s = tl + r * 65 + ks * 16;
      uint4 o0, o1;
      o0.x = pack2(s[0], s[1]); o0.y = pack2(s[2], s[3]); o0.z = pack2(s[4], s[5]); o0.w = pack2(s[6], s[7]);
      o1.x = pack2(s[8], s[9]); o1.y = pack2(s[10], s[11]); o1.z = pack2(s[12], s[13]); o1.w = pack2(s[14], s[15]);
      uint4* dp = (uint4*)(dst + (size_t)(R0 + r) * K + k0 + ks * 16);
      dp[0] = o0; dp[1] = o1;
    }
    __syncthreads();
  }
}

__device__ __forceinline__ void conv_ffn(const Params& p, int l, int f, char* smem) {
  conv_w(p.in[6] + (size_t)(l * 2 + f) * D * (2 * DFF), 2 * DFF, D, (u16*)(p.ws + OFF_WIN), 5632, 5632, 0, 1, smem);
  conv_w(p.in[7] + (size_t)(l * 2 + f) * DFF * D, D, DFF, (u16*)(p.ws + OFF_WOUT), 1024, 1024, 0, 0, smem);
}
__device__ __forceinline__ void conv_mix(const Params& p, int l, char* smem) {
  const float* mw = p.in[8] + (size_t)l * D * MIXC;
  conv_w(mw, MIXC, D, (u16*)(p.ws + OFF_WMIX), 4224, MIXN, 0, 0, smem);
  conv_w(mw, MIXC, D, (u16*)(p.ws + OFF_WG), 3072, 3072, MIXN, 0, smem);
  for (int i = 0; i < 3; ++i)
    conv_w(p.in[9] + (size_t)(l * 3 + i) * 512 * D, D, 512, (u16*)(p.ws + OFF_WB) + (size_t)i * 1024 * 512, 1024, 1024, 0, 0, smem);
  conv_w(p.in[10] + (size_t)l * D * D, D, D, (u16*)(p.ws + OFF_WO), 1024, 1024, 0, 0, smem);
  conv_w(p.in[11] + (size_t)l * 2048 * 256, 256, 2048, (u16*)(p.ws + OFF_W1), 256, 256, 0, 0, smem);
  conv_w(p.in[14] + (size_t)l * 2048 * 256, 256, 2048, (u16*)(p.ws + OFF_W1) + (size_t)256 * 2048, 256, 256, 0, 0, smem);
  u16* WL = (u16*)(p.ws + OFF_WL);
  conv_w(p.in[23] + (size_t)l * 64 * 512, 512, 64, WL + WL_W2, 512, 512, 0, 0, smem);
  conv_w(p.in[25] + (size_t)l * 64 * 512, 512, 64, WL + WL_A2, 512, 512, 0, 0, smem);
  conv_w(p.in[26] + (size_t)l * 128 * 512, 512, 128, WL + WL_G2, 512, 512, 0, 0, smem);
  if (l > 0) {
    conv_w(p.in[33], 32, 512, WL + WL_V1, 64, 32, 0, 0, smem);
    conv_w(p.in[34], 512, 64, WL + WL_V2, 512, 512, 0, 0, smem, 32);
  }
}

__device__ __forceinline__ void phase_mod(const Params& p, char* smem) {
  float* cond = (float*)smem;
  float* red = cond + 8192;
  const int tid = tidx();
  float* MOD = (float*)(p.ws + OFF_MOD);
  for (int item = blockIdx.x; item < 288; item += gridDim.x) {
    for (int e = tid; e < 8192; e += 256) cond[e] = siluf_(p.in[1][e]);
    __syncthreads();
    const int l = item / 144, n0 = (item % 144) * 64, col = n0 + (tid & 63), kq = tid >> 6;
    float acc[8];
#pragma unroll
    for (int b = 0; b < 8; ++b) acc[b] = 0.f;
    const float* w = p.in[2] + (size_t)l * D * 9216 + col;
#pragma unroll 4
    for (int k = kq * 256; k < kq * 256 + 256; ++k) {
      float wv = w[(size_t)k * 9216];
#pragma unroll
      for (int b = 0; b < 8; ++b) acc[b] += cond[b * 1024 + k] * wv;
    }
#pragma unroll
    for (int b = 0; b < 8; ++b) red[(kq * 8 + b) * 64 + (tid & 63)] = acc[b];
    __syncthreads();
    for (int e = tid; e < 512; e += 256) {
      int b = e >> 6, c = e & 63;
      float s = red[(0 * 8 + b) * 64 + c] + red[(1 * 8 + b) * 64 + c] + red[(2 * 8 + b) * 64 + c] + red[(3 * 8 + b) * 64 + c];
      MOD[(size_t)(l * 8 + b) * 9216 + n0 + c] = s + p.in[3][(size_t)l * 9216 + n0 + c];
    }
    __syncthreads();
  }
}

__device__ __forceinline__ void phase_norm(const float* xin, float* xout, const u16* y, const float* postg, const float* gate, float wgt,
                           const float* preg, const float* shift, const float* scale, u16* h) {
  const int lane = tidx() & 63, wid = tidx() >> 6;
  for (int row = blockIdx.x * 4 + wid; row < T; row += gridDim.x * 4) {
    const int b = row >> 12;
    float4 xv[4];
#pragma unroll
    for (int i = 0; i < 4; ++i) xv[i] = *(const float4*)(xin + (size_t)row * D + i * 256 + lane * 4);
    if (y) {
      float yv[4][4]; float ss = 0.f;
#pragma unroll
      for (int i = 0; i < 4; ++i) {
        uint2 u = *(const uint2*)(y + (size_t)row * D + i * 256 + lane * 4);
        yv[i][0] = bf2f((u16)(u.x & 0xffff)); yv[i][1] = bf2f((u16)(u.x >> 16));
        yv[i][2] = bf2f((u16)(u.y & 0xffff)); yv[i][3] = bf2f((u16)(u.y >> 16));
        ss += yv[i][0] * yv[i][0] + yv[i][1] * yv[i][1] + yv[i][2] * yv[i][2] + yv[i][3] * yv[i][3];
      }
      ss = wave_sum(ss);
      const float rs = rsqrtf(ss * (1.f / 1024.f) + 1e-6f) * wgt;
#pragma unroll
      for (int i = 0; i < 4; ++i) {
        const int c = i * 256 + lane * 4;
        float4 g = *(const float4*)(gate + (size_t)b * 9216 + c);
        float4 pg = *(const float4*)(postg + c);
        xv[i].x += g.x * yv[i][0] * rs * pg.x; xv[i].y += g.y * yv[i][1] * rs * pg.y;
        xv[i].z += g.z * yv[i][2] * rs * pg.z; xv[i].w += g.w * yv[i][3] * rs * pg.w;
      }
    }
    if (xout) {
#pragma unroll
      for (int i = 0; i < 4; ++i) *(float4*)(xout + (size_t)row * D + i * 256 + lane * 4) = xv[i];
    }
    if (h) {
      float ss = 0.f;
#pragma unroll
      for (int i = 0; i < 4; ++i) ss += xv[i].x * xv[i].x + xv[i].y * xv[i].y + xv[i].z * xv[i].z + xv[i].w * xv[i].w;
      ss = wave_sum(ss);
      const float rs = rsqrtf(ss * (1.f / 1024.f) + 1e-6f);
#pragma unroll
      for (int i = 0; i < 4; ++i) {
        const int c = i * 256 + lane * 4;
        float4 pg = *(const float4*)(preg + c);
        float4 sh = *(const float4*)(shift + (size_t)b * 9216 + c);
        float4 sc = *(const float4*)(scale + (size_t)b * 9216 + c);
        uint2 o;
        o.x = pack2(xv[i].x * rs * pg.x * (1.f + sc.x) + sh.x, xv[i].y * rs * pg.y * (1.f + sc.y) + sh.y);
        o.y = pack2(xv[i].z * rs * pg.z * (1.f + sc.z) + sh.z, xv[i].w * rs * pg.w * (1.f + sc.w) + sh.w);
        *(uint2*)(h + (size_t)row * D + c) = o;
      }
    }
  }
}

template <int NS, class FA, class FB>
__device__ __forceinline__ void gemm_loop(f32x4 (&acc)[4][NS], const FA& fa, const FB& fb, int K, u16* sm) {
  constexpr int BN = 32 * NS;
  constexpr int NBV = BN / 32;
  const int tid = tidx(), lane = tid & 63, wid = tid >> 6, wr = wid >> 1, wc = wid & 1, fr = lane & 15, fq = lane >> 4;
  u16* As = sm; u16* Bs = sm + 2 * 128 * 64;
  uint4 ra0[4], rb0[NBV], ra1[4], rb1[NBV];
  const int nt = K >> 6;
  const int lrow = tid >> 3, lk = (tid & 7) * 8;
  const int lsw = lrow * 64 + (((tid & 7) ^ ((lrow >> 1) & 7)) << 3);
  const int c0 = (fq ^ ((fr >> 1) & 7)) << 3, c1 = c0 ^ 32;
#define G_LOAD(RA, RB, KT) { const int kb_ = (KT) << 6; \
    _Pragma("unroll") for (int i = 0; i < 4; ++i) RA[i] = fa(lrow + 32 * i, kb_ + lk); \
    _Pragma("unroll") for (int i = 0; i < NBV; ++i) RB[i] = fb(lrow + 32 * i, kb_ + lk); }
#define G_STORE(RA, RB, BUF) { u16* Aw_ = As + (BUF) * 128 * 64 + lsw; u16* Bw_ = Bs + (BUF) * BN * 64 + lsw; \
    _Pragma("unroll") for (int i = 0; i < 4; ++i) *(uint4*)(Aw_ + i * 32 * 64) = RA[i]; \
    _Pragma("unroll") for (int i = 0; i < NBV; ++i) *(uint4*)(Bw_ + i * 32 * 64) = RB[i]; }
#define G_COMPUTE(BUF) { const u16* Ab = As + (BUF) * 128 * 64 + (wr * 64 + fr) * 64; \
    const u16* Bb = Bs + (BUF) * BN * 64 + (wc * 16 * NS + fr) * 64; \
    _Pragma("unroll") for (int ks = 0; ks < 2; ++ks) { bf16x8 a[4], b[NS]; const int co = ks ? c1 : c0; \
      _Pragma("unroll") for (int m = 0; m < 4; ++m) a[m] = *(const bf16x8*)(Ab + m * 16 * 64 + co); \
      _Pragma("unroll") for (int n = 0; n < NS; ++n) b[n] = *(const bf16x8*)(Bb + n * 16 * 64 + co); \
      __builtin_amdgcn_s_setprio(1); \
      _Pragma("unroll") for (int m = 0; m < 4; ++m) _Pragma("unroll") for (int n = 0; n < NS; ++n) acc[m][n] = mfma16(a[m], b[n], acc[m][n]); \
      __builtin_amdgcn_s_setprio(0); } }
  G_LOAD(ra0, rb0, 0)
  if (nt > 1) G_LOAD(ra1, rb1, 1)
  G_STORE(ra0, rb0, 0)
  __syncthreads();
#pragma unroll 1
  for (int kt = 0; kt < nt; kt += 2) {
    if (kt + 2 < nt) G_LOAD(ra0, rb0, kt + 2)
    G_COMPUTE(0)
    if (kt + 1 < nt) G_STORE(ra1, rb1, 1)
    __syncthreads();
    if (kt + 1 >= nt) break;
    if (kt + 3 < nt) G_LOAD(ra1, rb1, kt + 3)
    G_COMPUTE(1)
    if (kt + 2 < nt) G_STORE(ra0, rb0, 0)
    __syncthreads();
  }
#undef G_LOAD
#undef G_STORE
#undef G_COMPUTE
}

template <int NS>
__device__ __forceinline__ void gemm_loop_dma(f32x4 (&acc)[4][NS], const u16* Ab, int lda, const u16* Bb, int ldb, int K, u16* sm) {
  constexpr int BN = 32 * NS;
  constexpr int NBV = BN / 32;
  const int tid = tidx(), lane = tid & 63, wid = tid >> 6, wr = wid >> 1, wc = wid & 1, fr = lane & 15, fq = lane >> 4;
  u16* As = sm; u16* Bs = sm + 2 * 128 * 64;
  const int nt = K >> 6;
  const int lrow = tid >> 3;
  const int gk = (((tid & 7) ^ ((lrow >> 1) & 7)) << 3);
  const int c0 = (fq ^ ((fr >> 1) & 7)) << 3, c1 = c0 ^ 32;
  const u16* ga = Ab + (size_t)lrow * lda + gk;
  const u16* gb = Bb + (size_t)lrow * ldb + gk;
#define D_ISSUE(KT, BUF) { const int kb_ = (KT) << 6; \
    _Pragma("unroll") for (int i = 0; i < 4; ++i) \
      __builtin_amdgcn_global_load_lds((const unsigned*)(ga + (size_t)(32 * i) * lda + kb_), (unsigned*)(As + (BUF) * 128 * 64 + (tid + 256 * i) * 8), 16, 0, 0); \
    _Pragma("unroll") for (int i = 0; i < NBV; ++i) \
      __builtin_amdgcn_global_load_lds((const unsigned*)(gb + (size_t)(32 * i) * ldb + kb_), (unsigned*)(Bs + (BUF) * BN * 64 + (tid + 256 * i) * 8), 16, 0, 0); }
#define D_COMPUTE(BUF) { const u16* Ap = As + (BUF) * 128 * 64 + (wr * 64 + fr) * 64; \
    const u16* Bp = Bs + (BUF) * BN * 64 + (wc * 16 * NS + fr) * 64; \
    _Pragma("unroll") for (int ks = 0; ks < 2; ++ks) { bf16x8 a[4], b[NS]; const int co = ks ? c1 : c0; \
      _Pragma("unroll") for (int m = 0; m < 4; ++m) a[m] = *(const bf16x8*)(Ap + m * 16 * 64 + co); \
      _Pragma("unroll") for (int n = 0; n < NS; ++n) b[n] = *(const bf16x8*)(Bp + n * 16 * 64 + co); \
      __builtin_amdgcn_s_setprio(1); \
      _Pragma("unroll") for (int m = 0; m < 4; ++m) _Pragma("unroll") for (int n = 0; n < NS; ++n) acc[m][n] = mfma16(a[m], b[n], acc[m][n]); \
      __builtin_amdgcn_s_setprio(0); } }
  D_ISSUE(0, 0)
#pragma unroll 1
  for (int kt = 0; kt < nt; kt += 2) {
    __syncthreads();
    if (kt + 1 < nt) D_ISSUE(kt + 1, 1)
    D_COMPUTE(0)
    if (kt + 1 >= nt) break;
    __syncthreads();
    if (kt + 2 < nt) D_ISSUE(kt + 2, 0)
    D_COMPUTE(1)
  }
  __syncthreads();
#undef D_ISSUE
#undef D_COMPUTE
}

__device__ __forceinline__ bool tile_map(int it, int NT, int& mt, int& nt) {
  const int g = gridDim.x;
  if ((g & 7) == 0) {
    const int xcd = blockIdx.x & 7, bx = blockIdx.x >> 3, nbx = g >> 3;
    const int lid = bx + it * nbx;
    if (lid >= 32 * NT) return false;
    const int grp = lid / (8 * NT), rem = lid - grp * 8 * NT;
    nt = rem >> 3; mt = xcd * 32 + grp * 8 + (rem & 7);
    return true;
  } else {
    const int id = blockIdx.x + it * g;
    if (id >= 256 * NT) return false;
    nt = id % NT; mt = id / NT;
    return true;
  }
}

#define ZERO_ACC(acc, NSV) _Pragma("unroll") for (int m_ = 0; m_ < 4; ++m_) _Pragma("unroll") for (int n_ = 0; n_ < NSV; ++n_) acc[m_][n_] = f32x4{0.f, 0.f, 0.f, 0.f};

__device__ __forceinline__ void phase_ffn_in(const Params& p, char* smem) {
  const u16* H = (const u16*)(p.ws + OFF_H); const u16* W = (const u16*)(p.ws + OFF_WIN); u16* ACT = (u16*)(p.ws + OFF_ACT);
  const int lane = tidx() & 63, wid = tidx() >> 6, wr = wid >> 1, wc = wid & 1, fr = lane & 15, fq = lane >> 4;
  int mt, nt;
  for (int it = 0; tile_map(it, 44, mt, nt); ++it) {
    const int m0 = mt * 128, n0 = nt * 128;
    f32x4 acc[4][4]; ZERO_ACC(acc, 4)
    gemm_loop_dma<4>(acc, H + (size_t)m0 * 1024, 1024, W + (size_t)n0 * 1024, 1024, 1024, (u16*)smem);
#pragma unroll
    for (int m = 0; m < 4; ++m)
#pragma unroll
      for (int n = 0; n < 2; ++n) {
        const int col = nt * 64 + wc * 32 + n * 16 + fr;
        const int r0 = m0 + wr * 64 + m * 16 + fq * 4;
#pragma unroll
        for (int j = 0; j < 4; ++j) ACT[(size_t)(r0 + j) * DFF + col] = f2bf(siluf_(acc[m][n][j]) * acc[m][n + 2][j]);
      }
  }
}

__device__ __forceinline__ void phase_gemm_plain(const u16* A, int lda, const u16* Bt, int K, u16* C, char* smem) {
  const int lane = tidx() & 63, wid = tidx() >> 6, wr = wid >> 1, wc = wid & 1, fr = lane & 15, fq = lane >> 4;
  int mt, nt;
  for (int it = 0; tile_map(it, 8, mt, nt); ++it) {
    const int m0 = mt * 128, n0 = nt * 128;
    f32x4 acc[4][4]; ZERO_ACC(acc, 4)
    gemm_loop_dma<4>(acc, A + (size_t)m0 * lda, lda, Bt + (size_t)n0 * K, K, K, (u16*)smem);
#pragma unroll
    for (int m = 0; m < 4; ++m)
#pragma unroll
      for (int n = 0; n < 4; ++n) {
        const int col = n0 + wc * 64 + n * 16 + fr;
        const int r0 = m0 + wr * 64 + m * 16 + fq * 4;
#pragma unroll
        for (int j = 0; j < 4; ++j) C[(size_t)(r0 + j) * 1024 + col] = f2bf(acc[m][n][j]);
      }
  }
}

__device__ __forceinline__ void phase_inproj(const Params& p, char* smem) {
  const u16* H = (const u16*)(p.ws + OFF_H); const u16* W = (const u16*)(p.ws + OFF_WMIX);
  u16* P1 = (u16*)(p.ws + OFF_P1); u16* P2 = (u16*)(p.ws + OFF_P2); u16* VT = (u16*)(p.ws + OFF_VT); u16* PB = (u16*)(p.ws + OFF_PB);
  const int lane = tidx() & 63, wid = tidx() >> 6, wr = wid >> 1, wc = wid & 1, fr = lane & 15, fq = lane >> 4;
  int mt, nt;
  for (int it = 0; tile_map(it, 33, mt, nt); ++it) {
    const int m0 = mt * 128, n0 = nt * 128;
    f32x4 acc[4][4]; ZERO_ACC(acc, 4)
    gemm_loop_dma<4>(acc, H + (size_t)m0 * 1024, 1024, W + (size_t)n0 * 1024, 1024, 1024, (u16*)smem);
#pragma unroll
    for (int m = 0; m < 4; ++m)
#pragma unroll
      for (int nn = 0; nn < 4; ++nn) {
        const int n = n0 + wc * 64 + nn * 16 + fr;
        if (n >= MIXN) continue;
        const int r0 = m0 + wr * 64 + m * 16 + fq * 4;
        f32x4 v = acc[m][nn];
        if ((n >= 896 && n < 1024) || (n >= 1152 && n < 1280)) {
          const int which = (n >= 1152) ? 1 : 0;
          const int gd = n - (which ? 1152 : 896);
          const int b = r0 >> 12, t = r0 & 4095;
          uint2 o; o.x = pack2(v[0], v[1]); o.y = pack2(v[2], v[3]);
          *(uint2*)(VT + ((size_t)((which * 8 + b) * 128 + gd)) * 4096 + (t & ~31) + 8 * fq + 4 * (m & 1)) = o;
        } else if (n < 1304) {
          const int pc = (n < 896) ? n : ((n < 1152) ? n - 128 : n - 256);
          if (n < 512) { const float qs = 0.125f * 1.4426950408889634f; v[0] *= qs; v[1] *= qs; v[2] *= qs; v[3] *= qs; }
          if (n >= 1280) { v[0] = sigmoidf_(v[0]); v[1] = sigmoidf_(v[1]); v[2] = sigmoidf_(v[2]); v[3] = sigmoidf_(v[3]); }
#pragma unroll
          for (int j = 0; j < 4; ++j) P1[(size_t)(r0 + j) * PS1 + pc] = f2bf(v[j]);
        } else if (n < 2328) {
#pragma unroll
          for (int j = 0; j < 4; ++j) P1[(size_t)(r0 + j) * PS1 + (n - 256)] = f2bf(geluf_(v[j]));
        } else {
          const int pc = n - 2328;
#pragma unroll
          for (int j = 0; j < 4; ++j) P2[(size_t)(r0 + j) * PS2 + pc] = f2bf(v[j]);
          if ((m & 1) && fq == 3) PB[(size_t)((r0 + 3) >> 5) * 1792 + pc] = f2bf(v[3]);
        }
      }
  }
}

__device__ __forceinline__ void phase_merge(const Params& p, char* smem) {
  const u16* H2 = (const u16*)(p.ws + OFF_H); const u16* WG = (const u16*)(p.ws + OFF_WG); const u16* WB = (const u16*)(p.ws + OFF_WB);
  const u16* P1 = (const u16*)(p.ws + OFF_P1); u16* MG = (u16*)(p.ws + OFF_MERGED);
  const int lane = tidx() & 63, wid = tidx() >> 6, wr = wid >> 1, wc = wid & 1, fr = lane & 15, fq = lane >> 4;
  int mt, nt;
  for (int it = 0; tile_map(it, 16, mt, nt); ++it) {
    const int m0 = mt * 128, n0 = nt * 64;
    f32x4 tot[4][2]; ZERO_ACC(tot, 2)
#pragma unroll 1
    for (int i = 0; i < 3; ++i) {
      unsigned gpk[4][2][2];
      {
        f32x4 ag[4][2]; ZERO_ACC(ag, 2)
        gemm_loop_dma<2>(ag, H2 + (size_t)m0 * 1024, 1024, WG + (size_t)(i * 1024 + n0) * 1024, 1024, 1024, (u16*)smem);
#pragma unroll
        for (int m = 0; m < 4; ++m)
#pragma unroll
          for (int n = 0; n < 2; ++n) {
            gpk[m][n][0] = pack2(sigmoidf_(ag[m][n][0]), sigmoidf_(ag[m][n][1]));
            gpk[m][n][1] = pack2(sigmoidf_(ag[m][n][2]), sigmoidf_(ag[m][n][3]));
          }
      }
      f32x4 ay[4][2]; ZERO_ACC(ay, 2)
      const u16* ya = (i == 0) ? P1 : ((i == 1) ? P1 + 1048 : P1 + 1560);
      const int lda = PS1;
      const u16* wb = WB + (size_t)i * 1024 * 512;
      gemm_loop_dma<2>(ay, ya + (size_t)m0 * lda, lda, wb + (size_t)n0 * 512, 512, 512, (u16*)smem);
#pragma unroll
      for (int m = 0; m < 4; ++m)
#pragma unroll
        for (int n = 0; n < 2; ++n) {
          tot[m][n][0] += bf2f((u16)(gpk[m][n][0] & 0xffff)) * ay[m][n][0];
          tot[m][n][1] += bf2f((u16)(gpk[m][n][0] >> 16)) * ay[m][n][1];
          tot[m][n][2] += bf2f((u16)(gpk[m][n][1] & 0xffff)) * ay[m][n][2];
          tot[m][n][3] += bf2f((u16)(gpk[m][n][1] >> 16)) * ay[m][n][3];
        }
    }
#pragma unroll
    for (int m = 0; m < 4; ++m)
#pragma unroll
      for (int n = 0; n < 2; ++n) {
        const int col = n0 + wc * 32 + n * 16 + fr;
        const int r0 = m0 + wr * 64 + m * 16 + fq * 4;
#pragma unroll
        for (int j = 0; j < 4; ++j) MG[(size_t)(r0 + j) * 1024 + col] = f2bf(tot[m][n][j]);
      }
  }
}

__device__ __forceinline__ void phase_cmp1(const Params& p, int l, char* smem) {
  const u16* P1 = (const u16*)(p.ws + OFF_P1); const u16* W1 = (const u16*)(p.ws + OFF_W1); u16* HID = (u16*)(p.ws + OFF_HID);
  const int lane = tidx() & 63, wid = tidx() >> 6, wr = wid >> 1, wc = wid & 1, fr = lane & 15, fq = lane >> 4;
  for (int tix = blockIdx.x; tix < 128; tix += gridDim.x) {
    const int which = tix >> 6, mt = (tix >> 1) & 31, nt = tix & 1;
    const int m0 = mt * 128, n0 = nt * 128;
    const float* pe = (which ? p.in[16] : p.in[13]) + (size_t)l * 2048;
    const u16* w1 = W1 + (size_t)which * 256 * 2048;
    const int cbase = 512 + which * 128;
    f32x4 acc[4][4]; ZERO_ACC(acc, 4)
    auto fa = [&](int r, int k) {
      const int row = m0 + r; const int g = row & 1, n = (row >> 1) & 255, b = row >> 9;
      uint4 o = make_uint4(0, 0, 0, 0);
      if (n < 255) {
        const int lpos = k >> 6, d = k & 63;
        uint4 raw = *(const uint4*)(P1 + (size_t)(b * 4096 + 16 * n + lpos) * PS1 + cbase + g * 64 + d);
        const float* pp = pe + lpos * 64 + d;
        float4 e0 = *(const float4*)pp, e1 = *(const float4*)(pp + 4);
        o.x = pack2(bf2f((u16)(raw.x & 0xffff)) + e0.x, bf2f((u16)(raw.x >> 16)) + e0.y);
        o.y = pack2(bf2f((u16)(raw.y & 0xffff)) + e0.z, bf2f((u16)(raw.y >> 16)) + e0.w);
        o.z = pack2(bf2f((u16)(raw.z & 0xffff)) + e1.x, bf2f((u16)(raw.z >> 16)) + e1.y);
        o.w = pack2(bf2f((u16)(raw.w & 0xffff)) + e1.z, bf2f((u16)(raw.w >> 16)) + e1.w);
      }
      return o;
    };
    auto fb = [&](int r, int k) { return *(const uint4*)(w1 + (size_t)(n0 + r) * 2048 + k); };
    gemm_loop<4>(acc, fa, fb, 2048, (u16*)smem);
#pragma unroll
    for (int m = 0; m < 4; ++m)
#pragma unroll
      for (int n = 0; n < 4; ++n) {
        const int col = n0 + wc * 64 + n * 16 + fr;
        const int r0 = m0 + wr * 64 + m * 16 + fq * 4;
#pragma unroll
        for (int j = 0; j < 4; ++j) HID[((size_t)which * 4096 + r0 + j) * 256 + col] = f2bf(siluf_(acc[m][n][j]));
      }
  }
}

__device__ __forceinline__ void phase_cmp2(const Params& p, int l) {
  const u16* HID = (const u16*)(p.ws + OFF_HID); u16* KC = (u16*)(p.ws + OFF_KC); u16* VC = (u16*)(p.ws + OFF_VC);
  const int total = 2 * 4096 * 64;
  for (int idx = blockIdx.x * 256 + tidx(); idx < total; idx += gridDim.x * 256) {
    const int d = idx & 63, row = (idx >> 6) & 4095, which = idx >> 18;
    const float* w2 = (which ? p.in[15] : p.in[12]) + (size_t)l * 256 * 64;
    const u16* hr = HID + ((size_t)which * 4096 + row) * 256;
    float acc = 0.f;
#pragma unroll 8
    for (int j = 0; j < 256; ++j) acc += bf2f(hr[j]) * w2[j * 64 + d];
    const int g = row & 1, n = (row >> 1) & 255, b = row >> 9;
    if (which == 0) KC[((size_t)(b * 2 + g) * 256 + n) * 64 + d] = f2bf(acc);
    else {
      const int u = n & 31; const int pp = 8 * ((u >> 2) & 3) + 4 * (u >> 4) + (u & 3);
      VC[((size_t)(b * 2 + g) * 64 + d) * 256 + (n & ~31) + pp] = f2bf(acc);
    }
  }
}

__device__ __forceinline__ void phase_sgu(const Params& p, int l, char* smem) {
  u16* P1 = (u16*)(p.ws + OFF_P1);
  u16* Wt = (u16*)smem;
  u16* Vt = Wt + 128 * 136;
  float* st = (float*)(Vt + 128 * 136);
  const int tid = tidx(), lane = tid & 63, wid = tid >> 6, wr = wid >> 1, wc = wid & 1, fr = lane & 15, fq = lane >> 4;
  const float* lng = p.in[17] + (size_t)l * 512; const float* lnb = p.in[18] + (size_t)l * 512;
  for (int item = blockIdx.x; item < 1024; item += gridDim.x) {
    const int ci = item >> 2, gi = item & 3;
    const int tok0 = ci * 128;
#pragma unroll 1
    for (int r0 = wid * 32; r0 < wid * 32 + 32; r0 += 8) {
      uint4 raw[8];
#pragma unroll
      for (int u = 0; u < 8; ++u) raw[u] = *(const uint4*)(P1 + (size_t)(tok0 + r0 + u) * PS1 + 1560 + lane * 8);
#pragma unroll
      for (int u = 0; u < 8; ++u) {
        float f[8];
        f[0] = bf2f((u16)(raw[u].x & 0xffff)); f[1] = bf2f((u16)(raw[u].x >> 16)); f[2] = bf2f((u16)(raw[u].y & 0xffff)); f[3] = bf2f((u16)(raw[u].y >> 16));
        f[4] = bf2f((u16)(raw[u].z & 0xffff)); f[5] = bf2f((u16)(raw[u].z >> 16)); f[6] = bf2f((u16)(raw[u].w & 0xffff)); f[7] = bf2f((u16)(raw[u].w >> 16));
        float s = 0.f, s2 = 0.f;
#pragma unroll
        for (int e = 0; e < 8; ++e) { s += f[e]; }
        s = wave_sum(s);
        const float mu = s * (1.f / 512.f);
#pragma unroll
        for (int e = 0; e < 8; ++e) { float dlt = f[e] - mu; s2 += dlt * dlt; }
        s2 = wave_sum(s2);
        if (lane == 0) { st[(r0 + u) * 2] = mu; st[(r0 + u) * 2 + 1] = rsqrtf(s2 * (1.f / 512.f) + 1e-5f); }
      }
    }
    const float* wsrc = p.in[19] + ((size_t)(l * 4 + gi)) * 128 * 128;
    for (int e = tid; e < 128 * 32; e += 256) {
      const int t = e >> 5, s4 = (e & 31) * 4;
      float4 w = *(const float4*)(wsrc + t * 128 + s4);
      uint2 o;
      o.x = pack2(s4 + 0 <= t ? w.x : 0.f, s4 + 1 <= t ? w.y : 0.f);
      o.y = pack2(s4 + 2 <= t ? w.z : 0.f, s4 + 3 <= t ? w.w : 0.f);
      *(uint2*)(Wt + t * 136 + s4) = o;
    }
    __syncthreads();
    for (int e = tid; e < 128 * 16; e += 256) {
      const int s = e >> 4, c8 = (e & 15) * 8;
      uint4 raw = *(const uint4*)(P1 + (size_t)(tok0 + s) * PS1 + 1560 + gi * 128 + c8);
      const float mu = st[s * 2], rs = st[s * 2 + 1];
      u16 rv[8] = {(u16)(raw.x & 0xffff), (u16)(raw.x >> 16), (u16)(raw.y & 0xffff), (u16)(raw.y >> 16), (u16)(raw.z & 0xffff), (u16)(raw.z >> 16), (u16)(raw.w & 0xffff), (u16)(raw.w >> 16)};
#pragma unroll
      for (int i = 0; i < 8; ++i) {
        const int c = gi * 128 + c8 + i;
        Vt[(c8 + i) * 136 + s] = f2bf((bf2f(rv[i]) - mu) * rs * lng[c] + lnb[c]);
      }
    }
    __syncthreads();
    f32x4 acc[4][4]; ZERO_ACC(acc, 4)
#pragma unroll 1
    for (int ks = 0; ks < 4; ++ks) {
      bf16x8 a[4], b[4];
#pragma unroll
      for (int m = 0; m < 4; ++m) a[m] = *(const bf16x8*)(Wt + (wr * 64 + m * 16 + fr) * 136 + ks * 32 + fq * 8);
#pragma unroll
      for (int n = 0; n < 4; ++n) b[n] = *(const bf16x8*)(Vt + (wc * 64 + n * 16 + fr) * 136 + ks * 32 + fq * 8);
#pragma unroll
      for (int m = 0; m < 4; ++m)
#pragma unroll
        for (int n = 0; n < 4; ++n) acc[m][n] = mfma16(a[m], b[n], acc[m][n]);
    }
    const float* bs = p.in[20] + ((size_t)(l * 4 + gi)) * 128;
#pragma unroll
    for (int m = 0; m < 4; ++m)
#pragma unroll
      for (int n = 0; n < 4; ++n) {
        const int c = wc * 64 + n * 16 + fr;
#pragma unroll
        for (int j = 0; j < 4; ++j) {
          const int t = wr * 64 + m * 16 + fq * 4 + j;
          u16* up = P1 + (size_t)(tok0 + t) * PS1 + 1048 + gi * 128 + c;
          *up = f2bf(bf2f(*up) * (acc[m][n][j] + bs[t]));
        }
      }
    __syncthreads();
  }
}

__device__ __forceinline__ void phase_prep1(const Params& p, int l) {
  u16* P2 = (u16*)(p.ws + OFF_P2); const u16* PB = (const u16*)(p.ws + OFF_PB); u16* VF = (u16*)(p.ws + OFF_VFIRST);
  const float* mu = p.in[21] + (size_t)l * 1792;
  const int total = 1024 * 224;
  for (int idx = blockIdx.x * 256 + tidx(); idx < total; idx += gridDim.x * 256) {
    const int tile = idx / 224, cg8 = (idx % 224) * 8;
    const int tok0 = tile * 32;
    float m8[8];
#pragma unroll
    for (int e = 0; e < 8; ++e) m8[e] = mu[cg8 + e];
    uint4 prev = make_uint4(0, 0, 0, 0);
    if ((tok0 & 4095) != 0) prev = *(const uint4*)(PB + (size_t)(tile - 1) * 1792 + cg8);
#pragma unroll 1
    for (int r0 = 0; r0 < 32; r0 += 8) {
      uint4 cv[8];
#pragma unroll
      for (int u = 0; u < 8; ++u) cv[u] = *(const uint4*)(P2 + (size_t)(tok0 + r0 + u) * PS2 + cg8);
#pragma unroll
      for (int u = 0; u < 8; ++u) {
        const uint4 cur = cv[u];
        unsigned cu[4] = {cur.x, cur.y, cur.z, cur.w}, pu[4] = {prev.x, prev.y, prev.z, prev.w};
        float o[8];
#pragma unroll
        for (int e = 0; e < 8; ++e) {
          float c = bf2f((u16)((cu[e >> 1] >> ((e & 1) * 16)) & 0xffff));
          float pv = bf2f((u16)((pu[e >> 1] >> ((e & 1) * 16)) & 0xffff));
          float sv = c + (pv - c) * m8[e];
          if (cg8 >= 1536 && cg8 < 1600) sv = tanhf_(sv);
          else if (cg8 >= 1664) sv = sigmoidf_(sv);
          o[e] = sv;
        }
        uint4 ov; ov.x = pack2(o[0], o[1]); ov.y = pack2(o[2], o[3]); ov.z = pack2(o[4], o[5]); ov.w = pack2(o[6], o[7]);
        *(uint4*)(P2 + (size_t)(tok0 + r0 + u) * PS2 + cg8) = ov;
        if (l == 0 && cg8 >= 1024 && cg8 < 1536) *(uint4*)(VF + (size_t)(tok0 + r0 + u) * 512 + cg8 - 1024) = ov;
        prev = cur;
      }
    }
  }
}

__device__ __forceinline__ void phase_prep2(const Params& p, int l, char* smem) {
  u16* P2 = (u16*)(p.ws + OFF_P2); const u16* VF = (const u16*)(p.ws + OFF_VFIRST);
  float* twd = (float*)smem;
  float* adl = twd + 1024;
  float* vsh = adl + 1024;
  float* lv = vsh + 8192;
  const int tid = tidx();
  const float* w0 = p.in[22] + (size_t)l * 512; const float* w2 = p.in[23] + (size_t)l * 64 * 512;
  const float* a0 = p.in[24] + (size_t)l * 512; const float* a2 = p.in[25] + (size_t)l * 64 * 512;
  const float* kkp = p.in[27] + (size_t)l * 512; const float* kap = p.in[28] + (size_t)l * 512;
  for (int item = blockIdx.x; item < 2048; item += gridDim.x) {
    const int tok0 = item * 16;
    for (int e = tid; e < 2048; e += 256) {
      const int r = e >> 7, c = e & 127;
      twd[(c >> 6) * 1024 + r * 64 + (c & 63)] = bf2f(P2[(size_t)(tok0 + r) * PS2 + 1536 + c]);
    }
    if (l > 0) {
      for (int e = tid; e < 8192; e += 256) { const int r = e >> 9, c = e & 511; vsh[e] = bf2f(P2[(size_t)(tok0 + r) * PS2 + 1024 + c]); }
    }
    __syncthreads();
    if (l > 0) {
      const float* v1 = p.in[33];
      for (int e = tid; e < 512; e += 256) {
        const int r = e >> 5, j = e & 31;
        float s = 0.f;
#pragma unroll 2
        for (int c = 0; c < 512; c += 4) {
          const float4 t4 = *(const float4*)(vsh + r * 512 + c);
          s += t4.x * v1[c * 32 + j] + t4.y * v1[(c + 1) * 32 + j] + t4.z * v1[(c + 2) * 32 + j] + t4.w * v1[(c + 3) * 32 + j];
        }
        lv[r * 32 + j] = s;
      }
      __syncthreads();
    }
    {
      float aw[2][16], aa[2][16], am[2][16];
#pragma unroll
      for (int c = 0; c < 2; ++c)
#pragma unroll
        for (int r = 0; r < 16; ++r) { aw[c][r] = 0.f; aa[c][r] = 0.f; am[c][r] = 0.f; }
#pragma unroll 2
      for (int i = 0; i < 64; i += 4) {
        float wv[2][4], av[2][4];
#pragma unroll
        for (int c = 0; c < 2; ++c)
#pragma unroll
          for (int u = 0; u < 4; ++u) { wv[c][u] = w2[(i + u) * 512 + tid + c * 256]; av[c][u] = a2[(i + u) * 512 + tid + c * 256]; }
#pragma unroll
        for (int r = 0; r < 16; ++r) {
          const float4 tw = *(const float4*)(twd + r * 64 + i);
          const float4 ta = *(const float4*)(adl + r * 64 + i);
#pragma unroll
          for (int c = 0; c < 2; ++c) {
            aw[c][r] += tw.x * wv[c][0] + tw.y * wv[c][1] + tw.z * wv[c][2] + tw.w * wv[c][3];
            aa[c][r] += ta.x * av[c][0] + ta.y * av[c][1] + ta.z * av[c][2] + ta.w * av[c][3];
          }
        }
      }
      if (l > 0) {
        const float* v2 = p.in[34];
#pragma unroll 2
        for (int j = 0; j < 32; j += 4) {
          float vv[2][4];
#pragma unroll
          for (int c = 0; c < 2; ++c)
#pragma unroll
            for (int u = 0; u < 4; ++u) vv[c][u] = v2[(j + u) * 512 + tid + c * 256];
#pragma unroll
          for (int r = 0; r < 16; ++r) {
            const float4 t4 = *(const float4*)(lv + r * 32 + j);
#pragma unroll
            for (int c = 0; c < 2; ++c) am[c][r] += t4.x * vv[c][0] + t4.y * vv[c][1] + t4.z * vv[c][2] + t4.w * vv[c][3];
          }
        }
      }
#pragma unroll
      for (int c = 0; c < 2; ++c) {
        const int ch = tid + c * 256;
        const float w0v = w0[ch], a0v = a0[ch], kkv = kkp[ch], kav = kap[ch];
        const float v0v = (l > 0) ? p.in[32][ch] : 0.f;
        float kval[16];
#pragma unroll
        for (int r = 0; r < 16; ++r) kval[r] = bf2f(P2[(size_t)(tok0 + r) * PS2 + 512 + ch]);
#pragma unroll
        for (int r = 0; r < 16; ++r) {
          u16* row = P2 + (size_t)(tok0 + r) * PS2;
          const float wpre = w0v + aw[c][r];
          const float nx = -wpre;
          const float sp = fmaxf(nx, 0.f) + __logf(1.f + __expf(-fabsf(nx)));
          const float w = -sp - 0.5f;
          const float decay = __expf(-__expf(w));
          const float a = sigmoidf_(a0v + aa[c][r]);
          const float kk = kval[r] * kkv;
          const float ss = wave_sum(kk * kk);
          const float kkn = kk / fmaxf(sqrtf(ss), 1e-12f);
          row[1792 + ch] = f2bf(decay);
          row[2304 + ch] = f2bf(kkn);
          row[2816 + ch] = f2bf(kkn * a);
          row[512 + ch] = f2bf(kval[r] * (1.f + (a - 1.f) * kav));
          if (l > 0) {
            const float v = vsh[r * 512 + ch];
            const float vf = bf2f(VF[(size_t)(tok0 + r) * 512 + ch]);
            row[1024 + ch] = f2bf(v + (vf - v) * sigmoidf_(v0v + am[c][r]));
          }
        }
      }
    }
    __syncthreads();
  }
}

__device__ __forceinline__ void unpack4(uint2 u, float (&f)[4]) {
  f[0] = bf2f((u16)(u.x & 0xffff)); f[1] = bf2f((u16)(u.x >> 16)); f[2] = bf2f((u16)(u.y & 0xffff)); f[3] = bf2f((u16)(u.y >> 16));
}
__device__ __forceinline__ float quad_sum(float v) { v += __shfl_xor(v, 16); v += __shfl_xor(v, 32); return v; }

__device__ __forceinline__ void phase_prep2m(const Params& p, int l, char* smem) {
  u16* P2 = (u16*)(p.ws + OFF_P2); const u16* VF = (const u16*)(p.ws + OFF_VFIRST); const u16* WL = (const u16*)(p.ws + OFF_WL);
  u16* twl = (u16*)smem;
  u16* adl = twl + 16 * 72;
  u16* vl = adl + 16 * 72;
  const int tid = tidx(), lane = tid & 63, w = tid >> 6, fr = lane & 15, fq = lane >> 4;
  const float* w0 = p.in[22] + (size_t)l * 512; const float* a0 = p.in[24] + (size_t)l * 512;
  const float* kkp = p.in[27] + (size_t)l * 512; const float* kap = p.in[28] + (size_t)l * 512;
#pragma unroll 1
  for (int item = blockIdx.x; item < 2048; item += gridDim.x) {
    const int tok0 = item * 16;
    {
      const int r = tid >> 4, c = tid & 15;
      const uint4 v = *(const uint4*)(P2 + (size_t)(tok0 + r) * PS2 + 1536 + c * 8);
      if (c < 8) *(uint4*)(twl + r * 72 + c * 8) = v; else *(uint4*)(adl + r * 72 + (c - 8) * 8) = v;
    }
    if (l > 0) {
#pragma unroll
      for (int i = 0; i < 4; ++i) {
        const int idx = tid + 256 * i, r = idx >> 6, c = idx & 63;
        *(uint4*)(vl + r * 520 + c * 8) = *(const uint4*)(P2 + (size_t)(tok0 + r) * PS2 + 1024 + c * 8);
      }
    }
    __syncthreads();
    bf16x8 xw[2], xa[2];
#pragma unroll
    for (int ks = 0; ks < 2; ++ks) { xw[ks] = *(const bf16x8*)(twl + fr * 72 + ks * 32 + fq * 8); xa[ks] = *(const bf16x8*)(adl + fr * 72 + ks * 32 + fq * 8); }
    bf16x8 plv = {0, 0, 0, 0, 0, 0, 0, 0};
    if (l > 0) {
      f32x4 lv0 = {0.f, 0.f, 0.f, 0.f}, lv1 = {0.f, 0.f, 0.f, 0.f};
#pragma unroll 4
      for (int ks = 0; ks < 16; ++ks) {
        const bf16x8 xb = *(const bf16x8*)(vl + fr * 520 + ks * 32 + fq * 8);
        const bf16x8 a0f = *(const bf16x8*)(WL + WL_V1 + (size_t)fr * 512 + ks * 32 + fq * 8);
        const bf16x8 a1f = *(const bf16x8*)(WL + WL_V1 + (size_t)(16 + fr) * 512 + ks * 32 + fq * 8);
        lv0 = mfma16(a0f, xb, lv0); lv1 = mfma16(a1f, xb, lv1);
      }
      uint4 u; u.x = pack2(lv0[0], lv0[1]); u.y = pack2(lv0[2], lv0[3]); u.z = pack2(lv1[0], lv1[1]); u.w = pack2(lv1[2], lv1[3]);
      plv = *(bf16x8*)&u;
    }
    const size_t tok = (size_t)tok0 + fr;
    u16* row = P2 + tok * PS2;
#pragma unroll 1
    for (int hh = 0; hh < 2; ++hh) {
      f32x4 aw[4], aa[4], am[4];
#pragma unroll
      for (int m4 = 0; m4 < 4; ++m4) {
        const int chr = w * 128 + (hh * 4 + m4) * 16 + fr;
        f32x4 cw = {0.f, 0.f, 0.f, 0.f}, ca = {0.f, 0.f, 0.f, 0.f}, cm = {0.f, 0.f, 0.f, 0.f};
#pragma unroll
        for (int ks = 0; ks < 2; ++ks) {
          cw = mfma16(*(const bf16x8*)(WL + WL_W2 + (size_t)chr * 64 + ks * 32 + fq * 8), xw[ks], cw);
          ca = mfma16(*(const bf16x8*)(WL + WL_A2 + (size_t)chr * 64 + ks * 32 + fq * 8), xa[ks], ca);
        }
        if (l > 0) {
          const uint2 g0 = *(const uint2*)(WL + WL_V2 + (size_t)chr * 64 + 4 * fq);
          const uint2 g1 = *(const uint2*)(WL + WL_V2 + (size_t)chr * 64 + 16 + 4 * fq);
          uint4 u; u.x = g0.x; u.y = g0.y; u.z = g1.x; u.w = g1.y;
          cm = mfma16(*(bf16x8*)&u, plv, cm);
        }
        aw[m4] = cw; aa[m4] = ca; am[m4] = cm;
      }
      float kv[4][4], av[4][4], kk[4][4];
      float ss = 0.f;
#pragma unroll
      for (int m4 = 0; m4 < 4; ++m4) {
        const int ch0 = w * 128 + (hh * 4 + m4) * 16 + 4 * fq;
        unpack4(*(const uint2*)(row + 512 + ch0), kv[m4]);
        const float4 a0v = *(const float4*)(a0 + ch0), kkv = *(const float4*)(kkp + ch0);
        const float a0a[4] = {a0v.x, a0v.y, a0v.z, a0v.w}, kka[4] = {kkv.x, kkv.y, kkv.z, kkv.w};
#pragma unroll
        for (int j = 0; j < 4; ++j) {
          av[m4][j] = sigmoidf_(a0a[j] + aa[m4][j]);
          kk[m4][j] = kv[m4][j] * kka[j];
          ss += kk[m4][j] * kk[m4][j];
        }
      }
      ss = quad_sum(ss);
      const float rn = 1.f / fmaxf(sqrtf(ss), 1e-12f);
#pragma unroll
      for (int m4 = 0; m4 < 4; ++m4) {
        const int ch0 = w * 128 + (hh * 4 + m4) * 16 + 4 * fq;
        const float4 w0v = *(const float4*)(w0 + ch0), kav = *(const float4*)(kap + ch0);
        const float w0a[4] = {w0v.x, w0v.y, w0v.z, w0v.w}, kaa[4] = {kav.x, kav.y, kav.z, kav.w};
        float dc[4], kn[4], bb[4], kp[4];
#pragma unroll
        for (int j = 0; j < 4; ++j) {
          const float nx = -(w0a[j] + aw[m4][j]);
          const float sp = fmaxf(nx, 0.f) + __logf(1.f + __expf(-fabsf(nx)));
          dc[j] = __expf(-__expf(-sp - 0.5f));
          kn[j] = kk[m4][j] * rn;
          bb[j] = kn[j] * av[m4][j];
          kp[j] = kv[m4][j] * (1.f + (av[m4][j] - 1.f) * kaa[j]);
        }
        uint2 o;
        o.x = pack2(dc[0], dc[1]); o.y = pack2(dc[2], dc[3]); *(uint2*)(row + 1792 + ch0) = o;
        o.x = pack2(kn[0], kn[1]); o.y = pack2(kn[2], kn[3]); *(uint2*)(row + 2304 + ch0) = o;
        o.x = pack2(bb[0], bb[1]); o.y = pack2(bb[2], bb[3]); *(uint2*)(row + 2816 + ch0) = o;
        o.x = pack2(kp[0], kp[1]); o.y = pack2(kp[2], kp[3]); *(uint2*)(row + 512 + ch0) = o;
        if (l > 0) {
          float vv[4], vf[4];
          unpack4(*(const uint2*)(vl + fr * 520 + ch0), vv);
          unpack4(*(const uint2*)(VF + tok * 512 + ch0), vf);
          const float4 v0v = *(const float4*)(p.in[32] + ch0);
          const float v0a[4] = {v0v.x, v0v.y, v0v.z, v0v.w};
          float vo[4];
#pragma unroll
          for (int j = 0; j < 4; ++j) vo[j] = vv[j] + (vf[j] - vv[j]) * sigmoidf_(v0a[j] + am[m4][j]);
          o.x = pack2(vo[0], vo[1]); o.y = pack2(vo[2], vo[3]); *(uint2*)(row + 1024 + ch0) = o;
        }
      }
    }
    __syncthreads();
  }
}

__device__ __forceinline__ void phase_postm(const Params& p, int l, char* smem) {
  const u16* P2 = (const u16*)(p.ws + OFF_P2); u16* YC = (u16*)(p.ws + OFF_P1) + 1560; const u16* WL = (const u16*)(p.ws + OFF_WL);
  u16* sgl = (u16*)smem;
  const int tid = tidx(), lane = tid & 63, w = tid >> 6, fr = lane & 15, fq = lane >> 4;
  const float* rk = p.in[29] + (size_t)l * 512; const float* lg = p.in[30] + (size_t)l * 512; const float* lb = p.in[31] + (size_t)l * 512;
#pragma unroll 1
  for (int item = blockIdx.x; item < 2048; item += gridDim.x) {
    const int tok0 = item * 16;
    {
      const int r = tid >> 4, c = tid & 15;
      *(uint4*)(sgl + r * 136 + c * 8) = *(const uint4*)(P2 + (size_t)(tok0 + r) * PS2 + 1664 + c * 8);
    }
    __syncthreads();
    bf16x8 xb[4];
#pragma unroll
    for (int ks = 0; ks < 4; ++ks) xb[ks] = *(const bf16x8*)(sgl + fr * 136 + ks * 32 + fq * 8);
    const size_t tok = (size_t)tok0 + fr;
    const u16* row = P2 + tok * PS2;
    u16* yrow = YC + tok * PS1;
#pragma unroll 1
    for (int hh = 0; hh < 2; ++hh) {
      f32x4 ag[4];
#pragma unroll
      for (int m4 = 0; m4 < 4; ++m4) {
        const int chr = w * 128 + (hh * 4 + m4) * 16 + fr;
        f32x4 c = {0.f, 0.f, 0.f, 0.f};
#pragma unroll
        for (int ks = 0; ks < 4; ++ks) c = mfma16(*(const bf16x8*)(WL + WL_G2 + (size_t)chr * 128 + ks * 32 + fq * 8), xb[ks], c);
        ag[m4] = c;
      }
      float yv[4][4], vv[4][4];
      float s1 = 0.f, sb = 0.f;
#pragma unroll
      for (int m4 = 0; m4 < 4; ++m4) {
        const int ch0 = w * 128 + (hh * 4 + m4) * 16 + 4 * fq;
        float rr[4], kk[4];
        unpack4(*(const uint2*)(yrow + ch0), yv[m4]);
        unpack4(*(const uint2*)(row + ch0), rr);
        unpack4(*(const uint2*)(row + 512 + ch0), kk);
        unpack4(*(const uint2*)(row + 1024 + ch0), vv[m4]);
        const float4 rkv = *(const float4*)(rk + ch0);
        s1 += yv[m4][0] + yv[m4][1] + yv[m4][2] + yv[m4][3];
        sb += rr[0] * kk[0] * rkv.x + rr[1] * kk[1] * rkv.y + rr[2] * kk[2] * rkv.z + rr[3] * kk[3] * rkv.w;
      }
      s1 = quad_sum(s1); sb = quad_sum(sb);
      const float mean = s1 * (1.f / 64.f);
      float s2 = 0.f;
#pragma unroll
      for (int m4 = 0; m4 < 4; ++m4)
#pragma unroll
        for (int j = 0; j < 4; ++j) { const float d = yv[m4][j] - mean; s2 += d * d; }
      s2 = quad_sum(s2);
      const float rs = rsqrtf(s2 * (1.f / 64.f) + 64e-5f);
#pragma unroll
      for (int m4 = 0; m4 < 4; ++m4) {
        const int ch0 = w * 128 + (hh * 4 + m4) * 16 + 4 * fq;
        const float4 lgv = *(const float4*)(lg + ch0), lbv = *(const float4*)(lb + ch0);
        const float lga[4] = {lgv.x, lgv.y, lgv.z, lgv.w}, lba[4] = {lbv.x, lbv.y, lbv.z, lbv.w};
        float o4[4];
#pragma unroll
        for (int j = 0; j < 4; ++j) o4[j] = ((yv[m4][j] - mean) * rs * lga[j] + lba[j] + sb * vv[m4][j]) * ag[m4][j];
        uint2 o; o.x = pack2(o4[0], o4[1]); o.y = pack2(o4[2], o4[3]);
        *(uint2*)(yrow + ch0) = o;
      }
    }
    __syncthreads();
  }
}

__device__ __forceinline__ void scan_item(const Params& p, int item, char* smem) {
  const u16* P2 = (const u16*)(p.ws + OFF_P2); u16* YC = (u16*)(p.ws + OFF_P1) + 1560;
  float* vb = (float*)smem;
  float* yb = vb + 2 * 6 * 16 * 64;
  const int tid = tidx(), lane = tid & 63, wid = tid >> 6;
  const int rq = item & 3, h = (item >> 2) & 7, b = item >> 5;
  const int rl = lane >> 4, cq = lane & 15;
  const int rloc = wid * 4 + rl;
  const int ihead = rq * 16 + rloc;
  const int j0 = cq * 4;
  const size_t tokb = (size_t)b * 4096;
  float s0 = 0.f, s1 = 0.f, s2 = 0.f, s3 = 0.f;
  uint4 pA[3], pB[3], pC[3];
  auto gload = [&](uint4 (&pre)[3], int c) {
#pragma unroll
    for (int i = 0; i < 3; ++i) {
      const int v = tid + i * 256; const int vec = v >> 7, rem = v & 127, step = rem >> 3, c8 = rem & 7;
      const int off = (vec == 0) ? 0 : (vec == 1) ? 1792 : (vec == 2) ? 512 : (vec == 3) ? 1024 : (vec == 4) ? 2304 : 2816;
      pre[i] = *(const uint4*)(P2 + (tokb + c * 16 + step) * PS2 + off + h * 64 + c8 * 8);
    }
  };
  auto lstore = [&](const uint4 (&pre)[3], int buf) {
#pragma unroll
    for (int i = 0; i < 3; ++i) {
      const int v = tid + i * 256; const int vec = v >> 7, rem = v & 127, step = rem >> 3, c8 = rem & 7;
      float* d = vb + ((buf * 6 + vec) * 16 + step) * 64 + c8 * 8;
      float4 f0, f1;
      f0.x = bf2f((u16)(pre[i].x & 0xffff)); f0.y = bf2f((u16)(pre[i].x >> 16)); f0.z = bf2f((u16)(pre[i].y & 0xffff)); f0.w = bf2f((u16)(pre[i].y >> 16));
      f1.x = bf2f((u16)(pre[i].z & 0xffff)); f1.y = bf2f((u16)(pre[i].z >> 16)); f1.z = bf2f((u16)(pre[i].w & 0xffff)); f1.w = bf2f((u16)(pre[i].w >> 16));
      *(float4*)d = f0; *(float4*)(d + 4) = f1;
    }
  };
#define SC_LOAD(X, ST) { r##X = *(const float4*)(base + (0 * 16 + (ST)) * 64 + j0); w##X = *(const float4*)(base + (1 * 16 + (ST)) * 64 + j0); \
      k##X = *(const float4*)(base + (2 * 16 + (ST)) * 64 + j0); v##X = base[(3 * 16 + (ST)) * 64 + ihead]; \
      n##X = *(const float4*)(base + (4 * 16 + (ST)) * 64 + j0); b##X = *(const float4*)(base + (5 * 16 + (ST)) * 64 + j0); }
#define SC_STEP(X, ST) { float sa = s0 * n##X.x + s1 * n##X.y + s2 * n##X.z + s3 * n##X.w; \
      sa = -dpp_sum16(sa); \
      s0 = s0 * w##X.x + sa * b##X.x + v##X * k##X.x; s1 = s1 * w##X.y + sa * b##X.y + v##X * k##X.y; \
      s2 = s2 * w##X.z + sa * b##X.z + v##X * k##X.z; s3 = s3 * w##X.w + sa * b##X.w + v##X * k##X.w; \
      float y = s0 * r##X.x + s1 * r##X.y + s2 * r##X.z + s3 * r##X.w; \
      y = dpp_sum16(y); yb[(ST) * 16 + rloc] = y; }
#define SC_CHUNK(CC, PRE) { const int cc_ = (CC); if (cc_ >= 256) break; \
    const float* base = vb + (cc_ & 1) * 6 * 16 * 64; \
    { float4 rA, wA, kA, nA, bA, rB, wB, kB, nB, bB; float vA, vB; \
      SC_LOAD(A, 0) \
      _Pragma("unroll") for (int st = 0; st < 16; st += 2) { SC_LOAD(B, st + 1) SC_STEP(A, st) if (st + 2 < 16) SC_LOAD(A, st + 2) SC_STEP(B, st + 1) } } \
    __syncthreads(); \
    { const int st = tid >> 4, r = tid & 15; \
      YC[(tokb + cc_ * 16 + st) * PS1 + h * 64 + rq * 16 + r] = f2bf(yb[st * 16 + r]); } \
    if (cc_ + 1 < 256) lstore(PRE, (cc_ + 1) & 1); \
    if (cc_ + 4 < 256) gload(PRE, cc_ + 4); \
    __syncthreads(); }
  gload(pA, 0); lstore(pA, 0);
  __syncthreads();
  gload(pA, 1); gload(pB, 2); gload(pC, 3);
#pragma unroll 1
  for (int c = 0; c < 256; c += 3) {
    SC_CHUNK(c, pA)
    SC_CHUNK(c + 1, pB)
    SC_CHUNK(c + 2, pC)
  }
#undef SC_LOAD
#undef SC_STEP
#undef SC_CHUNK
}

__device__ __forceinline__ void phase_post(const Params& p, int l, char* smem) {
  const u16* P2 = (const u16*)(p.ws + OFF_P2); u16* YC = (u16*)(p.ws + OFF_P1) + 1560;
  float* sg = (float*)smem;
  const int tid = tidx();
  const float* g2 = p.in[26] + (size_t)l * 128 * 512;
  const float* rk = p.in[29] + (size_t)l * 512; const float* lg = p.in[30] + (size_t)l * 512; const float* lb = p.in[31] + (size_t)l * 512;
  for (int item = blockIdx.x; item < 2048; item += gridDim.x) {
    const int tok0 = item * 16;
    for (int e = tid; e < 2048; e += 256) { const int r = e >> 7, c = e & 127; sg[e] = bf2f(P2[(size_t)(tok0 + r) * PS2 + 1664 + c]); }
    __syncthreads();
    {
      float ag[2][16];
#pragma unroll
      for (int c = 0; c < 2; ++c)
#pragma unroll
        for (int r = 0; r < 16; ++r) ag[c][r] = 0.f;
#pragma unroll 4
      for (int i = 0; i < 128; i += 4) {
        float gv[2][4];
#pragma unroll
        for (int c = 0; c < 2; ++c)
#pragma unroll
          for (int u = 0; u < 4; ++u) gv[c][u] = g2[(i + u) * 512 + tid + c * 256];
#pragma unroll
        for (int r = 0; r < 16; ++r) {
          const float4 t4 = *(const float4*)(sg + r * 128 + i);
#pragma unroll
          for (int c = 0; c < 2; ++c) ag[c][r] += t4.x * gv[c][0] + t4.y * gv[c][1] + t4.z * gv[c][2] + t4.w * gv[c][3];
        }
      }
#pragma unroll
      for (int c = 0; c < 2; ++c) {
        const int ch = tid + c * 256;
        const float rkv = rk[ch], lgv = lg[ch], lbv = lb[ch];
        float yv[16], rr[16], kk[16], vv[16];
#pragma unroll
        for (int r = 0; r < 16; ++r) {
          const u16* row = P2 + (size_t)(tok0 + r) * PS2;
          yv[r] = bf2f(YC[(size_t)(tok0 + r) * PS1 + ch]);
          rr[r] = bf2f(row[ch]); kk[r] = bf2f(row[512 + ch]); vv[r] = bf2f(row[1024 + ch]);
        }
#pragma unroll
        for (int r = 0; r < 16; ++r) {
          const float mean = wave_sum(yv[r]) * (1.f / 64.f);
          const float dv = yv[r] - mean;
          const float var = wave_sum(dv * dv) * (1.f / 64.f);
          const float yn = dv * rsqrtf(var + 64e-5f) * lgv + lbv;
          const float bon = wave_sum(rr[r] * kk[r] * rkv) * vv[r];
          YC[(size_t)(tok0 + r) * PS1 + ch] = f2bf((yn + bon) * ag[c][r]);
        }
      }
    }
    __syncthreads();
  }
}

#define NEGV (-1e30f)
struct AttnState { float m[2]; float ls[2]; f32x4 ot[4][2]; };

#define MINIT (-1e20f)
template <int MODE, bool FULL>
__device__ __forceinline__ void attn_scores(f32x4 (&st)[4][2], const u16* kbase, int kstride, int key0, const bf16x8 (&qf)[2][2],
                                            const float (&slope)[2], int t, bool selbit, int c16, int q4) {
  const float fb = (float)(key0 + q4 * 4 - t);
#pragma unroll
  for (int mk = 0; mk < 4; ++mk) {
    const u16* kp = kbase + (size_t)(mk * 16 + c16) * kstride + q4 * 8;
    const bf16x8 k0 = *(const bf16x8*)kp, k1 = *(const bf16x8*)(kp + 32);
#pragma unroll
    for (int nq = 0; nq < 2; ++nq) {
      f32x4 a = {0.f, 0.f, 0.f, 0.f};
      a = mfma16(k0, qf[nq][0], a);
      a = mfma16(k1, qf[nq][1], a);
      if (FULL) {
        const float c0 = slope[nq] * fb;
#pragma unroll
        for (int j = 0; j < 4; ++j) {
          const float v = a[j] + (c0 + slope[nq] * (float)(mk * 16 + j));
          a[j] = (MODE == 1) ? (selbit ? v : NEGV) : v;
        }
      } else {
#pragma unroll
        for (int j = 0; j < 4; ++j) {
          const int key = key0 + mk * 16 + q4 * 4 + j;
          int dist; bool valid;
          if (MODE == 0) { dist = t - (16 * key + 31); valid = dist >= 0; }
          else if (MODE == 1) { dist = t - key; valid = (dist >= 0) && selbit; }
          else { dist = t - key; valid = (dist >= 0) && (dist < 512); }
          a[j] = valid ? (a[j] - slope[nq] * (float)dist) : NEGV;
        }
      }
      st[mk][nq] = a;
    }
  }
}

template <int MODE, bool FULL>
__device__ __forceinline__ void attn_tile(AttnState& S, const u16* kbase, int kstride, const u16* vtbase, int vstride, int key0,
                                          const bf16x8 (&qf)[2][2], const float (&slope)[2], int t, bool selbit, int c16, int q4) {
  f32x4 st[4][2];
  attn_scores<MODE, FULL>(st, kbase, kstride, key0, qf, slope, t, selbit, c16, q4);
  __builtin_amdgcn_sched_barrier(0);
#pragma unroll
  for (int nq = 0; nq < 2; ++nq) {
    float mx = fmaxf(fmaxf(st[0][nq][0], st[0][nq][1]), fmaxf(st[0][nq][2], st[0][nq][3]));
#pragma unroll
    for (int mk = 1; mk < 4; ++mk) mx = fmaxf(mx, fmaxf(fmaxf(st[mk][nq][0], st[mk][nq][1]), fmaxf(st[mk][nq][2], st[mk][nq][3])));
    mx = fmaxf(mx, __shfl_xor(mx, 16)); mx = fmaxf(mx, __shfl_xor(mx, 32));
    const float mnew = fmaxf(S.m[nq], mx);
    const float alpha = __builtin_amdgcn_exp2f(S.m[nq] - mnew);
    S.m[nq] = mnew;
    float ls = S.ls[nq] * alpha;
#pragma unroll
    for (int md = 0; md < 4; ++md) { S.ot[md][nq][0] *= alpha; S.ot[md][nq][1] *= alpha; S.ot[md][nq][2] *= alpha; S.ot[md][nq][3] *= alpha; }
#pragma unroll
    for (int mk = 0; mk < 4; ++mk)
#pragma unroll
      for (int j = 0; j < 4; ++j) {
        const float pv = __builtin_amdgcn_exp2f(st[mk][nq][j] - mnew);
        st[mk][nq][j] = pv; ls += pv;
      }
    S.ls[nq] = ls;
  }
#pragma unroll
  for (int s2 = 0; s2 < 2; ++s2) {
    __builtin_amdgcn_sched_barrier(0);
    bf16x8 pb[2];
#pragma unroll
    for (int nq = 0; nq < 2; ++nq) {
      uint4 u;
      u.x = pack2(st[2 * s2][nq][0], st[2 * s2][nq][1]); u.y = pack2(st[2 * s2][nq][2], st[2 * s2][nq][3]);
      u.z = pack2(st[2 * s2 + 1][nq][0], st[2 * s2 + 1][nq][1]); u.w = pack2(st[2 * s2 + 1][nq][2], st[2 * s2 + 1][nq][3]);
      pb[nq] = *(bf16x8*)&u;
    }
#pragma unroll
    for (int md = 0; md < 4; ++md) {
      const bf16x8 vf = *(const bf16x8*)(vtbase + (size_t)(md * 16 + c16) * vstride + s2 * 32 + q4 * 8);
#pragma unroll
      for (int nq = 0; nq < 2; ++nq) S.ot[md][nq] = mfma16(vf, pb[nq], S.ot[md][nq]);
    }
  }
}

__device__ __forceinline__ void attn_reset(AttnState& S) {
#pragma unroll
  for (int nq = 0; nq < 2; ++nq) { S.m[nq] = MINIT; S.ls[nq] = 0.f;
#pragma unroll
    for (int md = 0; md < 4; ++md) S.ot[md][nq] = f32x4{0.f, 0.f, 0.f, 0.f}; }
}
__device__ __forceinline__ void attn_fold(AttnState& S, float* oacc, const u16* gp, int br, float (&invl)[2], int lane) {
#pragma unroll
  for (int nq = 0; nq < 2; ++nq) {
    float l = S.ls[nq];
    l += __shfl_xor(l, 16); l += __shfl_xor(l, 32);
    const float inv = (l > 0.f) ? 1.f / l : 0.f;
    invl[nq] = inv;
    const float f = bf2f(gp[nq * 6 + br]) * inv;
#pragma unroll
    for (int md = 0; md < 4; ++md)
#pragma unroll
      for (int j = 0; j < 4; ++j) {
        float* a = oacc + ((md * 2 + nq) * 4 + j) * 64 + lane;
        const float v = f * S.ot[md][nq][j];
        if (br == 0) *a = v; else *a += v;
      }
  }
}

__device__ __forceinline__ void phase_nsa(const Params& p, char* smem, unsigned* queue) {
  u16* P1 = (u16*)(p.ws + OFF_P1);
  const u16* KC = (const u16*)(p.ws + OFF_KC); const u16* VC = (const u16*)(p.ws + OFF_VC); const u16* VT = (const u16*)(p.ws + OFF_VT);
  const int tid = tidx(), lane = tid & 63, wid = tid >> 6;
  const int c16 = lane & 15, q4 = lane >> 4, tq = lane & 7;
  float* ps = (float*)smem + wid * 2048;
  float* oacc = (float*)(smem + 32768) + wid * 2048;
  int* qslot = (int*)(smem + 65536);
#pragma unroll 1
  for (;;) {
    if (tid == 0) *qslot = (int)atomicAdd(queue, 1u);
    __syncthreads();
    const int it = *qslot;
    if (it >= 2048) break;
    const int bg = it & 15;
    const int tqd = 127 - (it >> 4);
    const int b = bg >> 1, g = bg & 1;
    const int t0 = (tqd * 4 + wid) * 8;
    const int tok0 = b * 4096 + t0;
    const int t = t0 + tq;
    const int cur = t0 >> 6;
#pragma unroll
    for (int i = 0; i < 8; ++i) *(float4*)(ps + i * 256 + lane * 4) = float4{0.f, 0.f, 0.f, 0.f};
    bf16x8 qf[2][2]; float slope[2];
    const u16* gp = P1 + (size_t)(tok0 + tq) * PS1 + 1024 + (g * 4 + (c16 >> 3)) * 3;
#pragma unroll
    for (int nq = 0; nq < 2; ++nq) {
      const int hh = nq * 2 + (c16 >> 3);
      const u16* rp = P1 + (size_t)(tok0 + tq) * PS1;
      qf[nq][0] = *(const bf16x8*)(rp + (g * 4 + hh) * 64 + q4 * 8);
      qf[nq][1] = *(const bf16x8*)(rp + (g * 4 + hh) * 64 + 32 + q4 * 8);
      slope[nq] = exp2f(-(float)(g * 4 + hh + 1)) * 1.4426950408889634f;
    }
    AttnState S;
    float invl[2];
    const u16* kcb = KC + (size_t)(b * 2 + g) * 256 * 64;
    const u16* vcb = VC + (size_t)(b * 2 + g) * 64 * 256;
    int ntc = 0;
    if (t0 + 7 >= 31) ntc = (((t0 + 7 - 31) >> 4) >> 6) + 1;
    attn_reset(S);
#pragma unroll 1
    for (int kt = 0; kt < ntc; ++kt) attn_tile<0, false>(S, kcb + (size_t)kt * 64 * 64, 64, vcb + kt * 64, 256, kt * 64, qf, slope, t, true, c16, q4);
    attn_fold(S, oacc, gp, 0, invl, lane);
#pragma unroll 1
    for (int kt = 0; kt < ntc; ++kt) {
      f32x4 st[4][2];
      attn_scores<0, false>(st, kcb + (size_t)kt * 64 * 64, 64, kt * 64, qf, slope, t, true, c16, q4);
#pragma unroll
      for (int mk = 0; mk < 4; ++mk) {
        f32x4 hs;
#pragma unroll
        for (int j = 0; j < 4; ++j) {
          const float a0 = st[mk][0][j], a1 = st[mk][1][j];
          const float p0 = __builtin_amdgcn_exp2f(a0 - S.m[0]) * invl[0];
          const float p1 = __builtin_amdgcn_exp2f(a1 - S.m[1]) * invl[1];
          float v = p0 + p1;
          v += __shfl_xor(v, 8);
          hs[j] = v;
        }
        if (c16 < 8) *(f32x4*)(ps + c16 * 256 + kt * 64 + mk * 16 + q4 * 4) = hs;
      }
    }
    __syncthreads();
    unsigned long long selm = 0ull, un = 0ull;
#pragma unroll 1
    for (int tqq = 0; tqq < 8; ++tqq) {
      const float* pr = ps + tqq * 256;
      float imp = pr[4 * lane];
      if (lane > 0) imp += pr[4 * lane - 4] + 2.f * (pr[4 * lane - 3] + pr[4 * lane - 2] + pr[4 * lane - 1]);
      const bool forced = (lane == 0) || (lane == cur) || (lane == cur - 1);
      const bool live = lane <= cur;
      const float val = forced ? 1e4f : (live ? imp : NEGV);
      int rank = 0;
#pragma unroll 8
      for (int i = 0; i < 64; ++i) {
        const float vi = __uint_as_float(__builtin_amdgcn_readlane(__float_as_uint(val), i));
        rank += ((vi > val) || (vi == val && i < lane)) ? 1 : 0;
      }
      const unsigned long long bal = __ballot((rank < 16) && live);
      if (tq == tqq) selm = bal;
      un |= bal;
    }
    __syncthreads();
    attn_reset(S);
    {
      const u16* vtb = VT + (size_t)((0 * 8 + b) * 2 + g) * 64 * 4096;
#pragma unroll 1
      for (int j = 0; j <= cur; ++j) {
        if (!((un >> j) & 1ull)) continue;
        const bool sb = (selm >> j) & 1ull;
        const u16* kb_ = P1 + (size_t)(b * 4096 + j * 64) * PS1 + 768 + g * 64;
        if (j < cur) attn_tile<1, true>(S, kb_, PS1, vtb + j * 64, 4096, j * 64, qf, slope, t, sb, c16, q4);
        else attn_tile<1, false>(S, kb_, PS1, vtb + j * 64, 4096, j * 64, qf, slope, t, sb, c16, q4);
      }
    }
    attn_fold(S, oacc, gp, 1, invl, lane);
    attn_reset(S);
    {
      const u16* vtb = VT + (size_t)((1 * 8 + b) * 2 + g) * 64 * 4096;
      int j0 = t0 - 511; if (j0 < 0) j0 = 0; j0 >>= 6;
#pragma unroll 1
      for (int j = j0; j <= cur; ++j) {
        const u16* kb_ = P1 + (size_t)(b * 4096 + j * 64) * PS1 + 896 + g * 64;
        const bool full = (j < cur) && (j * 64 >= t0 + 7 - 511);
        if (full) attn_tile<2, true>(S, kb_, PS1, vtb + j * 64, 4096, j * 64, qf, slope, t, true, c16, q4);
        else attn_tile<2, false>(S, kb_, PS1, vtb + j * 64, 4096, j * 64, qf, slope, t, true, c16, q4);
      }
    }
    attn_fold(S, oacc, gp, 2, invl, lane);
#pragma unroll
    for (int nq = 0; nq < 2; ++nq) {
      const int hh = nq * 2 + (c16 >> 3);
      u16* rp = P1 + (size_t)(tok0 + tq) * PS1 + (g * 4 + hh) * 64;
#pragma unroll
      for (int md = 0; md < 4; ++md) {
        const float* a = oacc + ((md * 2 + nq) * 4) * 64 + lane;
        uint2 o; o.x = pack2(a[0], a[64]); o.y = pack2(a[128], a[192]);
        *(uint2*)(rp + md * 16 + q4 * 4) = o;
      }
    }
  }
}

__device__ __forceinline__ const float* modp(const Params& p, int l, int sub, int kind) {
  return (const float*)(p.ws + OFF_MOD) + (size_t)l * 8 * 9216 + sub * 3072 + kind * 1024;
}

__device__ __forceinline__ void run_phase(const Params& p, int ph, char* smem) {
  char* ws = p.ws;
  if (ph == 0) {
    if (blockIdx.x == 0) { unsigned* c = (unsigned*)(ws + OFF_CNT); for (int e = tidx(); e < 1024; e += 256) c[e] = 0u; }
    phase_mod(p, smem);
  }
  int l = 0, s = -1;
  if (ph >= 2) { l = (ph - 2) / 14; s = (ph - 2) % 14; }
  const float* preg = p.in[4] + (size_t)l * 3 * 1024; const float* postg = p.in[5] + (size_t)l * 3 * 1024;
  const bool is_norm = (ph == 1) || s == 2 || s == 10 || s == 13;
  if (is_norm) {
    const float* xin = p.out; float* xout = p.out; const u16* y = nullptr; const float* pg = nullptr; const float* gate = nullptr; float wgt = 0.f;
    const float* prg = nullptr; const float* sh = nullptr; const float* sc = nullptr; u16* h = (u16*)(ws + OFF_H);
    if (ph == 1) { xin = p.in[0]; prg = p.in[4]; sh = modp(p, 0, 0, 0); sc = modp(p, 0, 0, 1); }
    else if (s == 2) { y = (const u16*)(ws + OFF_YF); pg = postg; gate = modp(p, l, 0, 2); wgt = 0.5f; prg = preg + 1024; sh = modp(p, l, 1, 0); sc = modp(p, l, 1, 1); }
    else if (s == 10) { y = (const u16*)(ws + OFF_YM); pg = postg + 1024; gate = modp(p, l, 1, 2); wgt = 1.0f; prg = preg + 2048; sh = modp(p, l, 2, 0); sc = modp(p, l, 2, 1); }
    else { y = (const u16*)(ws + OFF_YF); pg = postg + 2048; gate = modp(p, l, 2, 2); wgt = 0.5f;
      if (l == 0) { prg = p.in[4] + 3 * 1024; sh = modp(p, 1, 0, 0); sc = modp(p, 1, 0, 1); } else { h = nullptr; } }
    phase_norm(xin, xout, y, pg, gate, wgt, prg, sh, sc, h);
  }
  {
    int cl = -1, cf = 0;
    if (ph == 0) { cl = 0; cf = 0; } else if (s == 2) { cl = l; cf = 1; } else if (s == 13 && l == 0) { cl = 1; cf = 0; }
    if (cl >= 0) conv_ffn(p, cl, cf, smem);
    if (cl >= 0 && cf == 0) conv_mix(p, cl, smem);
  }
  if (s == 0 || s == 11) phase_ffn_in(p, smem);
  if (s == 1 || s == 12 || s == 9) {
    const bool o = (s == 9);
    phase_gemm_plain((const u16*)(ws + (o ? OFF_MERGED : OFF_ACT)), o ? 1024 : DFF, (const u16*)(ws + (o ? OFF_WO : OFF_WOUT)), o ? 1024 : DFF,
                     (u16*)(ws + (o ? OFF_YM : OFF_YF)), smem);
  }
  if (s == 3) phase_inproj(p, smem);
  if (s == 4) { phase_prep1(p, l); phase_sgu(p, l, smem); phase_cmp1(p, l, smem); }
  if (s == 5) { phase_prep2m(p, l, smem); phase_cmp2(p, l); }
  if (s == 6) {
    const int nb = gridDim.x;
    const int sid = (nb >= 512) ? (((int)blockIdx.x & 1) ? -1 : ((int)blockIdx.x >> 1)) : (int)blockIdx.x;
    const int sstride = (nb >= 512) ? (nb >> 1) : nb;
    if (sid >= 0) {
      __builtin_amdgcn_s_setprio(3);
      for (int it = sid; it < 256; it += sstride) scan_item(p, it, smem);
      __builtin_amdgcn_s_setprio(0);
    }
    phase_nsa(p, smem, (unsigned*)(ws + OFF_CNT) + 64 + l * 64);
  }
  if (s == 7) phase_postm(p, l, smem);
  if (s == 8) phase_merge(p, smem);
}

constexpr int NPHASE = 30;

#if COOP
typedef const float* __attribute__((address_space(4))) const* kargp_t;
template <int PH>
__device__ __forceinline__ void run_seq(char* smem, cg::grid_group& grid) {
  if constexpr (PH < NPHASE) {
    {
      kargp_t ka = (kargp_t)__builtin_amdgcn_kernarg_segment_ptr();
      asm volatile("" : "+s"(ka));
      Params q;
#pragma unroll
      for (int i = 0; i < 35; ++i) q.in[i] = ka[i];
      q.out = (float*)ka[35];
      q.ws = (char*)ka[36];
      run_phase(q, PH, smem);
    }
    if constexpr (PH == 0) {
      kargp_t kb = (kargp_t)__builtin_amdgcn_kernarg_segment_ptr();
      asm volatile("" : "+s"(kb));
      unsigned* bar = (unsigned*)((char*)kb[36] + OFF_XB);
      if (kb[36] == nullptr) grid.sync();
      if (tidx() == 0) {
        const unsigned x = xb_xcc_id();
        unsigned nloc, nx, sum;
        for (;;) {
          nloc = 1u; nx = 0u; sum = 0u;
          for (unsigned j = 0; j < 16; ++j) { const unsigned c = xb_ld(&bar[XB_XCNT(j)]); sum += c; nx += (c > 0u) ? 1u : 0u; if (j == x) nloc = c; }
          if (sum == gridDim.x) break;
          __builtin_amdgcn_s_sleep(2);
        }
        __hip_atomic_store(&bar[XB_SLOT(blockIdx.x)], nloc, __ATOMIC_RELAXED, __HIP_MEMORY_SCOPE_AGENT);
        __hip_atomic_store(&bar[XB_SLOT(blockIdx.x) + 1], nx, __ATOMIC_RELAXED, __HIP_MEMORY_SCOPE_AGENT);
      }
      gbar_xcd(bar);
    } else if constexpr (PH + 1 < NPHASE) {
      kargp_t kb = (kargp_t)__builtin_amdgcn_kernarg_segment_ptr();
      asm volatile("" : "+s"(kb));
      gbar_xcd((unsigned*)((char*)kb[36] + OFF_XB));
    }
    run_seq<PH + 1>(smem, grid);
  }
}

__global__ void __launch_bounds__(256, 2) mega(Params p) {
  __shared__ __attribute__((aligned(16))) char smem[SMEM_BYTES];
  cg::grid_group grid = cg::this_grid();
  {
    kargp_t kb = (kargp_t)__builtin_amdgcn_kernarg_segment_ptr();
    asm volatile("" : "+s"(kb));
    if (tidx() == 0) xb_add(&((unsigned*)((char*)kb[36] + OFF_XB))[XB_XCNT(xb_xcc_id())], 1u);
  }
  run_seq<0>(smem, grid);
}
#endif

template <int PH>
__global__ void __launch_bounds__(256, 2) kph(Params p) {
  __shared__ __attribute__((aligned(16))) char smem[SMEM_BYTES];
  run_phase(p, PH, smem);
}

template <int PH>
static void launch_seq(const Params& p, int grid, hipStream_t stream) {
  if constexpr (PH < NPHASE) {
    kph<PH><<<grid, 256, 0, stream>>>(p);
    launch_seq<PH + 1>(p, grid, stream);
  }
}

extern "C" void kernel_launch(void* const* d_in, const int* in_sizes, int n_in, void* d_out, int out_size, void* d_ws, size_t ws_size,
                              hipStream_t stream) {
  static int grid_blocks = 0;
  if (!grid_blocks) {
    int dev = 0, cus = 0, per_cu = 0;
    hipGetDevice(&dev);
    hipDeviceGetAttribute(&cus, hipDeviceAttributeMultiprocessorCount, dev);
    #if COOP
    hipOccupancyMaxActiveBlocksPerMultiprocessor(&per_cu, mega, 256, 0);
#else
    per_cu = 2;
#endif
    if (per_cu > 2) per_cu = 2;
    if (per_cu < 1) per_cu = 1;
    grid_blocks = cus * per_cu;
  }
  Params p{};
  for (int i = 0; i < 35; ++i) p.in[i] = (const float*)d_in[i];
  p.out = (float*)d_out;
  p.ws = (char*)d_ws;
#if COOP
  hipMemsetAsync((char*)d_ws + OFF_XB, 0, XB_BYTES, stream);
  void* args[] = {&p};
  hipError_t e = hipLaunchCooperativeKernel((void*)mega, dim3(grid_blocks), dim3(256), args, 0, stream);
  if (e != hipSuccess) fprintf(stderr, "cooperative launch failed: %s (grid %d)\n", hipGetErrorString(e), grid_blocks);
#else
  launch_seq<0>(p, grid_blocks, stream);
#endif
}
```

```cpp
#include <hip/hip_runtime.h>
#include <hip/hip_cooperative_groups.h>
#include <cstdio>
#include <cstdint>
namespace cg = cooperative_groups;

#ifndef COOP
#define COOP 1
#endif

typedef unsigned short u16;
using bf16x8 = __attribute__((ext_vector_type(8))) short;
using f32x4 = __attribute__((ext_vector_type(4))) float;

constexpr int T = 32768, D = 1024, SEQ = 4096, DFF = 2816;
constexpr int PS1 = 2072, PS2 = 3328;
constexpr int MIXC = 7192, MIXN = 4120;
constexpr size_t OFF_P1 = 0;
constexpr size_t OFF_P2 = OFF_P1 + (size_t)T * PS1 * 2;
constexpr size_t OFF_H = OFF_P2 + (size_t)T * PS2 * 2;
constexpr size_t OFF_WMIX = OFF_H + (size_t)T * 1024 * 2;
constexpr size_t OFF_WG = OFF_WMIX + (size_t)4224 * 1024 * 2;
constexpr size_t OFF_WB = OFF_WG + (size_t)3072 * 1024 * 2;
constexpr size_t OFF_WO = OFF_WB + (size_t)3 * 1024 * 512 * 2;
constexpr size_t OFF_W1 = OFF_WO + (size_t)1024 * 1024 * 2;
constexpr size_t OFF_WIN = OFF_W1 + (size_t)2 * 256 * 2048 * 2;
constexpr size_t OFF_WOUT = OFF_WIN + (size_t)5632 * 1024 * 2;
constexpr size_t OFF_VFIRST = OFF_WOUT + (size_t)1024 * 2816 * 2;
constexpr size_t OFF_VT = OFF_VFIRST + (size_t)T * 512 * 2;
constexpr size_t OFF_MOD = OFF_VT + (size_t)2 * 8 * 2 * 64 * 4096 * 2;
constexpr size_t OFF_PB = OFF_MOD + (size_t)2 * 8 * 9216 * 4;
constexpr size_t OFF_HID = OFF_PB + (size_t)1024 * 1792 * 2;
constexpr size_t OFF_KC = OFF_HID + (size_t)2 * 4096 * 256 * 2;
constexpr size_t OFF_VC = OFF_KC + (size_t)8 * 2 * 256 * 64 * 2;
constexpr size_t OFF_LV = OFF_VC + (size_t)8 * 2 * 64 * 256 * 2;
constexpr size_t OFF_CNT = OFF_LV + (size_t)T * 32 * 4;
constexpr size_t OFF_WL = OFF_CNT + 4096;
constexpr int WL_W2 = 0, WL_A2 = 512 * 64, WL_G2 = 2 * 512 * 64, WL_V1 = WL_G2 + 512 * 128, WL_V2 = WL_V1 + 64 * 512, WL_END = WL_V2 + 512 * 64;
constexpr size_t OFF_XB = (OFF_WL + (size_t)WL_END * 2 + 255) & ~(size_t)255;
constexpr size_t XB_BYTES = 32768;
constexpr size_t WS_END = OFF_XB + XB_BYTES;
constexpr size_t OFF_ACT = OFF_P1;
constexpr size_t OFF_YF = OFF_ACT + (size_t)T * DFF * 2;
constexpr size_t OFF_H2 = OFF_P2;
constexpr size_t OFF_MERGED = OFF_P2;
constexpr size_t OFF_YM = OFF_MERGED + (size_t)T * 1024 * 2;
constexpr size_t OFF_YC = OFF_H;

constexpr int SMEM_BYTES = 73728;

struct Params { const float* in[35]; float* out; char* ws; };

__device__ __forceinline__ int tidx() { int t = __builtin_amdgcn_workitem_id_x(); asm volatile("" : "+v"(t)); return t; }
__device__ __forceinline__ void gbar(unsigned* cnt, unsigned target) {
  asm volatile("s_waitcnt vmcnt(0) lgkmcnt(0)" ::: "memory");
  __syncthreads();
  if (tidx() == 0) {
    __builtin_amdgcn_fence(__ATOMIC_RELEASE, "agent");
    asm volatile("s_waitcnt vmcnt(0)" ::: "memory");
    __hip_atomic_fetch_add(cnt, 1u, __ATOMIC_RELAXED, __HIP_MEMORY_SCOPE_AGENT);
    while (__hip_atomic_load(cnt, __ATOMIC_RELAXED, __HIP_MEMORY_SCOPE_AGENT) < target) __builtin_amdgcn_s_sleep(1);
    __builtin_amdgcn_fence(__ATOMIC_ACQUIRE, "agent");
    asm volatile("s_waitcnt vmcnt(0)" ::: "memory");
  }
  __syncthreads();
}
#define XB_XCNT(j) (256 + 64 * (j))
#define XB_XSUB(j) (1280 + 64 * (j))
#define XB_XGEN(j) (2304 + 64 * (j))
#define XB_TOP 3328
#define XB_TOPGEN 3392
#define XB_SLOT(b) (4096 + 2 * (b))
__device__ __forceinline__ unsigned xb_ld(unsigned* p) { return __hip_atomic_load(p, __ATOMIC_RELAXED, __HIP_MEMORY_SCOPE_AGENT); }
__device__ __forceinline__ unsigned xb_add(unsigned* p, unsigned v) { return __hip_atomic_fetch_add(p, v, __ATOMIC_RELAXED, __HIP_MEMORY_SCOPE_AGENT); }
__device__ __forceinline__ unsigned xb_xcc_id() { return (unsigned)__builtin_amdgcn_s_getreg((3 << 11) | 20) & 0xFu; }
__device__ __forceinline__ void gbar_xcd(unsigned* bar) {
  asm volatile("s_waitcnt vmcnt(0) lgkmcnt(0)" ::: "memory");
  __syncthreads();
  if (tidx() == 0) {
    const unsigned x = xb_xcc_id();
    const unsigned nloc = xb_ld(&bar[XB_SLOT(blockIdx.x)]), nx = xb_ld(&bar[XB_SLOT(blockIdx.x) + 1]);
    const unsigned old = xb_add(&bar[XB_XSUB(x)], 1u);
    const unsigned gen = old / nloc;
    if (old + 1u == (gen + 1u) * nloc) {
      __builtin_amdgcn_fence(__ATOMIC_RELEASE, "agent");
      asm volatile("s_waitcnt vmcnt(0)" ::: "memory");
      const unsigned og = xb_add(&bar[XB_TOP], 1u);
      const unsigned tg = og / nx;
      if (og + 1u == (tg + 1u) * nx) xb_add(&bar[XB_TOPGEN], 1u);
      else while (xb_ld(&bar[XB_TOPGEN]) == tg) __builtin_amdgcn_s_sleep(1);
      __builtin_amdgcn_fence(__ATOMIC_ACQUIRE, "agent");
      xb_add(&bar[XB_XGEN(x)], 1u);
      asm volatile("s_waitcnt vmcnt(0)" ::: "memory");
    } else {
      while (xb_ld(&bar[XB_XGEN(x)]) == gen) __builtin_amdgcn_s_sleep(1);
      __builtin_amdgcn_fence(__ATOMIC_ACQUIRE, "agent");
      asm volatile("s_waitcnt vmcnt(0)" ::: "memory");
    }
  }
  __syncthreads();
}
__device__ __forceinline__ float dpp_sum16(float v) {
  v += __int_as_float(__builtin_amdgcn_update_dpp(0, __float_as_int(v), 0xB1, 0xF, 0xF, true));
  v += __int_as_float(__builtin_amdgcn_update_dpp(0, __float_as_int(v), 0x4E, 0xF, 0xF, true));
  v += __int_as_float(__builtin_amdgcn_update_dpp(0, __float_as_int(v), 0x141, 0xF, 0xF, true));
  v += __int_as_float(__builtin_amdgcn_update_dpp(0, __float_as_int(v), 0x140, 0xF, 0xF, true));
  return v;
}
__device__ __forceinline__ float bf2f(u16 u) { return __uint_as_float(((unsigned)u) << 16); }
__device__ __forceinline__ u16 f2bf(float f) { __bf16 r = (__bf16)f; return *(u16*)&r; }
typedef __attribute__((ext_vector_type(2))) float f2_t;
typedef __attribute__((ext_vector_type(2))) __bf16 b2_t;
__device__ __forceinline__ unsigned pack2(float a, float b) { f2_t v = {a, b}; b2_t r = __builtin_convertvector(v, b2_t); return *(unsigned*)&r; }
__device__ __forceinline__ float sigmoidf_(float x) { return 1.f / (1.f + __expf(-x)); }
__device__ __forceinline__ float siluf_(float x) { return x / (1.f + __expf(-x)); }
__device__ __forceinline__ float geluf_(float x) { float u = 0.7978845608028654f * (x + 0.044715f * x * x * x); return x / (1.f + __expf(-2.f * u)); }
__device__ __forceinline__ float tanhf_(float x) { return 1.f - 2.f / (1.f + __expf(2.f * x)); }
__device__ __forceinline__ float wave_sum(float v) {
#pragma unroll
  for (int o = 32; o >= 1; o >>= 1) v += __shfl_xor(v, o);
  return v;
}
__device__ __forceinline__ f32x4 mfma16(bf16x8 a, bf16x8 b, f32x4 c) { return __builtin_amdgcn_mfma_f32_16x16x32_bf16(a, b, c, 0, 0, 0); }

__device__ __forceinline__ void conv_w(const float* src, int ld, int K, u16* dst, int NR, int nvalid, int coff, int kind, char* smem, int kvalid = 1 << 30) {
  float* tl = (float*)smem;
  const int tid = tidx();
  const int ktn = K >> 6, ntile = (NR >> 6) * ktn;
  for (int tix = blockIdx.x; tix < ntile; tix += gridDim.x) {
    const int R0 = (tix / ktn) << 6, k0 = (tix % ktn) << 6;
    const int c = tid & 63, kq = tid >> 6;
    const int R = R0 + c;
    int sc; bool ok;
    if (kind == 0) { sc = coff + R; ok = R < nvalid; }
    else { int ntl = R >> 7, w = (R >> 6) & 1, n = (R >> 4) & 3, r = R & 15; sc = ((n >= 2) ? DFF : 0) + ntl * 64 + w * 32 + (n & 1) * 16 + r; ok = true; }
#pragma unroll 4
    for (int i = 0; i < 16; ++i) {
      int k = k0 + kq * 16 + i;
      tl[c * 65 + kq * 16 + i] = (ok && k < kvalid) ? src[(size_t)k * ld + sc] : 0.f;
    }
    __syncthreads();
    {
      const int r = tid >> 2, ks = tid & 3;
      const float* s = tl + r * 65 + ks * 16;
      uint4 o0, o1;
      o0.x = pack2(s[0], s[1]); o0.y = pack2(s[2], s[3]); o0.z = pack2(s[4], s[5]); o0.w = pack2(s[6], s[7]);
      o1.x = pack2(s[8], s[9]); o1.y = pack2(s[10], s[11]); o1.z = pack2(s[12], s[13]); o1.w = pack2(s[14], s[15]);
      uint4* dp = (uint4*)(dst + (size_t)(R0 + r) * K + k0 + ks * 16);
      dp[0] = o0; dp[1] = o1;
    }
    __syncthreads();
  }
}

__device__ __forceinline__ void conv_ffn(const Params& p, int l, int f, char* smem) {
  conv_w(p.in[6] + (size_t)(l * 2 + f) * D * (2 * DFF), 2 * DFF, D, (u16*)(p.ws + OFF_WIN), 5632, 5632, 0, 1, smem);
  conv_w(p.in[7] + (size_t)(l * 2 + f) * DFF * D, D, DFF, (u16*)(p.ws + OFF_WOUT), 1024, 1024, 0, 0, smem);
}
__device__ __forceinline__ void conv_mix(const Params& p, int l, char* smem) {
  const float* mw = p.in[8] + (size_t)l * D * MIXC;
  conv_w(mw, MIXC, D, (u16*)(p.ws + OFF_WMIX), 4224, MIXN, 0, 0, smem);
  conv_w(mw, MIXC, D, (u16*)(p.ws + OFF_WG), 3072, 3072, MIXN, 0, smem);
  for (int i = 0; i < 3; ++i)
    conv_w(p.in[9] + (size_t)(l * 3 + i) * 512 * D, D, 512, (u16*)(p.ws + OFF_WB) + (size_t)i * 1024 * 512, 1024, 1024, 0, 0, smem);
  conv_w(p.in[10] + (size_t)l * D * D, D, D, (u16*)(p.ws + OFF_WO), 1024, 1024, 0, 0, smem);
  conv_w(p.in[11] + (size_t)l * 2048 * 256, 256, 2048, (u16*)(p.ws + OFF_W1), 256, 256, 0, 0, smem);
  conv_w(p.in[14] + (size_t)l * 2048 * 256, 256, 2048, (u16*)(p.ws + OFF_W1) + (size_t)256 * 2048, 256, 256, 0, 0, smem);
  u16* WL = (u16*)(p.ws + OFF_WL);
  conv_w(p.in[23] + (size_t)l * 64 * 512, 512, 64, WL + WL_W2, 512, 512, 0, 0, smem);
  conv_w(p.in[25] + (size_t)l * 64 * 512, 512, 64, WL + WL_A2, 512, 512, 0, 0, smem);
  conv_w(p.in[26] + (size_t)l * 128 * 512, 512, 128, WL + WL_G2, 512, 512, 0, 0, smem);
  if (l > 0) {
    conv_w(p.in[33], 32, 512, WL + WL_V1, 64, 32, 0, 0, smem);
    conv_w(p.in[34], 512, 64, WL + WL_V2, 512, 512, 0, 0, smem, 32);
  }
}

__device__ __forceinline__ void phase_mod(const Params& p, char* smem) {
  float* cond = (float*)smem;
  float* red = cond + 8192;
  const int tid = tidx();
  float* MOD = (float*)(p.ws + OFF_MOD);
  for (int item = blockIdx.x; item < 288; item += gridDim.x) {
    for (int e = tid; e < 8192; e += 256) cond[e] = siluf_(p.in[1][e]);
    __syncthreads();
    const int l = item / 144, n0 = (item % 144) * 64, col = n0 + (tid & 63), kq = tid >> 6;
    float acc[8];
#pragma unroll
    for (int b = 0; b < 8; ++b) acc[b] = 0.f;
    const float* w = p.in[2] + (size_t)l * D * 9216 + col;
#pragma unroll 4
    for (int k = kq * 256; k < kq * 256 + 256; ++k) {
      float wv = w[(size_t)k * 9216];
#pragma unroll
      for (int b = 0; b < 8; ++b) acc[b] += cond[b * 1024 + k] * wv;
    }
#pragma unroll
    for (int b = 0; b < 8; ++b) red[(kq * 8 + b) * 64 + (tid & 63)] = acc[b];
    __syncthreads();
    for (int e = tid; e < 512; e += 256) {
      int b = e >> 6, c = e & 63;
      float s = red[(0 * 8 + b) * 64 + c] + red[(1 * 8 + b) * 64 + c] + red[(2 * 8 + b) * 64 + c] + red[(3 * 8 + b) * 64 + c];
      MOD[(size_t)(l * 8 + b) * 9216 + n0 + c] = s + p.in[3][(size_t)l * 9216 + n0 + c];
    }
    __syncthreads();
  }
}

__device__ __forceinline__ void phase_norm(const float* xin, float* xout, const u16* y, const float* postg, const float* gate, float wgt,
                           const float* preg, const float* shift, const float* scale, u16* h) {
  const int lane = tidx() & 63, wid = tidx() >> 6;
  for (int row = blockIdx.x * 4 + wid; row < T; row += gridDim.x * 4) {
    const int b = row >> 12;
    float4 xv[4];
#pragma unroll
    for (int i = 0; i < 4; ++i) xv[i] = *(const float4*)(xin + (size_t)row * D + i * 256 + lane * 4);
    if (y) {
      float yv[4][4]; float ss = 0.f;
#pragma unroll
      for (int i = 0; i < 4; ++i) {
        uint2 u = *(const uint2*)(y + (size_t)row * D + i * 256 + lane * 4);
        yv[i][0] = bf2f((u16)(u.x & 0xffff)); yv[i][1] = bf2f((u16)(u.x >> 16));
        yv[i][2] = bf2f((u16)(u.y & 0xffff)); yv[i][3] = bf2f((u16)(u.y >> 16));
        ss += yv[i][0] * yv[i][0] + yv[i][1] * yv[i][1] + yv[i][2] * yv[i][2] + yv[i][3] * yv[i][3];
      }
      ss = wave_sum(ss);
      const float rs = rsqrtf(ss * (1.f / 1024.f) + 1e-6f) * wgt;
#pragma unroll
      for (int i = 0; i < 4; ++i) {
        const int c = i * 256 + lane * 4;
        float4 g = *(const float4*)(gate + (size_t)b * 9216 + c);
        float4 pg = *(const float4*)(postg + c);
        xv[i].x += g.x * yv[i][0] * rs * pg.x; xv[i].y += g.y * yv[i][1] * rs * pg.y;
        xv[i].z += g.z * yv[i][2] * rs * pg.z; xv[i].w += g.w * yv[i][3] * rs * pg.w;
      }
    }
    if (xout) {
#pragma unroll
      for (int i = 0; i < 4; ++i) *(float4*)(xout + (size_t)row * D + i * 256 + lane * 4) = xv[i];
    }
    if (h) {
      float ss = 0.f;
#pragma unroll
      for (int i = 0; i < 4; ++i) ss += xv[i].x * xv[i].x + xv[i].y * xv[i].y + xv[i].z * xv[i].z + xv[i].w * xv[i].w;
      ss = wave_sum(ss);
      const float rs = rsqrtf(ss * (1.f / 1024.f) + 1e-6f);
#pragma unroll
      for (int i = 0; i < 4; ++i) {
        const int c = i * 256 + lane * 4;
        float4 pg = *(const float4*)(preg + c);
        float4 sh = *(const float4*)(shift + (size_t)b * 9216 + c);
        float4 sc = *(const float4*)(scale + (size_t)b * 9216 + c);
        uint2 o;
        o.x = pack2(xv[i].x * rs * pg.x * (1.f + sc.x) + sh.x, xv[i].y * rs * pg.y * (1.f + sc.y) + sh.y);
        o.y = pack2(xv[i].z * rs * pg.z * (1.f + sc.z) + sh.z, xv[i].w * rs * pg.w * (1.f + sc.w) + sh.w);
        *(uint2*)(h + (size_t)row * D + c) = o;
      }
    }
  }
}

template <int NS, class FA, class FB>
__device__ __forceinline__ void gemm_loop(f32x4 (&acc)[4][NS], const FA& fa, const FB& fb, int K, u16* sm) {
  constexpr int BN = 32 * NS;
  constexpr int NBV = BN / 32;
  const int tid = tidx(), lane = tid & 63, wid = tid >> 6, wr = wid >> 1, wc = wid & 1, fr = lane & 15, fq = lane >> 4;
  u16* As = sm; u16* Bs = sm + 2 * 128 * 64;
  uint4 ra0[4], rb0[NBV], ra1[4], rb1[NBV];
  const int nt = K >> 6;
  const int lrow = tid >> 3, lk = (tid & 7) * 8;
  const int lsw = lrow * 64 + (((tid & 7) ^ ((lrow >> 1) & 7)) << 3);
  const int c0 = (fq ^ ((fr >> 1) & 7)) << 3, c1 = c0 ^ 32;
#define G_LOAD(RA, RB, KT) { const int kb_ = (KT) << 6; \
    _Pragma("unroll") for (int i = 0; i < 4; ++i) RA[i] = fa(lrow + 32 * i, kb_ + lk); \
    _Pragma("unroll") for (int i = 0; i < NBV; ++i) RB[i] = fb(lrow + 32 * i, kb_ + lk); }
#define G_STORE(RA, RB, BUF) { u16* Aw_ = As + (BUF) * 128 * 64 + lsw; u16* Bw_ = Bs + (BUF) * BN * 64 + lsw; \
    _Pragma("unroll") for (int i = 0; i < 4; ++i) *(uint4*)(Aw_ + i * 32 * 64) = RA[i]; \
    _Pragma("unroll") for (int i = 0; i < NBV; ++i) *(uint4*)(Bw_ + i * 32 * 64) = RB[i]; }
#define G_COMPUTE(BUF) { const u16* Ab = As + (BUF) * 128 * 64 + (wr * 64 + fr) * 64; \
    const u16* Bb = Bs + (BUF) * BN * 64 + (wc * 16 * NS + fr) * 64; \
    _Pragma("unroll") for (int ks = 0; ks < 2; ++ks) { bf16x8 a[4], b[NS]; const int co = ks ? c1 : c0; \
      _Pragma("unroll") for (int m = 0; m < 4; ++m) a[m] = *(const bf16x8*)(Ab + m * 16 * 64 + co); \
      _Pragma("unroll") for (int n = 0; n < NS; ++n) b[n] = *(const bf16x8*)(Bb + n * 16 * 64 + co); \
      __builtin_amdgcn_s_setprio(1); \
      _Pragma("unroll") for (int m = 0; m < 4; ++m) _Pragma("unroll") for (int n = 0; n < NS; ++n) acc[m][n] = mfma16(a[m], b[n], acc[m][n]); \
      __builtin_amdgcn_s_setprio(0); } }
  G_LOAD(ra0, rb0, 0)
  if (nt > 1) G_LOAD(ra1, rb1, 1)
  G_STORE(ra0, rb0, 0)
  __syncthreads();
#pragma unroll 1
  for (int kt = 0; kt < nt; kt += 2) {
    if (kt + 2 < nt) G_LOAD(ra0, rb0, kt + 2)
    G_COMPUTE(0)
    if (kt + 1 < nt) G_STORE(ra1, rb1, 1)
    __syncthreads();
    if (kt + 1 >= nt) break;
    if (kt + 3 < nt) G_LOAD(ra1, rb1, kt + 3)
    G_COMPUTE(1)
    if (kt + 2 < nt) G_STORE(ra0, rb0, 0)
    __syncthreads();
  }
#undef G_LOAD
#undef G_STORE
#undef G_COMPUTE
}

template <int NS>
__device__ __forceinline__ void gemm_loop_dma(f32x4 (&acc)[4][NS], const u16* Ab, int lda, const u16* Bb, int ldb, int K, u16* sm) {
  constexpr int BN = 32 * NS;
  constexpr int NBV = BN / 32;
  const int tid = tidx(), lane = tid & 63, wid = tid >> 6, wr = wid >> 1, wc = wid & 1, fr = lane & 15, fq = lane >> 4;
  u16* As = sm; u16* Bs = sm + 2 * 128 * 64;
  const int nt = K >> 6;
  const int lrow = tid >> 3;
  const int gk = (((tid & 7) ^ ((lrow >> 1) & 7)) << 3);
  const int c0 = (fq ^ ((fr >> 1) & 7)) << 3, c1 = c0 ^ 32;
  const u16* ga = Ab + (size_t)lrow * lda + gk;
  const u16* gb = Bb + (size_t)lrow * ldb + gk;
#define D_ISSUE(KT, BUF) { const int kb_ = (KT) << 6; \
    _Pragma("unroll") for (int i = 0; i < 4; ++i) \
      __builtin_amdgcn_global_load_lds((const unsigned*)(ga + (size_t)(32 * i) * lda + kb_), (unsigned*)(As + (BUF) * 128 * 64 + (tid + 256 * i) * 8), 16, 0, 0); \
    _Pragma("unroll") for (int i = 0; i < NBV; ++i) \
      __builtin_amdgcn_global_load_lds((const unsigned*)(gb + (size_t)(32 * i) * ldb + kb_), (unsigned*)(Bs + (BUF) * BN * 64 + (tid + 256 * i) * 8), 16, 0, 0); }
#define D_COMPUTE(BUF) { const u16* Ap = As + (BUF) * 128 * 64 + (wr * 64 + fr) * 64; \
    const u16* Bp = Bs + (BUF) * BN * 64 + (wc * 16 * NS + fr) * 64; \
    _Pragma("unroll") for (int ks = 0; ks < 2; ++ks) { bf16x8 a[4], b[NS]; const int co = ks ? c1 : c0; \
      _Pragma("unroll") for (int m = 0; m < 4; ++m) a[m] = *(const bf16x8*)(Ap + m * 16 * 64 + co); \
      _Pragma("unroll") for (int n = 0; n < NS; ++n) b[n] = *(const bf16x8*)(Bp + n * 16 * 64 + co); \
      __builtin_amdgcn_s_setprio(1); \
      _Pragma("unroll") for (int m = 0; m < 4; ++m) _Pragma("unroll") for (int n = 0; n < NS; ++n) acc[m][n] = mfma16(a[m], b[n], acc[m][n]); \
      __builtin_amdgcn_s_setprio(0); } }
  D_ISSUE(0, 0)
#pragma unroll 1
  for (int kt = 0; kt < nt; kt += 2) {
    __syncthreads();
    if (kt + 1 < nt) D_ISSUE(kt + 1, 1)
    D_COMPUTE(0)
    if (kt + 1 >= nt) break;
    __syncthreads();
    if (kt + 2 < nt) D_ISSUE(kt + 2, 0)
    D_COMPUTE(1)
  }
  __syncthreads();
#undef D_ISSUE
#undef D_COMPUTE
}

__device__ __forceinline__ bool tile_map(int it, int NT, int& mt, int& nt) {
  const int g = gridDim.x;
  if ((g & 7) == 0) {
    const int xcd = blockIdx.x & 7, bx = blockIdx.x >> 3, nbx = g >> 3;
    const int lid = bx + it * nbx;
    if (lid >= 32 * NT) return false;
    const int grp = lid / (8 * NT), rem = lid - grp * 8 * NT;
    nt = rem >> 3; mt = xcd * 32 + grp * 8 + (rem & 7);
    return true;
  } else {
    const int id = blockIdx.x + it * g;
    if (id >= 256 * NT) return false;
    nt = id % NT; mt = id / NT;
    return true;
  }
}

#define ZERO_ACC(acc, NSV) _Pragma("unroll") for (int m_ = 0; m_ < 4; ++m_) _Pragma("unroll") for (int n_ = 0; n_ < NSV; ++n_) acc[m_][n_] = f32x4{0.f, 0.f, 0.f, 0.f};

__device__ __forceinline__ void phase_ffn_in(const Params& p, char* smem) {
  const u16* H = (const u16*)(p.ws + OFF_H); const u16* W = (const u16*)(p.ws + OFF_WIN); u16* ACT = (u16*)(p.ws + OFF_ACT);
  const int lane = tidx() & 63, wid = tidx() >> 6, wr = wid >> 1, wc = wid & 1, fr = lane & 15, fq = lane >> 4;
  int mt, nt;
  for (int it = 0; tile_map(it, 44, mt, nt); ++it) {
    const int m0 = mt * 128, n0 = nt * 128;
    f32x4 acc[4][4]; ZERO_ACC(acc, 4)
    gemm_loop_dma<4>(acc, H + (size_t)m0 * 1024, 1024, W + (size_t)n0 * 1024, 1024, 1024, (u16*)smem);
#pragma unroll
    for (int m = 0; m < 4; ++m)
#pragma unroll
      for (int n = 0; n < 2; ++n) {
        const int col = nt * 64 + wc * 32 + n * 16 + fr;
        const int r0 = m0 + wr * 64 + m * 16 + fq * 4;
#pragma unroll
        for (int j = 0; j < 4; ++j) ACT[(size_t)(r0 + j) * DFF + col] = f2bf(siluf_(acc[m][n][j]) * acc[m][n + 2][j]);
      }
  }
}

__device__ __forceinline__ void phase_gemm_plain(const u16* A, int lda, const u16* Bt, int K, u16* C, char* smem) {
  const int lane = tidx() & 63, wid = tidx() >> 6, wr = wid >> 1, wc = wid & 1, fr = lane & 15, fq = lane >> 4;
  int mt, nt;
  for (int it = 0; tile_map(it, 8, mt, nt); ++it) {
    const int m0 = mt * 128, n0 = nt * 128;
    f32x4 acc[4][4]; ZERO_ACC(acc, 4)
    gemm_loop_dma<4>(acc, A + (size_t)m0 * lda, lda, Bt + (size_t)n0 * K, K, K, (u16*)smem);
#pragma unroll
    for (int m = 0; m < 4; ++m)
#pragma unroll
      for (int n = 0; n < 4; ++n) {
        const int col = n0 + wc * 64 + n * 16 + fr;
        const int r0 = m0 + wr * 64 + m * 16 + fq * 4;
#pragma unroll
        for (int j = 0; j < 4; ++j) C[(size_t)(r0 + j) * 1024 + col] = f2bf(acc[m][n][j]);
      }
  }
}

__device__ __forceinline__ void phase_inproj(const Params& p, char* smem) {
  const u16* H = (const u16*)(p.ws + OFF_H); const u16* W = (const u16*)(p.ws + OFF_WMIX);
  u16* P1 = (u16*)(p.ws + OFF_P1); u16* P2 = (u16*)(p.ws + OFF_P2); u16* VT = (u16*)(p.ws + OFF_VT); u16* PB = (u16*)(p.ws + OFF_PB);
  const int lane = tidx() & 63, wid = tidx() >> 6, wr = wid >> 1, wc = wid & 1, fr = lane & 15, fq = lane >> 4;
  int mt, nt;
  for (int it = 0; tile_map(it, 33, mt, nt); ++it) {
    const int m0 = mt * 128, n0 = nt * 128;
    f32x4 acc[4][4]; ZERO_ACC(acc, 4)
    gemm_loop_dma<4>(acc, H + (size_t)m0 * 1024, 1024, W + (size_t)n0 * 1024, 1024, 1024, (u16*)smem);
#pragma unroll
    for (int m = 0; m < 4; ++m)
#pragma unroll
      for (int nn = 0; nn < 4; ++nn) {
        const int n = n0 + wc * 64 + nn * 16 + fr;
        if (n >= MIXN) continue;
        const int r0 = m0 + wr * 64 + m * 16 + fq * 4;
        f32x4 v = acc[m][nn];
        if ((n >= 896 && n < 1024) || (n >= 1152 && n < 1280)) {
          const int which = (n >= 1152) ? 1 : 0;
          const int gd = n - (which ? 1152 : 896);
          const int b = r0 >> 12, t = r0 & 4095;
          uint2 o; o.x = pack2(v[0], v[1]); o.y = pack2(v[2], v[3]);
          *(uint2*)(VT + ((size_t)((which * 8 + b) * 128 + gd)) * 4096 + (t & ~31) + 8 * fq + 4 * (m & 1)) = o;
        } else if (n < 1304) {
          const int pc = (n < 896) ? n : ((n < 1152) ? n - 128 : n - 256);
          if (n < 512) { const float qs = 0.125f * 1.4426950408889634f; v[0] *= qs; v[1] *= qs; v[2] *= qs; v[3] *= qs; }
          if (n >= 1280) { v[0] = sigmoidf_(v[0]); v[1] = sigmoidf_(v[1]); v[2] = sigmoidf_(v[2]); v[3] = sigmoidf_(v[3]); }
#pragma unroll
          for (int j = 0; j < 4; ++j) P1[(size_t)(r0 + j) * PS1 + pc] = f2bf(v[j]);
        } else if (n < 2328) {
#pragma unroll
          for (int j = 0; j < 4; ++j) P1[(size_t)(r0 + j) * PS1 + (n - 256)] = f2bf(geluf_(v[j]));
        } else {
          const int pc = n - 2328;
#pragma unroll
          for (int j = 0; j < 4; ++j) P2[(size_t)(r0 + j) * PS2 + pc] = f2bf(v[j]);
          if ((m & 1) && fq == 3) PB[(size_t)((r0 + 3) >> 5) * 1792 + pc] = f2bf(v[3]);
        }
      }
  }
}

__device__ __forceinline__ void phase_merge(const Params& p, char* smem) {
  const u16* H2 = (const u16*)(p.ws + OFF_H); const u16* WG = (const u16*)(p.ws + OFF_WG); const u16* WB = (const u16*)(p.ws + OFF_WB);
  const u16* P1 = (const u16*)(p.ws + OFF_P1); u16* MG = (u16*)(p.ws + OFF_MERGED);
  const int lane = tidx() & 63, wid = tidx() >> 6, wr = wid >> 1, wc = wid & 1, fr = lane & 15, fq = lane >> 4;
  int mt, nt;
  for (int it = 0; tile_map(it, 16, mt, nt); ++it) {
    const int m0 = mt * 128, n0 = nt * 64;
    f32x4 tot[4][2]; ZERO_ACC(tot, 2)
#pragma unroll 1
    for (int i = 0; i < 3; ++i) {
      unsigned gpk[4][2][2];
      {
        f32x4 ag[4][2]; ZERO_ACC(ag, 2)
        gemm_loop_dma<2>(ag, H2 + (size_t)m0 * 1024, 1024, WG + (size_t)(i * 1024 + n0) * 1024, 1024, 1024, (u16*)smem);
#pragma unroll
        for (int m = 0; m < 4; ++m)
#pragma unroll
          for (int n = 0; n < 2; ++n) {
            gpk[m][n][0] = pack2(sigmoidf_(ag[m][n][0]), sigmoidf_(ag[m][n][1]));
            gpk[m][n][1] = pack2(sigmoidf_(ag[m][n][2]), sigmoidf_(ag[m][n][3]));
          }
      }
      f32x4 ay[4][2]; ZERO_ACC(ay, 2)
      const u16* ya = (i == 0) ? P1 : ((i == 1) ? P1 + 1048 : P1 + 1560);
      const int lda = PS1;
      const u16* wb = WB + (size_t)i * 1024 * 512;
      gemm_loop_dma<2>(ay, ya + (size_t)m0 * lda, lda, wb + (size_t)n0 * 512, 512, 512, (u16*)smem);
#pragma unroll
      for (int m = 0; m < 4; ++m)
#pragma unroll
        for (int n = 0; n < 2; ++n) {
          tot[m][n][0] += bf2f((u16)(gpk[m][n][0] & 0xffff)) * ay[m][n][0];
          tot[m][n][1] += bf2f((u16)(gpk[m][n][0] >> 16)) * ay[m][n][1];
          tot[m][n][2] += bf2f((u16)(gpk[m][n][1] & 0xffff)) * ay[m][n][2];
          tot[m][n][3] += bf2f((u16)(gpk[m][n][1] >> 16)) * ay[m][n][3];
        }
    }
#pragma unroll
    for (int m = 0; m < 4; ++m)
#pragma unroll
      for (int n = 0; n < 2; ++n) {
        const int col = n0 + wc * 32 + n * 16 + fr;
        const int r0 = m0 + wr * 64 + m * 16 + fq * 4;
#pragma unroll
        for (int j = 0; j < 4; ++j) MG[(size_t)(r0 + j) * 1024 + col] = f2bf(tot[m][n][j]);
      }
  }
}

__device__ __forceinline__ void phase_cmp1(const Params& p, int l, char* smem) {
  const u16* P1 = (const u16*)(p.ws + OFF_P1); const u16* W1 = (const u16*)(p.ws + OFF_W1); u16* HID = (u16*)(p.ws + OFF_HID);
  const int lane = tidx() & 63, wid = tidx() >> 6, wr = wid >> 1, wc = wid & 1, fr = lane & 15, fq = lane >> 4;
  for (int tix = blockIdx.x; tix < 128; tix += gridDim.x) {
    const int which = tix >> 6, mt = (tix >> 1) & 31, nt = tix & 1;
    const int m0 = mt * 128, n0 = nt * 128;
    const float* pe = (which ? p.in[16] : p.in[13]) + (size_t)l * 2048;
    const u16* w1 = W1 + (size_t)which * 256 * 2048;
    const int cbase = 512 + which * 128;
    f32x4 acc[4][4]; ZERO_ACC(acc, 4)
    auto fa = [&](int r, int k) {
      const int row = m0 + r; const int g = row & 1, n = (row >> 1) & 255, b = row >> 9;
      uint4 o = make_uint4(0, 0, 0, 0);
      if (n < 255) {
        const int lpos = k >> 6, d = k & 63;
        uint4 raw = *(const uint4*)(P1 + (size_t)(b * 4096 + 16 * n + lpos) * PS1 + cbase + g * 64 + d);
        const float* pp = pe + lpos * 64 + d;
        float4 e0 = *(const float4*)pp, e1 = *(const float4*)(pp + 4);
        o.x = pack2(bf2f((u16)(raw.x & 0xffff)) + e0.x, bf2f((u16)(raw.x >> 16)) + e0.y);
        o.y = pack2(bf2f((u16)(raw.y & 0xffff)) + e0.z, bf2f((u16)(raw.y >> 16)) + e0.w);
        o.z = pack2(bf2f((u16)(raw.z & 0xffff)) + e1.x, bf2f((u16)(raw.z >> 16)) + e1.y);
        o.w = pack2(bf2f((u16)(raw.w & 0xffff)) + e1.z, bf2f((u16)(raw.w >> 16)) + e1.w);
      }
      return o;
    };
    auto fb = [&](int r, int k) { return *(const uint4*)(w1 + (size_t)(n0 + r) * 2048 + k); };
    gemm_loop<4>(acc, fa, fb, 2048, (u16*)smem);
#pragma unroll
    for (int m = 0; m < 4; ++m)
#pragma unroll
      for (int n = 0; n < 4; ++n) {
        const int col = n0 + wc * 64 + n * 16 + fr;
        const int r0 = m0 + wr * 64 + m * 16 + fq * 4;
#pragma unroll
        for (int j = 0; j < 4; ++j) HID[((size_t)which * 4096 + r0 + j) * 256 + col] = f2bf(siluf_(acc[m][n][j]));
      }
  }
}

__device__ __forceinline__ void phase_cmp2(const Params& p, int l) {
  const u16* HID = (const u16*)(p.ws + OFF_HID); u16* KC = (u16*)(p.ws + OFF_KC); u16* VC = (u16*)(p.ws + OFF_VC);
  const int total = 2 * 4096 * 64;
  for (int idx = blockIdx.x * 256 + tidx(); idx < total; idx += gridDim.x * 256) {
    const int d = idx & 63, row = (idx >> 6) & 4095, which = idx >> 18;
    const float* w2 = (which ? p.in[15] : p.in[12]) + (size_t)l * 256 * 64;
    const u16* hr = HID + ((size_t)which * 4096 + row) * 256;
    float acc = 0.f;
#pragma unroll 8
    for (int j = 0; j < 256; ++j) acc += bf2f(hr[j]) * w2[j * 64 + d];
    const int g = row & 1, n = (row >> 1) & 255, b = row >> 9;
    if (which == 0) KC[((size_t)(b * 2 + g) * 256 + n) * 64 + d] = f2bf(acc);
    else {
      const int u = n & 31; const int pp = 8 * ((u >> 2) & 3) + 4 * (u >> 4) + (u & 3);
      VC[((size_t)(b * 2 + g) * 64 + d) * 256 + (n & ~31) + pp] = f2bf(acc);
    }
  }
}

__device__ __forceinline__ void phase_sgu(const Params& p, int l, char* smem) {
  u16* P1 = (u16*)(p.ws + OFF_P1);
  u16* Wt = (u16*)smem;
  u16* Vt = Wt + 128 * 136;
  float* st = (float*)(Vt + 128 * 136);
  const int tid = tidx(), lane = tid & 63, wid = tid >> 6, wr = wid >> 1, wc = wid & 1, fr = lane & 15, fq = lane >> 4;
  const float* lng = p.in[17] + (size_t)l * 512; const float* lnb = p.in[18] + (size_t)l * 512;
  for (int item = blockIdx.x; item < 1024; item += gridDim.x) {
    const int ci = item >> 2, gi = item & 3;
    const int tok0 = ci * 128;
#pragma unroll 1
    for (int r0 = wid * 32; r0 < wid * 32 + 32; r0 += 8) {
      uint4 raw[8];
#pragma unroll
      for (int u = 0; u < 8; ++u) raw[u] = *(const uint4*)(P1 + (size_t)(tok0 + r0 + u) * PS1 + 1560 + lane * 8);
#pragma unroll
      for (int u = 0; u < 8; ++u) {
        float f[8];
        f[0] = bf2f((u16)(raw[u].x & 0xffff)); f[1] = bf2f((u16)(raw[u].x >> 16)); f[2] = bf2f((u16)(raw[u].y & 0xffff)); f[3] = bf2f((u16)(raw[u].y >> 16));
        f[4] = bf2f((u16)(raw[u].z & 0xffff)); f[5] = bf2f((u16)(raw[u].z >> 16)); f[6] = bf2f((u16)(raw[u].w & 0xffff)); f[7] = bf2f((u16)(raw[u].w >> 16));
        float s = 0.f, s2 = 0.f;
#pragma unroll
        for (int e = 0; e < 8; ++e) { s += f[e]; }
        s = wave_sum(s);
        const float mu = s * (1.f / 512.f);
#pragma unroll
        for (int e = 0; e < 8; ++e) { float dlt = f[e] - mu; s2 += dlt * dlt; }
        s2 = wave_sum(s2);
        if (lane == 0) { st[(r0 + u) * 2] = mu; st[(r0 + u) * 2 + 1] = rsqrtf(s2 * (1.f / 512.f) + 1e-5f); }
      }
    }
    const float* wsrc = p.in[19] + ((size_t)(l * 4 + gi)) * 128 * 128;
    for (int e = tid; e < 128 * 32; e += 256) {
      const int t = e >> 5, s4 = (e & 31) * 4;
      float4 w = *(const float4*)(wsrc + t * 128 + s4);
      uint2 o;
      o.x = pack2(s4 + 0 <= t ? w.x : 0.f, s4 + 1 <= t ? w.y : 0.f);
      o.y = pack2(s4 + 2 <= t ? w.z : 0.f, s4 + 3 <= t ? w.w : 0.f);
      *(uint2*)(Wt + t * 136 + s4) = o;
    }
    __syncthreads();
    for (int e = tid; e < 128 * 16; e += 256) {
      const int s = e >> 4, c8 = (e & 15) * 8;
      uint4 raw = *(const uint4*)(P1 + (size_t)(tok0 + s) * PS1 + 1560 + gi * 128 + c8);
      const float mu = st[s * 2], rs = st[s * 2 + 1];
      u16 rv[8] = {(u16)(raw.x & 0xffff), (u16)(raw.x >> 16), (u16)(raw.y & 0xffff), (u16)(raw.y >> 16), (u16)(raw.z & 0xffff), (u16)(raw.z >> 16), (u16)(raw.w & 0xffff), (u16)(raw.w >> 16)};
#pragma unroll
      for (int i = 0; i < 8; ++i) {
        const int c = gi * 128 + c8 + i;
        Vt[(c8 + i) * 136 + s] = f2bf((bf2f(rv[i]) - mu) * rs * lng[c] + lnb[c]);
      }
    }
    __syncthreads();
    f32x4 acc[4][4]; ZERO_ACC(acc, 4)
#pragma unroll 1
    for (int ks = 0; ks < 4; ++ks) {
      bf16x8 a[4], b[4];
#pragma unroll
      for (int m = 0; m < 4; ++m) a[m] = *(const bf16x8*)(Wt + (wr * 64 + m * 16 + fr) * 136 + ks * 32 + fq * 8);
#pragma unroll
      for (int n = 0; n < 4; ++n) b[n] = *(const bf16x8*)(Vt + (wc * 64 + n * 16 + fr) * 136 + ks * 32 + fq * 8);
#pragma unroll
      for (int m = 0; m < 4; ++m)
#pragma unroll
        for (int n = 0; n < 4; ++n) acc[m][n] = mfma16(a[m], b[n], acc[m][n]);
    }
    const float* bs = p.in[20] + ((size_t)(l * 4 + gi)) * 128;
#pragma unroll
    for (int m = 0; m < 4; ++m)
#pragma unroll
      for (int n = 0; n < 4; ++n) {
        const int c = wc * 64 + n * 16 + fr;
#pragma unroll
        for (int j = 0; j < 4; ++j) {
          const int t = wr * 64 + m * 16 + fq * 4 + j;
          u16* up = P1 + (size_t)(tok0 + t) * PS1 + 1048 + gi * 128 + c;
          *up = f2bf(bf2f(*up) * (acc[m][n][j] + bs[t]));
        }
      }
    __syncthreads();
  }
}

__device__ __forceinline__ void phase_prep1(const Params& p, int l) {
  u16* P2 = (u16*)(p.ws + OFF_P2); const u16* PB = (const u16*)(p.ws + OFF_PB); u16* VF = (u16*)(p.ws + OFF_VFIRST);
  const float* mu = p.in[21] + (size_t)l * 1792;
  const int total = 1024 * 224;
  for (int idx = blockIdx.x * 256 + tidx(); idx < total; idx += gridDim.x * 256) {
    const int tile = idx / 224, cg8 = (idx % 224) * 8;
    const int tok0 = tile * 32;
    float m8[8];
#pragma unroll
    for (int e = 0; e < 8; ++e) m8[e] = mu[cg8 + e];
    uint4 prev = make_uint4(0, 0, 0, 0);
    if ((tok0 & 4095) != 0) prev = *(const uint4*)(PB + (size_t)(tile - 1) * 1792 + cg8);
#pragma unroll 1
    for (int r0 = 0; r0 < 32; r0 += 8) {
      uint4 cv[8];
#pragma unroll
      for (int u = 0; u < 8; ++u) cv[u] = *(const uint4*)(P2 + (size_t)(tok0 + r0 + u) * PS2 + cg8);
#pragma unroll
      for (int u = 0; u < 8; ++u) {
        const uint4 cur = cv[u];
        unsigned cu[4] = {cur.x, cur.y, cur.z, cur.w}, pu[4] = {prev.x, prev.y, prev.z, prev.w};
        float o[8];
#pragma unroll
        for (int e = 0; e < 8; ++e) {
          float c = bf2f((u16)((cu[e >> 1] >> ((e & 1) * 16)) & 0xffff));
          float pv = bf2f((u16)((pu[e >> 1] >> ((e & 1) * 16)) & 0xffff));
          float sv = c + (pv - c) * m8[e];
          if (cg8 >= 1536 && cg8 < 1600) sv = tanhf_(sv);
          else if (cg8 >= 1664) sv = sigmoidf_(sv);
          o[e] = sv;
        }
        uint4 ov; ov.x = pack2(o[0], o[1]); ov.y = pack2(o[2], o[3]); ov.z = pack2(o[4], o[5]); ov.w = pack2(o[6], o[7]);
        *(uint4*)(P2 + (size_t)(tok0 + r0 + u) * PS2 + cg8) = ov;
        if (l == 0 && cg8 >= 1024 && cg8 < 1536) *(uint4*)(VF + (size_t)(tok0 + r0 + u) * 512 + cg8 - 1024) = ov;
        prev = cur;
      }
    }
  }
}

__device__ __forceinline__ void phase_prep2(const Params& p, int l, char* smem) {
  u16* P2 = (u16*)(p.ws + OFF_P2); const u16* VF = (const u16*)(p.ws + OFF_VFIRST);
  float* twd = (float*)smem;
  float* adl = twd + 1024;
  float* vsh = adl + 1024;
  float* lv = vsh + 8192;
  const int tid = tidx();
  const float* w0 = p.in[22] + (size_t)l * 512; const float* w2 = p.in[23] + (size_t)l * 64 * 512;
  const float* a0 = p.in[24] + (size_t)l * 512; const float* a2 = p.in[25] + (size_t)l * 64 * 512;
  const float* kkp = p.in[27] + (size_t)l * 512; const float* kap = p.in[28] + (size_t)l * 512;
  for (int item = blockIdx.x; item < 2048; item += gridDim.x) {
    const int tok0 = item * 16;
    for (int e = tid; e < 2048; e += 256) {
      const int r = e >> 7, c = e & 127;
      twd[(c >> 6) * 1024 + r * 64 + (c & 63)] = bf2f(P2[(size_t)(tok0 + r) * PS2 + 1536 + c]);
    }
    if (l > 0) {
      for (int e = tid; e < 8192; e += 256) { const int r = e >> 9, c = e & 511; vsh[e] = bf2f(P2[(size_t)(tok0 + r) * PS2 + 1024 + c]); }
    }
    __syncthreads();
    if (l > 0) {
      const float* v1 = p.in[33];
      for (int e = tid; e < 512; e += 256) {
        const int r = e >> 5, j = e & 31;
        float s = 0.f;
#pragma unroll 2
        for (int c = 0; c < 512; c += 4) {
          const float4 t4 = *(const float4*)(vsh + r * 512 + c);
          s += t4.x * v1[c * 32 + j] + t4.y * v1[(c + 1) * 32 + j] + t4.z * v1[(c + 2) * 32 + j] + t4.w * v1[(c + 3) * 32 + j];
        }
        lv[r * 32 + j] = s;
      }
      __syncthreads();
    }
    {
      float aw[2][16], aa[2][16], am[2][16];
#pragma unroll
      for (int c = 0; c < 2; ++c)
#pragma unroll
        for (int r = 0; r < 16; ++r) { aw[c][r] = 0.f; aa[c][r] = 0.f; am[c][r] = 0.f; }
#pragma unroll 2
      for (int i = 0; i < 64; i += 4) {
        float wv[2][4], av[2][4];
#pragma unroll
        for (int c = 0; c < 2; ++c)
#pragma unroll
          for (int u = 0; u < 4; ++u) { wv[c][u] = w2[(i + u) * 512 + tid + c * 256]; av[c][u] = a2[(i + u) * 512 + tid + c * 256]; }
#pragma unroll
        for (int r = 0; r < 16; ++r) {
          const float4 tw = *(const float4*)(twd + r * 64 + i);
          const float4 ta = *(const float4*)(adl + r * 64 + i);
#pragma unroll
          for (int c = 0; c < 2; ++c) {
            aw[c][r] += tw.x * wv[c][0] + tw.y * wv[c][1] + tw.z * wv[c][2] + tw.w * wv[c][3];
            aa[c][r] += ta.x * av[c][0] + ta.y * av[c][1] + ta.z * av[c][2] + ta.w * av[c][3];
          }
        }
      }
      if (l > 0) {
        const float* v2 = p.in[34];
#pragma unroll 2
        for (int j = 0; j < 32; j += 4) {
          float vv[2][4];
#pragma unroll
          for (int c = 0; c < 2; ++c)
#pragma unroll
            for (int u = 0; u < 4; ++u) vv[c][u] = v2[(j + u) * 512 + tid + c * 256];
#pragma unroll
          for (int r = 0; r < 16; ++r) {
            const float4 t4 = *(const float4*)(lv + r * 32 + j);
#pragma unroll
            for (int c = 0; c < 2; ++c) am[c][r] += t4.x * vv[c][0] + t4.y * vv[c][1] + t4.z * vv[c][2] + t4.w * vv[c][3];
          }
        }
      }
#pragma unroll
      for (int c = 0; c < 2; ++c) {
        const int ch = tid + c * 256;
        const float w0v = w0[ch], a0v = a0[ch], kkv = kkp[ch], kav = kap[ch];
        const float v0v = (l > 0) ? p.in[32][ch] : 0.f;
        float kval[16];
#pragma unroll
        for (int r = 0; r < 16; ++r) kval[r] = bf2f(P2[(size_t)(tok0 + r) * PS2 + 512 + ch]);
#pragma unroll
        for (int r = 0; r < 16; ++r) {
          u16* row = P2 + (size_t)(tok0 + r) * PS2;
          const float wpre = w0v + aw[c][r];
          const float nx = -wpre;
          const float sp = fmaxf(nx, 0.f) + __logf(1.f + __expf(-fabsf(nx)));
          const float w = -sp - 0.5f;
          const float decay = __expf(-__expf(w));
          const float a = sigmoidf_(a0v + aa[c][r]);
          const float kk = kval[r] * kkv;
          const float ss = wave_sum(kk * kk);
          const float kkn = kk / fmaxf(sqrtf(ss), 1e-12f);
          row[1792 + ch] = f2bf(decay);
          row[2304 + ch] = f2bf(kkn);
          row[2816 + ch] = f2bf(kkn * a);
          row[512 + ch] = f2bf(kval[r] * (1.f + (a - 1.f) * kav));
          if (l > 0) {
            const float v = vsh[r * 512 + ch];
            const float vf = bf2f(VF[(size_t)(tok0 + r) * 512 + ch]);
            row[1024 + ch] = f2bf(v + (vf - v) * sigmoidf_(v0v + am[c][r]));
          }
        }
      }
    }
    __syncthreads();
  }
}

__device__ __forceinline__ void unpack4(uint2 u, float (&f)[4]) {
  f[0] = bf2f((u16)(u.x & 0xffff)); f[1] = bf2f((u16)(u.x >> 16)); f[2] = bf2f((u16)(u.y & 0xffff)); f[3] = bf2f((u16)(u.y >> 16));
}
__device__ __forceinline__ float quad_sum(float v) { v += __shfl_xor(v, 16); v += __shfl_xor(v, 32); return v; }

__device__ __forceinline__ void phase_prep2m(const Params& p, int l, char* smem) {
  u16* P2 = (u16*)(p.ws + OFF_P2); const u16* VF = (const u16*)(p.ws + OFF_VFIRST); const u16* WL = (const u16*)(p.ws + OFF_WL);
  u16* twl = (u16*)smem;
  u16* adl = twl + 16 * 72;
  u16* vl = adl + 16 * 72;
  const int tid = tidx(), lane = tid & 63, w = tid >> 6, fr = lane & 15, fq = lane >> 4;
  const float* w0 = p.in[22] + (size_t)l * 512; const float* a0 = p.in[24] + (size_t)l * 512;
  const float* kkp = p.in[27] + (size_t)l * 512; const float* kap = p.in[28] + (size_t)l * 512;
#pragma unroll 1
  for (int item = blockIdx.x; item < 2048; item += gridDim.x) {
    const int tok0 = item * 16;
    {
      const int r = tid >> 4, c = tid & 15;
      const uint4 v = *(const uint4*)(P2 + (size_t)(tok0 + r) * PS2 + 1536 + c * 8);
      if (c < 8) *(uint4*)(twl + r * 72 + c * 8) = v; else *(uint4*)(adl + r * 72 + (c - 8) * 8) = v;
    }
    if (l > 0) {
#pragma unroll
      for (int i = 0; i < 4; ++i) {
        const int idx = tid + 256 * i, r = idx >> 6, c = idx & 63;
        *(uint4*)(vl + r * 520 + c * 8) = *(const uint4*)(P2 + (size_t)(tok0 + r) * PS2 + 1024 + c * 8);
      }
    }
    __syncthreads();
    bf16x8 xw[2], xa[2];
#pragma unroll
    for (int ks = 0; ks < 2; ++ks) { xw[ks] = *(const bf16x8*)(twl + fr * 72 + ks * 32 + fq * 8); xa[ks] = *(const bf16x8*)(adl + fr * 72 + ks * 32 + fq * 8); }
    bf16x8 plv = {0, 0, 0, 0, 0, 0, 0, 0};
    if (l > 0) {
      f32x4 lv0 = {0.f, 0.f, 0.f, 0.f}, lv1 = {0.f, 0.f, 0.f, 0.f};
#pragma unroll 4
      for (int ks = 0; ks < 16; ++ks) {
        const bf16x8 xb = *(const bf16x8*)(vl + fr * 520 + ks * 32 + fq * 8);
        const bf16x8 a0f = *(const bf16x8*)(WL + WL_V1 + (size_t)fr * 512 + ks * 32 + fq * 8);
        const bf16x8 a1f = *(const bf16x8*)(WL + WL_V1 + (size_t)(16 + fr) * 512 + ks * 32 + fq * 8);
        lv0 = mfma16(a0f, xb, lv0); lv1 = mfma16(a1f, xb, lv1);
      }
      uint4 u; u.x = pack2(lv0[0], lv0[1]); u.y = pack2(lv0[2], lv0[3]); u.z = pack2(lv1[0], lv1[1]); u.w = pack2(lv1[2], lv1[3]);
      plv = *(bf16x8*)&u;
    }
    const size_t tok = (size_t)tok0 + fr;
    u16* row = P2 + tok * PS2;
#pragma unroll 1
    for (int hh = 0; hh < 2; ++hh) {
      f32x4 aw[4], aa[4], am[4];
#pragma unroll
      for (int m4 = 0; m4 < 4; ++m4) {
        const int chr = w * 128 + (hh * 4 + m4) * 16 + fr;
        f32x4 cw = {0.f, 0.f, 0.f, 0.f}, ca = {0.f, 0.f, 0.f, 0.f}, cm = {0.f, 0.f, 0.f, 0.f};
#pragma unroll
        for (int ks = 0; ks < 2; ++ks) {
          cw = mfma16(*(const bf16x8*)(WL + WL_W2 + (size_t)chr * 64 + ks * 32 + fq * 8), xw[ks], cw);
          ca = mfma16(*(const bf16x8*)(WL + WL_A2 + (size_t)chr * 64 + ks * 32 + fq * 8), xa[ks], ca);
        }
        if (l > 0) {
          const uint2 g0 = *(const uint2*)(WL + WL_V2 + (size_t)chr * 64 + 4 * fq);
          const uint2 g1 = *(const uint2*)(WL + WL_V2 + (size_t)chr * 64 + 16 + 4 * fq);
          uint4 u; u.x = g0.x; u.y = g0.y; u.z = g1.x; u.w = g1.y;
          cm = mfma16(*(bf16x8*)&u, plv, cm);
        }
        aw[m4] = cw; aa[m4] = ca; am[m4] = cm;
      }
      float kv[4][4], av[4][4], kk[4][4];
      float ss = 0.f;
#pragma unroll
      for (int m4 = 0; m4 < 4; ++m4) {
        const int ch0 = w * 128 + (hh * 4 + m4) * 16 + 4 * fq;
        unpack4(*(const uint2*)(row + 512 + ch0), kv[m4]);
        const float4 a0v = *(const float4*)(a0 + ch0), kkv = *(const float4*)(kkp + ch0);
        const float a0a[4] = {a0v.x, a0v.y, a0v.z, a0v.w}, kka[4] = {kkv.x, kkv.y, kkv.z, kkv.w};
#pragma unroll
        for (int j = 0; j < 4; ++j) {
          av[m4][j] = sigmoidf_(a0a[j] + aa[m4][j]);
          kk[m4][j] = kv[m4][j] * kka[j];
          ss += kk[m4][j] * kk[m4][j];
        }
      }
      ss = quad_sum(ss);
      const float rn = 1.f / fmaxf(sqrtf(ss), 1e-12f);
#pragma unroll
      for (int m4 = 0; m4 < 4; ++m4) {
        const int ch0 = w * 128 + (hh * 4 + m4) * 16 + 4 * fq;
        const float4 w0v = *(const float4*)(w0 + ch0), kav = *(const float4*)(kap + ch0);
        const float w0a[4] = {w0v.x, w0v.y, w0v.z, w0v.w}, kaa[4] = {kav.x, kav.y, kav.z, kav.w};
        float dc[4], kn[4], bb[4], kp[4];
#pragma unroll
        for (int j = 0; j < 4; ++j) {
          const float nx = -(w0a[j] + aw[m4][j]);
          const float sp = fmaxf(nx, 0.f) + __logf(1.f + __expf(-fabsf(nx)));
          dc[j] = __expf(-__expf(-sp - 0.5f));
          kn[j] = kk[m4][j] * rn;
          bb[j] = kn[j] * av[m4][j];
          kp[j] = kv[m4][j] * (1.f + (av[m4][j] - 1.f) * kaa[j]);
        }
        uint2 o;
        o.x = pack2(dc[0], dc[1]); o.y = pack2(dc[2], dc[3]); *(uint2*)(row + 1792 + ch0) = o;
        o.x = pack2(kn[0], kn[1]); o.y = pack2(kn[2], kn[3]); *(uint2*)(row + 2304 + ch0) = o;
        o.x = pack2(bb[0], bb[1]); o.y = pack2(bb[2], bb[3]); *(uint2*)(row + 2816 + ch0) = o;
        o.x = pack2(kp[0], kp[1]); o.y = pack2(kp[2], kp[3]); *(uint2*)(row + 512 + ch0) = o;
        if (l > 0) {
          float vv[4], vf[4];
          unpack4(*(const uint2*)(vl + fr * 520 + ch0), vv);
          unpack4(*(const uint2*)(VF + tok * 512 + ch0), vf);
          const float4 v0v = *(const float4*)(p.in[32] + ch0);
          const float v0a[4] = {v0v.x, v0v.y, v0v.z, v0v.w};
          float vo[4];
#pragma unroll
          for (int j = 0; j < 4; ++j) vo[j] = vv[j] + (vf[j] - vv[j]) * sigmoidf_(v0a[j] + am[m4][j]);
          o.x = pack2(vo[0], vo[1]); o.y = pack2(vo[2], vo[3]); *(uint2*)(row + 1024 + ch0) = o;
        }
      }
    }
    __syncthreads();
  }
}

__device__ __forceinline__ void phase_postm(const Params& p, int l, char* smem) {
  const u16* P2 = (const u16*)(p.ws + OFF_P2); u16* YC = (u16*)(p.ws + OFF_P1) + 1560; const u16* WL = (const u16*)(p.ws + OFF_WL);
  u16* sgl = (u16*)smem;
  const int tid = tidx(), lane = tid & 63, w = tid >> 6, fr = lane & 15, fq = lane >> 4;
  const float* rk = p.in[29] + (size_t)l * 512; const float* lg = p.in[30] + (size_t)l * 512; const float* lb = p.in[31] + (size_t)l * 512;
#pragma unroll 1
  for (int item = blockIdx.x; item < 2048; item += gridDim.x) {
    const int tok0 = item * 16;
    {
      const int r = tid >> 4, c = tid & 15;
      *(uint4*)(sgl + r * 136 + c * 8) = *(const uint4*)(P2 + (size_t)(tok0 + r) * PS2 + 1664 + c * 8);
    }
    __syncthreads();
    bf16x8 xb[4];
#pragma unroll
    for (int ks = 0; ks < 4; ++ks) xb[ks] = *(const bf16x8*)(sgl + fr * 136 + ks * 32 + fq * 8);
    const size_t tok = (size_t)tok0 + fr;
    const u16* row = P2 + tok * PS2;
    u16* yrow = YC + tok * PS1;
#pragma unroll 1
    for (int hh = 0; hh < 2; ++hh) {
      f32x4 ag[4];
#pragma unroll
      for (int m4 = 0; m4 < 4; ++m4) {
        const int chr = w * 128 + (hh * 4 + m4) * 16 + fr;
        f32x4 c = {0.f, 0.f, 0.f, 0.f};
#pragma unroll
        for (int ks = 0; ks < 4; ++ks) c = mfma16(*(const bf16x8*)(WL + WL_G2 + (size_t)chr * 128 + ks * 32 + fq * 8), xb[ks], c);
        ag[m4] = c;
      }
      float yv[4][4], vv[4][4];
      float s1 = 0.f, sb = 0.f;
#pragma unroll
      for (int m4 = 0; m4 < 4; ++m4) {
        const int ch0 = w * 128 + (hh * 4 + m4) * 16 + 4 * fq;
        float rr[4], kk[4];
        unpack4(*(const uint2*)(yrow + ch0), yv[m4]);
        unpack4(*(const uint2*)(row + ch0), rr);
        unpack4(*(const uint2*)(row + 512 + ch0), kk);
        unpack4(*(const uint2*)(row + 1024 + ch0), vv[m4]);
        const float4 rkv = *(const float4*)(rk + ch0);
        s1 += yv[m4][0] + yv[m4][1] + yv[m4][2] + yv[m4][3];
        sb += rr[0] * kk[0] * rkv.x + rr[1] * kk[1] * rkv.y + rr[2] * kk[2] * rkv.z + rr[3] * kk[3] * rkv.w;
      }
      s1 = quad_sum(s1); sb = quad_sum(sb);
      const float mean = s1 * (1.f / 64.f);
      float s2 = 0.f;
#pragma unroll
      for (int m4 = 0; m4 < 4; ++m4)
#pragma unroll
        for (int j = 0; j < 4; ++j) { const float d = yv[m4][j] - mean; s2 += d * d; }
      s2 = quad_sum(s2);
      const float rs = rsqrtf(s2 * (1.f / 64.f) + 64e-5f);
#pragma unroll
      for (int m4 = 0; m4 < 4; ++m4) {
        const int ch0 = w * 128 + (hh * 4 + m4) * 16 + 4 * fq;
        const float4 lgv = *(const float4*)(lg + ch0), lbv = *(const float4*)(lb + ch0);
        const float lga[4] = {lgv.x, lgv.y, lgv.z, lgv.w}, lba[4] = {lbv.x, lbv.y, lbv.z, lbv.w};
        float o4[4];
#pragma unroll
        for (int j = 0; j < 4; ++j) o4[j] = ((yv[m4][j] - mean) * rs * lga[j] + lba[j] + sb * vv[m4][j]) * ag[m4][j];
        uint2 o; o.x = pack2(o4[0], o4[1]); o.y = pack2(o4[2], o4[3]);
        *(uint2*)(yrow + ch0) = o;
      }
    }
    __syncthreads();
  }
}

__device__ __forceinline__ void scan_item(const Params& p, int item, char* smem) {
  const u16* P2 = (const u16*)(p.ws + OFF_P2); u16* YC = (u16*)(p.ws + OFF_P1) + 1560;
  float* vb = (float*)smem;
  float* yb = vb + 2 * 6 * 16 * 64;
  const int tid = tidx(), lane = tid & 63, wid = tid >> 6;
  const int rq = item & 3, h = (item >> 2) & 7, b = item >> 5;
  const int rl = lane >> 4, cq = lane & 15;
  const int rloc = wid * 4 + rl;
  const int ihead = rq * 16 + rloc;
  const int j0 = cq * 4;
  const size_t tokb = (size_t)b * 4096;
  float s0 = 0.f, s1 = 0.f, s2 = 0.f, s3 = 0.f;
  uint4 pA[3], pB[3], pC[3];
  auto gload = [&](uint4 (&pre)[3], int c) {
#pragma unroll
    for (int i = 0; i < 3; ++i) {
      const int v = tid + i * 256; const int vec = v >> 7, rem = v & 127, step = rem >> 3, c8 = rem & 7;
      const int off = (vec == 0) ? 0 : (vec == 1) ? 1792 : (vec == 2) ? 512 : (vec == 3) ? 1024 : (vec == 4) ? 2304 : 2816;
      pre[i] = *(const uint4*)(P2 + (tokb + c * 16 + step) * PS2 + off + h * 64 + c8 * 8);
    }
  };
  auto lstore = [&](const uint4 (&pre)[3], int buf) {
#pragma unroll
    for (int i = 0; i < 3; ++i) {
      const int v = tid + i * 256; const int vec = v >> 7, rem = v & 127, step = rem >> 3, c8 = rem & 7;
      float* d = vb + ((buf * 6 + vec) * 16 + step) * 64 + c8 * 8;
      float4 f0, f1;
      f0.x = bf2f((u16)(pre[i].x & 0xffff)); f0.y = bf2f((u16)(pre[i].x >> 16)); f0.z = bf2f((u16)(pre[i].y & 0xffff)); f0.w = bf2f((u16)(pre[i].y >> 16));
      f1.x = bf2f((u16)(pre[i].z & 0xffff)); f1.y = bf2f((u16)(pre[i].z >> 16)); f1.z = bf2f((u16)(pre[i].w & 0xffff)); f1.w = bf2f((u16)(pre[i].w >> 16));
      *(float4*)d = f0; *(float4*)(d + 4) = f1;
    }
  };
#define SC_LOAD(X, ST) { r##X = *(const float4*)(base + (0 * 16 + (ST)) * 64 + j0); w##X = *(const float4*)(base + (1 * 16 + (ST)) * 64 + j0); \
      k##X = *(const float4*)(base + (2 * 16 + (ST)) * 64 + j0); v##X = base[(3 * 16 + (ST)) * 64 + ihead]; \
      n##X = *(const float4*)(base + (4 * 16 + (ST)) * 64 + j0); b##X = *(const float4*)(base + (5 * 16 + (ST)) * 64 + j0); }
#define SC_STEP(X, ST) { float sa = s0 * n##X.x + s1 * n##X.y + s2 * n##X.z + s3 * n##X.w; \
      sa = -dpp_sum16(sa); \
      s0 = s0 * w##X.x + sa * b##X.x + v##X * k##X.x; s1 = s1 * w##X.y + sa * b##X.y + v##X * k##X.y; \
      s2 = s2 * w##X.z + sa * b##X.z + v##X * k##X.z; s3 = s3 * w##X.w + sa * b##X.w + v##X * k##X.w; \
      float y = s0 * r##X.x + s1 * r##X.y + s2 * r##X.z + s3 * r##X.w; \
      y = dpp_sum16(y); yb[(ST) * 16 + rloc] = y; }
#define SC_CHUNK(CC, PRE) { const int cc_ = (CC); if (cc_ >= 256) break; \
    const float* base = vb + (cc_ & 1) * 6 * 16 * 64; \
    { float4 rA, wA, kA, nA, bA, rB, wB, kB, nB, bB; float vA, vB; \
      SC_LOAD(A, 0) \
      _Pragma("unroll") for (int st = 0; st < 16; st += 2) { SC_LOAD(B, st + 1) SC_STEP(A, st) if (st + 2 < 16) SC_LOAD(A, st + 2) SC_STEP(B, st + 1) } } \
    __syncthreads(); \
    { const int st = tid >> 4, r = tid & 15; \
      YC[(tokb + cc_ * 16 + st) * PS1 + h * 64 + rq * 16 + r] = f2bf(yb[st * 16 + r]); } \
    if (cc_ + 1 < 256) lstore(PRE, (cc_ + 1) & 1); \
    if (cc_ + 4 < 256) gload(PRE, cc_ + 4); \
    __syncthreads(); }
  gload(pA, 0); lstore(pA, 0);
  __syncthreads();
  gload(pA, 1); gload(pB, 2); gload(pC, 3);
#pragma unroll 1
  for (int c = 0; c < 256; c += 3) {
    SC_CHUNK(c, pA)
    SC_CHUNK(c + 1, pB)
    SC_CHUNK(c + 2, pC)
  }
#undef SC_LOAD
#undef SC_STEP
#undef SC_CHUNK
}

__device__ __forceinline__ void phase_post(const Params& p, int l, char* smem) {
  const u16* P2 = (const u16*)(p.ws + OFF_P2); u16* YC = (u16*)(p.ws + OFF_P1) + 1560;
  float* sg = (float*)smem;
  const int tid = tidx();
  const float* g2 = p.in[26] + (size_t)l * 128 * 512;
  const float* rk = p.in[29] + (size_t)l * 512; const float* lg = p.in[30] + (size_t)l * 512; const float* lb = p.in[31] + (size_t)l * 512;
  for (int item = blockIdx.x; item < 2048; item += gridDim.x) {
    const int tok0 = item * 16;
    for (int e = tid; e < 2048; e += 256) { const int r = e >> 7, c = e & 127; sg[e] = bf2f(P2[(size_t)(tok0 + r) * PS2 + 1664 + c]); }
    __syncthreads();
    {
      float ag[2][16];
#pragma unroll
      for (int c = 0; c < 2; ++c)
#pragma unroll
        for (int r = 0; r < 16; ++r) ag[c][r] = 0.f;
#pragma unroll 4
      for (int i = 0; i < 128; i += 4) {
        float gv[2][4];
#pragma unroll
        for (int c = 0; c < 2; ++c)
#pragma unroll
          for (int u = 0; u < 4; ++u) gv[c][u] = g2[(i + u) * 512 + tid + c * 256];
#pragma unroll
        for (int r = 0; r < 16; ++r) {
          const float4 t4 = *(const float4*)(sg + r * 128 + i);
#pragma unroll
          for (int c = 0; c < 2; ++c) ag[c][r] += t4.x * gv[c][0] + t4.y * gv[c][1] + t4.z * gv[c][2] + t4.w * gv[c][3];
        }
      }
#pragma unroll
      for (int c = 0; c < 2; ++c) {
        const int ch = tid + c * 256;
        const float rkv = rk[ch], lgv = lg[ch], lbv = lb[ch];
        float yv[16], rr[16], kk[16], vv[16];
#pragma unroll
        for (int r = 0; r < 16; ++r) {
          const u16* row = P2 + (size_t)(tok0 + r) * PS2;
          yv[r] = bf2f(YC[(size_t)(tok0 + r) * PS1 + ch]);
          rr[r] = bf2f(row[ch]); kk[r] = bf2f(row[512 + ch]); vv[r] = bf2f(row[1024 + ch]);
        }
#pragma unroll
        for (int r = 0; r < 16; ++r) {
          const float mean = wave_sum(yv[r]) * (1.f / 64.f);
          const float dv = yv[r] - mean;
          const float var = wave_sum(dv * dv) * (1.f / 64.f);
          const float yn = dv * rsqrtf(var + 64e-5f) * lgv + lbv;
          const float bon = wave_sum(rr[r] * kk[r] * rkv) * vv[r];
          YC[(size_t)(tok0 + r) * PS1 + ch] = f2bf((yn + bon) * ag[c][r]);
        }
      }
    }
    __syncthreads();
  }
}

#define NEGV (-1e30f)
struct AttnState { float m[2]; float ls[2]; f32x4 ot[4][2]; };

#define MINIT (-1e20f)
template <int MODE, bool FULL>
__device__ __forceinline__ void attn_scores(f32x4 (&st)[4][2], const u16* kbase, int kstride, int key0, const bf16x8 (&qf)[2][2],
                                            const float (&slope)[2], int t, bool selbit, int c16, int q4) {
  const float fb = (float)(key0 + q4 * 4 - t);
#pragma unroll
  for (int mk = 0; mk < 4; ++mk) {
    const u16* kp = kbase + (size_t)(mk * 16 + c16) * kstride + q4 * 8;
    const bf16x8 k0 = *(const bf16x8*)kp, k1 = *(const bf16x8*)(kp + 32);
#pragma unroll
    for (int nq = 0; nq < 2; ++nq) {
      f32x4 a = {0.f, 0.f, 0.f, 0.f};
      a = mfma16(k0, qf[nq][0], a);
      a = mfma16(k1, qf[nq][1], a);
      if (FULL) {
        const float c0 = slope[nq] * fb;
#pragma unroll
        for (int j = 0; j < 4; ++j) {
          const float v = a[j] + (c0 + slope[nq] * (float)(mk * 16 + j));
          a[j] = (MODE == 1) ? (selbit ? v : NEGV) : v;
        }
      } else {
#pragma unroll
        for (int j = 0; j < 4; ++j) {
          const int key = key0 + mk * 16 + q4 * 4 + j;
          int dist; bool valid;
          if (MODE == 0) { dist = t - (16 * key + 31); valid = dist >= 0; }
          else if (MODE == 1) { dist = t - key; valid = (dist >= 0) && selbit; }
          else { dist = t - key; valid = (dist >= 0) && (dist < 512); }
          a[j] = valid ? (a[j] - slope[nq] * (float)dist) : NEGV;
        }
      }
      st[mk][nq] = a;
    }
  }
}

template <int MODE, bool FULL>
__device__ __forceinline__ void attn_tile(AttnState& S, const u16* kbase, int kstride, const u16* vtbase, int vstride, int key0,
                                          const bf16x8 (&qf)[2][2], const float (&slope)[2], int t, bool selbit, int c16, int q4) {
  f32x4 st[4][2];
  attn_scores<MODE, FULL>(st, kbase, kstride, key0, qf, slope, t, selbit, c16, q4);
  __builtin_amdgcn_sched_barrier(0);
#pragma unroll
  for (int nq = 0; nq < 2; ++nq) {
    float mx = fmaxf(fmaxf(st[0][nq][0], st[0][nq][1]), fmaxf(st[0][nq][2], st[0][nq][3]));
#pragma unroll
    for (int mk = 1; mk < 4; ++mk) mx = fmaxf(mx, fmaxf(fmaxf(st[mk][nq][0], st[mk][nq][1]), fmaxf(st[mk][nq][2], st[mk][nq][3])));
    mx = fmaxf(mx, __shfl_xor(mx, 16)); mx = fmaxf(mx, __shfl_xor(mx, 32));
    const float mnew = fmaxf(S.m[nq], mx);
    const float alpha = __builtin_amdgcn_exp2f(S.m[nq] - mnew);
    S.m[nq] = mnew;
    float ls = S.ls[nq] * alpha;
#pragma unroll
    for (int md = 0; md < 4; ++md) { S.ot[md][nq][0] *= alpha; S.ot[md][nq][1] *= alpha; S.ot[md][nq][2] *= alpha; S.ot[md][nq][3] *= alpha; }
#pragma unroll
    for (int mk = 0; mk < 4; ++mk)
#pragma unroll
      for (int j = 0; j < 4; ++j) {
        const float pv = __builtin_amdgcn_exp2f(st[mk][nq][j] - mnew);
        st[mk][nq][j] = pv; ls += pv;
      }
    S.ls[nq] = ls;
  }
#pragma unroll
  for (int s2 = 0; s2 < 2; ++s2) {
    __builtin_amdgcn_sched_barrier(0);
    bf16x8 pb[2];
#pragma unroll
    for (int nq = 0; nq < 2; ++nq) {
      uint4 u;
      u.x = pack2(st[2 * s2][nq][0], st[2 * s2][nq][1]); u.y = pack2(st[2 * s2][nq][2], st[2 * s2][nq][3]);
      u.z = pack2(st[2 * s2 + 1][nq][0], st[2 * s2 + 1][nq][1]); u.w = pack2(st[2 * s2 + 1][nq][2], st[2 * s2 + 1][nq][3]);
      pb[nq] = *(bf16x8*)&u;
    }
#pragma unroll
    for (int md = 0; md < 4; ++md) {
      const bf16x8 vf = *(const bf16x8*)(vtbase + (size_t)(md * 16 + c16) * vstride + s2 * 32 + q4 * 8);
#pragma unroll
      for (int nq = 0; nq < 2; ++nq) S.ot[md][nq] = mfma16(vf, pb[nq], S.ot[md][nq]);
    }
  }
}

__device__ __forceinline__ void attn_reset(AttnState& S) {
#pragma unroll
  for (int nq = 0; nq < 2; ++nq) { S.m[nq] = MINIT; S.ls[nq] = 0.f;
#pragma unroll
    for (int md = 0; md < 4; ++md) S.ot[md][nq] = f32x4{0.f, 0.f, 0.f, 0.f}; }
}
__device__ __forceinline__ void attn_fold(AttnState& S, float* oacc, const u16* gp, int br, float (&invl)[2], int lane) {
#pragma unroll
  for (int nq = 0; nq < 2; ++nq) {
    float l = S.ls[nq];
    l += __shfl_xor(l, 16); l += __shfl_xor(l, 32);
    const float inv = (l > 0.f) ? 1.f / l : 0.f;
    invl[nq] = inv;
    const float f = bf2f(gp[nq * 6 + br]) * inv;
#pragma unroll
    for (int md = 0; md < 4; ++md)
#pragma unroll
      for (int j = 0; j < 4; ++j) {
        float* a = oacc + ((md * 2 + nq) * 4 + j) * 64 + lane;
        const float v = f * S.ot[md][nq][j];
        if (br == 0) *a = v; else *a += v;
      }
  }
}

__device__ __forceinline__ void phase_nsa(const Params& p, char* smem, unsigned* queue) {
  u16* P1 = (u16*)(p.ws + OFF_P1);
  const u16* KC = (const u16*)(p.ws + OFF_KC); const u16* VC = (const u16*)(p.ws + OFF_VC); const u16* VT = (const u16*)(p.ws + OFF_VT);
  const int tid = tidx(), lane = tid & 63, wid = tid >> 6;
  const int c16 = lane & 15, q4 = lane >> 4, tq = lane & 7;
  float* ps = (float*)smem + wid * 2048;
  float* oacc = (float*)(smem + 32768) + wid * 2048;
  int* qslot = (int*)(smem + 65536);
#pragma unroll 1
  for (;;) {
    if (tid == 0) *qslot = (int)atomicAdd(queue, 1u);
    __syncthreads();
    const int it = *qslot;
    if (it >= 2048) break;
    const int bg = it & 15;
    const int tqd = 127 - (it >> 4);
    const int b = bg >> 1, g = bg & 1;
    const int t0 = (tqd * 4 + wid) * 8;
    const int tok0 = b * 4096 + t0;
    const int t = t0 + tq;
    const int cur = t0 >> 6;
#pragma unroll
    for (int i = 0; i < 8; ++i) *(float4*)(ps + i * 256 + lane * 4) = float4{0.f, 0.f, 0.f, 0.f};
    bf16x8 qf[2][2]; float slope[2];
    const u16* gp = P1 + (size_t)(tok0 + tq) * PS1 + 1024 + (g * 4 + (c16 >> 3)) * 3;
#pragma unroll
    for (int nq = 0; nq < 2; ++nq) {
      const int hh = nq * 2 + (c16 >> 3);
      const u16* rp = P1 + (size_t)(tok0 + tq) * PS1;
      qf[nq][0] = *(const bf16x8*)(rp + (g * 4 + hh) * 64 + q4 * 8);
      qf[nq][1] = *(const bf16x8*)(rp + (g * 4 + hh) * 64 + 32 + q4 * 8);
      slope[nq] = exp2f(-(float)(g * 4 + hh + 1)) * 1.4426950408889634f;
    }
    AttnState S;
    float invl[2];
    const u16* kcb = KC + (size_t)(b * 2 + g) * 256 * 64;
    const u16* vcb = VC + (size_t)(b * 2 + g) * 64 * 256;
    int ntc = 0;
    if (t0 + 7 >= 31) ntc = (((t0 + 7 - 31) >> 4) >> 6) + 1;
    attn_reset(S);
#pragma unroll 1
    for (int kt = 0; kt < ntc; ++kt) attn_tile<0, false>(S, kcb + (size_t)kt * 64 * 64, 64, vcb + kt * 64, 256, kt * 64, qf, slope, t, true, c16, q4);
    attn_fold(S, oacc, gp, 0, invl, lane);
#pragma unroll 1
    for (int kt = 0; kt < ntc; ++kt) {
      f32x4 st[4][2];
      attn_scores<0, false>(st, kcb + (size_t)kt * 64 * 64, 64, kt * 64, qf, slope, t, true, c16, q4);
#pragma unroll
      for (int mk = 0; mk < 4; ++mk) {
        f32x4 hs;
#pragma unroll
        for (int j = 0; j < 4; ++j) {
          const float a0 = st[mk][0][j], a1 = st[mk][1][j];
          const float p0 = __builtin_amdgcn_exp2f(a0 - S.m[0]) * invl[0];
          const float p1 = __builtin_amdgcn_exp2f(a1 - S.m[1]) * invl[1];
          float v = p0 + p1;
          v += __shfl_xor(v, 8);
          hs[j] = v;
        }
        if (c16 < 8) *(f32x4*)(ps + c16 * 256 + kt * 64 + mk * 16 + q4 * 4) = hs;
      }
    }
    __syncthreads();
    unsigned long long selm = 0ull, un = 0ull;
#pragma unroll 1
    for (int tqq = 0; tqq < 8; ++tqq) {
      const float* pr = ps + tqq * 256;
      float imp = pr[4 * lane];
      if (lane > 0) imp += pr[4 * lane - 4] + 2.f * (pr[4 * lane - 3] + pr[4 * lane - 2] + pr[4 * lane - 1]);
      const bool forced = (lane == 0) || (lane == cur) || (lane == cur - 1);
      const bool live = lane <= cur;
      const float val = forced ? 1e4f : (live ? imp : NEGV);
      int rank = 0;
#pragma unroll 8
      for (int i = 0; i < 64; ++i) {
        const float vi = __uint_as_float(__builtin_amdgcn_readlane(__float_as_uint(val), i));
        rank += ((vi > val) || (vi == val && i < lane)) ? 1 : 0;
      }
      const unsigned long long bal = __ballot((rank < 16) && live);
      if (tq == tqq) selm = bal;
      un |= bal;
    }
    __syncthreads();
    attn_reset(S);
    {
      const u16* vtb = VT + (size_t)((0 * 8 + b) * 2 + g) * 64 * 4096;
#pragma unroll 1
      for (int j = 0; j <= cur; ++j) {
        if (!((un >> j) & 1ull)) continue;
        const bool sb = (selm >> j) & 1ull;
        const u16* kb_ = P1 + (size_t)(b * 4096 + j * 64) * PS1 + 768 + g * 64;
        if (j < cur) attn_tile<1, true>(S, kb_, PS1, vtb + j * 64, 4096, j * 64, qf, slope, t, sb, c16, q4);
        else attn_tile<1, false>(S, kb_, PS1, vtb + j * 64, 4096, j * 64, qf, slope, t, sb, c16, q4);
      }
    }
    attn_fold(S, oacc, gp, 1, invl, lane);
    attn_reset(S);
    {
      const u16* vtb = VT + (size_t)((1 * 8 + b) * 2 + g) * 64 * 4096;
      int j0 = t0 - 511; if (j0 < 0) j0 = 0; j0 >>= 6;
#pragma unroll 1
      for (int j = j0; j <= cur; ++j) {
        const u16* kb_ = P1 + (size_t)(b * 4096 + j * 64) * PS1 + 896 + g * 64;
        const bool full = (j < cur) && (j * 64 >= t0 + 7 - 511);
        if (full) attn_tile<2, true>(S, kb_, PS1, vtb + j * 64, 4096, j * 64, qf, slope, t, true, c16, q4);
        else attn_tile<2, false>(S, kb_, PS1, vtb + j * 64, 4096, j * 64, qf, slope, t, true, c16, q4);
      }
    }
    attn_fold(S, oacc, gp, 2, invl, lane);
#pragma unroll
    for (int nq = 0; nq < 2; ++nq) {
      const int hh = nq * 2 + (c16 >> 3);
      u16* rp = P1 + (size_t)(tok0 + tq) * PS1 + (g * 4 + hh) * 64;
#pragma unroll
      for (int md = 0; md < 4; ++md) {
        const float* a = oacc + ((md * 2 + nq) * 4) * 64 + lane;
        uint2 o; o.x = pack2(a[0], a[64]); o.y = pack2(a[128], a[192]);
        *(uint2*)(rp + md * 16 + q4 * 4) = o;
      }
    }
  }
}

__device__ __forceinline__ const float* modp(const Params& p, int l, int sub, int kind) {
  return (const float*)(p.ws + OFF_MOD) + (size_t)l * 8 * 9216 + sub * 3072 + kind * 1024;
}

__device__ __forceinline__ void run_phase(const Params& p, int ph, char* smem) {
  char* ws = p.ws;
  if (ph == 0) {
    if (blockIdx.x == 0) { unsigned* c = (unsigned*)(ws + OFF_CNT); for (int e = tidx(); e < 1024; e += 256) c[e] = 0u; }
    phase_mod(p, smem);
  }
  int l = 0, s = -1;
  if (ph >= 2) { l = (ph - 2) / 14; s = (ph - 2) % 14; }
  const float* preg = p.in[4] + (size_t)l * 3 * 1024; const float* postg = p.in[5] + (size_t)l * 3 * 1024;
  const bool is_norm = (ph == 1) || s == 2 || s == 10 || s == 13;
  if (is_norm) {
    const float* xin = p.out; float* xout = p.out; const u16* y = nullptr; const float* pg = nullptr; const float* gate = nullptr; float wgt = 0.f;
    const float* prg = nullptr; const float* sh = nullptr; const float* sc = nullptr; u16* h = (u16*)(ws + OFF_H);
    if (ph == 1) { xin = p.in[0]; prg = p.in[4]; sh = modp(p, 0, 0, 0); sc = modp(p, 0, 0, 1); }
    else if (s == 2) { y = (const u16*)(ws + OFF_YF); pg = postg; gate = modp(p, l, 0, 2); wgt = 0.5f; prg = preg + 1024; sh = modp(p, l, 1, 0); sc = modp(p, l, 1, 1); }
    else if (s == 10) { y = (const u16*)(ws + OFF_YM); pg = postg + 1024; gate = modp(p, l, 1, 2); wgt = 1.0f; prg = preg + 2048; sh = modp(p, l, 2, 0); sc = modp(p, l, 2, 1); }
    else { y = (const u16*)(ws + OFF_YF); pg = postg + 2048; gate = modp(p, l, 2, 2); wgt = 0.5f;
      if (l == 0) { prg = p.in[4] + 3 * 1024; sh = modp(p, 1, 0, 0); sc = modp(p, 1, 0, 1); } else { h = nullptr; } }
    phase_norm(xin, xout, y, pg, gate, wgt, prg, sh, sc, h);
  }
  {
    int cl = -1, cf = 0;
    if (ph == 0) { cl = 0; cf = 0; } else if (s == 2) { cl = l; cf = 1; } else if (s == 13 && l == 0) { cl = 1; cf = 0; }
    if (cl >= 0) conv_ffn(p, cl, cf, smem);
    if (cl >= 0 && cf == 0) conv_mix(p, cl, smem);
  }
  if (s == 0 || s == 11) phase_ffn_in(p, smem);
  if (s == 1 || s == 12 || s == 9) {
    const bool o = (s == 9);
    phase_gemm_plain((const u16*)(ws + (o ? OFF_MERGED : OFF_ACT)), o ? 1024 : DFF, (const u16*)(ws + (o ? OFF_WO : OFF_WOUT)), o ? 1024 : DFF,
                     (u16*)(ws + (o ? OFF_YM : OFF_YF)), smem);
  }
  if (s == 3) phase_inproj(p, smem);
  if (s == 4) { phase_prep1(p, l); phase_sgu(p, l, smem); phase_cmp1(p, l, smem); }
  if (s == 5) { phase_prep2m(p, l, smem); phase_cmp2(p, l); }
  if (s == 6) {
    const int nb = gridDim.x;
    const int sid = (nb >= 512) ? (((int)blockIdx.x >= 256) ? -1 : (int)blockIdx.x) : (int)blockIdx.x;
    const int sstride = (nb >= 512) ? (nb >> 1) : nb;
    if (sid >= 0) {
      __builtin_amdgcn_s_setprio(3);
      for (int it = sid; it < 256; it += sstride) scan_item(p, it, smem);
      __builtin_amdgcn_s_setprio(0);
    }
    phase_nsa(p, smem, (unsigned*)(ws + OFF_CNT) + 64 + l * 64);
  }
  if (s == 7) phase_postm(p, l, smem);
  if (s == 8) phase_merge(p, smem);
}

constexpr int NPHASE = 30;

#if COOP
typedef const float* __attribute__((address_space(4))) const* kargp_t;
template <int PH>
__device__ __forceinline__ void run_seq(char* smem, cg::grid_group& grid) {
  if constexpr (PH < NPHASE) {
    {
      kargp_t ka = (kargp_t)__builtin_amdgcn_kernarg_segment_ptr();
      asm volatile("" : "+s"(ka));
      Params q;
#pragma unroll
      for (int i = 0; i < 35; ++i) q.in[i] = ka[i];
      q.out = (float*)ka[35];
      q.ws = (char*)ka[36];
      run_phase(q, PH, smem);
    }
    if constexpr (PH == 0) {
      kargp_t kb = (kargp_t)__builtin_amdgcn_kernarg_segment_ptr();
      asm volatile("" : "+s"(kb));
      unsigned* bar = (unsigned*)((char*)kb[36] + OFF_XB);
      if (kb[36] == nullptr) grid.sync();
      if (tidx() == 0) {
        const unsigned x = xb_xcc_id();
        unsigned nloc, nx, sum;
        for (;;) {
          nloc = 1u; nx = 0u; sum = 0u;
          for (unsigned j = 0; j < 16; ++j) { const unsigned c = xb_ld(&bar[XB_XCNT(j)]); sum += c; nx += (c > 0u) ? 1u : 0u; if (j == x) nloc = c; }
          if (sum == gridDim.x) break;
          __builtin_amdgcn_s_sleep(2);
        }
        __hip_atomic_store(&bar[XB_SLOT(blockIdx.x)], nloc, __ATOMIC_RELAXED, __HIP_MEMORY_SCOPE_AGENT);
        __hip_atomic_store(&bar[XB_SLOT(blockIdx.x) + 1], nx, __ATOMIC_RELAXED, __HIP_MEMORY_SCOPE_AGENT);
      }
      gbar_xcd(bar);
    } else if constexpr (PH + 1 < NPHASE) {
      kargp_t kb = (kargp_t)__builtin_amdgcn_kernarg_segment_ptr();
      asm volatile("" : "+s"(kb));
      gbar_xcd((unsigned*)((char*)kb[36] + OFF_XB));
    }
    run_seq<PH + 1>(smem, grid);
  }
}

__global__ void __launch_bounds__(256, 2) mega(Params p) {
  __shared__ __attribute__((aligned(16))) char smem[SMEM_BYTES];
  cg::grid_group grid = cg::this_grid();
  {
    kargp_t kb = (kargp_t)__builtin_amdgcn_kernarg_segment_ptr();
    asm volatile("" : "+s"(kb));
    if (tidx() == 0) xb_add(&((unsigned*)((char*)kb[36] + OFF_XB))[XB_XCNT(xb_xcc_id())], 1u);
  }
  run_seq<0>(smem, grid);
}
#endif

template <int PH>
__global__ void __launch_bounds__(256, 2) kph(Params p) {
  __shared__ __attribute__((aligned(16))) char smem[SMEM_BYTES];
  run_phase(p, PH, smem);
}

template <int PH>
static void launch_seq(const Params& p, int grid, hipStream_t stream) {
  if constexpr (PH < NPHASE) {
    kph<PH><<<grid, 256, 0, stream>>>(p);
    launch_seq<PH + 1>(p, grid, stream);
  }
}

extern "C" void kernel_launch(void* const* d_in, const int* in_sizes, int n_in, void* d_out, int out_size, void* d_ws, size_t ws_size,
                              hipStream_t stream) {
  static int grid_blocks = 0;
  if (!grid_blocks) {
    int dev = 0, cus = 0, per_cu = 0;
    hipGetDevice(&dev);
    hipDeviceGetAttribute(&cus, hipDeviceAttributeMultiprocessorCount, dev);
    #if COOP
    hipOccupancyMaxActiveBlocksPerMultiprocessor(&per_cu, mega, 256, 0);
#else
    per_cu = 2;
#endif
    if (per_cu > 2) per_cu = 2;
    if (per_cu < 1) per_cu = 1;
    grid_blocks = cus * per_cu;
  }
  Params p{};
  for (int i = 0; i < 35; ++i) p.in[i] = (const float*)d_in[i];
  p.out = (float*)d_out;
  p.ws = (char*)d_ws;
#if COOP
  hipMemsetAsync((char*)d_ws + OFF_XB, 0, XB_BYTES, stream);
  void* args[] = {&p};
  hipError_t e = hipLaunchCooperativeKernel((void*)mega, dim3(grid_blocks), dim3(256), args, 0, stream);
  if (e != hipSuccess) fprintf(stderr, "cooperative launch failed: %s (grid %d)\n", hipGetErrorString(e), grid_blocks);
#else
  launch_seq<0>(p, grid_blocks, stream);
#endif
}
```

```cpp
#include <hip/hip_runtime.h>
#include <hip/hip_cooperative_groups.h>
#include <cstdio>
#include <cstdint>
namespace cg = cooperative_groups;

#ifndef COOP
#define COOP 1
#endif

typedef unsigned short u16;
using bf16x8 = __attribute__((ext_vector_type(8))) short;
using f32x4 = __attribute__((ext_vector_type(4))) float;

constexpr int T = 32768, D = 1024, SEQ = 4096, DFF = 2816;
constexpr int PS1 = 2072, PS2 = 3328;
constexpr int MIXC = 7192, MIXN = 4120;
constexpr size_t OFF_P1 = 0;
constexpr size_t OFF_P2 = OFF_P1 + (size_t)T * PS1 * 2;
constexpr size_t OFF_H = OFF_P2 + (size_t)T * PS2 * 2;
constexpr size_t OFF_WMIX = OFF_H + (size_t)T * 1024 * 2;
constexpr size_t OFF_WG = OFF_WMIX + (size_t)4224 * 1024 * 2;
constexpr size_t OFF_WB = OFF_WG + (size_t)3072 * 1024 * 2;
constexpr size_t OFF_WO = OFF_WB + (size_t)3 * 1024 * 512 * 2;
constexpr size_t OFF_W1 = OFF_WO + (size_t)1024 * 1024 * 2;
constexpr size_t OFF_WIN = OFF_W1 + (size_t)2 * 256 * 2048 * 2;
constexpr size_t OFF_WOUT = OFF_WIN + (size_t)5632 * 1024 * 2;
constexpr size_t OFF_VFIRST = OFF_WOUT + (size_t)1024 * 2816 * 2;
constexpr size_t OFF_VT = OFF_VFIRST + (size_t)T * 512 * 2;
constexpr size_t OFF_MOD = OFF_VT + (size_t)2 * 8 * 2 * 64 * 4096 * 2;
constexpr size_t OFF_PB = OFF_MOD + (size_t)2 * 8 * 9216 * 4;
constexpr size_t OFF_HID = OFF_PB + (size_t)1024 * 1792 * 2;
constexpr size_t OFF_KC = OFF_HID + (size_t)2 * 4096 * 256 * 2;
constexpr size_t OFF_VC = OFF_KC + (size_t)8 * 2 * 256 * 64 * 2;
constexpr size_t OFF_LV = OFF_VC + (size_t)8 * 2 * 64 * 256 * 2;
constexpr size_t OFF_CNT = OFF_LV + (size_t)T * 32 * 4;
constexpr size_t OFF_WL = OFF_CNT + 4096;
constexpr int WL_W2 = 0, WL_A2 = 512 * 64, WL_G2 = 2 * 512 * 64, WL_V1 = WL_G2 + 512 * 128, WL_V2 = WL_V1 + 64 * 512, WL_END = WL_V2 + 512 * 64;
constexpr size_t OFF_XB = (OFF_WL + (size_t)WL_END * 2 + 255) & ~(size_t)255;
constexpr size_t XB_BYTES = 32768;
constexpr size_t WS_END = OFF_XB + XB_BYTES;
constexpr size_t OFF_ACT = OFF_P1;
constexpr size_t OFF_YF = OFF_ACT + (size_t)T * DFF * 2;
constexpr size_t OFF_H2 = OFF_P2;
constexpr size_t OFF_MERGED = OFF_P2;
constexpr size_t OFF_YM = OFF_MERGED + (size_t)T * 1024 * 2;
constexpr size_t OFF_YC = OFF_H;

constexpr int SMEM_BYTES = 73728;

struct Params { const float* in[35]; float* out; char* ws; };

__device__ __forceinline__ int tidx() { int t = __builtin_amdgcn_workitem_id_x(); asm volatile("" : "+v"(t)); return t; }
__device__ __forceinline__ void gbar(unsigned* cnt, unsigned target) {
  asm volatile("s_waitcnt vmcnt(0) lgkmcnt(0)" ::: "memory");
  __syncthreads();
  if (tidx() == 0) {
    __builtin_amdgcn_fence(__ATOMIC_RELEASE, "agent");
    asm volatile("s_waitcnt vmcnt(0)" ::: "memory");
    __hip_atomic_fetch_add(cnt, 1u, __ATOMIC_RELAXED, __HIP_MEMORY_SCOPE_AGENT);
    while (__hip_atomic_load(cnt, __ATOMIC_RELAXED, __HIP_MEMORY_SCOPE_AGENT) < target) __builtin_amdgcn_s_sleep(1);
    __builtin_amdgcn_fence(__ATOMIC_ACQUIRE, "agent");
    asm volatile("s_waitcnt vmcnt(0)" ::: "memory");
  }
  __syncthreads();
}
#define XB_XCNT(j) (256 + 64 * (j))
#define XB_XSUB(j) (1280 + 64 * (j))
#define XB_XGEN(j) (2304 + 64 * (j))
#define XB_TOP 3328
#define XB_TOPGEN 3392
#define XB_SLOT(b) (4096 + 2 * (b))
__device__ __forceinline__ unsigned xb_ld(unsigned* p) { return __hip_atomic_load(p, __ATOMIC_RELAXED, __HIP_MEMORY_SCOPE_AGENT); }
__device__ __forceinline__ unsigned xb_add(unsigned* p, unsigned v) { return __hip_atomic_fetch_add(p, v, __ATOMIC_RELAXED, __HIP_MEMORY_SCOPE_AGENT); }
__device__ __forceinline__ unsigned xb_xcc_id() { return (unsigned)__builtin_amdgcn_s_getreg((3 << 11) | 20) & 0xFu; }
__device__ __forceinline__ void gbar_xcd(unsigned* bar) {
  asm volatile("s_waitcnt vmcnt(0) lgkmcnt(0)" ::: "memory");
  __syncthreads();
  if (tidx() == 0) {
    const unsigned x = xb_xcc_id();
    const unsigned nloc = xb_ld(&bar[XB_SLOT(blockIdx.x)]), nx = xb_ld(&bar[XB_SLOT(blockIdx.x) + 1]);
    const unsigned old = xb_add(&bar[XB_XSUB(x)], 1u);
    const unsigned gen = old / nloc;
    if (old + 1u == (gen + 1u) * nloc) {
      __builtin_amdgcn_fence(__ATOMIC_RELEASE, "agent");
      asm volatile("s_waitcnt vmcnt(0)" ::: "memory");
      const unsigned og = xb_add(&bar[XB_TOP], 1u);
      const unsigned tg = og / nx;
      if (og + 1u == (tg + 1u) * nx) xb_add(&bar[XB_TOPGEN], 1u);
      else while (xb_ld(&bar[XB_TOPGEN]) == tg) __builtin_amdgcn_s_sleep(1);
      __builtin_amdgcn_fence(__ATOMIC_ACQUIRE, "agent");
      xb_add(&bar[XB_XGEN(x)], 1u);
      asm volatile("s_waitcnt vmcnt(0)" ::: "memory");
    } else {
      while (xb_ld(&bar[XB_XGEN(x)]) == gen) __builtin_amdgcn_s_sleep(1);
      __builtin_amdgcn_fence(__ATOMIC_ACQUIRE, "agent");
      asm volatile("s_waitcnt vmcnt(0)" ::: "memory");
    }
  }
  __syncthreads();
}
__device__ __forceinline__ float dpp_sum16(float v) {
  v += __int_as_float(__builtin_amdgcn_update_dpp(0, __float_as_int(v), 0xB1, 0xF, 0xF, true));
  v += __int_as_float(__builtin_amdgcn_update_dpp(0, __float_as_int(v), 0x4E, 0xF, 0xF, true));
  v += __int_as_float(__builtin_amdgcn_update_dpp(0, __float_as_int(v), 0x141, 0xF, 0xF, true));
  v += __int_as_float(__builtin_amdgcn_update_dpp(0, __float_as_int(v), 0x140, 0xF, 0xF, true));
  return v;
}
__device__ __forceinline__ float bf2f(u16 u) { return __uint_as_float(((unsigned)u) << 16); }
__device__ __forceinline__ u16 f2bf(float f) { __bf16 r = (__bf16)f; return *(u16*)&r; }
typedef __attribute__((ext_vector_type(2))) float f2_t;
typedef __attribute__((ext_vector_type(2))) __bf16 b2_t;
__device__ __forceinline__ unsigned pack2(float a, float b) { f2_t v = {a, b}; b2_t r = __builtin_convertvector(v, b2_t); return *(unsigned*)&r; }
__device__ __forceinline__ float sigmoidf_(float x) { return 1.f / (1.f + __expf(-x)); }
__device__ __forceinline__ float siluf_(float x) { return x / (1.f + __expf(-x)); }
__device__ __forceinline__ float geluf_(float x) { float u = 0.7978845608028654f * (x + 0.044715f * x * x * x); return x / (1.f + __expf(-2.f * u)); }
__device__ __forceinline__ float tanhf_(float x) { return 1.f - 2.f / (1.f + __expf(2.f * x)); }
__device__ __forceinline__ float wave_sum(float v) {
#pragma unroll
  for (int o = 32; o >= 1; o >>= 1) v += __shfl_xor(v, o);
  return v;
}
__device__ __forceinline__ f32x4 mfma16(bf16x8 a, bf16x8 b, f32x4 c) { return __builtin_amdgcn_mfma_f32_16x16x32_bf16(a, b, c, 0, 0, 0); }

__device__ __forceinline__ void conv_w(const float* src, int ld, int K, u16* dst, int NR, int nvalid, int coff, int kind, char* smem, int kvalid = 1 << 30) {
  float* tl = (float*)smem;
  const int tid = tidx();
  const int ktn = K >> 6, ntile = (NR >> 6) * ktn;
  for (int tix = blockIdx.x; tix < ntile; tix += gridDim.x) {
    const int R0 = (tix / ktn) << 6, k0 = (tix % ktn) << 6;
    const int c = tid & 63, kq = tid >> 6;
    const int R = R0 + c;
    int sc; bool ok;
    if (kind == 0) { sc = coff + R; ok = R < nvalid; }
    else { int ntl = R >> 7, w = (R >> 6) & 1, n = (R >> 4) & 3, r = R & 15; sc = ((n >= 2) ? DFF : 0) + ntl * 64 + w * 32 + (n & 1) * 16 + r; ok = true; }
#pragma unroll 4
    for (int i = 0; i < 16; ++i) {
      int k = k0 + kq * 16 + i;
      tl[c * 65 + kq * 16 + i] = (ok && k < kvalid) ? src[(size_t)k * ld + sc] : 0.f;
    }
    __syncthreads();
    {
      const int r = tid >> 2, ks = tid & 3;
      const float* s = tl + r * 65 + ks * 16;
      uint4 o0, o1;
      o0.x = pack2(s[0], s[1]); o0.y = pack2(s[2], s[3]); o0.z = pack2(s[4], s[5]); o0.w = pack2(s[6], s[7]);
      o1.x = pack2(s[8], s[9]); o1.y = pack2(s[10], s[11]); o1.z = pack2(s[12], s[13]); o1.w = pack2(s[14], s[15]);
      uint4* dp = (uint4*)(dst + (size_t)(R0 + r) * K + k0 + ks * 16);
      dp[0] = o0; dp[1] = o1;
    }
    __syncthreads();
  }
}

__device__ __forceinline__ void conv_ffn(const Params& p, int l, int f, char* smem) {
  conv_w(p.in[6] + (size_t)(l * 2 + f) * D * (2 * DFF), 2 * DFF, D, (u16*)(p.ws + OFF_WIN), 5632, 5632, 0, 1, smem);
  conv_w(p.in[7] + (size_t)(l * 2 + f) * DFF * D, D, DFF, (u16*)(p.ws + OFF_WOUT), 1024, 1024, 0, 0, smem);
}
__device__ __forceinline__ void conv_mix(const Params& p, int l, char* smem) {
  const float* mw = p.in[8] + (size_t)l * D * MIXC;
  conv_w(mw, MIXC, D, (u16*)(p.ws + OFF_WMIX), 4224, MIXN, 0, 0, smem);
  conv_w(mw, MIXC, D, (u16*)(p.ws + OFF_WG), 3072, 3072, MIXN, 0, smem);
  for (int i = 0; i < 3; ++i)
    conv_w(p.in[9] + (size_t)(l * 3 + i) * 512 * D, D, 512, (u16*)(p.ws + OFF_WB) + (size_t)i * 1024 * 512, 1024, 1024, 0, 0, smem);
  conv_w(p.in[10] + (size_t)l * D * D, D, D, (u16*)(p.ws + OFF_WO), 1024, 1024, 0, 0, smem);
  conv_w(p.in[11] + (size_t)l * 2048 * 256, 256, 2048, (u16*)(p.ws + OFF_W1), 256, 256, 0, 0, smem);
  conv_w(p.in[14] + (size_t)l * 2048 * 256, 256, 2048, (u16*)(p.ws + OFF_W1) + (size_t)256 * 2048, 256, 256, 0, 0, smem);
  u16* WL = (u16*)(p.ws + OFF_WL);
  conv_w(p.in[23] + (size_t)l * 64 * 512, 512, 64, WL + WL_W2, 512, 512, 0, 0, smem);
  conv_w(p.in[25] + (size_t)l * 64 * 512, 512, 64, WL + WL_A2, 512, 512, 0, 0, smem);
  conv_w(p.in[26] + (size_t)l * 128 * 512, 512, 128, WL + WL_G2, 512, 512, 0, 0, smem);
  if (l > 0) {
    conv_w(p.in[33], 32, 512, WL + WL_V1, 64, 32, 0, 0, smem);
    conv_w(p.in[34], 512, 64, WL + WL_V2, 512, 512, 0, 0, smem, 32);
  }
}

__device__ __forceinline__ void phase_mod(const Params& p, char* smem) {
  float* cond = (float*)smem;
  float* red = cond + 8192;
  const int tid = tidx();
  float* MOD = (float*)(p.ws + OFF_MOD);
  for (int item = blockIdx.x; item < 288; item += gridDim.x) {
    for (int e = tid; e < 8192; e += 256) cond[e] = siluf_(p.in[1][e]);
    __syncthreads();
    const int l = item / 144, n0 = (item % 144) * 64, col = n0 + (tid & 63), kq = tid >> 6;
    float acc[8];
#pragma unroll
    for (int b = 0; b < 8; ++b) acc[b] = 0.f;
    const float* w = p.in[2] + (size_t)l * D * 9216 + col;
#pragma unroll 4
    for (int k = kq * 256; k < kq * 256 + 256; ++k) {
      float wv = w[(size_t)k * 9216];
#pragma unroll
      for (int b = 0; b < 8; ++b) acc[b] += cond[b * 1024 + k] * wv;
    }
#pragma unroll
    for (int b = 0; b < 8; ++b) red[(kq * 8 + b) * 64 + (tid & 63)] = acc[b];
    __syncthreads();
    for (int e = tid; e < 512; e += 256) {
      int b = e >> 6, c = e & 63;
      float s = red[(0 * 8 + b) * 64 + c] + red[(1 * 8 + b) * 64 + c] + red[(2 * 8 + b) * 64 + c] + red[(3 * 8 + b) * 64 + c];
      MOD[(size_t)(l * 8 + b) * 9216 + n0 + c] = s + p.in[3][(size_t)l * 9216 + n0 + c];
    }
    __syncthreads();
  }
}

__device__ __forceinline__ void phase_norm(const float* xin, float* xout, const u16* y, const float* postg, const float* gate, float wgt,
                           const float* preg, const float* shift, const float* scale, u16* h) {
  const int lane = tidx() & 63, wid = tidx() >> 6;
  for (int row = blockIdx.x * 4 + wid; row < T; row += gridDim.x * 4) {
    const int b = row >> 12;
    float4 xv[4];
#pragma unroll
    for (int i = 0; i < 4; ++i) xv[i] = *(const float4*)(xin + (size_t)row * D + i * 256 + lane * 4);
    if (y) {
      float yv[4][4]; float ss = 0.f;
#pragma unroll
      for (int i = 0; i < 4; ++i) {
        uint2 u = *(const uint2*)(y + (size_t)row * D + i * 256 + lane * 4);
        yv[i][0] = bf2f((u16)(u.x & 0xffff)); yv[i][1] = bf2f((u16)(u.x >> 16));
        yv[i][2] = bf2f((u16)(u.y & 0xffff)); yv[i][3] = bf2f((u16)(u.y >> 16));
        ss += yv[i][0] * yv[i][0] + yv[i][1] * yv[i][1] + yv[i][2] * yv[i][2] + yv[i][3] * yv[i][3];
      }
      ss = wave_sum(ss);
      const float rs = rsqrtf(ss * (1.f / 1024.f) + 1e-6f) * wgt;
#pragma unroll
      for (int i = 0; i < 4; ++i) {
        const int c = i * 256 + lane * 4;
        float4 g = *(const float4*)(gate + (size_t)b * 9216 + c);
        float4 pg = *(const float4*)(postg + c);
        xv[i].x += g.x * yv[i][0] * rs * pg.x; xv[i].y += g.y * yv[i][1] * rs * pg.y;
        xv[i].z += g.z * yv[i][2] * rs * pg.z; xv[i].w += g.w * yv[i][3] * rs * pg.w;
      }
    }
    if (xout) {
#pragma unroll
      for (int i = 0; i < 4; ++i) *(float4*)(xout + (size_t)row * D + i * 256 + lane * 4) = xv[i];
    }
    if (h) {
      float ss = 0.f;
#pragma unroll
      for (int i = 0; i < 4; ++i) ss += xv[i].x * xv[i].x + xv[i].y * xv[i].y + xv[i].z * xv[i].z + xv[i].w * xv[i].w;
      ss = wave_sum(ss);
      const float rs = rsqrtf(ss * (1.f / 1024.f) + 1e-6f);
#pragma unroll
      for (int i = 0; i < 4; ++i) {
        const int c = i * 256 + lane * 4;
        float4 pg = *(const float4*)(preg + c);
        float4 sh = *(const float4*)(shift + (size_t)b * 9216 + c);
        float4 sc = *(const float4*)(scale + (size_t)b * 9216 + c);
        uint2 o;
        o.x = pack2(xv[i].x * rs * pg.x * (1.f + sc.x) + sh.x, xv[i].y * rs * pg.y * (1.f + sc.y) + sh.y);
        o.y = pack2(xv[i].z * rs * pg.z * (1.f + sc.z) + sh.z, xv[i].w * rs * pg.w * (1.f + sc.w) + sh.w);
        *(uint2*)(h + (size_t)row * D + c) = o;
      }
    }
  }
}

template <int NS, class FA, class FB>
__device__ __forceinline__ void gemm_loop(f32x4 (&acc)[4][NS], const FA& fa, const FB& fb, int K, u16* sm) {
  constexpr int BN = 32 * NS;
  constexpr int NBV = BN / 32;
  const int tid = tidx(), lane = tid & 63, wid = tid >> 6, wr = wid >> 1, wc = wid & 1, fr = lane & 15, fq = lane >> 4;
  u16* As = sm; u16* Bs = sm + 2 * 128 * 64;
  uint4 ra0[4], rb0[NBV], ra1[4], rb1[NBV];
  const int nt = K >> 6;
  const int lrow = tid >> 3, lk = (tid & 7) * 8;
  const int lsw = lrow * 64 + (((tid & 7) ^ ((lrow >> 1) & 7)) << 3);
  const int c0 = (fq ^ ((fr >> 1) & 7)) << 3, c1 = c0 ^ 32;
#define G_LOAD(RA, RB, KT) { const int kb_ = (KT) << 6; \
    _Pragma("unroll") for (int i = 0; i < 4; ++i) RA[i] = fa(lrow + 32 * i, kb_ + lk); \
    _Pragma("unroll") for (int i = 0; i < NBV; ++i) RB[i] = fb(lrow + 32 * i, kb_ + lk); }
#define G_STORE(RA, RB, BUF) { u16* Aw_ = As + (BUF) * 128 * 64 + lsw; u16* Bw_ = Bs + (BUF) * BN * 64 + lsw; \
    _Pragma("unroll") for (int i = 0; i < 4; ++i) *(uint4*)(Aw_ + i * 32 * 64) = RA[i]; \
    _Pragma("unroll") for (int i = 0; i < NBV; ++i) *(uint4*)(Bw_ + i * 32 * 64) = RB[i]; }
#define G_COMPUTE(BUF) { const u16* Ab = As + (BUF) * 128 * 64 + (wr * 64 + fr) * 64; \
    const u16* Bb = Bs + (BUF) * BN * 64 + (wc * 16 * NS + fr) * 64; \
    _Pragma("unroll") for (int ks = 0; ks < 2; ++ks) { bf16x8 a[4], b[NS]; const int co = ks ? c1 : c0; \
      _Pragma("unroll") for (int m = 0; m < 4; ++m) a[m] = *(const bf16x8*)(Ab + m * 16 * 64 + co); \
      _Pragma("unroll") for (int n = 0; n < NS; ++n) b[n] = *(const bf16x8*)(Bb + n * 16 * 64 + co); \
      __builtin_amdgcn_s_setprio(1); \
      _Pragma("unroll") for (int m = 0; m < 4; ++m) _Pragma("unroll") for (int n = 0; n < NS; ++n) acc[m][n] = mfma16(a[m], b[n], acc[m][n]); \
      __builtin_amdgcn_s_setprio(0); } }
  G_LOAD(ra0, rb0, 0)
  if (nt > 1) G_LOAD(ra1, rb1, 1)
  G_STORE(ra0, rb0, 0)
  __syncthreads();
#pragma unroll 1
  for (int kt = 0; kt < nt; kt += 2) {
    if (kt + 2 < nt) G_LOAD(ra0, rb0, kt + 2)
    G_COMPUTE(0)
    if (kt + 1 < nt) G_STORE(ra1, rb1, 1)
    __syncthreads();
    if (kt + 1 >= nt) break;
    if (kt + 3 < nt) G_LOAD(ra1, rb1, kt + 3)
    G_COMPUTE(1)
    if (kt + 2 < nt) G_STORE(ra0, rb0, 0)
    __syncthreads();
  }
#undef G_LOAD
#undef G_STORE
#undef G_COMPUTE
}

template <int NS>
__device__ __forceinline__ void gemm_loop_dma(f32x4 (&acc)[4][NS], const u16* Ab, int lda, const u16* Bb, int ldb, int K, u16* sm) {
  constexpr int BN = 32 * NS;
  constexpr int NBV = BN / 32;
  const int tid = tidx(), lane = tid & 63, wid = tid >> 6, wr = wid >> 1, wc = wid & 1, fr = lane & 15, fq = lane >> 4;
  u16* As = sm; u16* Bs = sm + 2 * 128 * 64;
  const int nt = K >> 6;
  const int lrow = tid >> 3;
  const int gk = (((tid & 7) ^ ((lrow >> 1) & 7)) << 3);
  const int c0 = (fq ^ ((fr >> 1) & 7)) << 3, c1 = c0 ^ 32;
  const u16* ga = Ab + (size_t)lrow * lda + gk;
  const u16* gb = Bb + (size_t)lrow * ldb + gk;
#define D_ISSUE(KT, BUF) { const int kb_ = (KT) << 6; \
    _Pragma("unroll") for (int i = 0; i < 4; ++i) \
      __builtin_amdgcn_global_load_lds((const unsigned*)(ga + (size_t)(32 * i) * lda + kb_), (unsigned*)(As + (BUF) * 128 * 64 + (tid + 256 * i) * 8), 16, 0, 0); \
    _Pragma("unroll") for (int i = 0; i < NBV; ++i) \
      __builtin_amdgcn_global_load_lds((const unsigned*)(gb + (size_t)(32 * i) * ldb + kb_), (unsigned*)(Bs + (BUF) * BN * 64 + (tid + 256 * i) * 8), 16, 0, 0); }
#define D_COMPUTE(BUF) { const u16* Ap = As + (BUF) * 128 * 64 + (wr * 64 + fr) * 64; \
    const u16* Bp = Bs + (BUF) * BN * 64 + (wc * 16 * NS + fr) * 64; \
    _Pragma("unroll") for (int ks = 0; ks < 2; ++ks) { bf16x8 a[4], b[NS]; const int co = ks ? c1 : c0; \
      _Pragma("unroll") for (int m = 0; m < 4; ++m) a[m] = *(const bf16x8*)(Ap + m * 16 * 64 + co); \
      _Pragma("unroll") for (int n = 0; n < NS; ++n) b[n] = *(const bf16x8*)(Bp + n * 16 * 64 + co); \
      __builtin_amdgcn_s_setprio(1); \
      _Pragma("unroll") for (int m = 0; m < 4; ++m) _Pragma("unroll") for (int n = 0; n < NS; ++n) acc[m][n] = mfma16(a[m], b[n], acc[m][n]); \
      __builtin_amdgcn_s_setprio(0); } }
  D_ISSUE(0, 0)
#pragma unroll 1
  for (int kt = 0; kt < nt; kt += 2) {
    __syncthreads();
    if (kt + 1 < nt) D_ISSUE(kt + 1, 1)
    D_COMPUTE(0)
    if (kt + 1 >= nt) break;
    __syncthreads();
    if (kt + 2 < nt) D_ISSUE(kt + 2, 0)
    D_COMPUTE(1)
  }
  __syncthreads();
#undef D_ISSUE
#undef D_COMPUTE
}

__device__ __forceinline__ bool tile_map(int it, int NT, int& mt, int& nt) {
  const int g = gridDim.x;
  if ((g & 7) == 0) {
    const int xcd = blockIdx.x & 7, bx = blockIdx.x >> 3, nbx = g >> 3;
    const int lid = bx + it * nbx;
    if (lid >= 32 * NT) return false;
    const int grp = lid / (8 * NT), rem = lid - grp * 8 * NT;
    nt = rem >> 3; mt = xcd * 32 + grp * 8 + (rem & 7);
    return true;
  } else {
    const int id = blockIdx.x + it * g;
    if (id >= 256 * NT) return false;
    nt = id % NT; mt = id / NT;
    return true;
  }
}

#define ZERO_ACC(acc, NSV) _Pragma("unroll") for (int m_ = 0; m_ < 4; ++m_) _Pragma("unroll") for (int n_ = 0; n_ < NSV; ++n_) acc[m_][n_] = f32x4{0.f, 0.f, 0.f, 0.f};

__device__ __forceinline__ void phase_ffn_in(const Params& p, char* smem) {
  const u16* H = (const u16*)(p.ws + OFF_H); const u16* W = (const u16*)(p.ws + OFF_WIN); u16* ACT = (u16*)(p.ws + OFF_ACT);
  const int lane = tidx() & 63, wid = tidx() >> 6, wr = wid >> 1, wc = wid & 1, fr = lane & 15, fq = lane >> 4;
  int mt, nt;
  for (int it = 0; tile_map(it, 44, mt, nt); ++it) {
    const int m0 = mt * 128, n0 = nt * 128;
    f32x4 acc[4][4]; ZERO_ACC(acc, 4)
    gemm_loop_dma<4>(acc, H + (size_t)m0 * 1024, 1024, W + (size_t)n0 * 1024, 1024, 1024, (u16*)smem);
#pragma unroll
    for (int m = 0; m < 4; ++m)
#pragma unroll
      for (int n = 0; n < 2; ++n) {
        const int col = nt * 64 + wc * 32 + n * 16 + fr;
        const int r0 = m0 + wr * 64 + m * 16 + fq * 4;
#pragma unroll
        for (int j = 0; j < 4; ++j) ACT[(size_t)(r0 + j) * DFF + col] = f2bf(siluf_(acc[m][n][j]) * acc[m][n + 2][j]);
      }
  }
}

__device__ __forceinline__ void phase_gemm_plain(const u16* A, int lda, const u16* Bt, int K, u16* C, char* smem) {
  const int lane = tidx() & 63, wid = tidx() >> 6, wr = wid >> 1, wc = wid & 1, fr = lane & 15, fq = lane >> 4;
  int mt, nt;
  for (int it = 0; tile_map(it, 8, mt, nt); ++it) {
    const int m0 = mt * 128, n0 = nt * 128;
    f32x4 acc[4][4]; ZERO_ACC(acc, 4)
    gemm_loop_dma<4>(acc, A + (size_t)m0 * lda, lda, Bt + (size_t)n0 * K, K, K, (u16*)smem);
#pragma unroll
    for (int m = 0; m < 4; ++m)
#pragma unroll
      for (int n = 0; n < 4; ++n) {
        const int col = n0 + wc * 64 + n * 16 + fr;
        const int r0 = m0 + wr * 64 + m * 16 + fq * 4;
#pragma unroll
        for (int j = 0; j < 4; ++j) C[(size_t)(r0 + j) * 1024 + col] = f2bf(acc[m][n][j]);
      }
  }
}

__device__ __forceinline__ void phase_inproj(const Params& p, char* smem) {
  const u16* H = (const u16*)(p.ws + OFF_H); const u16* W = (const u16*)(p.ws + OFF_WMIX);
  u16* P1 = (u16*)(p.ws + OFF_P1); u16* P2 = (u16*)(p.ws + OFF_P2); u16* VT = (u16*)(p.ws + OFF_VT); u16* PB = (u16*)(p.ws + OFF_PB);
  const int lane = tidx() & 63, wid = tidx() >> 6, wr = wid >> 1, wc = wid & 1, fr = lane & 15, fq = lane >> 4;
  int mt, nt;
  for (int it = 0; tile_map(it, 33, mt, nt); ++it) {
    const int m0 = mt * 128, n0 = nt * 128;
    f32x4 acc[4][4]; ZERO_ACC(acc, 4)
    gemm_loop_dma<4>(acc, H + (size_t)m0 * 1024, 1024, W + (size_t)n0 * 1024, 1024, 1024, (u16*)smem);
#pragma unroll
    for (int m = 0; m < 4; ++m)
#pragma unroll
      for (int nn = 0; nn < 4; ++nn) {
        const int n = n0 + wc * 64 + nn * 16 + fr;
        if (n >= MIXN) continue;
        const int r0 = m0 + wr * 64 + m * 16 + fq * 4;
        f32x4 v = acc[m][nn];
        if ((n >= 896 && n < 1024) || (n >= 1152 && n < 1280)) {
          const int which = (n >= 1152) ? 1 : 0;
          const int gd = n - (which ? 1152 : 896);
          const int b = r0 >> 12, t = r0 & 4095;
          uint2 o; o.x = pack2(v[0], v[1]); o.y = pack2(v[2], v[3]);
          *(uint2*)(VT + ((size_t)((which * 8 + b) * 128 + gd)) * 4096 + (t & ~31) + 8 * fq + 4 * (m & 1)) = o;
        } else if (n < 1304) {
          const int pc = (n < 896) ? n : ((n < 1152) ? n - 128 : n - 256);
          if (n < 512) { const float qs = 0.125f * 1.4426950408889634f; v[0] *= qs; v[1] *= qs; v[2] *= qs; v[3] *= qs; }
          if (n >= 1280) { v[0] = sigmoidf_(v[0]); v[1] = sigmoidf_(v[1]); v[2] = sigmoidf_(v[2]); v[3] = sigmoidf_(v[3]); }
#pragma unroll
          for (int j = 0; j < 4; ++j) P1[(size_t)(r0 + j) * PS1 + pc] = f2bf(v[j]);
        } else if (n < 2328) {
#pragma unroll
          for (int j = 0; j < 4; ++j) P1[(size_t)(r0 + j) * PS1 + (n - 256)] = f2bf(geluf_(v[j]));
        } else {
          const int pc = n - 2328;
#pragma unroll
          for (int j = 0; j < 4; ++j) P2[(size_t)(r0 + j) * PS2 + pc] = f2bf(v[j]);
          if ((m & 1) && fq == 3) PB[(size_t)((r0 + 3) >> 5) * 1792 + pc] = f2bf(v[3]);
        }
      }
  }
}

__device__ __forceinline__ void phase_merge(const Params& p, char* smem) {
  const u16* H2 = (const u16*)(p.ws + OFF_H); const u16* WG = (const u16*)(p.ws + OFF_WG); const u16* WB = (const u16*)(p.ws + OFF_WB);
  const u16* P1 = (const u16*)(p.ws + OFF_P1); u16* MG = (u16*)(p.ws + OFF_MERGED);
  const int lane = tidx() & 63, wid = tidx() >> 6, wr = wid >> 1, wc = wid & 1, fr = lane & 15, fq = lane >> 4;
  int mt, nt;
  for (int it = 0; tile_map(it, 16, mt, nt); ++it) {
    const int m0 = mt * 128, n0 = nt * 64;
    f32x4 tot[4][2]; ZERO_ACC(tot, 2)
#pragma unroll 1
    for (int i = 0; i < 3; ++i) {
      unsigned gpk[4][2][2];
      {
        f32x4 ag[4][2]; ZERO_ACC(ag, 2)
        gemm_loop_dma<2>(ag, H2 + (size_t)m0 * 1024, 1024, WG + (size_t)(i * 1024 + n0) * 1024, 1024, 1024, (u16*)smem);
#pragma unroll
        for (int m = 0; m < 4; ++m)
#pragma unroll
          for (int n = 0; n < 2; ++n) {
            gpk[m][n][0] = pack2(sigmoidf_(ag[m][n][0]), sigmoidf_(ag[m][n][1]));
            gpk[m][n][1] = pack2(sigmoidf_(ag[m][n][2]), sigmoidf_(ag[m][n][3]));
          }
      }
      f32x4 ay[4][2]; ZERO_ACC(ay, 2)
      const u16* ya = (i == 0) ? P1 : ((i == 1) ? P1 + 1048 : P1 + 1560);
      const int lda = PS1;
      const u16* wb = WB + (size_t)i * 1024 * 512;
      gemm_loop_dma<2>(ay, ya + (size_t)m0 * lda, lda, wb + (size_t)n0 * 512, 512, 512, (u16*)smem);
#pragma unroll
      for (int m = 0; m < 4; ++m)
#pragma unroll
        for (int n = 0; n < 2; ++n) {
          tot[m][n][0] += bf2f((u16)(gpk[m][n][0] & 0xffff)) * ay[m][n][0];
          tot[m][n][1] += bf2f((u16)(gpk[m][n][0] >> 16)) * ay[m][n][1];
          tot[m][n][2] += bf2f((u16)(gpk[m][n][1] & 0xffff)) * ay[m][n][2];
          tot[m][n][3] += bf2f((u16)(gpk[m][n][1] >> 16)) * ay[m][n][3];
        }
    }
#pragma unroll
    for (int m = 0; m < 4; ++m)
#pragma unroll
      for (int n = 0; n < 2; ++n) {
        const int col = n0 + wc * 32 + n * 16 + fr;
        const int r0 = m0 + wr * 64 + m * 16 + fq * 4;
#pragma unroll
        for (int j = 0; j < 4; ++j) MG[(size_t)(r0 + j) * 1024 + col] = f2bf(tot[m][n][j]);
      }
  }
}

__device__ __forceinline__ void phase_cmp1(const Params& p, int l, char* smem) {
  const u16* P1 = (const u16*)(p.ws + OFF_P1); const u16* W1 = (const u16*)(p.ws + OFF_W1); u16* HID = (u16*)(p.ws + OFF_HID);
  const int lane = tidx() & 63, wid = tidx() >> 6, wr = wid >> 1, wc = wid & 1, fr = lane & 15, fq = lane >> 4;
  for (int tix = blockIdx.x; tix < 128; tix += gridDim.x) {
    const int which = tix >> 6, mt = (tix >> 1) & 31, nt = tix & 1;
    const int m0 = mt * 128, n0 = nt * 128;
    const float* pe = (which ? p.in[16] : p.in[13]) + (size_t)l * 2048;
    const u16* w1 = W1 + (size_t)which * 256 * 2048;
    const int cbase = 512 + which * 128;
    f32x4 acc[4][4]; ZERO_ACC(acc, 4)
    auto fa = [&](int r, int k) {
      const int row = m0 + r; const int g = row & 1, n = (row >> 1) & 255, b = row >> 9;
      uint4 o = make_uint4(0, 0, 0, 0);
      if (n < 255) {
        const int lpos = k >> 6, d = k & 63;
        uint4 raw = *(const uint4*)(P1 + (size_t)(b * 4096 + 16 * n + lpos) * PS1 + cbase + g * 64 + d);
        const float* pp = pe + lpos * 64 + d;
        float4 e0 = *(const float4*)pp, e1 = *(const float4*)(pp + 4);
        o.x = pack2(bf2f((u16)(raw.x & 0xffff)) + e0.x, bf2f((u16)(raw.x >> 16)) + e0.y);
        o.y = pack2(bf2f((u16)(raw.y & 0xffff)) + e0.z, bf2f((u16)(raw.y >> 16)) + e0.w);
        o.z = pack2(bf2f((u16)(raw.z & 0xffff)) + e1.x, bf2f((u16)(raw.z >> 16)) + e1.y);
        o.w = pack2(bf2f((u16)(raw.w & 0xffff)) + e1.z, bf2f((u16)(raw.w >> 16)) + e1.w);
      }
      return o;
    };
    auto fb = [&](int r, int k) { return *(const uint4*)(w1 + (size_t)(n0 + r) * 2048 + k); };
    gemm_loop<4>(acc, fa, fb, 2048, (u16*)smem);
#pragma unroll
    for (int m = 0; m < 4; ++m)
#pragma unroll
      for (int n = 0; n < 4; ++n) {
        const int col = n0 + wc * 64 + n * 16 + fr;
        const int r0 = m0 + wr * 64 + m * 16 + fq * 4;
#pragma unroll
        for (int j = 0; j < 4; ++j) HID[((size_t)which * 4096 + r0 + j) * 256 + col] = f2bf(siluf_(acc[m][n][j]));
      }
  }
}

__device__ __forceinline__ void phase_cmp2(const Params& p, int l) {
  const u16* HID = (const u16*)(p.ws + OFF_HID); u16* KC = (u16*)(p.ws + OFF_KC); u16* VC = (u16*)(p.ws + OFF_VC);
  const int total = 2 * 4096 * 64;
  for (int idx = blockIdx.x * 256 + tidx(); idx < total; idx += gridDim.x * 256) {
    const int d = idx & 63, row = (idx >> 6) & 4095, which = idx >> 18;
    const float* w2 = (which ? p.in[15] : p.in[12]) + (size_t)l * 256 * 64;
    const u16* hr = HID + ((size_t)which * 4096 + row) * 256;
    float acc = 0.f;
#pragma unroll 8
    for (int j = 0; j < 256; ++j) acc += bf2f(hr[j]) * w2[j * 64 + d];
    const int g = row & 1, n = (row >> 1) & 255, b = row >> 9;
    if (which == 0) KC[((size_t)(b * 2 + g) * 256 + n) * 64 + d] = f2bf(acc);
    else {
      const int u = n & 31; const int pp = 8 * ((u >> 2) & 3) + 4 * (u >> 4) + (u & 3);
      VC[((size_t)(b * 2 + g) * 64 + d) * 256 + (n & ~31) + pp] = f2bf(acc);
    }
  }
}

__device__ __forceinline__ void phase_sgu(const Params& p, int l, char* smem) {
  u16* P1 = (u16*)(p.ws + OFF_P1);
  u16* Wt = (u16*)smem;
  u16* Vt = Wt + 128 * 136;
  float* st = (float*)(Vt + 128 * 136);
  const int tid = tidx(), lane = tid & 63, wid = tid >> 6, wr = wid >> 1, wc = wid & 1, fr = lane & 15, fq = lane >> 4;
  const float* lng = p.in[17] + (size_t)l * 512; const float* lnb = p.in[18] + (size_t)l * 512;
  for (int item = blockIdx.x; item < 1024; item += gridDim.x) {
    const int ci = item >> 2, gi = item & 3;
    const int tok0 = ci * 128;
#pragma unroll 1
    for (int r0 = wid * 32; r0 < wid * 32 + 32; r0 += 8) {
      uint4 raw[8];
#pragma unroll
      for (int u = 0; u < 8; ++u) raw[u] = *(const uint4*)(P1 + (size_t)(tok0 + r0 + u) * PS1 + 1560 + lane * 8);
#pragma unroll
      for (int u = 0; u < 8; ++u) {
        float f[8];
        f[0] = bf2f((u16)(raw[u].x & 0xffff)); f[1] = bf2f((u16)(raw[u].x >> 16)); f[2] = bf2f((u16)(raw[u].y & 0xffff)); f[3] = bf2f((u16)(raw[u].y >> 16));
        f[4] = bf2f((u16)(raw[u].z & 0xffff)); f[5] = bf2f((u16)(raw[u].z >> 16)); f[6] = bf2f((u16)(raw[u].w & 0xffff)); f[7] = bf2f((u16)(raw[u].w >> 16));
        float s = 0.f, s2 = 0.f;
#pragma unroll
        for (int e = 0; e < 8; ++e) { s += f[e]; }
        s = wave_sum(s);
        const float mu = s * (1.f / 512.f);
#pragma unroll
        for (int e = 0; e < 8; ++e) { float dlt = f[e] - mu; s2 += dlt * dlt; }
        s2 = wave_sum(s2);
        if (lane == 0) { st[(r0 + u) * 2] = mu; st[(r0 + u) * 2 + 1] = rsqrtf(s2 * (1.f / 512.f) + 1e-5f); }
      }
    }
    const float* wsrc = p.in[19] + ((size_t)(l * 4 + gi)) * 128 * 128;
    for (int e = tid; e < 128 * 32; e += 256) {
      const int t = e >> 5, s4 = (e & 31) * 4;
      float4 w = *(const float4*)(wsrc + t * 128 + s4);
      uint2 o;
      o.x = pack2(s4 + 0 <= t ? w.x : 0.f, s4 + 1 <= t ? w.y : 0.f);
      o.y = pack2(s4 + 2 <= t ? w.z : 0.f, s4 + 3 <= t ? w.w : 0.f);
      *(uint2*)(Wt + t * 136 + s4) = o;
    }
    __syncthreads();
    for (int e = tid; e < 128 * 16; e += 256) {
      const int s = e >> 4, c8 = (e & 15) * 8;
      uint4 raw = *(const uint4*)(P1 + (size_t)(tok0 + s) * PS1 + 1560 + gi * 128 + c8);
      const float mu = st[s * 2], rs = st[s * 2 + 1];
      u16 rv[8] = {(u16)(raw.x & 0xffff), (u16)(raw.x >> 16), (u16)(raw.y & 0xffff), (u16)(raw.y >> 16), (u16)(raw.z & 0xffff), (u16)(raw.z >> 16), (u16)(raw.w & 0xffff), (u16)(raw.w >> 16)};
#pragma unroll
      for (int i = 0; i < 8; ++i) {
        const int c = gi * 128 + c8 + i;
        Vt[(c8 + i) * 136 + s] = f2bf((bf2f(rv[i]) - mu) * rs * lng[c] + lnb[c]);
      }
    }
    __syncthreads();
    f32x4 acc[4][4]; ZERO_ACC(acc, 4)
#pragma unroll 1
    for (int ks = 0; ks < 4; ++ks) {
      bf16x8 a[4], b[4];
#pragma unroll
      for (int m = 0; m < 4; ++m) a[m] = *(const bf16x8*)(Wt + (wr * 64 + m * 16 + fr) * 136 + ks * 32 + fq * 8);
#pragma unroll
      for (int n = 0; n < 4; ++n) b[n] = *(const bf16x8*)(Vt + (wc * 64 + n * 16 + fr) * 136 + ks * 32 + fq * 8);
#pragma unroll
      for (int m = 0; m < 4; ++m)
#pragma unroll
        for (int n = 0; n < 4; ++n) acc[m][n] = mfma16(a[m], b[n], acc[m][n]);
    }
    const float* bs = p.in[20] + ((size_t)(l * 4 + gi)) * 128;
#pragma unroll
    for (int m = 0; m < 4; ++m)
#pragma unroll
      for (int n = 0; n < 4; ++n) {
        const int c = wc * 64 + n * 16 + fr;
#pragma unroll
        for (int j = 0; j < 4; ++j) {
          const int t = wr * 64 + m * 16 + fq * 4 + j;
          u16* up = P1 + (size_t)(tok0 + t) * PS1 + 1048 + gi * 128 + c;
          *up = f2bf(bf2f(*up) * (acc[m][n][j] + bs[t]));
        }
      }
    __syncthreads();
  }
}

__device__ __forceinline__ void phase_prep1(const Params& p, int l) {
  u16* P2 = (u16*)(p.ws + OFF_P2); const u16* PB = (const u16*)(p.ws + OFF_PB); u16* VF = (u16*)(p.ws + OFF_VFIRST);
  const float* mu = p.in[21] + (size_t)l * 1792;
  const int total = 1024 * 224;
  for (int idx = blockIdx.x * 256 + tidx(); idx < total; idx += gridDim.x * 256) {
    const int tile = idx / 224, cg8 = (idx % 224) * 8;
    const int tok0 = tile * 32;
    float m8[8];
#pragma unroll
    for (int e = 0; e < 8; ++e) m8[e] = mu[cg8 + e];
    uint4 prev = make_uint4(0, 0, 0, 0);
    if ((tok0 & 4095) != 0) prev = *(const uint4*)(PB + (size_t)(tile - 1) * 1792 + cg8);
#pragma unroll 1
    for (int r0 = 0; r0 < 32; r0 += 8) {
      uint4 cv[8];
#pragma unroll
      for (int u = 0; u < 8; ++u) cv[u] = *(const uint4*)(P2 + (size_t)(tok0 + r0 + u) * PS2 + cg8);
#pragma unroll
      for (int u = 0; u < 8; ++u) {
        const uint4 cur = cv[u];
        unsigned cu[4] = {cur.x, cur.y, cur.z, cur.w}, pu[4] = {prev.x, prev.y, prev.z, prev.w};
        float o[8];
#pragma unroll
        for (int e = 0; e < 8; ++e) {
          float c = bf2f((u16)((cu[e >> 1] >> ((e & 1) * 16)) & 0xffff));
          float pv = bf2f((u16)((pu[e >> 1] >> ((e & 1) * 16)) & 0xffff));
          float sv = c + (pv - c) * m8[e];
          if (cg8 >= 1536 && cg8 < 1600) sv = tanhf_(sv);
          else if (cg8 >= 1664) sv = sigmoidf_(sv);
          o[e] = sv;
        }
        uint4 ov; ov.x = pack2(o[0], o[1]); ov.y = pack2(o[2], o[3]); ov.z = pack2(o[4], o[5]); ov.w = pack2(o[6], o[7]);
        *(uint4*)(P2 + (size_t)(tok0 + r0 + u) * PS2 + cg8) = ov;
        if (l == 0 && cg8 >= 1024 && cg8 < 1536) *(uint4*)(VF + (size_t)(tok0 + r0 + u) * 512 + cg8 - 1024) = ov;
        prev = cur;
      }
    }
  }
}

__device__ __forceinline__ void phase_prep2(const Params& p, int l, char* smem) {
  u16* P2 = (u16*)(p.ws + OFF_P2); const u16* VF = (const u16*)(p.ws + OFF_VFIRST);
  float* twd = (float*)smem;
  float* adl = twd + 1024;
  float* vsh = adl + 1024;
  float* lv = vsh + 8192;
  const int tid = tidx();
  const float* w0 = p.in[22] + (size_t)l * 512; const float* w2 = p.in[23] + (size_t)l * 64 * 512;
  const float* a0 = p.in[24] + (size_t)l * 512; const float* a2 = p.in[25] + (size_t)l * 64 * 512;
  const float* kkp = p.in[27] + (size_t)l * 512; const float* kap = p.in[28] + (size_t)l * 512;
  for (int item = blockIdx.x; item < 2048; item += gridDim.x) {
    const int tok0 = item * 16;
    for (int e = tid; e < 2048; e += 256) {
      const int r = e >> 7, c = e & 127;
      twd[(c >> 6) * 1024 + r * 64 + (c & 63)] = bf2f(P2[(size_t)(tok0 + r) * PS2 + 1536 + c]);
    }
    if (l > 0) {
      for (int e = tid; e < 8192; e += 256) { const int r = e >> 9, c = e & 511; vsh[e] = bf2f(P2[(size_t)(tok0 + r) * PS2 + 1024 + c]); }
    }
    __syncthreads();
    if (l > 0) {
      const float* v1 = p.in[33];
      for (int e = tid; e < 512; e += 256) {
        const int r = e >> 5, j = e & 31;
        float s = 0.f;
#pragma unroll 2
        for (int c = 0; c < 512; c += 4) {
          const float4 t4 = *(const float4*)(vsh + r * 512 + c);
          s += t4.x * v1[c * 32 + j] + t4.y * v1[(c + 1) * 32 + j] + t4.z * v1[(c + 2) * 32 + j] + t4.w * v1[(c + 3) * 32 + j];
        }
        lv[r * 32 + j] = s;
      }
      __syncthreads();
    }
    {
      float aw[2][16], aa[2][16], am[2][16];
#pragma unroll
      for (int c = 0; c < 2; ++c)
#pragma unroll
        for (int r = 0; r < 16; ++r) { aw[c][r] = 0.f; aa[c][r] = 0.f; am[c][r] = 0.f; }
#pragma unroll 2
      for (int i = 0; i < 64; i += 4) {
        float wv[2][4], av[2][4];
#pragma unroll
        for (int c = 0; c < 2; ++c)
#pragma unroll
          for (int u = 0; u < 4; ++u) { wv[c][u] = w2[(i + u) * 512 + tid + c * 256]; av[c][u] = a2[(i + u) * 512 + tid + c * 256]; }
#pragma unroll
        for (int r = 0; r < 16; ++r) {
          const float4 tw = *(const float4*)(twd + r * 64 + i);
          const float4 ta = *(const float4*)(adl + r * 64 + i);
#pragma unroll
          for (int c = 0; c < 2; ++c) {
            aw[c][r] += tw.x * wv[c][0] + tw.y * wv[c][1] + tw.z * wv[c][2] + tw.w * wv[c][3];
            aa[c][r] += ta.x * av[c][0] + ta.y * av[c][1] + ta.z * av[c][2] + ta.w * av[c][3];
          }
        }
      }
      if (l > 0) {
        const float* v2 = p.in[34];
#pragma unroll 2
        for (int j = 0; j < 32; j += 4) {
          float vv[2][4];
#pragma unroll
          for (int c = 0; c < 2; ++c)
#pragma unroll
            for (int u = 0; u < 4; ++u) vv[c][u] = v2[(j + u) * 512 + tid + c * 256];
#pragma unroll
          for (int r = 0; r < 16; ++r) {
            const float4 t4 = *(const float4*)(lv + r * 32 + j);
#pragma unroll
            for (int c = 0; c < 2; ++c) am[c][r] += t4.x * vv[c][0] + t4.y * vv[c][1] + t4.z * vv[c][2] + t4.w * vv[c][3];
          }
        }
      }
#pragma unroll
      for (int c = 0; c < 2; ++c) {
        const int ch = tid + c * 256;
        const float w0v = w0[ch], a0v = a0[ch], kkv = kkp[ch], kav = kap[ch];
        const float v0v = (l > 0) ? p.in[32][ch] : 0.f;
        float kval[16];
#pragma unroll
        for (int r = 0; r < 16; ++r) kval[r] = bf2f(P2[(size_t)(tok0 + r) * PS2 + 512 + ch]);
#pragma unroll
        for (int r = 0; r < 16; ++r) {
          u16* row = P2 + (size_t)(tok0 + r) * PS2;
          const float wpre = w0v + aw[c][r];
          const float nx = -wpre;
          const float sp = fmaxf(nx, 0.f) + __logf(1.f + __expf(-fabsf(nx)));
          const float w = -sp - 0.5f;
          const float decay = __expf(-__expf(w));
          const float a = sigmoidf_(a0v + aa[c][r]);
          const float kk = kval[r] * kkv;
          const float ss = wave_sum(kk * kk);
          const float kkn = kk / fmaxf(sqrtf(ss), 1e-12f);
          row[1792 + ch] = f2bf(decay);
          row[2304 + ch] = f2bf(kkn);
          row[2816 + ch] = f2bf(kkn * a);
          row[512 + ch] = f2bf(kval[r] * (1.f + (a - 1.f) * kav));
          if (l > 0) {
            const float v = vsh[r * 512 + ch];
            const float vf = bf2f(VF[(size_t)(tok0 + r) * 512 + ch]);
            row[1024 + ch] = f2bf(v + (vf - v) * sigmoidf_(v0v + am[c][r]));
          }
        }
      }
    }
    __syncthreads();
  }
}

__device__ __forceinline__ void unpack4(uint2 u, float (&f)[4]) {
  f[0] = bf2f((u16)(u.x & 0xffff)); f[1] = bf2f((u16)(u.x >> 16)); f[2] = bf2f((u16)(u.y & 0xffff)); f[3] = bf2f((u16)(u.y >> 16));
}
__device__ __forceinline__ float quad_sum(float v) { v += __shfl_xor(v, 16); v += __shfl_xor(v, 32); return v; }

__device__ __forceinline__ void phase_prep2m(const Params& p, int l, char* smem) {
  u16* P2 = (u16*)(p.ws + OFF_P2); const u16* VF = (const u16*)(p.ws + OFF_VFIRST); const u16* WL = (const u16*)(p.ws + OFF_WL);
  u16* twl = (u16*)smem;
  u16* adl = twl + 16 * 72;
  u16* vl = adl + 16 * 72;
  const int tid = tidx(), lane = tid & 63, w = tid >> 6, fr = lane & 15, fq = lane >> 4;
  const float* w0 = p.in[22] + (size_t)l * 512; const float* a0 = p.in[24] + (size_t)l * 512;
  const float* kkp = p.in[27] + (size_t)l * 512; const float* kap = p.in[28] + (size_t)l * 512;
#pragma unroll 1
  for (int item = blockIdx.x; item < 2048; item += gridDim.x) {
    const int tok0 = item * 16;
    {
      const int r = tid >> 4, c = tid & 15;
      const uint4 v = *(const uint4*)(P2 + (size_t)(tok0 + r) * PS2 + 1536 + c * 8);
      if (c < 8) *(uint4*)(twl + r * 72 + c * 8) = v; else *(uint4*)(adl + r * 72 + (c - 8) * 8) = v;
    }
    if (l > 0) {
#pragma unroll
      for (int i = 0; i < 4; ++i) {
        const int idx = tid + 256 * i, r = idx >> 6, c = idx & 63;
        *(uint4*)(vl + r * 520 + c * 8) = *(const uint4*)(P2 + (size_t)(tok0 + r) * PS2 + 1024 + c * 8);
      }
    }
    __syncthreads();
    bf16x8 xw[2], xa[2];
#pragma unroll
    for (int ks = 0; ks < 2; ++ks) { xw[ks] = *(const bf16x8*)(twl + fr * 72 + ks * 32 + fq * 8); xa[ks] = *(const bf16x8*)(adl + fr * 72 + ks * 32 + fq * 8); }
    bf16x8 plv = {0, 0, 0, 0, 0, 0, 0, 0};
    if (l > 0) {
      f32x4 lv0 = {0.f, 0.f, 0.f, 0.f}, lv1 = {0.f, 0.f, 0.f, 0.f};
#pragma unroll 4
      for (int ks = 0; ks < 16; ++ks) {
        const bf16x8 xb = *(const bf16x8*)(vl + fr * 520 + ks * 32 + fq * 8);
        const bf16x8 a0f = *(const bf16x8*)(WL + WL_V1 + (size_t)fr * 512 + ks * 32 + fq * 8);
        const bf16x8 a1f = *(const bf16x8*)(WL + WL_V1 + (size_t)(16 + fr) * 512 + ks * 32 + fq * 8);
        lv0 = mfma16(a0f, xb, lv0); lv1 = mfma16(a1f, xb, lv1);
      }
      uint4 u; u.x = pack2(lv0[0], lv0[1]); u.y = pack2(lv0[2], lv0[3]); u.z = pack2(lv1[0], lv1[1]); u.w = pack2(lv1[2], lv1[3]);
      plv = *(bf16x8*)&u;
    }
    const size_t tok = (size_t)tok0 + fr;
    u16* row = P2 + tok * PS2;
#pragma unroll 1
    for (int hh = 0; hh < 2; ++hh) {
      f32x4 aw[4], aa[4], am[4];
#pragma unroll
      for (int m4 = 0; m4 < 4; ++m4) {
        const int chr = w * 128 + (hh * 4 + m4) * 16 + fr;
        f32x4 cw = {0.f, 0.f, 0.f, 0.f}, ca = {0.f, 0.f, 0.f, 0.f}, cm = {0.f, 0.f, 0.f, 0.f};
#pragma unroll
        for (int ks = 0; ks < 2; ++ks) {
          cw = mfma16(*(const bf16x8*)(WL + WL_W2 + (size_t)chr * 64 + ks * 32 + fq * 8), xw[ks], cw);
          ca = mfma16(*(const bf16x8*)(WL + WL_A2 + (size_t)chr * 64 + ks * 32 + fq * 8), xa[ks], ca);
        }
        if (l > 0) {
          const uint2 g0 = *(const uint2*)(WL + WL_V2 + (size_t)chr * 64 + 4 * fq);
          const uint2 g1 = *(const uint2*)(WL + WL_V2 + (size_t)chr * 64 + 16 + 4 * fq);
          uint4 u; u.x = g0.x; u.y = g0.y; u.z = g1.x; u.w = g1.y;
          cm = mfma16(*(bf16x8*)&u, plv, cm);
        }
        aw[m4] = cw; aa[m4] = ca; am[m4] = cm;
      }
      float kv[4][4], av[4][4], kk[4][4];
      float ss = 0.f;
#pragma unroll
      for (int m4 = 0; m4 < 4; ++m4) {
        const int ch0 = w * 128 + (hh * 4 + m4) * 16 + 4 * fq;
        unpack4(*(const uint2*)(row + 512 + ch0), kv[m4]);
        const float4 a0v = *(const float4*)(a0 + ch0), kkv = *(const float4*)(kkp + ch0);
        const float a0a[4] = {a0v.x, a0v.y, a0v.z, a0v.w}, kka[4] = {kkv.x, kkv.y, kkv.z, kkv.w};
#pragma unroll
        for (int j = 0; j < 4; ++j) {
          av[m4][j] = sigmoidf_(a0a[j] + aa[m4][j]);
          kk[m4][j] = kv[m4][j] * kka[j];
          ss += kk[m4][j] * kk[m4][j];
        }
      }
      ss = quad_sum(ss);
      const float rn = 1.f / fmaxf(sqrtf(ss), 1e-12f);
#pragma unroll
      for (int m4 = 0; m4 < 4; ++m4) {
        const int ch0 = w * 128 + (hh * 4 + m4) * 16 + 4 * fq;
        const float4 w0v = *(const float4*)(w0 + ch0), kav = *(const float4*)(kap + ch0);
        const float w0a[4] = {w0v.x, w0v.y, w0v.z, w0v.w}, kaa[4] = {kav.x, kav.y, kav.z, kav.w};
        float dc[4], kn[4], bb[4], kp[4];
#pragma unroll
        for (int j = 0; j < 4; ++j) {
          const float nx = -(w0a[j] + aw[m4][j]);
          const float sp = fmaxf(nx, 0.f) + __logf(1.f + __expf(-fabsf(nx)));
          dc[j] = __expf(-__expf(-sp - 0.5f));
          kn[j] = kk[m4][j] * rn;
          bb[j] = kn[j] * av[m4][j];
          kp[j] = kv[m4][j] * (1.f + (av[m4][j] - 1.f) * kaa[j]);
        }
        uint2 o;
        o.x = pack2(dc[0], dc[1]); o.y = pack2(dc[2], dc[3]); *(uint2*)(row + 1792 + ch0) = o;
        o.x = pack2(kn[0], kn[1]); o.y = pack2(kn[2], kn[3]); *(uint2*)(row + 2304 + ch0) = o;
        o.x = pack2(bb[0], bb[1]); o.y = pack2(bb[2], bb[3]); *(uint2*)(row + 2816 + ch0) = o;
        o.x = pack2(kp[0], kp[1]); o.y = pack2(kp[2], kp[3]); *(uint2*)(row + 512 + ch0) = o;
        if (l > 0) {
          float vv[4], vf[4];
          unpack4(*(const uint2*)(vl + fr * 520 + ch0), vv);
          unpack4(*(const uint2*)(VF + tok * 512 + ch0), vf);
          const float4 v0v = *(const float4*)(p.in[32] + ch0);
          const float v0a[4] = {v0v.x, v0v.y, v0v.z, v0v.w};
          float vo[4];
#pragma unroll
          for (int j = 0; j < 4; ++j) vo[j] = vv[j] + (vf[j] - vv[j]) * sigmoidf_(v0a[j] + am[m4][j]);
          o.x = pack2(vo[0], vo[1]); o.y = pack2(vo[2], vo[3]); *(uint2*)(row + 1024 + ch0) = o;
        }
      }
    }
    __syncthreads();
  }
}

__device__ __forceinline__ void phase_postm(const Params& p, int l, char* smem) {
  const u16* P2 = (const u16*)(p.ws + OFF_P2); u16* YC = (u16*)(p.ws + OFF_P1) + 1560; const u16* WL = (const u16*)(p.ws + OFF_WL);
  u16* sgl = (u16*)smem;
  const int tid = tidx(), lane = tid & 63, w = tid >> 6, fr = lane & 15, fq = lane >> 4;
  const float* rk = p.in[29] + (size_t)l * 512; const float* lg = p.in[30] + (size_t)l * 512; const float* lb = p.in[31] + (size_t)l * 512;
#pragma unroll 1
  for (int item = blockIdx.x; item < 2048; item += gridDim.x) {
    const int tok0 = item * 16;
    {
      const int r = tid >> 4, c = tid & 15;
      *(uint4*)(sgl + r * 136 + c * 8) = *(const uint4*)(P2 + (size_t)(tok0 + r) * PS2 + 1664 + c * 8);
    }
    __syncthreads();
    bf16x8 xb[4];
#pragma unroll
    for (int ks = 0; ks < 4; ++ks) xb[ks] = *(const bf16x8*)(sgl + fr * 136 + ks * 32 + fq * 8);
    const size_t tok = (size_t)tok0 + fr;
    const u16* row = P2 + tok * PS2;
    u16* yrow = YC + tok * PS1;
#pragma unroll 1
    for (int hh = 0; hh < 2; ++hh) {
      f32x4 ag[4];
#pragma unroll
      for (int m4 = 0; m4 < 4; ++m4) {
        const int chr = w * 128 + (hh * 4 + m4) * 16 + fr;
        f32x4 c = {0.f, 0.f, 0.f, 0.f};
#pragma unroll
        for (int ks = 0; ks < 4; ++ks) c = mfma16(*(const bf16x8*)(WL + WL_G2 + (size_t)chr * 128 + ks * 32 + fq * 8), xb[ks], c);
        ag[m4] = c;
      }
      float yv[4][4], vv[4][4];
      float s1 = 0.f, sb = 0.f;
#pragma unroll
      for (int m4 = 0; m4 < 4; ++m4) {
        const int ch0 = w * 128 + (hh * 4 + m4) * 16 + 4 * fq;
        float rr[4], kk[4];
        unpack4(*(const uint2*)(yrow + ch0), yv[m4]);
        unpack4(*(const uint2*)(row + ch0), rr);
        unpack4(*(const uint2*)(row + 512 + ch0), kk);
        unpack4(*(const uint2*)(row + 1024 + ch0), vv[m4]);
        const float4 rkv = *(const float4*)(rk + ch0);
        s1 += yv[m4][0] + yv[m4][1] + yv[m4][2] + yv[m4][3];
        sb += rr[0] * kk[0] * rkv.x + rr[1] * kk[1] * rkv.y + rr[2] * kk[2] * rkv.z + rr[3] * kk[3] * rkv.w;
      }
      s1 = quad_sum(s1); sb = quad_sum(sb);
      const float mean = s1 * (1.f / 64.f);
      float s2 = 0.f;
#pragma unroll
      for (int m4 = 0; m4 < 4; ++m4)
#pragma unroll
        for (int j = 0; j < 4; ++j) { const float d = yv[m4][j] - mean; s2 += d * d; }
      s2 = quad_sum(s2);
      const float rs = rsqrtf(s2 * (1.f / 64.f) + 64e-5f);
#pragma unroll
      for (int m4 = 0; m4 < 4; ++m4) {
        const int ch0 = w * 128 + (hh * 4 + m4) * 16 + 4 * fq;
        const float4 lgv = *(const float4*)(lg + ch0), lbv = *(const float4*)(lb + ch0);
        const float lga[4] = {lgv.x, lgv.y, lgv.z, lgv.w}, lba[4] = {lbv.x, lbv.y, lbv.z, lbv.w};
        float o4[4];
#pragma unroll
        for (int j = 0; j < 4; ++j) o4[j] = ((yv[m4][j] - mean) * rs * lga[j] + lba[j] + sb * vv[m4][j]) * ag[m4][j];
        uint2 o; o.x = pack2(o4[0], o4[1]); o.y = pack2(o4[2], o4[3]);
        *(uint2*)(yrow + ch0) = o;
      }
    }
    __syncthreads();
  }
}

__device__ __forceinline__ void scan_item(const Params& p, int item, char* smem) {
  const u16* P2 = (const u16*)(p.ws + OFF_P2); u16* YC = (u16*)(p.ws + OFF_P1) + 1560;
  float* vb = (float*)smem;
  float* yb = vb + 2 * 6 * 16 * 64;
  const int tid = tidx(), lane = tid & 63, wid = tid >> 6;
  const int rq = item & 3, h = (item >> 2) & 7, b = item >> 5;
  const int rl = lane >> 4, cq = lane & 15;
  const int rloc = wid * 4 + rl;
  const int ihead = rq * 16 + rloc;
  const int j0 = cq * 4;
  const size_t tokb = (size_t)b * 4096;
  float s0 = 0.f, s1 = 0.f, s2 = 0.f, s3 = 0.f;
  uint4 pA[3], pB[3], pC[3];
  auto gload = [&](uint4 (&pre)[3], int c) {
#pragma unroll
    for (int i = 0; i < 3; ++i) {
      const int v = tid + i * 256; const int vec = v >> 7, rem = v & 127, step = rem >> 3, c8 = rem & 7;
      const int off = (vec == 0) ? 0 : (vec == 1) ? 1792 : (vec == 2) ? 512 : (vec == 3) ? 1024 : (vec == 4) ? 2304 : 2816;
      pre[i] = *(const uint4*)(P2 + (tokb + c * 16 + step) * PS2 + off + h * 64 + c8 * 8);
    }
  };
  auto lstore = [&](const uint4 (&pre)[3], int buf) {
#pragma unroll
    for (int i = 0; i < 3; ++i) {
      const int v = tid + i * 256; const int vec = v >> 7, rem = v & 127, step = rem >> 3, c8 = rem & 7;
      float* d = vb + ((buf * 6 + vec) * 16 + step) * 64 + c8 * 8;
      float4 f0, f1;
      f0.x = bf2f((u16)(pre[i].x & 0xffff)); f0.y = bf2f((u16)(pre[i].x >> 16)); f0.z = bf2f((u16)(pre[i].y & 0xffff)); f0.w = bf2f((u16)(pre[i].y >> 16));
      f1.x = bf2f((u16)(pre[i].z & 0xffff)); f1.y = bf2f((u16)(pre[i].z >> 16)); f1.z = bf2f((u16)(pre[i].w & 0xffff)); f1.w = bf2f((u16)(pre[i].w >> 16));
      *(float4*)d = f0; *(float4*)(d + 4) = f1;
    }
  };
#define SC_LOAD(X, ST) { r##X = *(const float4*)(base + (0 * 16 + (ST)) * 64 + j0); w##X = *(const float4*)(base + (1 * 16 + (ST)) * 64 + j0); \
      k##X = *(const float4*)(base + (2 * 16 + (ST)) * 64 + j0); v##X = base[(3 * 16 + (ST)) * 64 + ihead]; \
      n##X = *(const float4*)(base + (4 * 16 + (ST)) * 64 + j0); b##X = *(const float4*)(base + (5 * 16 + (ST)) * 64 + j0); }
#define SC_STEP(X, ST) { float sa = s0 * n##X.x + s1 * n##X.y + s2 * n##X.z + s3 * n##X.w; \
      sa = -dpp_sum16(sa); \
      s0 = s0 * w##X.x + sa * b##X.x + v##X * k##X.x; s1 = s1 * w##X.y + sa * b##X.y + v##X * k##X.y; \
      s2 = s2 * w##X.z + sa * b##X.z + v##X * k##X.z; s3 = s3 * w##X.w + sa * b##X.w + v##X * k##X.w; \
      float y = s0 * r##X.x + s1 * r##X.y + s2 * r##X.z + s3 * r##X.w; \
      y = dpp_sum16(y); yb[(ST) * 16 + rloc] = y; }
#define SC_CHUNK(CC, PRE) { const int cc_ = (CC); if (cc_ >= 256) break; \
    const float* base = vb + (cc_ & 1) * 6 * 16 * 64; \
    { float4 rA, wA, kA, nA, bA, rB, wB, kB, nB, bB; float vA, vB; \
      SC_LOAD(A, 0) \
      _Pragma("unroll") for (int st = 0; st < 16; st += 2) { SC_LOAD(B, st + 1) SC_STEP(A, st) if (st + 2 < 16) SC_LOAD(A, st + 2) SC_STEP(B, st + 1) } } \
    __syncthreads(); \
    { const int st = tid >> 4, r = tid & 15; \
      YC[(tokb + cc_ * 16 + st) * PS1 + h * 64 + rq * 16 + r] = f2bf(yb[st * 16 + r]); } \
    if (cc_ + 1 < 256) lstore(PRE, (cc_ + 1) & 1); \
    if (cc_ + 4 < 256) gload(PRE, cc_ + 4); \
    __syncthreads(); }
  gload(pA, 0); lstore(pA, 0);
  __syncthreads();
  gload(pA, 1); gload(pB, 2); gload(pC, 3);
#pragma unroll 1
  for (int c = 0; c < 256; c += 3) {
    SC_CHUNK(c, pA)
    SC_CHUNK(c + 1, pB)
    SC_CHUNK(c + 2, pC)
  }
#undef SC_LOAD
#undef SC_STEP
#undef SC_CHUNK
}

__device__ __forceinline__ void phase_post(const Params& p, int l, char* smem) {
  const u16* P2 = (const u16*)(p.ws + OFF_P2); u16* YC = (u16*)(p.ws + OFF_P1) + 1560;
  float* sg = (float*)smem;
  const int tid = tidx();
  const float* g2 = p.in[26] + (size_t)l * 128 * 512;
  const float* rk = p.in[29] + (size_t)l * 512; const float* lg = p.in[30] + (size_t)l * 512; const float* lb = p.in[31] + (size_t)l * 512;
  for (int item = blockIdx.x; item < 2048; item += gridDim.x) {
    const int tok0 = item * 16;
    for (int e = tid; e < 2048; e += 256) { const int r = e >> 7, c = e & 127; sg[e] = bf2f(P2[(size_t)(tok0 + r) * PS2 + 1664 + c]); }
    __syncthreads();
    {
      float ag[2][16];
#pragma unroll
      for (int c = 0; c < 2; ++c)
#pragma unroll
        for (int r = 0; r < 16; ++r) ag[c][r] = 0.f;
#pragma unroll 4
      for (int i = 0; i < 128; i += 4) {
        float gv[2][4];
#pragma unroll
        for (int c = 0; c < 2; ++c)
#pragma unroll
          for (int u = 0; u < 4; ++u) gv[c][u] = g2[(i + u) * 512 + tid + c * 256];
#pragma unroll
        for (int r = 0; r < 16; ++r) {
          const float4 t4 = *(const float4*)(sg + r * 128 + i);
#pragma unroll
          for (int c = 0; c < 2; ++c) ag[c][r] += t4.x * gv[c][0] + t4.y * gv[c][1] + t4.z * gv[c][2] + t4.w * gv[c][3];
        }
      }
#pragma unroll
      for (int c = 0; c < 2; ++c) {
        const int ch = tid + c * 256;
        const float rkv = rk[ch], lgv = lg[ch], lbv = lb[ch];
        float yv[16], rr[16], kk[16], vv[16];
#pragma unroll
        for (int r = 0; r < 16; ++r) {
          const u16* row = P2 + (size_t)(tok0 + r) * PS2;
          yv[r] = bf2f(YC[(size_t)(tok0 + r) * PS1 + ch]);
          rr[r] = bf2f(row[ch]); kk[r] = bf2f(row[512 + ch]); vv[r] = bf2f(row[1024 + ch]);
        }
#pragma unroll
        for (int r = 0; r < 16; ++r) {
          const float mean = wave_sum(yv[r]) * (1.f / 64.f);
          const float dv = yv[r] - mean;
          const float var = wave_sum(dv * dv) * (1.f / 64.f);
          const float yn = dv * rsqrtf(var + 64e-5f) * lgv + lbv;
          const float bon = wave_sum(rr[r] * kk[r] * rkv) * vv[r];
          YC[(size_t)(tok0 + r) * PS1 + ch] = f2bf((yn + bon) * ag[c][r]);
        }
      }
    }
    __syncthreads();
  }
}

#define NEGV (-1e30f)
struct AttnState { float m[2]; float ls[2]; f32x4 ot[4][2]; };

#define MINIT (-1e20f)
template <int MODE, bool FULL>
__device__ __forceinline__ void attn_scores(f32x4 (&st)[4][2], const u16* kbase, int kstride, int key0, const bf16x8 (&qf)[2][2],
                                            const float (&slope)[2], int t, bool selbit, int c16, int q4) {
  const float fb = (float)(key0 + q4 * 4 - t);
#pragma unroll
  for (int mk = 0; mk < 4; ++mk) {
    const u16* kp = kbase + (size_t)(mk * 16 + c16) * kstride + q4 * 8;
    const bf16x8 k0 = *(const bf16x8*)kp, k1 = *(const bf16x8*)(kp + 32);
#pragma unroll
    for (int nq = 0; nq < 2; ++nq) {
      f32x4 a = {0.f, 0.f, 0.f, 0.f};
      a = mfma16(k0, qf[nq][0], a);
      a = mfma16(k1, qf[nq][1], a);
      if (FULL) {
        const float c0 = slope[nq] * fb;
#pragma unroll
        for (int j = 0; j < 4; ++j) {
          const float v = a[j] + (c0 + slope[nq] * (float)(mk * 16 + j));
          a[j] = (MODE == 1) ? (selbit ? v : NEGV) : v;
        }
      } else {
#pragma unroll
        for (int j = 0; j < 4; ++j) {
          const int key = key0 + mk * 16 + q4 * 4 + j;
          int dist; bool valid;
          if (MODE == 0) { dist = t - (16 * key + 31); valid = dist >= 0; }
          else if (MODE == 1) { dist = t - key; valid = (dist >= 0) && selbit; }
          else { dist = t - key; valid = (dist >= 0) && (dist < 512); }
          a[j] = valid ? (a[j] - slope[nq] * (float)dist) : NEGV;
        }
      }
      st[mk][nq] = a;
    }
  }
}

template <int MODE, bool FULL>
__device__ __forceinline__ void attn_tile(AttnState& S, const u16* kbase, int kstride, const u16* vtbase, int vstride, int key0,
                                          const bf16x8 (&qf)[2][2], const float (&slope)[2], int t, bool selbit, int c16, int q4) {
  f32x4 st[4][2];
  attn_scores<MODE, FULL>(st, kbase, kstride, key0, qf, slope, t, selbit, c16, q4);
  __builtin_amdgcn_sched_barrier(0);
#pragma unroll
  for (int nq = 0; nq < 2; ++nq) {
    float mx = fmaxf(fmaxf(st[0][nq][0], st[0][nq][1]), fmaxf(st[0][nq][2], st[0][nq][3]));
#pragma unroll
    for (int mk = 1; mk < 4; ++mk) mx = fmaxf(mx, fmaxf(fmaxf(st[mk][nq][0], st[mk][nq][1]), fmaxf(st[mk][nq][2], st[mk][nq][3])));
    mx = fmaxf(mx, __shfl_xor(mx, 16)); mx = fmaxf(mx, __shfl_xor(mx, 32));
    const float mnew = fmaxf(S.m[nq], mx);
    const float alpha = __builtin_amdgcn_exp2f(S.m[nq] - mnew);
    S.m[nq] = mnew;
    float ls = S.ls[nq] * alpha;
#pragma unroll
    for (int md = 0; md < 4; ++md) { S.ot[md][nq][0] *= alpha; S.ot[md][nq][1] *= alpha; S.ot[md][nq][2] *= alpha; S.ot[md][nq][3] *= alpha; }
#pragma unroll
    for (int mk = 0; mk < 4; ++mk)
#pragma unroll
      for (int j = 0; j < 4; ++j) {
        const float pv = __builtin_amdgcn_exp2f(st[mk][nq][j] - mnew);
        st[mk][nq][j] = pv; ls += pv;
      }
    S.ls[nq] = ls;
  }
#pragma unroll
  for (int s2 = 0; s2 < 2; ++s2) {
    bf16x8 pb[2];
#pragma unroll
    for (int nq = 0; nq < 2; ++nq) {
      uint4 u;
      u.x = pack2(st[2 * s2][nq][0], st[2 * s2][nq][1]); u.y = pack2(st[2 * s2][nq][2], st[2 * s2][nq][3]);
      u.z = pack2(st[2 * s2 + 1][nq][0], st[2 * s2 + 1][nq][1]); u.w = pack2(st[2 * s2 + 1][nq][2], st[2 * s2 + 1][nq][3]);
      pb[nq] = *(bf16x8*)&u;
    }
#pragma unroll
    for (int md = 0; md < 4; ++md) {
      const bf16x8 vf = *(const bf16x8*)(vtbase + (size_t)(md * 16 + c16) * vstride + s2 * 32 + q4 * 8);
#pragma unroll
      for (int nq = 0; nq < 2; ++nq) S.ot[md][nq] = mfma16(vf, pb[nq], S.ot[md][nq]);
    }
  }
}

__device__ __forceinline__ void attn_reset(AttnState& S) {
#pragma unroll
  for (int nq = 0; nq < 2; ++nq) { S.m[nq] = MINIT; S.ls[nq] = 0.f;
#pragma unroll
    for (int md = 0; md < 4; ++md) S.ot[md][nq] = f32x4{0.f, 0.f, 0.f, 0.f}; }
}
__device__ __forceinline__ void attn_fold(AttnState& S, float* oacc, const u16* gp, int br, float (&invl)[2], int lane) {
#pragma unroll
  for (int nq = 0; nq < 2; ++nq) {
    float l = S.ls[nq];
    l += __shfl_xor(l, 16); l += __shfl_xor(l, 32);
    const float inv = (l > 0.f) ? 1.f / l : 0.f;
    invl[nq] = inv;
    const float f = bf2f(gp[nq * 6 + br]) * inv;
#pragma unroll
    for (int md = 0; md < 4; ++md)
#pragma unroll
      for (int j = 0; j < 4; ++j) {
        float* a = oacc + ((md * 2 + nq) * 4 + j) * 64 + lane;
        const float v = f * S.ot[md][nq][j];
        if (br == 0) *a = v; else *a += v;
      }
  }
}

__device__ __forceinline__ void phase_nsa(const Params& p, char* smem, unsigned* queue) {
  u16* P1 = (u16*)(p.ws + OFF_P1);
  const u16* KC = (const u16*)(p.ws + OFF_KC); const u16* VC = (const u16*)(p.ws + OFF_VC); const u16* VT = (const u16*)(p.ws + OFF_VT);
  const int tid = tidx(), lane = tid & 63, wid = tid >> 6;
  const int c16 = lane & 15, q4 = lane >> 4, tq = lane & 7;
  float* ps = (float*)smem + wid * 2048;
  float* oacc = (float*)(smem + 32768) + wid * 2048;
  int* qslot = (int*)(smem + 65536);
#pragma unroll 1
  for (;;) {
    if (tid == 0) *qslot = (int)atomicAdd(queue, 1u);
    __syncthreads();
    const int it = *qslot;
    if (it >= 2048) break;
    const int bg = it & 15;
    const int tqd = 127 - (it >> 4);
    const int b = bg >> 1, g = bg & 1;
    const int t0 = (tqd * 4 + wid) * 8;
    const int tok0 = b * 4096 + t0;
    const int t = t0 + tq;
    const int cur = t0 >> 6;
#pragma unroll
    for (int i = 0; i < 8; ++i) *(float4*)(ps + i * 256 + lane * 4) = float4{0.f, 0.f, 0.f, 0.f};
    bf16x8 qf[2][2]; float slope[2];
    const u16* gp = P1 + (size_t)(tok0 + tq) * PS1 + 1024 + (g * 4 + (c16 >> 3)) * 3;
#pragma unroll
    for (int nq = 0; nq < 2; ++nq) {
      const int hh = nq * 2 + (c16 >> 3);
      const u16* rp = P1 + (size_t)(tok0 + tq) * PS1;
      qf[nq][0] = *(const bf16x8*)(rp + (g * 4 + hh) * 64 + q4 * 8);
      qf[nq][1] = *(const bf16x8*)(rp + (g * 4 + hh) * 64 + 32 + q4 * 8);
      slope[nq] = exp2f(-(float)(g * 4 + hh + 1)) * 1.4426950408889634f;
    }
    AttnState S;
    float invl[2];
    const u16* kcb = KC + (size_t)(b * 2 + g) * 256 * 64;
    const u16* vcb = VC + (size_t)(b * 2 + g) * 64 * 256;
    int ntc = 0;
    if (t0 + 7 >= 31) ntc = (((t0 + 7 - 31) >> 4) >> 6) + 1;
    attn_reset(S);
#pragma unroll 1
    for (int kt = 0; kt < ntc; ++kt) attn_tile<0, false>(S, kcb + (size_t)kt * 64 * 64, 64, vcb + kt * 64, 256, kt * 64, qf, slope, t, true, c16, q4);
    attn_fold(S, oacc, gp, 0, invl, lane);
#pragma unroll 1
    for (int kt = 0; kt < ntc; ++kt) {
      f32x4 st[4][2];
      attn_scores<0, false>(st, kcb + (size_t)kt * 64 * 64, 64, kt * 64, qf, slope, t, true, c16, q4);
#pragma unroll
      for (int mk = 0; mk < 4; ++mk) {
        f32x4 hs;
#pragma unroll
        for (int j = 0; j < 4; ++j) {
          const float a0 = st[mk][0][j], a1 = st[mk][1][j];
          const float p0 = __builtin_amdgcn_exp2f(a0 - S.m[0]) * invl[0];
          const float p1 = __builtin_amdgcn_exp2f(a1 - S.m[1]) * invl[1];
          float v = p0 + p1;
          v += __shfl_xor(v, 8);
          hs[j] = v;
        }
        if (c16 < 8) *(f32x4*)(ps + c16 * 256 + kt * 64 + mk * 16 + q4 * 4) = hs;
      }
    }
    __syncthreads();
    unsigned long long selm = 0ull, un = 0ull;
#pragma unroll 1
    for (int tqq = 0; tqq < 8; ++tqq) {
      const float* pr = ps + tqq * 256;
      float imp = pr[4 * lane];
      if (lane > 0) imp += pr[4 * lane - 4] + 2.f * (pr[4 * lane - 3] + pr[4 * lane - 2] + pr[4 * lane - 1]);
      const bool forced = (lane == 0) || (lane == cur) || (lane == cur - 1);
      const bool live = lane <= cur;
      const float val = forced ? 1e4f : (live ? imp : NEGV);
      int rank = 0;
#pragma unroll 8
      for (int i = 0; i < 64; ++i) {
        const float vi = __uint_as_float(__builtin_amdgcn_readlane(__float_as_uint(val), i));
        rank += ((vi > val) || (vi == val && i < lane)) ? 1 : 0;
      }
      const unsigned long long bal = __ballot((rank < 16) && live);
      if (tq == tqq) selm = bal;
      un |= bal;
    }
    __syncthreads();
    attn_reset(S);
    {
      const u16* vtb = VT + (size_t)((0 * 8 + b) * 2 + g) * 64 * 4096;
#pragma unroll 1
      for (int j = 0; j <= cur; ++j) {
        if (!((un >> j) & 1ull)) continue;
        const bool sb = (selm >> j) & 1ull;
        const u16* kb_ = P1 + (size_t)(b * 4096 + j * 64) * PS1 + 768 + g * 64;
        if (j < cur) attn_tile<1, true>(S, kb_, PS1, vtb + j * 64, 4096, j * 64, qf, slope, t, sb, c16, q4);
        else attn_tile<1, false>(S, kb_, PS1, vtb + j * 64, 4096, j * 64, qf, slope, t, sb, c16, q4);
      }
    }
    attn_fold(S, oacc, gp, 1, invl, lane);
    attn_reset(S);
    {
      const u16* vtb = VT + (size_t)((1 * 8 + b) * 2 + g) * 64 * 4096;
      int j0 = t0 - 511; if (j0 < 0) j0 = 0; j0 >>= 6;
#pragma unroll 1
      for (int j = j0; j <= cur; ++j) {
        const u16* kb_ = P1 + (size_t)(b * 4096 + j * 64) * PS1 + 896 + g * 64;
        const bool full = (j < cur) && (j * 64 >= t0 + 7 - 511);
        if (full) attn_tile<2, true>(S, kb_, PS1, vtb + j * 64, 4096, j * 64, qf, slope, t, true, c16, q4);
        else attn_tile<2, false>(S, kb_, PS1, vtb + j * 64, 4096, j * 64, qf, slope, t, true, c16, q4);
      }
    }
    attn_fold(S, oacc, gp, 2, invl, lane);
#pragma unroll
    for (int nq = 0; nq < 2; ++nq) {
      const int hh = nq * 2 + (c16 >> 3);
      u16* rp = P1 + (size_t)(tok0 + tq) * PS1 + (g * 4 + hh) * 64;
#pragma unroll
      for (int md = 0; md < 4; ++md) {
        const float* a = oacc + ((md * 2 + nq) * 4) * 64 + lane;
        uint2 o; o.x = pack2(a[0], a[64]); o.y = pack2(a[128], a[192]);
        *(uint2*)(rp + md * 16 + q4 * 4) = o;
      }
    }
  }
}

__device__ __forceinline__ const float* modp(const Params& p, int l, int sub, int kind) {
  return (const float*)(p.ws + OFF_MOD) + (size_t)l * 8 * 9216 + sub * 3072 + kind * 1024;
}

__device__ __forceinline__ void run_phase(const Params& p, int ph, char* smem) {
  char* ws = p.ws;
  if (ph == 0) {
    if (blockIdx.x == 0) { unsigned* c = (unsigned*)(ws + OFF_CNT); for (int e = tidx(); e < 1024; e += 256) c[e] = 0u; }
    phase_mod(p, smem);
  }
  int l = 0, s = -1;
  if (ph >= 2) { l = (ph - 2) / 14; s = (ph - 2) % 14; }
  const float* preg = p.in[4] + (size_t)l * 3 * 1024; const float* postg = p.in[5] + (size_t)l * 3 * 1024;
  const bool is_norm = (ph == 1) || s == 2 || s == 10 || s == 13;
  if (is_norm) {
    const float* xin = p.out; float* xout = p.out; const u16* y = nullptr; const float* pg = nullptr; const float* gate = nullptr; float wgt = 0.f;
    const float* prg = nullptr; const float* sh = nullptr; const float* sc = nullptr; u16* h = (u16*)(ws + OFF_H);
    if (ph == 1) { xin = p.in[0]; prg = p.in[4]; sh = modp(p, 0, 0, 0); sc = modp(p, 0, 0, 1); }
    else if (s == 2) { y = (const u16*)(ws + OFF_YF); pg = postg; gate = modp(p, l, 0, 2); wgt = 0.5f; prg = preg + 1024; sh = modp(p, l, 1, 0); sc = modp(p, l, 1, 1); }
    else if (s == 10) { y = (const u16*)(ws + OFF_YM); pg = postg + 1024; gate = modp(p, l, 1, 2); wgt = 1.0f; prg = preg + 2048; sh = modp(p, l, 2, 0); sc = modp(p, l, 2, 1); }
    else { y = (const u16*)(ws + OFF_YF); pg = postg + 2048; gate = modp(p, l, 2, 2); wgt = 0.5f;
      if (l == 0) { prg = p.in[4] + 3 * 1024; sh = modp(p, 1, 0, 0); sc = modp(p, 1, 0, 1); } else { h = nullptr; } }
    phase_norm(xin, xout, y, pg, gate, wgt, prg, sh, sc, h);
  }
  {
    int cl = -1, cf = 0;
    if (ph == 0) { cl = 0; cf = 0; } else if (s == 2) { cl = l; cf = 1; } else if (s == 13 && l == 0) { cl = 1; cf = 0; }
    if (cl >= 0) conv_ffn(p, cl, cf, smem);
    if (cl >= 0 && cf == 0) conv_mix(p, cl, smem);
  }
  if (s == 0 || s == 11) phase_ffn_in(p, smem);
  if (s == 1 || s == 12 || s == 9) {
    const bool o = (s == 9);
    phase_gemm_plain((const u16*)(ws + (o ? OFF_MERGED : OFF_ACT)), o ? 1024 : DFF, (const u16*)(ws + (o ? OFF_WO : OFF_WOUT)), o ? 1024 : DFF,
                     (u16*)(ws + (o ? OFF_YM : OFF_YF)), smem);
  }
  if (s == 3) phase_inproj(p, smem);
  if (s == 4) { phase_prep1(p, l); phase_sgu(p, l, smem); phase_cmp1(p, l, smem); }
  if (s == 5) { phase_prep2m(p, l, smem); phase_cmp2(p, l); }
  if (s == 6) {
    const int nb = gridDim.x;
    const int sid = (nb >= 512) ? (((int)blockIdx.x >= 256) ? -1 : (int)blockIdx.x) : (int)blockIdx.x;
    const int sstride = (nb >= 512) ? (nb >> 1) : nb;
    if (sid >= 0) {
      __builtin_amdgcn_s_setprio(3);
      for (int it = sid; it < 256; it += sstride) scan_item(p, it, smem);
      __builtin_amdgcn_s_setprio(0);
    }
    phase_nsa(p, smem, (unsigned*)(ws + OFF_CNT) + 64 + l * 64);
  }
  if (s == 7) phase_postm(p, l, smem);
  if (s == 8) phase_merge(p, smem);
}

constexpr int NPHASE = 30;

#if COOP
typedef const float* __attribute__((address_space(4))) const* kargp_t;
template <int PH>
__device__ __forceinline__ void run_seq(char* smem, cg::grid_group& grid) {
  if constexpr (PH < NPHASE) {
    {
      kargp_t ka = (kargp_t)__builtin_amdgcn_kernarg_segment_ptr();
      asm volatile("" : "+s"(ka));
      Params q;
#pragma unroll
      for (int i = 0; i < 35; ++i) q.in[i] = ka[i];
      q.out = (float*)ka[35];
      q.ws = (char*)ka[36];
      run_phase(q, PH, smem);
    }
    if constexpr (PH == 0) {
      kargp_t kb = (kargp_t)__builtin_amdgcn_kernarg_segment_ptr();
      asm volatile("" : "+s"(kb));
      unsigned* bar = (unsigned*)((char*)kb[36] + OFF_XB);
      if (kb[36] == nullptr) grid.sync();
      if (tidx() == 0) {
        const unsigned x = xb_xcc_id();
        unsigned nloc, nx, sum;
        for (;;) {
          nloc = 1u; nx = 0u; sum = 0u;
          for (unsigned j = 0; j < 16; ++j) { const unsigned c = xb_ld(&bar[XB_XCNT(j)]); sum += c; nx += (c > 0u) ? 1u : 0u; if (j == x) nloc = c; }
          if (sum == gridDim.x) break;
          __builtin_amdgcn_s_sleep(2);
        }
        __hip_atomic_store(&bar[XB_SLOT(blockIdx.x)], nloc, __ATOMIC_RELAXED, __HIP_MEMORY_SCOPE_AGENT);
        __hip_atomic_store(&bar[XB_SLOT(blockIdx.x) + 1], nx, __ATOMIC_RELAXED, __HIP_MEMORY_SCOPE_AGENT);
      }
      gbar_xcd(bar);
    } else if constexpr (PH + 1 < NPHASE) {
      kargp_t kb = (kargp_t)__builtin_amdgcn_kernarg_segment_ptr();
      asm volatile("" : "+s"(kb));
      gbar_xcd((unsigned*)((char*)kb[36] + OFF_XB));
    }
    run_seq<PH + 1>(smem, grid);
  }
}

__global__ void __launch_bounds__(256, 2) mega(Params p) {
  __shared__ __attribute__((aligned(16))) char smem[SMEM_BYTES];
  cg::grid_group grid = cg::this_grid();
  {
    kargp_t kb = (kargp_t)__builtin_amdgcn_kernarg_segment_ptr();
    asm volatile("" : "+s"(kb));
    if (tidx() == 0) xb_add(&((unsigned*)((char*)kb[36] + OFF_XB))[XB_XCNT(xb_xcc_id())], 1u);
  }
  run_seq<0>(smem, grid);
}
#endif

template <int PH>
__global__ void __launch_bounds__(256, 2) kph(Params p) {
  __shared__ __attribute__((aligned(16))) char smem[SMEM_BYTES];
  run_phase(p, PH, smem);
}

template <int PH>
static void launch_seq(const Params& p, int grid, hipStream_t stream) {
  if constexpr (PH < NPHASE) {
    kph<PH><<<grid, 256, 0, stream>>>(p);
    launch_seq<PH + 1>(p, grid, stream);
  }
}

extern "C" void kernel_launch(void* const* d_in, const int* in_sizes, int n_in, void* d_out, int out_size, void* d_ws, size_t ws_size,
                              hipStream_t stream) {
  static int grid_blocks = 0;
  if (!grid_blocks) {
    int dev = 0, cus = 0, per_cu = 0;
    hipGetDevice(&dev);
    hipDeviceGetAttribute(&cus, hipDeviceAttributeMultiprocessorCount, dev);
    #if COOP
    hipOccupancyMaxActiveBlocksPerMultiprocessor(&per_cu, mega, 256, 0);
#else
    per_cu = 2;
#endif
    if (per_cu > 2) per_cu = 2;
    if (per_cu < 1) per_cu = 1;
    grid_blocks = cus * per_cu;
  }
  Params p{};
  for (int i = 0; i < 35; ++i) p.in[i] = (const float*)d_in[i];
  p.out = (float*)d_out;
  p.ws = (char*)d_ws;
#if COOP
  hipMemsetAsync((char*)d_ws + OFF_XB, 0, XB_BYTES, stream);
  void* args[] = {&p};
  hipError_t e = hipLaunchCooperativeKernel((void*)mega, dim3(grid_blocks), dim3(256), args, 0, stream);
  if (e != hipSuccess) fprintf(stderr, "cooperative launch failed: %s (grid %d)\n", hipGetErrorString(e), grid_blocks);
#else
  launch_seq<0>(p, grid_blocks, stream);
#endif
}
```
